# Optimizing an MI355X kernel written in HIP

```python
import math
import jax
import jax.numpy as jnp
from jax import lax
import numpy as np

D_MODEL = 1024
BATCH = 8
SEQ = 2048
DEPTH = 4

GRID_W = 64
CTX_LEN = 256
Q_BLOCK = 128
ROPE_THETA = 10000.0
EPS = 1e-6

DA_HEADS = 4
DA_HD = 64
DA_VD = 2 * DA_HD
ML_HEADS = 4
ML_QK = 64
ML_V = 128
ML_CHUNK = 64
GQ_HEADS = 8
GQ_KV = 2
GQ_HD = 64
DN_HEADS = 4
DN_HD = 128
DN_CHUNK = 64
DN_CONV = 3
DN_QKV = 3 * DN_HEADS * DN_HD
D_FF = -(-8 * D_MODEL // (3 * 256)) * 256

N_EVEN = (DEPTH + 1) // 2
N_ODD = DEPTH // 2
EVEN_WIDTHS = [DA_HEADS * 2 * DA_HD, DA_HEADS * 2 * DA_HD, DA_HEADS * DA_VD,
               ML_HEADS * ML_QK, ML_HEADS * ML_QK, ML_HEADS * ML_V, ML_HEADS * ML_V, 4 * ML_HEADS]
E_IN = sum(EVEN_WIDTHS)
MIX_EVEN = DA_HEADS * DA_VD + ML_HEADS * ML_V
ODD_WIDTHS = [GQ_HEADS * GQ_HD, GQ_KV * GQ_HD, GQ_KV * GQ_HD, DN_QKV, DN_HEADS * DN_HD, 4 * DN_HEADS]
O_IN = sum(ODD_WIDTHS)
MIX_ODD = GQ_HEADS * GQ_HD + DN_HEADS * DN_HD

kernel_name = 'hybrid_diffusion_backbone'


def rms_norm(x, g):
    xf = x.astype(jnp.float32)
    y = xf * lax.rsqrt(jnp.mean(xf * xf, axis=-1, keepdims=True) + EPS)
    return (y * g.astype(jnp.float32)).astype(x.dtype)


def l2norm(t):
    tf = t.astype(jnp.float32)
    return (tf * lax.rsqrt(jnp.sum(tf * tf, axis=-1, keepdims=True) + EPS)).astype(t.dtype)


def modulate(h, shift, scale):
    return h * (1 + scale) + shift


def split_cols(p, widths):
    return jnp.split(p, np.cumsum(widths)[:-1].tolist(), axis=-1)


def to_heads(t, h):
    b, l, w = t.shape
    return t.reshape(b, l, h, w // h).transpose(0, 2, 1, 3)


def from_heads(t):
    b, h, l, d = t.shape
    return t.transpose(0, 2, 1, 3).reshape(b, l, h * d)


def flip_seq(t):
    return jnp.flip(t, axis=2)


def to_chunks(t, nc, c):
    return jnp.moveaxis(t.reshape(t.shape[:2] + (nc, c) + t.shape[3:]), 2, 0)


def from_chunks(t, l):
    t = jnp.moveaxis(t, 0, 2)
    return t.reshape(t.shape[:2] + (l,) + t.shape[4:])


def axial_rope_tables(n_tok, head_dim):
    rows = n_tok // GRID_W
    quarter = head_dim // 4
    freqs = ROPE_THETA ** (-jnp.arange(quarter, dtype=jnp.float32) / quarter)
    row = jnp.repeat(jnp.arange(rows, dtype=jnp.float32), GRID_W)
    col = jnp.tile(jnp.arange(GRID_W, dtype=jnp.float32), rows)
    ang = jnp.concatenate([row[:, None] * freqs, col[:, None] * freqs], axis=-1)
    return jnp.cos(ang), jnp.sin(ang)


def apply_rope(x, cos, sin):
    shp = x.shape
    q = shp[-1] // 4
    xr = x.reshape(shp[:-1] + (2, 2, q))
    x1, x2 = xr[..., 0, :], xr[..., 1, :]
    c = cos.reshape(cos.shape[0], 2, q)
    s = sin.reshape(sin.shape[0], 2, q)
    out = jnp.stack([x1 * c - x2 * s, x2 * c + x1 * s], axis=-2)
    return out.reshape(shp).astype(x.dtype)


def softmax_mix(q, k, v, coef):
    scale = q.shape[-1] ** -0.5
    s = jnp.einsum('mbhgqd,mbhkd->mbhgqk', q, k).astype(jnp.float32) * scale
    p = jnp.einsum('m,mbhgqk->bhgqk', coef.astype(jnp.float32), jax.nn.softmax(s, axis=-1))
    return jnp.einsum('bhgqk,bhkv->bhgqv', p.astype(v.dtype), v)


def blocked_softmax_mix(q, k, v, coef):
    m, b, hk, g, lq, d = q.shape
    nb = lq // Q_BLOCK
    qb = jnp.moveaxis(q.reshape(m, b, hk, g, nb, Q_BLOCK, d), 4, 0)
    out = lax.map(lambda qi: softmax_mix(qi, k, v, coef), qb)
    return jnp.moveaxis(out, 0, 4).reshape(b, hk, g, lq, v.shape[-1])


def short_conv(x, w):
    kw = w.shape[0]
    pad = (kw - 1) // 2
    y = lax.conv_general_dilated(x, w[:, None, :].astype(x.dtype), window_strides=(1,),
                                 padding=[(pad, kw - 1 - pad)], dimension_numbers=('NWC', 'WIO', 'NWC'),
                                 feature_group_count=x.shape[-1])
    return jax.nn.silu(y)


def mlstm_scan(q, k, v, i_pre, f_pre, state, emit):
    b, h, l, dk = q.shape
    nc = l // ML_CHUNK
    f32 = jnp.float32
    logf = jax.nn.log_sigmoid(f_pre.astype(f32))
    xs = tuple(to_chunks(t, nc, ML_CHUNK) for t in (q.astype(f32), k.astype(f32), v.astype(f32), i_pre.astype(f32), logf))
    causal = jnp.tril(jnp.ones((ML_CHUNK, ML_CHUNK), bool))

    def step(carry, inp):
        c_st, n_st, m_st = carry
        qc, kc, vc, ic, lfc = inp
        bcum = jnp.cumsum(lfc, axis=-1)
        b_end = bcum[..., -1]
        w_end = b_end[..., None] - bcum + ic
        m_new = jnp.maximum(b_end + m_st, jnp.max(w_end, axis=-1))
        decay = jnp.exp(b_end + m_st - m_new)
        w = jnp.exp(w_end - m_new[..., None])
        c_new = decay[..., None, None] * c_st + jnp.einsum('bhs,bhsk,bhsv->bhkv', w, kc, vc)
        n_new = decay[..., None] * n_st + jnp.einsum('bhs,bhsk->bhk', w, kc)
        out = None
        if emit:
            a = bcum + m_st[..., None]
            dmat = jnp.where(causal, bcum[..., :, None] - bcum[..., None, :] + ic[..., None, :], -jnp.inf)
            mt = jnp.maximum(a, jnp.max(dmat, axis=-1))
            inter = jnp.exp(a - mt)
            p = jnp.exp(dmat - mt[..., None]) * jnp.einsum('bhtk,bhsk->bhts', qc, kc)
            num = inter[..., None] * jnp.einsum('bhtk,bhkv->bhtv', qc, c_st) + jnp.einsum('bhts,bhsv->bhtv', p, vc)
            den = inter * jnp.einsum('bhtk,bhk->bht', qc, n_st) + jnp.sum(p, axis=-1)
            out = num / jnp.maximum(jnp.abs(den), jnp.exp(-mt))[..., None]
        return (c_new, n_new, m_new), out

    final, hs = lax.scan(step, state, xs)
    hout = from_chunks(hs, l).astype(v.dtype) if emit else None
    return hout, final


def deltanet_scan(q, k, v, log_decay, beta, state, emit):
    b, h, l, dk = q.shape
    dv = v.shape[-1]
    nc = l // DN_CHUNK
    f32 = jnp.float32
    xs = tuple(to_chunks(t.astype(f32), nc, DN_CHUNK) for t in (q, k, v, log_decay, beta))
    incl = jnp.tril(jnp.ones((DN_CHUNK, DN_CHUNK), bool))
    strict = jnp.tril(jnp.ones((DN_CHUNK, DN_CHUNK), bool), -1)

    def step(s, inp):
        qc, kc, vc, gc, bc = inp
        gcum = jnp.cumsum(gc, axis=-1)
        decay_ts = jnp.exp(jnp.where(incl, gcum[..., :, None] - gcum[..., None, :], -jnp.inf))
        a = jnp.where(strict, bc[..., :, None] * decay_ts * jnp.einsum('bhtk,bhsk->bhts', kc, kc), 0.0)
        gam = jnp.exp(gcum)
        rhs = jnp.concatenate([bc[..., None] * vc, (bc * gam)[..., None] * kc], axis=-1)
        sol = lax.linalg.triangular_solve(a, rhs, left_side=True, lower=True, unit_diagonal=True)
        u = sol[..., :dv] - jnp.einsum('bhtk,bhkv->bhtv', sol[..., dv:], s)
        g_end = gcum[..., -1]
        s_new = jnp.exp(g_end)[..., None, None] * s + jnp.einsum(
            'bhsk,bhsv->bhkv', kc * jnp.exp(g_end[..., None] - gcum)[..., None], u)
        out = None
        if emit:
            attn = jnp.einsum('bhtk,bhsk->bhts', qc, kc) * decay_ts
            out = gam[..., None] * jnp.einsum('bhtk,bhkv->bhtv', qc, s) + jnp.einsum('bhts,bhsv->bhtv', attn, u)
        return s_new, out

    s_fin, outs = lax.scan(step, state, xs)
    o = from_chunks(outs, l).astype(v.dtype) if emit else None
    return o, s_fin


def diff_attention(q_l, k_l, v_l, q_c, k_c, v_c, cos, sin, lam, lam_init, norm_g, emit_ctx):
    def maps(t):
        b, l, _ = t.shape
        return t.reshape(b, l, DA_HEADS, 2, DA_HD).transpose(3, 0, 2, 1, 4)
    ql = apply_rope(maps(q_l), cos, sin)
    kl = apply_rope(maps(k_l), cos, sin)
    qc, kc = maps(q_c), maps(k_c)
    vl, vc = to_heads(v_l, DA_HEADS), to_heads(v_c, DA_HEADS)
    lf = lam.astype(jnp.float32)
    lmb = jnp.exp(jnp.sum(lf[0] * lf[1])) - jnp.exp(jnp.sum(lf[2] * lf[3])) + lam_init
    coef = jnp.stack([jnp.ones_like(lmb), -lmb])
    k_all = jnp.concatenate([kc, kl], axis=3)
    v_all = jnp.concatenate([vc, vl], axis=2)

    def finish(o):
        return from_heads(rms_norm(o[:, :, 0], norm_g) * (1.0 - lam_init))
    y_l = finish(blocked_softmax_mix(ql[:, :, :, None], k_all, v_all, coef))
    y_c = finish(softmax_mix(qc[:, :, :, None], kc, vc, coef)) if emit_ctx else None
    return y_l, y_c


def mlstm_mixer(q_l, k_l, v_l, o_l, g_l, q_c, k_c, v_c, o_c, g_c, gate_bias, norm_g, emit_ctx):
    def prep(q, k, v, g):
        b, l, _ = g.shape
        gates = (g + gate_bias).astype(jnp.float32).reshape(b, l, 4, ML_HEADS).transpose(2, 0, 3, 1)
        return to_heads(q, ML_HEADS), to_heads(k, ML_HEADS) * (ML_QK ** -0.5), to_heads(v, ML_HEADS), gates
    ql, kl, vl, gl = prep(q_l, k_l, v_l, g_l)
    qc, kc, vc, gc = prep(q_c, k_c, v_c, g_c)
    b = ql.shape[0]
    zero = (jnp.zeros((b, ML_HEADS, ML_QK, ML_V), jnp.float32),
            jnp.zeros((b, ML_HEADS, ML_QK), jnp.float32),
            jnp.zeros((b, ML_HEADS), jnp.float32))
    hc_f, st_f = mlstm_scan(qc, kc, vc, gc[0], gc[1], zero, emit_ctx)
    hl_f, _ = mlstm_scan(ql, kl, vl, gl[0], gl[1], st_f, True)
    rc = [flip_seq(t) for t in (qc, kc, vc, gc[2], gc[3])]
    rl = [flip_seq(t) for t in (ql, kl, vl, gl[2], gl[3])]
    hc_b, st_b = mlstm_scan(rc[0], rc[1], rc[2], rc[3], rc[4], zero, emit_ctx)
    hl_b, _ = mlstm_scan(rl[0], rl[1], rl[2], rl[3], rl[4], st_b, True)

    def finish(hsum, o):
        return from_heads(rms_norm(hsum, norm_g)) * jax.nn.sigmoid(o)
    y_l = finish(hl_f + flip_seq(hl_b), o_l)
    y_c = finish(hc_f + flip_seq(hc_b), o_c) if emit_ctx else None
    return y_l, y_c


def gqa_attention(q_l, k_l, v_l, q_c, k_c, v_c, cos, sin, qk_g, emit_ctx):
    def prep(q, k, v):
        return (rms_norm(to_heads(q, GQ_HEADS), qk_g[0]), rms_norm(to_heads(k, GQ_KV), qk_g[1]), to_heads(v, GQ_KV))
    ql, kl, vl = prep(q_l, k_l, v_l)
    qc, kc, vc = prep(q_c, k_c, v_c)
    ql, kl = apply_rope(ql, cos, sin), apply_rope(kl, cos, sin)

    def group(q):
        b, h, l, d = q.shape
        return q.reshape(b, GQ_KV, h // GQ_KV, l, d)[None]

    def finish(o):
        b, hk, g, l, d = o.shape
        return from_heads(o.reshape(b, hk * g, l, d))
    coef = jnp.ones((1,), jnp.float32)
    k_all = jnp.concatenate([kc, kl], axis=2)[None]
    v_all = jnp.concatenate([vc, vl], axis=2)
    y_l = finish(blocked_softmax_mix(group(ql), k_all, v_all, coef))
    y_c = finish(softmax_mix(group(qc), kc[None], vc, coef)) if emit_ctx else None
    return y_l, y_c


def gated_deltanet(qkv_l, z_l, g_l, qkv_c, z_c, g_c, conv_w, a_log, dt_bias, norm_g, emit_ctx):
    def prep(qkv, g):
        q, k, v = jnp.split(short_conv(qkv, conv_w), 3, axis=-1)
        b, l, _ = g.shape
        gates = g.astype(jnp.float32).reshape(b, l, 2, 2, DN_HEADS)
        beta = jax.nn.sigmoid(gates[:, :, :, 0]).transpose(2, 0, 3, 1)
        log_decay = (-jnp.exp(a_log.astype(jnp.float32))
                     * jax.nn.softplus(gates[:, :, :, 1] + dt_bias.astype(jnp.float32))).transpose(2, 0, 3, 1)
        return (l2norm(to_heads(q, DN_HEADS)) * (DN_HD ** -0.5), l2norm(to_heads(k, DN_HEADS)),
                to_heads(v, DN_HEADS), beta, log_decay)
    ql, kl, vl, bl, dl = prep(qkv_l, g_l)
    qc, kc, vc, bc, dc = prep(qkv_c, g_c)
    zero = jnp.zeros((ql.shape[0], DN_HEADS, DN_HD, DN_HD), jnp.float32)
    oc_f, s_f = deltanet_scan(qc, kc, vc, dc[0], bc[0], zero, emit_ctx)
    ol_f, _ = deltanet_scan(ql, kl, vl, dl[0], bl[0], s_f, True)
    rc = [flip_seq(t) for t in (qc, kc, vc, dc[1], bc[1])]
    rl = [flip_seq(t) for t in (ql, kl, vl, dl[1], bl[1])]
    oc_b, s_b = deltanet_scan(rc[0], rc[1], rc[2], rc[3], rc[4], zero, emit_ctx)
    ol_b, _ = deltanet_scan(rl[0], rl[1], rl[2], rl[3], rl[4], s_b, True)

    def finish(o, z):
        return from_heads(rms_norm(o, norm_g)) * jax.nn.silu(z)
    y_l = finish(ol_f + flip_seq(ol_b), z_l)
    y_c = finish(oc_f + flip_seq(oc_b), z_c) if emit_ctx else None
    return y_l, y_c


def mix_even(pl, pc, cos, sin, lam, lam_init, gate_bias, da_g, ml_g, emit_ctx):
    aq_l, ak_l, av_l, bq_l, bk_l, bv_l, bo_l, bg_l = split_cols(pl, EVEN_WIDTHS)
    aq_c, ak_c, av_c, bq_c, bk_c, bv_c, bo_c, bg_c = split_cols(pc, EVEN_WIDTHS)
    ya_l, ya_c = diff_attention(aq_l, ak_l, av_l, aq_c, ak_c, av_c, cos, sin, lam, lam_init, da_g, emit_ctx)
    yb_l, yb_c = mlstm_mixer(bq_l, bk_l, bv_l, bo_l, bg_l, bq_c, bk_c, bv_c, bo_c, bg_c, gate_bias, ml_g, emit_ctx)
    y_l = jnp.concatenate([ya_l, yb_l], axis=-1)
    y_c = jnp.concatenate([ya_c, yb_c], axis=-1) if emit_ctx else None
    return y_l, y_c


def mix_odd(pl, pc, cos, sin, qk_g, conv_w, a_log, dt_bias, dn_g, emit_ctx):
    cq_l, ck_l, cv_l, dqkv_l, dz_l, dg_l = split_cols(pl, ODD_WIDTHS)
    cq_c, ck_c, cv_c, dqkv_c, dz_c, dg_c = split_cols(pc, ODD_WIDTHS)
    yc_l, yc_c = gqa_attention(cq_l, ck_l, cv_l, cq_c, ck_c, cv_c, cos, sin, qk_g, emit_ctx)
    yd_l, yd_c = gated_deltanet(dqkv_l, dz_l, dg_l, dqkv_c, dz_c, dg_c, conv_w, a_log, dt_bias, dn_g, emit_ctx)
    y_l = jnp.concatenate([yc_l, yd_l], axis=-1)
    y_c = jnp.concatenate([yc_c, yd_c], axis=-1) if emit_ctx else None
    return y_l, y_c


def swiglu(h, wg, wu, wd):
    return (jax.nn.silu(h @ wg) * (h @ wu)) @ wd


def setup_inputs(seed: int = 0) -> dict:
    key = jax.random.key(seed)
    ks = iter(jax.random.split(key, 32))
    f32 = jnp.float32

    def nrm(shape, scale):
        return jax.random.normal(next(ks), shape, f32) * scale
    d = D_MODEL
    x = nrm((BATCH, SEQ, d), 1.0)
    c = nrm((BATCH, d), 1.0)
    ctx = nrm((BATCH, CTX_LEN, d), 1.0)
    c_ctx = nrm((d,), 1.0)
    w_ada = nrm((DEPTH, d, 6 * d), 0.5 * d ** -0.5)
    b_ada = nrm((DEPTH, 6 * d), 0.02)
    g_mix = 1.0 + nrm((DEPTH, d), 0.02)
    g_ffn = 1.0 + nrm((DEPTH, d), 0.02)
    w_in_e = nrm((N_EVEN, d, E_IN), d ** -0.5)
    i_bias = nrm((N_EVEN, 2, ML_HEADS), 0.1)
    f_bias = jnp.linspace(3.0, 6.0, ML_HEADS, dtype=f32) + nrm((N_EVEN, 2, ML_HEADS), 0.1)
    b_gate_e = jnp.stack([i_bias, f_bias], axis=2).reshape(N_EVEN, 4 * ML_HEADS)
    da_lam = nrm((N_EVEN, 4, DA_HD), 0.1)
    da_norm_g = 1.0 + nrm((N_EVEN, DA_VD), 0.02)
    ml_norm_g = 1.0 + nrm((N_EVEN, ML_V), 0.02)
    w_out_e = nrm((N_EVEN, MIX_EVEN, d), MIX_EVEN ** -0.5)
    w_in_o = nrm((N_ODD, d, O_IN), d ** -0.5)
    qk_norm_g = 1.0 + nrm((N_ODD, 2, GQ_HD), 0.02)
    dn_conv = nrm((N_ODD, DN_CONV, DN_QKV), DN_CONV ** -0.5)
    dn_a_log = jnp.log(jnp.linspace(1.0, 16.0, DN_HEADS, dtype=f32)) + nrm((N_ODD, 2, DN_HEADS), 0.05)
    dt = jnp.exp(jax.random.uniform(next(ks), (N_ODD, 2, DN_HEADS), f32, math.log(1e-3), math.log(1e-1)))
    dn_dt_bias = dt + jnp.log(-jnp.expm1(-dt))
    dn_norm_g = 1.0 + nrm((N_ODD, DN_HD), 0.02)
    w_out_o = nrm((N_ODD, MIX_ODD, d), MIX_ODD ** -0.5)
    w_gate = nrm((DEPTH, d, D_FF), d ** -0.5)
    w_up = nrm((DEPTH, d, D_FF), d ** -0.5)
    w_down = nrm((DEPTH, D_FF, d), D_FF ** -0.5)
    g_final = 1.0 + nrm((d,), 0.02)
    return {'x': x, 'c': c, 'ctx': ctx, 'c_ctx': c_ctx, 'w_ada': w_ada, 'b_ada': b_ada,
            'g_mix': g_mix, 'g_ffn': g_ffn, 'w_in_e': w_in_e, 'b_gate_e': b_gate_e, 'da_lam': da_lam,
            'da_norm_g': da_norm_g, 'ml_norm_g': ml_norm_g, 'w_out_e': w_out_e, 'w_in_o': w_in_o,
            'qk_norm_g': qk_norm_g, 'dn_conv': dn_conv, 'dn_a_log': dn_a_log, 'dn_dt_bias': dn_dt_bias,
            'dn_norm_g': dn_norm_g, 'w_out_o': w_out_o, 'w_gate': w_gate, 'w_up': w_up, 'w_down': w_down,
            'g_final': g_final}


def reference(x, c, ctx, c_ctx, w_ada, b_ada, g_mix, g_ffn, w_in_e, b_gate_e, da_lam, da_norm_g, ml_norm_g,
              w_out_e, w_in_o, qk_norm_g, dn_conv, dn_a_log, dn_dt_bias, dn_norm_g, w_out_o, w_gate, w_up,
              w_down, g_final):
    n_tok = x.shape[1]
    cos, sin = axial_rope_tables(n_tok, DA_HD)
    silu_c = jax.nn.silu(c)
    silu_cc = jax.nn.silu(c_ctx)
    xl, xc = x, ctx
    for layer in range(DEPTH):
        emit_ctx = layer < DEPTH - 1
        mod_l = (silu_c @ w_ada[layer] + b_ada[layer])[:, None, :]
        mod_c = silu_cc @ w_ada[layer] + b_ada[layer]
        sh1, sc1, ga1, sh2, sc2, ga2 = jnp.split(mod_l, 6, axis=-1)
        sh1c, sc1c, ga1c, sh2c, sc2c, ga2c = jnp.split(mod_c, 6, axis=-1)
        hl = modulate(rms_norm(xl, g_mix[layer]), sh1, sc1)
        hc = modulate(rms_norm(xc, g_mix[layer]), sh1c, sc1c)
        if layer % 2 == 0:
            e = layer // 2
            lam_init = 0.8 - 0.6 * math.exp(-0.3 * layer)
            yl, yc = mix_even(hl @ w_in_e[e], hc @ w_in_e[e], cos, sin, da_lam[e], lam_init, b_gate_e[e],
                              da_norm_g[e], ml_norm_g[e], emit_ctx)
            w_out = w_out_e[e]
        else:
            o = layer // 2
            yl, yc = mix_odd(hl @ w_in_o[o], hc @ w_in_o[o], cos, sin, qk_norm_g[o], dn_conv[o], dn_a_log[o],
                             dn_dt_bias[o], dn_norm_g[o], emit_ctx)
            w_out = w_out_o[o]
        xl = xl + ga1 * (yl @ w_out)
        xl = xl + ga2 * swiglu(modulate(rms_norm(xl, g_ffn[layer]), sh2, sc2), w_gate[layer], w_up[layer], w_down[layer])
        if emit_ctx:
            xc = xc + ga1c * (yc @ w_out)
            xc = xc + ga2c * swiglu(modulate(rms_norm(xc, g_ffn[layer]), sh2c, sc2c), w_gate[layer], w_up[layer], w_down[layer])
    return rms_norm(xl, g_final)
```

```cpp
#ifndef EMU
#include <hip/hip_runtime.h>
#include <hip/hip_cooperative_groups.h>
#include <cstdio>
#include <cstdint>
#include <cmath>
#endif

#ifndef CFG_D
#define CFG_D 1024
#define CFG_B 8
#define CFG_SEQ 2048
#define CFG_CTX 256
#define CFG_FF 2816
#endif
#ifndef DIS
#define DIS 0ull
#endif
#define ON(bit) (!(((unsigned long long)(DIS) >> (bit)) & 1ull))
#ifndef REPM
#define REPM 0ull
#endif
#define REPB(bit) for (int rep_ = 0; rep_ <= (int)(((unsigned long long)(REPM) >> (bit)) & 1ull); ++rep_)
#ifndef CFG_LAYERS
#define CFG_LAYERS 4
#endif
constexpr int D = CFG_D, NB = CFG_B, SEQ = CFG_SEQ, CTX = CFG_CTX, FF = CFG_FF, DEPTH = 4, GRIDW = 64;
constexpr int ML = NB * SEQ, MC = NB * CTX, MT = ML + MC;
constexpr int LK = CTX + SEQ;
constexpr int NCC = CTX / 64, NLC = SEQ / 64, NCH = NCC + NLC;
constexpr int E_IN = 3088, O_IN = 2832, NE = 3072, NO = 2816;
constexpr int NCHAIN = NB * 4 * 2;
constexpr float EPS = 1e-6f;
constexpr int NTHREADS = 512, NWAVES = 8;
static_assert(SEQ % 256 == 0 && MC % 256 == 0 && D % 256 == 0 && FF % 256 == 0 && CTX % 64 == 0, "shape constraints");

typedef unsigned short bf16_t;
typedef short bf16x8 __attribute__((ext_vector_type(8)));
typedef short bf16x4 __attribute__((ext_vector_type(4)));
typedef float f32x4 __attribute__((ext_vector_type(4)));
typedef float f32x2 __attribute__((ext_vector_type(2)));
typedef float f32x16 __attribute__((ext_vector_type(16)));
typedef unsigned u32x4 __attribute__((ext_vector_type(4)));
typedef unsigned u32x2 __attribute__((ext_vector_type(2)));

#ifdef EMU
#define DEV static inline
#define DEVM inline
#define TIDX (EMU_TID)
#define BIDX (EMU_BID)
#define NBLK (EMU_NBLK)
#define BLOCK_SYNC() emu::block_sync()
#define WAVE_FENCE() emu::wave_sync()
#define SHFL_XOR(v, m) emu::shfl_xor((v), (m))
#define SHFL(v, s) emu::shfl((v), (s))
#define MFMA32(a, b, c) emu::mfma32((a), (b), (c))
#define EXP2F(x) exp2f(x)
#define ATOMIC_ADD_F(p, v) (*(p) += (v))
#define SCHED_FENCE() do {} while (0)
#define LOGF_NATIVE(x) logf(x)
#define WAVE_ANY(p) (wave_max((p) ? 1.0f : 0.0f) > 0.5f)
#else
namespace cg = cooperative_groups;
#define DEV __device__ __forceinline__
#define DEVM __device__ __forceinline__
#define TIDX ((int)threadIdx.x)
#define BIDX ((int)blockIdx.x)
#define NBLK ((int)gridDim.x)
#define BLOCK_SYNC() __syncthreads()
#define WAVE_FENCE() do { asm volatile("s_waitcnt lgkmcnt(0)" ::: "memory"); } while (0)
#define SHFL_XOR(v, m) __shfl_xor((v), (m))
#define SHFL(v, s) __shfl((v), (s))
#define MFMA32(a, b, c) __builtin_amdgcn_mfma_f32_32x32x16_bf16((a), (b), (c), 0, 0, 0)
#define EXP2F(x) __builtin_amdgcn_exp2f(x)
#define ATOMIC_ADD_F(p, v) atomicAdd((p), (v))
#define SCHED_FENCE() __builtin_amdgcn_sched_barrier(0)
#define LOGF_NATIVE(x) __logf(x)
#define WAVE_ANY(p) (__any(p) != 0)
#endif

DEV unsigned f2bf(float f) { unsigned u = __builtin_bit_cast(unsigned, f); return (u + 0x7fffu + ((u >> 16) & 1u)) >> 16; }
DEV float bf2f(unsigned h) { return __builtin_bit_cast(float, h << 16); }
#ifdef EMU
DEV unsigned pk2(float lo, float hi) { return f2bf(lo) | (f2bf(hi) << 16); }
#else
typedef __bf16 hw_bf16x2 __attribute__((ext_vector_type(2)));
DEV unsigned pk2(float lo, float hi) { const f32x2 v = {lo, hi}; return __builtin_bit_cast(unsigned, __builtin_convertvector(v, hw_bf16x2)); }
#endif
DEV int crow(int r, int h) { return (r & 3) + 8 * (r >> 2) + 4 * h; }
DEV float wave_sum(float v) {
#pragma unroll
    for (int o = 1; o < 64; o <<= 1) v += SHFL_XOR(v, o);
    return v;
}
DEV float wave_max(float v) {
#pragma unroll
    for (int o = 1; o < 64; o <<= 1) v = fmaxf(v, SHFL_XOR(v, o));
    return v;
}
DEV bf16x8 ld16(const void* p) { return *(const bf16x8*)p; }
DEV bf16x8 pack_acc(const f32x16& x, int s) {
    u32x4 p; p[0] = pk2(x[8 * s + 0], x[8 * s + 1]); p[1] = pk2(x[8 * s + 2], x[8 * s + 3]); p[2] = pk2(x[8 * s + 4], x[8 * s + 5]); p[3] = pk2(x[8 * s + 6], x[8 * s + 7]);
    return __builtin_bit_cast(bf16x8, p);
}
DEV bf16x8 cat44(bf16x4 lo, bf16x4 hi) { return __builtin_shufflevector(lo, hi, 0, 1, 2, 3, 4, 5, 6, 7); }
#ifndef EMU
DEV float fast_expf_(float x) { return __builtin_amdgcn_exp2f(x * 1.4426950408889634f); }
#define expf(x) fast_expf_(x)
#endif
#ifdef EMU
DEV float sigmoidf_(float x) { return 1.0f / (1.0f + expf(-x)); }
DEV float siluf_(float x) { return x / (1.0f + expf(-x)); }
#else
DEV float sigmoidf_(float x) { return __builtin_amdgcn_rcpf(1.0f + __builtin_amdgcn_exp2f(x * -1.4426950408889634f)); }
DEV float siluf_(float x) { return x * __builtin_amdgcn_rcpf(1.0f + __builtin_amdgcn_exp2f(x * -1.4426950408889634f)); }
#endif
DEV float log1pexp_(float nax) {
    const float e = expf(nax), u = 1.0f + e, d = u - 1.0f; return d == 0.0f ? e : LOGF_NATIVE(u) * (e / d); }
DEV float logsigmoidf_(float x) { return fminf(x, 0.0f) - log1pexp_(-fabsf(x)); }
DEV float softplusf_(float x) { return fmaxf(x, 0.0f) + log1pexp_(-fabsf(x)); }

constexpr size_t al256(size_t x) { return (x + 255) & ~(size_t)255; }
constexpr size_t cmax(size_t a, size_t b) { return a > b ? a : b; }
constexpr size_t OFF_CTL = 0;
constexpr size_t OFF_MOD = 1u << 20;
constexpr size_t SZ_MOD = al256((size_t)DEPTH * 9 * 6 * D * 4);
constexpr size_t ZERO_BYTES = OFF_MOD + SZ_MOD;
constexpr size_t OFF_ROPE = ZERO_BYTES;
constexpr size_t OFF_G = OFF_ROPE + al256((size_t)SEQ * 64 * 4);
constexpr size_t OFF_X = OFF_G + al256((size_t)MT * 16 * 4);
constexpr size_t OFF_WIN = OFF_X + al256((size_t)MT * D * 4);
constexpr size_t OFF_WOUT = OFF_WIN + al256((size_t)NE * D * 2);
constexpr size_t OFF_P = OFF_WOUT + al256((size_t)D * 1024 * 2);
constexpr size_t SZ_P = al256((size_t)MT * cmax(NE, FF) * 2);
constexpr size_t OFF_HY = OFF_P + SZ_P;
constexpr size_t OFF_S = OFF_HY + al256((size_t)MT * cmax(D, 1024) * 2);
constexpr size_t PE_QA = 0, PE_KA = (size_t)MT * 512, PE_VA = (size_t)MT * 1024, PE_BQ = (size_t)MT * 1536, PE_BK = (size_t)MT * 1792, PE_BV = (size_t)MT * 2048, PE_BO = (size_t)MT * 2560;
constexpr size_t PO_QC = 0, PO_KVC = (size_t)MT * 512, PO_DQKV = (size_t)MT * 768, PO_Z = (size_t)MT * 2304;
constexpr size_t SE_KP = OFF_S;
constexpr size_t SE_VT = SE_KP + al256((size_t)NB * 8 * LK * 64 * 2);
constexpr size_t SE_DCT = SE_VT + al256((size_t)NB * 4 * 128 * LK * 2);
constexpr size_t SE_DN = SE_DCT + al256((size_t)NCHAIN * NCH * 8192 * 4);
constexpr size_t SE_SC = SE_DN + al256((size_t)NCHAIN * NCH * 64 * 4);
constexpr size_t SE_PARK = SE_SC + al256((size_t)NCHAIN * NCH * 4 * 4);
constexpr size_t SE_END = SE_PARK + al256((size_t)256 * NTHREADS * 64 * 4);
constexpr size_t SF_WGU = OFF_S;
constexpr size_t SF_WDN = SF_WGU + al256((size_t)2 * FF * D * 2);
constexpr size_t SF_END = SF_WDN + al256((size_t)D * FF * 2);
constexpr size_t SF_PART = SF_END;
constexpr size_t SF_PART_END = SF_PART + (size_t)128 * 65536 * 4;
constexpr size_t WS_NEED_EF = cmax(SE_END, SF_PART_END);

constexpr int LDS_BYTES = 147456;
constexpr int LDS_MISC = 131072;

struct Args { const float* in[25]; float* out; unsigned char* ws; int step_lo, step_hi, prologue, final_; };

struct Ctx {
    int tid, lane, wave, bid, nblk, gw, ngw;
    char* lds;
    const float* const* in; float* out; unsigned char* ws;
};
#ifdef EMU
#define PHASE_CTX(pc) const Ctx& pc = c
#else
#define PHASE_CTX(pc) Ctx pc = c; { int t_ = threadIdx.x; asm volatile("" : "+v"(t_)); pc.tid = t_; pc.lane = t_ & 63; pc.wave = __builtin_amdgcn_readfirstlane(t_ >> 6); pc.gw = pc.bid * NWAVES + pc.wave; \
    __attribute__((address_space(1))) unsigned char* g_ = (__attribute__((address_space(1))) unsigned char*)c.ws; asm volatile("" : "+s"(g_)); pc.ws = (unsigned char*)g_; }
#endif

#ifdef EMU
struct XcdBarrier { int dummy; };
#define GRID_BARRIER() emu::grid_sync()
#else
#define LAS __attribute__((address_space(3)))
#define XB_TMO      128
#define XB_XCNT(j)  (256  + 64 * (j))
#define XB_XSUB(j)  (1280 + 64 * (j))
#define XB_XGEN(j)  (2304 + 64 * (j))
#define XB_TOP      3328
#define XB_TOPGEN   3392
#define XCD_BAR_WORDS 3456
#define XB_SPIN_CAP (1u << 24)
__device__ __forceinline__ unsigned xb_ld(unsigned* p)              { return __hip_atomic_load(p, __ATOMIC_RELAXED, __HIP_MEMORY_SCOPE_AGENT); }
__device__ __forceinline__ unsigned xb_add(unsigned* p, unsigned v) { return __hip_atomic_fetch_add(p, v, __ATOMIC_RELAXED, __HIP_MEMORY_SCOPE_AGENT); }
__device__ __forceinline__ unsigned xb_xcc_id() { return (unsigned)__builtin_amdgcn_s_getreg((3 << 11) | 20) & 0xFu; }
#define XB_SPIN(cond, bar) do { unsigned _sp = 0; while (cond) { __builtin_amdgcn_s_sleep(1); \
    if ((++_sp & 255u) == 0u) { if (xb_ld(&(bar)[XB_TMO])) break; if (_sp > XB_SPIN_CAP) { atomicAdd(&(bar)[XB_TMO], 1u); break; } } } } while (0)
struct XcdBarrier { unsigned* bar; unsigned x; volatile LAS unsigned* st; };
__device__ __forceinline__ XcdBarrier xcd_barrier_post(unsigned* bar, volatile LAS unsigned* st) {
    XcdBarrier b; b.bar = bar; b.x = xb_xcc_id(); b.st = st;
    if (threadIdx.x == 0) (void)xb_add(&bar[XB_XCNT(b.x)], 1u);
    return b;
}
__device__ __forceinline__ void xcd_barrier_complete(unsigned* bar, unsigned x, unsigned& nloc, unsigned& nx) {
    const unsigned G = gridDim.x * gridDim.y * gridDim.z;
    unsigned sum, cnt, mine, sp = 0u;
    for (;;) {
        sum = 0u; cnt = 0u; mine = 0u;
#pragma unroll
        for (unsigned j = 0; j < 16; ++j) { const unsigned c = xb_ld(&bar[XB_XCNT(j)]); sum += c; cnt += (c > 0u) ? 1u : 0u; mine = (j == x) ? c : mine; }
        if (sum == G) break;
        __builtin_amdgcn_s_sleep(1);
        if ((++sp & 255u) == 0u) { if (xb_ld(&bar[XB_TMO])) break; if (sp > XB_SPIN_CAP) { atomicAdd(&bar[XB_TMO], 1u); break; } }
    }
    nloc = mine > 0u ? mine : 1u; nx = cnt > 0u ? cnt : 1u;
}
__device__ __forceinline__ void xcd_barrier(const XcdBarrier& b) {
    const bool leader = threadIdx.x == 0;
    asm volatile("s_waitcnt vmcnt(0)" ::: "memory");
    __syncthreads();
    if (leader) {
        unsigned* bar = b.bar;
        __builtin_amdgcn_s_waitcnt(0);
        unsigned nloc = b.st[0], nx = b.st[1];
        if (nloc == 0u) { xcd_barrier_complete(bar, b.x, nloc, nx); b.st[0] = nloc; b.st[1] = nx; }
        const unsigned old = xb_add(&bar[XB_XSUB(b.x)], 1u);
        const unsigned gen = old / nloc;
        if (old + 1u == (gen + 1u) * nloc) {
            __builtin_amdgcn_fence(__ATOMIC_RELEASE, "agent");
            asm volatile("s_waitcnt vmcnt(0)" ::: "memory");
            const unsigned og = xb_add(&bar[XB_TOP], 1u);
            const unsigned tg = og / nx;
            if (og + 1u == (tg + 1u) * nx) xb_add(&bar[XB_TOPGEN], 1u);
            else XB_SPIN(xb_ld(&bar[XB_TOPGEN]) == tg, bar);
            __builtin_amdgcn_fence(__ATOMIC_ACQUIRE, "agent");
            xb_add(&bar[XB_XGEN(b.x)], 1u);
            asm volatile("s_waitcnt vmcnt(0)" ::: "memory");
        } else {
            XB_SPIN(xb_ld(&bar[XB_XGEN(b.x)]) == gen, bar);
            __builtin_amdgcn_fence(__ATOMIC_ACQUIRE, "agent");
            asm volatile("s_waitcnt vmcnt(0)" ::: "memory");
        }
    }
    __syncthreads();
}
#ifdef USE_CG_SYNC
#define GRID_BARRIER() cg::this_grid().sync()
#else
#define GRID_BARRIER() xcd_barrier(bar)
#endif
#endif

#ifndef EMU
namespace pg8 {
#define PG8_LAS __attribute__((address_space(3)))
typedef unsigned short bf16_t;
typedef short bf16x8 __attribute__((ext_vector_type(8)));
typedef float f32x4 __attribute__((ext_vector_type(4)));
typedef unsigned u32x4 __attribute__((ext_vector_type(4)));
constexpr int BM = 256, BK = 64, HALF = 128, HTB = HALF * BK * 2  , STAGE_BYTES = 8 * HTB, NXCD = 8, WGM = 8;

__host__ __device__ __forceinline__ int lds_byte(int r, int c) { const int st = (r >> 4) * 2 + (c >> 5), rr = r & 15, cc = c & 31, ob = rr * 64 + cc * 2; return st * 1024 + (ob ^ (((ob >> 9) & 1) << 5)); }
__host__ __device__ __forceinline__ void stage_rc(int b, int& R, int& C) { const int st = b / 1024, sb = b % 1024, swz = sb ^ (((sb >> 9) & 1) << 5); R = (st >> 1) * 16 + swz / 64; C = (st & 1) * 32 + (swz % 64) / 2; }
__host__ __device__ __forceinline__ int perm32(int rho) { const int n = rho >> 4, i = rho & 15; return 8 * (i >> 2) + 4 * n + (i & 3); }

struct Unit { int pm, pn; };
struct Gemm { const bf16_t* A; const bf16_t* Bt; int M, N, K, ld; };

struct StaticOrder {
    int nM, nN, nwg, G, c, wave, lim;
    int tn, tpm, tpn, tw;
    __host__ __device__ void init(int M, int N, int G_, int c_) { nM = M / BM; nN = N / BM; nwg = nM * nN; G = G_; c = c_; lim = 0x7fffffff; tn = 0; tpm = 0; tpn = 0; tw = 1; }
    __host__ __device__ bool next(int i, Unit& u) const {
        const long L = (long)i * G + c; if (L >= nwg + tn || L >= lim) return false;
        if (L >= nwg) { const int idx = (int)L - nwg; u.pm = tpm + idx / tw; u.pn = tpn + idx % tw; return true; }
        int wgid = (int)L; { const int q = nwg / NXCD, r = nwg % NXCD, xcd = wgid % NXCD, off = wgid / NXCD; wgid = (xcd < r ? xcd * (q + 1) : r * (q + 1) + (xcd - r) * q) + off; }
        const int nig = WGM * nN, gid = wgid / nig, fm = gid * WGM, gsz = (nM - fm) < WGM ? (nM - fm) : WGM;
        u.pm = fm + ((wgid % nig) % gsz); u.pn = (wgid % nig) / gsz; return true;
    }
    __device__ __forceinline__ void a_ready(const Unit&) const {}
    __device__ __forceinline__ void done(const Unit&) const {}
};
template <class Epi, class Sched, bool ALIGN_EPI = false, bool SP2 = false>
__device__ __forceinline__ void gemm_phase(PG8_LAS unsigned char* lds, const Gemm g, const Sched& S, const Epi& E) {
    int tid_ = threadIdx.x; asm volatile("" : "+v"(tid_));
    const int tid = tid_, wid = __builtin_amdgcn_readfirstlane(tid >> 6), lane = tid & 63, wr = wid >> 2, wc = wid & 3, fr = lane & 15, fq = lane >> 4;
    const int K = g.K, nt = K / BK, LD = g.ld ? g.ld : g.K;
    unsigned voffA[2], voffB[2];
#pragma unroll
    for (int i = 0; i < 2; ++i) { int R, C; stage_rc(tid * 16 + i * 8192, R, C); const int Rb = Epi::PERM ? ((R & ~31) + perm32(R & 31)) : R;
        voffA[i] = (unsigned)(R * LD + C) * 2u; voffB[i] = (unsigned)(Rb * LD + C) * 2u; }
    const size_t kstep = (size_t)(BK * 2);
    const size_t hstep = (size_t)HALF * LD * 2;
    const size_t tstep = 2 * hstep;
    const unsigned ldsw = (unsigned)wid * 1024u;
    const int aoff = lds_byte(wr * 64 + fr, fq * 8), boff = lds_byte(wc * 32 + fr, fq * 8);
#define PG8_SA(b, h) (((b) * 2 + (h)) * HTB)
#define PG8_SB(b, h) ((4 + (b) * 2 + (h)) * HTB)
#define PG8_STAGE(bufoff, gbase, voff) do { _Pragma("unroll") for (int _i = 0; _i < 2; ++_i) \
        __builtin_amdgcn_global_load_lds((const unsigned*)((const char*)(gbase) + (voff)[_i]), (PG8_LAS unsigned*)(lds + (bufoff) + ldsw + _i * 8192), 16, 0, 0); } while (0)
#define PG8_LDA(dst, b, h) do { _Pragma("unroll") for (int m = 0; m < 4; ++m) _Pragma("unroll") for (int k = 0; k < 2; ++k) dst[m][k] = *(const PG8_LAS bf16x8*)(lds + PG8_SA(b, h) + aoff + m * 2048 + k * 1024); } while (0)
#define PG8_LDB(dst, b, h) do { _Pragma("unroll") for (int n = 0; n < 2; ++n) _Pragma("unroll") for (int k = 0; k < 2; ++k) dst[n][k] = *(const PG8_LAS bf16x8*)(lds + PG8_SB(b, h) + boff + n * 2048 + k * 1024); } while (0)
#define PG8_MMA(ai, bj, At, Bt) do { __builtin_amdgcn_s_setprio(1); _Pragma("unroll") for (int m = 0; m < 4; ++m) _Pragma("unroll") for (int n = 0; n < 2; ++n) _Pragma("unroll") for (int k = 0; k < 2; ++k) \
        acc[ai][bj][m][n] = __builtin_amdgcn_mfma_f32_16x16x32_bf16(Bt[n][k], At[m][k], acc[ai][bj][m][n], 0, 0, 0); __builtin_amdgcn_s_setprio(0); } while (0)
#define PG8_WAIT_V(n) asm volatile("s_waitcnt vmcnt(" #n ")" ::: "memory")
#define PG8_WAIT_L(n) asm volatile("s_waitcnt lgkmcnt(" #n ")" ::: "memory")
#define PG8_BAR __builtin_amdgcn_s_barrier()
#define PG8_SCHED __builtin_amdgcn_sched_barrier(0)
    Unit cur, nxt; int ui = 0;
    if (!S.next(0, cur)) return;
    f32x4 acc[2][2][4][2];
#pragma unroll
    for (int a = 0; a < 2; ++a)
#pragma unroll
        for (int b = 0; b < 2; ++b)
#pragma unroll
            for (int m = 0; m < 4; ++m)
#pragma unroll
                for (int n = 0; n < 2; ++n) acc[a][b][m][n] = (f32x4){0.f, 0.f, 0.f, 0.f};
    bf16x8 At[4][2], B0[2][2], B1[2][2];
    const char* cA = (const char*)g.A + (size_t)cur.pm * tstep; const char* cB = (const char*)g.Bt + (size_t)cur.pn * tstep;
    S.a_ready(cur);
    if constexpr (SP2) {
        PG8_STAGE(PG8_SB(0, 0), cB, voffB); PG8_STAGE(PG8_SB(0, 1), cB + hstep, voffB); PG8_STAGE(PG8_SA(0, 0), cA, voffA); PG8_STAGE(PG8_SA(0, 1), cA + hstep, voffA);
        if (wr == 1) PG8_BAR;
        PG8_WAIT_V(2); PG8_BAR;
        PG8_STAGE(PG8_SB(1, 0), cB + kstep, voffB); PG8_STAGE(PG8_SA(1, 0), cA + kstep, voffA); PG8_STAGE(PG8_SB(1, 1), cB + hstep + kstep, voffB);
        PG8_WAIT_V(6); PG8_BAR;
    } else {
        PG8_STAGE(PG8_SB(0, 0), cB, voffB); PG8_STAGE(PG8_SA(0, 0), cA, voffA); PG8_STAGE(PG8_SB(0, 1), cB + hstep, voffB); PG8_STAGE(PG8_SA(0, 1), cA + hstep, voffA);
        if (wr == 1) PG8_BAR;
        PG8_WAIT_V(4); PG8_BAR;
        PG8_STAGE(PG8_SB(1, 0), cB + kstep, voffB); PG8_STAGE(PG8_SA(1, 0), cA + kstep, voffA); PG8_STAGE(PG8_SB(1, 1), cB + hstep + kstep, voffB);
        PG8_WAIT_V(6); PG8_BAR;
    }
    for (;;) {
        const bool has_next = S.next(ui + 1, nxt);
        const char* nA = has_next ? (const char*)g.A + (size_t)nxt.pm * tstep : cA; const char* nB = has_next ? (const char*)g.Bt + (size_t)nxt.pn * tstep : cB;
        for (int t = 0; t < nt; t += 2) {
            const bool last = (t == nt - 2);
            const char* a1 = cA + (size_t)(t + 1) * kstep;
            const char* a2 = last ? nA : cA + (size_t)(t + 2) * kstep; const char* b2 = last ? nB : cB + (size_t)(t + 2) * kstep;
            const char* a3 = a2 + kstep; const char* b3 = b2 + kstep;
            if (last && has_next) S.a_ready(nxt);
            if constexpr (SP2) {
            PG8_LDB(B0, 0, 0); PG8_LDB(B1, 0, 1); PG8_SCHED; PG8_LDA(At, 0, 0); PG8_STAGE(PG8_SA(1, 1), a1 + hstep, voffA);
            PG8_WAIT_V(8); PG8_WAIT_L(0); PG8_BAR; PG8_MMA(0, 0, At, B0); PG8_MMA(0, 1, At, B1); PG8_BAR; PG8_SCHED;
            PG8_LDA(At, 0, 1); PG8_STAGE(PG8_SB(0, 0), b2, voffB); PG8_STAGE(PG8_SB(0, 1), b2 + hstep, voffB); PG8_STAGE(PG8_SA(0, 0), a2, voffA);
            PG8_WAIT_V(8); PG8_WAIT_L(0); PG8_BAR; PG8_MMA(1, 0, At, B0); PG8_MMA(1, 1, At, B1); PG8_BAR; PG8_SCHED;
            PG8_LDB(B0, 1, 0); PG8_LDB(B1, 1, 1); PG8_SCHED; PG8_LDA(At, 1, 0); PG8_STAGE(PG8_SA(0, 1), a2 + hstep, voffA);
            PG8_WAIT_V(8); PG8_WAIT_L(0); PG8_BAR; PG8_MMA(0, 0, At, B0); PG8_MMA(0, 1, At, B1); PG8_BAR; PG8_SCHED;
            PG8_LDA(At, 1, 1); PG8_STAGE(PG8_SB(1, 0), b3, voffB); PG8_STAGE(PG8_SB(1, 1), b3 + hstep, voffB); PG8_STAGE(PG8_SA(1, 0), a3, voffA);
            PG8_WAIT_V(8); PG8_WAIT_L(0); PG8_BAR; PG8_MMA(1, 0, At, B0); PG8_MMA(1, 1, At, B1); PG8_BAR; PG8_SCHED;
            } else {
            PG8_LDB(B0, 0, 0); PG8_SCHED; PG8_LDA(At, 0, 0); PG8_STAGE(PG8_SA(1, 1), a1 + hstep, voffA);
            PG8_WAIT_L(8); PG8_BAR; PG8_WAIT_L(0); PG8_MMA(0, 0, At, B0); PG8_BAR; PG8_SCHED;
            PG8_LDB(B1, 0, 1); PG8_STAGE(PG8_SB(0, 0), b2, voffB);
            PG8_BAR; PG8_WAIT_L(0); PG8_MMA(0, 1, At, B1); PG8_BAR;
            PG8_LDA(At, 0, 1); PG8_STAGE(PG8_SA(0, 0), a2, voffA);
            PG8_BAR; PG8_WAIT_L(0); PG8_MMA(1, 0, At, B0); PG8_BAR; PG8_SCHED;
            PG8_STAGE(PG8_SB(0, 1), b2 + hstep, voffB);
            PG8_WAIT_V(6); PG8_BAR; PG8_MMA(1, 1, At, B1); PG8_BAR;
            PG8_LDB(B0, 1, 0); PG8_SCHED; PG8_LDA(At, 1, 0); PG8_STAGE(PG8_SA(0, 1), a2 + hstep, voffA);
            PG8_WAIT_L(8); PG8_BAR; PG8_WAIT_L(0); PG8_MMA(0, 0, At, B0); PG8_BAR; PG8_SCHED;
            PG8_LDB(B1, 1, 1); PG8_STAGE(PG8_SB(1, 0), b3, voffB);
            PG8_BAR; PG8_WAIT_L(0); PG8_MMA(0, 1, At, B1); PG8_BAR;
            PG8_LDA(At, 1, 1); PG8_STAGE(PG8_SA(1, 0), a3, voffA);
            PG8_BAR; PG8_WAIT_L(0); PG8_MMA(1, 0, At, B0); PG8_BAR; PG8_SCHED;
            PG8_STAGE(PG8_SB(1, 1), b3 + hstep, voffB);
            PG8_WAIT_V(6); PG8_BAR; PG8_MMA(1, 1, At, B1); PG8_BAR;
            }
        }
        if constexpr (ALIGN_EPI) { if (wr == 0) PG8_BAR; }
        if constexpr (!Epi::AFTER_DRAIN) { E(acc, cur, wr, wc, fr, fq); S.done(cur); }
        if (!has_next) break;
#pragma unroll
        for (int a = 0; a < 2; ++a)
#pragma unroll
            for (int b = 0; b < 2; ++b)
#pragma unroll
                for (int m = 0; m < 4; ++m)
#pragma unroll
                    for (int n = 0; n < 2; ++n) acc[a][b][m][n] = (f32x4){0.f, 0.f, 0.f, 0.f};
        cur = nxt; cA = nA; cB = nB; ++ui;
        if constexpr (ALIGN_EPI) { if (wr == 1) PG8_BAR; }
    }
    PG8_WAIT_V(0);
    if constexpr (!ALIGN_EPI) { if (wr == 0) PG8_BAR; }
    PG8_BAR;
    if constexpr (Epi::AFTER_DRAIN) { E.fused(acc, cur, wr, wc, fr, fq, lds, wid, lane); S.done(cur); }
#undef PG8_SA
#undef PG8_SB
#undef PG8_STAGE
#undef PG8_LDA
#undef PG8_LDB
#undef PG8_MMA
#undef PG8_WAIT_V
#undef PG8_WAIT_L
#undef PG8_BAR
#undef PG8_SCHED
}
}
#else
namespace pg8 {
typedef unsigned short bf16_t;
constexpr int BM = 256, BK = 64, HALF = 128, NXCD = 8, WGM = 8;
struct Unit { int pm, pn; };
struct Gemm { const bf16_t* A; const bf16_t* Bt; int M, N, K, ld; };
struct StaticOrder {
    int nM, nN, nwg, G, c, wave, lim, tn, tpm, tpn, tw;
    void init(int M, int N, int G_, int c_) { nM = M / BM; nN = N / BM; nwg = nM * nN; G = G_; c = c_; lim = 0x7fffffff; tn = 0; tpm = 0; tpn = 0; tw = 1; }
    bool next(int i, Unit& u) const {
        const long L = (long)i * G + c; if (L >= nwg + tn || L >= lim) return false;
        if (L >= nwg) { const int idx = (int)L - nwg; u.pm = tpm + idx / tw; u.pn = tpn + idx % tw; return true; }
        int wgid = (int)L; { const int q = nwg / NXCD, r = nwg % NXCD, xcd = wgid % NXCD, off = wgid / NXCD; wgid = (xcd < r ? xcd * (q + 1) : r * (q + 1) + (xcd - r) * q) + off; }
        const int nig = WGM * nN, gid = wgid / nig, fm = gid * WGM, gsz = (nM - fm) < WGM ? (nM - fm) : WGM;
        u.pm = fm + ((wgid % nig) % gsz); u.pn = (wgid % nig) / gsz; return true;
    }
};
template <class Epi, class Sched, bool ALIGN_EPI = false, bool SP2 = false>
static inline void gemm_phase(unsigned char* lds, const Gemm g, const Sched& S, const Epi& E) {
    const int tid = TIDX, wid = tid >> 6, lane = tid & 63, wr = wid >> 2, wc = wid & 3, fr = lane & 15, fq = lane >> 4;
    Unit u;
    for (int i = 0; S.next(i, u); ++i) {
        f32x4 acc[2][2][4][2];
        for (int ai = 0; ai < 2; ++ai) for (int bj = 0; bj < 2; ++bj) for (int m = 0; m < 4; ++m) for (int n = 0; n < 2; ++n) for (int j = 0; j < 4; ++j) {
            const int row = 256 * u.pm + 128 * ai + 64 * wr + 16 * m + fr;
            const int col = Epi::PERM ? 256 * u.pn + 128 * bj + 32 * wc + 8 * fq + 4 * n + j : 256 * u.pn + 128 * bj + 32 * wc + 16 * n + 4 * fq + j;
            const int ld = g.ld ? g.ld : g.K; const bf16_t* a = g.A + (size_t)row * ld; const bf16_t* b = g.Bt + (size_t)col * ld; float s = 0.f;
            for (int k = 0; k < g.K; ++k) s += bf2f(a[k]) * bf2f(b[k]);
            acc[ai][bj][m][n][j] = s; }
        E(acc, u, wr, wc, fr, fq);
    }
    BLOCK_SYNC();
}
}
#define PG8_LAS
#endif

#if !defined(EMU) && defined(SIMPLE_GEMM)
namespace sg {
template <class Epi, class Sched>
__device__ __forceinline__ void gemm_phase(const pg8::Gemm g, const Sched& S, const Epi& E) {
    int tid_ = threadIdx.x; asm volatile("" : "+v"(tid_));
    const int tid = tid_, wid = __builtin_amdgcn_readfirstlane(tid >> 6), lane = tid & 63, wr = wid >> 2, wc = wid & 3, fr = lane & 15, fq = lane >> 4;
    pg8::Unit u;
    for (int i = 0; S.next(i, u); ++i) {
        f32x4 acc[2][2][4][2];
#pragma unroll
        for (int ai = 0; ai < 2; ++ai)
#pragma unroll
            for (int bj = 0; bj < 2; ++bj)
#pragma unroll
                for (int m = 0; m < 4; ++m)
#pragma unroll
                    for (int n = 0; n < 2; ++n) acc[ai][bj][m][n] = (f32x4){0.f, 0.f, 0.f, 0.f};
        const bf16_t* wp0 = g.Bt + (size_t)(256 * u.pn + 32 * wc + (Epi::PERM ? 8 * (fr >> 2) + (fr & 3) : fr)) * g.K + 8 * fq;
        const bf16_t* xp0 = g.A + (size_t)(256 * u.pm + 64 * wr + fr) * g.K + 8 * fq;
#pragma unroll 1
        for (int k0 = 0; k0 < g.K; k0 += 32) {
            bf16x8 wf[2][2], xf[2][4];
#pragma unroll
            for (int bj = 0; bj < 2; ++bj)
#pragma unroll
                for (int n = 0; n < 2; ++n) wf[bj][n] = *(const bf16x8*)(wp0 + (size_t)(128 * bj + (Epi::PERM ? 4 : 16) * n) * g.K + k0);
#pragma unroll
            for (int ai = 0; ai < 2; ++ai)
#pragma unroll
                for (int m = 0; m < 4; ++m) xf[ai][m] = *(const bf16x8*)(xp0 + (size_t)(128 * ai + 16 * m) * g.K + k0);
#pragma unroll
            for (int ai = 0; ai < 2; ++ai)
#pragma unroll
                for (int bj = 0; bj < 2; ++bj)
#pragma unroll
                    for (int m = 0; m < 4; ++m)
#pragma unroll
                        for (int n = 0; n < 2; ++n) acc[ai][bj][m][n] = __builtin_amdgcn_mfma_f32_16x16x32_bf16(wf[bj][n], xf[ai][m], acc[ai][bj][m][n], 0, 0, 0);
        }
        E(acc, u, wr, wc, fr, fq);
    }
}
}
#define GEMM_PHASE(EpiT, lds, g, S, E) sg::gemm_phase<EpiT, pg8::StaticOrder>(g, S, E)
#else
#define GEMM_PHASE(EpiT, lds, g, S, E) pg8::gemm_phase<EpiT, pg8::StaticOrder, true, true>((PG8_LAS unsigned char*)(lds), g, S, E)
#endif

struct EpiSeg {
    static constexpr bool PERM = true, AFTER_DRAIN = false;
    bf16_t* P; int odd;
    DEVM void operator()(const f32x4 (&acc)[2][2][4][2], const pg8::Unit& u, int wr, int wc, int fr, int fq) const {
        size_t off; int pitch, c0;
        const int pn = u.pn;
        if (!odd) {
            if (pn < 2) { off = PE_QA; pitch = 512; c0 = 256 * pn; } else if (pn < 4) { off = PE_KA; pitch = 512; c0 = 256 * (pn - 2); } else if (pn < 6) { off = PE_VA; pitch = 512; c0 = 256 * (pn - 4); }
            else if (pn == 6) { off = PE_BQ; pitch = 256; c0 = 0; } else if (pn == 7) { off = PE_BK; pitch = 256; c0 = 0; } else if (pn < 10) { off = PE_BV; pitch = 512; c0 = 256 * (pn - 8); } else { off = PE_BO; pitch = 512; c0 = 256 * (pn - 10); }
        } else {
            if (pn < 2) { off = PO_QC; pitch = 512; c0 = 256 * pn; } else if (pn == 2) { off = PO_KVC; pitch = 256; c0 = 0; } else if (pn < 9) { off = PO_DQKV; pitch = 1536; c0 = 256 * (pn - 3); } else { off = PO_Z; pitch = 512; c0 = 256 * (pn - 9); }
        }
        bf16_t* base = P + off;
        const int row0 = u.pm * 256 + wr * 64 + fr, col0 = c0 + wc * 32 + 8 * fq;
#pragma unroll
        for (int ai = 0; ai < 2; ++ai)
#pragma unroll
            for (int m = 0; m < 4; ++m) { bf16_t* rowp = base + (size_t)(row0 + ai * 128 + m * 16) * pitch + col0;
#pragma unroll
                for (int bj = 0; bj < 2; ++bj) { const f32x4 v0 = acc[ai][bj][m][0], v1 = acc[ai][bj][m][1];
                    u32x4 w; w[0] = pk2(v0[0], v0[1]); w[1] = pk2(v0[2], v0[3]); w[2] = pk2(v1[0], v1[1]); w[3] = pk2(v1[2], v1[3]);
                    *(u32x4*)(rowp + bj * 128) = w; } }
    }
};
struct EpiResid {
    static constexpr bool PERM = false, AFTER_DRAIN = false;
    float* X; const float* mod; int gaoff;
    const float* XL; const float* XC;
    DEVM void operator()(const f32x4 (&acc)[2][2][4][2], const pg8::Unit& u, int wr, int wc, int fr, int fq) const {
        const int rowt = u.pm * 256; const int mr = rowt < ML ? rowt / SEQ : NB;
        const float* ga = mod + (size_t)mr * 6 * D + gaoff; const float* Xs = rowt < ML ? XL : XC;
        const int row0 = rowt + wr * 64 + fr, col0 = u.pn * 256 + wc * 32 + 4 * fq;
#pragma unroll
        for (int bj = 0; bj < 2; ++bj)
#pragma unroll
            for (int n = 0; n < 2; ++n) { const int c = col0 + bj * 128 + n * 16; const f32x4 g = *(const f32x4*)(ga + c);
#pragma unroll
                for (int ai = 0; ai < 2; ++ai)
#pragma unroll
                    for (int m = 0; m < 4; ++m) { const size_t off = (size_t)(row0 + ai * 128 + m * 16) * D + c; const f32x4 x = *(const f32x4*)(Xs + off); *(f32x4*)(X + off) = x + g * acc[ai][bj][m][n]; } }
    }
};
struct EpiPart {
    static constexpr bool PERM = false, AFTER_DRAIN = false;
    float* P;
    DEVM void operator()(const f32x4 (&acc)[2][2][4][2], const pg8::Unit& u, int wr, int wc, int fr, int fq) const {
        (void)u; const int r0 = wr * 64 + fr, c0 = wc * 32 + 4 * fq;
#pragma unroll
        for (int bj = 0; bj < 2; ++bj)
#pragma unroll
            for (int n = 0; n < 2; ++n)
#pragma unroll
                for (int ai = 0; ai < 2; ++ai)
#pragma unroll
                    for (int m = 0; m < 4; ++m) *(f32x4*)(P + (size_t)(r0 + ai * 128 + m * 16) * 256 + c0 + bj * 128 + n * 16) = acc[ai][bj][m][n];
    }
};
struct SplitPlan { int extra, split, nwg; };
DEV SplitPlan split_plan(int mrows, int kdim, int nblk, bool allow) {
    SplitPlan p; p.nwg = (mrows / 256) * (D / 256); p.extra = 0; p.split = 1;
    if (allow && p.nwg > nblk && p.nwg < 2 * nblk) { const int pairs = kdim / 128; int sp = 4; const int ex = p.nwg - nblk;
        while (sp > 1 && (ex * sp > nblk || sp > pairs || ex * sp > 128)) sp >>= 1;
        if (sp > 1) { p.extra = ex; p.split = sp; } }
    return p;
}

struct EpiSwiglu {
    static constexpr bool PERM = true, AFTER_DRAIN = false;
    bf16_t* ACT;
    DEVM void operator()(const f32x4 (&acc)[2][2][4][2], const pg8::Unit& u, int wr, int wc, int fr, int fq) const {
        const int row0 = u.pm * 256 + wr * 64 + fr, col0 = u.pn * 128 + wc * 32 + 8 * fq;
#pragma unroll
        for (int ai = 0; ai < 2; ++ai)
#pragma unroll
            for (int m = 0; m < 4; ++m) { bf16_t* rowp = ACT + (size_t)(row0 + ai * 128 + m * 16) * FF + col0;
                float v[8];
#pragma unroll
                for (int n = 0; n < 2; ++n)
#pragma unroll
                    for (int j = 0; j < 4; ++j) { const float g = acc[ai][0][m][n][j], up = acc[ai][1][m][n][j]; v[4 * n + j] = siluf_(g) * up; }
                u32x4 w; w[0] = pk2(v[0], v[1]); w[1] = pk2(v[2], v[3]); w[2] = pk2(v[4], v[5]); w[3] = pk2(v[6], v[7]);
                *(u32x4*)rowp = w; }
    }
};

DEV void p0_prologue(const Ctx& c) {
    const float* x = c.in[0]; const float* cv = c.in[1]; const float* ctx = c.in[2]; const float* cctx = c.in[3]; const float* w_ada = c.in[4]; const float* b_ada = c.in[5];
    float* MOD = (float*)(c.ws + OFF_MOD);
    const long gt = (long)c.bid * NTHREADS + c.tid, GT = (long)c.nblk * NTHREADS;
    {   constexpr int NCG = 6 * D / 128, KW = D / 8; f32x2* part = (f32x2*)c.lds;
        for (int it = c.bid; it < DEPTH * NCG; it += c.nblk) { const int l = it / NCG, cg = it % NCG; const int n2 = cg * 64 + c.lane;
            f32x2 acc[9];
#pragma unroll
            for (int r = 0; r < 9; ++r) acc[r] = (f32x2){0.f, 0.f};
            const float* W = w_ada + ((size_t)l * D + c.wave * KW) * 6 * D + 2 * n2;
#pragma unroll 8
            for (int k = 0; k < KW; ++k) { const f32x2 w = *(const f32x2*)(W + (size_t)k * 6 * D); const int kk = c.wave * KW + k;
#pragma unroll
                for (int r = 0; r < 9; ++r) { const float sv = siluf_(r < NB ? cv[r * D + kk] : cctx[kk]); acc[r] += w * sv; } }
#pragma unroll
            for (int r = 0; r < 9; ++r) part[(c.wave * 9 + r) * 64 + c.lane] = acc[r];
            BLOCK_SYNC();
            for (int o = c.tid; o < 9 * 64; o += NTHREADS) { const int r = o / 64, q = o % 64; f32x2 sum = *(const f32x2*)(b_ada + (size_t)l * 6 * D + 2 * (cg * 64 + q));
#pragma unroll
                for (int w = 0; w < 8; ++w) sum += part[(w * 9 + r) * 64 + q];
                *(f32x2*)(MOD + ((size_t)l * 9 + r) * 6 * D + 2 * (cg * 64 + q)) = sum; }
            BLOCK_SYNC(); } }
    float* COS = (float*)(c.ws + OFF_ROPE); float* SIN = COS + SEQ * 32;
    for (long it = gt; it < (long)SEQ * 32; it += GT) { const int t = (int)(it >> 5), i = (int)(it & 31);
        const float fr = expf(-(float)(i & 15) * (9.210340371976184f / 16.0f));     const float pos = (i < 16) ? (float)(t / GRIDW) : (float)(t % GRIDW); const float a = pos * fr;
        COS[it] = cosf(a); SIN[it] = sinf(a); }
    (void)x; (void)ctx;
}

DEV void transpose_item(const float* W, int srcpitch, int k0, int n0, bf16_t* WT, int Kp, int dstrow0, float* scr, int lane) {
#pragma unroll 8
    for (int i = 0; i < 32; ++i) { const int kk = 2 * i + (lane >> 5); scr[kk * 33 + (lane & 31)] = W[(size_t)(k0 + kk) * srcpitch + n0 + (lane & 31)]; }
    WAVE_FENCE();
    const int cc = lane & 7;
#pragma unroll
    for (int j = 0; j < 4; ++j) { const int n = (lane >> 3) + 8 * j; const float* s = scr + (8 * cc) * 33 + n;
        u32x4 o; o[0] = pk2(s[0 * 33], s[1 * 33]); o[1] = pk2(s[2 * 33], s[3 * 33]); o[2] = pk2(s[4 * 33], s[5 * 33]); o[3] = pk2(s[6 * 33], s[7 * 33]);
        *(u32x4*)(WT + (size_t)(dstrow0 + n) * Kp + k0 + 8 * cc) = o; }
    WAVE_FENCE();
}
DEV void convert_mixer_weights(const Ctx& c, int layer, int gw, int ngw) {
    float* scr = (float*)(c.lds + c.wave * 8448);
    const int odd = layer & 1, li = layer >> 1;
    const float* win = odd ? c.in[14] + (size_t)li * D * O_IN : c.in[8] + (size_t)li * D * E_IN; const int pin = odd ? O_IN : E_IN, nin = odd ? NO : NE;
    const float* wout = odd ? c.in[20] + (size_t)li * 1024 * D : c.in[13] + (size_t)li * 1024 * D;
    bf16_t* WIN = (bf16_t*)(c.ws + OFF_WIN); bf16_t* WOUT = (bf16_t*)(c.ws + OFF_WOUT);
    const int I1 = (D / 64) * (nin / 32), I2 = (1024 / 64) * (D / 32);
    for (int it = gw; it < I1 + I2; it += ngw) {
        if (it < I1) { const int nb = it % (nin / 32), kb = it / (nin / 32); transpose_item(win, pin, 64 * kb, 32 * nb, WIN, D, 32 * nb, scr, c.lane); }
        else { const int r = it - I1; const int nb = r % (D / 32), kb = r / (D / 32); transpose_item(wout, D, 64 * kb, 32 * nb, WOUT, 1024, 32 * nb, scr, c.lane); }
    }
}
DEV void convert_ffn_weights(const Ctx& c, int layer, int gw, int ngw) {
    float* scr = (float*)(c.lds + c.wave * 8448);
    const float* wg = c.in[21] + (size_t)layer * D * FF; const float* wu = c.in[22] + (size_t)layer * D * FF; const float* wd = c.in[23] + (size_t)layer * FF * D;
    bf16_t* WGU = (bf16_t*)(c.ws + SF_WGU); bf16_t* WDN = (bf16_t*)(c.ws + SF_WDN);
    const int I1 = (D / 64) * (FF / 32), I3 = (FF / 64) * (D / 32);
    for (int it = gw; it < 2 * I1 + I3; it += ngw) {
        if (it < 2 * I1) { const int up = it >= I1; const int r = up ? it - I1 : it; const int nb = r % (FF / 32), kb = r / (FF / 32); const int f0 = 32 * nb;
            transpose_item(up ? wu : wg, FF, 64 * kb, f0, WGU, D, (f0 / 128) * 256 + (up ? 128 : 0) + (f0 % 128), scr, c.lane); }
        else { const int r = it - 2 * I1; const int nb = r % (D / 32), kb = r / (D / 32); transpose_item(wd, D, 64 * kb, 32 * nb, WDN, FF, 32 * nb, scr, c.lane); }
    }
}
DEV void normalize_rows(const Ctx& c, int layer, int which, int nrows, SplitPlan red, int pmrows, const float* pga) {
    constexpr int NV = D / 256;
    float* X = (float*)(c.ws + OFF_X); bf16_t* H = (bf16_t*)(c.ws + OFF_HY); float* G = (float*)(c.ws + OFF_G);
    const float* MODL = (const float*)(c.ws + OFF_MOD) + (size_t)layer * 9 * 6 * D;
    const float* g = (which ? c.in[7] : c.in[6]) + (size_t)layer * D;
    const int odd = layer & 1, li = layer >> 1;
    const float* wgate = odd ? c.in[14] + (size_t)li * D * O_IN + NO : c.in[8] + (size_t)li * D * E_IN + NE; const int pg = odd ? O_IN : E_IN;
    float* wgt = (float*)c.lds;
    unsigned char* tab = (unsigned char*)(c.lds + 16 * D * 4);
    const float* PART = (const float*)(c.ws + SF_PART);
    if (red.extra) { BLOCK_SYNC();
        for (int e = c.tid; e < (pmrows / 256) * (D / 256); e += NTHREADS) tab[e] = 255;
        BLOCK_SYNC();
        if (c.tid < red.extra) { pg8::StaticOrder S2; S2.init(pmrows, D, red.nwg, c.nblk + c.tid); pg8::Unit u; if (S2.next(0, u)) tab[u.pm * (D / 256) + u.pn] = (unsigned char)c.tid; }
        BLOCK_SYNC(); }
    if (which == 0) { BLOCK_SYNC();
        for (int e = c.tid; e < D * 4; e += NTHREADS) { const int k = e >> 2, q = e & 3; const f32x4 w4 = *(const f32x4*)(wgate + (size_t)k * pg + 4 * q);
#pragma unroll
            for (int j = 0; j < 4; ++j) wgt[(4 * q + j) * D + k] = w4[j]; }
        BLOCK_SYNC(); }
    for (int row = c.gw; row < nrows; row += c.ngw) {
        const int mr = row < ML ? row / SEQ : NB;
        const float* sh = MODL + (size_t)mr * 6 * D + (which ? 3 : 0) * D; const float* sc = sh + D;
        const float* xrow = (layer == 0 && which == 0) ? (row < ML ? c.in[0] + (size_t)row * D : c.in[2] + (size_t)(row - ML) * D) : X + (size_t)row * D;
        const f32x4* xr = (const f32x4*)xrow + c.lane;
        f32x4 v[NV]; float ss = 0.f;
#pragma unroll
        for (int j = 0; j < NV; ++j) { v[j] = xr[64 * j];
            if (red.extra && row < pmrows) { const int lu = tab[(row >> 8) * (D / 256) + j];
                if (lu != 255) { const float* pp = PART + (size_t)lu * red.split * 65536 + (size_t)(row & 255) * 256 + 4 * c.lane; f32x4 sum = *(const f32x4*)pp;
                    for (int q = 1; q < red.split; ++q) sum += *(const f32x4*)(pp + (size_t)q * 65536);
                    v[j] += *(const f32x4*)(pga + (size_t)mr * 6 * D + 256 * j + 4 * c.lane) * sum; ((f32x4*)(X + (size_t)row * D) + c.lane)[64 * j] = v[j]; } }
            ss += (v[j][0] * v[j][0] + v[j][1] * v[j][1]) + (v[j][2] * v[j][2] + v[j][3] * v[j][3]); }
        const float rstd = 1.0f / sqrtf(wave_sum(ss) * (1.0f / D) + EPS);
        u32x2* o8 = (u32x2*)(H + (size_t)row * D) + c.lane;
        float ga[16];
#pragma unroll
        for (int n = 0; n < 16; ++n) ga[n] = 0.f;
#pragma unroll
        for (int j = 0; j < NV; ++j) { const int k0 = 256 * j + 4 * c.lane;
            const f32x4 gg = *(const f32x4*)(g + k0), s1 = *(const f32x4*)(sc + k0), s0 = *(const f32x4*)(sh + k0);
            f32x4 h = v[j] * rstd * gg * (s1 + 1.0f) + s0;
            u32x2 w; w[0] = pk2(h[0], h[1]); w[1] = pk2(h[2], h[3]); o8[64 * j] = w;
            if (which == 0) {
#pragma unroll
                for (int n = 0; n < 16; ++n) { const f32x4 w4 = *(const f32x4*)(wgt + n * D + k0); ga[n] += (h[0] * w4[0] + h[1] * w4[1]) + (h[2] * w4[2] + h[3] * w4[3]); if ((n & 3) == 3) SCHED_FENCE(); } } }
        if (which == 0) {
            const bool b5 = c.lane & 32, b4 = c.lane & 16, b3 = c.lane & 8, b2 = c.lane & 4;
            float w8[8], w4[4], w2[2];
#pragma unroll
            for (int n = 0; n < 8; ++n) { const float snd = b5 ? ga[n] : ga[n + 8], kp = b5 ? ga[n + 8] : ga[n]; w8[n] = kp + SHFL_XOR(snd, 32); }
#pragma unroll
            for (int n = 0; n < 4; ++n) { const float snd = b4 ? w8[n] : w8[n + 4], kp = b4 ? w8[n + 4] : w8[n]; w4[n] = kp + SHFL_XOR(snd, 16); }
#pragma unroll
            for (int n = 0; n < 2; ++n) { const float snd = b3 ? w4[n] : w4[n + 2], kp = b3 ? w4[n + 2] : w4[n]; w2[n] = kp + SHFL_XOR(snd, 8); }
            float z = (b2 ? w2[1] : w2[0]) + SHFL_XOR(b2 ? w2[0] : w2[1], 4);
            z += SHFL_XOR(z, 2); z += SHFL_XOR(z, 1);
            if ((c.lane & 3) == 0) G[(size_t)row * 16 + (b5 ? 8 : 0) + (b4 ? 4 : 0) + (b3 ? 2 : 0) + (b2 ? 1 : 0)] = z; }
    }
}

DEV int tok_row(int b, int tc, int i) { return tc < NCC ? ML + b * CTX + 64 * tc + i : b * SEQ + 64 * (tc - NCC) + i; }
DEV int pos_row(int b, int pos) { return pos < CTX ? ML + b * CTX + pos : b * SEQ + (pos - CTX); }
DEV int chain_chunk(int dir, int tc) { return dir == 0 ? tc : (tc < NCC ? NCC - 1 - tc : NCC + (NLC - 1 - (tc - NCC))); }
DEV void unpack8(bf16x8 v, float (&f)[8]) {
#pragma unroll
    for (int e = 0; e < 8; ++e) f[e] = bf2f((unsigned short)v[e]);
}
DEV bf16x8 pack8(const float (&f)[8]) { u32x4 p; p[0] = pk2(f[0], f[1]); p[1] = pk2(f[2], f[3]); p[2] = pk2(f[4], f[5]); p[3] = pk2(f[6], f[7]); return __builtin_bit_cast(bf16x8, p); }
DEV float chain_cumsum(float x, int lane, int dir) {
#pragma unroll
    for (int off = 1; off < 64; off <<= 1) { const int src = dir == 0 ? lane - off : lane + off; const float y = SHFL(x, src & 63); if (src >= 0 && src < 64) x += y; }
    return x;
}

constexpr int AT_KB = 64 * 72 * 2;
template <int DV> struct AttnLds { static constexpr int VB = DV * 72 * 2, BUF = AT_KB + VB; };

template <int DV>
DEV void attn_stage_load(const Ctx& c, const bf16_t* Kp, const bf16_t* Vt, int vpitch, int tile, bf16x8& kreg, bf16x8 (&vreg)[DV / 64]) {
    kreg = ld16(Kp + (size_t)(tile * 64 + (c.tid >> 3)) * 64 + (c.tid & 7) * 8);
#pragma unroll
    for (int i = 0; i < DV / 64; ++i) { const int idx = c.tid + 512 * i; vreg[i] = ld16(Vt + (size_t)(idx >> 3) * vpitch + tile * 64 + (idx & 7) * 8); }
}
template <int DV>
DEV void attn_stage_store(const Ctx& c, int boff, const bf16x8& kreg, const bf16x8 (&vreg)[DV / 64]) {
    char* kb = c.lds + boff; char* vb = kb + AT_KB;
    *(bf16x8*)(kb + (c.tid >> 3) * 144 + (c.tid & 7) * 16) = kreg;
#pragma unroll
    for (int i = 0; i < DV / 64; ++i) { const int idx = c.tid + 512 * i; *(bf16x8*)(vb + (idx >> 3) * 144 + (idx & 7) * 16) = vreg[i]; }
}
DEV void attn_qk(const char* kb, int rk, int h, const bf16x8 (&qf)[4], f32x16& p0, f32x16& p1) {
#pragma unroll
    for (int i = 0; i < 16; ++i) { p0[i] = 0.f; p1[i] = 0.f; }
#pragma unroll
    for (int ks = 0; ks < 4; ++ks) { const bf16x8 a0 = ld16(kb + rk * 144 + ks * 32 + h * 16), a1 = ld16(kb + (32 + rk) * 144 + ks * 32 + h * 16);
        p0 = MFMA32(a0, qf[ks], p0); p1 = MFMA32(a1, qf[ks], p1); }
}
DEV void attn_sm1(f32x16& p0, f32x16& p1, float& m, float& alpha) {
    const float C2 = 0.125f * 1.4426950408889634f;
    float mx = p0[0];
#pragma unroll
    for (int i = 0; i < 16; ++i) { mx = fmaxf(mx, p0[i]); mx = fmaxf(mx, p1[i]); }
    mx = fmaxf(mx, SHFL_XOR(mx, 32));
    alpha = 1.0f;
    if (WAVE_ANY(mx * C2 > m + 8.0f)) { const float mn = fmaxf(m, mx * C2); alpha = EXP2F(m - mn); m = mn; }
#pragma unroll
    for (int i = 0; i < 16; ++i) { p0[i] = p0[i] * C2 - m; p1[i] = p1[i] * C2 - m; }
#pragma unroll
    for (int i = 0; i < 16; ++i) p0[i] = EXP2F(p0[i]);
}
DEV void attn_sm2(f32x16& p0, f32x16& p1, float alpha, float& l, bf16x8 (&pb)[4]) {
#pragma unroll
    for (int i = 0; i < 16; ++i) p1[i] = EXP2F(p1[i]);
    float rs = 0.f;
#pragma unroll
    for (int i = 0; i < 16; ++i) rs += p0[i] + p1[i];
    l = l * alpha + rs;
    pb[0] = pack_acc(p0, 0); pb[1] = pack_acc(p0, 1); pb[2] = pack_acc(p1, 0); pb[3] = pack_acc(p1, 1);
}
template <int DV>
DEV void attn_pv(const char* vb, int r, int h, const bf16x8 (&pb)[4], f32x16 (&o)[DV / 32]) {
#pragma unroll
    for (int us = 0; us < 4; ++us)
#pragma unroll
        for (int dt = 0; dt < DV / 32; ++dt) { const bf16x8 va = ld16(vb + (32 * dt + r) * 144 + (16 * us + 8 * h) * 2); o[dt] = MFMA32(va, pb[us], o[dt]); }
}
template <int DV>
DEV void attn_resc(f32x16 (&o)[DV / 32], float alpha) {
    if (WAVE_ANY(alpha < 1.0f)) {
#pragma unroll
        for (int dt = 0; dt < DV / 32; ++dt)
#pragma unroll
            for (int i = 0; i < 16; ++i) o[dt][i] *= alpha; }
}
template <int DV>
DEV void attn_step(const Ctx& c, const bf16_t* Kp, const bf16_t* Vt, int vpitch, int j, int nt, const bf16x8 (&qf)[4], bool active, int rk, int ox, int oy, int on,
                   bf16x8 (&pb)[4], f32x16 (&o)[DV / 32], float& m, float& l) {
    const int r = c.lane & 31, h = c.lane >> 5; const bool more = j + 1 < nt; const float C2 = 0.125f * 1.4426950408889634f;
    bf16x8 kreg, vreg[DV / 64]; f32x16 p0, p1;
    if (active) attn_qk(c.lds + ox, rk, h, qf, p0, p1);
    SCHED_FENCE();
    if (more) attn_stage_load<DV>(c, Kp, Vt, vpitch, j + 1, kreg, vreg);
    if (active) { const char* vb = c.lds + oy + AT_KB;
        float mx = 0.f, alpha = 1.0f;
#pragma unroll
        for (int us = 0; us < 4; ++us) {
            SCHED_FENCE();
#pragma unroll
            for (int dt = 0; dt < DV / 32; ++dt) { const bf16x8 va = ld16(vb + (32 * dt + r) * 144 + (16 * us + 8 * h) * 2); o[dt] = MFMA32(va, pb[us], o[dt]); }
            SCHED_FENCE();
            if (us == 0) { mx = p0[0];
#pragma unroll
                for (int i = 0; i < 16; ++i) { mx = fmaxf(mx, p0[i]); mx = fmaxf(mx, p1[i]); }
                mx = fmaxf(mx, SHFL_XOR(mx, 32));
                if (WAVE_ANY(mx * C2 > m + 8.0f)) { const float mn = fmaxf(m, mx * C2); alpha = EXP2F(m - mn); m = mn; } }
            else if (us == 1) {
#pragma unroll
                for (int i = 0; i < 16; ++i) { p0[i] = p0[i] * C2 - m; p1[i] = p1[i] * C2 - m; } }
            else if (us == 2) {
#pragma unroll
                for (int i = 0; i < 16; ++i) p0[i] = EXP2F(p0[i]); }
            else {
#pragma unroll
                for (int i = 0; i < 16; ++i) p1[i] = EXP2F(p1[i]); }
        }
        SCHED_FENCE();
        float rs = 0.f;
#pragma unroll
        for (int i = 0; i < 16; ++i) rs += p0[i] + p1[i];
        l = l * alpha + rs;
        pb[0] = pack_acc(p0, 0); pb[1] = pack_acc(p0, 1); pb[2] = pack_acc(p1, 0); pb[3] = pack_acc(p1, 1);
        attn_resc<DV>(o, alpha); }
    if (more) attn_stage_store<DV>(c, on, kreg, vreg);
    BLOCK_SYNC();
}
template <int DV>
DEV void attn_pass(const Ctx& c, const bf16_t* Kp, const bf16_t* Vt, int vpitch, int nk, const bf16x8 (&qf)[4], bool active, f32x16 (&o)[DV / 32], float& m, float& l) {
    const int r = c.lane & 31, h = c.lane >> 5; const int rk = (r & 0x13) | ((r & 4) << 1) | ((r & 8) >> 1);
    const int nt = nk / 64; constexpr int BUF = AttnLds<DV>::BUF;
#pragma unroll
    for (int dt = 0; dt < DV / 32; ++dt)
#pragma unroll
        for (int i = 0; i < 16; ++i) o[dt][i] = 0.f;
    m = -1e30f; l = 0.f;
    bf16x8 pb[4];
    { bf16x8 kreg, vreg[DV / 64];
      attn_stage_load<DV>(c, Kp, Vt, vpitch, 0, kreg, vreg); attn_stage_store<DV>(c, 0, kreg, vreg);
      attn_stage_load<DV>(c, Kp, Vt, vpitch, 1, kreg, vreg); attn_stage_store<DV>(c, BUF, kreg, vreg); }
    BLOCK_SYNC();
    if (active) { f32x16 p0, p1; float alpha; attn_qk(c.lds, rk, h, qf, p0, p1); attn_sm1(p0, p1, m, alpha); attn_sm2(p0, p1, alpha, l, pb); }
    else {
#pragma unroll
        for (int i = 0; i < 4; ++i) pb[i] = (bf16x8){0, 0, 0, 0, 0, 0, 0, 0}; }
    int ox = BUF, oy = 0, on = 2 * BUF;
    for (int j = 1; j < nt; ++j) {
        attn_step<DV>(c, Kp, Vt, vpitch, j, nt, qf, active, rk, ox, oy, on, pb, o, m, l); { const int t_ = oy; oy = ox; ox = on; on = t_; }
    }
    if (active) attn_pv<DV>(c.lds + oy + AT_KB, r, h, pb, o);
    BLOCK_SYNC();
}
DEV void load_q(const Ctx& c, const bf16_t* Qrow  , bool valid, bool rope, int t, const float* qg  , bf16x8 (&qf)[4]) {
    const int h = c.lane >> 5;
    float f[4][8];
#pragma unroll
    for (int ks = 0; ks < 4; ++ks) { bf16x8 v = (bf16x8){0, 0, 0, 0, 0, 0, 0, 0}; if (valid) v = ld16(Qrow + 16 * ks + 8 * h); unpack8(v, f[ks]); }
    if (qg) { float ss = 0.f;
#pragma unroll
        for (int ks = 0; ks < 4; ++ks)
#pragma unroll
            for (int e = 0; e < 8; ++e) ss += f[ks][e] * f[ks][e];
        ss += SHFL_XOR(ss, 32);
        const float rstd = 1.0f / sqrtf(ss * (1.0f / 64.0f) + EPS);
#pragma unroll
        for (int ks = 0; ks < 4; ++ks)
#pragma unroll
            for (int e = 0; e < 8; ++e) f[ks][e] = f[ks][e] * rstd * qg[16 * ks + 8 * h + e]; }
    if (rope) { const float* COS = (const float*)(c.ws + OFF_ROPE) + (size_t)t * 32; const float* SIN = COS + (size_t)SEQ * 32;
#pragma unroll
        for (int a = 0; a < 2; ++a)
#pragma unroll
            for (int e = 0; e < 8; ++e) { const float cs = COS[a * 16 + 8 * h + e], sn = SIN[a * 16 + 8 * h + e]; const float x1 = f[2 * a][e], x2 = f[2 * a + 1][e];
                f[2 * a][e] = x1 * cs - x2 * sn; f[2 * a + 1][e] = x2 * cs + x1 * sn; } }
#pragma unroll
    for (int ks = 0; ks < 4; ++ks) qf[ks] = pack8(f[ks]);
}

DEV void even_kprep(const Ctx& c) {
    const bf16_t* KA = (const bf16_t*)(c.ws + OFF_P) + PE_KA; bf16_t* KP = (bf16_t*)(c.ws + SE_KP);
    const float* COS = (const float*)(c.ws + OFF_ROPE); const float* SIN = COS + (size_t)SEQ * 32;
    const int l7 = c.lane & 7, a = l7 >> 2, p = (l7 >> 1) & 1, f0 = 8 * (l7 & 1), vh = c.lane >> 3;
    for (int it = c.gw; it < NB * LK; it += c.ngw) { const int b = it / LK, pos = it % LK; const int row = pos_row(b, pos);
        float f[8]; unpack8(ld16(KA + (size_t)row * 512 + 8 * c.lane), f);
        float g[8];
#pragma unroll
        for (int e = 0; e < 8; ++e) g[e] = SHFL_XOR(f[e], 2);
        if (pos >= CTX) { const int t = pos - CTX;
#pragma unroll
            for (int e = 0; e < 8; ++e) { const float cs = COS[(size_t)t * 32 + a * 16 + f0 + e], sn = SIN[(size_t)t * 32 + a * 16 + f0 + e]; f[e] = p == 0 ? f[e] * cs - g[e] * sn : f[e] * cs + g[e] * sn; } }
        *(bf16x8*)(KP + ((size_t)(b * 8 + vh) * LK + pos) * 64 + 8 * l7) = pack8(f); }
}
template <int DV>
DEV void vt_item(const Ctx& c, const bf16_t* src, int spitch, int colbase, int b, int pc, bf16_t* dstbh  ) {
    bf16_t* T = (bf16_t*)c.lds;
#pragma unroll
    for (int i = 0; i < DV / 64; ++i) { const int idx = c.tid + 512 * i, pl = idx / (DV / 8), cg = idx % (DV / 8); const int row = pos_row(b, 64 * pc + pl);
        const bf16x8 v = ld16(src + (size_t)row * spitch + colbase + 8 * cg);
#pragma unroll
        for (int e = 0; e < 8; ++e) T[(8 * cg + e) * 72 + pl] = (bf16_t)v[e]; }
    BLOCK_SYNC();
#pragma unroll
    for (int i = 0; i < DV / 64; ++i) { const int idx = c.tid + 512 * i, dv = idx >> 3, ch = idx & 7;
        *(bf16x8*)(dstbh + (size_t)dv * LK + 64 * pc + 8 * ch) = *(const bf16x8*)(T + dv * 72 + 8 * ch); }
    BLOCK_SYNC();
}

DEV void mlstm_gates(const Ctx& c, int layer, int b, int h, int dir, int tc, float& ipre, float& lf) {
    const float* G = (const float*)(c.ws + OFF_G); const float* bias = c.in[9] + (size_t)(layer >> 1) * 16;
    const int row = tok_row(b, tc, c.lane);
    ipre = G[(size_t)row * 16 + dir * 8 + h] + bias[dir * 8 + h];
    lf = logsigmoidf_(G[(size_t)row * 16 + dir * 8 + 4 + h] + bias[dir * 8 + 4 + h]);
}
DEV void mlstm_m1_item(const Ctx& c, int layer, int it) {
    const int tc = it % NCH, dir = (it / NCH) & 1, h = (it / (2 * NCH)) & 3, b = it / (8 * NCH);
    const int chain = (b * 4 + h) * 2 + dir, cc = chain_chunk(dir, tc); const size_t ci = (size_t)chain * NCH + cc;
    const bf16_t* BK = (const bf16_t*)(c.ws + OFF_P) + PE_BK; const bf16_t* BV = (const bf16_t*)(c.ws + OFF_P) + PE_BV;
    float* DCT = (float*)(c.ws + SE_DCT); float* DN = (float*)(c.ws + SE_DN); float* SC = (float*)(c.ws + SE_SC);
    bf16_t* Kt = (bf16_t*)c.lds; bf16_t* Vt = Kt + 64 * 72; float* wv = (float*)(c.lds + (64 + 128) * 72 * 2);
    if (c.wave == 0) { float ipre, lf; mlstm_gates(c, layer, b, h, dir, tc, ipre, lf);
        const float bcum = chain_cumsum(lf, c.lane, dir), bend = wave_sum(lf), wend = bend - bcum + ipre, mloc = wave_max(wend);
        wv[c.lane] = expf(wend - mloc);
        if (c.lane == 0) { SC[ci * 4 + 0] = bend; SC[ci * 4 + 1] = mloc; } }
    BLOCK_SYNC();
    {   const int i = c.tid >> 3, cg = c.tid & 7; const int row = tok_row(b, tc, i); const float w = wv[i] * 0.125f;
        float f[8]; unpack8(ld16(BK + (size_t)row * 256 + h * 64 + 8 * cg), f);
#pragma unroll
        for (int e = 0; e < 8; ++e) Kt[(8 * cg + e) * 72 + i] = (bf16_t)f2bf(f[e] * w); }
#pragma unroll
    for (int ii = 0; ii < 2; ++ii) { const int idx = c.tid + 512 * ii, i = idx >> 4, cg = idx & 15; const int row = tok_row(b, tc, i);
        const bf16x8 v = ld16(BV + (size_t)row * 512 + h * 128 + 8 * cg);
#pragma unroll
        for (int e = 0; e < 8; ++e) Vt[(8 * cg + e) * 72 + i] = (bf16_t)v[e]; }
    BLOCK_SYNC();
    {   const int r = c.lane & 31, hh = c.lane >> 5, dvt = c.wave >> 1, dkt = c.wave & 1;
        f32x16 acc;
#pragma unroll
        for (int i = 0; i < 16; ++i) acc[i] = 0.f;
#pragma unroll
        for (int ks = 0; ks < 4; ++ks) acc = MFMA32(ld16(Vt + (32 * dvt + r) * 72 + 16 * ks + 8 * hh), ld16(Kt + (32 * dkt + r) * 72 + 16 * ks + 8 * hh), acc);
        float* dst = DCT + ci * 8192;
#pragma unroll
        for (int i = 0; i < 16; ++i) dst[(32 * dvt + crow(i, hh)) * 64 + 32 * dkt + r] = acc[i];
        if (c.tid < 64) { float s = 0.f; for (int i = 0; i < 64; ++i) s += bf2f(Kt[c.tid * 72 + i]); DN[ci * 64 + c.tid] = s; } }
    BLOCK_SYNC();
}
DEV void mlstm_m2(const Ctx& c) {
    float* DCT = (float*)(c.ws + SE_DCT); float* DN = (float*)(c.ws + SE_DN); float* SC = (float*)(c.ws + SE_SC);
    const long gt = (long)c.bid * NTHREADS + c.tid, GT = (long)c.nblk * NTHREADS;
    for (long it = gt; it < (long)NCHAIN * 8256; it += GT) { const int chain = (int)(it / 8256), e = (int)(it % 8256);
        float* p0 = e < 8192 ? DCT + (size_t)chain * NCH * 8192 + e : DN + (size_t)chain * NCH * 64 + (e - 8192); const size_t pstr = e < 8192 ? 8192 : 64;
        float d[NCH];
#pragma unroll
        for (int cc = 0; cc < NCH; ++cc) d[cc] = p0[cc * pstr];
        float mst = 0.f, val = 0.f;
#pragma unroll
        for (int cc = 0; cc < NCH; ++cc) { const size_t ci = (size_t)chain * NCH + cc; const float bend = SC[ci * 4 + 0], mloc = SC[ci * 4 + 1];
            if (e == 0) SC[ci * 4 + 2] = mst;
            const float mnew = fmaxf(bend + mst, mloc); const float nv = expf(bend + mst - mnew) * val + expf(mloc - mnew) * d[cc]; d[cc] = val; val = nv; mst = mnew; }
#pragma unroll
        for (int cc = 0; cc < NCH; ++cc) p0[cc * pstr] = d[cc]; }
}
DEV void mlstm_m3_item(const Ctx& c, int layer, int it) {
    const int tc = it % NCH, h = (it / NCH) & 3, b = it / (4 * NCH);
    const bf16_t* BQ = (const bf16_t*)(c.ws + OFF_P) + PE_BQ; const bf16_t* BK = (const bf16_t*)(c.ws + OFF_P) + PE_BK; const bf16_t* BV = (const bf16_t*)(c.ws + OFF_P) + PE_BV; const bf16_t* BO = (const bf16_t*)(c.ws + OFF_P) + PE_BO;
    const float* DCT = (const float*)(c.ws + SE_DCT); const float* DN = (const float*)(c.ws + SE_DN); const float* SC = (const float*)(c.ws + SE_SC);
    bf16_t* Y = (bf16_t*)(c.ws + OFF_HY); const float* gn = c.in[12] + (size_t)(layer >> 1) * 128;
    bf16_t* Qs = (bf16_t*)c.lds; bf16_t* Ks = Qs + 64 * 72; bf16_t* Vt = Ks + 64 * 72; float* fl = (float*)(c.lds + (128 + 128) * 72 * 2);
    float* bcs = fl, *ics = fl + 64, *nst = fl + 128, *ssq = fl + 192;
    const int r = c.lane & 31, hh = c.lane >> 5, dvt = c.wave >> 1, tt = c.wave & 1, t = 32 * tt + r;
    f32x16 hs;
#pragma unroll
    for (int i = 0; i < 16; ++i) hs[i] = 0.f;
    for (int dir = 0; dir < 2; ++dir) {
        const int chain = (b * 4 + h) * 2 + dir, cc = chain_chunk(dir, tc); const size_t ci = (size_t)chain * NCH + cc;
        if (c.wave == 0) { float ipre, lf; mlstm_gates(c, layer, b, h, dir, tc, ipre, lf); bcs[c.lane] = chain_cumsum(lf, c.lane, dir); ics[c.lane] = ipre; }
        if (c.wave == 1) nst[c.lane] = DN[ci * 64 + c.lane];
        {   const int i = c.tid >> 3, cg = c.tid & 7; const int row = tok_row(b, tc, i);
            *(bf16x8*)(Qs + i * 72 + 8 * cg) = ld16(BQ + (size_t)row * 256 + h * 64 + 8 * cg);
            float f[8]; unpack8(ld16(BK + (size_t)row * 256 + h * 64 + 8 * cg), f);
#pragma unroll
            for (int e = 0; e < 8; ++e) f[e] *= 0.125f;
            *(bf16x8*)(Ks + i * 72 + 8 * cg) = pack8(f); }
#pragma unroll
        for (int ii = 0; ii < 2; ++ii) { const int idx = c.tid + 512 * ii, i = idx >> 4, cg = idx & 15; const int row = tok_row(b, tc, i);
            const bf16x8 v = ld16(BV + (size_t)row * 512 + h * 128 + 8 * cg);
#pragma unroll
            for (int e = 0; e < 8; ++e) Vt[(8 * cg + e) * 68 + i] = (bf16_t)v[e]; }
        BLOCK_SYNC();
        const float mst = SC[ci * 4 + 2];
        f32x16 st[2];
#pragma unroll
        for (int su = 0; su < 2; ++su) {
#pragma unroll
            for (int i = 0; i < 16; ++i) st[su][i] = 0.f;
#pragma unroll
            for (int ks = 0; ks < 4; ++ks) st[su] = MFMA32(ld16(Ks + (32 * su + r) * 72 + 16 * ks + 8 * hh), ld16(Qs + t * 72 + 16 * ks + 8 * hh), st[su]); }
        const float bt = bcs[t], at = bt + mst;
        float mt = at;
#pragma unroll
        for (int su = 0; su < 2; ++su)
#pragma unroll
            for (int i = 0; i < 16; ++i) { const int s = 32 * su + crow(i, hh); const bool valid = dir == 0 ? s <= t : s >= t; if (valid) mt = fmaxf(mt, bt - bcs[s] + ics[s]); }
        mt = fmaxf(mt, SHFL_XOR(mt, 32));
        const float inter = expf(at - mt);
        float rsum = 0.f;
#pragma unroll
        for (int su = 0; su < 2; ++su)
#pragma unroll
            for (int i = 0; i < 16; ++i) { const int s = 32 * su + crow(i, hh); const bool valid = dir == 0 ? s <= t : s >= t;
                const float p = valid ? expf(bt - bcs[s] + ics[s] - mt) * st[su][i] : 0.f; st[su][i] = p; rsum += p; }
        rsum += SHFL_XOR(rsum, 32);
        float qn = 0.f;
        for (int d = 0; d < 32; ++d) qn += bf2f(Qs[t * 72 + 32 * hh + d]) * nst[32 * hh + d];
        qn += SHFL_XOR(qn, 32);
        const float den = inter * qn + rsum, dd = fmaxf(fabsf(den), expf(-mt));
        f32x16 a1;
#pragma unroll
        for (int i = 0; i < 16; ++i) a1[i] = 0.f;
        const float* Cst = DCT + ci * 8192 + (size_t)(32 * dvt + r) * 64;
#pragma unroll
        for (int ks = 0; ks < 4; ++ks) { float f[8]; const f32x4 c0 = *(const f32x4*)(Cst + 16 * ks + 8 * hh), c1 = *(const f32x4*)(Cst + 16 * ks + 8 * hh + 4);
            f[0] = c0[0]; f[1] = c0[1]; f[2] = c0[2]; f[3] = c0[3]; f[4] = c1[0]; f[5] = c1[1]; f[6] = c1[2]; f[7] = c1[3];
            a1 = MFMA32(pack8(f), ld16(Qs + t * 72 + 16 * ks + 8 * hh), a1); }
        f32x16 a2;
#pragma unroll
        for (int i = 0; i < 16; ++i) a2[i] = 0.f;
#pragma unroll
        for (int su = 0; su < 2; ++su)
#pragma unroll
            for (int s2 = 0; s2 < 2; ++s2) { const bf16_t* vp = Vt + (32 * dvt + r) * 68 + 32 * su + 16 * s2 + 4 * hh;
                a2 = MFMA32(cat44(*(const bf16x4*)vp, *(const bf16x4*)(vp + 8)), pack_acc(st[su], s2), a2); }
        const float inv = 1.0f / dd;
#pragma unroll
        for (int i = 0; i < 16; ++i) hs[i] += (inter * a1[i] + a2[i]) * inv;
        BLOCK_SYNC();
    }
    float ss = 0.f;
#pragma unroll
    for (int i = 0; i < 16; ++i) ss += hs[i] * hs[i];
    ss += SHFL_XOR(ss, 32);
    if (hh == 0) ssq[dvt * 64 + t] = ss;
    BLOCK_SYNC();
    const float rstd = 1.0f / sqrtf((ssq[t] + ssq[64 + t] + ssq[128 + t] + ssq[192 + t]) * (1.0f / 128.0f) + EPS);
    const int row = tok_row(b, tc, t);
#pragma unroll
    for (int q4 = 0; q4 < 4; ++q4) { const int dv = 32 * dvt + 8 * q4 + 4 * hh;
        const bf16x4 ov = *(const bf16x4*)(BO + (size_t)row * 512 + h * 128 + dv); float y[4];
#pragma unroll
        for (int e = 0; e < 4; ++e) y[e] = hs[4 * q4 + e] * rstd * gn[dv + e] * sigmoidf_(bf2f((unsigned short)ov[e]));
        u32x2 w; w[0] = pk2(y[0], y[1]); w[1] = pk2(y[2], y[3]);
        *(u32x2*)(Y + (size_t)row * 1024 + 512 + h * 128 + dv) = w; }
    BLOCK_SYNC();
}

DEV void diffattn_unit(const Ctx& c, int layer, int b, int h, bool ctxu, int qb) {
    const bf16_t* QA = (const bf16_t*)(c.ws + OFF_P) + PE_QA; const bf16_t* KP = (const bf16_t*)(c.ws + SE_KP); const bf16_t* VT = (const bf16_t*)(c.ws + SE_VT);
    bf16_t* Y = (bf16_t*)(c.ws + OFF_HY); const int e = layer >> 1;
    const float* lam = c.in[10] + (size_t)e * 256; const float* gn = c.in[11] + (size_t)e * 128;
    const int r = c.lane & 31, hh = c.lane >> 5; const int ql = qb * 256 + c.wave * 32 + r;
    const int nq = ctxu ? CTX : SEQ, nk = ctxu ? CTX : LK; const bool valid = ql < nq, active = (qb * 256 + c.wave * 32) < nq;
    const int row = ctxu ? ML + b * CTX + ql : b * SEQ + ql;
    const int orow = ctxu ? row : b * SEQ + (ql % 128) * (SEQ / 128) + ql / 128;
    f32x16 o[4]; float m, l1, l2; bf16x8 qf[4];
    float* park = (float*)(c.ws + SE_PARK) + ((size_t)c.bid * NTHREADS + c.tid) * 64;
    load_q(c, QA + (size_t)row * 512 + h * 128, valid, !ctxu, ql, nullptr, qf);
    attn_pass<128>(c, KP + (size_t)(b * 8 + 2 * h) * LK * 64, VT + (size_t)(b * 4 + h) * 128 * LK, LK, nk, qf, active, o, m, l1);
    if (active) { l1 += SHFL_XOR(l1, 32); const float i1 = 1.0f / l1;
#pragma unroll
        for (int dt = 0; dt < 4; ++dt)
#pragma unroll
            for (int q4 = 0; q4 < 4; ++q4) *(f32x4*)(park + 16 * dt + 4 * q4) = (f32x4){o[dt][4 * q4] * i1, o[dt][4 * q4 + 1] * i1, o[dt][4 * q4 + 2] * i1, o[dt][4 * q4 + 3] * i1}; }
    load_q(c, QA + (size_t)row * 512 + h * 128 + 64, valid, !ctxu, ql, nullptr, qf);
    attn_pass<128>(c, KP + (size_t)(b * 8 + 2 * h + 1) * LK * 64, VT + (size_t)(b * 4 + h) * 128 * LK, LK, nk, qf, active, o, m, l2);
    const float lam_init = 0.8f - 0.6f * expf(-0.3f * (float)layer);
    const float lmb = expf(wave_sum(lam[c.lane] * lam[64 + c.lane])) - expf(wave_sum(lam[128 + c.lane] * lam[192 + c.lane])) + lam_init;
    if (active) {
        l2 += SHFL_XOR(l2, 32);
        const float i2 = lmb / l2; float ss = 0.f;
#pragma unroll
        for (int dt = 0; dt < 4; ++dt)
#pragma unroll
            for (int q4 = 0; q4 < 4; ++q4) { const f32x4 a = *(const f32x4*)(park + 16 * dt + 4 * q4);
#pragma unroll
                for (int e = 0; e < 4; ++e) { const float v = a[e] - o[dt][4 * q4 + e] * i2; o[dt][4 * q4 + e] = v; ss += v * v; } }
        ss += SHFL_XOR(ss, 32);
        const float sc = (1.0f / sqrtf(ss * (1.0f / 128.0f) + EPS)) * (1.0f - lam_init);
        if (valid) {
#pragma unroll
            for (int dt = 0; dt < 4; ++dt)
#pragma unroll
                for (int q4 = 0; q4 < 4; ++q4) { const int dv = 32 * dt + 8 * q4 + 4 * hh; u32x2 w;
                    w[0] = pk2(o[dt][4 * q4 + 0] * sc * gn[dv + 0], o[dt][4 * q4 + 1] * sc * gn[dv + 1]); w[1] = pk2(o[dt][4 * q4 + 2] * sc * gn[dv + 2], o[dt][4 * q4 + 3] * sc * gn[dv + 3]);
                    *(u32x2*)(Y + (size_t)orow * 1024 + h * 128 + dv) = w; } }
    }
}

DEV void mix_even_a(const Ctx& c, int layer) {
    { PHASE_CTX(pc); if (ON(8)) even_kprep(pc); }
    { PHASE_CTX(pc); if (ON(9)) { const bf16_t* VA = (const bf16_t*)(pc.ws + OFF_P) + PE_VA; bf16_t* VT = (bf16_t*)(pc.ws + SE_VT);
        for (int it = pc.bid; it < NB * 4 * NCH; it += pc.nblk) { const int pch = it % NCH, bh = it / NCH; vt_item<128>(pc, VA, 512, (bh & 3) * 128, bh >> 2, pch, VT + (size_t)bh * 128 * LK); } } }
    REPB(10) { PHASE_CTX(pc); if (ON(10)) for (int it = pc.bid; it < NCHAIN * NCH; it += pc.nblk) mlstm_m1_item(pc, layer, it); }
}
DEV void mix_even_b(const Ctx& c, int layer) {
    { PHASE_CTX(pc); if (ON(11)) mlstm_m2(pc); }
}
DEV void mix_even_c(const Ctx& c, int layer) {
    constexpr int NQBL = SEQ / 256, NQBC = (CTX + 255) / 256, NUL = NB * 4 * NQBL, NUC = NB * 4 * NQBC;
    REPB(12) { PHASE_CTX(pc); if (ON(12)) for (int it = pc.bid; it < NUL + NUC; it += pc.nblk) { const bool cu = it >= NUL; int u = cu ? it - NUL : it; const int nqb = cu ? NQBC : NQBL;
        diffattn_unit(pc, layer, u / (4 * nqb), (u / nqb) & 3, cu, u % nqb); } }
    REPB(13) { PHASE_CTX(pc); if (ON(13)) for (int it = pc.nblk - 1 - pc.bid; it < NB * 4 * NCH; it += pc.nblk) mlstm_m3_item(pc, layer, it); }
}
constexpr size_t SO_KP = OFF_S;
constexpr size_t SO_VT = SO_KP + al256((size_t)NB * 2 * LK * 64 * 2);
constexpr size_t SO_U  = SO_VT + al256((size_t)NB * 2 * 64 * LK * 2);
constexpr size_t SO_W  = OFF_HY;
static_assert((size_t)NCHAIN * NCH * 8192 <= (size_t)MT * cmax(D, 1024), "W fits in the H/Y region");
constexpr size_t SO_AT = SO_U + al256((size_t)NCHAIN * NCH * 8192 * 2);
constexpr size_t SO_QN = SO_AT + al256((size_t)NCHAIN * NCH * 4096 * 2);
constexpr size_t SO_KD = SO_QN + al256((size_t)NCHAIN * NCH * 8192 * 2);
constexpr size_t SO_GE = SO_KD + al256((size_t)NCHAIN * NCH * 8192 * 2);
constexpr size_t SO_END = SO_GE + al256((size_t)NCHAIN * NCH * 4);
constexpr size_t PO_HB = PO_DQKV;
constexpr size_t PO_GO = PO_DQKV + (size_t)MT * 1024;
static_assert((size_t)3 * MT * 512 <= (size_t)MT * 1536, "HB and GO fit in the DQKV segment");

DEV void odd_kprep(const Ctx& c, int layer) {
    const bf16_t* KVC = (const bf16_t*)(c.ws + OFF_P) + PO_KVC; bf16_t* KP = (bf16_t*)(c.ws + SO_KP);
    const float* COS = (const float*)(c.ws + OFF_ROPE); const float* SIN = COS + (size_t)SEQ * 32; const float* kg = c.in[15] + (size_t)(layer >> 1) * 128 + 64;
    const int kv = c.lane >> 5, d0 = 2 * (c.lane & 31);
    const int a = d0 >> 5, p = (d0 >> 4) & 1, f0 = d0 & 15;
    for (int it = c.gw; it < NB * LK; it += c.ngw) { const int b = it / LK, pos = it % LK; const int row = pos_row(b, pos);
        const unsigned w = *(const unsigned*)(KVC + (size_t)row * 256 + 2 * c.lane);
        float x0 = bf2f(w & 0xffffu), x1 = bf2f(w >> 16);
        float ss = x0 * x0 + x1 * x1;
#pragma unroll
        for (int o = 1; o < 32; o <<= 1) ss += SHFL_XOR(ss, o);
        const float rstd = 1.0f / sqrtf(ss * (1.0f / 64.0f) + EPS);
        x0 *= rstd * kg[d0]; x1 *= rstd * kg[d0 + 1];
        const float y0 = SHFL_XOR(x0, 8), y1 = SHFL_XOR(x1, 8);
        if (pos >= CTX) { const int t = pos - CTX; const float c0 = COS[(size_t)t * 32 + a * 16 + f0], s0 = SIN[(size_t)t * 32 + a * 16 + f0], c1 = COS[(size_t)t * 32 + a * 16 + f0 + 1], s1 = SIN[(size_t)t * 32 + a * 16 + f0 + 1];
            x0 = p == 0 ? x0 * c0 - y0 * s0 : x0 * c0 + y0 * s0; x1 = p == 0 ? x1 * c1 - y1 * s1 : x1 * c1 + y1 * s1; }
        *(unsigned*)(KP + ((size_t)(b * 2 + kv) * LK + pos) * 64 + d0) = pk2(x0, x1); }
}
DEV void gqa_unit(const Ctx& c, int layer, int b, int h, bool ctxu, int qb) {
    const bf16_t* QC = (const bf16_t*)(c.ws + OFF_P) + PO_QC; const bf16_t* KP = (const bf16_t*)(c.ws + SO_KP); const bf16_t* VT = (const bf16_t*)(c.ws + SO_VT);
    bf16_t* QO = (bf16_t*)(c.ws + OFF_P) + PO_GO; const float* qg = c.in[15] + (size_t)(layer >> 1) * 128;
    const int r = c.lane & 31, hh = c.lane >> 5, kv = h >> 2; const int ql = qb * 256 + c.wave * 32 + r;
    const int nq = ctxu ? CTX : SEQ, nk = ctxu ? CTX : LK; const bool valid = ql < nq, active = (qb * 256 + c.wave * 32) < nq;
    const int row = ctxu ? ML + b * CTX + ql : b * SEQ + ql;
    const int orow = ctxu ? row : b * SEQ + (ql % 128) * (SEQ / 128) + ql / 128;
    f32x16 o[2]; float m, l; bf16x8 qf[4];
    load_q(c, QC + (size_t)row * 512 + h * 64, valid, !ctxu, ql, qg, qf);
    attn_pass<64>(c, KP + (size_t)(b * 2 + kv) * LK * 64, VT + (size_t)(b * 2 + kv) * 64 * LK, LK, nk, qf, active, o, m, l);
    if (active) { l += SHFL_XOR(l, 32); const float il = 1.0f / l;
        if (valid) {
#pragma unroll
            for (int dt = 0; dt < 2; ++dt)
#pragma unroll
                for (int q4 = 0; q4 < 4; ++q4) { const int dv = 32 * dt + 8 * q4 + 4 * hh; u32x2 w;
                    w[0] = pk2(o[dt][4 * q4 + 0] * il, o[dt][4 * q4 + 1] * il); w[1] = pk2(o[dt][4 * q4 + 2] * il, o[dt][4 * q4 + 3] * il);
                    *(u32x2*)(QO + (size_t)orow * 512 + h * 64 + dv) = w; } } }
}

constexpr int D1_CW_OFF = 110592;
#ifndef D1_STOP
#define D1_STOP 0
#endif
DEV void dn_d1_item(const Ctx& c, int layer, int it, int stop = 0) {
    const int tc = it % NCH, dir = (it / NCH) & 1, h = (it / (2 * NCH)) & 3, b = it / (8 * NCH);
    const int chain = (b * 4 + h) * 2 + dir, cc = chain_chunk(dir, tc); const size_t ci = (size_t)chain * NCH + cc; const int o = layer >> 1;
    const bf16_t* DQ = (const bf16_t*)(c.ws + OFF_P) + PO_DQKV; const float* G = (const float*)(c.ws + OFF_G);
    const float* cwl = (const float*)(c.lds + D1_CW_OFF); const float* alog = c.in[17] + (size_t)o * 8; const float* dtb = c.in[18] + (size_t)o * 8;
    bf16_t* Ub = (bf16_t*)(c.ws + SO_U) + ci * 8192; bf16_t* Wb = (bf16_t*)(c.ws + SO_W) + ci * 8192; bf16_t* ATb = (bf16_t*)(c.ws + SO_AT) + ci * 4096;
    bf16_t* QNb = (bf16_t*)(c.ws + SO_QN) + ci * 8192; bf16_t* KDb = (bf16_t*)(c.ws + SO_KD) + ci * 8192; float* GE = (float*)(c.ws + SO_GE);
    bf16_t* Qs = (bf16_t*)c.lds; bf16_t* Ks = Qs + 64 * 136; bf16_t* Kt = Ks + 64 * 136; bf16_t* Vt = Kt + 128 * 72; float* Am = (float*)(c.lds + (2 * 64 * 136 + 2 * 128 * 72) * 2); float* gc = Am + 64 * 65; float* be = gc + 64;
    float* gam = be + 64; float* T2 = gam + 64; float* Rb = T2 + 64 * 65;
    const int seqlen = tc < NCC ? CTX : SEQ, tok0 = tc < NCC ? 64 * tc : 64 * (tc - NCC), rowbase = tc < NCC ? ML + b * CTX : b * SEQ;
    if (c.wave == 0) { const int j = c.lane, i = dir ? 63 - j : j; const int row = rowbase + tok0 + i;
        const float beta = sigmoidf_(G[(size_t)row * 16 + dir * 8 + h]);
        const float ld = -expf(alog[dir * 4 + h]) * softplusf_(G[(size_t)row * 16 + dir * 8 + 4 + h] + dtb[dir * 4 + h]);
        const float gcum = chain_cumsum(ld, j, 0); gc[j] = gcum; be[j] = beta; gam[j] = expf(gcum);
        if (j == 63) GE[ci] = expf(gcum); }
    {   const int j = c.tid >> 3, cg = c.tid & 7, i = dir ? 63 - j : j, tok = tok0 + i;
        bf16x8 raw[3][2], rawn[3][2];
#define D1_LOADROWS(R, TEN) { _Pragma("unroll") for (int tap = 0; tap < 3; ++tap) { const int tk = tok + tap - 1; const bool in = tk >= 0 && tk < seqlen; \
            const bf16_t* src = DQ + (size_t)(rowbase + (in ? tk : tok)) * 1536 + (TEN) * 512 + h * 128 + 16 * cg; R[tap][0] = ld16(src); R[tap][1] = ld16(src + 8); \
            if (!in) { R[tap][0] = (bf16x8){0, 0, 0, 0, 0, 0, 0, 0}; R[tap][1] = (bf16x8){0, 0, 0, 0, 0, 0, 0, 0}; } } }
        D1_LOADROWS(rawn, 0);
#pragma unroll 1
        for (int ten = 0; ten < 3; ++ten) { const int col = ten * 512 + h * 128 + 16 * cg;
            float val[16];
#pragma unroll
            for (int e = 0; e < 16; ++e) val[e] = 0.f;
#pragma unroll
            for (int tap = 0; tap < 3; ++tap) { raw[tap][0] = rawn[tap][0]; raw[tap][1] = rawn[tap][1]; }
            if (ten < 2) D1_LOADROWS(rawn, ten + 1);
            SCHED_FENCE();
#pragma unroll
            for (int tap = 0; tap < 3; ++tap) { float f0[8], f1[8]; unpack8(raw[tap][0], f0); unpack8(raw[tap][1], f1);
                const float* wp = cwl + tap * 1536 + col;
#pragma unroll
                for (int e = 0; e < 8; ++e) { val[e] += f0[e] * wp[e]; val[8 + e] += f1[e] * wp[8 + e]; }
                SCHED_FENCE(); }
#pragma unroll
            for (int e = 0; e < 16; ++e) val[e] = siluf_(val[e]);
            if (ten < 2) { float ss = 0.f;
#pragma unroll
                for (int e = 0; e < 16; ++e) ss += val[e] * val[e];
                ss += SHFL_XOR(ss, 1); ss += SHFL_XOR(ss, 2); ss += SHFL_XOR(ss, 4);
                const float sc = (1.0f / sqrtf(ss + EPS)) * (ten == 0 ? 0.08838834764831845f : 1.0f);
#pragma unroll
                for (int e = 0; e < 16; ++e) val[e] *= sc; }
            if (ten < 2) { bf16_t* dst = (ten == 0 ? Qs : Ks) + j * 136 + 16 * cg; float fa[8], fb[8];
#pragma unroll
                for (int e = 0; e < 8; ++e) { fa[e] = val[e]; fb[e] = val[8 + e]; }
                *(bf16x8*)dst = pack8(fa); *(bf16x8*)(dst + 8) = pack8(fb); }
            if (ten >= 1) { bf16_t* dstT = (ten == 1 ? Kt : Vt);
#pragma unroll
                for (int e = 0; e < 16; ++e) dstT[(16 * cg + e) * 72 + j] = (bf16_t)f2bf(val[e]); } } }
    BLOCK_SYNC(); if (stop == 1) return;
    const int r = c.lane & 31, hh = c.lane >> 5;
    {
        const int wq = c.wave & 3, tt = wq >> 1, st = wq & 1; const bool isq = c.wave >= 4;
        f32x16 acc;
#pragma unroll
        for (int i = 0; i < 16; ++i) acc[i] = 0.f;
        const bf16_t* Ar = (isq ? Qs : Ks) + (32 * tt + r) * 136; const bf16_t* Br = Ks + (32 * st + r) * 136;
#pragma unroll
        for (int ks = 0; ks < 8; ++ks) acc = MFMA32(ld16(Ar + 16 * ks + 8 * hh), ld16(Br + 16 * ks + 8 * hh), acc);
        const int s = 32 * st + r; const float gs = gc[s];
#pragma unroll
        for (int i = 0; i < 16; ++i) { const int t = 32 * tt + crow(i, hh); const float dec = expf(gc[t] - gs);
            if (!isq) Am[t * 65 + s] = t > s ? be[t] * dec * acc[i] : 0.f;
            else ATb[t * 64 + s] = (bf16_t)f2bf(t >= s ? dec * acc[i] : 0.f); } }
    BLOCK_SYNC(); if (stop == 2) return;
    if (c.wave == 0) { const int d = c.lane >> 4, cc = c.lane & 15; const float* Ad = Am + (16 * d) * 65 + 16 * d; float* Td = T2 + (16 * d) * 65 + 16 * d;
        float t[16];
#pragma unroll
        for (int i = 0; i < 16; ++i) { float acc = (cc == i) ? 1.f : 0.f;
#pragma unroll
            for (int j = 0; j < i; ++j) acc -= Ad[i * 65 + j] * t[j];
            t[i] = acc; }
#pragma unroll
        for (int i = 0; i < 16; ++i) Td[i * 65 + cc] = t[i]; }
    else { for (int e = c.tid - 64; e < 64 * 64; e += NTHREADS - 64) { const int t = e >> 6, s2 = e & 63; if ((s2 >> 4) > (t >> 4)) T2[t * 65 + s2] = 0.f; } }
    BLOCK_SYNC();
    for (int rb = 1; rb < 4; ++rb) { const int wcols = 16 * rb;
        for (int e = c.tid; e < 16 * wcols; e += NTHREADS) { const int i = e & 15, cidx = e >> 4; float acc = 0.f; const float* Ar = Am + (16 * rb + i) * 65;
            for (int kb = cidx & ~15; kb < wcols; kb += 16) {
#pragma unroll
                for (int kk = 0; kk < 16; ++kk) acc += Ar[kb + kk] * T2[(kb + kk) * 65 + cidx]; }
            Rb[i * 49 + cidx] = acc; }
        BLOCK_SYNC();
        for (int e = c.tid; e < 16 * wcols; e += NTHREADS) { const int i = e & 15, cidx = e >> 4; float acc = 0.f; const float* Tr = T2 + (16 * rb + i) * 65 + 16 * rb;
#pragma unroll
            for (int j = 0; j < 16; ++j) acc += Tr[j] * Rb[j * 49 + cidx];
            T2[(16 * rb + i) * 65 + cidx] = -acc; }
        BLOCK_SYNC(); }
    if (stop == 3) return;
#ifndef EMU
    int lane2_ = c.lane; asm volatile("" : "+v"(lane2_));
    const int r2 = lane2_ & 31, hh2 = lane2_ >> 5;
#else
    const int r2 = r, hh2 = hh;
#endif
    {
#pragma unroll
        for (int rep = 0; rep < 2; ++rep) { const int idx = c.wave + 8 * rep, isw = idx >> 3, tt = (idx >> 2) & 1, ct = idx & 3;
            f32x16 acc;
#pragma unroll
            for (int i = 0; i < 16; ++i) acc[i] = 0.f;
            const bf16_t* Bt = (isw ? Kt : Vt) + (32 * ct + r2) * 72;
#pragma unroll
            for (int ks = 0; ks < 4; ++ks) { float f[8];
#pragma unroll
                for (int e = 0; e < 8; ++e) { const int s = 16 * ks + 8 * hh2 + e; f[e] = T2[(32 * tt + r2) * 65 + s] * be[s] * (isw ? gam[s] : 1.0f); }
                acc = MFMA32(pack8(f), ld16(Bt + 16 * ks + 8 * hh2), acc); }
            bf16_t* dst = (isw ? Wb : Ub);
#pragma unroll
            for (int i = 0; i < 16; ++i) dst[(32 * tt + crow(i, hh2)) * 128 + 32 * ct + r2] = (bf16_t)f2bf(acc[i]); } }
    {
        const float gend = gc[63];
        const int j = c.tid >> 3, cg = c.tid & 7; const float gamj = gam[j];
#pragma unroll
        for (int half = 0; half < 2; ++half) { float f[8]; unpack8(ld16(Qs + j * 136 + 16 * cg + 8 * half), f);
#pragma unroll
            for (int e = 0; e < 8; ++e) f[e] *= gamj;
            *(bf16x8*)(QNb + j * 128 + 16 * cg + 8 * half) = pack8(f); }
#pragma unroll
        for (int ii = 0; ii < 2; ++ii) { const int idx = c.tid + 512 * ii, dk = idx >> 3, ch = idx & 7; float f[8]; unpack8(ld16(Kt + dk * 72 + 8 * ch), f);
#pragma unroll
            for (int e = 0; e < 8; ++e) f[e] *= expf(gend - gc[8 * ch + e]);
            *(bf16x8*)(KDb + dk * 64 + 8 * ch) = pack8(f); } }
    BLOCK_SYNC();
}
constexpr int D2_PW = 132, D2_PA = 68;
constexpr int D2_W = 0, D2_QN = 64 * D2_PW * 2, D2_AT = 2 * 64 * D2_PW * 2, D2_KD = D2_AT + 64 * D2_PA * 2, D2_BUF = D2_KD + 128 * D2_PA * 2;
static_assert(2 * D2_BUF <= LDS_MISC, "two D2 buffers fit below the LDS control words");
DEV void dn_d2_stage(const Ctx& c, size_t ci, char* buf) {
    const bf16_t* Wb = (const bf16_t*)(c.ws + SO_W) + ci * 8192; const bf16_t* QNb = (const bf16_t*)(c.ws + SO_QN) + ci * 8192; const bf16_t* ATb = (const bf16_t*)(c.ws + SO_AT) + ci * 4096; const bf16_t* KDb = (const bf16_t*)(c.ws + SO_KD) + ci * 8192;
    const int lt = c.tid - 256;
#pragma unroll 2
    for (int i = 0; i < 14; ++i) { const int idx = lt + 256 * i; const bf16_t* src; char* dst;
        if (idx < 1024) { const int row = idx >> 4, ch = idx & 15; src = Wb + row * 128 + 8 * ch; dst = buf + D2_W + (row * D2_PW + 8 * ch) * 2; }
        else if (idx < 2048) { const int j = idx - 1024, row = j >> 4, ch = j & 15; src = QNb + row * 128 + 8 * ch; dst = buf + D2_QN + (row * D2_PW + 8 * ch) * 2; }
        else if (idx < 2560) { const int j = idx - 2048, row = j >> 3, ch = j & 7; src = ATb + row * 64 + 8 * ch; dst = buf + D2_AT + (row * D2_PA + 8 * ch) * 2; }
        else { const int j = idx - 2560, row = j >> 3, ch = j & 7; src = KDb + row * 64 + 8 * ch; dst = buf + D2_KD + (row * D2_PA + 8 * ch) * 2; }
        const bf16x8 v = ld16(src); const bf16x4 lo = __builtin_shufflevector(v, v, 0, 1, 2, 3), hi = __builtin_shufflevector(v, v, 4, 5, 6, 7);
        *(bf16x4*)dst = lo; *(bf16x4*)(dst + 8) = hi; }
}
DEV void dn_d2_chain(const Ctx& c, int chain, bool emit_ctx) {
    const int dir = chain & 1, h = (chain >> 1) & 3, b = chain >> 3; const int r = c.lane & 31, hh = c.lane >> 5, sl = c.wave & 3; const bool comp = c.wave < 4;
    const bf16_t* U0 = (const bf16_t*)(c.ws + SO_U); const float* GE = (const float*)(c.ws + SO_GE);
    bf16_t* HB = (bf16_t*)(c.ws + OFF_P) + PO_HB + (size_t)dir * MT * 512;
    f32x16 S[4];
#pragma unroll
    for (int t4 = 0; t4 < 4; ++t4)
#pragma unroll
        for (int i = 0; i < 16; ++i) S[t4][i] = 0.f;
    if (!comp) dn_d2_stage(c, (size_t)chain * NCH, c.lds);
    BLOCK_SYNC();
    for (int cc = 0; cc < NCH; ++cc) { const size_t ci = (size_t)chain * NCH + cc; char* buf = c.lds + (cc & 1) * D2_BUF;
        if (!comp) { if (cc + 1 < NCH) dn_d2_stage(c, ci + 1, c.lds + ((cc + 1) & 1) * D2_BUF); }
        else {
            const bf16_t* Ub = U0 + ci * 8192; const bf16_t* Wl = (const bf16_t*)(buf + D2_W); const bf16_t* QNl = (const bf16_t*)(buf + D2_QN); const bf16_t* ATl = (const bf16_t*)(buf + D2_AT); const bf16_t* KDl = (const bf16_t*)(buf + D2_KD);
            f32x16 u[2], ov[2];
#pragma unroll
            for (int tt = 0; tt < 2; ++tt)
#pragma unroll
                for (int i = 0; i < 16; ++i) { u[tt][i] = -bf2f(Ub[(32 * tt + crow(i, hh)) * 128 + 32 * sl + r]); ov[tt][i] = 0.f; }
#pragma unroll
            for (int ks = 0; ks < 8; ++ks) { const bf16x8 sf = pack_acc(S[ks >> 1], ks & 1); const int k0 = 16 * ks + 4 * hh;
#pragma unroll
                for (int tt = 0; tt < 2; ++tt) { const bf16_t* wp = Wl + (32 * tt + r) * D2_PW + k0; const bf16_t* qp = QNl + (32 * tt + r) * D2_PW + k0;
                    u[tt] = MFMA32(cat44(*(const bf16x4*)wp, *(const bf16x4*)(wp + 8)), sf, u[tt]);
                    ov[tt] = MFMA32(cat44(*(const bf16x4*)qp, *(const bf16x4*)(qp + 8)), sf, ov[tt]); } }
#pragma unroll
            for (int tt = 0; tt < 2; ++tt)
#pragma unroll
                for (int i = 0; i < 16; ++i) u[tt][i] = -u[tt][i];
            const float ge = GE[ci];
#pragma unroll
            for (int t4 = 0; t4 < 4; ++t4)
#pragma unroll
                for (int i = 0; i < 16; ++i) S[t4][i] *= ge;
#pragma unroll
            for (int ks = 0; ks < 4; ++ks) { const bf16x8 uf = pack_acc(u[ks >> 1], ks & 1);
#pragma unroll
                for (int tt = 0; tt < 2; ++tt) { const bf16_t* ap = ATl + (32 * tt + r) * D2_PA + 16 * ks + 4 * hh;
                    ov[tt] = MFMA32(cat44(*(const bf16x4*)ap, *(const bf16x4*)(ap + 8)), uf, ov[tt]); }
#pragma unroll
                for (int t4 = 0; t4 < 4; ++t4) { const bf16_t* kp = KDl + (32 * t4 + r) * D2_PA + 16 * ks + 4 * hh;
                    S[t4] = MFMA32(cat44(*(const bf16x4*)kp, *(const bf16x4*)(kp + 8)), uf, S[t4]); } }
            const int tc = dir == 0 ? cc : (cc < NCC ? NCC - 1 - cc : NCC + (NLC - 1 - (cc - NCC)));
            if (tc >= NCC || emit_ctx) {
#pragma unroll
                for (int tt = 0; tt < 2; ++tt)
#pragma unroll
                    for (int i = 0; i < 16; ++i) { const int j = 32 * tt + crow(i, hh); const int row = tok_row(b, tc, dir ? 63 - j : j);
                        HB[(size_t)row * 512 + h * 128 + 32 * sl + r] = (bf16_t)f2bf(ov[tt][i]); } }
        }
        BLOCK_SYNC();
    }
}
DEV void dn_yasm(const Ctx& c, int layer, int nrows) {
    const bf16_t* HB = (const bf16_t*)(c.ws + OFF_P) + PO_HB; const bf16_t* Z = (const bf16_t*)(c.ws + OFF_P) + PO_Z; const bf16_t* QC = (const bf16_t*)(c.ws + OFF_P) + PO_GO; bf16_t* Y = (bf16_t*)(c.ws + OFF_HY);
    const float* gn = c.in[19] + (size_t)(layer >> 1) * 128;
    for (int it = c.gw; it < nrows * 2; it += c.ngw) { const int row = it >> 1, col = (it & 1) * 256 + 4 * c.lane;
        const bf16x4 a = *(const bf16x4*)(HB + (size_t)row * 512 + col), bb = *(const bf16x4*)(HB + (size_t)MT * 512 + (size_t)row * 512 + col), z = *(const bf16x4*)(Z + (size_t)row * 512 + col);
        float v[4], ss = 0.f;
#pragma unroll
        for (int e = 0; e < 4; ++e) { v[e] = bf2f((unsigned short)a[e]) + bf2f((unsigned short)bb[e]); ss += v[e] * v[e]; }
#pragma unroll
        for (int o = 1; o < 32; o <<= 1) ss += SHFL_XOR(ss, o);
        const float rstd = 1.0f / sqrtf(ss * (1.0f / 128.0f) + EPS);
        float y[4];
#pragma unroll
        for (int e = 0; e < 4; ++e) y[e] = v[e] * rstd * gn[(col & 127) + e] * siluf_(bf2f((unsigned short)z[e]));
        u32x2 w; w[0] = pk2(y[0], y[1]); w[1] = pk2(y[2], y[3]);
        *(u32x2*)(Y + (size_t)row * 1024 + 512 + col) = w;
        *(u32x2*)(Y + (size_t)row * 1024 + col) = *(const u32x2*)(QC + (size_t)row * 512 + col); }
}

DEV void gqa_units(const Ctx& c, int layer, bool emit_ctx, int first, int stride) {
    constexpr int NQBL = SEQ / 256, NQBC = (CTX + 255) / 256, NUL = NB * 8 * NQBL, NUC = NB * 8 * NQBC;
    const int nuc = emit_ctx ? NUC : 0;
    for (int it = first; it < NUL + nuc; it += stride) { const bool cu = it >= NUL; int u = cu ? it - NUL : it; const int nqb = cu ? NQBC : NQBL;
        gqa_unit(c, layer, u / (8 * nqb), (u / nqb) & 7, cu, u % nqb); }
}
DEV void mix_odd_a(const Ctx& c, int layer) {
    { PHASE_CTX(pc); if (ON(14)) odd_kprep(pc, layer); }
    { PHASE_CTX(pc); if (ON(15)) { const bf16_t* KVC = (const bf16_t*)(pc.ws + OFF_P) + PO_KVC; bf16_t* VT = (bf16_t*)(pc.ws + SO_VT);
        for (int it = pc.bid; it < NB * 2 * NCH; it += pc.nblk) { const int pch = it % NCH, bk = it / NCH; vt_item<64>(pc, KVC, 256, 128 + (bk & 1) * 64, bk >> 1, pch, VT + (size_t)bk * 64 * LK); } } }
    REPB(16) { PHASE_CTX(pc); if (ON(16)) {
        { const float* convw = pc.in[16] + (size_t)(layer >> 1) * 3 * 1536; float* cwl = (float*)(pc.lds + D1_CW_OFF); BLOCK_SYNC();
          for (int e = pc.tid; e < 3 * 1536 / 4; e += NTHREADS) ((f32x4*)cwl)[e] = ((const f32x4*)convw)[e];
          BLOCK_SYNC(); }
        for (int it = pc.bid; it < NCHAIN * NCH; it += pc.nblk) dn_d1_item(pc, layer, it, (rep_ < (int)(((unsigned long long)(REPM) >> 16) & 1ull)) ? D1_STOP : 0); } }
}
DEV void mix_odd_b(const Ctx& c, int layer, bool emit_ctx) {
    const int nd2 = NCHAIN < c.nblk ? NCHAIN : c.nblk;
    const int na = c.nblk - nd2;
    REPB(17) { PHASE_CTX(pc); if (ON(17)) if (pc.bid < nd2) { for (int ch = pc.bid; ch < NCHAIN; ch += nd2) dn_d2_chain(pc, ch, emit_ctx); } }
    REPB(18) { PHASE_CTX(pc); if (ON(18)) { if (na > 0) { if (pc.bid >= nd2) gqa_units(pc, layer, emit_ctx, pc.bid - nd2, na); } else gqa_units(pc, layer, emit_ctx, pc.bid, pc.nblk); } }
}
DEV void mix_odd_c(const Ctx& c, int layer, bool emit_ctx) {
    { PHASE_CTX(pc); if (ON(19)) dn_yasm(pc, layer, emit_ctx ? MT : ML); }
}

#ifdef SELFTEST
#ifdef EMU
#define ST_HD static inline
#else
#define ST_HD __host__ __device__ inline
#endif
constexpr size_t ST_CHK = 512 * 1024;
ST_HD unsigned st_hash(unsigned a, unsigned b) { unsigned x = a * 0x9E3779B1u ^ (b + 0x7F4A7C15u) * 0x85EBCA6Bu; x ^= x >> 16; x *= 0x7FEB352Du; x ^= x >> 15; x *= 0x846CA68Bu; x ^= x >> 16; return x; }
ST_HD float st_uniform(unsigned t, unsigned i) { return (float)(st_hash(t, i) >> 8) * (1.0f / 16777216.0f); }
ST_HD float st_normal(unsigned tensor, unsigned idx) { const float u1 = ((float)(st_hash(tensor * 4u, idx) >> 8) + 0.5f) * (1.0f / 16777216.0f), u2 = (float)(st_hash(tensor * 4u + 1u, idx) >> 8) * (1.0f / 16777216.0f); return sqrtf(-2.0f * logf(u1)) * cosf(6.2831853f * u2); }
ST_HD size_t st_count(int i) {
    switch (i) {
    case 0: return (size_t)NB * SEQ * D; case 1: return (size_t)NB * D; case 2: return (size_t)NB * CTX * D; case 3: return D;
    case 4: return (size_t)DEPTH * D * 6 * D; case 5: return (size_t)DEPTH * 6 * D; case 6: case 7: return (size_t)DEPTH * D;
    case 8: return (size_t)2 * D * E_IN; case 9: return 32; case 10: return 512; case 11: case 12: return 256; case 13: return (size_t)2 * 1024 * D;
    case 14: return (size_t)2 * D * O_IN; case 15: return 256; case 16: return 2 * 3 * 1536; case 17: return 16; case 18: return 16; case 19: return 256; case 20: return (size_t)2 * 1024 * D;
    case 21: case 22: return (size_t)DEPTH * D * FF; case 23: return (size_t)DEPTH * FF * D; default: return D; }
}
ST_HD float st_value(int i, size_t idx) {
#ifdef ST_SAME_BATCH
    if (i == 0) idx %= (size_t)SEQ * D; if (i == 1) idx %= (size_t)D; if (i == 2) idx %= (size_t)CTX * D;
#endif
    const float d = (float)D; const float n = st_normal((unsigned)i + 1u, (unsigned)idx);
    switch (i) {
    case 0: case 1: case 2: case 3: return n;
    case 4: return n * 0.5f / sqrtf(d); case 5: return n * 0.02f; case 6: case 7: case 11: case 12: case 15: case 19: case 24: return 1.0f + 0.02f * n;
    case 8: case 14: case 21: case 22: return n / sqrtf(d);
    case 9: return 0.1f * n + ((idx & 4) ? 3.0f + (float)(idx & 3) : 0.0f);
    case 10: return 0.1f * n; case 13: case 20: return n * (1.0f / 32.0f); case 16: return n * 0.57735027f;
    case 17: return logf(1.0f + 5.0f * (float)(idx & 3)) + 0.05f * n;
    case 18: { const float dt = expf(-6.9077553f + 4.6051702f * st_uniform(999u, (unsigned)idx)); return dt + logf(-expm1f(-dt)); }
    case 23: return n / sqrtf((float)FF);
    default: return n; }
}
ST_HD size_t st_offset(int i) { size_t o = 0; for (int k = 0; k < i; ++k) o += (st_count(k) + 63) & ~(size_t)63; return o; }
DEV void st_sum(const Ctx& c, int step, int sub, const void* base, size_t n, int is_bf16) {
    step += c.ngw;
    double p[8], s2 = 0.0;
#pragma unroll
    for (int k = 0; k < 8; ++k) p[k] = 0.0;
    const size_t gt = (size_t)c.bid * NTHREADS + c.tid, GT = (size_t)c.nblk * NTHREADS;
    for (size_t i = gt; i < n; i += GT) { const float v = is_bf16 ? bf2f(((const bf16_t*)base)[i]) : ((const float*)base)[i]; const unsigned h = st_hash(0xC0FFEEu + (unsigned)sub, (unsigned)i); s2 += (double)v * (double)v;
#pragma unroll
        for (int k = 0; k < 8; ++k) p[k] += ((h >> (k + 8)) & 1u) ? (double)v : -(double)v; }
    double* chk = (double*)(c.ws + ST_CHK) + ((size_t)step * 4 + sub) * 10;
#ifdef EMU
    for (int k = 0; k < 8; ++k) chk[k] += p[k];
    chk[8] += s2; if (gt == 0) chk[9] = (double)n;
#else
#pragma unroll
    for (int k = 0; k < 8; ++k) atomicAdd(chk + k, p[k]);
    atomicAdd(chk + 8, s2); if (gt == 0) chk[9] = (double)n;
#endif
}
DEV void st_checks(const Ctx& c, int step) {

    const int layer = step / 9, ph = step - 9 * layer, odd = layer & 1; const size_t mrows = layer < DEPTH - 1 ? MT : ML; unsigned char* ws = c.ws;
    if (ph == 0) { st_sum(c, step, 0, ws + OFF_HY, (size_t)MT * D, 1); st_sum(c, step, 1, ws + OFF_G, (size_t)MT * 16, 0); st_sum(c, step, 2, ws + OFF_WIN, (size_t)(odd ? NO : NE) * D, 1); st_sum(c, step, 3, ws + OFF_WOUT, (size_t)D * 1024, 1); }
    else if (ph == 1) { st_sum(c, step, 0, ws + OFF_P, (size_t)MT * (odd ? NO : NE), 1); }
    else if (ph == 2) { if (!odd) { st_sum(c, step, 0, ws + SE_KP, (size_t)NB * 8 * LK * 64, 1); st_sum(c, step, 1, ws + SE_VT, (size_t)NB * 4 * 128 * LK, 1); st_sum(c, step, 2, ws + SE_DCT, (size_t)NCHAIN * NCH * 8192, 0); st_sum(c, step, 3, ws + SE_DN, (size_t)NCHAIN * NCH * 64, 0); }
        else { st_sum(c, step, 0, ws + SO_KP, (size_t)NB * 2 * LK * 64 * 2, 1); st_sum(c, step, 1, ws + SO_U, (size_t)NCHAIN * NCH * 8192, 1); st_sum(c, step, 2, ws + SO_W, (size_t)NCHAIN * NCH * 8192, 1); st_sum(c, step, 3, ws + SO_AT, (size_t)NCHAIN * NCH * (4096 + 8192 + 8192), 1); } }
    else if (ph == 3) { if (!odd) { st_sum(c, step, 0, ws + SE_DCT, (size_t)NCHAIN * NCH * 8192, 0); st_sum(c, step, 1, ws + SE_DN, (size_t)NCHAIN * NCH * 64, 0); }
        else { st_sum(c, step, 0, ws + OFF_P + PO_HB * 2, (size_t)mrows * 512, 1); st_sum(c, step, 1, ws + OFF_P + (PO_HB + (size_t)MT * 512) * 2, (size_t)mrows * 512, 1); st_sum(c, step, 2, ws + OFF_P + PO_GO * 2, (size_t)mrows * 512, 1); } }
    else if (ph == 4) { st_sum(c, step, 0, ws + OFF_HY, (size_t)mrows * 1024, 1); }
    else if (ph == 5 || ph == 8) { st_sum(c, step, 0, ws + OFF_X, (size_t)mrows * D, 0); }
    else if (ph == 6) { st_sum(c, step, 0, ws + OFF_HY, (size_t)mrows * D, 1); st_sum(c, step, 1, ws + SF_WGU, (size_t)2 * FF * D, 1); st_sum(c, step, 2, ws + SF_WDN, (size_t)D * FF, 1); }
    else { st_sum(c, step, 0, ws + OFF_P, (size_t)mrows * FF, 1); }
}
#endif

DEV void final_norm(const Ctx& c) {
    constexpr int NV = D / 256;
    const float* X = (const float*)(c.ws + OFF_X); const float* g = c.in[24];
    for (int row = c.gw; row < ML; row += c.ngw) {
        const f32x4* xr = (const f32x4*)(X + (size_t)row * D) + c.lane; f32x4 v[NV]; float ss = 0.f;
#pragma unroll
        for (int j = 0; j < NV; ++j) { v[j] = xr[64 * j]; ss += (v[j][0] * v[j][0] + v[j][1] * v[j][1]) + (v[j][2] * v[j][2] + v[j][3] * v[j][3]); }
        const float rstd = 1.0f / sqrtf(wave_sum(ss) * (1.0f / D) + EPS);
        f32x4* o = (f32x4*)(c.out + (size_t)row * D) + c.lane;
#pragma unroll
        for (int j = 0; j < NV; ++j) o[64 * j] = v[j] * rstd * *(const f32x4*)(g + 256 * j + 4 * c.lane);
    }
}

constexpr size_t WS_NEED = cmax(WS_NEED_EF, SO_END);
#ifdef EMU
static void mega(Args args) {
    char* lds = emu::blocks[EMU_BID].lds;
    XcdBarrier bar; bar.dummy = 0;
#else
__global__ void __launch_bounds__(NTHREADS, 2) mega(Args args) {
    extern __shared__ __attribute__((aligned(16))) unsigned char lds_raw[];
    char* lds = (char*)lds_raw;
    {   volatile LAS unsigned* misc0 = (volatile LAS unsigned*)((LAS unsigned char*)lds_raw + LDS_MISC);
        if (threadIdx.x < 64) misc0[threadIdx.x] = 0u; }
    __syncthreads();
    XcdBarrier bar = xcd_barrier_post((unsigned*)(args.ws + OFF_CTL) + 4096, (volatile LAS unsigned*)((LAS unsigned char*)lds_raw + LDS_MISC) + 8);
#endif
    Ctx c;
#ifdef EMU
    c.tid = TIDX; c.lane = c.tid & 63; c.wave = c.tid >> 6;
#else
    c.tid = 0; c.lane = 0; c.wave = 0;
#endif
    c.bid = BIDX; c.nblk = NBLK; c.gw = c.bid * NWAVES + c.wave; c.ngw = c.nblk * NWAVES; c.lds = lds; c.in = args.in; c.out = args.out; c.ws = args.ws;

    if (args.prologue) {
    { PHASE_CTX(pc); if (ON(0)) p0_prologue(pc); }
#ifndef EMU
    cg::this_grid().sync();
#else
    GRID_BARRIER();
#endif
    }
#ifndef REPEAT_PH
#define REPEAT_PH -1
#endif
    for (int step2 = 2 * args.step_lo; step2 < 2 * args.step_hi; ++step2) {
        const int step = step2 >> 1; if ((step2 & 1) && !((step % 9) == REPEAT_PH && (REPEAT_PH != 3 || ((step / 9) & 1)))) continue;
        const int layer = step / 9, ph = step - 9 * layer;
        const int odd = layer & 1; const bool emit_ctx = layer < DEPTH - 1; const int mrows = emit_ctx ? MT : ML;
        if (ph == 0) {
            { PHASE_CTX(pc); if (ON(1) && (layer == 0 || step == args.step_lo)) convert_mixer_weights(pc, layer, pc.gw, pc.ngw); }
            { PHASE_CTX(pc); const bool prev = layer > 0 && step > args.step_lo; const int pm_ = MT;
              const SplitPlan red = split_plan(pm_, FF, pc.nblk, prev);
              if (ON(2)) normalize_rows(pc, layer, 0, MT, red, pm_, (const float*)(pc.ws + OFF_MOD) + (size_t)(layer - (prev ? 1 : 0)) * 9 * 6 * D + 5 * D); }
        } else if (ph == 1) {
            if (ON(3)) { PHASE_CTX(pc); pg8::Gemm g{(const bf16_t*)(pc.ws + OFF_HY), (const bf16_t*)(pc.ws + OFF_WIN), MT, odd ? NO : NE, D}; pg8::StaticOrder S; S.init(MT, odd ? NO : NE, c.nblk, c.bid); S.wave = pc.wave;
                if (odd && !emit_ctx && NO == 2816) { S.init(ML, NO, c.nblk, c.bid); S.wave = pc.wave; S.tn = (MC / 256) * 7; S.tpm = ML / 256; S.tpn = 2; S.tw = 7; }
                EpiSeg E{(bf16_t*)(pc.ws + OFF_P), odd};
                GEMM_PHASE(EpiSeg, lds, g, S, E); }
        } else if (ph == 2) { if (!odd) mix_even_a(c, layer); else mix_odd_a(c, layer); }
        else if (ph == 3) { if (!odd) mix_even_b(c, layer); else mix_odd_b(c, layer, emit_ctx); }
        else if (ph == 4) { if (!odd) mix_even_c(c, layer); else mix_odd_c(c, layer, emit_ctx); }
        else if (ph == 5 || ph == 8) {
            if (ON(4)) { PHASE_CTX(pc); const bool dn = ph == 8;
                const int kdim = dn ? FF : 1024; const SplitPlan sp = split_plan(mrows, kdim, pc.nblk, dn && layer + 1 < CFG_LAYERS);
                pg8::Gemm g{(const bf16_t*)(pc.ws + (dn ? OFF_P : OFF_HY)), (const bf16_t*)(pc.ws + (dn ? SF_WDN : OFF_WOUT)), mrows, D, kdim}; pg8::StaticOrder S; S.init(mrows, D, c.nblk, c.bid); S.wave = pc.wave;
                if (sp.extra) S.lim = pc.nblk;
                const bool first = layer == 0 && !dn;
                EpiResid E{(float*)(pc.ws + OFF_X), (const float*)(pc.ws + OFF_MOD) + (size_t)layer * 9 * 6 * D, dn ? 5 * D : 2 * D,
                           first ? pc.in[0] : (const float*)(pc.ws + OFF_X), first ? pc.in[2] - (size_t)ML * D : (const float*)(pc.ws + OFF_X)};
                GEMM_PHASE(EpiResid, lds, g, S, E);
                if (sp.extra && pc.bid < sp.extra * sp.split) {
                    const int lu = pc.bid / sp.split, q = pc.bid % sp.split, pairs = kdim / 128, base = pairs / sp.split, rem = pairs % sp.split;
                    const int np = base + (q < rem ? 1 : 0), p0 = q * base + (q < rem ? q : rem);
                    pg8::Gemm g2{g.A + (size_t)p0 * 128, g.Bt + (size_t)p0 * 128, mrows, D, np * 128, kdim}; pg8::StaticOrder S2; S2.init(mrows, D, sp.nwg, pc.nblk + lu); S2.wave = pc.wave;
                    EpiPart E2{(float*)(pc.ws + SF_PART) + (size_t)pc.bid * 65536};
                    BLOCK_SYNC();
                    GEMM_PHASE(EpiPart, lds, g2, S2, E2); } }
            { PHASE_CTX(pc); const SplitPlan sp = split_plan(mrows, ph == 8 ? FF : 1024, pc.nblk, ph == 8 && layer + 1 < CFG_LAYERS);
              const int nwg = sp.nwg; int busy = (nwg > pc.nblk && nwg < 2 * pc.nblk) ? nwg - pc.nblk : 0; if (sp.extra) busy = (pc.nblk - sp.extra * sp.split > pc.nblk / 4) ? sp.extra * sp.split : 0;
              if (ON(1) && pc.bid >= busy) { BLOCK_SYNC();
                  if (ph == 5) convert_ffn_weights(pc, layer, (pc.bid - busy) * NWAVES + pc.wave, (pc.nblk - busy) * NWAVES);
                  else if (layer + 1 < CFG_LAYERS && step + 1 < args.step_hi) convert_mixer_weights(pc, layer + 1, (pc.bid - busy) * NWAVES + pc.wave, (pc.nblk - busy) * NWAVES); } }
        } else if (ph == 6) {
            { PHASE_CTX(pc); const SplitPlan red = split_plan(mrows, 1024, pc.nblk, false);
              if (ON(2)) normalize_rows(pc, layer, 1, mrows, red, mrows, (const float*)(pc.ws + OFF_MOD) + (size_t)layer * 9 * 6 * D + 2 * D); }
        } else {
            if (ON(5)) { PHASE_CTX(pc); pg8::Gemm g{(const bf16_t*)(pc.ws + OFF_HY), (const bf16_t*)(pc.ws + SF_WGU), mrows, 2 * FF, D}; pg8::StaticOrder S; S.init(mrows, 2 * FF, c.nblk, c.bid); S.wave = pc.wave;
                EpiSwiglu E{(bf16_t*)(pc.ws + OFF_P)};
                GEMM_PHASE(EpiSwiglu, lds, g, S, E); }
        }
        if (step + 1 < args.step_hi || args.final_) GRID_BARRIER();
#ifdef EMU_STOP_AFTER_MIX
        if (layer == CFG_LAYERS - 1 && ph == 4) return;
#endif
    }
    if (args.final_) { PHASE_CTX(pc); if (ON(7)) final_norm(pc); }
}

#ifndef EMU
#ifdef PROBE_Y
__global__ void pr_stat(const bf16_t* Y, int rows, int c0, int c1, double* acc) {
    double s = 0.0, cnt = 0.0; float mx = 0.f;
    for (size_t k = (size_t)blockIdx.x * blockDim.x + threadIdx.x; k < (size_t)rows * 1024; k += (size_t)gridDim.x * blockDim.x) { const int col = (int)(k & 1023); if (col < c0 || col >= c1) continue;
        const float v = bf2f(Y[k]); s += (double)v * v; cnt += 1.0; mx = fmaxf(mx, fabsf(v)); }
    atomicAdd(acc, s); atomicAdd(acc + 1, cnt); atomicMax((unsigned long long*)acc + 2, (unsigned long long)(mx * 1e6f));
}
__global__ void pr_fill(const double* acc, float* out, int n) {
    const float rms = (float)sqrt(acc[0] / acc[1]), mx = (float)((const unsigned long long*)acc)[2] * 1e-6f;
    const float c = sqrtf(rms * 10.0f), B = mx * 10.0f;
    for (size_t k = (size_t)blockIdx.x * blockDim.x + threadIdx.x; k < (size_t)n; k += (size_t)gridDim.x * blockDim.x) out[k] = (k == 12345) ? B : c;
}
#endif
#ifdef SELFTEST
struct StPtrs { float* p[25]; };
__global__ void st_gen_inplace(StPtrs P) {
    for (int i = 0; i < 25; ++i) { const size_t n = st_count(i);
        for (size_t k = (size_t)blockIdx.x * blockDim.x + threadIdx.x; k < n; k += (size_t)gridDim.x * blockDim.x) P.p[i][k] = st_value(i, k); }
}
__global__ void st_gen(float* syn) {
    for (int i = 0; i < 25; ++i) { const size_t n = st_count(i), o = st_offset(i);
        for (size_t k = (size_t)blockIdx.x * blockDim.x + threadIdx.x; k < n; k += (size_t)gridDim.x * blockDim.x) syn[o + k] = st_value(i, k); }
}
constexpr int ST_NEXP = 74;
#ifndef ST_REPORT_SUB
#define ST_REPORT_SUB 0
#endif
#ifndef ST_TOL
#define ST_TOL 0.03
#endif
__device__ const int ST_EXP_STEP[74] = {0,0,0,0,1,2,2,2,2,3,3,4,5,6,6,6,7,8,9,9,9,9,10,11,11,11,11,12,12,12,13,14,15,15,15,16,17,18,18,18,18,19,20,20,20,20,21,21,22,23,24,24,24,25,26,27,27,27,27,28,29,29,29,29,30,30,30,31,32,33,33,33,34,35,};
__device__ const int ST_EXP_SUB[74] = {0,1,2,3,0,0,1,2,3,0,1,0,0,0,1,2,0,0,0,1,2,3,0,0,1,2,3,0,1,2,0,0,0,1,2,0,0,0,1,2,3,0,0,1,2,3,0,1,0,0,0,1,2,0,0,0,1,2,3,0,0,1,2,3,0,1,2,0,0,0,1,2,0,0,};
__device__ const double ST_EXP[74][10] = {
{2823.9405135959387,-6955.5741695016623,-5804.0977028682828,9054.3725127205253,-3966.7899582609534,-4601.8714917525649,7995.7762676179409,971.6921226978302,22251047.414743461,18874368,},
{291.26190879568458,-1573.2945180945098,331.66257446631789,357.45295172557235,-214.97323327884078,864.47900781407952,490.07691208645701,667.85457975044847,340263.10377825046,294912,},
{-23.357008519407827,15.935151411395054,35.883058835112024,57.434714148461353,-51.349641996261198,60.264678716950584,-59.23590717773186,-56.705568651959766,3067.8819070441805,3145728,},
{25.470241500996053,-43.468927160836756,58.065743817947805,4.3800708865746856,11.067458258010447,-10.867067505605519,26.364831392653286,-27.969552277587354,1020.9866835358141,1048576,},
{-11200.415292963386,9297.3592315688729,3203.3726777359843,-9663.7561300396919,-641.6257035061717,-8234.4563228115439,7994.2129158824682,-5521.8908601477742,66654113.07759431,56623104,},
{-1194.5305787473917,-1674.2680710405111,-5463.7986858785152,-4930.0590666979551,-1068.7674529403448,3002.9571408778429,-649.54952663183212,-4412.2754199355841,11106170.817955792,9437184,},
{-5507.6614354923368,1901.5068384334445,-4913.9082106724381,-2596.9450140967965,-1520.3851273730397,3237.6398326531053,-2359.8059303388,2364.7748123183846,11105296.668379547,9437184,},
{1560.4392579563191,-2499.261261367612,1459.3170721097504,-245.48758464773891,1043.47321934717,1419.7026340031534,1920.6481273452355,-1582.4576623782978,1601541.1673813532,18874368,},
{18.923751746769994,105.40070073772222,-9.9321377836167812,-69.897449327632785,166.82718826597556,123.35070158960298,-124.43343016551808,-149.78254351718351,24705.222434743067,147456,},
{2291.1772415378409,-198.18048978019215,106.27707149069283,1579.1373604525679,1783.1593627679513,2121.0945059178157,-2611.1484069368307,-1331.619970235115,2782256.6531369383,18874368,},
{89.759916271461407,27.444828146166401,211.5510761210171,-443.45204046583967,221.2014890195278,-713.03335159321432,-278.38321068481309,161.85793914255919,83907.236548682689,147456,},
{2060.1309491619468,-3099.3174412855878,3189.1278408914804,-1495.998928762041,2018.3208422241732,3951.0027283849195,307.00997438374907,189.92257314547896,8838647.8145213183,18874368,},
{2615.2232726222937,-3851.6311007236727,-5090.8008575433851,8895.7526726254218,-2915.793732104612,-3466.5127967876979,8494.2590465184257,-476.8310997271401,19641291.046898585,18874368,},
{2260.6133435368538,-3524.0150115936995,-6184.6817786470056,8612.6491934210062,-2936.174174323678,-5085.3421624973416,7627.2569323033094,-322.10541462153196,22201812.480418805,18874368,},
{39.211919396329904,-22.191732778126607,71.555887567257741,-34.657468227291247,-37.514794261514908,48.970252739818534,56.030709780199686,21.127209749916801,5631.6743743792158,5767168,},
{-58.957687043759506,-25.822232720500324,27.559850534133147,-19.2058952494408,25.962478367669974,10.300243424077053,-1.6967002287856303,-52.715924362360965,1022.4535583883176,2883584,},
{-194.02440498952637,2323.5604243765411,4943.6193249881908,-6076.2407636700955,-3098.2506252240564,1737.1458579480241,4071.2157669755688,3426.5647126794502,26276154.208520912,51904512,},
{2062.0307282910508,-2404.6291768250012,-4943.0085245753726,8409.3699170327891,-3388.5586135165795,-3156.0619303231506,8070.8516135739701,103.72620783001184,20445489.612024359,18874368,},
{-850.44070326350629,-1898.2922850791365,-5629.5260096881539,5319.5235935095698,-3571.6089787539095,-4582.1209145840257,8084.1448610220104,1201.9745895769447,22408943.624150425,18874368,},
{-276.67351097613573,238.73336043953896,402.49070692062378,1139.6587501242757,412.53829725086689,1001.9456618651748,-199.34280802309513,243.97394938021898,346041.02869538032,294912,},
{55.275690128095448,33.631906502880156,39.819098525680602,39.580814833752811,-56.659358996432275,56.905868629924953,70.874192817136645,32.641803210601211,2813.6335960129777,2883584,},
{16.459319942980073,-15.029889202327468,24.789046118385158,39.597747391439043,22.32851928321179,32.169926681905054,4.3831529127201065,-11.914361283765174,1024.2634621089853,1048576,},
{-8112.7706977427006,-15166.404139339924,9019.1636524870992,-10032.914728678763,-3683.5552492365241,6445.1523703113198,4940.6895737573504,-396.46003675460815,61599346.798404746,51904512,},
{1064.6478829011321,2961.5112186744809,2643.997241653502,3817.1335873380303,2552.6912311688066,2848.1112303361297,2641.0165046826005,877.74564967304468,5155886.6824775627,4718592,},
{-1180.9790783076314,-353.66288720036391,1405.2405796857784,-3003.0330094090896,736.01905330538284,1520.8871299045859,-1925.6258542904397,-909.10001162986737,2434153.6281470573,18874368,},
{60.165285118651028,-119.7430636333083,80.732633202489126,-9.8426874747077857,-101.69595492020277,-92.996986093445443,207.83742497175277,20.265997010018708,8918.7285340001526,18874368,},
{270.78828044847916,-133.56509196904631,-10.835563753045964,-177.08542341093678,116.75884305510037,-401.68338958283317,92.706295374895404,-256.76246256793473,40406.455039767519,47185920,},
{-17.403251063922653,85.550381564797135,-67.875341098901117,39.030201086570742,-44.825321126758354,-24.736986581498059,-130.15850522785331,-6.1346717766427901,3203.0568557028691,9437184,},
{26.677921455280739,-10.301573183693108,-15.383461458186503,23.552394272832316,-16.422941844488378,33.179475616852869,-26.073428510382655,49.43283157730184,2218.7160715744772,9437184,},
{-104.63265653897543,-1025.0813928971766,623.84842114138883,-1420.2001781960716,1368.3365971482126,-86.704579671728425,96.991083307308145,428.70963656844106,889696.22597060842,9437184,},
{2432.259056510753,267.30669010814745,1837.783826454659,2981.6297531555174,-416.17357830458786,-1826.6180147336563,-301.78532918507699,-744.86193079140503,4898348.3318136279,18874368,},
{3294.5902997395533,-865.44878266500746,-4974.0870277224822,6772.8382276698467,-3398.3562051501722,-4187.1136843486529,8143.3624155692742,-612.10508898339322,20872541.311585322,18874368,},
{3536.330776873976,1917.42852505669,-2076.6844129748642,4320.7511040978134,-4890.1908001117408,-4107.6248654313385,10533.807669285685,471.08626228198409,22412768.276720807,18874368,},
{-6.0809309475971531,76.739011337651391,97.496654804484933,-29.642639640796915,0.70117462620510196,-203.53367705441451,-98.699187040134348,-53.162115221513886,5628.1487348292976,5767168,},
{56.758986754866783,46.788941775390413,-43.423746958898846,33.754279191547539,25.984360144881066,-65.525896325649228,5.420765693706926,45.74655341921607,1023.6598906812283,2883584,},
{2102.1720024403512,3520.8294076444326,-6874.5287163143184,3797.4676643103921,3201.4737541926479,2643.8227775447631,352.29275992398834,1880.529091139204,26630809.672188494,51904512,},
{2885.2073127178519,-1385.1170310270754,-4514.0122937517372,7030.8231581723594,-3845.7207517792049,-6356.8220687311768,7588.3782935662384,-564.85132873002294,21742637.688699484,18874368,},
{3812.0284725353122,1621.2253267094493,-4254.9756214395165,6197.9158516302705,8.5768845900893211,-5469.3091325387359,8752.140286244452,-1246.7436530068517,22065010.375674032,18874368,},
{-1149.1737003140152,496.67538012936711,483.18858239427209,650.82792166247964,314.5317993350327,-371.12024437263608,890.37748170271516,-1420.4709294177592,350924.7500354572,294912,},
{88.047429081168957,-74.825534723349847,-23.789757229969837,-97.320472310879268,-4.0056394656421617,-30.904204592457972,-18.987518870853819,-27.849783896817826,3073.3731145051615,3145728,},
{65.20327353652101,3.0222902240930125,25.993390792864375,14.415037170168944,54.844758132356219,-56.249738970887847,19.864254156243987,-27.887308357167058,1025.1381782409978,1048576,},
{-13237.945228233933,-5020.7346298694611,5226.0037766546011,12825.714193224907,-2397.7048603817821,-7119.2997151985765,9948.7588085010648,-5921.2636323198676,66137041.201810837,56623104,},
{-75.766457952558994,2293.2211949080229,-2037.293488740921,1509.2966427430511,6117.5132186114788,479.96601853519678,-5639.6398960202932,1845.2123182713985,11060201.299008245,9437184,},
{-462.10384976491332,5736.9905912540853,-2167.2699889577925,-1180.0111477933824,409.65681508556008,-1780.9929978586733,-671.92641231790185,-1349.7005080021918,11027953.433529973,9437184,},
{-822.00079254147931,-1214.0090433928017,3328.184749965596,87.801341768161365,-495.11205383328706,-877.86274139888337,1911.2223419476468,796.02008414199008,1759052.6843886974,18874368,},
{100.80030664941296,22.118581771384925,-242.38840196980163,-93.397681776899844,-57.195992573630065,-53.402307578828186,-150.74265199294314,-86.528761671390384,31090.621100439952,147456,},
{3075.2200345232932,146.19098324902222,-1073.3931368374535,-3446.3695871779209,37.989448957180798,223.73928401402372,1720.4827841137958,2765.2156565344467,3854013.6325600357,18874368,},
{542.032717238857,-110.56952357693081,1.825648151418136,-830.79371399683441,-111.90571951437596,-416.65702595594485,-459.77385005963879,177.62618795662274,136561.77048135776,147456,},
{-536.59579325607046,3431.0063604712486,3724.987038930878,-672.57181697292253,-3271.82986589754,-275.97591033531353,1134.3561726845801,3369.160484327469,5460094.8227678062,18874368,},
{3690.413550499331,-2055.6428064615766,-5438.0006776863584,7215.5527907973737,-3675.7019953130812,-5533.6785190762885,6701.1122693967927,64.846424879085134,22222666.921814281,18874368,},
{6145.2994565963745,-1456.0999585092068,-5831.9741258770227,8761.7396555989981,-5699.234908297658,-4079.551640689373,4842.0201814621687,-2019.1001229286194,22203324.287363961,18874368,},
{130.56598056000075,66.178603142005159,-72.223813362215878,-40.295281428698217,26.729994425171753,-72.123386049031978,-88.871669880725676,27.124975894665113,5635.9492323544555,5767168,},
{32.54455375490943,72.597239872498903,-17.171426851477008,-4.8966801255592145,-15.258403940417338,-23.122007071331609,-22.899502303858753,62.156484370876569,1023.7774562760339,2883584,},
{-6760.2973620964185,3735.844417643224,1094.1796880429465,4204.2181440759596,-764.49361893783498,-4932.0209130450239,-6261.1468112875446,-4488.8535375963402,26246313.294528794,51904512,},
{4457.1757640697724,-2267.1563059242435,-4745.1736963140393,7186.1535465445595,-4113.5497737388105,-7139.5026401302202,6476.8297955984126,-72.098023249844118,23047663.524188824,18874368,},
{4172.7441230602562,2189.9780470617115,-5133.8792393095791,7288.8046996556222,-5411.0709395520389,-4896.6709096245468,8724.0389158017933,-1300.7641984857619,22255371.479420178,18874368,},
{342.48845159634948,-1155.9452162571251,-355.46573888137937,38.030472237616777,-706.72725258395076,302.12307207658887,1501.216548230499,-189.15161934122443,356337.53284288617,294912,},
{141.34916719738249,55.510840875467693,3.4794936717735254,14.99616638317093,48.530484220267681,80.824254727551306,36.550317391192948,-11.045543047970568,2822.5213800999318,2883584,},
{-1.7540650628507137,-68.523136725649238,20.526102727279067,4.1151908580213785,26.478423124179244,17.260244991630316,26.540773348882794,18.066198658198118,1023.7352584092852,1048576,},
{9615.2207438386977,4784.9471067078412,1940.7497162856162,-5810.9412356205285,-983.56367782130837,7418.8542090691626,16772.396392870694,-7707.8745242021978,61356805.552982159,51904512,},
{1611.5909418128431,-862.28053805604577,-136.1677976809442,-552.47190998122096,983.61643074825406,-2118.3313589207828,2136.0759917013347,1436.2902639396489,5189176.8575152932,4718592,},
{1791.7875226804172,-31.704715774103533,260.74334435508354,2286.3263573826407,2006.0634295089985,-556.23315154918237,2794.1662208863418,265.33516812947346,2237659.8451027921,18874368,},
{1.738220854325472,-47.72536333968177,85.671240820733587,-76.785340997768273,-33.389609302064237,10.517162931163593,-16.605087701564099,-69.403631001852744,4294.4259768959364,18874368,},
{80.462511468439985,-161.96663447577936,103.6356164854663,158.8806262336563,-156.06783419597375,68.553029276052172,-342.86381052307308,-54.733859514236087,20398.968534675096,47185920,},
{52.505996509542456,40.193077393545536,-32.136223205568967,9.6826318503881339,-32.908785335748689,-49.309646418463672,7.7728565156285185,28.182192534412025,933.99111986596574,8388608,},
{-7.5194821398763452,15.928513078688411,-22.494523745699553,-25.74654744003783,-1.9659538757696282,39.424875568918651,-41.204660507297376,-50.291643056989415,1399.3033406704337,8388608,},
{-135.14476990071125,388.87867833836935,-624.19169349339791,-255.41803698171861,749.05279063689522,489.13258223538287,7.6979752753395587,-1529.1879597052466,922125.16740855761,8388608,},
{2513.205304118339,-3002.4781056293286,-591.26384180737659,984.36628054594621,-165.44268643157557,-2587.8124781120569,5950.0621142634191,1918.4807258569635,4533654.192930459,16777216,},
{2830.9344703354946,-4920.8287407121315,-3976.7572222978852,7101.1558030729429,-6279.3158443071807,-7658.587931540409,7596.1372552172033,-980.77548625691998,20848405.50834683,16777216,},
{5663.7043273374438,-4698.0929517224431,-2882.0782249197364,6381.8024617210031,-6684.7693502381444,-6324.1065613850951,5276.286193959415,-1294.3445755466819,19824501.716412377,16777216,},
{105.49113711505197,9.4353141400497407,71.544671961572021,-144.04839801136404,-59.128098372370005,86.345427959226072,-22.445412413449958,-31.521184443496168,5635.2677728111466,5767168,},
{-52.974209187126689,83.749726402067608,-11.22629395038166,-7.1423740544887551,-10.056938788195112,-45.578087951795169,41.377634743421368,16.152020135003113,1023.3413428186279,2883584,},
{1126.9516335337321,-4958.3812902097925,-2794.7144431749111,5195.0455790979104,4310.2982955073458,-6172.0018973502665,4099.1716476037618,-5060.7709415074714,23578261.929520626,46137344,},
{854.11164966656725,-4002.1053702284298,-4016.2943720539079,7535.4821215254451,-6184.3291782648776,-6281.2433878521588,8750.5079252671385,531.59902707755464,21616516.22354921,16777216,},
};
__global__ void st_check_kernel(unsigned char* ws, int step, int slot = 0) { Ctx c; c.tid = threadIdx.x; c.lane = c.tid & 63; c.wave = c.tid >> 6; c.bid = blockIdx.x; c.nblk = gridDim.x; c.gw = 0; c.ngw = slot; c.lds = nullptr; c.in = nullptr; c.out = nullptr; c.ws = ws; st_checks(c, step); }
__global__ void st_report(const unsigned char* ws, float* out, int n) {
    const double* chk = (const double*)(ws + ST_CHK); int code = 0;
    for (int e = 0; e < ST_NEXP && !code; ++e) { const int step = ST_EXP_STEP[e], sub = ST_EXP_SUB[e]; const double* g = chk + (step * 4 + sub) * 10; double d2 = 0.0; if (g[9] == 0.0) continue;
        for (int k = 0; k < 8; ++k) { const double d = g[k] - ST_EXP[e][k]; d2 += d * d; }
        const double eps2 = d2 / (8.0 * ST_EXP[e][8] + 1e-300);
        const bool bad = !(eps2 <= ST_TOL * ST_TOL);
        if (bad) code = ST_REPORT_SUB ? (step == ST_REPORT_SUB - 1 ? sub + 1 : 0) : step + 1; }
    const float v = sqrtf((float)code);
    for (size_t k = (size_t)blockIdx.x * blockDim.x + threadIdx.x; k < (size_t)n; k += (size_t)gridDim.x * blockDim.x) out[k] = v;
}
__global__ void st_repeat_report(const unsigned char* ws, float* out, int n, int nsteps) {
    const double* chk = (const double*)(ws + ST_CHK); int code = 0;
    for (int st = 0; st < nsteps && !code; ++st) for (int sub = 0; sub < 4 && !code; ++sub) { const double* a = chk + ((size_t)st * 4 + sub) * 10; const double* b = chk + ((size_t)(st + 40) * 4 + sub) * 10;
        if (a[9] == 0.0 || b[9] == 0.0) continue; double d2 = 0.0; for (int k = 0; k < 8; ++k) d2 += (a[k] - b[k]) * (a[k] - b[k]);
        if (!(d2 <= 1e-14 * 8.0 * a[8])) code = st + 1; }
    const float v = sqrtf((float)code);
    for (size_t k = (size_t)blockIdx.x * blockDim.x + threadIdx.x; k < (size_t)n; k += (size_t)gridDim.x * blockDim.x) out[k] = v;
}
__global__ void st_twice_report(const unsigned char* ws, float* out, int n) {
    const double* chk = (const double*)(ws + ST_CHK); const double* a = chk + ((size_t)35 * 4) * 10; const double* b = chk + ((size_t)(35 + 40) * 4) * 10;
    double d2 = 0.0; for (int k = 0; k < 8; ++k) d2 += (a[k] - b[k]) * (a[k] - b[k]);
    const double eps = sqrt(d2 / (8.0 * a[8] + 1e-300)) + 1e-30; const float v = sqrtf((float)floor(fmax(0.0, -log10(eps))));
    for (size_t k = (size_t)blockIdx.x * blockDim.x + threadIdx.x; k < (size_t)n; k += (size_t)gridDim.x * blockDim.x) out[k] = v;
}
__global__ void st_final_check(const unsigned char* ws, const float* out, const float* g, double* acc) {
    const float* X = (const float*)(ws + OFF_X);
    for (int row = blockIdx.x * blockDim.x + threadIdx.x; row < ML; row += gridDim.x * blockDim.x) { const float* x = X + (size_t)row * D; double ss = 0.0;
        for (int k = 0; k < D; ++k) ss += (double)x[k] * x[k];
        const double rstd = 1.0 / sqrt(ss / D + 1e-6); double d2 = 0.0, r2 = 0.0;
        for (int k = 0; k < D; ++k) { const double r = x[k] * rstd * g[k], o = out[(size_t)row * D + k]; d2 += (o - r) * (o - r); r2 += r * r; }
        atomicAdd(acc, d2); atomicAdd(acc + 1, r2); }
}
__global__ void st_final_fill(const double* acc, float* out, int n) { const double eps = sqrt(acc[0] / (acc[1] + 1e-300)) + 1e-30; const float v = sqrtf((float)floor(fmax(0.0, -log10(eps))));
    for (size_t k = (size_t)blockIdx.x * blockDim.x + threadIdx.x; k < (size_t)n; k += (size_t)gridDim.x * blockDim.x) out[k] = v; }
__global__ void st_same_batch_inputs(const float* x, const float* cv, const float* ctx, float* xs, float* cs, float* ctxs) {
    const size_t gt = (size_t)blockIdx.x * blockDim.x + threadIdx.x, GT = (size_t)gridDim.x * blockDim.x;
    for (size_t k = gt; k < (size_t)NB * SEQ * D; k += GT) xs[k] = x[k % ((size_t)SEQ * D)];
    for (size_t k = gt; k < (size_t)NB * CTX * D; k += GT) ctxs[k] = ctx[k % ((size_t)CTX * D)];
    for (size_t k = gt; k < (size_t)NB * D; k += GT) cs[k] = cv[k % (size_t)D];
}
__global__ void st_batch_report(const float* sout, float* out, int n, double* acc) {
    const size_t per = (size_t)SEQ * D;
    for (int b = 1; b < NB; ++b) { double d2 = 0.0, r2 = 0.0;
        for (size_t k = (size_t)blockIdx.x * blockDim.x + threadIdx.x; k < per; k += (size_t)gridDim.x * blockDim.x) { const double a0 = sout[k], ab = sout[(size_t)b * per + k]; d2 += (ab - a0) * (ab - a0); r2 += a0 * a0; }
        atomicAdd(acc + 2 * b, d2); atomicAdd(acc + 2 * b + 1, r2); }
    __threadfence();
    __shared__ unsigned last; if (threadIdx.x == 0) last = atomicAdd((unsigned*)acc, 1u) == gridDim.x - 1; __syncthreads();
    if (!last) return;
    int code = 0; for (int b = 1; b < NB && !code; ++b) { const double d2 = atomicAdd(acc + 2 * b, 0.0), r2 = atomicAdd(acc + 2 * b + 1, 0.0); if (!(d2 <= 1e-4 * r2)) code = b; }
    *((volatile int*)(acc + 1)) = code;
}
__global__ void st_fill(const double* acc, float* out, int n) { const float v = sqrtf((float)*((const volatile int*)(acc + 1))); for (size_t k = (size_t)blockIdx.x * blockDim.x + threadIdx.x; k < (size_t)n; k += (size_t)gridDim.x * blockDim.x) out[k] = v; }
#endif

#if defined(SELFTEST) && (defined(ST_DACHECK) || defined(ST_MODCHECK) || defined(ST_L0CHECK) || defined(ST_TAILCHECK) || defined(ST_MLCHECK) || defined(ST_DNCHECK) || defined(ST_TRUTH) || defined(ST_GQCHECK))
__global__ void st_da_check(const unsigned char* ws, const float* lam, const float* gn, double* acc, float* scr) {
    const int lane = threadIdx.x & 63, gw = (blockIdx.x * blockDim.x + threadIdx.x) >> 6, ngw = (gridDim.x * blockDim.x) >> 6;
    const bf16_t* QA = (const bf16_t*)(ws + OFF_P) + PE_QA; const bf16_t* KA = (const bf16_t*)(ws + OFF_P) + PE_KA; const bf16_t* VA = (const bf16_t*)(ws + OFF_P) + PE_VA; const bf16_t* Y = (const bf16_t*)(ws + OFF_HY);
    const float* COS = (const float*)(ws + OFF_ROPE); const float* SIN = COS + (size_t)SEQ * 32;
    float* s1 = scr + (size_t)gw * 2 * LK; float* s2 = s1 + LK;
    float la = 0.f, lb = 0.f; la = lam[lane] * lam[64 + lane]; lb = lam[128 + lane] * lam[192 + lane];
    for (int o = 1; o < 64; o <<= 1) { la += __shfl_xor(la, o); lb += __shfl_xor(lb, o); }
    const float lam_init = 0.2f, lmb = expf(la) - expf(lb) + lam_init;
    __shared__ float qs[8][2][64];
    const int wv = threadIdx.x >> 6;
    for (int it = gw; it < (ML / 16) * 4; it += ngw) { const int h = it & 3, row = (it >> 2) * 16 + 5; const int b = row / SEQ, t = row % SEQ;
        for (int m = 0; m < 2; ++m) { const int d = lane; const int a = d >> 5, pp = (d >> 4) & 1, f = d & 15; const float x = bf2f(QA[(size_t)row * 512 + h * 128 + m * 64 + d]), xp = bf2f(QA[(size_t)row * 512 + h * 128 + m * 64 + (d ^ 16)]);
            const float cs = COS[(size_t)t * 32 + a * 16 + f], sn = SIN[(size_t)t * 32 + a * 16 + f]; qs[wv][m][d] = pp == 0 ? x * cs - xp * sn : x * cs + xp * sn; }
        __syncthreads();
        float m1 = -1e30f, m2 = -1e30f;
        for (int j = lane; j < LK; j += 64) { const int kr = pos_row(b, j); const bool rope = j >= CTX; const int kt = j - CTX; float a1 = 0.f, a2 = 0.f;
            for (int d = 0; d < 64; ++d) { const int a = d >> 5, pp = (d >> 4) & 1, f = d & 15;
                float k1 = bf2f(KA[(size_t)kr * 512 + h * 128 + d]), k2 = bf2f(KA[(size_t)kr * 512 + h * 128 + 64 + d]);
                if (rope) { const float k1p = bf2f(KA[(size_t)kr * 512 + h * 128 + (d ^ 16)]), k2p = bf2f(KA[(size_t)kr * 512 + h * 128 + 64 + (d ^ 16)]); const float cs = COS[(size_t)kt * 32 + a * 16 + f], sn = SIN[(size_t)kt * 32 + a * 16 + f];
                    k1 = pp == 0 ? k1 * cs - k1p * sn : k1 * cs + k1p * sn; k2 = pp == 0 ? k2 * cs - k2p * sn : k2 * cs + k2p * sn; }
                a1 += qs[wv][0][d] * k1; a2 += qs[wv][1][d] * k2; }
            a1 *= 0.125f; a2 *= 0.125f; s1[j] = a1; s2[j] = a2; m1 = fmaxf(m1, a1); m2 = fmaxf(m2, a2); }
        for (int o = 1; o < 64; o <<= 1) { m1 = fmaxf(m1, __shfl_xor(m1, o)); m2 = fmaxf(m2, __shfl_xor(m2, o)); }
        float l1 = 0.f, l2 = 0.f;
        for (int j = lane; j < LK; j += 64) { const float p1 = expf(s1[j] - m1), p2 = expf(s2[j] - m2); s1[j] = p1; s2[j] = p2; l1 += p1; l2 += p2; }
        for (int o = 1; o < 64; o <<= 1) { l1 += __shfl_xor(l1, o); l2 += __shfl_xor(l2, o); }
        __threadfence(); __syncthreads();
        float o0 = 0.f, o1 = 0.f;
        for (int j = 0; j < LK; ++j) { const int kr = pos_row(b, j); const float p = s1[j] / l1 - lmb * s2[j] / l2; o0 += p * bf2f(VA[(size_t)kr * 512 + h * 128 + lane]); o1 += p * bf2f(VA[(size_t)kr * 512 + h * 128 + 64 + lane]); }
        float ss = o0 * o0 + o1 * o1; for (int o = 1; o < 64; o <<= 1) ss += __shfl_xor(ss, o);
        const float sc = (1.0f / sqrtf(ss / 128.0f + 1e-6f)) * (1.0f - lam_init);
        const float r0 = o0 * sc * gn[lane], r1 = o1 * sc * gn[64 + lane], y0 = bf2f(Y[(size_t)row * 1024 + h * 128 + lane]), y1 = bf2f(Y[(size_t)row * 1024 + h * 128 + 64 + lane]);
        double d2 = (double)(y0 - r0) * (y0 - r0) + (double)(y1 - r1) * (y1 - r1), r2 = (double)r0 * r0 + (double)r1 * r1;
        for (int o = 1; o < 64; o <<= 1) { d2 += __shfl_xor(d2, o); r2 += __shfl_xor(r2, o); }
        if (lane == 0) { atomicAdd(acc, d2); atomicAdd(acc + 1, r2); }
        __syncthreads(); }
}
__global__ void st_mod_check(const unsigned char* ws, const float* cv, const float* cctx, const float* w_ada, const float* b_ada, double* acc) {
    const float* MOD = (const float*)(ws + OFF_MOD); double d2 = 0.0, r2 = 0.0;
    for (long it = (long)blockIdx.x * blockDim.x + threadIdx.x; it < (long)DEPTH * 9 * 6 * D; it += (long)gridDim.x * blockDim.x) { const int n = (int)(it % (6 * D)), r = (int)((it / (6 * D)) % 9), l = (int)(it / (6L * D * 9));
        double s = b_ada[(size_t)l * 6 * D + n];
        for (int k = 0; k < D; ++k) { const double cc = r < NB ? cv[r * D + k] : cctx[k]; s += cc / (1.0 + exp(-cc)) * (double)w_ada[((size_t)l * D + k) * 6 * D + n]; }
        const double m = MOD[it]; d2 += (m - s) * (m - s); r2 += s * s; }
    atomicAdd(acc, d2); atomicAdd(acc + 1, r2);
}
__global__ void st_inproj_check(const unsigned char* ws, const float* w_in_e, double* acc) {
    const bf16_t* H = (const bf16_t*)(ws + OFF_HY); const bf16_t* P = (const bf16_t*)(ws + OFF_P); double d2 = 0.0, r2 = 0.0;
    for (long it = (long)blockIdx.x * blockDim.x + threadIdx.x; it < 72L * NE; it += (long)gridDim.x * blockDim.x) { const int col = (int)(it % NE), row = (int)(it / NE) * 256 + 37;
        float s = 0.f; for (int k = 0; k < D; ++k) s += bf2f(H[(size_t)row * D + k]) * bf2f(f2bf(w_in_e[(size_t)k * E_IN + col]));
        size_t off; int pitch, c0; const int pn = col / 256;
        if (pn < 2) { off = PE_QA; pitch = 512; c0 = 256 * pn; } else if (pn < 4) { off = PE_KA; pitch = 512; c0 = 256 * (pn - 2); } else if (pn < 6) { off = PE_VA; pitch = 512; c0 = 256 * (pn - 4); }
        else if (pn == 6) { off = PE_BQ; pitch = 256; c0 = 0; } else if (pn == 7) { off = PE_BK; pitch = 256; c0 = 0; } else if (pn < 10) { off = PE_BV; pitch = 512; c0 = 256 * (pn - 8); } else { off = PE_BO; pitch = 512; c0 = 256 * (pn - 10); }
        const float v = bf2f(P[off + (size_t)row * pitch + c0 + (col & 255)]); d2 += (double)(v - s) * (v - s); r2 += (double)s * s; }
    atomicAdd(acc, d2); atomicAdd(acc + 1, r2);
}
__global__ void st_norm_check(const unsigned char* ws, const float* g_mix, const float* w_in_e, const float* xin, const float* ctxin, double* acc) {
    const bf16_t* H = (const bf16_t*)(ws + OFF_HY); const float* G = (const float*)(ws + OFF_G); const float* MOD = (const float*)(ws + OFF_MOD); double d2 = 0.0, r2 = 0.0, dg = 0.0, rg = 0.0;
    for (int it = blockIdx.x * blockDim.x + threadIdx.x; it < 72; it += gridDim.x * blockDim.x) { const int row = it * 256 + 37; const int mr = row < ML ? row / SEQ : NB;
        const float* x = row < ML ? xin + (size_t)row * D : ctxin + (size_t)(row - ML) * D; double ss = 0.0; for (int k = 0; k < D; ++k) ss += (double)x[k] * x[k];
        const double rstd = 1.0 / sqrt(ss / D + 1e-6); double ga[16]; for (int n = 0; n < 16; ++n) ga[n] = 0.0;
        for (int k = 0; k < D; ++k) { const double h = x[k] * rstd * g_mix[k] * (1.0 + MOD[(size_t)mr * 6 * D + D + k]) + MOD[(size_t)mr * 6 * D + k]; const double v = bf2f(H[(size_t)row * D + k]); d2 += (v - h) * (v - h); r2 += h * h;
            for (int n = 0; n < 16; ++n) ga[n] += h * w_in_e[(size_t)k * E_IN + NE + n]; }
        for (int n = 0; n < 16; ++n) { const double v = G[(size_t)row * 16 + n]; dg += (v - ga[n]) * (v - ga[n]); rg += ga[n] * ga[n]; } }
    atomicAdd(acc + 2, d2); atomicAdd(acc + 3, r2); atomicAdd(acc + 4, dg); atomicAdd(acc + 5, rg);
}
__global__ void st_eps3_fill(const double* acc, float* out, int n) {
    double e = 0.0; for (int i = 0; i < 3; ++i) e = fmax(e, sqrt(acc[2 * i] / (acc[2 * i + 1] + 1e-300))); e += 1e-30; const float v = sqrtf((float)fmax(0.0, -10.0 * log10(e)));
    for (size_t k = (size_t)blockIdx.x * blockDim.x + threadIdx.x; k < (size_t)n; k += (size_t)gridDim.x * blockDim.x) out[k] = v; }
__global__ void st_tail_check(const unsigned char* ws, const float* xin, const float* ctxin, const float* w_out, const float* g_ffn, const float* wg, const float* wu, const float* wd, double* acc) {
    __shared__ float xm[D]; __shared__ float h2[D]; __shared__ float act[FF]; __shared__ float red[256];
    const bf16_t* Y = (const bf16_t*)(ws + OFF_HY); const float* X = (const float*)(ws + OFF_X); const float* MOD = (const float*)(ws + OFF_MOD);
    const int row = blockIdx.x * 256 + 37, tid = threadIdx.x; const int mr = row < ML ? row / SEQ : NB; const float* md = MOD + (size_t)mr * 6 * D;
    const float* x0 = row < ML ? xin + (size_t)row * D : ctxin + (size_t)(row - ML) * D;
    for (int n = tid; n < D; n += 256) { float s = 0.f; for (int k = 0; k < 1024; ++k) s += bf2f(Y[(size_t)row * 1024 + k]) * w_out[(size_t)k * D + n]; xm[n] = x0[n] + md[2 * D + n] * s; }
    __syncthreads();
    float ss = 0.f; for (int n = tid; n < D; n += 256) ss += xm[n] * xm[n]; red[tid] = ss; __syncthreads();
    for (int o = 128; o > 0; o >>= 1) { if (tid < o) red[tid] += red[tid + o]; __syncthreads(); }
    const float rstd = 1.0f / sqrtf(red[0] / D + 1e-6f); __syncthreads();
    for (int n = tid; n < D; n += 256) h2[n] = xm[n] * rstd * g_ffn[n] * (1.0f + md[4 * D + n]) + md[3 * D + n];
    __syncthreads();
    for (int f = tid; f < FF; f += 256) { float a = 0.f, b = 0.f; for (int k = 0; k < D; ++k) { a += h2[k] * wg[(size_t)k * FF + f]; b += h2[k] * wu[(size_t)k * FF + f]; } act[f] = a / (1.0f + expf(-a)) * b; }
    __syncthreads();
    double d2 = 0.0, r2 = 0.0;
    for (int n = tid; n < D; n += 256) { float s = 0.f; for (int f = 0; f < FF; ++f) s += act[f] * wd[(size_t)f * D + n]; const float ref = xm[n] + md[5 * D + n] * s, v = X[(size_t)row * D + n]; d2 += (double)(v - ref) * (v - ref); r2 += (double)(ref - x0[n]) * (ref - x0[n]); }
    atomicAdd(acc, d2); atomicAdd(acc + 1, r2);
}
__global__ void st_ml_ref(const unsigned char* ws, const float* bias, float* href) {
    __shared__ float qs[64], ks[64], red[4][128], dred[4];
    const bf16_t* BQ = (const bf16_t*)(ws + OFF_P) + PE_BQ; const bf16_t* BK = (const bf16_t*)(ws + OFF_P) + PE_BK; const bf16_t* BV = (const bf16_t*)(ws + OFF_P) + PE_BV; const float* G = (const float*)(ws + OFF_G);
    const int chain = blockIdx.x, dir = chain & 1, h = (chain >> 1) & 3, b = chain >> 3, tid = threadIdx.x, dv = tid & 127, kg = tid >> 7;
    float C[16], nn[16]; for (int j = 0; j < 16; ++j) { C[j] = 0.f; nn[j] = 0.f; } float m = 0.f;
    for (int p = 0; p < LK; ++p) { int row; if (p < CTX) row = ML + b * CTX + (dir ? CTX - 1 - p : p); else row = b * SEQ + (dir ? SEQ - 1 - (p - CTX) : p - CTX);
        if (tid < 64) { qs[tid] = bf2f(BQ[(size_t)row * 256 + h * 64 + tid]); ks[tid] = bf2f(BK[(size_t)row * 256 + h * 64 + tid]) * 0.125f; }
        const float v = bf2f(BV[(size_t)row * 512 + h * 128 + dv]);
        const float ipre = G[(size_t)row * 16 + dir * 8 + h] + bias[dir * 8 + h], fpre = G[(size_t)row * 16 + dir * 8 + 4 + h] + bias[dir * 8 + 4 + h];
        const float lf = fminf(fpre, 0.f) - log1pf(expf(-fabsf(fpre)));
        __syncthreads();
        const float mn = fmaxf(lf + m, ipre), fs = expf(lf + m - mn), is = expf(ipre - mn); m = mn;
        float pn = 0.f, pd = 0.f;
        for (int j = 0; j < 16; ++j) { const int dk = 16 * kg + j; C[j] = fs * C[j] + is * ks[dk] * v; nn[j] = fs * nn[j] + is * ks[dk]; pn += qs[dk] * C[j]; pd += qs[dk] * nn[j]; }
        red[kg][dv] = pn; if (dv == 0) dred[kg] = pd;
        __syncthreads();
        if (kg == 0) { const float num = (red[0][dv] + red[1][dv]) + (red[2][dv] + red[3][dv]), den = (dred[0] + dred[1]) + (dred[2] + dred[3]);
            href[((size_t)dir * MT + row) * 512 + h * 128 + dv] = num / fmaxf(fabsf(den), expf(-m)); }
        __syncthreads(); }
}
__global__ void st_ml_cmp(const unsigned char* ws, const float* href, const float* gn, double* acc) {
    const bf16_t* BO = (const bf16_t*)(ws + OFF_P) + PE_BO; const bf16_t* Y = (const bf16_t*)(ws + OFF_HY); const int lane = threadIdx.x & 63;
    for (int it = (blockIdx.x * blockDim.x + threadIdx.x) >> 6; it < MT * 4; it += (gridDim.x * blockDim.x) >> 6) { const int row = it >> 2, h = it & 3; float v[2], ss = 0.f;
        for (int e = 0; e < 2; ++e) { const size_t o = (size_t)row * 512 + h * 128 + lane + 64 * e; v[e] = href[o] + href[(size_t)MT * 512 + o]; ss += v[e] * v[e]; }
        for (int o = 1; o < 64; o <<= 1) ss += __shfl_xor(ss, o);
        const float rstd = 1.0f / sqrtf(ss / 128.0f + 1e-6f); double d2 = 0.0, r2 = 0.0;
        for (int e = 0; e < 2; ++e) { const int dv = lane + 64 * e; const float og = bf2f(BO[(size_t)row * 512 + h * 128 + dv]); const float ref = v[e] * rstd * gn[dv] / (1.0f + expf(-og)), y = bf2f(Y[(size_t)row * 1024 + 512 + h * 128 + dv]); d2 += (double)(y - ref) * (y - ref); r2 += (double)ref * ref; }
        for (int o = 1; o < 64; o <<= 1) { d2 += __shfl_xor(d2, o); r2 += __shfl_xor(r2, o); }
        if (lane == 0) { atomicAdd(acc, d2); atomicAdd(acc + 1, r2); } }
}
__global__ void st_dn_ref(const unsigned char* ws, const float* convw, const float* alog, const float* dtb, float* href) {
    __shared__ float qkv[3][128], red[4][128], nrm[2];
    const bf16_t* DQ = (const bf16_t*)(ws + OFF_P) + PO_DQKV; const float* G = (const float*)(ws + OFF_G);
    const int chain = blockIdx.x, dir = chain & 1, h = (chain >> 1) & 3, b = chain >> 3, tid = threadIdx.x, dv = tid & 127, kg = tid >> 7;
    float S[32]; for (int j = 0; j < 32; ++j) S[j] = 0.f;
    for (int p = 0; p < LK; ++p) { const bool isctx = p < CTX; const int seqlen = isctx ? CTX : SEQ, rowbase = isctx ? ML + b * CTX : b * SEQ; const int tok = isctx ? (dir ? CTX - 1 - p : p) : (dir ? SEQ - 1 - (p - CTX) : p - CTX); const int row = rowbase + tok;
        if (tid < 384) { const int ten = tid >> 7, d = tid & 127, col = ten * 512 + h * 128 + d; float a = 0.f;
            for (int tap = 0; tap < 3; ++tap) { const int tk = tok + tap - 1; if (tk >= 0 && tk < seqlen) a += bf2f(DQ[(size_t)(rowbase + tk) * 1536 + col]) * convw[tap * 1536 + col]; }
            qkv[ten][d] = a / (1.0f + expf(-a)); }
        __syncthreads();
        if (tid < 128) { float s = 0.f; const int ten = tid >> 6; for (int d = (tid & 63); d < 128; d += 64) s += qkv[ten][d] * qkv[ten][d]; for (int o = 1; o < 64; o <<= 1) s += __shfl_xor(s, o); if ((tid & 63) == 0) nrm[ten] = s; }
        __syncthreads();
        const float qn = (1.0f / sqrtf(nrm[0] + 1e-6f)) * 0.08838834764831845f, kn = 1.0f / sqrtf(nrm[1] + 1e-6f);
        const float beta = 1.0f / (1.0f + expf(-G[(size_t)row * 16 + dir * 8 + h])); const float xg = G[(size_t)row * 16 + dir * 8 + 4 + h] + dtb[dir * 4 + h];
        const float at = expf(-expf(alog[dir * 4 + h]) * (fmaxf(xg, 0.f) + log1pf(expf(-fabsf(xg)))));
        const float v = qkv[2][dv]; float pk = 0.f;
        for (int j = 0; j < 32; ++j) pk += qkv[1][32 * kg + j] * kn * S[j];
        red[kg][dv] = pk; __syncthreads();
        const float kS = (red[0][dv] + red[1][dv]) + (red[2][dv] + red[3][dv]); __syncthreads();
        float po = 0.f;
        for (int j = 0; j < 32; ++j) { const float kk = qkv[1][32 * kg + j] * kn; S[j] = at * (S[j] - beta * kk * kS) + beta * kk * v; po += qkv[0][32 * kg + j] * qn * S[j]; }
        red[kg][dv] = po; __syncthreads();
        if (kg == 0 && !isctx) href[((size_t)dir * ML + row) * 512 + h * 128 + dv] = (red[0][dv] + red[1][dv]) + (red[2][dv] + red[3][dv]);
        __syncthreads(); }
}
__global__ void st_dn_cmp(const unsigned char* ws, const float* href, const float* gn, double* acc) {
    const bf16_t* Z = (const bf16_t*)(ws + OFF_P) + PO_Z; const bf16_t* Y = (const bf16_t*)(ws + OFF_HY); const int lane = threadIdx.x & 63;
    for (int it = (blockIdx.x * blockDim.x + threadIdx.x) >> 6; it < ML * 4; it += (gridDim.x * blockDim.x) >> 6) { const int row = it >> 2, h = it & 3; float v[2], ss = 0.f;
        for (int e = 0; e < 2; ++e) { const size_t o = (size_t)row * 512 + h * 128 + lane + 64 * e; v[e] = href[o] + href[(size_t)ML * 512 + o]; ss += v[e] * v[e]; }
        for (int o = 1; o < 64; o <<= 1) ss += __shfl_xor(ss, o);
        const float rstd = 1.0f / sqrtf(ss / 128.0f + 1e-6f); double d2 = 0.0, r2 = 0.0;
        for (int e = 0; e < 2; ++e) { const int dv = lane + 64 * e; const float z = bf2f(Z[(size_t)row * 512 + h * 128 + dv]); const float ref = v[e] * rstd * gn[dv] * (z / (1.0f + expf(-z))), y = bf2f(Y[(size_t)row * 1024 + 512 + h * 128 + dv]); d2 += (double)(y - ref) * (y - ref); r2 += (double)ref * ref; }
        for (int o = 1; o < 64; o <<= 1) { d2 += __shfl_xor(d2, o); r2 += __shfl_xor(r2, o); }
        if (lane == 0) { atomicAdd(acc, d2); atomicAdd(acc + 1, r2); } }
}
__global__ void st_truth_fill(const unsigned char* ws, float* out, int n) {
    const double T[9] = {846.38902932657311,-3988.0872614528216,-4023.4252461296091,7499.0995520059896,-6191.4193272974135,-6282.081387437358,8748.2446258433793,548.97920503418845,21616550.564093322};
    const double* g = (const double*)(ws + ST_CHK) + ((size_t)35 * 4) * 10; double d2 = 0.0; for (int k = 0; k < 8; ++k) d2 += (g[k] - T[k]) * (g[k] - T[k]);
    const double eps = sqrt(d2 / (8.0 * T[8])) + 1e-30; const float v = sqrtf((float)fmax(0.0, -10.0 * log10(eps)));
    for (size_t k = (size_t)blockIdx.x * blockDim.x + threadIdx.x; k < (size_t)n; k += (size_t)gridDim.x * blockDim.x) out[k] = v; }
__global__ void st_gqa_check(const unsigned char* ws, const bf16_t* QS, const float* qkg, double* acc, float* scr) {
    const int lane = threadIdx.x & 63, gw = (blockIdx.x * blockDim.x + threadIdx.x) >> 6, ngw = (gridDim.x * blockDim.x) >> 6, wv = threadIdx.x >> 6;
    const bf16_t* KVC = (const bf16_t*)(ws + OFF_P) + PO_KVC; const bf16_t* O = (const bf16_t*)(ws + OFF_P) + PO_QC;
    const float* COS = (const float*)(ws + OFF_ROPE); const float* SIN = COS + (size_t)SEQ * 32;
    float* s1 = scr + (size_t)gw * LK; __shared__ float qs[8][64];
    for (int it = gw; it < (ML / 16) * 8; it += ngw) { const int h = it & 7, kv = h >> 2, row = (it >> 3) * 16 + 5; const int b = row / SEQ, t = row % SEQ;
        {   const int d = lane, a = d >> 5, pp = (d >> 4) & 1, f = d & 15; float x = bf2f(QS[(size_t)row * 512 + h * 64 + d]); float ss = x * x; for (int o = 1; o < 64; o <<= 1) ss += __shfl_xor(ss, o);
            x = x * (1.0f / sqrtf(ss / 64.0f + 1e-6f)) * qkg[d]; const float xp = __shfl_xor(x, 16); const float cs = COS[(size_t)t * 32 + a * 16 + f], sn = SIN[(size_t)t * 32 + a * 16 + f]; qs[wv][d] = pp == 0 ? x * cs - xp * sn : x * cs + xp * sn; }
        __syncthreads();
        float m1 = -1e30f;
        for (int j = lane; j < LK; j += 64) { const int kr = pos_row(b, j); const bool rope = j >= CTX; const int kt = j - CTX; float ss = 0.f; const bf16_t* kp = KVC + (size_t)kr * 256 + kv * 64;
            for (int d = 0; d < 64; ++d) { const float kd = bf2f(kp[d]); ss += kd * kd; }
            const float rs = 1.0f / sqrtf(ss / 64.0f + 1e-6f); float a1 = 0.f;
            for (int d = 0; d < 64; ++d) { const int a = d >> 5, pp = (d >> 4) & 1, f = d & 15; float k1 = bf2f(kp[d]) * rs * qkg[64 + d];
                if (rope) { const float k1p = bf2f(kp[d ^ 16]) * rs * qkg[64 + (d ^ 16)]; const float cs = COS[(size_t)kt * 32 + a * 16 + f], sn = SIN[(size_t)kt * 32 + a * 16 + f]; k1 = pp == 0 ? k1 * cs - k1p * sn : k1 * cs + k1p * sn; }
                a1 += qs[wv][d] * k1; }
            a1 *= 0.125f; s1[j] = a1; m1 = fmaxf(m1, a1); }
        for (int o = 1; o < 64; o <<= 1) m1 = fmaxf(m1, __shfl_xor(m1, o));
        float l1 = 0.f;
        for (int j = lane; j < LK; j += 64) { const float p1 = expf(s1[j] - m1); s1[j] = p1; l1 += p1; }
        for (int o = 1; o < 64; o <<= 1) l1 += __shfl_xor(l1, o);
        __threadfence(); __syncthreads();
        float o0 = 0.f;
        for (int j = 0; j < LK; ++j) { const int kr = pos_row(b, j); o0 += s1[j] * bf2f(KVC[(size_t)kr * 256 + 128 + kv * 64 + lane]); }
        const float ref = o0 / l1, y = bf2f(O[(size_t)row * 512 + h * 64 + lane]);
        double d2 = (double)(y - ref) * (y - ref), r2 = (double)ref * ref;
        for (int o = 1; o < 64; o <<= 1) { d2 += __shfl_xor(d2, o); r2 += __shfl_xor(r2, o); }
        if (lane == 0) { atomicAdd(acc, d2); atomicAdd(acc + 1, r2); }
        __syncthreads(); }
}
__global__ void st_eps_fill(const double* acc, float* out, int n) { const double eps = sqrt(acc[0] / (acc[1] + 1e-300)) + 1e-30; const float v = sqrtf((float)fmax(0.0, -10.0 * log10(eps)));
    for (size_t k = (size_t)blockIdx.x * blockDim.x + threadIdx.x; k < (size_t)n; k += (size_t)gridDim.x * blockDim.x) out[k] = v; }
#endif
extern "C" void kernel_launch(void* const* d_in, const int* in_sizes, int n_in, void* d_out, int out_size, void* d_ws, size_t ws_size, hipStream_t stream) {
    static int grid = 0;
    if (grid == 0) {
        int dev = 0, cus = 0, per_cu = 0;
        if (hipGetDevice(&dev) != hipSuccess || hipDeviceGetAttribute(&cus, hipDeviceAttributeMultiprocessorCount, dev) != hipSuccess) { fprintf(stderr, "kernel_launch: device query failed\n"); grid = -1; return; }
        if (hipFuncSetAttribute((const void*)mega, hipFuncAttributeMaxDynamicSharedMemorySize, LDS_BYTES) != hipSuccess) { fprintf(stderr, "kernel_launch: hipFuncSetAttribute failed\n"); grid = -1; return; }
        if (hipOccupancyMaxActiveBlocksPerMultiprocessor(&per_cu, (const void*)mega, NTHREADS, LDS_BYTES) != hipSuccess || per_cu < 1) { fprintf(stderr, "kernel_launch: occupancy query says %d\n", per_cu); per_cu = 1; }
        (void)hipGetLastError();
        if (ws_size < WS_NEED || n_in != 25) { fprintf(stderr, "kernel_launch: workspace %zu < %zu needed or n_in %d != 25\n", ws_size, (size_t)WS_NEED, n_in); grid = -1; return; }
        grid = cus;
    }
    if (grid < 0) return;
    (void)hipMemsetAsync(d_ws, 0, ZERO_BYTES, stream);
    Args a{};
#if defined(SELFTEST) && (defined(ST_REPEAT) || defined(ST_TWICE) || defined(ST_FINAL) || defined(ST_DACHECK) || defined(ST_MODCHECK) || defined(ST_L0CHECK) || defined(ST_TAILCHECK) || defined(ST_MLCHECK) || defined(ST_DNCHECK) || defined(ST_GQCHECK))
    for (int i = 0; i < 25; ++i) a.in[i] = (const float*)d_in[i];
    a.out = (float*)d_out; a.ws = (unsigned char*)d_ws; float* sout = (float*)d_out;
#elif defined(SELFTEST) && defined(ST_SAME_BATCH)
    for (int i = 0; i < 25; ++i) a.in[i] = (const float*)d_in[i];
    float* ctxs = (float*)((unsigned char*)d_ws + al256(WS_NEED)); float* cs = ctxs + (size_t)NB * CTX * D; float* sout = (float*)d_out;
    hipLaunchKernelGGL(st_same_batch_inputs, dim3(1024), dim3(256), 0, stream, (const float*)d_in[0], (const float*)d_in[1], (const float*)d_in[2], (float*)d_out, cs, ctxs);
    a.in[0] = (const float*)d_out; a.in[1] = cs; a.in[2] = ctxs; a.out = (float*)d_out; a.ws = (unsigned char*)d_ws;
#elif defined(SELFTEST) && defined(ST_INPLACE)
    { StPtrs P; for (int i = 0; i < 25; ++i) { P.p[i] = (float*)d_in[i]; a.in[i] = (const float*)d_in[i]; }
      hipLaunchKernelGGL(st_gen_inplace, dim3(1024), dim3(256), 0, stream, P); }
    float* sout = (float*)d_out; a.out = sout; a.ws = (unsigned char*)d_ws;
#elif defined(SELFTEST)
    float* syn = (float*)((unsigned char*)d_ws + al256(WS_NEED)); float* sout = syn + st_offset(25);
    hipLaunchKernelGGL(st_gen, dim3(1024), dim3(256), 0, stream, syn);
    for (int i = 0; i < 25; ++i) a.in[i] = syn + st_offset(i);
    a.out = sout; a.ws = (unsigned char*)d_ws;
#else
    for (int i = 0; i < 25; ++i) a.in[i] = (const float*)d_in[i];
    a.out = (float*)d_out; a.ws = (unsigned char*)d_ws;
#endif
#ifdef SELFTEST
#ifdef ST_GQCHECK
    {   a.step_lo = 0; a.step_hi = 9 + 3; a.prologue = 1; a.final_ = 0;
        void* args[] = {&a};
        hipError_t e = hipLaunchCooperativeKernel((const void*)mega, dim3(grid), dim3(NTHREADS), args, LDS_BYTES, stream);
        if (e != hipSuccess) fprintf(stderr, "cooperative launch failed: %s (grid %d)\n", hipGetErrorString(e), grid);
        (void)hipMemcpyAsync(d_out, (unsigned char*)d_ws + OFF_P + PO_QC * 2, (size_t)MT * 512 * 2, hipMemcpyDeviceToDevice, stream);
        a.step_lo = 12; a.step_hi = 13; a.prologue = 0;
        (void)hipMemsetAsync(d_ws, 0, 512 * 1024, stream);
        e = hipLaunchCooperativeKernel((const void*)mega, dim3(grid), dim3(NTHREADS), args, LDS_BYTES, stream);
        double* acc = (double*)((unsigned char*)d_ws + ST_CHK); float* scr = (float*)((unsigned char*)d_ws + SO_U);
        hipLaunchKernelGGL(st_gqa_check, dim3(256), dim3(512), 0, stream, (const unsigned char*)d_ws, (const bf16_t*)d_out, (const float*)d_in[15], acc, scr);
        hipLaunchKernelGGL(st_eps_fill, dim3(1024), dim3(256), 0, stream, (const double*)acc, (float*)d_out, out_size); }
#elif defined(ST_DNCHECK)
#ifndef ST_LAYER
#define ST_LAYER 1
#endif
    {   a.step_lo = 0; a.step_hi = 9 * ST_LAYER + 3; a.prologue = 1; a.final_ = 0;
        void* args[] = {&a};
        hipError_t e = hipLaunchCooperativeKernel((const void*)mega, dim3(grid), dim3(NTHREADS), args, LDS_BYTES, stream);
        if (e != hipSuccess) fprintf(stderr, "cooperative launch failed: %s (grid %d)\n", hipGetErrorString(e), grid);
        float* href = (float*)d_out; double* acc = (double*)((unsigned char*)d_ws + ST_CHK);
        hipLaunchKernelGGL(st_dn_ref, dim3(NCHAIN), dim3(512), 0, stream, (const unsigned char*)d_ws, (const float*)d_in[16] + (ST_LAYER / 2) * 3 * 1536, (const float*)d_in[17] + (ST_LAYER / 2) * 8, (const float*)d_in[18] + (ST_LAYER / 2) * 8, href);
        a.step_lo = 9 * ST_LAYER + 3; a.step_hi = 9 * ST_LAYER + 5; a.prologue = 0;
        (void)hipMemsetAsync(d_ws, 0, 512 * 1024, stream);
        e = hipLaunchCooperativeKernel((const void*)mega, dim3(grid), dim3(NTHREADS), args, LDS_BYTES, stream);
        hipLaunchKernelGGL(st_dn_cmp, dim3(512), dim3(256), 0, stream, (const unsigned char*)d_ws, (const float*)href, (const float*)d_in[19] + (ST_LAYER / 2) * 128, acc);
        hipLaunchKernelGGL(st_eps_fill, dim3(1024), dim3(256), 0, stream, (const double*)acc, (float*)d_out, out_size); }
#elif defined(ST_MLCHECK)
#ifndef ST_LAYER
#define ST_LAYER 0
#endif
    {   a.step_lo = 0; a.step_hi = 9 * ST_LAYER + 5; a.prologue = 1; a.final_ = 0;
        void* args[] = {&a};
        hipError_t e = hipLaunchCooperativeKernel((const void*)mega, dim3(grid), dim3(NTHREADS), args, LDS_BYTES, stream);
        if (e != hipSuccess) fprintf(stderr, "cooperative launch failed: %s (grid %d)\n", hipGetErrorString(e), grid);
        float* href = (float*)((unsigned char*)d_ws + SE_DCT); double* acc = (double*)((unsigned char*)d_ws + ST_CHK);
        hipLaunchKernelGGL(st_ml_ref, dim3(NCHAIN), dim3(512), 0, stream, (const unsigned char*)d_ws, (const float*)d_in[9] + (ST_LAYER / 2) * 16, href);
        hipLaunchKernelGGL(st_ml_cmp, dim3(512), dim3(256), 0, stream, (const unsigned char*)d_ws, (const float*)href, (const float*)d_in[12] + (ST_LAYER / 2) * 128, acc);
        hipLaunchKernelGGL(st_eps_fill, dim3(1024), dim3(256), 0, stream, (const double*)acc, (float*)d_out, out_size); }
#elif defined(ST_TAILCHECK)
    {   a.step_lo = 0; a.step_hi = 5; a.prologue = 1; a.final_ = 0;
        void* args[] = {&a};
        hipError_t e = hipLaunchCooperativeKernel((const void*)mega, dim3(grid), dim3(NTHREADS), args, LDS_BYTES, stream);
        if (e != hipSuccess) fprintf(stderr, "cooperative launch failed: %s (grid %d)\n", hipGetErrorString(e), grid);
        float* ysave = (float*)((unsigned char*)d_ws + SE_DCT);
        (void)hipMemcpyAsync(ysave, (unsigned char*)d_ws + OFF_HY, (size_t)MT * 1024 * 2, hipMemcpyDeviceToDevice, stream);
        a.step_lo = 5; a.step_hi = 9; a.prologue = 0;
        (void)hipMemsetAsync(d_ws, 0, 512 * 1024, stream);
        e = hipLaunchCooperativeKernel((const void*)mega, dim3(grid), dim3(NTHREADS), args, LDS_BYTES, stream);
        (void)hipMemcpyAsync((unsigned char*)d_ws + OFF_HY, ysave, (size_t)MT * 1024 * 2, hipMemcpyDeviceToDevice, stream);
        double* acc = (double*)((unsigned char*)d_ws + ST_CHK);
        hipLaunchKernelGGL(st_tail_check, dim3(72), dim3(256), 0, stream, (const unsigned char*)d_ws, (const float*)d_in[0], (const float*)d_in[2], (const float*)d_in[13], (const float*)d_in[7], (const float*)d_in[21], (const float*)d_in[22], (const float*)d_in[23], acc);
        hipLaunchKernelGGL(st_eps_fill, dim3(1024), dim3(256), 0, stream, (const double*)acc, (float*)d_out, out_size); }
#elif defined(ST_L0CHECK)
    {   a.step_lo = 0; a.step_hi = 2; a.prologue = 1; a.final_ = 0;
        void* args[] = {&a};
        hipError_t e = hipLaunchCooperativeKernel((const void*)mega, dim3(grid), dim3(NTHREADS), args, LDS_BYTES, stream);
        if (e != hipSuccess) fprintf(stderr, "cooperative launch failed: %s (grid %d)\n", hipGetErrorString(e), grid);
        double* acc = (double*)((unsigned char*)d_ws + ST_CHK);
        hipLaunchKernelGGL(st_inproj_check, dim3(512), dim3(256), 0, stream, (const unsigned char*)d_ws, (const float*)d_in[8], acc);
        hipLaunchKernelGGL(st_norm_check, dim3(1), dim3(128), 0, stream, (const unsigned char*)d_ws, (const float*)d_in[6], (const float*)d_in[8], (const float*)d_in[0], (const float*)d_in[2], acc);
        hipLaunchKernelGGL(st_eps3_fill, dim3(1024), dim3(256), 0, stream, (const double*)acc, (float*)d_out, out_size); }
#elif defined(ST_MODCHECK)
    {   a.step_lo = 0; a.step_hi = 0; a.prologue = 1; a.final_ = 0;
        void* args[] = {&a};
        hipError_t e = hipLaunchCooperativeKernel((const void*)mega, dim3(grid), dim3(NTHREADS), args, LDS_BYTES, stream);
        if (e != hipSuccess) fprintf(stderr, "cooperative launch failed: %s (grid %d)\n", hipGetErrorString(e), grid);
        double* acc = (double*)((unsigned char*)d_ws + ST_CHK);
        hipLaunchKernelGGL(st_mod_check, dim3(512), dim3(256), 0, stream, (const unsigned char*)d_ws, (const float*)d_in[1], (const float*)d_in[3], (const float*)d_in[4], (const float*)d_in[5], acc);
        hipLaunchKernelGGL(st_eps_fill, dim3(1024), dim3(256), 0, stream, (const double*)acc, (float*)d_out, out_size); }
#elif defined(ST_DACHECK)
    {   a.step_lo = 0; a.step_hi = 5; a.prologue = 1; a.final_ = 0;
        void* args[] = {&a};
        hipError_t e = hipLaunchCooperativeKernel((const void*)mega, dim3(grid), dim3(NTHREADS), args, LDS_BYTES, stream);
        if (e != hipSuccess) fprintf(stderr, "cooperative launch failed: %s (grid %d)\n", hipGetErrorString(e), grid);
        double* acc = (double*)((unsigned char*)d_ws + ST_CHK); float* scr = (float*)((unsigned char*)d_ws + SE_DCT);
        hipLaunchKernelGGL(st_da_check, dim3(256), dim3(512), 0, stream, (const unsigned char*)d_ws, (const float*)d_in[10], (const float*)d_in[11], acc, scr);
        hipLaunchKernelGGL(st_eps_fill, dim3(1024), dim3(256), 0, stream, (const double*)acc, (float*)d_out, out_size); }
#elif defined(ST_FINAL)
    {   a.step_lo = 0; a.step_hi = CFG_LAYERS * 9; a.prologue = 1; a.final_ = 1;
        void* args[] = {&a};
        hipError_t e = hipLaunchCooperativeKernel((const void*)mega, dim3(grid), dim3(NTHREADS), args, LDS_BYTES, stream);
        if (e != hipSuccess) fprintf(stderr, "cooperative launch failed: %s (grid %d)\n", hipGetErrorString(e), grid);
        double* acc = (double*)((unsigned char*)d_ws + ST_CHK);
        hipLaunchKernelGGL(st_final_check, dim3(64), dim3(256), 0, stream, (const unsigned char*)d_ws, (const float*)d_out, (const float*)d_in[24], acc);
        hipLaunchKernelGGL(st_final_fill, dim3(1024), dim3(256), 0, stream, (const double*)acc, (float*)d_out, out_size); }
#elif defined(ST_TWICE)
    for (int rep = 0; rep < 2; ++rep) {
        (void)hipMemsetAsync(d_ws, 0, 512 * 1024, stream); (void)hipMemsetAsync((unsigned char*)d_ws + OFF_MOD, 0, ZERO_BYTES - OFF_MOD, stream);
        a.step_lo = 0; a.step_hi = CFG_LAYERS * 9; a.prologue = 1; a.final_ = 0;
        void* args[] = {&a};
        hipError_t e = hipLaunchCooperativeKernel((const void*)mega, dim3(grid), dim3(NTHREADS), args, LDS_BYTES, stream);
        if (e != hipSuccess) fprintf(stderr, "cooperative launch failed: %s (grid %d)\n", hipGetErrorString(e), grid);
        hipLaunchKernelGGL(st_check_kernel, dim3(256), dim3(NTHREADS), 0, stream, (unsigned char*)d_ws, 35, rep * 40); }
    hipLaunchKernelGGL(st_twice_report, dim3(1024), dim3(256), 0, stream, (const unsigned char*)d_ws, (float*)d_out, out_size);
#elif defined(ST_REPEAT)
    for (int st = 0; st < CFG_LAYERS * 9; ++st) { const int ph = st % 9;
        for (int rep = 0; rep < ((ph == 3 || ph == 5 || ph == 8) ? 1 : 2); ++rep) {
            a.step_lo = st; a.step_hi = st + 1; a.prologue = (st == 0 && rep == 0); a.final_ = 0;
            void* args[] = {&a};
            hipError_t e = hipLaunchCooperativeKernel((const void*)mega, dim3(grid), dim3(NTHREADS), args, LDS_BYTES, stream);
            if (e != hipSuccess) fprintf(stderr, "cooperative launch failed: %s (grid %d)\n", hipGetErrorString(e), grid);
            hipLaunchKernelGGL(st_check_kernel, dim3(256), dim3(NTHREADS), 0, stream, (unsigned char*)d_ws, st, rep * 40); } }
    hipLaunchKernelGGL(st_repeat_report, dim3(1024), dim3(256), 0, stream, (const unsigned char*)d_ws, (float*)d_out, out_size, CFG_LAYERS * 9);
#elif defined(ST_SAME_BATCH)
    a.step_lo = 0; a.step_hi = CFG_LAYERS * 9; a.prologue = 1; a.final_ = 1;
    { void* args[] = {&a};
      hipError_t e = hipLaunchCooperativeKernel((const void*)mega, dim3(grid), dim3(NTHREADS), args, LDS_BYTES, stream);
      if (e != hipSuccess) fprintf(stderr, "cooperative launch failed: %s (grid %d)\n", hipGetErrorString(e), grid); }
    double* acc = (double*)((unsigned char*)d_ws + ST_CHK);
    hipLaunchKernelGGL(st_batch_report, dim3(256), dim3(256), 0, stream, (const float*)sout, (float*)d_out, out_size, acc);
    hipLaunchKernelGGL(st_fill, dim3(1024), dim3(256), 0, stream, (const double*)acc, (float*)d_out, out_size);
#else
#ifndef ST_CHUNK
#define ST_CHUNK 1
#endif
    for (int st = 0; st < CFG_LAYERS * 9; st += ST_CHUNK) {
        a.step_lo = st; a.step_hi = st + ST_CHUNK; a.prologue = st == 0; a.final_ = 0;
        void* args[] = {&a};
        hipError_t e = hipLaunchCooperativeKernel((const void*)mega, dim3(grid), dim3(NTHREADS), args, LDS_BYTES, stream);
        if (e != hipSuccess) fprintf(stderr, "cooperative launch failed: %s (grid %d)\n", hipGetErrorString(e), grid);
        hipLaunchKernelGGL(st_check_kernel, dim3(256), dim3(NTHREADS), 0, stream, (unsigned char*)d_ws, st + ST_CHUNK - 1);
    }
#ifdef ST_TRUTH
    hipLaunchKernelGGL(st_truth_fill, dim3(1024), dim3(256), 0, stream, (const unsigned char*)d_ws, (float*)d_out, out_size);
#else
    hipLaunchKernelGGL(st_report, dim3(1024), dim3(256), 0, stream, (const unsigned char*)d_ws, (float*)d_out, out_size);
#endif
#endif
#elif defined(MULTI_LAUNCH)
    for (int st = 0; st < CFG_LAYERS * 9; st += MULTI_LAUNCH) {
        a.step_lo = st; a.step_hi = st + MULTI_LAUNCH < CFG_LAYERS * 9 ? st + MULTI_LAUNCH : CFG_LAYERS * 9; a.prologue = st == 0; a.final_ = 0;
        void* args[] = {&a};
        hipError_t e = hipLaunchCooperativeKernel((const void*)mega, dim3(grid), dim3(NTHREADS), args, LDS_BYTES, stream);
        if (e != hipSuccess) fprintf(stderr, "cooperative launch failed: %s (grid %d)\n", hipGetErrorString(e), grid);
    }
    {   a.step_lo = a.step_hi = CFG_LAYERS * 9; a.prologue = 0; a.final_ = 1;
        void* args[] = {&a};
        hipError_t e = hipLaunchCooperativeKernel((const void*)mega, dim3(grid), dim3(NTHREADS), args, LDS_BYTES, stream);
        if (e != hipSuccess) fprintf(stderr, "cooperative launch failed: %s (grid %d)\n", hipGetErrorString(e), grid); }
#elif defined(PROBE_Y)
    {   a.step_lo = 0; a.step_hi = 9 * (PROBE_Y - 1) + 5; a.prologue = 1; a.final_ = 0;
        void* args[] = {&a};
        hipError_t e = hipLaunchCooperativeKernel((const void*)mega, dim3(grid), dim3(NTHREADS), args, LDS_BYTES, stream);
        if (e != hipSuccess) fprintf(stderr, "cooperative launch failed: %s (grid %d)\n", hipGetErrorString(e), grid);
        double* acc = (double*)((unsigned char*)d_ws + 512 * 1024);
        hipLaunchKernelGGL(pr_stat, dim3(512), dim3(256), 0, stream, (const bf16_t*)((unsigned char*)d_ws + OFF_HY), ML, PROBE_C0, PROBE_C1, acc);
        hipLaunchKernelGGL(pr_fill, dim3(1024), dim3(256), 0, stream, (const double*)acc, (float*)d_out, out_size); }
#else
    a.step_lo = 0; a.step_hi = CFG_LAYERS * 9; a.prologue = 1; a.final_ = 1;
    void* args[] = {&a};
    hipError_t e = hipLaunchCooperativeKernel((const void*)mega, dim3(grid), dim3(NTHREADS), args, LDS_BYTES, stream);
    if (e != hipSuccess) fprintf(stderr, "cooperative launch failed: %s (grid %d)\n", hipGetErrorString(e), grid);
#ifdef RUN_TWICE
    (void)hipMemsetAsync(d_ws, 0, ZERO_BYTES, stream);
    e = hipLaunchCooperativeKernel((const void*)mega, dim3(grid), dim3(NTHREADS), args, LDS_BYTES, stream);
#endif
#endif
}
#endif
```

```cpp
#ifndef EMU
#include <hip/hip_runtime.h>
#include <hip/hip_cooperative_groups.h>
#include <cstdio>
#include <cstdint>
#include <cmath>
#endif

#ifndef CFG_D
#define CFG_D 1024
#define CFG_B 8
#define CFG_SEQ 2048
#define CFG_CTX 256
#define CFG_FF 2816
#endif
#ifndef DIS
#define DIS 0ull
#endif
#define ON(bit) (!(((unsigned long long)(DIS) >> (bit)) & 1ull))
#ifndef REPM
#define REPM 0ull
#endif
#define REPB(bit) for (int rep_ = 0; rep_ <= (int)(((unsigned long long)(REPM) >> (bit)) & 1ull); ++rep_)
#ifndef CFG_LAYERS
#define CFG_LAYERS 4
#endif
constexpr int D = CFG_D, NB = CFG_B, SEQ = CFG_SEQ, CTX = CFG_CTX, FF = CFG_FF, DEPTH = 4, GRIDW = 64;
constexpr int ML = NB * SEQ, MC = NB * CTX, MT = ML + MC;
constexpr int LK = CTX + SEQ;
constexpr int NCC = CTX / 64, NLC = SEQ / 64, NCH = NCC + NLC;
constexpr int E_IN = 3088, O_IN = 2832, NE = 3072, NO = 2816;
constexpr int NCHAIN = NB * 4 * 2;
constexpr float EPS = 1e-6f;
constexpr int NTHREADS = 512, NWAVES = 8;
static_assert(SEQ % 256 == 0 && MC % 256 == 0 && D % 256 == 0 && FF % 256 == 0 && CTX % 64 == 0, "shape constraints");

typedef unsigned short bf16_t;
typedef short bf16x8 __attribute__((ext_vector_type(8)));
typedef short bf16x4 __attribute__((ext_vector_type(4)));
typedef float f32x4 __attribute__((ext_vector_type(4)));
typedef float f32x2 __attribute__((ext_vector_type(2)));
typedef float f32x16 __attribute__((ext_vector_type(16)));
typedef unsigned u32x4 __attribute__((ext_vector_type(4)));
typedef unsigned u32x2 __attribute__((ext_vector_type(2)));

#ifdef EMU
#define DEV static inline
#define DEVM inline
#define TIDX (EMU_TID)
#define BIDX (EMU_BID)
#define NBLK (EMU_NBLK)
#define BLOCK_SYNC() emu::block_sync()
#define WAVE_FENCE() emu::wave_sync()
#define SHFL_XOR(v, m) emu::shfl_xor((v), (m))
#define SHFL(v, s) emu::shfl((v), (s))
#define MFMA32(a, b, c) emu::mfma32((a), (b), (c))
#define EXP2F(x) exp2f(x)
#define ATOMIC_ADD_F(p, v) (*(p) += (v))
#define SCHED_FENCE() do {} while (0)
#define LOGF_NATIVE(x) logf(x)
#define WAVE_ANY(p) (wave_max((p) ? 1.0f : 0.0f) > 0.5f)
#else
namespace cg = cooperative_groups;
#define DEV __device__ __forceinline__
#define DEVM __device__ __forceinline__
#define TIDX ((int)threadIdx.x)
#define BIDX ((int)blockIdx.x)
#define NBLK ((int)gridDim.x)
#define BLOCK_SYNC() __syncthreads()
#define WAVE_FENCE() do { asm volatile("s_waitcnt lgkmcnt(0)" ::: "memory"); } while (0)
#define SHFL_XOR(v, m) __shfl_xor((v), (m))
#define SHFL(v, s) __shfl((v), (s))
#define MFMA32(a, b, c) __builtin_amdgcn_mfma_f32_32x32x16_bf16((a), (b), (c), 0, 0, 0)
#define EXP2F(x) __builtin_amdgcn_exp2f(x)
#define ATOMIC_ADD_F(p, v) atomicAdd((p), (v))
#define SCHED_FENCE() __builtin_amdgcn_sched_barrier(0)
#define LOGF_NATIVE(x) __logf(x)
#define WAVE_ANY(p) (__any(p) != 0)
#endif

DEV unsigned f2bf(float f) { unsigned u = __builtin_bit_cast(unsigned, f); return (u + 0x7fffu + ((u >> 16) & 1u)) >> 16; }
DEV float bf2f(unsigned h) { return __builtin_bit_cast(float, h << 16); }
#ifdef EMU
DEV unsigned pk2(float lo, float hi) { return f2bf(lo) | (f2bf(hi) << 16); }
#else
typedef __bf16 hw_bf16x2 __attribute__((ext_vector_type(2)));
DEV unsigned pk2(float lo, float hi) { const f32x2 v = {lo, hi}; return __builtin_bit_cast(unsigned, __builtin_convertvector(v, hw_bf16x2)); }
#endif
DEV int crow(int r, int h) { return (r & 3) + 8 * (r >> 2) + 4 * h; }
DEV float wave_sum(float v) {
#pragma unroll
    for (int o = 1; o < 64; o <<= 1) v += SHFL_XOR(v, o);
    return v;
}
DEV float wave_max(float v) {
#pragma unroll
    for (int o = 1; o < 64; o <<= 1) v = fmaxf(v, SHFL_XOR(v, o));
    return v;
}
DEV bf16x8 ld16(const void* p) { return *(const bf16x8*)p; }
DEV bf16x8 pack_acc(const f32x16& x, int s) {
    u32x4 p; p[0] = pk2(x[8 * s + 0], x[8 * s + 1]); p[1] = pk2(x[8 * s + 2], x[8 * s + 3]); p[2] = pk2(x[8 * s + 4], x[8 * s + 5]); p[3] = pk2(x[8 * s + 6], x[8 * s + 7]);
    return __builtin_bit_cast(bf16x8, p);
}
DEV bf16x8 cat44(bf16x4 lo, bf16x4 hi) { return __builtin_shufflevector(lo, hi, 0, 1, 2, 3, 4, 5, 6, 7); }
#ifndef EMU
DEV float fast_expf_(float x) { return __builtin_amdgcn_exp2f(x * 1.4426950408889634f); }
#define expf(x) fast_expf_(x)
#endif
#ifdef EMU
DEV float sigmoidf_(float x) { return 1.0f / (1.0f + expf(-x)); }
DEV float siluf_(float x) { return x / (1.0f + expf(-x)); }
#else
DEV float sigmoidf_(float x) { return __builtin_amdgcn_rcpf(1.0f + __builtin_amdgcn_exp2f(x * -1.4426950408889634f)); }
DEV float siluf_(float x) { return x * __builtin_amdgcn_rcpf(1.0f + __builtin_amdgcn_exp2f(x * -1.4426950408889634f)); }
#endif
DEV float log1pexp_(float nax) {
    const float e = expf(nax), u = 1.0f + e, d = u - 1.0f; return d == 0.0f ? e : LOGF_NATIVE(u) * (e / d); }
DEV float logsigmoidf_(float x) { return fminf(x, 0.0f) - log1pexp_(-fabsf(x)); }
DEV float softplusf_(float x) { return fmaxf(x, 0.0f) + log1pexp_(-fabsf(x)); }

constexpr size_t al256(size_t x) { return (x + 255) & ~(size_t)255; }
constexpr size_t cmax(size_t a, size_t b) { return a > b ? a : b; }
constexpr size_t OFF_CTL = 0;
constexpr size_t OFF_MOD = 1u << 20;
constexpr size_t SZ_MOD = al256((size_t)DEPTH * 9 * 6 * D * 4);
constexpr size_t ZERO_BYTES = OFF_MOD + SZ_MOD;
constexpr size_t OFF_ROPE = ZERO_BYTES;
constexpr size_t OFF_G = OFF_ROPE + al256((size_t)SEQ * 64 * 4);
constexpr size_t OFF_X = OFF_G + al256((size_t)MT * 16 * 4);
constexpr size_t OFF_WIN = OFF_X + al256((size_t)MT * D * 4);
constexpr size_t OFF_WOUT = OFF_WIN + al256((size_t)NE * D * 2);
constexpr size_t OFF_P = OFF_WOUT + al256((size_t)D * 1024 * 2);
constexpr size_t SZ_P = al256((size_t)MT * cmax(NE, FF) * 2);
constexpr size_t OFF_HY = OFF_P + SZ_P;
constexpr size_t OFF_S = OFF_HY + al256((size_t)MT * cmax(D, 1024) * 2);
constexpr size_t PE_QA = 0, PE_KA = (size_t)MT * 512, PE_VA = (size_t)MT * 1024, PE_BQ = (size_t)MT * 1536, PE_BK = (size_t)MT * 1792, PE_BV = (size_t)MT * 2048, PE_BO = (size_t)MT * 2560;
constexpr size_t PO_QC = 0, PO_KVC = (size_t)MT * 512, PO_DQKV = (size_t)MT * 768, PO_Z = (size_t)MT * 2304;
constexpr size_t SE_KP = OFF_S;
constexpr size_t SE_VT = SE_KP + al256((size_t)NB * 8 * LK * 64 * 2);
constexpr size_t SE_DCT = SE_VT + al256((size_t)NB * 4 * 128 * LK * 2);
constexpr size_t SE_DN = SE_DCT + al256((size_t)NCHAIN * NCH * 8192 * 4);
constexpr size_t SE_SC = SE_DN + al256((size_t)NCHAIN * NCH * 64 * 4);
constexpr size_t SE_PARK = SE_SC + al256((size_t)NCHAIN * NCH * 4 * 4);
constexpr size_t SE_END = SE_PARK + al256((size_t)256 * NTHREADS * 64 * 4);
constexpr size_t SF_WGU = OFF_S;
constexpr size_t SF_WDN = SF_WGU + al256((size_t)2 * FF * D * 2);
constexpr size_t SF_END = SF_WDN + al256((size_t)D * FF * 2);
constexpr size_t SF_PART = SF_END;
constexpr size_t SF_PART_END = SF_PART + (size_t)128 * 65536 * 4;
constexpr size_t WS_NEED_EF = cmax(SE_END, SF_PART_END);

constexpr int LDS_BYTES = 147456;
constexpr int LDS_MISC = 131072;

struct Args { const float* in[25]; float* out; unsigned char* ws; int step_lo, step_hi, prologue, final_; };

struct Ctx {
    int tid, lane, wave, bid, nblk, gw, ngw;
    char* lds;
    const float* const* in; float* out; unsigned char* ws;
};
#ifdef EMU
#define PHASE_CTX(pc) const Ctx& pc = c
#else
#define PHASE_CTX(pc) Ctx pc = c; { int t_ = threadIdx.x; asm volatile("" : "+v"(t_)); pc.tid = t_; pc.lane = t_ & 63; pc.wave = __builtin_amdgcn_readfirstlane(t_ >> 6); pc.gw = pc.bid * NWAVES + pc.wave; \
    __attribute__((address_space(1))) unsigned char* g_ = (__attribute__((address_space(1))) unsigned char*)c.ws; asm volatile("" : "+s"(g_)); pc.ws = (unsigned char*)g_; }
#endif

#ifdef EMU
struct XcdBarrier { int dummy; };
#define GRID_BARRIER() emu::grid_sync()
#else
#define LAS __attribute__((address_space(3)))
#define XB_TMO      128
#define XB_XCNT(j)  (256  + 64 * (j))
#define XB_XSUB(j)  (1280 + 64 * (j))
#define XB_XGEN(j)  (2304 + 64 * (j))
#define XB_TOP      3328
#define XB_TOPGEN   3392
#define XCD_BAR_WORDS 3456
#define XB_SPIN_CAP (1u << 24)
__device__ __forceinline__ unsigned xb_ld(unsigned* p)              { return __hip_atomic_load(p, __ATOMIC_RELAXED, __HIP_MEMORY_SCOPE_AGENT); }
__device__ __forceinline__ unsigned xb_add(unsigned* p, unsigned v) { return __hip_atomic_fetch_add(p, v, __ATOMIC_RELAXED, __HIP_MEMORY_SCOPE_AGENT); }
__device__ __forceinline__ unsigned xb_xcc_id() { return (unsigned)__builtin_amdgcn_s_getreg((3 << 11) | 20) & 0xFu; }
#define XB_SPIN(cond, bar) do { unsigned _sp = 0; while (cond) { __builtin_amdgcn_s_sleep(1); \
    if ((++_sp & 255u) == 0u) { if (xb_ld(&(bar)[XB_TMO])) break; if (_sp > XB_SPIN_CAP) { atomicAdd(&(bar)[XB_TMO], 1u); break; } } } } while (0)
struct XcdBarrier { unsigned* bar; unsigned x; volatile LAS unsigned* st; };
__device__ __forceinline__ XcdBarrier xcd_barrier_post(unsigned* bar, volatile LAS unsigned* st) {
    XcdBarrier b; b.bar = bar; b.x = xb_xcc_id(); b.st = st;
    if (threadIdx.x == 0) (void)xb_add(&bar[XB_XCNT(b.x)], 1u);
    return b;
}
__device__ __forceinline__ void xcd_barrier_complete(unsigned* bar, unsigned x, unsigned& nloc, unsigned& nx) {
    const unsigned G = gridDim.x * gridDim.y * gridDim.z;
    unsigned sum, cnt, mine, sp = 0u;
    for (;;) {
        sum = 0u; cnt = 0u; mine = 0u;
#pragma unroll
        for (unsigned j = 0; j < 16; ++j) { const unsigned c = xb_ld(&bar[XB_XCNT(j)]); sum += c; cnt += (c > 0u) ? 1u : 0u; mine = (j == x) ? c : mine; }
        if (sum == G) break;
        __builtin_amdgcn_s_sleep(1);
        if ((++sp & 255u) == 0u) { if (xb_ld(&bar[XB_TMO])) break; if (sp > XB_SPIN_CAP) { atomicAdd(&bar[XB_TMO], 1u); break; } }
    }
    nloc = mine > 0u ? mine : 1u; nx = cnt > 0u ? cnt : 1u;
}
__device__ __forceinline__ void xcd_barrier(const XcdBarrier& b) {
    const bool leader = threadIdx.x == 0;
    asm volatile("s_waitcnt vmcnt(0)" ::: "memory");
    __syncthreads();
    if (leader) {
        unsigned* bar = b.bar;
        __builtin_amdgcn_s_waitcnt(0);
        unsigned nloc = b.st[0], nx = b.st[1];
        if (nloc == 0u) { xcd_barrier_complete(bar, b.x, nloc, nx); b.st[0] = nloc; b.st[1] = nx; }
        const unsigned old = xb_add(&bar[XB_XSUB(b.x)], 1u);
        const unsigned gen = old / nloc;
        if (old + 1u == (gen + 1u) * nloc) {
            __builtin_amdgcn_fence(__ATOMIC_RELEASE, "agent");
            asm volatile("s_waitcnt vmcnt(0)" ::: "memory");
            const unsigned og = xb_add(&bar[XB_TOP], 1u);
            const unsigned tg = og / nx;
            if (og + 1u == (tg + 1u) * nx) xb_add(&bar[XB_TOPGEN], 1u);
            else XB_SPIN(xb_ld(&bar[XB_TOPGEN]) == tg, bar);
            __builtin_amdgcn_fence(__ATOMIC_ACQUIRE, "agent");
            xb_add(&bar[XB_XGEN(b.x)], 1u);
            asm volatile("s_waitcnt vmcnt(0)" ::: "memory");
        } else {
            XB_SPIN(xb_ld(&bar[XB_XGEN(b.x)]) == gen, bar);
            __builtin_amdgcn_fence(__ATOMIC_ACQUIRE, "agent");
            asm volatile("s_waitcnt vmcnt(0)" ::: "memory");
        }
    }
    __syncthreads();
}
#ifdef USE_CG_SYNC
#define GRID_BARRIER() cg::this_grid().sync()
#else
#define GRID_BARRIER() xcd_barrier(bar)
#endif
#endif

#ifndef EMU
namespace pg8 {
#define PG8_LAS __attribute__((address_space(3)))
typedef unsigned short bf16_t;
typedef short bf16x8 __attribute__((ext_vector_type(8)));
typedef float f32x4 __attribute__((ext_vector_type(4)));
typedef unsigned u32x4 __attribute__((ext_vector_type(4)));
constexpr int BM = 256, BK = 64, HALF = 128, HTB = HALF * BK * 2  , STAGE_BYTES = 8 * HTB, NXCD = 8, WGM = 8;

__host__ __device__ __forceinline__ int lds_byte(int r, int c) { const int st = (r >> 4) * 2 + (c >> 5), rr = r & 15, cc = c & 31, ob = rr * 64 + cc * 2; return st * 1024 + (ob ^ (((ob >> 9) & 1) << 5)); }
__host__ __device__ __forceinline__ void stage_rc(int b, int& R, int& C) { const int st = b / 1024, sb = b % 1024, swz = sb ^ (((sb >> 9) & 1) << 5); R = (st >> 1) * 16 + swz / 64; C = (st & 1) * 32 + (swz % 64) / 2; }
__host__ __device__ __forceinline__ int perm32(int rho) { const int n = rho >> 4, i = rho & 15; return 8 * (i >> 2) + 4 * n + (i & 3); }

struct Unit { int pm, pn; };
struct Gemm { const bf16_t* A; const bf16_t* Bt; int M, N, K, ld; };

struct StaticOrder {
    int nM, nN, nwg, G, c, wave, lim;
    int tn, tpm, tpn, tw;
    __host__ __device__ void init(int M, int N, int G_, int c_) { nM = M / BM; nN = N / BM; nwg = nM * nN; G = G_; c = c_; lim = 0x7fffffff; tn = 0; tpm = 0; tpn = 0; tw = 1; }
    __host__ __device__ bool next(int i, Unit& u) const {
        const long L = (long)i * G + c; if (L >= nwg + tn || L >= lim) return false;
        if (L >= nwg) { const int idx = (int)L - nwg; u.pm = tpm + idx / tw; u.pn = tpn + idx % tw; return true; }
        int wgid = (int)L; { const int q = nwg / NXCD, r = nwg % NXCD, xcd = wgid % NXCD, off = wgid / NXCD; wgid = (xcd < r ? xcd * (q + 1) : r * (q + 1) + (xcd - r) * q) + off; }
        const int nig = WGM * nN, gid = wgid / nig, fm = gid * WGM, gsz = (nM - fm) < WGM ? (nM - fm) : WGM;
        u.pm = fm + ((wgid % nig) % gsz); u.pn = (wgid % nig) / gsz; return true;
    }
    __device__ __forceinline__ void a_ready(const Unit&) const {}
    __device__ __forceinline__ void done(const Unit&) const {}
};
template <class Epi, class Sched, bool ALIGN_EPI = false, bool SP2 = false>
__device__ __forceinline__ void gemm_phase(PG8_LAS unsigned char* lds, const Gemm g, const Sched& S, const Epi& E) {
    int tid_ = threadIdx.x; asm volatile("" : "+v"(tid_));
    const int tid = tid_, wid = __builtin_amdgcn_readfirstlane(tid >> 6), lane = tid & 63, wr = wid >> 2, wc = wid & 3, fr = lane & 15, fq = lane >> 4;
    const int K = g.K, nt = K / BK, LD = g.ld ? g.ld : g.K;
    unsigned voffA[2], voffB[2];
#pragma unroll
    for (int i = 0; i < 2; ++i) { int R, C; stage_rc(tid * 16 + i * 8192, R, C); const int Rb = Epi::PERM ? ((R & ~31) + perm32(R & 31)) : R;
        voffA[i] = (unsigned)(R * LD + C) * 2u; voffB[i] = (unsigned)(Rb * LD + C) * 2u; }
    const size_t kstep = (size_t)(BK * 2);
    const size_t hstep = (size_t)HALF * LD * 2;
    const size_t tstep = 2 * hstep;
    const unsigned ldsw = (unsigned)wid * 1024u;
    const int aoff = lds_byte(wr * 64 + fr, fq * 8), boff = lds_byte(wc * 32 + fr, fq * 8);
#define PG8_SA(b, h) (((b) * 2 + (h)) * HTB)
#define PG8_SB(b, h) ((4 + (b) * 2 + (h)) * HTB)
#define PG8_STAGE(bufoff, gbase, voff) do { _Pragma("unroll") for (int _i = 0; _i < 2; ++_i) \
        __builtin_amdgcn_global_load_lds((const unsigned*)((const char*)(gbase) + (voff)[_i]), (PG8_LAS unsigned*)(lds + (bufoff) + ldsw + _i * 8192), 16, 0, 0); } while (0)
#define PG8_LDA(dst, b, h) do { _Pragma("unroll") for (int m = 0; m < 4; ++m) _Pragma("unroll") for (int k = 0; k < 2; ++k) dst[m][k] = *(const PG8_LAS bf16x8*)(lds + PG8_SA(b, h) + aoff + m * 2048 + k * 1024); } while (0)
#define PG8_LDB(dst, b, h) do { _Pragma("unroll") for (int n = 0; n < 2; ++n) _Pragma("unroll") for (int k = 0; k < 2; ++k) dst[n][k] = *(const PG8_LAS bf16x8*)(lds + PG8_SB(b, h) + boff + n * 2048 + k * 1024); } while (0)
#define PG8_MMA(ai, bj, At, Bt) do { __builtin_amdgcn_s_setprio(1); _Pragma("unroll") for (int m = 0; m < 4; ++m) _Pragma("unroll") for (int n = 0; n < 2; ++n) _Pragma("unroll") for (int k = 0; k < 2; ++k) \
        acc[ai][bj][m][n] = __builtin_amdgcn_mfma_f32_16x16x32_bf16(Bt[n][k], At[m][k], acc[ai][bj][m][n], 0, 0, 0); __builtin_amdgcn_s_setprio(0); } while (0)
#define PG8_WAIT_V(n) asm volatile("s_waitcnt vmcnt(" #n ")" ::: "memory")
#define PG8_WAIT_L(n) asm volatile("s_waitcnt lgkmcnt(" #n ")" ::: "memory")
#define PG8_BAR __builtin_amdgcn_s_barrier()
#define PG8_SCHED __builtin_amdgcn_sched_barrier(0)
    Unit cur, nxt; int ui = 0;
    if (!S.next(0, cur)) return;
    f32x4 acc[2][2][4][2];
#pragma unroll
    for (int a = 0; a < 2; ++a)
#pragma unroll
        for (int b = 0; b < 2; ++b)
#pragma unroll
            for (int m = 0; m < 4; ++m)
#pragma unroll
                for (int n = 0; n < 2; ++n) acc[a][b][m][n] = (f32x4){0.f, 0.f, 0.f, 0.f};
    bf16x8 At[4][2], B0[2][2], B1[2][2];
    const char* cA = (const char*)g.A + (size_t)cur.pm * tstep; const char* cB = (const char*)g.Bt + (size_t)cur.pn * tstep;
    S.a_ready(cur);
    if constexpr (SP2) {
        PG8_STAGE(PG8_SB(0, 0), cB, voffB); PG8_STAGE(PG8_SB(0, 1), cB + hstep, voffB); PG8_STAGE(PG8_SA(0, 0), cA, voffA); PG8_STAGE(PG8_SA(0, 1), cA + hstep, voffA);
        if (wr == 1) PG8_BAR;
        PG8_WAIT_V(2); PG8_BAR;
        PG8_STAGE(PG8_SB(1, 0), cB + kstep, voffB); PG8_STAGE(PG8_SA(1, 0), cA + kstep, voffA); PG8_STAGE(PG8_SB(1, 1), cB + hstep + kstep, voffB);
        PG8_WAIT_V(6); PG8_BAR;
    } else {
        PG8_STAGE(PG8_SB(0, 0), cB, voffB); PG8_STAGE(PG8_SA(0, 0), cA, voffA); PG8_STAGE(PG8_SB(0, 1), cB + hstep, voffB); PG8_STAGE(PG8_SA(0, 1), cA + hstep, voffA);
        if (wr == 1) PG8_BAR;
        PG8_WAIT_V(4); PG8_BAR;
        PG8_STAGE(PG8_SB(1, 0), cB + kstep, voffB); PG8_STAGE(PG8_SA(1, 0), cA + kstep, voffA); PG8_STAGE(PG8_SB(1, 1), cB + hstep + kstep, voffB);
        PG8_WAIT_V(6); PG8_BAR;
    }
    for (;;) {
        const bool has_next = S.next(ui + 1, nxt);
        const char* nA = has_next ? (const char*)g.A + (size_t)nxt.pm * tstep : cA; const char* nB = has_next ? (const char*)g.Bt + (size_t)nxt.pn * tstep : cB;
        for (int t = 0; t < nt; t += 2) {
            const bool last = (t == nt - 2);
            const char* a1 = cA + (size_t)(t + 1) * kstep;
            const char* a2 = last ? nA : cA + (size_t)(t + 2) * kstep; const char* b2 = last ? nB : cB + (size_t)(t + 2) * kstep;
            const char* a3 = a2 + kstep; const char* b3 = b2 + kstep;
            if (last && has_next) S.a_ready(nxt);
            if constexpr (SP2) {
            PG8_LDB(B0, 0, 0); PG8_LDB(B1, 0, 1); PG8_SCHED; PG8_LDA(At, 0, 0); PG8_STAGE(PG8_SA(1, 1), a1 + hstep, voffA);
            PG8_WAIT_V(8); PG8_WAIT_L(0); PG8_BAR; PG8_MMA(0, 0, At, B0); PG8_MMA(0, 1, At, B1); PG8_BAR; PG8_SCHED;
            PG8_LDA(At, 0, 1); PG8_STAGE(PG8_SB(0, 0), b2, voffB); PG8_STAGE(PG8_SB(0, 1), b2 + hstep, voffB); PG8_STAGE(PG8_SA(0, 0), a2, voffA);
            PG8_WAIT_V(8); PG8_WAIT_L(0); PG8_BAR; PG8_MMA(1, 0, At, B0); PG8_MMA(1, 1, At, B1); PG8_BAR; PG8_SCHED;
            PG8_LDB(B0, 1, 0); PG8_LDB(B1, 1, 1); PG8_SCHED; PG8_LDA(At, 1, 0); PG8_STAGE(PG8_SA(0, 1), a2 + hstep, voffA);
            PG8_WAIT_V(8); PG8_WAIT_L(0); PG8_BAR; PG8_MMA(0, 0, At, B0); PG8_MMA(0, 1, At, B1); PG8_BAR; PG8_SCHED;
            PG8_LDA(At, 1, 1); PG8_STAGE(PG8_SB(1, 0), b3, voffB); PG8_STAGE(PG8_SB(1, 1), b3 + hstep, voffB); PG8_STAGE(PG8_SA(1, 0), a3, voffA);
            PG8_WAIT_V(8); PG8_WAIT_L(0); PG8_BAR; PG8_MMA(1, 0, At, B0); PG8_MMA(1, 1, At, B1); PG8_BAR; PG8_SCHED;
            } else {
            PG8_LDB(B0, 0, 0); PG8_SCHED; PG8_LDA(At, 0, 0); PG8_STAGE(PG8_SA(1, 1), a1 + hstep, voffA);
            PG8_WAIT_L(8); PG8_BAR; PG8_WAIT_L(0); PG8_MMA(0, 0, At, B0); PG8_BAR; PG8_SCHED;
            PG8_LDB(B1, 0, 1); PG8_STAGE(PG8_SB(0, 0), b2, voffB);
            PG8_BAR; PG8_WAIT_L(0); PG8_MMA(0, 1, At, B1); PG8_BAR;
            PG8_LDA(At, 0, 1); PG8_STAGE(PG8_SA(0, 0), a2, voffA);
            PG8_BAR; PG8_WAIT_L(0); PG8_MMA(1, 0, At, B0); PG8_BAR; PG8_SCHED;
            PG8_STAGE(PG8_SB(0, 1), b2 + hstep, voffB);
            PG8_WAIT_V(6); PG8_BAR; PG8_MMA(1, 1, At, B1); PG8_BAR;
            PG8_LDB(B0, 1, 0); PG8_SCHED; PG8_LDA(At, 1, 0); PG8_STAGE(PG8_SA(0, 1), a2 + hstep, voffA);
            PG8_WAIT_L(8); PG8_BAR; PG8_WAIT_L(0); PG8_MMA(0, 0, At, B0); PG8_BAR; PG8_SCHED;
            PG8_LDB(B1, 1, 1); PG8_STAGE(PG8_SB(1, 0), b3, voffB);
            PG8_BAR; PG8_WAIT_L(0); PG8_MMA(0, 1, At, B1); PG8_BAR;
            PG8_LDA(At, 1, 1); PG8_STAGE(PG8_SA(1, 0), a3, voffA);
            PG8_BAR; PG8_WAIT_L(0); PG8_MMA(1, 0, At, B0); PG8_BAR; PG8_SCHED;
            PG8_STAGE(PG8_SB(1, 1), b3 + hstep, voffB);
            PG8_WAIT_V(6); PG8_BAR; PG8_MMA(1, 1, At, B1); PG8_BAR;
            }
        }
        if constexpr (ALIGN_EPI) { if (wr == 0) PG8_BAR; }
        if constexpr (!Epi::AFTER_DRAIN) { E(acc, cur, wr, wc, fr, fq); S.done(cur); }
        if (!has_next) break;
#pragma unroll
        for (int a = 0; a < 2; ++a)
#pragma unroll
            for (int b = 0; b < 2; ++b)
#pragma unroll
                for (int m = 0; m < 4; ++m)
#pragma unroll
                    for (int n = 0; n < 2; ++n) acc[a][b][m][n] = (f32x4){0.f, 0.f, 0.f, 0.f};
        cur = nxt; cA = nA; cB = nB; ++ui;
        if constexpr (ALIGN_EPI) { if (wr == 1) PG8_BAR; }
    }
    PG8_WAIT_V(0);
    if constexpr (!ALIGN_EPI) { if (wr == 0) PG8_BAR; }
    PG8_BAR;
    if constexpr (Epi::AFTER_DRAIN) { E.fused(acc, cur, wr, wc, fr, fq, lds, wid, lane); S.done(cur); }
#undef PG8_SA
#undef PG8_SB
#undef PG8_STAGE
#undef PG8_LDA
#undef PG8_LDB
#undef PG8_MMA
#undef PG8_WAIT_V
#undef PG8_WAIT_L
#undef PG8_BAR
#undef PG8_SCHED
}
}
#else
namespace pg8 {
typedef unsigned short bf16_t;
constexpr int BM = 256, BK = 64, HALF = 128, NXCD = 8, WGM = 8;
struct Unit { int pm, pn; };
struct Gemm { const bf16_t* A; const bf16_t* Bt; int M, N, K, ld; };
struct StaticOrder {
    int nM, nN, nwg, G, c, wave, lim, tn, tpm, tpn, tw;
    void init(int M, int N, int G_, int c_) { nM = M / BM; nN = N / BM; nwg = nM * nN; G = G_; c = c_; lim = 0x7fffffff; tn = 0; tpm = 0; tpn = 0; tw = 1; }
    bool next(int i, Unit& u) const {
        const long L = (long)i * G + c; if (L >= nwg + tn || L >= lim) return false;
        if (L >= nwg) { const int idx = (int)L - nwg; u.pm = tpm + idx / tw; u.pn = tpn + idx % tw; return true; }
        int wgid = (int)L; { const int q = nwg / NXCD, r = nwg % NXCD, xcd = wgid % NXCD, off = wgid / NXCD; wgid = (xcd < r ? xcd * (q + 1) : r * (q + 1) + (xcd - r) * q) + off; }
        const int nig = WGM * nN, gid = wgid / nig, fm = gid * WGM, gsz = (nM - fm) < WGM ? (nM - fm) : WGM;
        u.pm = fm + ((wgid % nig) % gsz); u.pn = (wgid % nig) / gsz; return true;
    }
};
template <class Epi, class Sched, bool ALIGN_EPI = false, bool SP2 = false>
static inline void gemm_phase(unsigned char* lds, const Gemm g, const Sched& S, const Epi& E) {
    const int tid = TIDX, wid = tid >> 6, lane = tid & 63, wr = wid >> 2, wc = wid & 3, fr = lane & 15, fq = lane >> 4;
    Unit u;
    for (int i = 0; S.next(i, u); ++i) {
        f32x4 acc[2][2][4][2];
        for (int ai = 0; ai < 2; ++ai) for (int bj = 0; bj < 2; ++bj) for (int m = 0; m < 4; ++m) for (int n = 0; n < 2; ++n) for (int j = 0; j < 4; ++j) {
            const int row = 256 * u.pm + 128 * ai + 64 * wr + 16 * m + fr;
            const int col = Epi::PERM ? 256 * u.pn + 128 * bj + 32 * wc + 8 * fq + 4 * n + j : 256 * u.pn + 128 * bj + 32 * wc + 16 * n + 4 * fq + j;
            const int ld = g.ld ? g.ld : g.K; const bf16_t* a = g.A + (size_t)row * ld; const bf16_t* b = g.Bt + (size_t)col * ld; float s = 0.f;
            for (int k = 0; k < g.K; ++k) s += bf2f(a[k]) * bf2f(b[k]);
            acc[ai][bj][m][n][j] = s; }
        E(acc, u, wr, wc, fr, fq);
    }
    BLOCK_SYNC();
}
}
#define PG8_LAS
#endif

#if !defined(EMU) && defined(SIMPLE_GEMM)
namespace sg {
template <class Epi, class Sched>
__device__ __forceinline__ void gemm_phase(const pg8::Gemm g, const Sched& S, const Epi& E) {
    int tid_ = threadIdx.x; asm volatile("" : "+v"(tid_));
    const int tid = tid_, wid = __builtin_amdgcn_readfirstlane(tid >> 6), lane = tid & 63, wr = wid >> 2, wc = wid & 3, fr = lane & 15, fq = lane >> 4;
    pg8::Unit u;
    for (int i = 0; S.next(i, u); ++i) {
        f32x4 acc[2][2][4][2];
#pragma unroll
        for (int ai = 0; ai < 2; ++ai)
#pragma unroll
            for (int bj = 0; bj < 2; ++bj)
#pragma unroll
                for (int m = 0; m < 4; ++m)
#pragma unroll
                    for (int n = 0; n < 2; ++n) acc[ai][bj][m][n] = (f32x4){0.f, 0.f, 0.f, 0.f};
        const bf16_t* wp0 = g.Bt + (size_t)(256 * u.pn + 32 * wc + (Epi::PERM ? 8 * (fr >> 2) + (fr & 3) : fr)) * g.K + 8 * fq;
        const bf16_t* xp0 = g.A + (size_t)(256 * u.pm + 64 * wr + fr) * g.K + 8 * fq;
#pragma unroll 1
        for (int k0 = 0; k0 < g.K; k0 += 32) {
            bf16x8 wf[2][2], xf[2][4];
#pragma unroll
            for (int bj = 0; bj < 2; ++bj)
#pragma unroll
                for (int n = 0; n < 2; ++n) wf[bj][n] = *(const bf16x8*)(wp0 + (size_t)(128 * bj + (Epi::PERM ? 4 : 16) * n) * g.K + k0);
#pragma unroll
            for (int ai = 0; ai < 2; ++ai)
#pragma unroll
                for (int m = 0; m < 4; ++m) xf[ai][m] = *(const bf16x8*)(xp0 + (size_t)(128 * ai + 16 * m) * g.K + k0);
#pragma unroll
            for (int ai = 0; ai < 2; ++ai)
#pragma unroll
                for (int bj = 0; bj < 2; ++bj)
#pragma unroll
                    for (int m = 0; m < 4; ++m)
#pragma unroll
                        for (int n = 0; n < 2; ++n) acc[ai][bj][m][n] = __builtin_amdgcn_mfma_f32_16x16x32_bf16(wf[bj][n], xf[ai][m], acc[ai][bj][m][n], 0, 0, 0);
        }
        E(acc, u, wr, wc, fr, fq);
    }
}
}
#define GEMM_PHASE(EpiT, lds, g, S, E) sg::gemm_phase<EpiT, pg8::StaticOrder>(g, S, E)
#else
#define GEMM_PHASE(EpiT, lds, g, S, E) pg8::gemm_phase<EpiT, pg8::StaticOrder, true, true>((PG8_LAS unsigned char*)(lds), g, S, E)
#endif

struct EpiSeg {
    static constexpr bool PERM = true, AFTER_DRAIN = false;
    bf16_t* P; int odd;
    DEVM void operator()(const f32x4 (&acc)[2][2][4][2], const pg8::Unit& u, int wr, int wc, int fr, int fq) const {
        size_t off; int pitch, c0;
        const int pn = u.pn;
        if (!odd) {
            if (pn < 2) { off = PE_QA; pitch = 512; c0 = 256 * pn; } else if (pn < 4) { off = PE_KA; pitch = 512; c0 = 256 * (pn - 2); } else if (pn < 6) { off = PE_VA; pitch = 512; c0 = 256 * (pn - 4); }
            else if (pn == 6) { off = PE_BQ; pitch = 256; c0 = 0; } else if (pn == 7) { off = PE_BK; pitch = 256; c0 = 0; } else if (pn < 10) { off = PE_BV; pitch = 512; c0 = 256 * (pn - 8); } else { off = PE_BO; pitch = 512; c0 = 256 * (pn - 10); }
        } else {
            if (pn < 2) { off = PO_QC; pitch = 512; c0 = 256 * pn; } else if (pn == 2) { off = PO_KVC; pitch = 256; c0 = 0; } else if (pn < 9) { off = PO_DQKV; pitch = 1536; c0 = 256 * (pn - 3); } else { off = PO_Z; pitch = 512; c0 = 256 * (pn - 9); }
        }
        bf16_t* base = P + off;
        const int row0 = u.pm * 256 + wr * 64 + fr, col0 = c0 + wc * 32 + 8 * fq;
#pragma unroll
        for (int ai = 0; ai < 2; ++ai)
#pragma unroll
            for (int m = 0; m < 4; ++m) { bf16_t* rowp = base + (size_t)(row0 + ai * 128 + m * 16) * pitch + col0;
#pragma unroll
                for (int bj = 0; bj < 2; ++bj) { const f32x4 v0 = acc[ai][bj][m][0], v1 = acc[ai][bj][m][1];
                    u32x4 w; w[0] = pk2(v0[0], v0[1]); w[1] = pk2(v0[2], v0[3]); w[2] = pk2(v1[0], v1[1]); w[3] = pk2(v1[2], v1[3]);
                    *(u32x4*)(rowp + bj * 128) = w; } }
    }
};
struct EpiResid {
    static constexpr bool PERM = false, AFTER_DRAIN = false;
    float* X; const float* mod; int gaoff;
    const float* XL; const float* XC;
    DEVM void operator()(const f32x4 (&acc)[2][2][4][2], const pg8::Unit& u, int wr, int wc, int fr, int fq) const {
        const int rowt = u.pm * 256; const int mr = rowt < ML ? rowt / SEQ : NB;
        const float* ga = mod + (size_t)mr * 6 * D + gaoff; const float* Xs = rowt < ML ? XL : XC;
        const int row0 = rowt + wr * 64 + fr, col0 = u.pn * 256 + wc * 32 + 4 * fq;
#pragma unroll
        for (int bj = 0; bj < 2; ++bj)
#pragma unroll
            for (int n = 0; n < 2; ++n) { const int c = col0 + bj * 128 + n * 16; const f32x4 g = *(const f32x4*)(ga + c);
#pragma unroll
                for (int ai = 0; ai < 2; ++ai)
#pragma unroll
                    for (int m = 0; m < 4; ++m) { const size_t off = (size_t)(row0 + ai * 128 + m * 16) * D + c; const f32x4 x = *(const f32x4*)(Xs + off); *(f32x4*)(X + off) = x + g * acc[ai][bj][m][n]; } }
    }
};
struct EpiPart {
    static constexpr bool PERM = false, AFTER_DRAIN = false;
    float* P;
    DEVM void operator()(const f32x4 (&acc)[2][2][4][2], const pg8::Unit& u, int wr, int wc, int fr, int fq) const {
        (void)u; const int r0 = wr * 64 + fr, c0 = wc * 32 + 4 * fq;
#pragma unroll
        for (int bj = 0; bj < 2; ++bj)
#pragma unroll
            for (int n = 0; n < 2; ++n)
#pragma unroll
                for (int ai = 0; ai < 2; ++ai)
#pragma unroll
                    for (int m = 0; m < 4; ++m) *(f32x4*)(P + (size_t)(r0 + ai * 128 + m * 16) * 256 + c0 + bj * 128 + n * 16) = acc[ai][bj][m][n];
    }
};
struct SplitPlan { int extra, split, nwg; };
DEV SplitPlan split_plan(int mrows, int kdim, int nblk, bool allow) {
    SplitPlan p; p.nwg = (mrows / 256) * (D / 256); p.extra = 0; p.split = 1;
    if (allow && p.nwg > nblk && p.nwg < 2 * nblk) { const int pairs = kdim / 128; int sp = 4; const int ex = p.nwg - nblk;
        while (sp > 1 && (ex * sp > nblk || sp > pairs || ex * sp > 128)) sp >>= 1;
        if (sp > 1) { p.extra = ex; p.split = sp; } }
    return p;
}

struct EpiSwiglu {
    static constexpr bool PERM = true, AFTER_DRAIN = false;
    bf16_t* ACT;
    DEVM void operator()(const f32x4 (&acc)[2][2][4][2], const pg8::Unit& u, int wr, int wc, int fr, int fq) const {
        const int row0 = u.pm * 256 + wr * 64 + fr, col0 = u.pn * 128 + wc * 32 + 8 * fq;
#pragma unroll
        for (int ai = 0; ai < 2; ++ai)
#pragma unroll
            for (int m = 0; m < 4; ++m) { bf16_t* rowp = ACT + (size_t)(row0 + ai * 128 + m * 16) * FF + col0;
                float v[8];
#pragma unroll
                for (int n = 0; n < 2; ++n)
#pragma unroll
                    for (int j = 0; j < 4; ++j) { const float g = acc[ai][0][m][n][j], up = acc[ai][1][m][n][j]; v[4 * n + j] = siluf_(g) * up; }
                u32x4 w; w[0] = pk2(v[0], v[1]); w[1] = pk2(v[2], v[3]); w[2] = pk2(v[4], v[5]); w[3] = pk2(v[6], v[7]);
                *(u32x4*)rowp = w; }
    }
};

DEV void p0_prologue(const Ctx& c) {
    const float* x = c.in[0]; const float* cv = c.in[1]; const float* ctx = c.in[2]; const float* cctx = c.in[3]; const float* w_ada = c.in[4]; const float* b_ada = c.in[5];
    float* MOD = (float*)(c.ws + OFF_MOD);
    const long gt = (long)c.bid * NTHREADS + c.tid, GT = (long)c.nblk * NTHREADS;
    {   constexpr int NCG = 6 * D / 128, KW = D / 8; f32x2* part = (f32x2*)c.lds;
        for (int it = c.bid; it < DEPTH * NCG; it += c.nblk) { const int l = it / NCG, cg = it % NCG; const int n2 = cg * 64 + c.lane;
            f32x2 acc[9];
#pragma unroll
            for (int r = 0; r < 9; ++r) acc[r] = (f32x2){0.f, 0.f};
            const float* W = w_ada + ((size_t)l * D + c.wave * KW) * 6 * D + 2 * n2;
#pragma unroll 8
            for (int k = 0; k < KW; ++k) { const f32x2 w = *(const f32x2*)(W + (size_t)k * 6 * D); const int kk = c.wave * KW + k;
#pragma unroll
                for (int r = 0; r < 9; ++r) { const float sv = siluf_(r < NB ? cv[r * D + kk] : cctx[kk]); acc[r] += w * sv; } }
#pragma unroll
            for (int r = 0; r < 9; ++r) part[(c.wave * 9 + r) * 64 + c.lane] = acc[r];
            BLOCK_SYNC();
            for (int o = c.tid; o < 9 * 64; o += NTHREADS) { const int r = o / 64, q = o % 64; f32x2 sum = *(const f32x2*)(b_ada + (size_t)l * 6 * D + 2 * (cg * 64 + q));
#pragma unroll
                for (int w = 0; w < 8; ++w) sum += part[(w * 9 + r) * 64 + q];
                *(f32x2*)(MOD + ((size_t)l * 9 + r) * 6 * D + 2 * (cg * 64 + q)) = sum; }
            BLOCK_SYNC(); } }
    float* COS = (float*)(c.ws + OFF_ROPE); float* SIN = COS + SEQ * 32;
    for (long it = gt; it < (long)SEQ * 32; it += GT) { const int t = (int)(it >> 5), i = (int)(it & 31);
        const float fr = expf(-(float)(i & 15) * (9.210340371976184f / 16.0f));     const float pos = (i < 16) ? (float)(t / GRIDW) : (float)(t % GRIDW); const float a = pos * fr;
        COS[it] = cosf(a); SIN[it] = sinf(a); }
    (void)x; (void)ctx;
}

DEV void transpose_item(const float* W, int srcpitch, int k0, int n0, bf16_t* WT, int Kp, int dstrow0, float* scr, int lane) {
#pragma unroll 8
    for (int i = 0; i < 32; ++i) { const int kk = 2 * i + (lane >> 5); scr[kk * 33 + (lane & 31)] = W[(size_t)(k0 + kk) * srcpitch + n0 + (lane & 31)]; }
    WAVE_FENCE();
    const int cc = lane & 7;
#pragma unroll
    for (int j = 0; j < 4; ++j) { const int n = (lane >> 3) + 8 * j; const float* s = scr + (8 * cc) * 33 + n;
        u32x4 o; o[0] = pk2(s[0 * 33], s[1 * 33]); o[1] = pk2(s[2 * 33], s[3 * 33]); o[2] = pk2(s[4 * 33], s[5 * 33]); o[3] = pk2(s[6 * 33], s[7 * 33]);
        *(u32x4*)(WT + (size_t)(dstrow0 + n) * Kp + k0 + 8 * cc) = o; }
    WAVE_FENCE();
}
DEV void convert_mixer_weights(const Ctx& c, int layer, int gw, int ngw) {
    float* scr = (float*)(c.lds + c.wave * 8448);
    const int odd = layer & 1, li = layer >> 1;
    const float* win = odd ? c.in[14] + (size_t)li * D * O_IN : c.in[8] + (size_t)li * D * E_IN; const int pin = odd ? O_IN : E_IN, nin = odd ? NO : NE;
    const float* wout = odd ? c.in[20] + (size_t)li * 1024 * D : c.in[13] + (size_t)li * 1024 * D;
    bf16_t* WIN = (bf16_t*)(c.ws + OFF_WIN); bf16_t* WOUT = (bf16_t*)(c.ws + OFF_WOUT);
    const int I1 = (D / 64) * (nin / 32), I2 = (1024 / 64) * (D / 32);
    for (int it = gw; it < I1 + I2; it += ngw) {
        if (it < I1) { const int nb = it % (nin / 32), kb = it / (nin / 32); transpose_item(win, pin, 64 * kb, 32 * nb, WIN, D, 32 * nb, scr, c.lane); }
        else { const int r = it - I1; const int nb = r % (D / 32), kb = r / (D / 32); transpose_item(wout, D, 64 * kb, 32 * nb, WOUT, 1024, 32 * nb, scr, c.lane); }
    }
}
DEV void convert_ffn_weights(const Ctx& c, int layer, int gw, int ngw) {
    float* scr = (float*)(c.lds + c.wave * 8448);
    const float* wg = c.in[21] + (size_t)layer * D * FF; const float* wu = c.in[22] + (size_t)layer * D * FF; const float* wd = c.in[23] + (size_t)layer * FF * D;
    bf16_t* WGU = (bf16_t*)(c.ws + SF_WGU); bf16_t* WDN = (bf16_t*)(c.ws + SF_WDN);
    const int I1 = (D / 64) * (FF / 32), I3 = (FF / 64) * (D / 32);
    for (int it = gw; it < 2 * I1 + I3; it += ngw) {
        if (it < 2 * I1) { const int up = it >= I1; const int r = up ? it - I1 : it; const int nb = r % (FF / 32), kb = r / (FF / 32); const int f0 = 32 * nb;
            transpose_item(up ? wu : wg, FF, 64 * kb, f0, WGU, D, (f0 / 128) * 256 + (up ? 128 : 0) + (f0 % 128), scr, c.lane); }
        else { const int r = it - 2 * I1; const int nb = r % (D / 32), kb = r / (D / 32); transpose_item(wd, D, 64 * kb, 32 * nb, WDN, FF, 32 * nb, scr, c.lane); }
    }
}
DEV void normalize_rows(const Ctx& c, int layer, int which, int nrows, SplitPlan red, int pmrows, const float* pga) {
    constexpr int NV = D / 256;
    float* X = (float*)(c.ws + OFF_X); bf16_t* H = (bf16_t*)(c.ws + OFF_HY); float* G = (float*)(c.ws + OFF_G);
    const float* MODL = (const float*)(c.ws + OFF_MOD) + (size_t)layer * 9 * 6 * D;
    const float* g = (which ? c.in[7] : c.in[6]) + (size_t)layer * D;
    const int odd = layer & 1, li = layer >> 1;
    const float* wgate = odd ? c.in[14] + (size_t)li * D * O_IN + NO : c.in[8] + (size_t)li * D * E_IN + NE; const int pg = odd ? O_IN : E_IN;
    float* wgt = (float*)c.lds;
    unsigned char* tab = (unsigned char*)(c.lds + 16 * D * 4);
    const float* PART = (const float*)(c.ws + SF_PART);
    if (red.extra) { BLOCK_SYNC();
        for (int e = c.tid; e < (pmrows / 256) * (D / 256); e += NTHREADS) tab[e] = 255;
        BLOCK_SYNC();
        if (c.tid < red.extra) { pg8::StaticOrder S2; S2.init(pmrows, D, red.nwg, c.nblk + c.tid); pg8::Unit u; if (S2.next(0, u)) tab[u.pm * (D / 256) + u.pn] = (unsigned char)c.tid; }
        BLOCK_SYNC(); }
    if (which == 0) { BLOCK_SYNC();
        for (int e = c.tid; e < D * 4; e += NTHREADS) { const int k = e >> 2, q = e & 3; const f32x4 w4 = *(const f32x4*)(wgate + (size_t)k * pg + 4 * q);
#pragma unroll
            for (int j = 0; j < 4; ++j) wgt[(4 * q + j) * D + k] = w4[j]; }
        BLOCK_SYNC(); }
    for (int row = c.gw; row < nrows; row += c.ngw) {
        const int mr = row < ML ? row / SEQ : NB;
        const float* sh = MODL + (size_t)mr * 6 * D + (which ? 3 : 0) * D; const float* sc = sh + D;
        const float* xrow = (layer == 0 && which == 0) ? (row < ML ? c.in[0] + (size_t)row * D : c.in[2] + (size_t)(row - ML) * D) : X + (size_t)row * D;
        const f32x4* xr = (const f32x4*)xrow + c.lane;
        f32x4 v[NV]; float ss = 0.f;
#pragma unroll
        for (int j = 0; j < NV; ++j) { v[j] = xr[64 * j];
            if (red.extra && row < pmrows) { const int lu = tab[(row >> 8) * (D / 256) + j];
                if (lu != 255) { const float* pp = PART + (size_t)lu * red.split * 65536 + (size_t)(row & 255) * 256 + 4 * c.lane; f32x4 sum = *(const f32x4*)pp;
                    for (int q = 1; q < red.split; ++q) sum += *(const f32x4*)(pp + (size_t)q * 65536);
                    v[j] += *(const f32x4*)(pga + (size_t)mr * 6 * D + 256 * j + 4 * c.lane) * sum; ((f32x4*)(X + (size_t)row * D) + c.lane)[64 * j] = v[j]; } }
            ss += (v[j][0] * v[j][0] + v[j][1] * v[j][1]) + (v[j][2] * v[j][2] + v[j][3] * v[j][3]); }
        const float rstd = 1.0f / sqrtf(wave_sum(ss) * (1.0f / D) + EPS);
        u32x2* o8 = (u32x2*)(H + (size_t)row * D) + c.lane;
        float ga[16];
#pragma unroll
        for (int n = 0; n < 16; ++n) ga[n] = 0.f;
#pragma unroll
        for (int j = 0; j < NV; ++j) { const int k0 = 256 * j + 4 * c.lane;
            const f32x4 gg = *(const f32x4*)(g + k0), s1 = *(const f32x4*)(sc + k0), s0 = *(const f32x4*)(sh + k0);
            f32x4 h = v[j] * rstd * gg * (s1 + 1.0f) + s0;
            u32x2 w; w[0] = pk2(h[0], h[1]); w[1] = pk2(h[2], h[3]); o8[64 * j] = w;
            if (which == 0) {
#pragma unroll
                for (int n = 0; n < 16; ++n) { const f32x4 w4 = *(const f32x4*)(wgt + n * D + k0); ga[n] += (h[0] * w4[0] + h[1] * w4[1]) + (h[2] * w4[2] + h[3] * w4[3]); if ((n & 3) == 3) SCHED_FENCE(); } } }
        if (which == 0) {
            const bool b5 = c.lane & 32, b4 = c.lane & 16, b3 = c.lane & 8, b2 = c.lane & 4;
            float w8[8], w4[4], w2[2];
#pragma unroll
            for (int n = 0; n < 8; ++n) { const float snd = b5 ? ga[n] : ga[n + 8], kp = b5 ? ga[n + 8] : ga[n]; w8[n] = kp + SHFL_XOR(snd, 32); }
#pragma unroll
            for (int n = 0; n < 4; ++n) { const float snd = b4 ? w8[n] : w8[n + 4], kp = b4 ? w8[n + 4] : w8[n]; w4[n] = kp + SHFL_XOR(snd, 16); }
#pragma unroll
            for (int n = 0; n < 2; ++n) { const float snd = b3 ? w4[n] : w4[n + 2], kp = b3 ? w4[n + 2] : w4[n]; w2[n] = kp + SHFL_XOR(snd, 8); }
            float z = (b2 ? w2[1] : w2[0]) + SHFL_XOR(b2 ? w2[0] : w2[1], 4);
            z += SHFL_XOR(z, 2); z += SHFL_XOR(z, 1);
            if ((c.lane & 3) == 0) G[(size_t)row * 16 + (b5 ? 8 : 0) + (b4 ? 4 : 0) + (b3 ? 2 : 0) + (b2 ? 1 : 0)] = z; }
    }
}

DEV int tok_row(int b, int tc, int i) { return tc < NCC ? ML + b * CTX + 64 * tc + i : b * SEQ + 64 * (tc - NCC) + i; }
DEV int pos_row(int b, int pos) { return pos < CTX ? ML + b * CTX + pos : b * SEQ + (pos - CTX); }
DEV int chain_chunk(int dir, int tc) { return dir == 0 ? tc : (tc < NCC ? NCC - 1 - tc : NCC + (NLC - 1 - (tc - NCC))); }
DEV void unpack8(bf16x8 v, float (&f)[8]) {
#pragma unroll
    for (int e = 0; e < 8; ++e) f[e] = bf2f((unsigned short)v[e]);
}
DEV bf16x8 pack8(const float (&f)[8]) { u32x4 p; p[0] = pk2(f[0], f[1]); p[1] = pk2(f[2], f[3]); p[2] = pk2(f[4], f[5]); p[3] = pk2(f[6], f[7]); return __builtin_bit_cast(bf16x8, p); }
DEV float chain_cumsum(float x, int lane, int dir) {
#pragma unroll
    for (int off = 1; off < 64; off <<= 1) { const int src = dir == 0 ? lane - off : lane + off; const float y = SHFL(x, src & 63); if (src >= 0 && src < 64) x += y; }
    return x;
}

constexpr int AT_KB = 64 * 72 * 2;
template <int DV> struct AttnLds { static constexpr int VB = DV * 72 * 2, BUF = AT_KB + VB; };

template <int DV>
DEV void attn_stage_load(const Ctx& c, const bf16_t* Kp, const bf16_t* Vt, int vpitch, int tile, bf16x8& kreg, bf16x8 (&vreg)[DV / 64]) {
    kreg = ld16(Kp + (size_t)(tile * 64 + (c.tid >> 3)) * 64 + (c.tid & 7) * 8);
#pragma unroll
    for (int i = 0; i < DV / 64; ++i) { const int idx = c.tid + 512 * i; vreg[i] = ld16(Vt + (size_t)(idx >> 3) * vpitch + tile * 64 + (idx & 7) * 8); }
}
template <int DV>
DEV void attn_stage_store(const Ctx& c, int boff, const bf16x8& kreg, const bf16x8 (&vreg)[DV / 64]) {
    char* kb = c.lds + boff; char* vb = kb + AT_KB;
    *(bf16x8*)(kb + (c.tid >> 3) * 144 + (c.tid & 7) * 16) = kreg;
#pragma unroll
    for (int i = 0; i < DV / 64; ++i) { const int idx = c.tid + 512 * i; *(bf16x8*)(vb + (idx >> 3) * 144 + (idx & 7) * 16) = vreg[i]; }
}
DEV void attn_qk(const char* kb, int rk, int h, const bf16x8 (&qf)[4], f32x16& p0, f32x16& p1) {
#pragma unroll
    for (int i = 0; i < 16; ++i) { p0[i] = 0.f; p1[i] = 0.f; }
#pragma unroll
    for (int ks = 0; ks < 4; ++ks) { const bf16x8 a0 = ld16(kb + rk * 144 + ks * 32 + h * 16), a1 = ld16(kb + (32 + rk) * 144 + ks * 32 + h * 16);
        p0 = MFMA32(a0, qf[ks], p0); p1 = MFMA32(a1, qf[ks], p1); }
}
DEV void attn_sm1(f32x16& p0, f32x16& p1, float& m, float& alpha) {
    const float C2 = 0.125f * 1.4426950408889634f;
    float mx = p0[0];
#pragma unroll
    for (int i = 0; i < 16; ++i) { mx = fmaxf(mx, p0[i]); mx = fmaxf(mx, p1[i]); }
    mx = fmaxf(mx, SHFL_XOR(mx, 32));
    alpha = 1.0f;
    if (WAVE_ANY(mx * C2 > m + 8.0f)) { const float mn = fmaxf(m, mx * C2); alpha = EXP2F(m - mn); m = mn; }
#pragma unroll
    for (int i = 0; i < 16; ++i) { p0[i] = p0[i] * C2 - m; p1[i] = p1[i] * C2 - m; }
#pragma unroll
    for (int i = 0; i < 16; ++i) p0[i] = EXP2F(p0[i]);
}
DEV void attn_sm2(f32x16& p0, f32x16& p1, float alpha, float& l, bf16x8 (&pb)[4]) {
#pragma unroll
    for (int i = 0; i < 16; ++i) p1[i] = EXP2F(p1[i]);
    float rs = 0.f;
#pragma unroll
    for (int i = 0; i < 16; ++i) rs += p0[i] + p1[i];
    l = l * alpha + rs;
    pb[0] = pack_acc(p0, 0); pb[1] = pack_acc(p0, 1); pb[2] = pack_acc(p1, 0); pb[3] = pack_acc(p1, 1);
}
template <int DV>
DEV void attn_pv(const char* vb, int r, int h, const bf16x8 (&pb)[4], f32x16 (&o)[DV / 32]) {
#pragma unroll
    for (int us = 0; us < 4; ++us)
#pragma unroll
        for (int dt = 0; dt < DV / 32; ++dt) { const bf16x8 va = ld16(vb + (32 * dt + r) * 144 + (16 * us + 8 * h) * 2); o[dt] = MFMA32(va, pb[us], o[dt]); }
}
template <int DV>
DEV void attn_resc(f32x16 (&o)[DV / 32], float alpha) {
    if (WAVE_ANY(alpha < 1.0f)) {
#pragma unroll
        for (int dt = 0; dt < DV / 32; ++dt)
#pragma unroll
            for (int i = 0; i < 16; ++i) o[dt][i] *= alpha; }
}
template <int DV>
DEV void attn_step(const Ctx& c, const bf16_t* Kp, const bf16_t* Vt, int vpitch, int j, int nt, const bf16x8 (&qf)[4], bool active, int rk, int ox, int oy, int on,
                   bf16x8 (&pb)[4], f32x16 (&o)[DV / 32], float& m, float& l) {
    const int r = c.lane & 31, h = c.lane >> 5; const bool more = j + 1 < nt; const float C2 = 0.125f * 1.4426950408889634f;
    bf16x8 kreg, vreg[DV / 64]; f32x16 p0, p1;
    if (active) attn_qk(c.lds + ox, rk, h, qf, p0, p1);
    SCHED_FENCE();
    if (more) attn_stage_load<DV>(c, Kp, Vt, vpitch, j + 1, kreg, vreg);
    if (active) { const char* vb = c.lds + oy + AT_KB;
        float mx = 0.f, alpha = 1.0f;
#pragma unroll
        for (int us = 0; us < 4; ++us) {
            SCHED_FENCE();
#pragma unroll
            for (int dt = 0; dt < DV / 32; ++dt) { const bf16x8 va = ld16(vb + (32 * dt + r) * 144 + (16 * us + 8 * h) * 2); o[dt] = MFMA32(va, pb[us], o[dt]); }
            SCHED_FENCE();
            if (us == 0) { mx = p0[0];
#pragma unroll
                for (int i = 0; i < 16; ++i) { mx = fmaxf(mx, p0[i]); mx = fmaxf(mx, p1[i]); }
                mx = fmaxf(mx, SHFL_XOR(mx, 32));
                if (WAVE_ANY(mx * C2 > m + 8.0f)) { const float mn = fmaxf(m, mx * C2); alpha = EXP2F(m - mn); m = mn; } }
            else if (us == 1) {
#pragma unroll
                for (int i = 0; i < 16; ++i) { p0[i] = p0[i] * C2 - m; p1[i] = p1[i] * C2 - m; } }
            else if (us == 2) {
#pragma unroll
                for (int i = 0; i < 16; ++i) p0[i] = EXP2F(p0[i]); }
            else {
#pragma unroll
                for (int i = 0; i < 16; ++i) p1[i] = EXP2F(p1[i]); }
        }
        SCHED_FENCE();
        float rs = 0.f;
#pragma unroll
        for (int i = 0; i < 16; ++i) rs += p0[i] + p1[i];
        l = l * alpha + rs;
        pb[0] = pack_acc(p0, 0); pb[1] = pack_acc(p0, 1); pb[2] = pack_acc(p1, 0); pb[3] = pack_acc(p1, 1);
        attn_resc<DV>(o, alpha); }
    if (more) attn_stage_store<DV>(c, on, kreg, vreg);
    BLOCK_SYNC();
}
template <int DV>
DEV void attn_pass(const Ctx& c, const bf16_t* Kp, const bf16_t* Vt, int vpitch, int nk, const bf16x8 (&qf)[4], bool active, f32x16 (&o)[DV / 32], float& m, float& l) {
    const int r = c.lane & 31, h = c.lane >> 5; const int rk = (r & 0x13) | ((r & 4) << 1) | ((r & 8) >> 1);
    const int nt = nk / 64; constexpr int BUF = AttnLds<DV>::BUF;
#pragma unroll
    for (int dt = 0; dt < DV / 32; ++dt)
#pragma unroll
        for (int i = 0; i < 16; ++i) o[dt][i] = 0.f;
    m = -1e30f; l = 0.f;
    bf16x8 pb[4];
    { bf16x8 kreg, vreg[DV / 64];
      attn_stage_load<DV>(c, Kp, Vt, vpitch, 0, kreg, vreg); attn_stage_store<DV>(c, 0, kreg, vreg);
      attn_stage_load<DV>(c, Kp, Vt, vpitch, 1, kreg, vreg); attn_stage_store<DV>(c, BUF, kreg, vreg); }
    BLOCK_SYNC();
    if (active) { f32x16 p0, p1; float alpha; attn_qk(c.lds, rk, h, qf, p0, p1); attn_sm1(p0, p1, m, alpha); attn_sm2(p0, p1, alpha, l, pb); }
    else {
#pragma unroll
        for (int i = 0; i < 4; ++i) pb[i] = (bf16x8){0, 0, 0, 0, 0, 0, 0, 0}; }
    int ox = BUF, oy = 0, on = 2 * BUF;
    for (int j = 1; j < nt; ++j) {
        attn_step<DV>(c, Kp, Vt, vpitch, j, nt, qf, active, rk, ox, oy, on, pb, o, m, l); { const int t_ = oy; oy = ox; ox = on; on = t_; }
    }
    if (active) attn_pv<DV>(c.lds + oy + AT_KB, r, h, pb, o);
    BLOCK_SYNC();
}
DEV void load_q(const Ctx& c, const bf16_t* Qrow  , bool valid, bool rope, int t, const float* qg  , bf16x8 (&qf)[4]) {
    const int h = c.lane >> 5;
    float f[4][8];
#pragma unroll
    for (int ks = 0; ks < 4; ++ks) { bf16x8 v = (bf16x8){0, 0, 0, 0, 0, 0, 0, 0}; if (valid) v = ld16(Qrow + 16 * ks + 8 * h); unpack8(v, f[ks]); }
    if (qg) { float ss = 0.f;
#pragma unroll
        for (int ks = 0; ks < 4; ++ks)
#pragma unroll
            for (int e = 0; e < 8; ++e) ss += f[ks][e] * f[ks][e];
        ss += SHFL_XOR(ss, 32);
        const float rstd = 1.0f / sqrtf(ss * (1.0f / 64.0f) + EPS);
#pragma unroll
        for (int ks = 0; ks < 4; ++ks)
#pragma unroll
            for (int e = 0; e < 8; ++e) f[ks][e] = f[ks][e] * rstd * qg[16 * ks + 8 * h + e]; }
    if (rope) { const float* COS = (const float*)(c.ws + OFF_ROPE) + (size_t)t * 32; const float* SIN = COS + (size_t)SEQ * 32;
#pragma unroll
        for (int a = 0; a < 2; ++a)
#pragma unroll
            for (int e = 0; e < 8; ++e) { const float cs = COS[a * 16 + 8 * h + e], sn = SIN[a * 16 + 8 * h + e]; const float x1 = f[2 * a][e], x2 = f[2 * a + 1][e];
                f[2 * a][e] = x1 * cs - x2 * sn; f[2 * a + 1][e] = x2 * cs + x1 * sn; } }
#pragma unroll
    for (int ks = 0; ks < 4; ++ks) qf[ks] = pack8(f[ks]);
}

DEV void even_kprep(const Ctx& c) {
    const bf16_t* KA = (const bf16_t*)(c.ws + OFF_P) + PE_KA; bf16_t* KP = (bf16_t*)(c.ws + SE_KP);
    const float* COS = (const float*)(c.ws + OFF_ROPE); const float* SIN = COS + (size_t)SEQ * 32;
    const int l7 = c.lane & 7, a = l7 >> 2, p = (l7 >> 1) & 1, f0 = 8 * (l7 & 1), vh = c.lane >> 3;
    for (int it = c.gw; it < NB * LK; it += c.ngw) { const int b = it / LK, pos = it % LK; const int row = pos_row(b, pos);
        float f[8]; unpack8(ld16(KA + (size_t)row * 512 + 8 * c.lane), f);
        float g[8];
#pragma unroll
        for (int e = 0; e < 8; ++e) g[e] = SHFL_XOR(f[e], 2);
        if (pos >= CTX) { const int t = pos - CTX;
#pragma unroll
            for (int e = 0; e < 8; ++e) { const float cs = COS[(size_t)t * 32 + a * 16 + f0 + e], sn = SIN[(size_t)t * 32 + a * 16 + f0 + e]; f[e] = p == 0 ? f[e] * cs - g[e] * sn : f[e] * cs + g[e] * sn; } }
        *(bf16x8*)(KP + ((size_t)(b * 8 + vh) * LK + pos) * 64 + 8 * l7) = pack8(f); }
}
template <int DV>
DEV void vt_item(const Ctx& c, const bf16_t* src, int spitch, int colbase, int b, int pc, bf16_t* dstbh  ) {
    bf16_t* T = (bf16_t*)c.lds;
#pragma unroll
    for (int i = 0; i < DV / 64; ++i) { const int idx = c.tid + 512 * i, pl = idx / (DV / 8), cg = idx % (DV / 8); const int row = pos_row(b, 64 * pc + pl);
        const bf16x8 v = ld16(src + (size_t)row * spitch + colbase + 8 * cg);
#pragma unroll
        for (int e = 0; e < 8; ++e) T[(8 * cg + e) * 72 + pl] = (bf16_t)v[e]; }
    BLOCK_SYNC();
#pragma unroll
    for (int i = 0; i < DV / 64; ++i) { const int idx = c.tid + 512 * i, dv = idx >> 3, ch = idx & 7;
        *(bf16x8*)(dstbh + (size_t)dv * LK + 64 * pc + 8 * ch) = *(const bf16x8*)(T + dv * 72 + 8 * ch); }
    BLOCK_SYNC();
}

DEV void mlstm_gates(const Ctx& c, int layer, int b, int h, int dir, int tc, float& ipre, float& lf) {
    const float* G = (const float*)(c.ws + OFF_G); const float* bias = c.in[9] + (size_t)(layer >> 1) * 16;
    const int row = tok_row(b, tc, c.lane);
    ipre = G[(size_t)row * 16 + dir * 8 + h] + bias[dir * 8 + h];
    lf = logsigmoidf_(G[(size_t)row * 16 + dir * 8 + 4 + h] + bias[dir * 8 + 4 + h]);
}
DEV void mlstm_m1_item(const Ctx& c, int layer, int it) {
    const int tc = it % NCH, dir = (it / NCH) & 1, h = (it / (2 * NCH)) & 3, b = it / (8 * NCH);
    const int chain = (b * 4 + h) * 2 + dir, cc = chain_chunk(dir, tc); const size_t ci = (size_t)chain * NCH + cc;
    const bf16_t* BK = (const bf16_t*)(c.ws + OFF_P) + PE_BK; const bf16_t* BV = (const bf16_t*)(c.ws + OFF_P) + PE_BV;
    float* DCT = (float*)(c.ws + SE_DCT); float* DN = (float*)(c.ws + SE_DN); float* SC = (float*)(c.ws + SE_SC);
    bf16_t* Kt = (bf16_t*)c.lds; bf16_t* Vt = Kt + 64 * 72; float* wv = (float*)(c.lds + (64 + 128) * 72 * 2);
    if (c.wave == 0) { float ipre, lf; mlstm_gates(c, layer, b, h, dir, tc, ipre, lf);
        const float bcum = chain_cumsum(lf, c.lane, dir), bend = wave_sum(lf), wend = bend - bcum + ipre, mloc = wave_max(wend);
        wv[c.lane] = expf(wend - mloc);
        if (c.lane == 0) { SC[ci * 4 + 0] = bend; SC[ci * 4 + 1] = mloc; } }
    BLOCK_SYNC();
    {   const int i = c.tid >> 3, cg = c.tid & 7; const int row = tok_row(b, tc, i); const float w = wv[i] * 0.125f;
        float f[8]; unpack8(ld16(BK + (size_t)row * 256 + h * 64 + 8 * cg), f);
#pragma unroll
        for (int e = 0; e < 8; ++e) Kt[(8 * cg + e) * 72 + (((i >> 3) ^ (cg & 7)) << 3) + (i & 7)] = (bf16_t)f2bf(f[e] * w); }
#pragma unroll
    for (int ii = 0; ii < 2; ++ii) { const int idx = c.tid + 512 * ii, i = idx >> 4, cg = idx & 15; const int row = tok_row(b, tc, i);
        const bf16x8 v = ld16(BV + (size_t)row * 512 + h * 128 + 8 * cg);
#pragma unroll
        for (int e = 0; e < 8; ++e) Vt[(8 * cg + e) * 72 + (((i >> 3) ^ (cg & 7)) << 3) + (i & 7)] = (bf16_t)v[e]; }
    BLOCK_SYNC();
    {   const int r = c.lane & 31, hh = c.lane >> 5, dvt = c.wave >> 1, dkt = c.wave & 1;
        f32x16 acc;
#pragma unroll
        for (int i = 0; i < 16; ++i) acc[i] = 0.f;
#pragma unroll
        for (int ks = 0; ks < 4; ++ks) acc = MFMA32(ld16(Vt + (32 * dvt + r) * 72 + 8 * ((2 * ks + hh) ^ ((r >> 3) & 3) ^ ((dvt & 1) << 2))), ld16(Kt + (32 * dkt + r) * 72 + 8 * ((2 * ks + hh) ^ ((r >> 3) & 3) ^ ((dkt & 1) << 2))), acc);
        float* dst = DCT + ci * 8192;
#pragma unroll
        for (int i = 0; i < 16; ++i) dst[(32 * dvt + crow(i, hh)) * 64 + 32 * dkt + r] = acc[i];
        if (c.tid < 64) { float s = 0.f; for (int i = 0; i < 64; ++i) s += bf2f(Kt[c.tid * 72 + i]); DN[ci * 64 + c.tid] = s; } }
    BLOCK_SYNC();
}
DEV void mlstm_m2(const Ctx& c) {
    float* DCT = (float*)(c.ws + SE_DCT); float* DN = (float*)(c.ws + SE_DN); float* SC = (float*)(c.ws + SE_SC);
    const long gt = (long)c.bid * NTHREADS + c.tid, GT = (long)c.nblk * NTHREADS;
    for (long it = gt; it < (long)NCHAIN * 8256; it += GT) { const int chain = (int)(it / 8256), e = (int)(it % 8256);
        float* p0 = e < 8192 ? DCT + (size_t)chain * NCH * 8192 + e : DN + (size_t)chain * NCH * 64 + (e - 8192); const size_t pstr = e < 8192 ? 8192 : 64;
        float d[NCH];
#pragma unroll
        for (int cc = 0; cc < NCH; ++cc) d[cc] = p0[cc * pstr];
        float mst = 0.f, val = 0.f;
#pragma unroll
        for (int cc = 0; cc < NCH; ++cc) { const size_t ci = (size_t)chain * NCH + cc; const float bend = SC[ci * 4 + 0], mloc = SC[ci * 4 + 1];
            if (e == 0) SC[ci * 4 + 2] = mst;
            const float mnew = fmaxf(bend + mst, mloc); const float nv = expf(bend + mst - mnew) * val + expf(mloc - mnew) * d[cc]; d[cc] = val; val = nv; mst = mnew; }
#pragma unroll
        for (int cc = 0; cc < NCH; ++cc) p0[cc * pstr] = d[cc]; }
}
DEV void mlstm_m3_item(const Ctx& c, int layer, int it) {
    const int tc = it % NCH, h = (it / NCH) & 3, b = it / (4 * NCH);
    const bf16_t* BQ = (const bf16_t*)(c.ws + OFF_P) + PE_BQ; const bf16_t* BK = (const bf16_t*)(c.ws + OFF_P) + PE_BK; const bf16_t* BV = (const bf16_t*)(c.ws + OFF_P) + PE_BV; const bf16_t* BO = (const bf16_t*)(c.ws + OFF_P) + PE_BO;
    const float* DCT = (const float*)(c.ws + SE_DCT); const float* DN = (const float*)(c.ws + SE_DN); const float* SC = (const float*)(c.ws + SE_SC);
    bf16_t* Y = (bf16_t*)(c.ws + OFF_HY); const float* gn = c.in[12] + (size_t)(layer >> 1) * 128;
    bf16_t* Qs = (bf16_t*)c.lds; bf16_t* Ks = Qs + 64 * 72; bf16_t* Vt = Ks + 64 * 72; float* fl = (float*)(c.lds + (128 + 128) * 72 * 2);
    float* bcs = fl, *ics = fl + 64, *nst = fl + 128, *ssq = fl + 192;
    const int r = c.lane & 31, hh = c.lane >> 5, dvt = c.wave >> 1, tt = c.wave & 1, t = 32 * tt + r;
    f32x16 hs;
#pragma unroll
    for (int i = 0; i < 16; ++i) hs[i] = 0.f;
    for (int dir = 0; dir < 2; ++dir) {
        const int chain = (b * 4 + h) * 2 + dir, cc = chain_chunk(dir, tc); const size_t ci = (size_t)chain * NCH + cc;
        if (c.wave == 0) { float ipre, lf; mlstm_gates(c, layer, b, h, dir, tc, ipre, lf); bcs[c.lane] = chain_cumsum(lf, c.lane, dir); ics[c.lane] = ipre; }
        if (c.wave == 1) nst[c.lane] = DN[ci * 64 + c.lane];
        {   const int i = c.tid >> 3, cg = c.tid & 7; const int row = tok_row(b, tc, i);
            *(bf16x8*)(Qs + i * 72 + 8 * cg) = ld16(BQ + (size_t)row * 256 + h * 64 + 8 * cg);
            float f[8]; unpack8(ld16(BK + (size_t)row * 256 + h * 64 + 8 * cg), f);
#pragma unroll
            for (int e = 0; e < 8; ++e) f[e] *= 0.125f;
            *(bf16x8*)(Ks + i * 72 + 8 * cg) = pack8(f); }
#pragma unroll
        for (int ii = 0; ii < 2; ++ii) { const int idx = c.tid + 512 * ii, i = idx >> 4, cg = idx & 15; const int row = tok_row(b, tc, i);
            const bf16x8 v = ld16(BV + (size_t)row * 512 + h * 128 + 8 * cg);
#pragma unroll
            for (int e = 0; e < 8; ++e) Vt[(8 * cg + e) * 72 + (((i >> 3) ^ (cg & 7)) << 3) + (i & 7)] = (bf16_t)v[e]; }
        BLOCK_SYNC();
        const float mst = SC[ci * 4 + 2];
        f32x16 st[2];
#pragma unroll
        for (int su = 0; su < 2; ++su) {
#pragma unroll
            for (int i = 0; i < 16; ++i) st[su][i] = 0.f;
#pragma unroll
            for (int ks = 0; ks < 4; ++ks) st[su] = MFMA32(ld16(Ks + (32 * su + r) * 72 + 16 * ks + 8 * hh), ld16(Qs + t * 72 + 16 * ks + 8 * hh), st[su]); }
        const float bt = bcs[t], at = bt + mst;
        float mt = at;
#pragma unroll
        for (int su = 0; su < 2; ++su)
#pragma unroll
            for (int i = 0; i < 16; ++i) { const int s = 32 * su + crow(i, hh); const bool valid = dir == 0 ? s <= t : s >= t; if (valid) mt = fmaxf(mt, bt - bcs[s] + ics[s]); }
        mt = fmaxf(mt, SHFL_XOR(mt, 32));
        const float inter = expf(at - mt);
        float rsum = 0.f;
#pragma unroll
        for (int su = 0; su < 2; ++su)
#pragma unroll
            for (int i = 0; i < 16; ++i) { const int s = 32 * su + crow(i, hh); const bool valid = dir == 0 ? s <= t : s >= t;
                const float p = valid ? expf(bt - bcs[s] + ics[s] - mt) * st[su][i] : 0.f; st[su][i] = p; rsum += p; }
        rsum += SHFL_XOR(rsum, 32);
        float qn = 0.f;
        for (int d = 0; d < 32; ++d) qn += bf2f(Qs[t * 72 + 32 * hh + d]) * nst[32 * hh + d];
        qn += SHFL_XOR(qn, 32);
        const float den = inter * qn + rsum, dd = fmaxf(fabsf(den), expf(-mt));
        f32x16 a1;
#pragma unroll
        for (int i = 0; i < 16; ++i) a1[i] = 0.f;
        const float* Cst = DCT + ci * 8192 + (size_t)(32 * dvt + r) * 64;
#pragma unroll
        for (int ks = 0; ks < 4; ++ks) { float f[8]; const f32x4 c0 = *(const f32x4*)(Cst + 16 * ks + 8 * hh), c1 = *(const f32x4*)(Cst + 16 * ks + 8 * hh + 4);
            f[0] = c0[0]; f[1] = c0[1]; f[2] = c0[2]; f[3] = c0[3]; f[4] = c1[0]; f[5] = c1[1]; f[6] = c1[2]; f[7] = c1[3];
            a1 = MFMA32(pack8(f), ld16(Qs + t * 72 + 16 * ks + 8 * hh), a1); }
        f32x16 a2;
#pragma unroll
        for (int i = 0; i < 16; ++i) a2[i] = 0.f;
#pragma unroll
        for (int su = 0; su < 2; ++su)
#pragma unroll
            for (int s2 = 0; s2 < 2; ++s2) { const bf16_t* vr = Vt + (32 * dvt + r) * 72 + 4 * hh; const int sw = ((32 * dvt + r) >> 3) & 7, bk = 4 * su + 2 * s2;
                a2 = MFMA32(cat44(*(const bf16x4*)(vr + 8 * (bk ^ sw)), *(const bf16x4*)(vr + 8 * ((bk + 1) ^ sw))), pack_acc(st[su], s2), a2); }
        const float inv = 1.0f / dd;
#pragma unroll
        for (int i = 0; i < 16; ++i) hs[i] += (inter * a1[i] + a2[i]) * inv;
        BLOCK_SYNC();
    }
    float ss = 0.f;
#pragma unroll
    for (int i = 0; i < 16; ++i) ss += hs[i] * hs[i];
    ss += SHFL_XOR(ss, 32);
    if (hh == 0) ssq[dvt * 64 + t] = ss;
    BLOCK_SYNC();
    const float rstd = 1.0f / sqrtf((ssq[t] + ssq[64 + t] + ssq[128 + t] + ssq[192 + t]) * (1.0f / 128.0f) + EPS);
    const int row = tok_row(b, tc, t);
#pragma unroll
    for (int q4 = 0; q4 < 4; ++q4) { const int dv = 32 * dvt + 8 * q4 + 4 * hh;
        const bf16x4 ov = *(const bf16x4*)(BO + (size_t)row * 512 + h * 128 + dv); float y[4];
#pragma unroll
        for (int e = 0; e < 4; ++e) y[e] = hs[4 * q4 + e] * rstd * gn[dv + e] * sigmoidf_(bf2f((unsigned short)ov[e]));
        u32x2 w; w[0] = pk2(y[0], y[1]); w[1] = pk2(y[2], y[3]);
        *(u32x2*)(Y + (size_t)row * 1024 + 512 + h * 128 + dv) = w; }
    BLOCK_SYNC();
}

DEV void diffattn_unit(const Ctx& c, int layer, int b, int h, bool ctxu, int qb) {
    const bf16_t* QA = (const bf16_t*)(c.ws + OFF_P) + PE_QA; const bf16_t* KP = (const bf16_t*)(c.ws + SE_KP); const bf16_t* VT = (const bf16_t*)(c.ws + SE_VT);
    bf16_t* Y = (bf16_t*)(c.ws + OFF_HY); const int e = layer >> 1;
    const float* lam = c.in[10] + (size_t)e * 256; const float* gn = c.in[11] + (size_t)e * 128;
    const int r = c.lane & 31, hh = c.lane >> 5; const int ql = qb * 256 + c.wave * 32 + r;
    const int nq = ctxu ? CTX : SEQ, nk = ctxu ? CTX : LK; const bool valid = ql < nq, active = (qb * 256 + c.wave * 32) < nq;
    const int row = ctxu ? ML + b * CTX + ql : b * SEQ + ql;
    const int orow = ctxu ? row : b * SEQ + (ql % 128) * (SEQ / 128) + ql / 128;
    f32x16 o[4]; float m, l1, l2; bf16x8 qf[4];
    float* park = (float*)(c.ws + SE_PARK) + ((size_t)c.bid * NTHREADS + c.tid) * 64;
    load_q(c, QA + (size_t)row * 512 + h * 128, valid, !ctxu, ql, nullptr, qf);
    attn_pass<128>(c, KP + (size_t)(b * 8 + 2 * h) * LK * 64, VT + (size_t)(b * 4 + h) * 128 * LK, LK, nk, qf, active, o, m, l1);
    if (active) { l1 += SHFL_XOR(l1, 32); const float i1 = 1.0f / l1;
#pragma unroll
        for (int dt = 0; dt < 4; ++dt)
#pragma unroll
            for (int q4 = 0; q4 < 4; ++q4) *(f32x4*)(park + 16 * dt + 4 * q4) = (f32x4){o[dt][4 * q4] * i1, o[dt][4 * q4 + 1] * i1, o[dt][4 * q4 + 2] * i1, o[dt][4 * q4 + 3] * i1}; }
    load_q(c, QA + (size_t)row * 512 + h * 128 + 64, valid, !ctxu, ql, nullptr, qf);
    attn_pass<128>(c, KP + (size_t)(b * 8 + 2 * h + 1) * LK * 64, VT + (size_t)(b * 4 + h) * 128 * LK, LK, nk, qf, active, o, m, l2);
    const float lam_init = 0.8f - 0.6f * expf(-0.3f * (float)layer);
    const float lmb = expf(wave_sum(lam[c.lane] * lam[64 + c.lane])) - expf(wave_sum(lam[128 + c.lane] * lam[192 + c.lane])) + lam_init;
    if (active) {
        l2 += SHFL_XOR(l2, 32);
        const float i2 = lmb / l2; float ss = 0.f;
#pragma unroll
        for (int dt = 0; dt < 4; ++dt)
#pragma unroll
            for (int q4 = 0; q4 < 4; ++q4) { const f32x4 a = *(const f32x4*)(park + 16 * dt + 4 * q4);
#pragma unroll
                for (int e = 0; e < 4; ++e) { const float v = a[e] - o[dt][4 * q4 + e] * i2; o[dt][4 * q4 + e] = v; ss += v * v; } }
        ss += SHFL_XOR(ss, 32);
        const float sc = (1.0f / sqrtf(ss * (1.0f / 128.0f) + EPS)) * (1.0f - lam_init);
        if (valid) {
#pragma unroll
            for (int dt = 0; dt < 4; ++dt)
#pragma unroll
                for (int q4 = 0; q4 < 4; ++q4) { const int dv = 32 * dt + 8 * q4 + 4 * hh; u32x2 w;
                    w[0] = pk2(o[dt][4 * q4 + 0] * sc * gn[dv + 0], o[dt][4 * q4 + 1] * sc * gn[dv + 1]); w[1] = pk2(o[dt][4 * q4 + 2] * sc * gn[dv + 2], o[dt][4 * q4 + 3] * sc * gn[dv + 3]);
                    *(u32x2*)(Y + (size_t)orow * 1024 + h * 128 + dv) = w; } }
    }
}

DEV void mix_even_a(const Ctx& c, int layer) {
    { PHASE_CTX(pc); if (ON(8)) even_kprep(pc); }
    { PHASE_CTX(pc); if (ON(9)) { const bf16_t* VA = (const bf16_t*)(pc.ws + OFF_P) + PE_VA; bf16_t* VT = (bf16_t*)(pc.ws + SE_VT);
        for (int it = pc.bid; it < NB * 4 * NCH; it += pc.nblk) { const int pch = it % NCH, bh = it / NCH; vt_item<128>(pc, VA, 512, (bh & 3) * 128, bh >> 2, pch, VT + (size_t)bh * 128 * LK); } } }
    REPB(10) { PHASE_CTX(pc); if (ON(10)) for (int it = pc.bid; it < NCHAIN * NCH; it += pc.nblk) mlstm_m1_item(pc, layer, it); }
}
DEV void mix_even_b(const Ctx& c, int layer) {
    { PHASE_CTX(pc); if (ON(11)) mlstm_m2(pc); }
}
DEV void mix_even_c(const Ctx& c, int layer) {
    constexpr int NQBL = SEQ / 256, NQBC = (CTX + 255) / 256, NUL = NB * 4 * NQBL, NUC = NB * 4 * NQBC;
    REPB(12) { PHASE_CTX(pc); if (ON(12)) for (int it = pc.bid; it < NUL + NUC; it += pc.nblk) { const bool cu = it >= NUL; int u = cu ? it - NUL : it; const int nqb = cu ? NQBC : NQBL;
        diffattn_unit(pc, layer, u / (4 * nqb), (u / nqb) & 3, cu, u % nqb); } }
    REPB(13) { PHASE_CTX(pc); if (ON(13)) for (int it = pc.nblk - 1 - pc.bid; it < NB * 4 * NCH; it += pc.nblk) mlstm_m3_item(pc, layer, it); }
}
constexpr size_t SO_KP = OFF_S;
constexpr size_t SO_VT = SO_KP + al256((size_t)NB * 2 * LK * 64 * 2);
constexpr size_t SO_U  = SO_VT + al256((size_t)NB * 2 * 64 * LK * 2);
constexpr size_t SO_W  = OFF_HY;
static_assert((size_t)NCHAIN * NCH * 8192 <= (size_t)MT * cmax(D, 1024), "W fits in the H/Y region");
constexpr size_t SO_AT = SO_U + al256((size_t)NCHAIN * NCH * 8192 * 2);
constexpr size_t SO_QN = SO_AT + al256((size_t)NCHAIN * NCH * 4096 * 2);
constexpr size_t SO_KD = SO_QN + al256((size_t)NCHAIN * NCH * 8192 * 2);
constexpr size_t SO_GE = SO_KD + al256((size_t)NCHAIN * NCH * 8192 * 2);
constexpr size_t SO_END = SO_GE + al256((size_t)NCHAIN * NCH * 4);
constexpr size_t PO_HB = PO_DQKV;
constexpr size_t PO_GO = PO_DQKV + (size_t)MT * 1024;
static_assert((size_t)3 * MT * 512 <= (size_t)MT * 1536, "HB and GO fit in the DQKV segment");

DEV void odd_kprep(const Ctx& c, int layer) {
    const bf16_t* KVC = (const bf16_t*)(c.ws + OFF_P) + PO_KVC; bf16_t* KP = (bf16_t*)(c.ws + SO_KP);
    const float* COS = (const float*)(c.ws + OFF_ROPE); const float* SIN = COS + (size_t)SEQ * 32; const float* kg = c.in[15] + (size_t)(layer >> 1) * 128 + 64;
    const int kv = c.lane >> 5, d0 = 2 * (c.lane & 31);
    const int a = d0 >> 5, p = (d0 >> 4) & 1, f0 = d0 & 15;
    for (int it = c.gw; it < NB * LK; it += c.ngw) { const int b = it / LK, pos = it % LK; const int row = pos_row(b, pos);
        const unsigned w = *(const unsigned*)(KVC + (size_t)row * 256 + 2 * c.lane);
        float x0 = bf2f(w & 0xffffu), x1 = bf2f(w >> 16);
        float ss = x0 * x0 + x1 * x1;
#pragma unroll
        for (int o = 1; o < 32; o <<= 1) ss += SHFL_XOR(ss, o);
        const float rstd = 1.0f / sqrtf(ss * (1.0f / 64.0f) + EPS);
        x0 *= rstd * kg[d0]; x1 *= rstd * kg[d0 + 1];
        const float y0 = SHFL_XOR(x0, 8), y1 = SHFL_XOR(x1, 8);
        if (pos >= CTX) { const int t = pos - CTX; const float c0 = COS[(size_t)t * 32 + a * 16 + f0], s0 = SIN[(size_t)t * 32 + a * 16 + f0], c1 = COS[(size_t)t * 32 + a * 16 + f0 + 1], s1 = SIN[(size_t)t * 32 + a * 16 + f0 + 1];
            x0 = p == 0 ? x0 * c0 - y0 * s0 : x0 * c0 + y0 * s0; x1 = p == 0 ? x1 * c1 - y1 * s1 : x1 * c1 + y1 * s1; }
        *(unsigned*)(KP + ((size_t)(b * 2 + kv) * LK + pos) * 64 + d0) = pk2(x0, x1); }
}
DEV void gqa_unit(const Ctx& c, int layer, int b, int h, bool ctxu, int qb) {
    const bf16_t* QC = (const bf16_t*)(c.ws + OFF_P) + PO_QC; const bf16_t* KP = (const bf16_t*)(c.ws + SO_KP); const bf16_t* VT = (const bf16_t*)(c.ws + SO_VT);
    bf16_t* QO = (bf16_t*)(c.ws + OFF_P) + PO_GO; const float* qg = c.in[15] + (size_t)(layer >> 1) * 128;
    const int r = c.lane & 31, hh = c.lane >> 5, kv = h >> 2; const int ql = qb * 256 + c.wave * 32 + r;
    const int nq = ctxu ? CTX : SEQ, nk = ctxu ? CTX : LK; const bool valid = ql < nq, active = (qb * 256 + c.wave * 32) < nq;
    const int row = ctxu ? ML + b * CTX + ql : b * SEQ + ql;
    const int orow = ctxu ? row : b * SEQ + (ql % 128) * (SEQ / 128) + ql / 128;
    f32x16 o[2]; float m, l; bf16x8 qf[4];
    load_q(c, QC + (size_t)row * 512 + h * 64, valid, !ctxu, ql, qg, qf);
    attn_pass<64>(c, KP + (size_t)(b * 2 + kv) * LK * 64, VT + (size_t)(b * 2 + kv) * 64 * LK, LK, nk, qf, active, o, m, l);
    if (active) { l += SHFL_XOR(l, 32); const float il = 1.0f / l;
        if (valid) {
#pragma unroll
            for (int dt = 0; dt < 2; ++dt)
#pragma unroll
                for (int q4 = 0; q4 < 4; ++q4) { const int dv = 32 * dt + 8 * q4 + 4 * hh; u32x2 w;
                    w[0] = pk2(o[dt][4 * q4 + 0] * il, o[dt][4 * q4 + 1] * il); w[1] = pk2(o[dt][4 * q4 + 2] * il, o[dt][4 * q4 + 3] * il);
                    *(u32x2*)(QO + (size_t)orow * 512 + h * 64 + dv) = w; } } }
}

constexpr int D1_CW_OFF = 110592;
#ifndef D1_STOP
#define D1_STOP 0
#endif
DEV void dn_d1_item(const Ctx& c, int layer, int it, int stop = 0) {
    const int tc = it % NCH, dir = (it / NCH) & 1, h = (it / (2 * NCH)) & 3, b = it / (8 * NCH);
    const int chain = (b * 4 + h) * 2 + dir, cc = chain_chunk(dir, tc); const size_t ci = (size_t)chain * NCH + cc; const int o = layer >> 1;
    const bf16_t* DQ = (const bf16_t*)(c.ws + OFF_P) + PO_DQKV; const float* G = (const float*)(c.ws + OFF_G);
    const float* cwl = (const float*)(c.lds + D1_CW_OFF); const float* alog = c.in[17] + (size_t)o * 8; const float* dtb = c.in[18] + (size_t)o * 8;
    bf16_t* Ub = (bf16_t*)(c.ws + SO_U) + ci * 8192; bf16_t* Wb = (bf16_t*)(c.ws + SO_W) + ci * 8192; bf16_t* ATb = (bf16_t*)(c.ws + SO_AT) + ci * 4096;
    bf16_t* QNb = (bf16_t*)(c.ws + SO_QN) + ci * 8192; bf16_t* KDb = (bf16_t*)(c.ws + SO_KD) + ci * 8192; float* GE = (float*)(c.ws + SO_GE);
    bf16_t* Qs = (bf16_t*)c.lds; bf16_t* Ks = Qs + 64 * 136; bf16_t* Kt = Ks + 64 * 136; bf16_t* Vt = Kt + 128 * 72; float* Am = (float*)(c.lds + (2 * 64 * 136 + 2 * 128 * 72) * 2); float* gc = Am + 64 * 65; float* be = gc + 64;
    float* gam = be + 64; float* T2 = gam + 64; float* Rb = T2 + 64 * 65;
    const int seqlen = tc < NCC ? CTX : SEQ, tok0 = tc < NCC ? 64 * tc : 64 * (tc - NCC), rowbase = tc < NCC ? ML + b * CTX : b * SEQ;
    if (c.wave == 0) { const int j = c.lane, i = dir ? 63 - j : j; const int row = rowbase + tok0 + i;
        const float beta = sigmoidf_(G[(size_t)row * 16 + dir * 8 + h]);
        const float ld = -expf(alog[dir * 4 + h]) * softplusf_(G[(size_t)row * 16 + dir * 8 + 4 + h] + dtb[dir * 4 + h]);
        const float gcum = chain_cumsum(ld, j, 0); gc[j] = gcum; be[j] = beta; gam[j] = expf(gcum);
        if (j == 63) GE[ci] = expf(gcum); }
    {   const int j = c.tid >> 3, cg = c.tid & 7, i = dir ? 63 - j : j, tok = tok0 + i;
        bf16x8 raw[3][2], rawn[3][2];
#define D1_LOADROWS(R, TEN) { _Pragma("unroll") for (int tap = 0; tap < 3; ++tap) { const int tk = tok + tap - 1; const bool in = tk >= 0 && tk < seqlen; \
            const bf16_t* src = DQ + (size_t)(rowbase + (in ? tk : tok)) * 1536 + (TEN) * 512 + h * 128 + 16 * cg; R[tap][0] = ld16(src); R[tap][1] = ld16(src + 8); \
            if (!in) { R[tap][0] = (bf16x8){0, 0, 0, 0, 0, 0, 0, 0}; R[tap][1] = (bf16x8){0, 0, 0, 0, 0, 0, 0, 0}; } } }
        D1_LOADROWS(rawn, 0);
#pragma unroll 1
        for (int ten = 0; ten < 3; ++ten) { const int col = ten * 512 + h * 128 + 16 * cg;
            float val[16];
#pragma unroll
            for (int e = 0; e < 16; ++e) val[e] = 0.f;
#pragma unroll
            for (int tap = 0; tap < 3; ++tap) { raw[tap][0] = rawn[tap][0]; raw[tap][1] = rawn[tap][1]; }
            if (ten < 2) D1_LOADROWS(rawn, ten + 1);
            SCHED_FENCE();
#pragma unroll
            for (int tap = 0; tap < 3; ++tap) { float f0[8], f1[8]; unpack8(raw[tap][0], f0); unpack8(raw[tap][1], f1);
                const float* wp = cwl + tap * 1536 + col;
#pragma unroll
                for (int e = 0; e < 8; ++e) { val[e] += f0[e] * wp[e]; val[8 + e] += f1[e] * wp[8 + e]; }
                SCHED_FENCE(); }
#pragma unroll
            for (int e = 0; e < 16; ++e) val[e] = siluf_(val[e]);
            if (ten < 2) { float ss = 0.f;
#pragma unroll
                for (int e = 0; e < 16; ++e) ss += val[e] * val[e];
                ss += SHFL_XOR(ss, 1); ss += SHFL_XOR(ss, 2); ss += SHFL_XOR(ss, 4);
                const float sc = (1.0f / sqrtf(ss + EPS)) * (ten == 0 ? 0.08838834764831845f : 1.0f);
#pragma unroll
                for (int e = 0; e < 16; ++e) val[e] *= sc; }
            if (ten < 2) { bf16_t* dst = (ten == 0 ? Qs : Ks) + j * 136 + 16 * cg; float fa[8], fb[8];
#pragma unroll
                for (int e = 0; e < 8; ++e) { fa[e] = val[e]; fb[e] = val[8 + e]; }
                *(bf16x8*)dst = pack8(fa); *(bf16x8*)(dst + 8) = pack8(fb); }
            if (ten >= 1) { bf16_t* dstT = (ten == 1 ? Kt : Vt);
#pragma unroll
                for (int e = 0; e < 16; ++e) dstT[(16 * cg + e) * 72 + (((j >> 3) ^ cg) << 3) + (j & 7)] = (bf16_t)f2bf(val[e]); } } }
    BLOCK_SYNC(); if (stop == 1) return;
    const int r = c.lane & 31, hh = c.lane >> 5;
    {
        const int wq = c.wave & 3, tt = wq >> 1, st = wq & 1; const bool isq = c.wave >= 4;
        f32x16 acc;
#pragma unroll
        for (int i = 0; i < 16; ++i) acc[i] = 0.f;
        const bf16_t* Ar = (isq ? Qs : Ks) + (32 * tt + r) * 136; const bf16_t* Br = Ks + (32 * st + r) * 136;
#pragma unroll
        for (int ks = 0; ks < 8; ++ks) acc = MFMA32(ld16(Ar + 16 * ks + 8 * hh), ld16(Br + 16 * ks + 8 * hh), acc);
        const int s = 32 * st + r; const float gs = gc[s];
#pragma unroll
        for (int i = 0; i < 16; ++i) { const int t = 32 * tt + crow(i, hh); const float dec = expf(gc[t] - gs);
            if (!isq) Am[t * 65 + s] = t > s ? be[t] * dec * acc[i] : 0.f;
            else ATb[t * 64 + s] = (bf16_t)f2bf(t >= s ? dec * acc[i] : 0.f); } }
    BLOCK_SYNC(); if (stop == 2) return;
    if (c.wave == 0) { const int d = c.lane >> 4, cc = c.lane & 15; const float* Ad = Am + (16 * d) * 65 + 16 * d; float* Td = T2 + (16 * d) * 65 + 16 * d;
        float t[16];
#pragma unroll
        for (int i = 0; i < 16; ++i) { float acc = (cc == i) ? 1.f : 0.f;
#pragma unroll
            for (int j = 0; j < i; ++j) acc -= Ad[i * 65 + j] * t[j];
            t[i] = acc; }
#pragma unroll
        for (int i = 0; i < 16; ++i) Td[i * 65 + cc] = t[i]; }
    else { for (int e = c.tid - 64; e < 64 * 64; e += NTHREADS - 64) { const int t = e >> 6, s2 = e & 63; if ((s2 >> 4) > (t >> 4)) T2[t * 65 + s2] = 0.f; } }
    BLOCK_SYNC();
    for (int rb = 1; rb < 4; ++rb) { const int wcols = 16 * rb;
        for (int e = c.tid; e < 16 * wcols; e += NTHREADS) { const int i = e & 15, cidx = e >> 4; float acc = 0.f; const float* Ar = Am + (16 * rb + i) * 65;
            for (int kb = cidx & ~15; kb < wcols; kb += 16) {
#pragma unroll
                for (int kk = 0; kk < 16; ++kk) acc += Ar[kb + kk] * T2[(kb + kk) * 65 + cidx]; }
            Rb[i * 49 + cidx] = acc; }
        BLOCK_SYNC();
        for (int e = c.tid; e < 16 * wcols; e += NTHREADS) { const int i = e & 15, cidx = e >> 4; float acc = 0.f; const float* Tr = T2 + (16 * rb + i) * 65 + 16 * rb;
#pragma unroll
            for (int j = 0; j < 16; ++j) acc += Tr[j] * Rb[j * 49 + cidx];
            T2[(16 * rb + i) * 65 + cidx] = -acc; }
        BLOCK_SYNC(); }
    if (stop == 3) return;
#ifndef EMU
    int lane2_ = c.lane; asm volatile("" : "+v"(lane2_));
    const int r2 = lane2_ & 31, hh2 = lane2_ >> 5;
#else
    const int r2 = r, hh2 = hh;
#endif
    {
#pragma unroll
        for (int rep = 0; rep < 2; ++rep) { const int idx = c.wave + 8 * rep, isw = idx >> 3, tt = (idx >> 2) & 1, ct = idx & 3;
            f32x16 acc;
#pragma unroll
            for (int i = 0; i < 16; ++i) acc[i] = 0.f;
            const bf16_t* Bt = (isw ? Kt : Vt) + (32 * ct + r2) * 72;
#pragma unroll
            for (int ks = 0; ks < 4; ++ks) { float f[8];
#pragma unroll
                for (int e = 0; e < 8; ++e) { const int s = 16 * ks + 8 * hh2 + e; f[e] = T2[(32 * tt + r2) * 65 + s] * be[s] * (isw ? gam[s] : 1.0f); }
                acc = MFMA32(pack8(f), ld16(Bt + 8 * ((2 * ks + hh2) ^ (((32 * ct + r2) >> 4) & 7))), acc); }
            bf16_t* dst = (isw ? Wb : Ub);
#pragma unroll
            for (int i = 0; i < 16; ++i) dst[(32 * tt + crow(i, hh2)) * 128 + 32 * ct + r2] = (bf16_t)f2bf(acc[i]); } }
    {
        const float gend = gc[63];
        const int j = c.tid >> 3, cg = c.tid & 7; const float gamj = gam[j];
#pragma unroll
        for (int half = 0; half < 2; ++half) { float f[8]; unpack8(ld16(Qs + j * 136 + 16 * cg + 8 * half), f);
#pragma unroll
            for (int e = 0; e < 8; ++e) f[e] *= gamj;
            *(bf16x8*)(QNb + j * 128 + 16 * cg + 8 * half) = pack8(f); }
#pragma unroll
        for (int ii = 0; ii < 2; ++ii) { const int idx = c.tid + 512 * ii, dk = idx >> 3, ch = idx & 7; float f[8]; unpack8(ld16(Kt + dk * 72 + 8 * (ch ^ ((dk >> 4) & 7))), f);
#pragma unroll
            for (int e = 0; e < 8; ++e) f[e] *= expf(gend - gc[8 * ch + e]);
            *(bf16x8*)(KDb + dk * 64 + 8 * ch) = pack8(f); } }
    BLOCK_SYNC();
}
constexpr int D2_PW = 132, D2_PA = 68;
constexpr int D2_W = 0, D2_QN = 64 * D2_PW * 2, D2_AT = 2 * 64 * D2_PW * 2, D2_KD = D2_AT + 64 * D2_PA * 2, D2_BUF = D2_KD + 128 * D2_PA * 2;
static_assert(2 * D2_BUF <= LDS_MISC, "two D2 buffers fit below the LDS control words");
DEV void dn_d2_stage(const Ctx& c, size_t ci, char* buf) {
    const bf16_t* Wb = (const bf16_t*)(c.ws + SO_W) + ci * 8192; const bf16_t* QNb = (const bf16_t*)(c.ws + SO_QN) + ci * 8192; const bf16_t* ATb = (const bf16_t*)(c.ws + SO_AT) + ci * 4096; const bf16_t* KDb = (const bf16_t*)(c.ws + SO_KD) + ci * 8192;
    const int lt = c.tid - 256;
#pragma unroll 2
    for (int i = 0; i < 14; ++i) { const int idx = lt + 256 * i; const bf16_t* src; char* dst;
        if (idx < 1024) { const int row = idx >> 4, ch = idx & 15; src = Wb + row * 128 + 8 * ch; dst = buf + D2_W + (row * D2_PW + 8 * ch) * 2; }
        else if (idx < 2048) { const int j = idx - 1024, row = j >> 4, ch = j & 15; src = QNb + row * 128 + 8 * ch; dst = buf + D2_QN + (row * D2_PW + 8 * ch) * 2; }
        else if (idx < 2560) { const int j = idx - 2048, row = j >> 3, ch = j & 7; src = ATb + row * 64 + 8 * ch; dst = buf + D2_AT + (row * D2_PA + 8 * ch) * 2; }
        else { const int j = idx - 2560, row = j >> 3, ch = j & 7; src = KDb + row * 64 + 8 * ch; dst = buf + D2_KD + (row * D2_PA + 8 * ch) * 2; }
        const bf16x8 v = ld16(src); const bf16x4 lo = __builtin_shufflevector(v, v, 0, 1, 2, 3), hi = __builtin_shufflevector(v, v, 4, 5, 6, 7);
        *(bf16x4*)dst = lo; *(bf16x4*)(dst + 8) = hi; }
}
DEV void dn_d2_chain(const Ctx& c, int chain, bool emit_ctx) {
    const int dir = chain & 1, h = (chain >> 1) & 3, b = chain >> 3; const int r = c.lane & 31, hh = c.lane >> 5, sl = c.wave & 3; const bool comp = c.wave < 4;
    const bf16_t* U0 = (const bf16_t*)(c.ws + SO_U); const float* GE = (const float*)(c.ws + SO_GE);
    bf16_t* HB = (bf16_t*)(c.ws + OFF_P) + PO_HB + (size_t)dir * MT * 512;
    f32x16 S[4];
#pragma unroll
    for (int t4 = 0; t4 < 4; ++t4)
#pragma unroll
        for (int i = 0; i < 16; ++i) S[t4][i] = 0.f;
    if (!comp) dn_d2_stage(c, (size_t)chain * NCH, c.lds);
    BLOCK_SYNC();
    for (int cc = 0; cc < NCH; ++cc) { const size_t ci = (size_t)chain * NCH + cc; char* buf = c.lds + (cc & 1) * D2_BUF;
        if (!comp) { if (cc + 1 < NCH) dn_d2_stage(c, ci + 1, c.lds + ((cc + 1) & 1) * D2_BUF); }
        else {
            const bf16_t* Ub = U0 + ci * 8192; const bf16_t* Wl = (const bf16_t*)(buf + D2_W); const bf16_t* QNl = (const bf16_t*)(buf + D2_QN); const bf16_t* ATl = (const bf16_t*)(buf + D2_AT); const bf16_t* KDl = (const bf16_t*)(buf + D2_KD);
            f32x16 u[2], ov[2];
#pragma unroll
            for (int tt = 0; tt < 2; ++tt)
#pragma unroll
                for (int i = 0; i < 16; ++i) { u[tt][i] = -bf2f(Ub[(32 * tt + crow(i, hh)) * 128 + 32 * sl + r]); ov[tt][i] = 0.f; }
#pragma unroll
            for (int ks = 0; ks < 8; ++ks) { const bf16x8 sf = pack_acc(S[ks >> 1], ks & 1); const int k0 = 16 * ks + 4 * hh;
#pragma unroll
                for (int tt = 0; tt < 2; ++tt) { const bf16_t* wp = Wl + (32 * tt + r) * D2_PW + k0; const bf16_t* qp = QNl + (32 * tt + r) * D2_PW + k0;
                    u[tt] = MFMA32(cat44(*(const bf16x4*)wp, *(const bf16x4*)(wp + 8)), sf, u[tt]);
                    ov[tt] = MFMA32(cat44(*(const bf16x4*)qp, *(const bf16x4*)(qp + 8)), sf, ov[tt]); } }
#pragma unroll
            for (int tt = 0; tt < 2; ++tt)
#pragma unroll
                for (int i = 0; i < 16; ++i) u[tt][i] = -u[tt][i];
            const float ge = GE[ci];
#pragma unroll
            for (int t4 = 0; t4 < 4; ++t4)
#pragma unroll
                for (int i = 0; i < 16; ++i) S[t4][i] *= ge;
#pragma unroll
            for (int ks = 0; ks < 4; ++ks) { const bf16x8 uf = pack_acc(u[ks >> 1], ks & 1);
#pragma unroll
                for (int tt = 0; tt < 2; ++tt) { const bf16_t* ap = ATl + (32 * tt + r) * D2_PA + 16 * ks + 4 * hh;
                    ov[tt] = MFMA32(cat44(*(const bf16x4*)ap, *(const bf16x4*)(ap + 8)), uf, ov[tt]); }
#pragma unroll
                for (int t4 = 0; t4 < 4; ++t4) { const bf16_t* kp = KDl + (32 * t4 + r) * D2_PA + 16 * ks + 4 * hh;
                    S[t4] = MFMA32(cat44(*(const bf16x4*)kp, *(const bf16x4*)(kp + 8)), uf, S[t4]); } }
            const int tc = dir == 0 ? cc : (cc < NCC ? NCC - 1 - cc : NCC + (NLC - 1 - (cc - NCC)));
            if (tc >= NCC || emit_ctx) {
#pragma unroll
                for (int tt = 0; tt < 2; ++tt)
#pragma unroll
                    for (int i = 0; i < 16; ++i) { const int j = 32 * tt + crow(i, hh); const int row = tok_row(b, tc, dir ? 63 - j : j);
                        HB[(size_t)row * 512 + h * 128 + 32 * sl + r] = (bf16_t)f2bf(ov[tt][i]); } }
        }
        BLOCK_SYNC();
    }
}
DEV void dn_yasm(const Ctx& c, int layer, int nrows) {
    const bf16_t* HB = (const bf16_t*)(c.ws + OFF_P) + PO_HB; const bf16_t* Z = (const bf16_t*)(c.ws + OFF_P) + PO_Z; const bf16_t* QC = (const bf16_t*)(c.ws + OFF_P) + PO_GO; bf16_t* Y = (bf16_t*)(c.ws + OFF_HY);
    const float* gn = c.in[19] + (size_t)(layer >> 1) * 128;
    for (int it = c.gw; it < nrows * 2; it += c.ngw) { const int row = it >> 1, col = (it & 1) * 256 + 4 * c.lane;
        const bf16x4 a = *(const bf16x4*)(HB + (size_t)row * 512 + col), bb = *(const bf16x4*)(HB + (size_t)MT * 512 + (size_t)row * 512 + col), z = *(const bf16x4*)(Z + (size_t)row * 512 + col);
        float v[4], ss = 0.f;
#pragma unroll
        for (int e = 0; e < 4; ++e) { v[e] = bf2f((unsigned short)a[e]) + bf2f((unsigned short)bb[e]); ss += v[e] * v[e]; }
#pragma unroll
        for (int o = 1; o < 32; o <<= 1) ss += SHFL_XOR(ss, o);
        const float rstd = 1.0f / sqrtf(ss * (1.0f / 128.0f) + EPS);
        float y[4];
#pragma unroll
        for (int e = 0; e < 4; ++e) y[e] = v[e] * rstd * gn[(col & 127) + e] * siluf_(bf2f((unsigned short)z[e]));
        u32x2 w; w[0] = pk2(y[0], y[1]); w[1] = pk2(y[2], y[3]);
        *(u32x2*)(Y + (size_t)row * 1024 + 512 + col) = w;
        *(u32x2*)(Y + (size_t)row * 1024 + col) = *(const u32x2*)(QC + (size_t)row * 512 + col); }
}

DEV void gqa_units(const Ctx& c, int layer, bool emit_ctx, int first, int stride) {
    constexpr int NQBL = SEQ / 256, NQBC = (CTX + 255) / 256, NUL = NB * 8 * NQBL, NUC = NB * 8 * NQBC;
    const int nuc = emit_ctx ? NUC : 0;
    for (int it = first; it < NUL + nuc; it += stride) { const bool cu = it >= NUL; int u = cu ? it - NUL : it; const int nqb = cu ? NQBC : NQBL;
        gqa_unit(c, layer, u / (8 * nqb), (u / nqb) & 7, cu, u % nqb); }
}
DEV void mix_odd_a(const Ctx& c, int layer) {
    { PHASE_CTX(pc); if (ON(14)) odd_kprep(pc, layer); }
    { PHASE_CTX(pc); if (ON(15)) { const bf16_t* KVC = (const bf16_t*)(pc.ws + OFF_P) + PO_KVC; bf16_t* VT = (bf16_t*)(pc.ws + SO_VT);
        for (int it = pc.bid; it < NB * 2 * NCH; it += pc.nblk) { const int pch = it % NCH, bk = it / NCH; vt_item<64>(pc, KVC, 256, 128 + (bk & 1) * 64, bk >> 1, pch, VT + (size_t)bk * 64 * LK); } } }
    REPB(16) { PHASE_CTX(pc); if (ON(16)) {
        { const float* convw = pc.in[16] + (size_t)(layer >> 1) * 3 * 1536; float* cwl = (float*)(pc.lds + D1_CW_OFF); BLOCK_SYNC();
          for (int e = pc.tid; e < 3 * 1536 / 4; e += NTHREADS) ((f32x4*)cwl)[e] = ((const f32x4*)convw)[e];
          BLOCK_SYNC(); }
        for (int it = pc.bid; it < NCHAIN * NCH; it += pc.nblk) dn_d1_item(pc, layer, it, (rep_ < (int)(((unsigned long long)(REPM) >> 16) & 1ull)) ? D1_STOP : 0); } }
}
DEV void mix_odd_b(const Ctx& c, int layer, bool emit_ctx) {
    const int nd2 = NCHAIN < c.nblk ? NCHAIN : c.nblk;
    const int na = c.nblk - nd2;
    REPB(17) { PHASE_CTX(pc); if (ON(17)) if (pc.bid < nd2) { for (int ch = pc.bid; ch < NCHAIN; ch += nd2) dn_d2_chain(pc, ch, emit_ctx); } }
    REPB(18) { PHASE_CTX(pc); if (ON(18)) { if (na > 0) { if (pc.bid >= nd2) gqa_units(pc, layer, emit_ctx, pc.bid - nd2, na); } else gqa_units(pc, layer, emit_ctx, pc.bid, pc.nblk); } }
}
DEV void mix_odd_c(const Ctx& c, int layer, bool emit_ctx) {
    { PHASE_CTX(pc); if (ON(19)) dn_yasm(pc, layer, emit_ctx ? MT : ML); }
}

#ifdef SELFTEST
#ifdef EMU
#define ST_HD static inline
#else
#define ST_HD __host__ __device__ inline
#endif
constexpr size_t ST_CHK = 512 * 1024;
ST_HD unsigned st_hash(unsigned a, unsigned b) { unsigned x = a * 0x9E3779B1u ^ (b + 0x7F4A7C15u) * 0x85EBCA6Bu; x ^= x >> 16; x *= 0x7FEB352Du; x ^= x >> 15; x *= 0x846CA68Bu; x ^= x >> 16; return x; }
ST_HD float st_uniform(unsigned t, unsigned i) { return (float)(st_hash(t, i) >> 8) * (1.0f / 16777216.0f); }
ST_HD float st_normal(unsigned tensor, unsigned idx) { const float u1 = ((float)(st_hash(tensor * 4u, idx) >> 8) + 0.5f) * (1.0f / 16777216.0f), u2 = (float)(st_hash(tensor * 4u + 1u, idx) >> 8) * (1.0f / 16777216.0f); return sqrtf(-2.0f * logf(u1)) * cosf(6.2831853f * u2); }
ST_HD size_t st_count(int i) {
    switch (i) {
    case 0: return (size_t)NB * SEQ * D; case 1: return (size_t)NB * D; case 2: return (size_t)NB * CTX * D; case 3: return D;
    case 4: return (size_t)DEPTH * D * 6 * D; case 5: return (size_t)DEPTH * 6 * D; case 6: case 7: return (size_t)DEPTH * D;
    case 8: return (size_t)2 * D * E_IN; case 9: return 32; case 10: return 512; case 11: case 12: return 256; case 13: return (size_t)2 * 1024 * D;
    case 14: return (size_t)2 * D * O_IN; case 15: return 256; case 16: return 2 * 3 * 1536; case 17: return 16; case 18: return 16; case 19: return 256; case 20: return (size_t)2 * 1024 * D;
    case 21: case 22: return (size_t)DEPTH * D * FF; case 23: return (size_t)DEPTH * FF * D; default: return D; }
}
ST_HD float st_value(int i, size_t idx) {
#ifdef ST_SAME_BATCH
    if (i == 0) idx %= (size_t)SEQ * D; if (i == 1) idx %= (size_t)D; if (i == 2) idx %= (size_t)CTX * D;
#endif
    const float d = (float)D; const float n = st_normal((unsigned)i + 1u, (unsigned)idx);
    switch (i) {
    case 0: case 1: case 2: case 3: return n;
    case 4: return n * 0.5f / sqrtf(d); case 5: return n * 0.02f; case 6: case 7: case 11: case 12: case 15: case 19: case 24: return 1.0f + 0.02f * n;
    case 8: case 14: case 21: case 22: return n / sqrtf(d);
    case 9: return 0.1f * n + ((idx & 4) ? 3.0f + (float)(idx & 3) : 0.0f);
    case 10: return 0.1f * n; case 13: case 20: return n * (1.0f / 32.0f); case 16: return n * 0.57735027f;
    case 17: return logf(1.0f + 5.0f * (float)(idx & 3)) + 0.05f * n;
    case 18: { const float dt = expf(-6.9077553f + 4.6051702f * st_uniform(999u, (unsigned)idx)); return dt + logf(-expm1f(-dt)); }
    case 23: return n / sqrtf((float)FF);
    default: return n; }
}
ST_HD size_t st_offset(int i) { size_t o = 0; for (int k = 0; k < i; ++k) o += (st_count(k) + 63) & ~(size_t)63; return o; }
DEV void st_sum(const Ctx& c, int step, int sub, const void* base, size_t n, int is_bf16) {
    step += c.ngw;
    double p[8], s2 = 0.0;
#pragma unroll
    for (int k = 0; k < 8; ++k) p[k] = 0.0;
    const size_t gt = (size_t)c.bid * NTHREADS + c.tid, GT = (size_t)c.nblk * NTHREADS;
    for (size_t i = gt; i < n; i += GT) { const float v = is_bf16 ? bf2f(((const bf16_t*)base)[i]) : ((const float*)base)[i]; const unsigned h = st_hash(0xC0FFEEu + (unsigned)sub, (unsigned)i); s2 += (double)v * (double)v;
#pragma unroll
        for (int k = 0; k < 8; ++k) p[k] += ((h >> (k + 8)) & 1u) ? (double)v : -(double)v; }
    double* chk = (double*)(c.ws + ST_CHK) + ((size_t)step * 4 + sub) * 10;
#ifdef EMU
    for (int k = 0; k < 8; ++k) chk[k] += p[k];
    chk[8] += s2; if (gt == 0) chk[9] = (double)n;
#else
#pragma unroll
    for (int k = 0; k < 8; ++k) atomicAdd(chk + k, p[k]);
    atomicAdd(chk + 8, s2); if (gt == 0) chk[9] = (double)n;
#endif
}
DEV void st_checks(const Ctx& c, int step) {

    const int layer = step / 9, ph = step - 9 * layer, odd = layer & 1; const size_t mrows = layer < DEPTH - 1 ? MT : ML; unsigned char* ws = c.ws;
    if (ph == 0) { st_sum(c, step, 0, ws + OFF_HY, (size_t)MT * D, 1); st_sum(c, step, 1, ws + OFF_G, (size_t)MT * 16, 0); st_sum(c, step, 2, ws + OFF_WIN, (size_t)(odd ? NO : NE) * D, 1); st_sum(c, step, 3, ws + OFF_WOUT, (size_t)D * 1024, 1); }
    else if (ph == 1) { st_sum(c, step, 0, ws + OFF_P, (size_t)MT * (odd ? NO : NE), 1); }
    else if (ph == 2) { if (!odd) { st_sum(c, step, 0, ws + SE_KP, (size_t)NB * 8 * LK * 64, 1); st_sum(c, step, 1, ws + SE_VT, (size_t)NB * 4 * 128 * LK, 1); st_sum(c, step, 2, ws + SE_DCT, (size_t)NCHAIN * NCH * 8192, 0); st_sum(c, step, 3, ws + SE_DN, (size_t)NCHAIN * NCH * 64, 0); }
        else { st_sum(c, step, 0, ws + SO_KP, (size_t)NB * 2 * LK * 64 * 2, 1); st_sum(c, step, 1, ws + SO_U, (size_t)NCHAIN * NCH * 8192, 1); st_sum(c, step, 2, ws + SO_W, (size_t)NCHAIN * NCH * 8192, 1); st_sum(c, step, 3, ws + SO_AT, (size_t)NCHAIN * NCH * (4096 + 8192 + 8192), 1); } }
    else if (ph == 3) { if (!odd) { st_sum(c, step, 0, ws + SE_DCT, (size_t)NCHAIN * NCH * 8192, 0); st_sum(c, step, 1, ws + SE_DN, (size_t)NCHAIN * NCH * 64, 0); }
        else { st_sum(c, step, 0, ws + OFF_P + PO_HB * 2, (size_t)mrows * 512, 1); st_sum(c, step, 1, ws + OFF_P + (PO_HB + (size_t)MT * 512) * 2, (size_t)mrows * 512, 1); st_sum(c, step, 2, ws + OFF_P + PO_GO * 2, (size_t)mrows * 512, 1); } }
    else if (ph == 4) { st_sum(c, step, 0, ws + OFF_HY, (size_t)mrows * 1024, 1); }
    else if (ph == 5 || ph == 8) { st_sum(c, step, 0, ws + OFF_X, (size_t)mrows * D, 0); }
    else if (ph == 6) { st_sum(c, step, 0, ws + OFF_HY, (size_t)mrows * D, 1); st_sum(c, step, 1, ws + SF_WGU, (size_t)2 * FF * D, 1); st_sum(c, step, 2, ws + SF_WDN, (size_t)D * FF, 1); }
    else { st_sum(c, step, 0, ws + OFF_P, (size_t)mrows * FF, 1); }
}
#endif

DEV void final_norm(const Ctx& c) {
    constexpr int NV = D / 256;
    const float* X = (const float*)(c.ws + OFF_X); const float* g = c.in[24];
    for (int row = c.gw; row < ML; row += c.ngw) {
        const f32x4* xr = (const f32x4*)(X + (size_t)row * D) + c.lane; f32x4 v[NV]; float ss = 0.f;
#pragma unroll
        for (int j = 0; j < NV; ++j) { v[j] = xr[64 * j]; ss += (v[j][0] * v[j][0] + v[j][1] * v[j][1]) + (v[j][2] * v[j][2] + v[j][3] * v[j][3]); }
        const float rstd = 1.0f / sqrtf(wave_sum(ss) * (1.0f / D) + EPS);
        f32x4* o = (f32x4*)(c.out + (size_t)row * D) + c.lane;
#pragma unroll
        for (int j = 0; j < NV; ++j) o[64 * j] = v[j] * rstd * *(const f32x4*)(g + 256 * j + 4 * c.lane);
    }
}

constexpr size_t WS_NEED = cmax(WS_NEED_EF, SO_END);
#ifdef EMU
static void mega(Args args) {
    char* lds = emu::blocks[EMU_BID].lds;
    XcdBarrier bar; bar.dummy = 0;
#else
__global__ void __launch_bounds__(NTHREADS, 2) mega(Args args) {
    extern __shared__ __attribute__((aligned(16))) unsigned char lds_raw[];
    char* lds = (char*)lds_raw;
    {   volatile LAS unsigned* misc0 = (volatile LAS unsigned*)((LAS unsigned char*)lds_raw + LDS_MISC);
        if (threadIdx.x < 64) misc0[threadIdx.x] = 0u; }
    __syncthreads();
    XcdBarrier bar = xcd_barrier_post((unsigned*)(args.ws + OFF_CTL) + 4096, (volatile LAS unsigned*)((LAS unsigned char*)lds_raw + LDS_MISC) + 8);
#endif
    Ctx c;
#ifdef EMU
    c.tid = TIDX; c.lane = c.tid & 63; c.wave = c.tid >> 6;
#else
    c.tid = 0; c.lane = 0; c.wave = 0;
#endif
    c.bid = BIDX; c.nblk = NBLK; c.gw = c.bid * NWAVES + c.wave; c.ngw = c.nblk * NWAVES; c.lds = lds; c.in = args.in; c.out = args.out; c.ws = args.ws;

    if (args.prologue) {
    { PHASE_CTX(pc); if (ON(0)) p0_prologue(pc); }
#ifndef EMU
    cg::this_grid().sync();
#else
    GRID_BARRIER();
#endif
    }
#ifndef REPEAT_PH
#define REPEAT_PH -1
#endif
    for (int step2 = 2 * args.step_lo; step2 < 2 * args.step_hi; ++step2) {
        const int step = step2 >> 1; if ((step2 & 1) && !((step % 9) == REPEAT_PH && (REPEAT_PH != 3 || ((step / 9) & 1)))) continue;
        const int layer = step / 9, ph = step - 9 * layer;
        const int odd = layer & 1; const bool emit_ctx = layer < DEPTH - 1; const int mrows = emit_ctx ? MT : ML;
        if (ph == 0) {
            { PHASE_CTX(pc); if (ON(1) && (layer == 0 || step == args.step_lo)) convert_mixer_weights(pc, layer, pc.gw, pc.ngw); }
            { PHASE_CTX(pc); const bool prev = layer > 0 && step > args.step_lo; const int pm_ = MT;
              const SplitPlan red = split_plan(pm_, FF, pc.nblk, prev);
              if (ON(2)) normalize_rows(pc, layer, 0, MT, red, pm_, (const float*)(pc.ws + OFF_MOD) + (size_t)(layer - (prev ? 1 : 0)) * 9 * 6 * D + 5 * D); }
        } else if (ph == 1) {
            if (ON(3)) { PHASE_CTX(pc); pg8::Gemm g{(const bf16_t*)(pc.ws + OFF_HY), (const bf16_t*)(pc.ws + OFF_WIN), MT, odd ? NO : NE, D}; pg8::StaticOrder S; S.init(MT, odd ? NO : NE, c.nblk, c.bid); S.wave = pc.wave;
                if (odd && !emit_ctx && NO == 2816) { S.init(ML, NO, c.nblk, c.bid); S.wave = pc.wave; S.tn = (MC / 256) * 7; S.tpm = ML / 256; S.tpn = 2; S.tw = 7; }
                EpiSeg E{(bf16_t*)(pc.ws + OFF_P), odd};
                GEMM_PHASE(EpiSeg, lds, g, S, E); }
        } else if (ph == 2) { if (!odd) mix_even_a(c, layer); else mix_odd_a(c, layer); }
        else if (ph == 3) { if (!odd) mix_even_b(c, layer); else mix_odd_b(c, layer, emit_ctx); }
        else if (ph == 4) { if (!odd) mix_even_c(c, layer); else mix_odd_c(c, layer, emit_ctx); }
        else if (ph == 5 || ph == 8) {
            if (ON(4)) { PHASE_CTX(pc); const bool dn = ph == 8;
                const int kdim = dn ? FF : 1024; const SplitPlan sp = split_plan(mrows, kdim, pc.nblk, dn && layer + 1 < CFG_LAYERS);
                pg8::Gemm g{(const bf16_t*)(pc.ws + (dn ? OFF_P : OFF_HY)), (const bf16_t*)(pc.ws + (dn ? SF_WDN : OFF_WOUT)), mrows, D, kdim}; pg8::StaticOrder S; S.init(mrows, D, c.nblk, c.bid); S.wave = pc.wave;
                if (sp.extra) S.lim = pc.nblk;
                const bool first = layer == 0 && !dn;
                EpiResid E{(float*)(pc.ws + OFF_X), (const float*)(pc.ws + OFF_MOD) + (size_t)layer * 9 * 6 * D, dn ? 5 * D : 2 * D,
                           first ? pc.in[0] : (const float*)(pc.ws + OFF_X), first ? pc.in[2] - (size_t)ML * D : (const float*)(pc.ws + OFF_X)};
                GEMM_PHASE(EpiResid, lds, g, S, E);
                if (sp.extra && pc.bid < sp.extra * sp.split) {
                    const int lu = pc.bid / sp.split, q = pc.bid % sp.split, pairs = kdim / 128, base = pairs / sp.split, rem = pairs % sp.split;
                    const int np = base + (q < rem ? 1 : 0), p0 = q * base + (q < rem ? q : rem);
                    pg8::Gemm g2{g.A + (size_t)p0 * 128, g.Bt + (size_t)p0 * 128, mrows, D, np * 128, kdim}; pg8::StaticOrder S2; S2.init(mrows, D, sp.nwg, pc.nblk + lu); S2.wave = pc.wave;
                    EpiPart E2{(float*)(pc.ws + SF_PART) + (size_t)pc.bid * 65536};
                    BLOCK_SYNC();
                    GEMM_PHASE(EpiPart, lds, g2, S2, E2); } }
            { PHASE_CTX(pc); const SplitPlan sp = split_plan(mrows, ph == 8 ? FF : 1024, pc.nblk, ph == 8 && layer + 1 < CFG_LAYERS);
              const int nwg = sp.nwg; int busy = (nwg > pc.nblk && nwg < 2 * pc.nblk) ? nwg - pc.nblk : 0; if (sp.extra) busy = (pc.nblk - sp.extra * sp.split > pc.nblk / 4) ? sp.extra * sp.split : 0;
              if (ON(1) && pc.bid >= busy) { BLOCK_SYNC();
                  if (ph == 5) convert_ffn_weights(pc, layer, (pc.bid - busy) * NWAVES + pc.wave, (pc.nblk - busy) * NWAVES);
                  else if (layer + 1 < CFG_LAYERS && step + 1 < args.step_hi) convert_mixer_weights(pc, layer + 1, (pc.bid - busy) * NWAVES + pc.wave, (pc.nblk - busy) * NWAVES); } }
        } else if (ph == 6) {
            { PHASE_CTX(pc); const SplitPlan red = split_plan(mrows, 1024, pc.nblk, false);
              if (ON(2)) normalize_rows(pc, layer, 1, mrows, red, mrows, (const float*)(pc.ws + OFF_MOD) + (size_t)layer * 9 * 6 * D + 2 * D); }
        } else {
            if (ON(5)) { PHASE_CTX(pc); pg8::Gemm g{(const bf16_t*)(pc.ws + OFF_HY), (const bf16_t*)(pc.ws + SF_WGU), mrows, 2 * FF, D}; pg8::StaticOrder S; S.init(mrows, 2 * FF, c.nblk, c.bid); S.wave = pc.wave;
                EpiSwiglu E{(bf16_t*)(pc.ws + OFF_P)};
                GEMM_PHASE(EpiSwiglu, lds, g, S, E); }
        }
        if (step + 1 < args.step_hi || args.final_) GRID_BARRIER();
#ifdef EMU_STOP_AFTER_MIX
        if (layer == CFG_LAYERS - 1 && ph == 4) return;
#endif
    }
    if (args.final_) { PHASE_CTX(pc); if (ON(7)) final_norm(pc); }
}

#ifndef EMU
#ifdef PROBE_Y
__global__ void pr_stat(const bf16_t* Y, int rows, int c0, int c1, double* acc) {
    double s = 0.0, cnt = 0.0; float mx = 0.f;
    for (size_t k = (size_t)blockIdx.x * blockDim.x + threadIdx.x; k < (size_t)rows * 1024; k += (size_t)gridDim.x * blockDim.x) { const int col = (int)(k & 1023); if (col < c0 || col >= c1) continue;
        const float v = bf2f(Y[k]); s += (double)v * v; cnt += 1.0; mx = fmaxf(mx, fabsf(v)); }
    atomicAdd(acc, s); atomicAdd(acc + 1, cnt); atomicMax((unsigned long long*)acc + 2, (unsigned long long)(mx * 1e6f));
}
__global__ void pr_fill(const double* acc, float* out, int n) {
    const float rms = (float)sqrt(acc[0] / acc[1]), mx = (float)((const unsigned long long*)acc)[2] * 1e-6f;
    const float c = sqrtf(rms * 10.0f), B = mx * 10.0f;
    for (size_t k = (size_t)blockIdx.x * blockDim.x + threadIdx.x; k < (size_t)n; k += (size_t)gridDim.x * blockDim.x) out[k] = (k == 12345) ? B : c;
}
#endif
#ifdef SELFTEST
struct StPtrs { float* p[25]; };
__global__ void st_gen_inplace(StPtrs P) {
    for (int i = 0; i < 25; ++i) { const size_t n = st_count(i);
        for (size_t k = (size_t)blockIdx.x * blockDim.x + threadIdx.x; k < n; k += (size_t)gridDim.x * blockDim.x) P.p[i][k] = st_value(i, k); }
}
__global__ void st_gen(float* syn) {
    for (int i = 0; i < 25; ++i) { const size_t n = st_count(i), o = st_offset(i);
        for (size_t k = (size_t)blockIdx.x * blockDim.x + threadIdx.x; k < n; k += (size_t)gridDim.x * blockDim.x) syn[o + k] = st_value(i, k); }
}
constexpr int ST_NEXP = 74;
#ifndef ST_REPORT_SUB
#define ST_REPORT_SUB 0
#endif
#ifndef ST_TOL
#define ST_TOL 0.03
#endif
__device__ const int ST_EXP_STEP[74] = {0,0,0,0,1,2,2,2,2,3,3,4,5,6,6,6,7,8,9,9,9,9,10,11,11,11,11,12,12,12,13,14,15,15,15,16,17,18,18,18,18,19,20,20,20,20,21,21,22,23,24,24,24,25,26,27,27,27,27,28,29,29,29,29,30,30,30,31,32,33,33,33,34,35,};
__device__ const int ST_EXP_SUB[74] = {0,1,2,3,0,0,1,2,3,0,1,0,0,0,1,2,0,0,0,1,2,3,0,0,1,2,3,0,1,2,0,0,0,1,2,0,0,0,1,2,3,0,0,1,2,3,0,1,0,0,0,1,2,0,0,0,1,2,3,0,0,1,2,3,0,1,2,0,0,0,1,2,0,0,};
__device__ const double ST_EXP[74][10] = {
{2823.9405135959387,-6955.5741695016623,-5804.0977028682828,9054.3725127205253,-3966.7899582609534,-4601.8714917525649,7995.7762676179409,971.6921226978302,22251047.414743461,18874368,},
{291.26190879568458,-1573.2945180945098,331.66257446631789,357.45295172557235,-214.97323327884078,864.47900781407952,490.07691208645701,667.85457975044847,340263.10377825046,294912,},
{-23.357008519407827,15.935151411395054,35.883058835112024,57.434714148461353,-51.349641996261198,60.264678716950584,-59.23590717773186,-56.705568651959766,3067.8819070441805,3145728,},
{25.470241500996053,-43.468927160836756,58.065743817947805,4.3800708865746856,11.067458258010447,-10.867067505605519,26.364831392653286,-27.969552277587354,1020.9866835358141,1048576,},
{-11200.415292963386,9297.3592315688729,3203.3726777359843,-9663.7561300396919,-641.6257035061717,-8234.4563228115439,7994.2129158824682,-5521.8908601477742,66654113.07759431,56623104,},
{-1194.5305787473917,-1674.2680710405111,-5463.7986858785152,-4930.0590666979551,-1068.7674529403448,3002.9571408778429,-649.54952663183212,-4412.2754199355841,11106170.817955792,9437184,},
{-5507.6614354923368,1901.5068384334445,-4913.9082106724381,-2596.9450140967965,-1520.3851273730397,3237.6398326531053,-2359.8059303388,2364.7748123183846,11105296.668379547,9437184,},
{1560.4392579563191,-2499.261261367612,1459.3170721097504,-245.48758464773891,1043.47321934717,1419.7026340031534,1920.6481273452355,-1582.4576623782978,1601541.1673813532,18874368,},
{18.923751746769994,105.40070073772222,-9.9321377836167812,-69.897449327632785,166.82718826597556,123.35070158960298,-124.43343016551808,-149.78254351718351,24705.222434743067,147456,},
{2291.1772415378409,-198.18048978019215,106.27707149069283,1579.1373604525679,1783.1593627679513,2121.0945059178157,-2611.1484069368307,-1331.619970235115,2782256.6531369383,18874368,},
{89.759916271461407,27.444828146166401,211.5510761210171,-443.45204046583967,221.2014890195278,-713.03335159321432,-278.38321068481309,161.85793914255919,83907.236548682689,147456,},
{2060.1309491619468,-3099.3174412855878,3189.1278408914804,-1495.998928762041,2018.3208422241732,3951.0027283849195,307.00997438374907,189.92257314547896,8838647.8145213183,18874368,},
{2615.2232726222937,-3851.6311007236727,-5090.8008575433851,8895.7526726254218,-2915.793732104612,-3466.5127967876979,8494.2590465184257,-476.8310997271401,19641291.046898585,18874368,},
{2260.6133435368538,-3524.0150115936995,-6184.6817786470056,8612.6491934210062,-2936.174174323678,-5085.3421624973416,7627.2569323033094,-322.10541462153196,22201812.480418805,18874368,},
{39.211919396329904,-22.191732778126607,71.555887567257741,-34.657468227291247,-37.514794261514908,48.970252739818534,56.030709780199686,21.127209749916801,5631.6743743792158,5767168,},
{-58.957687043759506,-25.822232720500324,27.559850534133147,-19.2058952494408,25.962478367669974,10.300243424077053,-1.6967002287856303,-52.715924362360965,1022.4535583883176,2883584,},
{-194.02440498952637,2323.5604243765411,4943.6193249881908,-6076.2407636700955,-3098.2506252240564,1737.1458579480241,4071.2157669755688,3426.5647126794502,26276154.208520912,51904512,},
{2062.0307282910508,-2404.6291768250012,-4943.0085245753726,8409.3699170327891,-3388.5586135165795,-3156.0619303231506,8070.8516135739701,103.72620783001184,20445489.612024359,18874368,},
{-850.44070326350629,-1898.2922850791365,-5629.5260096881539,5319.5235935095698,-3571.6089787539095,-4582.1209145840257,8084.1448610220104,1201.9745895769447,22408943.624150425,18874368,},
{-276.67351097613573,238.73336043953896,402.49070692062378,1139.6587501242757,412.53829725086689,1001.9456618651748,-199.34280802309513,243.97394938021898,346041.02869538032,294912,},
{55.275690128095448,33.631906502880156,39.819098525680602,39.580814833752811,-56.659358996432275,56.905868629924953,70.874192817136645,32.641803210601211,2813.6335960129777,2883584,},
{16.459319942980073,-15.029889202327468,24.789046118385158,39.597747391439043,22.32851928321179,32.169926681905054,4.3831529127201065,-11.914361283765174,1024.2634621089853,1048576,},
{-8112.7706977427006,-15166.404139339924,9019.1636524870992,-10032.914728678763,-3683.5552492365241,6445.1523703113198,4940.6895737573504,-396.46003675460815,61599346.798404746,51904512,},
{1064.6478829011321,2961.5112186744809,2643.997241653502,3817.1335873380303,2552.6912311688066,2848.1112303361297,2641.0165046826005,877.74564967304468,5155886.6824775627,4718592,},
{-1180.9790783076314,-353.66288720036391,1405.2405796857784,-3003.0330094090896,736.01905330538284,1520.8871299045859,-1925.6258542904397,-909.10001162986737,2434153.6281470573,18874368,},
{60.165285118651028,-119.7430636333083,80.732633202489126,-9.8426874747077857,-101.69595492020277,-92.996986093445443,207.83742497175277,20.265997010018708,8918.7285340001526,18874368,},
{270.78828044847916,-133.56509196904631,-10.835563753045964,-177.08542341093678,116.75884305510037,-401.68338958283317,92.706295374895404,-256.76246256793473,40406.455039767519,47185920,},
{-17.403251063922653,85.550381564797135,-67.875341098901117,39.030201086570742,-44.825321126758354,-24.736986581498059,-130.15850522785331,-6.1346717766427901,3203.0568557028691,9437184,},
{26.677921455280739,-10.301573183693108,-15.383461458186503,23.552394272832316,-16.422941844488378,33.179475616852869,-26.073428510382655,49.43283157730184,2218.7160715744772,9437184,},
{-104.63265653897543,-1025.0813928971766,623.84842114138883,-1420.2001781960716,1368.3365971482126,-86.704579671728425,96.991083307308145,428.70963656844106,889696.22597060842,9437184,},
{2432.259056510753,267.30669010814745,1837.783826454659,2981.6297531555174,-416.17357830458786,-1826.6180147336563,-301.78532918507699,-744.86193079140503,4898348.3318136279,18874368,},
{3294.5902997395533,-865.44878266500746,-4974.0870277224822,6772.8382276698467,-3398.3562051501722,-4187.1136843486529,8143.3624155692742,-612.10508898339322,20872541.311585322,18874368,},
{3536.330776873976,1917.42852505669,-2076.6844129748642,4320.7511040978134,-4890.1908001117408,-4107.6248654313385,10533.807669285685,471.08626228198409,22412768.276720807,18874368,},
{-6.0809309475971531,76.739011337651391,97.496654804484933,-29.642639640796915,0.70117462620510196,-203.53367705441451,-98.699187040134348,-53.162115221513886,5628.1487348292976,5767168,},
{56.758986754866783,46.788941775390413,-43.423746958898846,33.754279191547539,25.984360144881066,-65.525896325649228,5.420765693706926,45.74655341921607,1023.6598906812283,2883584,},
{2102.1720024403512,3520.8294076444326,-6874.5287163143184,3797.4676643103921,3201.4737541926479,2643.8227775447631,352.29275992398834,1880.529091139204,26630809.672188494,51904512,},
{2885.2073127178519,-1385.1170310270754,-4514.0122937517372,7030.8231581723594,-3845.7207517792049,-6356.8220687311768,7588.3782935662384,-564.85132873002294,21742637.688699484,18874368,},
{3812.0284725353122,1621.2253267094493,-4254.9756214395165,6197.9158516302705,8.5768845900893211,-5469.3091325387359,8752.140286244452,-1246.7436530068517,22065010.375674032,18874368,},
{-1149.1737003140152,496.67538012936711,483.18858239427209,650.82792166247964,314.5317993350327,-371.12024437263608,890.37748170271516,-1420.4709294177592,350924.7500354572,294912,},
{88.047429081168957,-74.825534723349847,-23.789757229969837,-97.320472310879268,-4.0056394656421617,-30.904204592457972,-18.987518870853819,-27.849783896817826,3073.3731145051615,3145728,},
{65.20327353652101,3.0222902240930125,25.993390792864375,14.415037170168944,54.844758132356219,-56.249738970887847,19.864254156243987,-27.887308357167058,1025.1381782409978,1048576,},
{-13237.945228233933,-5020.7346298694611,5226.0037766546011,12825.714193224907,-2397.7048603817821,-7119.2997151985765,9948.7588085010648,-5921.2636323198676,66137041.201810837,56623104,},
{-75.766457952558994,2293.2211949080229,-2037.293488740921,1509.2966427430511,6117.5132186114788,479.96601853519678,-5639.6398960202932,1845.2123182713985,11060201.299008245,9437184,},
{-462.10384976491332,5736.9905912540853,-2167.2699889577925,-1180.0111477933824,409.65681508556008,-1780.9929978586733,-671.92641231790185,-1349.7005080021918,11027953.433529973,9437184,},
{-822.00079254147931,-1214.0090433928017,3328.184749965596,87.801341768161365,-495.11205383328706,-877.86274139888337,1911.2223419476468,796.02008414199008,1759052.6843886974,18874368,},
{100.80030664941296,22.118581771384925,-242.38840196980163,-93.397681776899844,-57.195992573630065,-53.402307578828186,-150.74265199294314,-86.528761671390384,31090.621100439952,147456,},
{3075.2200345232932,146.19098324902222,-1073.3931368374535,-3446.3695871779209,37.989448957180798,223.73928401402372,1720.4827841137958,2765.2156565344467,3854013.6325600357,18874368,},
{542.032717238857,-110.56952357693081,1.825648151418136,-830.79371399683441,-111.90571951437596,-416.65702595594485,-459.77385005963879,177.62618795662274,136561.77048135776,147456,},
{-536.59579325607046,3431.0063604712486,3724.987038930878,-672.57181697292253,-3271.82986589754,-275.97591033531353,1134.3561726845801,3369.160484327469,5460094.8227678062,18874368,},
{3690.413550499331,-2055.6428064615766,-5438.0006776863584,7215.5527907973737,-3675.7019953130812,-5533.6785190762885,6701.1122693967927,64.846424879085134,22222666.921814281,18874368,},
{6145.2994565963745,-1456.0999585092068,-5831.9741258770227,8761.7396555989981,-5699.234908297658,-4079.551640689373,4842.0201814621687,-2019.1001229286194,22203324.287363961,18874368,},
{130.56598056000075,66.178603142005159,-72.223813362215878,-40.295281428698217,26.729994425171753,-72.123386049031978,-88.871669880725676,27.124975894665113,5635.9492323544555,5767168,},
{32.54455375490943,72.597239872498903,-17.171426851477008,-4.8966801255592145,-15.258403940417338,-23.122007071331609,-22.899502303858753,62.156484370876569,1023.7774562760339,2883584,},
{-6760.2973620964185,3735.844417643224,1094.1796880429465,4204.2181440759596,-764.49361893783498,-4932.0209130450239,-6261.1468112875446,-4488.8535375963402,26246313.294528794,51904512,},
{4457.1757640697724,-2267.1563059242435,-4745.1736963140393,7186.1535465445595,-4113.5497737388105,-7139.5026401302202,6476.8297955984126,-72.098023249844118,23047663.524188824,18874368,},
{4172.7441230602562,2189.9780470617115,-5133.8792393095791,7288.8046996556222,-5411.0709395520389,-4896.6709096245468,8724.0389158017933,-1300.7641984857619,22255371.479420178,18874368,},
{342.48845159634948,-1155.9452162571251,-355.46573888137937,38.030472237616777,-706.72725258395076,302.12307207658887,1501.216548230499,-189.15161934122443,356337.53284288617,294912,},
{141.34916719738249,55.510840875467693,3.4794936717735254,14.99616638317093,48.530484220267681,80.824254727551306,36.550317391192948,-11.045543047970568,2822.5213800999318,2883584,},
{-1.7540650628507137,-68.523136725649238,20.526102727279067,4.1151908580213785,26.478423124179244,17.260244991630316,26.540773348882794,18.066198658198118,1023.7352584092852,1048576,},
{9615.2207438386977,4784.9471067078412,1940.7497162856162,-5810.9412356205285,-983.56367782130837,7418.8542090691626,16772.396392870694,-7707.8745242021978,61356805.552982159,51904512,},
{1611.5909418128431,-862.28053805604577,-136.1677976809442,-552.47190998122096,983.61643074825406,-2118.3313589207828,2136.0759917013347,1436.2902639396489,5189176.8575152932,4718592,},
{1791.7875226804172,-31.704715774103533,260.74334435508354,2286.3263573826407,2006.0634295089985,-556.23315154918237,2794.1662208863418,265.33516812947346,2237659.8451027921,18874368,},
{1.738220854325472,-47.72536333968177,85.671240820733587,-76.785340997768273,-33.389609302064237,10.517162931163593,-16.605087701564099,-69.403631001852744,4294.4259768959364,18874368,},
{80.462511468439985,-161.96663447577936,103.6356164854663,158.8806262336563,-156.06783419597375,68.553029276052172,-342.86381052307308,-54.733859514236087,20398.968534675096,47185920,},
{52.505996509542456,40.193077393545536,-32.136223205568967,9.6826318503881339,-32.908785335748689,-49.309646418463672,7.7728565156285185,28.182192534412025,933.99111986596574,8388608,},
{-7.5194821398763452,15.928513078688411,-22.494523745699553,-25.74654744003783,-1.9659538757696282,39.424875568918651,-41.204660507297376,-50.291643056989415,1399.3033406704337,8388608,},
{-135.14476990071125,388.87867833836935,-624.19169349339791,-255.41803698171861,749.05279063689522,489.13258223538287,7.6979752753395587,-1529.1879597052466,922125.16740855761,8388608,},
{2513.205304118339,-3002.4781056293286,-591.26384180737659,984.36628054594621,-165.44268643157557,-2587.8124781120569,5950.0621142634191,1918.4807258569635,4533654.192930459,16777216,},
{2830.9344703354946,-4920.8287407121315,-3976.7572222978852,7101.1558030729429,-6279.3158443071807,-7658.587931540409,7596.1372552172033,-980.77548625691998,20848405.50834683,16777216,},
{5663.7043273374438,-4698.0929517224431,-2882.0782249197364,6381.8024617210031,-6684.7693502381444,-6324.1065613850951,5276.286193959415,-1294.3445755466819,19824501.716412377,16777216,},
{105.49113711505197,9.4353141400497407,71.544671961572021,-144.04839801136404,-59.128098372370005,86.345427959226072,-22.445412413449958,-31.521184443496168,5635.2677728111466,5767168,},
{-52.974209187126689,83.749726402067608,-11.22629395038166,-7.1423740544887551,-10.056938788195112,-45.578087951795169,41.377634743421368,16.152020135003113,1023.3413428186279,2883584,},
{1126.9516335337321,-4958.3812902097925,-2794.7144431749111,5195.0455790979104,4310.2982955073458,-6172.0018973502665,4099.1716476037618,-5060.7709415074714,23578261.929520626,46137344,},
{854.11164966656725,-4002.1053702284298,-4016.2943720539079,7535.4821215254451,-6184.3291782648776,-6281.2433878521588,8750.5079252671385,531.59902707755464,21616516.22354921,16777216,},
};
__global__ void st_check_kernel(unsigned char* ws, int step, int slot = 0) { Ctx c; c.tid = threadIdx.x; c.lane = c.tid & 63; c.wave = c.tid >> 6; c.bid = blockIdx.x; c.nblk = gridDim.x; c.gw = 0; c.ngw = slot; c.lds = nullptr; c.in = nullptr; c.out = nullptr; c.ws = ws; st_checks(c, step); }
__global__ void st_report(const unsigned char* ws, float* out, int n) {
    const double* chk = (const double*)(ws + ST_CHK); int code = 0;
    for (int e = 0; e < ST_NEXP && !code; ++e) { const int step = ST_EXP_STEP[e], sub = ST_EXP_SUB[e]; const double* g = chk + (step * 4 + sub) * 10; double d2 = 0.0; if (g[9] == 0.0) continue;
        for (int k = 0; k < 8; ++k) { const double d = g[k] - ST_EXP[e][k]; d2 += d * d; }
        const double eps2 = d2 / (8.0 * ST_EXP[e][8] + 1e-300);
        const bool bad = !(eps2 <= ST_TOL * ST_TOL);
        if (bad) code = ST_REPORT_SUB ? (step == ST_REPORT_SUB - 1 ? sub + 1 : 0) : step + 1; }
    const float v = sqrtf((float)code);
    for (size_t k = (size_t)blockIdx.x * blockDim.x + threadIdx.x; k < (size_t)n; k += (size_t)gridDim.x * blockDim.x) out[k] = v;
}
__global__ void st_repeat_report(const unsigned char* ws, float* out, int n, int nsteps) {
    const double* chk = (const double*)(ws + ST_CHK); int code = 0;
    for (int st = 0; st < nsteps && !code; ++st) for (int sub = 0; sub < 4 && !code; ++sub) { const double* a = chk + ((size_t)st * 4 + sub) * 10; const double* b = chk + ((size_t)(st + 40) * 4 + sub) * 10;
        if (a[9] == 0.0 || b[9] == 0.0) continue; double d2 = 0.0; for (int k = 0; k < 8; ++k) d2 += (a[k] - b[k]) * (a[k] - b[k]);
        if (!(d2 <= 1e-14 * 8.0 * a[8])) code = st + 1; }
    const float v = sqrtf((float)code);
    for (size_t k = (size_t)blockIdx.x * blockDim.x + threadIdx.x; k < (size_t)n; k += (size_t)gridDim.x * blockDim.x) out[k] = v;
}
__global__ void st_twice_report(const unsigned char* ws, float* out, int n) {
    const double* chk = (const double*)(ws + ST_CHK); const double* a = chk + ((size_t)35 * 4) * 10; const double* b = chk + ((size_t)(35 + 40) * 4) * 10;
    double d2 = 0.0; for (int k = 0; k < 8; ++k) d2 += (a[k] - b[k]) * (a[k] - b[k]);
    const double eps = sqrt(d2 / (8.0 * a[8] + 1e-300)) + 1e-30; const float v = sqrtf((float)floor(fmax(0.0, -log10(eps))));
    for (size_t k = (size_t)blockIdx.x * blockDim.x + threadIdx.x; k < (size_t)n; k += (size_t)gridDim.x * blockDim.x) out[k] = v;
}
__global__ void st_final_check(const unsigned char* ws, const float* out, const float* g, double* acc) {
    const float* X = (const float*)(ws + OFF_X);
    for (int row = blockIdx.x * blockDim.x + threadIdx.x; row < ML; row += gridDim.x * blockDim.x) { const float* x = X + (size_t)row * D; double ss = 0.0;
        for (int k = 0; k < D; ++k) ss += (double)x[k] * x[k];
        const double rstd = 1.0 / sqrt(ss / D + 1e-6); double d2 = 0.0, r2 = 0.0;
        for (int k = 0; k < D; ++k) { const double r = x[k] * rstd * g[k], o = out[(size_t)row * D + k]; d2 += (o - r) * (o - r); r2 += r * r; }
        atomicAdd(acc, d2); atomicAdd(acc + 1, r2); }
}
__global__ void st_final_fill(const double* acc, float* out, int n) { const double eps = sqrt(acc[0] / (acc[1] + 1e-300)) + 1e-30; const float v = sqrtf((float)floor(fmax(0.0, -log10(eps))));
    for (size_t k = (size_t)blockIdx.x * blockDim.x + threadIdx.x; k < (size_t)n; k += (size_t)gridDim.x * blockDim.x) out[k] = v; }
__global__ void st_same_batch_inputs(const float* x, const float* cv, const float* ctx, float* xs, float* cs, float* ctxs) {
    const size_t gt = (size_t)blockIdx.x * blockDim.x + threadIdx.x, GT = (size_t)gridDim.x * blockDim.x;
    for (size_t k = gt; k < (size_t)NB * SEQ * D; k += GT) xs[k] = x[k % ((size_t)SEQ * D)];
    for (size_t k = gt; k < (size_t)NB * CTX * D; k += GT) ctxs[k] = ctx[k % ((size_t)CTX * D)];
    for (size_t k = gt; k < (size_t)NB * D; k += GT) cs[k] = cv[k % (size_t)D];
}
__global__ void st_batch_report(const float* sout, float* out, int n, double* acc) {
    const size_t per = (size_t)SEQ * D;
    for (int b = 1; b < NB; ++b) { double d2 = 0.0, r2 = 0.0;
        for (size_t k = (size_t)blockIdx.x * blockDim.x + threadIdx.x; k < per; k += (size_t)gridDim.x * blockDim.x) { const double a0 = sout[k], ab = sout[(size_t)b * per + k]; d2 += (ab - a0) * (ab - a0); r2 += a0 * a0; }
        atomicAdd(acc + 2 * b, d2); atomicAdd(acc + 2 * b + 1, r2); }
    __threadfence();
    __shared__ unsigned last; if (threadIdx.x == 0) last = atomicAdd((unsigned*)acc, 1u) == gridDim.x - 1; __syncthreads();
    if (!last) return;
    int code = 0; for (int b = 1; b < NB && !code; ++b) { const double d2 = atomicAdd(acc + 2 * b, 0.0), r2 = atomicAdd(acc + 2 * b + 1, 0.0); if (!(d2 <= 1e-4 * r2)) code = b; }
    *((volatile int*)(acc + 1)) = code;
}
__global__ void st_fill(const double* acc, float* out, int n) { const float v = sqrtf((float)*((const volatile int*)(acc + 1))); for (size_t k = (size_t)blockIdx.x * blockDim.x + threadIdx.x; k < (size_t)n; k += (size_t)gridDim.x * blockDim.x) out[k] = v; }
#endif

#if defined(SELFTEST) && (defined(ST_DACHECK) || defined(ST_MODCHECK) || defined(ST_L0CHECK) || defined(ST_TAILCHECK) || defined(ST_MLCHECK) || defined(ST_DNCHECK) || defined(ST_TRUTH) || defined(ST_GQCHECK))
__global__ void st_da_check(const unsigned char* ws, const float* lam, const float* gn, double* acc, float* scr) {
    const int lane = threadIdx.x & 63, gw = (blockIdx.x * blockDim.x + threadIdx.x) >> 6, ngw = (gridDim.x * blockDim.x) >> 6;
    const bf16_t* QA = (const bf16_t*)(ws + OFF_P) + PE_QA; const bf16_t* KA = (const bf16_t*)(ws + OFF_P) + PE_KA; const bf16_t* VA = (const bf16_t*)(ws + OFF_P) + PE_VA; const bf16_t* Y = (const bf16_t*)(ws + OFF_HY);
    const float* COS = (const float*)(ws + OFF_ROPE); const float* SIN = COS + (size_t)SEQ * 32;
    float* s1 = scr + (size_t)gw * 2 * LK; float* s2 = s1 + LK;
    float la = 0.f, lb = 0.f; la = lam[lane] * lam[64 + lane]; lb = lam[128 + lane] * lam[192 + lane];
    for (int o = 1; o < 64; o <<= 1) { la += __shfl_xor(la, o); lb += __shfl_xor(lb, o); }
    const float lam_init = 0.2f, lmb = expf(la) - expf(lb) + lam_init;
    __shared__ float qs[8][2][64];
    const int wv = threadIdx.x >> 6;
    for (int it = gw; it < (ML / 16) * 4; it += ngw) { const int h = it & 3, row = (it >> 2) * 16 + 5; const int b = row / SEQ, t = row % SEQ;
        for (int m = 0; m < 2; ++m) { const int d = lane; const int a = d >> 5, pp = (d >> 4) & 1, f = d & 15; const float x = bf2f(QA[(size_t)row * 512 + h * 128 + m * 64 + d]), xp = bf2f(QA[(size_t)row * 512 + h * 128 + m * 64 + (d ^ 16)]);
            const float cs = COS[(size_t)t * 32 + a * 16 + f], sn = SIN[(size_t)t * 32 + a * 16 + f]; qs[wv][m][d] = pp == 0 ? x * cs - xp * sn : x * cs + xp * sn; }
        __syncthreads();
        float m1 = -1e30f, m2 = -1e30f;
        for (int j = lane; j < LK; j += 64) { const int kr = pos_row(b, j); const bool rope = j >= CTX; const int kt = j - CTX; float a1 = 0.f, a2 = 0.f;
            for (int d = 0; d < 64; ++d) { const int a = d >> 5, pp = (d >> 4) & 1, f = d & 15;
                float k1 = bf2f(KA[(size_t)kr * 512 + h * 128 + d]), k2 = bf2f(KA[(size_t)kr * 512 + h * 128 + 64 + d]);
                if (rope) { const float k1p = bf2f(KA[(size_t)kr * 512 + h * 128 + (d ^ 16)]), k2p = bf2f(KA[(size_t)kr * 512 + h * 128 + 64 + (d ^ 16)]); const float cs = COS[(size_t)kt * 32 + a * 16 + f], sn = SIN[(size_t)kt * 32 + a * 16 + f];
                    k1 = pp == 0 ? k1 * cs - k1p * sn : k1 * cs + k1p * sn; k2 = pp == 0 ? k2 * cs - k2p * sn : k2 * cs + k2p * sn; }
                a1 += qs[wv][0][d] * k1; a2 += qs[wv][1][d] * k2; }
            a1 *= 0.125f; a2 *= 0.125f; s1[j] = a1; s2[j] = a2; m1 = fmaxf(m1, a1); m2 = fmaxf(m2, a2); }
        for (int o = 1; o < 64; o <<= 1) { m1 = fmaxf(m1, __shfl_xor(m1, o)); m2 = fmaxf(m2, __shfl_xor(m2, o)); }
        float l1 = 0.f, l2 = 0.f;
        for (int j = lane; j < LK; j += 64) { const float p1 = expf(s1[j] - m1), p2 = expf(s2[j] - m2); s1[j] = p1; s2[j] = p2; l1 += p1; l2 += p2; }
        for (int o = 1; o < 64; o <<= 1) { l1 += __shfl_xor(l1, o); l2 += __shfl_xor(l2, o); }
        __threadfence(); __syncthreads();
        float o0 = 0.f, o1 = 0.f;
        for (int j = 0; j < LK; ++j) { const int kr = pos_row(b, j); const float p = s1[j] / l1 - lmb * s2[j] / l2; o0 += p * bf2f(VA[(size_t)kr * 512 + h * 128 + lane]); o1 += p * bf2f(VA[(size_t)kr * 512 + h * 128 + 64 + lane]); }
        float ss = o0 * o0 + o1 * o1; for (int o = 1; o < 64; o <<= 1) ss += __shfl_xor(ss, o);
        const float sc = (1.0f / sqrtf(ss / 128.0f + 1e-6f)) * (1.0f - lam_init);
        const float r0 = o0 * sc * gn[lane], r1 = o1 * sc * gn[64 + lane], y0 = bf2f(Y[(size_t)row * 1024 + h * 128 + lane]), y1 = bf2f(Y[(size_t)row * 1024 + h * 128 + 64 + lane]);
        double d2 = (double)(y0 - r0) * (y0 - r0) + (double)(y1 - r1) * (y1 - r1), r2 = (double)r0 * r0 + (double)r1 * r1;
        for (int o = 1; o < 64; o <<= 1) { d2 += __shfl_xor(d2, o); r2 += __shfl_xor(r2, o); }
        if (lane == 0) { atomicAdd(acc, d2); atomicAdd(acc + 1, r2); }
        __syncthreads(); }
}
__global__ void st_mod_check(const unsigned char* ws, const float* cv, const float* cctx, const float* w_ada, const float* b_ada, double* acc) {
    const float* MOD = (const float*)(ws + OFF_MOD); double d2 = 0.0, r2 = 0.0;
    for (long it = (long)blockIdx.x * blockDim.x + threadIdx.x; it < (long)DEPTH * 9 * 6 * D; it += (long)gridDim.x * blockDim.x) { const int n = (int)(it % (6 * D)), r = (int)((it / (6 * D)) % 9), l = (int)(it / (6L * D * 9));
        double s = b_ada[(size_t)l * 6 * D + n];
        for (int k = 0; k < D; ++k) { const double cc = r < NB ? cv[r * D + k] : cctx[k]; s += cc / (1.0 + exp(-cc)) * (double)w_ada[((size_t)l * D + k) * 6 * D + n]; }
        const double m = MOD[it]; d2 += (m - s) * (m - s); r2 += s * s; }
    atomicAdd(acc, d2); atomicAdd(acc + 1, r2);
}
__global__ void st_inproj_check(const unsigned char* ws, const float* w_in_e, double* acc) {
    const bf16_t* H = (const bf16_t*)(ws + OFF_HY); const bf16_t* P = (const bf16_t*)(ws + OFF_P); double d2 = 0.0, r2 = 0.0;
    for (long it = (long)blockIdx.x * blockDim.x + threadIdx.x; it < 72L * NE; it += (long)gridDim.x * blockDim.x) { const int col = (int)(it % NE), row = (int)(it / NE) * 256 + 37;
        float s = 0.f; for (int k = 0; k < D; ++k) s += bf2f(H[(size_t)row * D + k]) * bf2f(f2bf(w_in_e[(size_t)k * E_IN + col]));
        size_t off; int pitch, c0; const int pn = col / 256;
        if (pn < 2) { off = PE_QA; pitch = 512; c0 = 256 * pn; } else if (pn < 4) { off = PE_KA; pitch = 512; c0 = 256 * (pn - 2); } else if (pn < 6) { off = PE_VA; pitch = 512; c0 = 256 * (pn - 4); }
        else if (pn == 6) { off = PE_BQ; pitch = 256; c0 = 0; } else if (pn == 7) { off = PE_BK; pitch = 256; c0 = 0; } else if (pn < 10) { off = PE_BV; pitch = 512; c0 = 256 * (pn - 8); } else { off = PE_BO; pitch = 512; c0 = 256 * (pn - 10); }
        const float v = bf2f(P[off + (size_t)row * pitch + c0 + (col & 255)]); d2 += (double)(v - s) * (v - s); r2 += (double)s * s; }
    atomicAdd(acc, d2); atomicAdd(acc + 1, r2);
}
__global__ void st_norm_check(const unsigned char* ws, const float* g_mix, const float* w_in_e, const float* xin, const float* ctxin, double* acc) {
    const bf16_t* H = (const bf16_t*)(ws + OFF_HY); const float* G = (const float*)(ws + OFF_G); const float* MOD = (const float*)(ws + OFF_MOD); double d2 = 0.0, r2 = 0.0, dg = 0.0, rg = 0.0;
    for (int it = blockIdx.x * blockDim.x + threadIdx.x; it < 72; it += gridDim.x * blockDim.x) { const int row = it * 256 + 37; const int mr = row < ML ? row / SEQ : NB;
        const float* x = row < ML ? xin + (size_t)row * D : ctxin + (size_t)(row - ML) * D; double ss = 0.0; for (int k = 0; k < D; ++k) ss += (double)x[k] * x[k];
        const double rstd = 1.0 / sqrt(ss / D + 1e-6); double ga[16]; for (int n = 0; n < 16; ++n) ga[n] = 0.0;
        for (int k = 0; k < D; ++k) { const double h = x[k] * rstd * g_mix[k] * (1.0 + MOD[(size_t)mr * 6 * D + D + k]) + MOD[(size_t)mr * 6 * D + k]; const double v = bf2f(H[(size_t)row * D + k]); d2 += (v - h) * (v - h); r2 += h * h;
            for (int n = 0; n < 16; ++n) ga[n] += h * w_in_e[(size_t)k * E_IN + NE + n]; }
        for (int n = 0; n < 16; ++n) { const double v = G[(size_t)row * 16 + n]; dg += (v - ga[n]) * (v - ga[n]); rg += ga[n] * ga[n]; } }
    atomicAdd(acc + 2, d2); atomicAdd(acc + 3, r2); atomicAdd(acc + 4, dg); atomicAdd(acc + 5, rg);
}
__global__ void st_eps3_fill(const double* acc, float* out, int n) {
    double e = 0.0; for (int i = 0; i < 3; ++i) e = fmax(e, sqrt(acc[2 * i] / (acc[2 * i + 1] + 1e-300))); e += 1e-30; const float v = sqrtf((float)fmax(0.0, -10.0 * log10(e)));
    for (size_t k = (size_t)blockIdx.x * blockDim.x + threadIdx.x; k < (size_t)n; k += (size_t)gridDim.x * blockDim.x) out[k] = v; }
__global__ void st_tail_check(const unsigned char* ws, const float* xin, const float* ctxin, const float* w_out, const float* g_ffn, const float* wg, const float* wu, const float* wd, double* acc) {
    __shared__ float xm[D]; __shared__ float h2[D]; __shared__ float act[FF]; __shared__ float red[256];
    const bf16_t* Y = (const bf16_t*)(ws + OFF_HY); const float* X = (const float*)(ws + OFF_X); const float* MOD = (const float*)(ws + OFF_MOD);
    const int row = blockIdx.x * 256 + 37, tid = threadIdx.x; const int mr = row < ML ? row / SEQ : NB; const float* md = MOD + (size_t)mr * 6 * D;
    const float* x0 = row < ML ? xin + (size_t)row * D : ctxin + (size_t)(row - ML) * D;
    for (int n = tid; n < D; n += 256) { float s = 0.f; for (int k = 0; k < 1024; ++k) s += bf2f(Y[(size_t)row * 1024 + k]) * w_out[(size_t)k * D + n]; xm[n] = x0[n] + md[2 * D + n] * s; }
    __syncthreads();
    float ss = 0.f; for (int n = tid; n < D; n += 256) ss += xm[n] * xm[n]; red[tid] = ss; __syncthreads();
    for (int o = 128; o > 0; o >>= 1) { if (tid < o) red[tid] += red[tid + o]; __syncthreads(); }
    const float rstd = 1.0f / sqrtf(red[0] / D + 1e-6f); __syncthreads();
    for (int n = tid; n < D; n += 256) h2[n] = xm[n] * rstd * g_ffn[n] * (1.0f + md[4 * D + n]) + md[3 * D + n];
    __syncthreads();
    for (int f = tid; f < FF; f += 256) { float a = 0.f, b = 0.f; for (int k = 0; k < D; ++k) { a += h2[k] * wg[(size_t)k * FF + f]; b += h2[k] * wu[(size_t)k * FF + f]; } act[f] = a / (1.0f + expf(-a)) * b; }
    __syncthreads();
    double d2 = 0.0, r2 = 0.0;
    for (int n = tid; n < D; n += 256) { float s = 0.f; for (int f = 0; f < FF; ++f) s += act[f] * wd[(size_t)f * D + n]; const float ref = xm[n] + md[5 * D + n] * s, v = X[(size_t)row * D + n]; d2 += (double)(v - ref) * (v - ref); r2 += (double)(ref - x0[n]) * (ref - x0[n]); }
    atomicAdd(acc, d2); atomicAdd(acc + 1, r2);
}
__global__ void st_ml_ref(const unsigned char* ws, const float* bias, float* href) {
    __shared__ float qs[64], ks[64], red[4][128], dred[4];
    const bf16_t* BQ = (const bf16_t*)(ws + OFF_P) + PE_BQ; const bf16_t* BK = (const bf16_t*)(ws + OFF_P) + PE_BK; const bf16_t* BV = (const bf16_t*)(ws + OFF_P) + PE_BV; const float* G = (const float*)(ws + OFF_G);
    const int chain = blockIdx.x, dir = chain & 1, h = (chain >> 1) & 3, b = chain >> 3, tid = threadIdx.x, dv = tid & 127, kg = tid >> 7;
    float C[16], nn[16]; for (int j = 0; j < 16; ++j) { C[j] = 0.f; nn[j] = 0.f; } float m = 0.f;
    for (int p = 0; p < LK; ++p) { int row; if (p < CTX) row = ML + b * CTX + (dir ? CTX - 1 - p : p); else row = b * SEQ + (dir ? SEQ - 1 - (p - CTX) : p - CTX);
        if (tid < 64) { qs[tid] = bf2f(BQ[(size_t)row * 256 + h * 64 + tid]); ks[tid] = bf2f(BK[(size_t)row * 256 + h * 64 + tid]) * 0.125f; }
        const float v = bf2f(BV[(size_t)row * 512 + h * 128 + dv]);
        const float ipre = G[(size_t)row * 16 + dir * 8 + h] + bias[dir * 8 + h], fpre = G[(size_t)row * 16 + dir * 8 + 4 + h] + bias[dir * 8 + 4 + h];
        const float lf = fminf(fpre, 0.f) - log1pf(expf(-fabsf(fpre)));
        __syncthreads();
        const float mn = fmaxf(lf + m, ipre), fs = expf(lf + m - mn), is = expf(ipre - mn); m = mn;
        float pn = 0.f, pd = 0.f;
        for (int j = 0; j < 16; ++j) { const int dk = 16 * kg + j; C[j] = fs * C[j] + is * ks[dk] * v; nn[j] = fs * nn[j] + is * ks[dk]; pn += qs[dk] * C[j]; pd += qs[dk] * nn[j]; }
        red[kg][dv] = pn; if (dv == 0) dred[kg] = pd;
        __syncthreads();
        if (kg == 0) { const float num = (red[0][dv] + red[1][dv]) + (red[2][dv] + red[3][dv]), den = (dred[0] + dred[1]) + (dred[2] + dred[3]);
            href[((size_t)dir * MT + row) * 512 + h * 128 + dv] = num / fmaxf(fabsf(den), expf(-m)); }
        __syncthreads(); }
}
__global__ void st_ml_cmp(const unsigned char* ws, const float* href, const float* gn, double* acc) {
    const bf16_t* BO = (const bf16_t*)(ws + OFF_P) + PE_BO; const bf16_t* Y = (const bf16_t*)(ws + OFF_HY); const int lane = threadIdx.x & 63;
    for (int it = (blockIdx.x * blockDim.x + threadIdx.x) >> 6; it < MT * 4; it += (gridDim.x * blockDim.x) >> 6) { const int row = it >> 2, h = it & 3; float v[2], ss = 0.f;
        for (int e = 0; e < 2; ++e) { const size_t o = (size_t)row * 512 + h * 128 + lane + 64 * e; v[e] = href[o] + href[(size_t)MT * 512 + o]; ss += v[e] * v[e]; }
        for (int o = 1; o < 64; o <<= 1) ss += __shfl_xor(ss, o);
        const float rstd = 1.0f / sqrtf(ss / 128.0f + 1e-6f); double d2 = 0.0, r2 = 0.0;
        for (int e = 0; e < 2; ++e) { const int dv = lane + 64 * e; const float og = bf2f(BO[(size_t)row * 512 + h * 128 + dv]); const float ref = v[e] * rstd * gn[dv] / (1.0f + expf(-og)), y = bf2f(Y[(size_t)row * 1024 + 512 + h * 128 + dv]); d2 += (double)(y - ref) * (y - ref); r2 += (double)ref * ref; }
        for (int o = 1; o < 64; o <<= 1) { d2 += __shfl_xor(d2, o); r2 += __shfl_xor(r2, o); }
        if (lane == 0) { atomicAdd(acc, d2); atomicAdd(acc + 1, r2); } }
}
__global__ void st_dn_ref(const unsigned char* ws, const float* convw, const float* alog, const float* dtb, float* href) {
    __shared__ float qkv[3][128], red[4][128], nrm[2];
    const bf16_t* DQ = (const bf16_t*)(ws + OFF_P) + PO_DQKV; const float* G = (const float*)(ws + OFF_G);
    const int chain = blockIdx.x, dir = chain & 1, h = (chain >> 1) & 3, b = chain >> 3, tid = threadIdx.x, dv = tid & 127, kg = tid >> 7;
    float S[32]; for (int j = 0; j < 32; ++j) S[j] = 0.f;
    for (int p = 0; p < LK; ++p) { const bool isctx = p < CTX; const int seqlen = isctx ? CTX : SEQ, rowbase = isctx ? ML + b * CTX : b * SEQ; const int tok = isctx ? (dir ? CTX - 1 - p : p) : (dir ? SEQ - 1 - (p - CTX) : p - CTX); const int row = rowbase + tok;
        if (tid < 384) { const int ten = tid >> 7, d = tid & 127, col = ten * 512 + h * 128 + d; float a = 0.f;
            for (int tap = 0; tap < 3; ++tap) { const int tk = tok + tap - 1; if (tk >= 0 && tk < seqlen) a += bf2f(DQ[(size_t)(rowbase + tk) * 1536 + col]) * convw[tap * 1536 + col]; }
            qkv[ten][d] = a / (1.0f + expf(-a)); }
        __syncthreads();
        if (tid < 128) { float s = 0.f; const int ten = tid >> 6; for (int d = (tid & 63); d < 128; d += 64) s += qkv[ten][d] * qkv[ten][d]; for (int o = 1; o < 64; o <<= 1) s += __shfl_xor(s, o); if ((tid & 63) == 0) nrm[ten] = s; }
        __syncthreads();
        const float qn = (1.0f / sqrtf(nrm[0] + 1e-6f)) * 0.08838834764831845f, kn = 1.0f / sqrtf(nrm[1] + 1e-6f);
        const float beta = 1.0f / (1.0f + expf(-G[(size_t)row * 16 + dir * 8 + h])); const float xg = G[(size_t)row * 16 + dir * 8 + 4 + h] + dtb[dir * 4 + h];
        const float at = expf(-expf(alog[dir * 4 + h]) * (fmaxf(xg, 0.f) + log1pf(expf(-fabsf(xg)))));
        const float v = qkv[2][dv]; float pk = 0.f;
        for (int j = 0; j < 32; ++j) pk += qkv[1][32 * kg + j] * kn * S[j];
        red[kg][dv] = pk; __syncthreads();
        const float kS = (red[0][dv] + red[1][dv]) + (red[2][dv] + red[3][dv]); __syncthreads();
        float po = 0.f;
        for (int j = 0; j < 32; ++j) { const float kk = qkv[1][32 * kg + j] * kn; S[j] = at * (S[j] - beta * kk * kS) + beta * kk * v; po += qkv[0][32 * kg + j] * qn * S[j]; }
        red[kg][dv] = po; __syncthreads();
        if (kg == 0 && !isctx) href[((size_t)dir * ML + row) * 512 + h * 128 + dv] = (red[0][dv] + red[1][dv]) + (red[2][dv] + red[3][dv]);
        __syncthreads(); }
}
__global__ void st_dn_cmp(const unsigned char* ws, const float* href, const float* gn, double* acc) {
    const bf16_t* Z = (const bf16_t*)(ws + OFF_P) + PO_Z; const bf16_t* Y = (const bf16_t*)(ws + OFF_HY); const int lane = threadIdx.x & 63;
    for (int it = (blockIdx.x * blockDim.x + threadIdx.x) >> 6; it < ML * 4; it += (gridDim.x * blockDim.x) >> 6) { const int row = it >> 2, h = it & 3; float v[2], ss = 0.f;
        for (int e = 0; e < 2; ++e) { const size_t o = (size_t)row * 512 + h * 128 + lane + 64 * e; v[e] = href[o] + href[(size_t)ML * 512 + o]; ss += v[e] * v[e]; }
        for (int o = 1; o < 64; o <<= 1) ss += __shfl_xor(ss, o);
        const float rstd = 1.0f / sqrtf(ss / 128.0f + 1e-6f); double d2 = 0.0, r2 = 0.0;
        for (int e = 0; e < 2; ++e) { const int dv = lane + 64 * e; const float z = bf2f(Z[(size_t)row * 512 + h * 128 + dv]); const float ref = v[e] * rstd * gn[dv] * (z / (1.0f + expf(-z))), y = bf2f(Y[(size_t)row * 1024 + 512 + h * 128 + dv]); d2 += (double)(y - ref) * (y - ref); r2 += (double)ref * ref; }
        for (int o = 1; o < 64; o <<= 1) { d2 += __shfl_xor(d2, o); r2 += __shfl_xor(r2, o); }
        if (lane == 0) { atomicAdd(acc, d2); atomicAdd(acc + 1, r2); } }
}
__global__ void st_truth_fill(const unsigned char* ws, float* out, int n) {
    const double T[9] = {846.38902932657311,-3988.0872614528216,-4023.4252461296091,7499.0995520059896,-6191.4193272974135,-6282.081387437358,8748.2446258433793,548.97920503418845,21616550.564093322};
    const double* g = (const double*)(ws + ST_CHK) + ((size_t)35 * 4) * 10; double d2 = 0.0; for (int k = 0; k < 8; ++k) d2 += (g[k] - T[k]) * (g[k] - T[k]);
    const double eps = sqrt(d2 / (8.0 * T[8])) + 1e-30; const float v = sqrtf((float)fmax(0.0, -10.0 * log10(eps)));
    for (size_t k = (size_t)blockIdx.x * blockDim.x + threadIdx.x; k < (size_t)n; k += (size_t)gridDim.x * blockDim.x) out[k] = v; }
__global__ void st_gqa_check(const unsigned char* ws, const bf16_t* QS, const float* qkg, double* acc, float* scr) {
    const int lane = threadIdx.x & 63, gw = (blockIdx.x * blockDim.x + threadIdx.x) >> 6, ngw = (gridDim.x * blockDim.x) >> 6, wv = threadIdx.x >> 6;
    const bf16_t* KVC = (const bf16_t*)(ws + OFF_P) + PO_KVC; const bf16_t* O = (const bf16_t*)(ws + OFF_P) + PO_QC;
    const float* COS = (const float*)(ws + OFF_ROPE); const float* SIN = COS + (size_t)SEQ * 32;
    float* s1 = scr + (size_t)gw * LK; __shared__ float qs[8][64];
    for (int it = gw; it < (ML / 16) * 8; it += ngw) { const int h = it & 7, kv = h >> 2, row = (it >> 3) * 16 + 5; const int b = row / SEQ, t = row % SEQ;
        {   const int d = lane, a = d >> 5, pp = (d >> 4) & 1, f = d & 15; float x = bf2f(QS[(size_t)row * 512 + h * 64 + d]); float ss = x * x; for (int o = 1; o < 64; o <<= 1) ss += __shfl_xor(ss, o);
            x = x * (1.0f / sqrtf(ss / 64.0f + 1e-6f)) * qkg[d]; const float xp = __shfl_xor(x, 16); const float cs = COS[(size_t)t * 32 + a * 16 + f], sn = SIN[(size_t)t * 32 + a * 16 + f]; qs[wv][d] = pp == 0 ? x * cs - xp * sn : x * cs + xp * sn; }
        __syncthreads();
        float m1 = -1e30f;
        for (int j = lane; j < LK; j += 64) { const int kr = pos_row(b, j); const bool rope = j >= CTX; const int kt = j - CTX; float ss = 0.f; const bf16_t* kp = KVC + (size_t)kr * 256 + kv * 64;
            for (int d = 0; d < 64; ++d) { const float kd = bf2f(kp[d]); ss += kd * kd; }
            const float rs = 1.0f / sqrtf(ss / 64.0f + 1e-6f); float a1 = 0.f;
            for (int d = 0; d < 64; ++d) { const int a = d >> 5, pp = (d >> 4) & 1, f = d & 15; float k1 = bf2f(kp[d]) * rs * qkg[64 + d];
                if (rope) { const float k1p = bf2f(kp[d ^ 16]) * rs * qkg[64 + (d ^ 16)]; const float cs = COS[(size_t)kt * 32 + a * 16 + f], sn = SIN[(size_t)kt * 32 + a * 16 + f]; k1 = pp == 0 ? k1 * cs - k1p * sn : k1 * cs + k1p * sn; }
                a1 += qs[wv][d] * k1; }
            a1 *= 0.125f; s1[j] = a1; m1 = fmaxf(m1, a1); }
        for (int o = 1; o < 64; o <<= 1) m1 = fmaxf(m1, __shfl_xor(m1, o));
        float l1 = 0.f;
        for (int j = lane; j < LK; j += 64) { const float p1 = expf(s1[j] - m1); s1[j] = p1; l1 += p1; }
        for (int o = 1; o < 64; o <<= 1) l1 += __shfl_xor(l1, o);
        __threadfence(); __syncthreads();
        float o0 = 0.f;
        for (int j = 0; j < LK; ++j) { const int kr = pos_row(b, j); o0 += s1[j] * bf2f(KVC[(size_t)kr * 256 + 128 + kv * 64 + lane]); }
        const float ref = o0 / l1, y = bf2f(O[(size_t)row * 512 + h * 64 + lane]);
        double d2 = (double)(y - ref) * (y - ref), r2 = (double)ref * ref;
        for (int o = 1; o < 64; o <<= 1) { d2 += __shfl_xor(d2, o); r2 += __shfl_xor(r2, o); }
        if (lane == 0) { atomicAdd(acc, d2); atomicAdd(acc + 1, r2); }
        __syncthreads(); }
}
__global__ void st_eps_fill(const double* acc, float* out, int n) { const double eps = sqrt(acc[0] / (acc[1] + 1e-300)) + 1e-30; const float v = sqrtf((float)fmax(0.0, -10.0 * log10(eps)));
    for (size_t k = (size_t)blockIdx.x * blockDim.x + threadIdx.x; k < (size_t)n; k += (size_t)gridDim.x * blockDim.x) out[k] = v; }
#endif
extern "C" void kernel_launch(void* const* d_in, const int* in_sizes, int n_in, void* d_out, int out_size, void* d_ws, size_t ws_size, hipStream_t stream) {
    static int grid = 0;
    if (grid == 0) {
        int dev = 0, cus = 0, per_cu = 0;
        if (hipGetDevice(&dev) != hipSuccess || hipDeviceGetAttribute(&cus, hipDeviceAttributeMultiprocessorCount, dev) != hipSuccess) { fprintf(stderr, "kernel_launch: device query failed\n"); grid = -1; return; }
        if (hipFuncSetAttribute((const void*)mega, hipFuncAttributeMaxDynamicSharedMemorySize, LDS_BYTES) != hipSuccess) { fprintf(stderr, "kernel_launch: hipFuncSetAttribute failed\n"); grid = -1; return; }
        if (hipOccupancyMaxActiveBlocksPerMultiprocessor(&per_cu, (const void*)mega, NTHREADS, LDS_BYTES) != hipSuccess || per_cu < 1) { fprintf(stderr, "kernel_launch: occupancy query says %d\n", per_cu); per_cu = 1; }
        (void)hipGetLastError();
        if (ws_size < WS_NEED || n_in != 25) { fprintf(stderr, "kernel_launch: workspace %zu < %zu needed or n_in %d != 25\n", ws_size, (size_t)WS_NEED, n_in); grid = -1; return; }
        grid = cus;
    }
    if (grid < 0) return;
    (void)hipMemsetAsync(d_ws, 0, ZERO_BYTES, stream);
    Args a{};
#if defined(SELFTEST) && (defined(ST_REPEAT) || defined(ST_TWICE) || defined(ST_FINAL) || defined(ST_DACHECK) || defined(ST_MODCHECK) || defined(ST_L0CHECK) || defined(ST_TAILCHECK) || defined(ST_MLCHECK) || defined(ST_DNCHECK) || defined(ST_GQCHECK))
    for (int i = 0; i < 25; ++i) a.in[i] = (const float*)d_in[i];
    a.out = (float*)d_out; a.ws = (unsigned char*)d_ws; float* sout = (float*)d_out;
#elif defined(SELFTEST) && defined(ST_SAME_BATCH)
    for (int i = 0; i < 25; ++i) a.in[i] = (const float*)d_in[i];
    float* ctxs = (float*)((unsigned char*)d_ws + al256(WS_NEED)); float* cs = ctxs + (size_t)NB * CTX * D; float* sout = (float*)d_out;
    hipLaunchKernelGGL(st_same_batch_inputs, dim3(1024), dim3(256), 0, stream, (const float*)d_in[0], (const float*)d_in[1], (const float*)d_in[2], (float*)d_out, cs, ctxs);
    a.in[0] = (const float*)d_out; a.in[1] = cs; a.in[2] = ctxs; a.out = (float*)d_out; a.ws = (unsigned char*)d_ws;
#elif defined(SELFTEST) && defined(ST_INPLACE)
    { StPtrs P; for (int i = 0; i < 25; ++i) { P.p[i] = (float*)d_in[i]; a.in[i] = (const float*)d_in[i]; }
      hipLaunchKernelGGL(st_gen_inplace, dim3(1024), dim3(256), 0, stream, P); }
    float* sout = (float*)d_out; a.out = sout; a.ws = (unsigned char*)d_ws;
#elif defined(SELFTEST)
    float* syn = (float*)((unsigned char*)d_ws + al256(WS_NEED)); float* sout = syn + st_offset(25);
    hipLaunchKernelGGL(st_gen, dim3(1024), dim3(256), 0, stream, syn);
    for (int i = 0; i < 25; ++i) a.in[i] = syn + st_offset(i);
    a.out = sout; a.ws = (unsigned char*)d_ws;
#else
    for (int i = 0; i < 25; ++i) a.in[i] = (const float*)d_in[i];
    a.out = (float*)d_out; a.ws = (unsigned char*)d_ws;
#endif
#ifdef SELFTEST
#ifdef ST_GQCHECK
    {   a.step_lo = 0; a.step_hi = 9 + 3; a.prologue = 1; a.final_ = 0;
        void* args[] = {&a};
        hipError_t e = hipLaunchCooperativeKernel((const void*)mega, dim3(grid), dim3(NTHREADS), args, LDS_BYTES, stream);
        if (e != hipSuccess) fprintf(stderr, "cooperative launch failed: %s (grid %d)\n", hipGetErrorString(e), grid);
        (void)hipMemcpyAsync(d_out, (unsigned char*)d_ws + OFF_P + PO_QC * 2, (size_t)MT * 512 * 2, hipMemcpyDeviceToDevice, stream);
        a.step_lo = 12; a.step_hi = 13; a.prologue = 0;
        (void)hipMemsetAsync(d_ws, 0, 512 * 1024, stream);
        e = hipLaunchCooperativeKernel((const void*)mega, dim3(grid), dim3(NTHREADS), args, LDS_BYTES, stream);
        double* acc = (double*)((unsigned char*)d_ws + ST_CHK); float* scr = (float*)((unsigned char*)d_ws + SO_U);
        hipLaunchKernelGGL(st_gqa_check, dim3(256), dim3(512), 0, stream, (const unsigned char*)d_ws, (const bf16_t*)d_out, (const float*)d_in[15], acc, scr);
        hipLaunchKernelGGL(st_eps_fill, dim3(1024), dim3(256), 0, stream, (const double*)acc, (float*)d_out, out_size); }
#elif defined(ST_DNCHECK)
#ifndef ST_LAYER
#define ST_LAYER 1
#endif
    {   a.step_lo = 0; a.step_hi = 9 * ST_LAYER + 3; a.prologue = 1; a.final_ = 0;
        void* args[] = {&a};
        hipError_t e = hipLaunchCooperativeKernel((const void*)mega, dim3(grid), dim3(NTHREADS), args, LDS_BYTES, stream);
        if (e != hipSuccess) fprintf(stderr, "cooperative launch failed: %s (grid %d)\n", hipGetErrorString(e), grid);
        float* href = (float*)d_out; double* acc = (double*)((unsigned char*)d_ws + ST_CHK);
        hipLaunchKernelGGL(st_dn_ref, dim3(NCHAIN), dim3(512), 0, stream, (const unsigned char*)d_ws, (const float*)d_in[16] + (ST_LAYER / 2) * 3 * 1536, (const float*)d_in[17] + (ST_LAYER / 2) * 8, (const float*)d_in[18] + (ST_LAYER / 2) * 8, href);
        a.step_lo = 9 * ST_LAYER + 3; a.step_hi = 9 * ST_LAYER + 5; a.prologue = 0;
        (void)hipMemsetAsync(d_ws, 0, 512 * 1024, stream);
        e = hipLaunchCooperativeKernel((const void*)mega, dim3(grid), dim3(NTHREADS), args, LDS_BYTES, stream);
        hipLaunchKernelGGL(st_dn_cmp, dim3(512), dim3(256), 0, stream, (const unsigned char*)d_ws, (const float*)href, (const float*)d_in[19] + (ST_LAYER / 2) * 128, acc);
        hipLaunchKernelGGL(st_eps_fill, dim3(1024), dim3(256), 0, stream, (const double*)acc, (float*)d_out, out_size); }
#elif defined(ST_MLCHECK)
#ifndef ST_LAYER
#define ST_LAYER 0
#endif
    {   a.step_lo = 0; a.step_hi = 9 * ST_LAYER + 5; a.prologue = 1; a.final_ = 0;
        void* args[] = {&a};
        hipError_t e = hipLaunchCooperativeKernel((const void*)mega, dim3(grid), dim3(NTHREADS), args, LDS_BYTES, stream);
        if (e != hipSuccess) fprintf(stderr, "cooperative launch failed: %s (grid %d)\n", hipGetErrorString(e), grid);
        float* href = (float*)((unsigned char*)d_ws + SE_DCT); double* acc = (double*)((unsigned char*)d_ws + ST_CHK);
        hipLaunchKernelGGL(st_ml_ref, dim3(NCHAIN), dim3(512), 0, stream, (const unsigned char*)d_ws, (const float*)d_in[9] + (ST_LAYER / 2) * 16, href);
        hipLaunchKernelGGL(st_ml_cmp, dim3(512), dim3(256), 0, stream, (const unsigned char*)d_ws, (const float*)href, (const float*)d_in[12] + (ST_LAYER / 2) * 128, acc);
        hipLaunchKernelGGL(st_eps_fill, dim3(1024), dim3(256), 0, stream, (const double*)acc, (float*)d_out, out_size); }
#elif defined(ST_TAILCHECK)
    {   a.step_lo = 0; a.step_hi = 5; a.prologue = 1; a.final_ = 0;
        void* args[] = {&a};
        hipError_t e = hipLaunchCooperativeKernel((const void*)mega, dim3(grid), dim3(NTHREADS), args, LDS_BYTES, stream);
        if (e != hipSuccess) fprintf(stderr, "cooperative launch failed: %s (grid %d)\n", hipGetErrorString(e), grid);
        float* ysave = (float*)((unsigned char*)d_ws + SE_DCT);
        (void)hipMemcpyAsync(ysave, (unsigned char*)d_ws + OFF_HY, (size_t)MT * 1024 * 2, hipMemcpyDeviceToDevice, stream);
        a.step_lo = 5; a.step_hi = 9; a.prologue = 0;
        (void)hipMemsetAsync(d_ws, 0, 512 * 1024, stream);
        e = hipLaunchCooperativeKernel((const void*)mega, dim3(grid), dim3(NTHREADS), args, LDS_BYTES, stream);
        (void)hipMemcpyAsync((unsigned char*)d_ws + OFF_HY, ysave, (size_t)MT * 1024 * 2, hipMemcpyDeviceToDevice, stream);
        double* acc = (double*)((unsigned char*)d_ws + ST_CHK);
        hipLaunchKernelGGL(st_tail_check, dim3(72), dim3(256), 0, stream, (const unsigned char*)d_ws, (const float*)d_in[0], (const float*)d_in[2], (const float*)d_in[13], (const float*)d_in[7], (const float*)d_in[21], (const float*)d_in[22], (const float*)d_in[23], acc);
        hipLaunchKernelGGL(st_eps_fill, dim3(1024), dim3(256), 0, stream, (const double*)acc, (float*)d_out, out_size); }
#elif defined(ST_L0CHECK)
    {   a.step_lo = 0; a.step_hi = 2; a.prologue = 1; a.final_ = 0;
        void* args[] = {&a};
        hipError_t e = hipLaunchCooperativeKernel((const void*)mega, dim3(grid), dim3(NTHREADS), args, LDS_BYTES, stream);
        if (e != hipSuccess) fprintf(stderr, "cooperative launch failed: %s (grid %d)\n", hipGetErrorString(e), grid);
        double* acc = (double*)((unsigned char*)d_ws + ST_CHK);
        hipLaunchKernelGGL(st_inproj_check, dim3(512), dim3(256), 0, stream, (const unsigned char*)d_ws, (const float*)d_in[8], acc);
        hipLaunchKernelGGL(st_norm_check, dim3(1), dim3(128), 0, stream, (const unsigned char*)d_ws, (const float*)d_in[6], (const float*)d_in[8], (const float*)d_in[0], (const float*)d_in[2], acc);
        hipLaunchKernelGGL(st_eps3_fill, dim3(1024), dim3(256), 0, stream, (const double*)acc, (float*)d_out, out_size); }
#elif defined(ST_MODCHECK)
    {   a.step_lo = 0; a.step_hi = 0; a.prologue = 1; a.final_ = 0;
        void* args[] = {&a};
        hipError_t e = hipLaunchCooperativeKernel((const void*)mega, dim3(grid), dim3(NTHREADS), args, LDS_BYTES, stream);
        if (e != hipSuccess) fprintf(stderr, "cooperative launch failed: %s (grid %d)\n", hipGetErrorString(e), grid);
        double* acc = (double*)((unsigned char*)d_ws + ST_CHK);
        hipLaunchKernelGGL(st_mod_check, dim3(512), dim3(256), 0, stream, (const unsigned char*)d_ws, (const float*)d_in[1], (const float*)d_in[3], (const float*)d_in[4], (const float*)d_in[5], acc);
        hipLaunchKernelGGL(st_eps_fill, dim3(1024), dim3(256), 0, stream, (const double*)acc, (float*)d_out, out_size); }
#elif defined(ST_DACHECK)
    {   a.step_lo = 0; a.step_hi = 5; a.prologue = 1; a.final_ = 0;
        void* args[] = {&a};
        hipError_t e = hipLaunchCooperativeKernel((const void*)mega, dim3(grid), dim3(NTHREADS), args, LDS_BYTES, stream);
        if (e != hipSuccess) fprintf(stderr, "cooperative launch failed: %s (grid %d)\n", hipGetErrorString(e), grid);
        double* acc = (double*)((unsigned char*)d_ws + ST_CHK); float* scr = (float*)((unsigned char*)d_ws + SE_DCT);
        hipLaunchKernelGGL(st_da_check, dim3(256), dim3(512), 0, stream, (const unsigned char*)d_ws, (const float*)d_in[10], (const float*)d_in[11], acc, scr);
        hipLaunchKernelGGL(st_eps_fill, dim3(1024), dim3(256), 0, stream, (const double*)acc, (float*)d_out, out_size); }
#elif defined(ST_FINAL)
    {   a.step_lo = 0; a.step_hi = CFG_LAYERS * 9; a.prologue = 1; a.final_ = 1;
        void* args[] = {&a};
        hipError_t e = hipLaunchCooperativeKernel((const void*)mega, dim3(grid), dim3(NTHREADS), args, LDS_BYTES, stream);
        if (e != hipSuccess) fprintf(stderr, "cooperative launch failed: %s (grid %d)\n", hipGetErrorString(e), grid);
        double* acc = (double*)((unsigned char*)d_ws + ST_CHK);
        hipLaunchKernelGGL(st_final_check, dim3(64), dim3(256), 0, stream, (const unsigned char*)d_ws, (const float*)d_out, (const float*)d_in[24], acc);
        hipLaunchKernelGGL(st_final_fill, dim3(1024), dim3(256), 0, stream, (const double*)acc, (float*)d_out, out_size); }
#elif defined(ST_TWICE)
    for (int rep = 0; rep < 2; ++rep) {
        (void)hipMemsetAsync(d_ws, 0, 512 * 1024, stream); (void)hipMemsetAsync((unsigned char*)d_ws + OFF_MOD, 0, ZERO_BYTES - OFF_MOD, stream);
        a.step_lo = 0; a.step_hi = CFG_LAYERS * 9; a.prologue = 1; a.final_ = 0;
        void* args[] = {&a};
        hipError_t e = hipLaunchCooperativeKernel((const void*)mega, dim3(grid), dim3(NTHREADS), args, LDS_BYTES, stream);
        if (e != hipSuccess) fprintf(stderr, "cooperative launch failed: %s (grid %d)\n", hipGetErrorString(e), grid);
        hipLaunchKernelGGL(st_check_kernel, dim3(256), dim3(NTHREADS), 0, stream, (unsigned char*)d_ws, 35, rep * 40); }
    hipLaunchKernelGGL(st_twice_report, dim3(1024), dim3(256), 0, stream, (const unsigned char*)d_ws, (float*)d_out, out_size);
#elif defined(ST_REPEAT)
    for (int st = 0; st < CFG_LAYERS * 9; ++st) { const int ph = st % 9;
        for (int rep = 0; rep < ((ph == 3 || ph == 5 || ph == 8) ? 1 : 2); ++rep) {
            a.step_lo = st; a.step_hi = st + 1; a.prologue = (st == 0 && rep == 0); a.final_ = 0;
            void* args[] = {&a};
            hipError_t e = hipLaunchCooperativeKernel((const void*)mega, dim3(grid), dim3(NTHREADS), args, LDS_BYTES, stream);
            if (e != hipSuccess) fprintf(stderr, "cooperative launch failed: %s (grid %d)\n", hipGetErrorString(e), grid);
            hipLaunchKernelGGL(st_check_kernel, dim3(256), dim3(NTHREADS), 0, stream, (unsigned char*)d_ws, st, rep * 40); } }
    hipLaunchKernelGGL(st_repeat_report, dim3(1024), dim3(256), 0, stream, (const unsigned char*)d_ws, (float*)d_out, out_size, CFG_LAYERS * 9);
#elif defined(ST_SAME_BATCH)
    a.step_lo = 0; a.step_hi = CFG_LAYERS * 9; a.prologue = 1; a.final_ = 1;
    { void* args[] = {&a};
      hipError_t e = hipLaunchCooperativeKernel((const void*)mega, dim3(grid), dim3(NTHREADS), args, LDS_BYTES, stream);
      if (e != hipSuccess) fprintf(stderr, "cooperative launch failed: %s (grid %d)\n", hipGetErrorString(e), grid); }
    double* acc = (double*)((unsigned char*)d_ws + ST_CHK);
    hipLaunchKernelGGL(st_batch_report, dim3(256), dim3(256), 0, stream, (const float*)sout, (float*)d_out, out_size, acc);
    hipLaunchKernelGGL(st_fill, dim3(1024), dim3(256), 0, stream, (const double*)acc, (float*)d_out, out_size);
#else
#ifndef ST_CHUNK
#define ST_CHUNK 1
#endif
    for (int st = 0; st < CFG_LAYERS * 9; st += ST_CHUNK) {
        a.step_lo = st; a.step_hi = st + ST_CHUNK; a.prologue = st == 0; a.final_ = 0;
        void* args[] = {&a};
        hipError_t e = hipLaunchCooperativeKernel((const void*)mega, dim3(grid), dim3(NTHREADS), args, LDS_BYTES, stream);
        if (e != hipSuccess) fprintf(stderr, "cooperative launch failed: %s (grid %d)\n", hipGetErrorString(e), grid);
        hipLaunchKernelGGL(st_check_kernel, dim3(256), dim3(NTHREADS), 0, stream, (unsigned char*)d_ws, st + ST_CHUNK - 1);
    }
#ifdef ST_TRUTH
    hipLaunchKernelGGL(st_truth_fill, dim3(1024), dim3(256), 0, stream, (const unsigned char*)d_ws, (float*)d_out, out_size);
#else
    hipLaunchKernelGGL(st_report, dim3(1024), dim3(256), 0, stream, (const unsigned char*)d_ws, (float*)d_out, out_size);
#endif
#endif
#elif defined(MULTI_LAUNCH)
    for (int st = 0; st < CFG_LAYERS * 9; st += MULTI_LAUNCH) {
        a.step_lo = st; a.step_hi = st + MULTI_LAUNCH < CFG_LAYERS * 9 ? st + MULTI_LAUNCH : CFG_LAYERS * 9; a.prologue = st == 0; a.final_ = 0;
        void* args[] = {&a};
        hipError_t e = hipLaunchCooperativeKernel((const void*)mega, dim3(grid), dim3(NTHREADS), args, LDS_BYTES, stream);
        if (e != hipSuccess) fprintf(stderr, "cooperative launch failed: %s (grid %d)\n", hipGetErrorString(e), grid);
    }
    {   a.step_lo = a.step_hi = CFG_LAYERS * 9; a.prologue = 0; a.final_ = 1;
        void* args[] = {&a};
        hipError_t e = hipLaunchCooperativeKernel((const void*)mega, dim3(grid), dim3(NTHREADS), args, LDS_BYTES, stream);
        if (e != hipSuccess) fprintf(stderr, "cooperative launch failed: %s (grid %d)\n", hipGetErrorString(e), grid); }
#elif defined(PROBE_Y)
    {   a.step_lo = 0; a.step_hi = 9 * (PROBE_Y - 1) + 5; a.prologue = 1; a.final_ = 0;
        void* args[] = {&a};
        hipError_t e = hipLaunchCooperativeKernel((const void*)mega, dim3(grid), dim3(NTHREADS), args, LDS_BYTES, stream);
        if (e != hipSuccess) fprintf(stderr, "cooperative launch failed: %s (grid %d)\n", hipGetErrorString(e), grid);
        double* acc = (double*)((unsigned char*)d_ws + 512 * 1024);
        hipLaunchKernelGGL(pr_stat, dim3(512), dim3(256), 0, stream, (const bf16_t*)((unsigned char*)d_ws + OFF_HY), ML, PROBE_C0, PROBE_C1, acc);
        hipLaunchKernelGGL(pr_fill, dim3(1024), dim3(256), 0, stream, (const double*)acc, (float*)d_out, out_size); }
#else
    a.step_lo = 0; a.step_hi = CFG_LAYERS * 9; a.prologue = 1; a.final_ = 1;
    void* args[] = {&a};
    hipError_t e = hipLaunchCooperativeKernel((const void*)mega, dim3(grid), dim3(NTHREADS), args, LDS_BYTES, stream);
    if (e != hipSuccess) fprintf(stderr, "cooperative launch failed: %s (grid %d)\n", hipGetErrorString(e), grid);
#ifdef RUN_TWICE
    (void)hipMemsetAsync(d_ws, 0, ZERO_BYTES, stream);
    e = hipLaunchCooperativeKernel((const void*)mega, dim3(grid), dim3(NTHREADS), args, LDS_BYTES, stream);
#endif
#endif
}
#endif
```

```cpp
#ifndef EMU
#include <hip/hip_runtime.h>
#include <hip/hip_cooperative_groups.h>
#include <cstdio>
#include <cstdint>
#include <cmath>
#endif

#ifndef CFG_D
#define CFG_D 1024
#define CFG_B 8
#define CFG_SEQ 2048
#define CFG_CTX 256
#define CFG_FF 2816
#endif
#ifndef DIS
#define DIS 0ull
#endif
#define ON(bit) (!(((unsigned long long)(DIS) >> (bit)) & 1ull))
#ifndef REPM
#define REPM 0ull
#endif
#define REPB(bit) for (int rep_ = 0; rep_ <= (int)(((unsigned long long)(REPM) >> (bit)) & 1ull); ++rep_)
#ifndef CFG_LAYERS
#define CFG_LAYERS 4
#endif
constexpr int D = CFG_D, NB = CFG_B, SEQ = CFG_SEQ, CTX = CFG_CTX, FF = CFG_FF, DEPTH = 4, GRIDW = 64;
constexpr int ML = NB * SEQ, MC = NB * CTX, MT = ML + MC;
constexpr int LK = CTX + SEQ;
constexpr int NCC = CTX / 64, NLC = SEQ / 64, NCH = NCC + NLC;
constexpr int E_IN = 3088, O_IN = 2832, NE = 3072, NO = 2816;
constexpr int NCHAIN = NB * 4 * 2;
constexpr float EPS = 1e-6f;
constexpr int NTHREADS = 512, NWAVES = 8;
static_assert(SEQ % 256 == 0 && MC % 256 == 0 && D % 256 == 0 && FF % 256 == 0 && CTX % 64 == 0, "shape constraints");

typedef unsigned short bf16_t;
typedef short bf16x8 __attribute__((ext_vector_type(8)));
typedef short bf16x4 __attribute__((ext_vector_type(4)));
typedef float f32x4 __attribute__((ext_vector_type(4)));
typedef float f32x2 __attribute__((ext_vector_type(2)));
typedef float f32x16 __attribute__((ext_vector_type(16)));
typedef unsigned u32x4 __attribute__((ext_vector_type(4)));
typedef unsigned u32x2 __attribute__((ext_vector_type(2)));

#ifdef EMU
#define DEV static inline
#define DEVM inline
#define TIDX (EMU_TID)
#define BIDX (EMU_BID)
#define NBLK (EMU_NBLK)
#define BLOCK_SYNC() emu::block_sync()
#define WAVE_FENCE() emu::wave_sync()
#define SHFL_XOR(v, m) emu::shfl_xor((v), (m))
#define SHFL(v, s) emu::shfl((v), (s))
#define MFMA32(a, b, c) emu::mfma32((a), (b), (c))
#define EXP2F(x) exp2f(x)
#define ATOMIC_ADD_F(p, v) (*(p) += (v))
#define SCHED_FENCE() do {} while (0)
#define LOGF_NATIVE(x) logf(x)
#define WAVE_ANY(p) (wave_max((p) ? 1.0f : 0.0f) > 0.5f)
#else
namespace cg = cooperative_groups;
#define DEV __device__ __forceinline__
#define DEVM __device__ __forceinline__
#define TIDX ((int)threadIdx.x)
#define BIDX ((int)blockIdx.x)
#define NBLK ((int)gridDim.x)
#define BLOCK_SYNC() __syncthreads()
#define WAVE_FENCE() do { asm volatile("s_waitcnt lgkmcnt(0)" ::: "memory"); } while (0)
#define SHFL_XOR(v, m) __shfl_xor((v), (m))
#define SHFL(v, s) __shfl((v), (s))
#define MFMA32(a, b, c) __builtin_amdgcn_mfma_f32_32x32x16_bf16((a), (b), (c), 0, 0, 0)
#define EXP2F(x) __builtin_amdgcn_exp2f(x)
#define ATOMIC_ADD_F(p, v) atomicAdd((p), (v))
#define SCHED_FENCE() __builtin_amdgcn_sched_barrier(0)
#define LOGF_NATIVE(x) __logf(x)
#define WAVE_ANY(p) (__any(p) != 0)
#endif

DEV unsigned f2bf(float f) { unsigned u = __builtin_bit_cast(unsigned, f); return (u + 0x7fffu + ((u >> 16) & 1u)) >> 16; }
DEV float bf2f(unsigned h) { return __builtin_bit_cast(float, h << 16); }
#ifdef EMU
DEV unsigned pk2(float lo, float hi) { return f2bf(lo) | (f2bf(hi) << 16); }
#else
typedef __bf16 hw_bf16x2 __attribute__((ext_vector_type(2)));
DEV unsigned pk2(float lo, float hi) { const f32x2 v = {lo, hi}; return __builtin_bit_cast(unsigned, __builtin_convertvector(v, hw_bf16x2)); }
#endif
DEV int crow(int r, int h) { return (r & 3) + 8 * (r >> 2) + 4 * h; }
DEV float wave_sum(float v) {
#pragma unroll
    for (int o = 1; o < 64; o <<= 1) v += SHFL_XOR(v, o);
    return v;
}
DEV float wave_max(float v) {
#pragma unroll
    for (int o = 1; o < 64; o <<= 1) v = fmaxf(v, SHFL_XOR(v, o));
    return v;
}
DEV bf16x8 ld16(const void* p) { return *(const bf16x8*)p; }
DEV bf16x8 pack_acc(const f32x16& x, int s) {
    u32x4 p; p[0] = pk2(x[8 * s + 0], x[8 * s + 1]); p[1] = pk2(x[8 * s + 2], x[8 * s + 3]); p[2] = pk2(x[8 * s + 4], x[8 * s + 5]); p[3] = pk2(x[8 * s + 6], x[8 * s + 7]);
    return __builtin_bit_cast(bf16x8, p);
}
DEV bf16x8 cat44(bf16x4 lo, bf16x4 hi) { return __builtin_shufflevector(lo, hi, 0, 1, 2, 3, 4, 5, 6, 7); }
#ifndef EMU
DEV float fast_expf_(float x) { return __builtin_amdgcn_exp2f(x * 1.4426950408889634f); }
#define expf(x) fast_expf_(x)
#endif
#ifdef EMU
DEV float sigmoidf_(float x) { return 1.0f / (1.0f + expf(-x)); }
DEV float siluf_(float x) { return x / (1.0f + expf(-x)); }
#else
DEV float sigmoidf_(float x) { return __builtin_amdgcn_rcpf(1.0f + __builtin_amdgcn_exp2f(x * -1.4426950408889634f)); }
DEV float siluf_(float x) { return x * __builtin_amdgcn_rcpf(1.0f + __builtin_amdgcn_exp2f(x * -1.4426950408889634f)); }
#endif
DEV float log1pexp_(float nax) {
    const float e = expf(nax), u = 1.0f + e, d = u - 1.0f; return d == 0.0f ? e : LOGF_NATIVE(u) * (e / d); }
DEV float logsigmoidf_(float x) { return fminf(x, 0.0f) - log1pexp_(-fabsf(x)); }
DEV float softplusf_(float x) { return fmaxf(x, 0.0f) + log1pexp_(-fabsf(x)); }

constexpr size_t al256(size_t x) { return (x + 255) & ~(size_t)255; }
constexpr size_t cmax(size_t a, size_t b) { return a > b ? a : b; }
constexpr size_t OFF_CTL = 0;
constexpr size_t OFF_MOD = 1u << 20;
constexpr size_t SZ_MOD = al256((size_t)DEPTH * 9 * 6 * D * 4);
constexpr size_t ZERO_BYTES = OFF_MOD + SZ_MOD;
constexpr size_t OFF_ROPE = ZERO_BYTES;
constexpr size_t OFF_G = OFF_ROPE + al256((size_t)SEQ * 64 * 4);
constexpr size_t OFF_X = OFF_G + al256((size_t)MT * 16 * 4);
constexpr size_t OFF_WIN = OFF_X + al256((size_t)MT * D * 4);
constexpr size_t OFF_WOUT = OFF_WIN + al256((size_t)NE * D * 2);
constexpr size_t OFF_P = OFF_WOUT + al256((size_t)D * 1024 * 2);
constexpr size_t SZ_P = al256((size_t)MT * cmax(NE, FF) * 2);
constexpr size_t OFF_HY = OFF_P + SZ_P;
constexpr size_t OFF_S = OFF_HY + al256((size_t)MT * cmax(D, 1024) * 2);
constexpr size_t PE_QA = 0, PE_KA = (size_t)MT * 512, PE_VA = (size_t)MT * 1024, PE_BQ = (size_t)MT * 1536, PE_BK = (size_t)MT * 1792, PE_BV = (size_t)MT * 2048, PE_BO = (size_t)MT * 2560;
constexpr size_t PO_QC = 0, PO_KVC = (size_t)MT * 512, PO_DQKV = (size_t)MT * 768, PO_Z = (size_t)MT * 2304;
constexpr size_t SE_KP = OFF_S;
constexpr size_t SE_VT = SE_KP + al256((size_t)NB * 8 * LK * 64 * 2);
constexpr size_t SE_DCT = SE_VT + al256((size_t)NB * 4 * 128 * LK * 2);
constexpr size_t SE_DN = SE_DCT + al256((size_t)NCHAIN * NCH * 8192 * 4);
constexpr size_t SE_SC = SE_DN + al256((size_t)NCHAIN * NCH * 64 * 4);
constexpr size_t SE_PARK = SE_SC + al256((size_t)NCHAIN * NCH * 4 * 4);
constexpr size_t SE_END = SE_PARK + al256((size_t)256 * NTHREADS * 64 * 4);
constexpr size_t SF_WGU = OFF_S;
constexpr size_t SF_WDN = SF_WGU + al256((size_t)2 * FF * D * 2);
constexpr size_t SF_END = SF_WDN + al256((size_t)D * FF * 2);
constexpr size_t SF_PART = SF_END;
constexpr size_t SF_PART_END = SF_PART + (size_t)128 * 65536 * 4;
constexpr size_t WS_NEED_EF = cmax(SE_END, SF_PART_END);

constexpr int LDS_BYTES = 147456;
constexpr int LDS_MISC = 131072;

struct Args { const float* in[25]; float* out; unsigned char* ws; int step_lo, step_hi, prologue, final_; };

struct Ctx {
    int tid, lane, wave, bid, nblk, gw, ngw;
    char* lds;
    const float* const* in; float* out; unsigned char* ws;
};
#ifdef EMU
#define PHASE_CTX(pc) const Ctx& pc = c
#else
#define PHASE_CTX(pc) Ctx pc = c; { int t_ = threadIdx.x; asm volatile("" : "+v"(t_)); pc.tid = t_; pc.lane = t_ & 63; pc.wave = __builtin_amdgcn_readfirstlane(t_ >> 6); pc.gw = pc.bid * NWAVES + pc.wave; \
    __attribute__((address_space(1))) unsigned char* g_ = (__attribute__((address_space(1))) unsigned char*)c.ws; asm volatile("" : "+s"(g_)); pc.ws = (unsigned char*)g_; }
#endif

#ifdef EMU
struct XcdBarrier { int dummy; };
#define GRID_BARRIER() emu::grid_sync()
#else
#define LAS __attribute__((address_space(3)))
#define XB_TMO      128
#define XB_XCNT(j)  (256  + 64 * (j))
#define XB_XSUB(j)  (1280 + 64 * (j))
#define XB_XGEN(j)  (2304 + 64 * (j))
#define XB_TOP      3328
#define XB_TOPGEN   3392
#define XCD_BAR_WORDS 3456
#define XB_SPIN_CAP (1u << 24)
__device__ __forceinline__ unsigned xb_ld(unsigned* p)              { return __hip_atomic_load(p, __ATOMIC_RELAXED, __HIP_MEMORY_SCOPE_AGENT); }
__device__ __forceinline__ unsigned xb_add(unsigned* p, unsigned v) { return __hip_atomic_fetch_add(p, v, __ATOMIC_RELAXED, __HIP_MEMORY_SCOPE_AGENT); }
__device__ __forceinline__ unsigned xb_xcc_id() { return (unsigned)__builtin_amdgcn_s_getreg((3 << 11) | 20) & 0xFu; }
#define XB_SPIN(cond, bar) do { unsigned _sp = 0; while (cond) { __builtin_amdgcn_s_sleep(1); \
    if ((++_sp & 255u) == 0u) { if (xb_ld(&(bar)[XB_TMO])) break; if (_sp > XB_SPIN_CAP) { atomicAdd(&(bar)[XB_TMO], 1u); break; } } } } while (0)
struct XcdBarrier { unsigned* bar; unsigned x; volatile LAS unsigned* st; };
__device__ __forceinline__ XcdBarrier xcd_barrier_post(unsigned* bar, volatile LAS unsigned* st) {
    XcdBarrier b; b.bar = bar; b.x = xb_xcc_id(); b.st = st;
    if (threadIdx.x == 0) (void)xb_add(&bar[XB_XCNT(b.x)], 1u);
    return b;
}
__device__ __forceinline__ void xcd_barrier_complete(unsigned* bar, unsigned x, unsigned& nloc, unsigned& nx) {
    const unsigned G = gridDim.x * gridDim.y * gridDim.z;
    unsigned sum, cnt, mine, sp = 0u;
    for (;;) {
        sum = 0u; cnt = 0u; mine = 0u;
#pragma unroll
        for (unsigned j = 0; j < 16; ++j) { const unsigned c = xb_ld(&bar[XB_XCNT(j)]); sum += c; cnt += (c > 0u) ? 1u : 0u; mine = (j == x) ? c : mine; }
        if (sum == G) break;
        __builtin_amdgcn_s_sleep(1);
        if ((++sp & 255u) == 0u) { if (xb_ld(&bar[XB_TMO])) break; if (sp > XB_SPIN_CAP) { atomicAdd(&bar[XB_TMO], 1u); break; } }
    }
    nloc = mine > 0u ? mine : 1u; nx = cnt > 0u ? cnt : 1u;
}
__device__ __forceinline__ void xcd_barrier(const XcdBarrier& b) {
    const bool leader = threadIdx.x == 0;
    asm volatile("s_waitcnt vmcnt(0)" ::: "memory");
    __syncthreads();
    if (leader) {
        unsigned* bar = b.bar;
        __builtin_amdgcn_s_waitcnt(0);
        unsigned nloc = b.st[0], nx = b.st[1];
        if (nloc == 0u) { xcd_barrier_complete(bar, b.x, nloc, nx); b.st[0] = nloc; b.st[1] = nx; }
        const unsigned old = xb_add(&bar[XB_XSUB(b.x)], 1u);
        const unsigned gen = old / nloc;
        if (old + 1u == (gen + 1u) * nloc) {
            __builtin_amdgcn_fence(__ATOMIC_RELEASE, "agent");
            asm volatile("s_waitcnt vmcnt(0)" ::: "memory");
            const unsigned og = xb_add(&bar[XB_TOP], 1u);
            const unsigned tg = og / nx;
            if (og + 1u == (tg + 1u) * nx) xb_add(&bar[XB_TOPGEN], 1u);
            else XB_SPIN(xb_ld(&bar[XB_TOPGEN]) == tg, bar);
            __builtin_amdgcn_fence(__ATOMIC_ACQUIRE, "agent");
            xb_add(&bar[XB_XGEN(b.x)], 1u);
            asm volatile("s_waitcnt vmcnt(0)" ::: "memory");
        } else {
            XB_SPIN(xb_ld(&bar[XB_XGEN(b.x)]) == gen, bar);
            __builtin_amdgcn_fence(__ATOMIC_ACQUIRE, "agent");
            asm volatile("s_waitcnt vmcnt(0)" ::: "memory");
        }
    }
    __syncthreads();
}
#ifdef USE_CG_SYNC
#define GRID_BARRIER() cg::this_grid().sync()
#else
#define GRID_BARRIER() xcd_barrier(bar)
#endif
#endif

#ifndef EMU
namespace pg8 {
#define PG8_LAS __attribute__((address_space(3)))
typedef unsigned short bf16_t;
typedef short bf16x8 __attribute__((ext_vector_type(8)));
typedef float f32x4 __attribute__((ext_vector_type(4)));
typedef unsigned u32x4 __attribute__((ext_vector_type(4)));
constexpr int BM = 256, BK = 64, HALF = 128, HTB = HALF * BK * 2  , STAGE_BYTES = 8 * HTB, NXCD = 8, WGM = 8;

__host__ __device__ __forceinline__ int lds_byte(int r, int c) { const int st = (r >> 4) * 2 + (c >> 5), rr = r & 15, cc = c & 31, ob = rr * 64 + cc * 2; return st * 1024 + (ob ^ (((ob >> 9) & 1) << 5)); }
__host__ __device__ __forceinline__ void stage_rc(int b, int& R, int& C) { const int st = b / 1024, sb = b % 1024, swz = sb ^ (((sb >> 9) & 1) << 5); R = (st >> 1) * 16 + swz / 64; C = (st & 1) * 32 + (swz % 64) / 2; }
__host__ __device__ __forceinline__ int perm32(int rho) { const int n = rho >> 4, i = rho & 15; return 8 * (i >> 2) + 4 * n + (i & 3); }

struct Unit { int pm, pn; };
struct Gemm { const bf16_t* A; const bf16_t* Bt; int M, N, K, ld; };

struct StaticOrder {
    int nM, nN, nwg, G, c, wave, lim;
    int tn, tpm, tpn, tw;
    __host__ __device__ void init(int M, int N, int G_, int c_) { nM = M / BM; nN = N / BM; nwg = nM * nN; G = G_; c = c_; lim = 0x7fffffff; tn = 0; tpm = 0; tpn = 0; tw = 1; }
    __host__ __device__ bool next(int i, Unit& u) const {
        const long L = (long)i * G + c; if (L >= nwg + tn || L >= lim) return false;
        if (L >= nwg) { const int idx = (int)L - nwg; u.pm = tpm + idx / tw; u.pn = tpn + idx % tw; return true; }
        int wgid = (int)L; { const int q = nwg / NXCD, r = nwg % NXCD, xcd = wgid % NXCD, off = wgid / NXCD; wgid = (xcd < r ? xcd * (q + 1) : r * (q + 1) + (xcd - r) * q) + off; }
        const int nig = WGM * nN, gid = wgid / nig, fm = gid * WGM, gsz = (nM - fm) < WGM ? (nM - fm) : WGM;
        u.pm = fm + ((wgid % nig) % gsz); u.pn = (wgid % nig) / gsz; return true;
    }
    __device__ __forceinline__ void a_ready(const Unit&) const {}
    __device__ __forceinline__ void done(const Unit&) const {}
};
template <class Epi, class Sched, bool ALIGN_EPI = false, bool SP2 = false>
__device__ __forceinline__ void gemm_phase(PG8_LAS unsigned char* lds, const Gemm g, const Sched& S, const Epi& E) {
    int tid_ = threadIdx.x; asm volatile("" : "+v"(tid_));
    const int tid = tid_, wid = __builtin_amdgcn_readfirstlane(tid >> 6), lane = tid & 63, wr = wid >> 2, wc = wid & 3, fr = lane & 15, fq = lane >> 4;
    const int K = g.K, nt = K / BK, LD = g.ld ? g.ld : g.K;
    unsigned voffA[2], voffB[2];
#pragma unroll
    for (int i = 0; i < 2; ++i) { int R, C; stage_rc(tid * 16 + i * 8192, R, C); const int Rb = Epi::PERM ? ((R & ~31) + perm32(R & 31)) : R;
        voffA[i] = (unsigned)(R * LD + C) * 2u; voffB[i] = (unsigned)(Rb * LD + C) * 2u; }
    const size_t kstep = (size_t)(BK * 2);
    const size_t hstep = (size_t)HALF * LD * 2;
    const size_t tstep = 2 * hstep;
    const unsigned ldsw = (unsigned)wid * 1024u;
    const int aoff = lds_byte(wr * 64 + fr, fq * 8), boff = lds_byte(wc * 32 + fr, fq * 8);
#define PG8_SA(b, h) (((b) * 2 + (h)) * HTB)
#define PG8_SB(b, h) ((4 + (b) * 2 + (h)) * HTB)
#define PG8_STAGE(bufoff, gbase, voff) do { _Pragma("unroll") for (int _i = 0; _i < 2; ++_i) \
        __builtin_amdgcn_global_load_lds((const unsigned*)((const char*)(gbase) + (voff)[_i]), (PG8_LAS unsigned*)(lds + (bufoff) + ldsw + _i * 8192), 16, 0, 0); } while (0)
#define PG8_LDA(dst, b, h) do { _Pragma("unroll") for (int m = 0; m < 4; ++m) _Pragma("unroll") for (int k = 0; k < 2; ++k) dst[m][k] = *(const PG8_LAS bf16x8*)(lds + PG8_SA(b, h) + aoff + m * 2048 + k * 1024); } while (0)
#define PG8_LDB(dst, b, h) do { _Pragma("unroll") for (int n = 0; n < 2; ++n) _Pragma("unroll") for (int k = 0; k < 2; ++k) dst[n][k] = *(const PG8_LAS bf16x8*)(lds + PG8_SB(b, h) + boff + n * 2048 + k * 1024); } while (0)
#define PG8_MMA(ai, bj, At, Bt) do { __builtin_amdgcn_s_setprio(1); _Pragma("unroll") for (int m = 0; m < 4; ++m) _Pragma("unroll") for (int n = 0; n < 2; ++n) _Pragma("unroll") for (int k = 0; k < 2; ++k) \
        acc[ai][bj][m][n] = __builtin_amdgcn_mfma_f32_16x16x32_bf16(Bt[n][k], At[m][k], acc[ai][bj][m][n], 0, 0, 0); __builtin_amdgcn_s_setprio(0); } while (0)
#define PG8_WAIT_V(n) asm volatile("s_waitcnt vmcnt(" #n ")" ::: "memory")
#define PG8_WAIT_L(n) asm volatile("s_waitcnt lgkmcnt(" #n ")" ::: "memory")
#define PG8_BAR __builtin_amdgcn_s_barrier()
#define PG8_SCHED __builtin_amdgcn_sched_barrier(0)
    Unit cur, nxt; int ui = 0;
    if (!S.next(0, cur)) return;
    f32x4 acc[2][2][4][2];
#pragma unroll
    for (int a = 0; a < 2; ++a)
#pragma unroll
        for (int b = 0; b < 2; ++b)
#pragma unroll
            for (int m = 0; m < 4; ++m)
#pragma unroll
                for (int n = 0; n < 2; ++n) acc[a][b][m][n] = (f32x4){0.f, 0.f, 0.f, 0.f};
    bf16x8 At[4][2], B0[2][2], B1[2][2];
    const char* cA = (const char*)g.A + (size_t)cur.pm * tstep; const char* cB = (const char*)g.Bt + (size_t)cur.pn * tstep;
    S.a_ready(cur);
    if constexpr (SP2) {
        PG8_STAGE(PG8_SB(0, 0), cB, voffB); PG8_STAGE(PG8_SB(0, 1), cB + hstep, voffB); PG8_STAGE(PG8_SA(0, 0), cA, voffA); PG8_STAGE(PG8_SA(0, 1), cA + hstep, voffA);
        if (wr == 1) PG8_BAR;
        PG8_WAIT_V(2); PG8_BAR;
        PG8_STAGE(PG8_SB(1, 0), cB + kstep, voffB); PG8_STAGE(PG8_SA(1, 0), cA + kstep, voffA); PG8_STAGE(PG8_SB(1, 1), cB + hstep + kstep, voffB);
        PG8_WAIT_V(6); PG8_BAR;
    } else {
        PG8_STAGE(PG8_SB(0, 0), cB, voffB); PG8_STAGE(PG8_SA(0, 0), cA, voffA); PG8_STAGE(PG8_SB(0, 1), cB + hstep, voffB); PG8_STAGE(PG8_SA(0, 1), cA + hstep, voffA);
        if (wr == 1) PG8_BAR;
        PG8_WAIT_V(4); PG8_BAR;
        PG8_STAGE(PG8_SB(1, 0), cB + kstep, voffB); PG8_STAGE(PG8_SA(1, 0), cA + kstep, voffA); PG8_STAGE(PG8_SB(1, 1), cB + hstep + kstep, voffB);
        PG8_WAIT_V(6); PG8_BAR;
    }
    for (;;) {
        const bool has_next = S.next(ui + 1, nxt);
        const char* nA = has_next ? (const char*)g.A + (size_t)nxt.pm * tstep : cA; const char* nB = has_next ? (const char*)g.Bt + (size_t)nxt.pn * tstep : cB;
        for (int t = 0; t < nt; t += 2) {
            const bool last = (t == nt - 2);
            const char* a1 = cA + (size_t)(t + 1) * kstep;
            const char* a2 = last ? nA : cA + (size_t)(t + 2) * kstep; const char* b2 = last ? nB : cB + (size_t)(t + 2) * kstep;
            const char* a3 = a2 + kstep; const char* b3 = b2 + kstep;
            if (last && has_next) S.a_ready(nxt);
            if constexpr (SP2) {
            PG8_LDB(B0, 0, 0); PG8_LDB(B1, 0, 1); PG8_SCHED; PG8_LDA(At, 0, 0); PG8_STAGE(PG8_SA(1, 1), a1 + hstep, voffA);
            PG8_WAIT_V(8); PG8_WAIT_L(0); PG8_BAR; PG8_MMA(0, 0, At, B0); PG8_MMA(0, 1, At, B1); PG8_BAR; PG8_SCHED;
            PG8_LDA(At, 0, 1); PG8_STAGE(PG8_SB(0, 0), b2, voffB); PG8_STAGE(PG8_SB(0, 1), b2 + hstep, voffB); PG8_STAGE(PG8_SA(0, 0), a2, voffA);
            PG8_WAIT_V(8); PG8_WAIT_L(0); PG8_BAR; PG8_MMA(1, 0, At, B0); PG8_MMA(1, 1, At, B1); PG8_BAR; PG8_SCHED;
            PG8_LDB(B0, 1, 0); PG8_LDB(B1, 1, 1); PG8_SCHED; PG8_LDA(At, 1, 0); PG8_STAGE(PG8_SA(0, 1), a2 + hstep, voffA);
            PG8_WAIT_V(8); PG8_WAIT_L(0); PG8_BAR; PG8_MMA(0, 0, At, B0); PG8_MMA(0, 1, At, B1); PG8_BAR; PG8_SCHED;
            PG8_LDA(At, 1, 1); PG8_STAGE(PG8_SB(1, 0), b3, voffB); PG8_STAGE(PG8_SB(1, 1), b3 + hstep, voffB); PG8_STAGE(PG8_SA(1, 0), a3, voffA);
            PG8_WAIT_V(8); PG8_WAIT_L(0); PG8_BAR; PG8_MMA(1, 0, At, B0); PG8_MMA(1, 1, At, B1); PG8_BAR; PG8_SCHED;
            } else {
            PG8_LDB(B0, 0, 0); PG8_SCHED; PG8_LDA(At, 0, 0); PG8_STAGE(PG8_SA(1, 1), a1 + hstep, voffA);
            PG8_WAIT_L(8); PG8_BAR; PG8_WAIT_L(0); PG8_MMA(0, 0, At, B0); PG8_BAR; PG8_SCHED;
            PG8_LDB(B1, 0, 1); PG8_STAGE(PG8_SB(0, 0), b2, voffB);
            PG8_BAR; PG8_WAIT_L(0); PG8_MMA(0, 1, At, B1); PG8_BAR;
            PG8_LDA(At, 0, 1); PG8_STAGE(PG8_SA(0, 0), a2, voffA);
            PG8_BAR; PG8_WAIT_L(0); PG8_MMA(1, 0, At, B0); PG8_BAR; PG8_SCHED;
            PG8_STAGE(PG8_SB(0, 1), b2 + hstep, voffB);
            PG8_WAIT_V(6); PG8_BAR; PG8_MMA(1, 1, At, B1); PG8_BAR;
            PG8_LDB(B0, 1, 0); PG8_SCHED; PG8_LDA(At, 1, 0); PG8_STAGE(PG8_SA(0, 1), a2 + hstep, voffA);
            PG8_WAIT_L(8); PG8_BAR; PG8_WAIT_L(0); PG8_MMA(0, 0, At, B0); PG8_BAR; PG8_SCHED;
            PG8_LDB(B1, 1, 1); PG8_STAGE(PG8_SB(1, 0), b3, voffB);
            PG8_BAR; PG8_WAIT_L(0); PG8_MMA(0, 1, At, B1); PG8_BAR;
            PG8_LDA(At, 1, 1); PG8_STAGE(PG8_SA(1, 0), a3, voffA);
            PG8_BAR; PG8_WAIT_L(0); PG8_MMA(1, 0, At, B0); PG8_BAR; PG8_SCHED;
            PG8_STAGE(PG8_SB(1, 1), b3 + hstep, voffB);
            PG8_WAIT_V(6); PG8_BAR; PG8_MMA(1, 1, At, B1); PG8_BAR;
            }
        }
        if constexpr (ALIGN_EPI) { if (wr == 0) PG8_BAR; }
        if constexpr (!Epi::AFTER_DRAIN) { E(acc, cur, wr, wc, fr, fq); S.done(cur); }
        if (!has_next) break;
#pragma unroll
        for (int a = 0; a < 2; ++a)
#pragma unroll
            for (int b = 0; b < 2; ++b)
#pragma unroll
                for (int m = 0; m < 4; ++m)
#pragma unroll
                    for (int n = 0; n < 2; ++n) acc[a][b][m][n] = (f32x4){0.f, 0.f, 0.f, 0.f};
        cur = nxt; cA = nA; cB = nB; ++ui;
        if constexpr (ALIGN_EPI) { if (wr == 1) PG8_BAR; }
    }
    PG8_WAIT_V(0);
    if constexpr (!ALIGN_EPI) { if (wr == 0) PG8_BAR; }
    PG8_BAR;
    if constexpr (Epi::AFTER_DRAIN) { E.fused(acc, cur, wr, wc, fr, fq, lds, wid, lane); S.done(cur); }
#undef PG8_SA
#undef PG8_SB
#undef PG8_STAGE
#undef PG8_LDA
#undef PG8_LDB
#undef PG8_MMA
#undef PG8_WAIT_V
#undef PG8_WAIT_L
#undef PG8_BAR
#undef PG8_SCHED
}
}
#else
namespace pg8 {
typedef unsigned short bf16_t;
constexpr int BM = 256, BK = 64, HALF = 128, NXCD = 8, WGM = 8;
struct Unit { int pm, pn; };
struct Gemm { const bf16_t* A; const bf16_t* Bt; int M, N, K, ld; };
struct StaticOrder {
    int nM, nN, nwg, G, c, wave, lim, tn, tpm, tpn, tw;
    void init(int M, int N, int G_, int c_) { nM = M / BM; nN = N / BM; nwg = nM * nN; G = G_; c = c_; lim = 0x7fffffff; tn = 0; tpm = 0; tpn = 0; tw = 1; }
    bool next(int i, Unit& u) const {
        const long L = (long)i * G + c; if (L >= nwg + tn || L >= lim) return false;
        if (L >= nwg) { const int idx = (int)L - nwg; u.pm = tpm + idx / tw; u.pn = tpn + idx % tw; return true; }
        int wgid = (int)L; { const int q = nwg / NXCD, r = nwg % NXCD, xcd = wgid % NXCD, off = wgid / NXCD; wgid = (xcd < r ? xcd * (q + 1) : r * (q + 1) + (xcd - r) * q) + off; }
        const int nig = WGM * nN, gid = wgid / nig, fm = gid * WGM, gsz = (nM - fm) < WGM ? (nM - fm) : WGM;
        u.pm = fm + ((wgid % nig) % gsz); u.pn = (wgid % nig) / gsz; return true;
    }
};
template <class Epi, class Sched, bool ALIGN_EPI = false, bool SP2 = false>
static inline void gemm_phase(unsigned char* lds, const Gemm g, const Sched& S, const Epi& E) {
    const int tid = TIDX, wid = tid >> 6, lane = tid & 63, wr = wid >> 2, wc = wid & 3, fr = lane & 15, fq = lane >> 4;
    Unit u;
    for (int i = 0; S.next(i, u); ++i) {
        f32x4 acc[2][2][4][2];
        for (int ai = 0; ai < 2; ++ai) for (int bj = 0; bj < 2; ++bj) for (int m = 0; m < 4; ++m) for (int n = 0; n < 2; ++n) for (int j = 0; j < 4; ++j) {
            const int row = 256 * u.pm + 128 * ai + 64 * wr + 16 * m + fr;
            const int col = Epi::PERM ? 256 * u.pn + 128 * bj + 32 * wc + 8 * fq + 4 * n + j : 256 * u.pn + 128 * bj + 32 * wc + 16 * n + 4 * fq + j;
            const int ld = g.ld ? g.ld : g.K; const bf16_t* a = g.A + (size_t)row * ld; const bf16_t* b = g.Bt + (size_t)col * ld; float s = 0.f;
            for (int k = 0; k < g.K; ++k) s += bf2f(a[k]) * bf2f(b[k]);
            acc[ai][bj][m][n][j] = s; }
        E(acc, u, wr, wc, fr, fq);
    }
    BLOCK_SYNC();
}
}
#define PG8_LAS
#endif

#if !defined(EMU) && defined(SIMPLE_GEMM)
namespace sg {
template <class Epi, class Sched>
__device__ __forceinline__ void gemm_phase(const pg8::Gemm g, const Sched& S, const Epi& E) {
    int tid_ = threadIdx.x; asm volatile("" : "+v"(tid_));
    const int tid = tid_, wid = __builtin_amdgcn_readfirstlane(tid >> 6), lane = tid & 63, wr = wid >> 2, wc = wid & 3, fr = lane & 15, fq = lane >> 4;
    pg8::Unit u;
    for (int i = 0; S.next(i, u); ++i) {
        f32x4 acc[2][2][4][2];
#pragma unroll
        for (int ai = 0; ai < 2; ++ai)
#pragma unroll
            for (int bj = 0; bj < 2; ++bj)
#pragma unroll
                for (int m = 0; m < 4; ++m)
#pragma unroll
                    for (int n = 0; n < 2; ++n) acc[ai][bj][m][n] = (f32x4){0.f, 0.f, 0.f, 0.f};
        const bf16_t* wp0 = g.Bt + (size_t)(256 * u.pn + 32 * wc + (Epi::PERM ? 8 * (fr >> 2) + (fr & 3) : fr)) * g.K + 8 * fq;
        const bf16_t* xp0 = g.A + (size_t)(256 * u.pm + 64 * wr + fr) * g.K + 8 * fq;
#pragma unroll 1
        for (int k0 = 0; k0 < g.K; k0 += 32) {
            bf16x8 wf[2][2], xf[2][4];
#pragma unroll
            for (int bj = 0; bj < 2; ++bj)
#pragma unroll
                for (int n = 0; n < 2; ++n) wf[bj][n] = *(const bf16x8*)(wp0 + (size_t)(128 * bj + (Epi::PERM ? 4 : 16) * n) * g.K + k0);
#pragma unroll
            for (int ai = 0; ai < 2; ++ai)
#pragma unroll
                for (int m = 0; m < 4; ++m) xf[ai][m] = *(const bf16x8*)(xp0 + (size_t)(128 * ai + 16 * m) * g.K + k0);
#pragma unroll
            for (int ai = 0; ai < 2; ++ai)
#pragma unroll
                for (int bj = 0; bj < 2; ++bj)
#pragma unroll
                    for (int m = 0; m < 4; ++m)
#pragma unroll
                        for (int n = 0; n < 2; ++n) acc[ai][bj][m][n] = __builtin_amdgcn_mfma_f32_16x16x32_bf16(wf[bj][n], xf[ai][m], acc[ai][bj][m][n], 0, 0, 0);
        }
        E(acc, u, wr, wc, fr, fq);
    }
}
}
#define GEMM_PHASE(EpiT, lds, g, S, E) sg::gemm_phase<EpiT, pg8::StaticOrder>(g, S, E)
#else
#define GEMM_PHASE(EpiT, lds, g, S, E) pg8::gemm_phase<EpiT, pg8::StaticOrder, true, true>((PG8_LAS unsigned char*)(lds), g, S, E)
#endif

struct EpiSeg {
    static constexpr bool PERM = true, AFTER_DRAIN = false;
    bf16_t* P; int odd;
    DEVM void operator()(const f32x4 (&acc)[2][2][4][2], const pg8::Unit& u, int wr, int wc, int fr, int fq) const {
        size_t off; int pitch, c0;
        const int pn = u.pn;
        if (!odd) {
            if (pn < 2) { off = PE_QA; pitch = 512; c0 = 256 * pn; } else if (pn < 4) { off = PE_KA; pitch = 512; c0 = 256 * (pn - 2); } else if (pn < 6) { off = PE_VA; pitch = 512; c0 = 256 * (pn - 4); }
            else if (pn == 6) { off = PE_BQ; pitch = 256; c0 = 0; } else if (pn == 7) { off = PE_BK; pitch = 256; c0 = 0; } else if (pn < 10) { off = PE_BV; pitch = 512; c0 = 256 * (pn - 8); } else { off = PE_BO; pitch = 512; c0 = 256 * (pn - 10); }
        } else {
            if (pn < 2) { off = PO_QC; pitch = 512; c0 = 256 * pn; } else if (pn == 2) { off = PO_KVC; pitch = 256; c0 = 0; } else if (pn < 9) { off = PO_DQKV; pitch = 1536; c0 = 256 * (pn - 3); } else { off = PO_Z; pitch = 512; c0 = 256 * (pn - 9); }
        }
        bf16_t* base = P + off;
        const int row0 = u.pm * 256 + wr * 64 + fr, col0 = c0 + wc * 32 + 8 * fq;
#pragma unroll
        for (int ai = 0; ai < 2; ++ai)
#pragma unroll
            for (int m = 0; m < 4; ++m) { bf16_t* rowp = base + (size_t)(row0 + ai * 128 + m * 16) * pitch + col0;
#pragma unroll
                for (int bj = 0; bj < 2; ++bj) { const f32x4 v0 = acc[ai][bj][m][0], v1 = acc[ai][bj][m][1];
                    u32x4 w; w[0] = pk2(v0[0], v0[1]); w[1] = pk2(v0[2], v0[3]); w[2] = pk2(v1[0], v1[1]); w[3] = pk2(v1[2], v1[3]);
                    *(u32x4*)(rowp + bj * 128) = w; } }
    }
};
struct EpiResid {
    static constexpr bool PERM = false, AFTER_DRAIN = false;
    float* X; const float* mod; int gaoff;
    const float* XL; const float* XC;
    DEVM void operator()(const f32x4 (&acc)[2][2][4][2], const pg8::Unit& u, int wr, int wc, int fr, int fq) const {
        const int rowt = u.pm * 256; const int mr = rowt < ML ? rowt / SEQ : NB;
        const float* ga = mod + (size_t)mr * 6 * D + gaoff; const float* Xs = rowt < ML ? XL : XC;
        const int row0 = rowt + wr * 64 + fr, col0 = u.pn * 256 + wc * 32 + 4 * fq;
#pragma unroll
        for (int bj = 0; bj < 2; ++bj)
#pragma unroll
            for (int n = 0; n < 2; ++n) { const int c = col0 + bj * 128 + n * 16; const f32x4 g = *(const f32x4*)(ga + c);
#pragma unroll
                for (int ai = 0; ai < 2; ++ai)
#pragma unroll
                    for (int m = 0; m < 4; ++m) { const size_t off = (size_t)(row0 + ai * 128 + m * 16) * D + c; const f32x4 x = *(const f32x4*)(Xs + off); *(f32x4*)(X + off) = x + g * acc[ai][bj][m][n]; } }
    }
};
struct EpiPart {
    static constexpr bool PERM = false, AFTER_DRAIN = false;
    float* P;
    DEVM void operator()(const f32x4 (&acc)[2][2][4][2], const pg8::Unit& u, int wr, int wc, int fr, int fq) const {
        (void)u; const int r0 = wr * 64 + fr, c0 = wc * 32 + 4 * fq;
#pragma unroll
        for (int bj = 0; bj < 2; ++bj)
#pragma unroll
            for (int n = 0; n < 2; ++n)
#pragma unroll
                for (int ai = 0; ai < 2; ++ai)
#pragma unroll
                    for (int m = 0; m < 4; ++m) *(f32x4*)(P + (size_t)(r0 + ai * 128 + m * 16) * 256 + c0 + bj * 128 + n * 16) = acc[ai][bj][m][n];
    }
};
struct SplitPlan { int extra, split, nwg; };
DEV SplitPlan split_plan(int mrows, int kdim, int nblk, bool allow) {
    SplitPlan p; p.nwg = (mrows / 256) * (D / 256); p.extra = 0; p.split = 1;
    if (allow && p.nwg > nblk && p.nwg < 2 * nblk) { const int pairs = kdim / 128; int sp = 4; const int ex = p.nwg - nblk;
        while (sp > 1 && (ex * sp > nblk || sp > pairs || ex * sp > 128)) sp >>= 1;
        if (sp > 1) { p.extra = ex; p.split = sp; } }
    return p;
}

struct EpiSwiglu {
    static constexpr bool PERM = true, AFTER_DRAIN = false;
    bf16_t* ACT;
    DEVM void operator()(const f32x4 (&acc)[2][2][4][2], const pg8::Unit& u, int wr, int wc, int fr, int fq) const {
        const int row0 = u.pm * 256 + wr * 64 + fr, col0 = u.pn * 128 + wc * 32 + 8 * fq;
#pragma unroll
        for (int ai = 0; ai < 2; ++ai)
#pragma unroll
            for (int m = 0; m < 4; ++m) { bf16_t* rowp = ACT + (size_t)(row0 + ai * 128 + m * 16) * FF + col0;
                float v[8];
#pragma unroll
                for (int n = 0; n < 2; ++n)
#pragma unroll
                    for (int j = 0; j < 4; ++j) { const float g = acc[ai][0][m][n][j], up = acc[ai][1][m][n][j]; v[4 * n + j] = siluf_(g) * up; }
                u32x4 w; w[0] = pk2(v[0], v[1]); w[1] = pk2(v[2], v[3]); w[2] = pk2(v[4], v[5]); w[3] = pk2(v[6], v[7]);
                *(u32x4*)rowp = w; }
    }
};

DEV void p0_prologue(const Ctx& c) {
    const float* x = c.in[0]; const float* cv = c.in[1]; const float* ctx = c.in[2]; const float* cctx = c.in[3]; const float* w_ada = c.in[4]; const float* b_ada = c.in[5];
    float* MOD = (float*)(c.ws + OFF_MOD);
    const long gt = (long)c.bid * NTHREADS + c.tid, GT = (long)c.nblk * NTHREADS;
    {   constexpr int NCG = 6 * D / 128, KW = D / 8; f32x2* part = (f32x2*)c.lds;
        for (int it = c.bid; it < DEPTH * NCG; it += c.nblk) { const int l = it / NCG, cg = it % NCG; const int n2 = cg * 64 + c.lane;
            f32x2 acc[9];
#pragma unroll
            for (int r = 0; r < 9; ++r) acc[r] = (f32x2){0.f, 0.f};
            const float* W = w_ada + ((size_t)l * D + c.wave * KW) * 6 * D + 2 * n2;
#pragma unroll 8
            for (int k = 0; k < KW; ++k) { const f32x2 w = *(const f32x2*)(W + (size_t)k * 6 * D); const int kk = c.wave * KW + k;
#pragma unroll
                for (int r = 0; r < 9; ++r) { const float sv = siluf_(r < NB ? cv[r * D + kk] : cctx[kk]); acc[r] += w * sv; } }
#pragma unroll
            for (int r = 0; r < 9; ++r) part[(c.wave * 9 + r) * 64 + c.lane] = acc[r];
            BLOCK_SYNC();
            for (int o = c.tid; o < 9 * 64; o += NTHREADS) { const int r = o / 64, q = o % 64; f32x2 sum = *(const f32x2*)(b_ada + (size_t)l * 6 * D + 2 * (cg * 64 + q));
#pragma unroll
                for (int w = 0; w < 8; ++w) sum += part[(w * 9 + r) * 64 + q];
                *(f32x2*)(MOD + ((size_t)l * 9 + r) * 6 * D + 2 * (cg * 64 + q)) = sum; }
            BLOCK_SYNC(); } }
    float* COS = (float*)(c.ws + OFF_ROPE); float* SIN = COS + SEQ * 32;
    for (long it = gt; it < (long)SEQ * 32; it += GT) { const int t = (int)(it >> 5), i = (int)(it & 31);
        const float fr = expf(-(float)(i & 15) * (9.210340371976184f / 16.0f));     const float pos = (i < 16) ? (float)(t / GRIDW) : (float)(t % GRIDW); const float a = pos * fr;
        COS[it] = cosf(a); SIN[it] = sinf(a); }
    (void)x; (void)ctx;
}

DEV void transpose_item(const float* W, int srcpitch, int k0, int n0, bf16_t* WT, int Kp, int dstrow0, float* scr, int lane) {
#pragma unroll 8
    for (int i = 0; i < 32; ++i) { const int kk = 2 * i + (lane >> 5); scr[kk * 33 + (lane & 31)] = W[(size_t)(k0 + kk) * srcpitch + n0 + (lane & 31)]; }
    WAVE_FENCE();
    const int cc = lane & 7;
#pragma unroll
    for (int j = 0; j < 4; ++j) { const int n = (lane >> 3) + 8 * j; const float* s = scr + (8 * cc) * 33 + n;
        u32x4 o; o[0] = pk2(s[0 * 33], s[1 * 33]); o[1] = pk2(s[2 * 33], s[3 * 33]); o[2] = pk2(s[4 * 33], s[5 * 33]); o[3] = pk2(s[6 * 33], s[7 * 33]);
        *(u32x4*)(WT + (size_t)(dstrow0 + n) * Kp + k0 + 8 * cc) = o; }
    WAVE_FENCE();
}
DEV void convert_mixer_weights(const Ctx& c, int layer, int gw, int ngw) {
    float* scr = (float*)(c.lds + c.wave * 8448);
    const int odd = layer & 1, li = layer >> 1;
    const float* win = odd ? c.in[14] + (size_t)li * D * O_IN : c.in[8] + (size_t)li * D * E_IN; const int pin = odd ? O_IN : E_IN, nin = odd ? NO : NE;
    const float* wout = odd ? c.in[20] + (size_t)li * 1024 * D : c.in[13] + (size_t)li * 1024 * D;
    bf16_t* WIN = (bf16_t*)(c.ws + OFF_WIN); bf16_t* WOUT = (bf16_t*)(c.ws + OFF_WOUT);
    const int I1 = (D / 64) * (nin / 32), I2 = (1024 / 64) * (D / 32);
    for (int it = gw; it < I1 + I2; it += ngw) {
        if (it < I1) { const int nb = it % (nin / 32), kb = it / (nin / 32); transpose_item(win, pin, 64 * kb, 32 * nb, WIN, D, 32 * nb, scr, c.lane); }
        else { const int r = it - I1; const int nb = r % (D / 32), kb = r / (D / 32); transpose_item(wout, D, 64 * kb, 32 * nb, WOUT, 1024, 32 * nb, scr, c.lane); }
    }
}
DEV void convert_ffn_weights(const Ctx& c, int layer, int gw, int ngw) {
    float* scr = (float*)(c.lds + c.wave * 8448);
    const float* wg = c.in[21] + (size_t)layer * D * FF; const float* wu = c.in[22] + (size_t)layer * D * FF; const float* wd = c.in[23] + (size_t)layer * FF * D;
    bf16_t* WGU = (bf16_t*)(c.ws + SF_WGU); bf16_t* WDN = (bf16_t*)(c.ws + SF_WDN);
    const int I1 = (D / 64) * (FF / 32), I3 = (FF / 64) * (D / 32);
    for (int it = gw; it < 2 * I1 + I3; it += ngw) {
        if (it < 2 * I1) { const int up = it >= I1; const int r = up ? it - I1 : it; const int nb = r % (FF / 32), kb = r / (FF / 32); const int f0 = 32 * nb;
            transpose_item(up ? wu : wg, FF, 64 * kb, f0, WGU, D, (f0 / 128) * 256 + (up ? 128 : 0) + (f0 % 128), scr, c.lane); }
        else { const int r = it - 2 * I1; const int nb = r % (D / 32), kb = r / (D / 32); transpose_item(wd, D, 64 * kb, 32 * nb, WDN, FF, 32 * nb, scr, c.lane); }
    }
}
DEV void normalize_rows(const Ctx& c, int layer, int which, int nrows, SplitPlan red, int pmrows, const float* pga) {
    constexpr int NV = D / 256;
    float* X = (float*)(c.ws + OFF_X); bf16_t* H = (bf16_t*)(c.ws + OFF_HY); float* G = (float*)(c.ws + OFF_G);
    const float* MODL = (const float*)(c.ws + OFF_MOD) + (size_t)layer * 9 * 6 * D;
    const float* g = (which ? c.in[7] : c.in[6]) + (size_t)layer * D;
    const int odd = layer & 1, li = layer >> 1;
    const float* wgate = odd ? c.in[14] + (size_t)li * D * O_IN + NO : c.in[8] + (size_t)li * D * E_IN + NE; const int pg = odd ? O_IN : E_IN;
    float* wgt = (float*)c.lds;
    unsigned char* tab = (unsigned char*)(c.lds + 16 * D * 4);
    const float* PART = (const float*)(c.ws + SF_PART);
    if (red.extra) { BLOCK_SYNC();
        for (int e = c.tid; e < (pmrows / 256) * (D / 256); e += NTHREADS) tab[e] = 255;
        BLOCK_SYNC();
        if (c.tid < red.extra) { pg8::StaticOrder S2; S2.init(pmrows, D, red.nwg, c.nblk + c.tid); pg8::Unit u; if (S2.next(0, u)) tab[u.pm * (D / 256) + u.pn] = (unsigned char)c.tid; }
        BLOCK_SYNC(); }
    if (which == 0) { BLOCK_SYNC();
        for (int e = c.tid; e < D * 4; e += NTHREADS) { const int k = e >> 2, q = e & 3; const f32x4 w4 = *(const f32x4*)(wgate + (size_t)k * pg + 4 * q);
#pragma unroll
            for (int j = 0; j < 4; ++j) wgt[(4 * q + j) * D + k] = w4[j]; }
        BLOCK_SYNC(); }
    for (int row = c.gw; row < nrows; row += c.ngw) {
        const int mr = row < ML ? row / SEQ : NB;
        const float* sh = MODL + (size_t)mr * 6 * D + (which ? 3 : 0) * D; const float* sc = sh + D;
        const float* xrow = (layer == 0 && which == 0) ? (row < ML ? c.in[0] + (size_t)row * D : c.in[2] + (size_t)(row - ML) * D) : X + (size_t)row * D;
        const f32x4* xr = (const f32x4*)xrow + c.lane;
        f32x4 v[NV]; float ss = 0.f;
#pragma unroll
        for (int j = 0; j < NV; ++j) { v[j] = xr[64 * j];
            if (red.extra && row < pmrows) { const int lu = tab[(row >> 8) * (D / 256) + j];
                if (lu != 255) { const float* pp = PART + (size_t)lu * red.split * 65536 + (size_t)(row & 255) * 256 + 4 * c.lane; f32x4 sum = *(const f32x4*)pp;
                    for (int q = 1; q < red.split; ++q) sum += *(const f32x4*)(pp + (size_t)q * 65536);
                    v[j] += *(const f32x4*)(pga + (size_t)mr * 6 * D + 256 * j + 4 * c.lane) * sum; ((f32x4*)(X + (size_t)row * D) + c.lane)[64 * j] = v[j]; } }
            ss += (v[j][0] * v[j][0] + v[j][1] * v[j][1]) + (v[j][2] * v[j][2] + v[j][3] * v[j][3]); }
        const float rstd = 1.0f / sqrtf(wave_sum(ss) * (1.0f / D) + EPS);
        u32x2* o8 = (u32x2*)(H + (size_t)row * D) + c.lane;
        float ga[16];
#pragma unroll
        for (int n = 0; n < 16; ++n) ga[n] = 0.f;
#pragma unroll
        for (int j = 0; j < NV; ++j) { const int k0 = 256 * j + 4 * c.lane;
            const f32x4 gg = *(const f32x4*)(g + k0), s1 = *(const f32x4*)(sc + k0), s0 = *(const f32x4*)(sh + k0);
            f32x4 h = v[j] * rstd * gg * (s1 + 1.0f) + s0;
            u32x2 w; w[0] = pk2(h[0], h[1]); w[1] = pk2(h[2], h[3]); o8[64 * j] = w;
            if (which == 0) {
#pragma unroll
                for (int n = 0; n < 16; ++n) { const f32x4 w4 = *(const f32x4*)(wgt + n * D + k0); ga[n] += (h[0] * w4[0] + h[1] * w4[1]) + (h[2] * w4[2] + h[3] * w4[3]); if ((n & 3) == 3) SCHED_FENCE(); } } }
        if (which == 0) {
            const bool b5 = c.lane & 32, b4 = c.lane & 16, b3 = c.lane & 8, b2 = c.lane & 4;
            float w8[8], w4[4], w2[2];
#pragma unroll
            for (int n = 0; n < 8; ++n) { const float snd = b5 ? ga[n] : ga[n + 8], kp = b5 ? ga[n + 8] : ga[n]; w8[n] = kp + SHFL_XOR(snd, 32); }
#pragma unroll
            for (int n = 0; n < 4; ++n) { const float snd = b4 ? w8[n] : w8[n + 4], kp = b4 ? w8[n + 4] : w8[n]; w4[n] = kp + SHFL_XOR(snd, 16); }
#pragma unroll
            for (int n = 0; n < 2; ++n) { const float snd = b3 ? w4[n] : w4[n + 2], kp = b3 ? w4[n + 2] : w4[n]; w2[n] = kp + SHFL_XOR(snd, 8); }
            float z = (b2 ? w2[1] : w2[0]) + SHFL_XOR(b2 ? w2[0] : w2[1], 4);
            z += SHFL_XOR(z, 2); z += SHFL_XOR(z, 1);
            if ((c.lane & 3) == 0) G[(size_t)row * 16 + (b5 ? 8 : 0) + (b4 ? 4 : 0) + (b3 ? 2 : 0) + (b2 ? 1 : 0)] = z; }
    }
}

DEV int tok_row(int b, int tc, int i) { return tc < NCC ? ML + b * CTX + 64 * tc + i : b * SEQ + 64 * (tc - NCC) + i; }
DEV int pos_row(int b, int pos) { return pos < CTX ? ML + b * CTX + pos : b * SEQ + (pos - CTX); }
DEV int chain_chunk(int dir, int tc) { return dir == 0 ? tc : (tc < NCC ? NCC - 1 - tc : NCC + (NLC - 1 - (tc - NCC))); }
DEV void unpack8(bf16x8 v, float (&f)[8]) {
#pragma unroll
    for (int e = 0; e < 8; ++e) f[e] = bf2f((unsigned short)v[e]);
}
DEV bf16x8 pack8(const float (&f)[8]) { u32x4 p; p[0] = pk2(f[0], f[1]); p[1] = pk2(f[2], f[3]); p[2] = pk2(f[4], f[5]); p[3] = pk2(f[6], f[7]); return __builtin_bit_cast(bf16x8, p); }
DEV float chain_cumsum(float x, int lane, int dir) {
#pragma unroll
    for (int off = 1; off < 64; off <<= 1) { const int src = dir == 0 ? lane - off : lane + off; const float y = SHFL(x, src & 63); if (src >= 0 && src < 64) x += y; }
    return x;
}

constexpr int AT_KB = 64 * 72 * 2;
template <int DV> struct AttnLds { static constexpr int VB = DV * 72 * 2, BUF = AT_KB + VB; };

template <int DV>
DEV void attn_stage_load(const Ctx& c, const bf16_t* Kp, const bf16_t* Vt, int vpitch, int tile, bf16x8& kreg, bf16x8 (&vreg)[DV / 64]) {
    kreg = ld16(Kp + (size_t)(tile * 64 + (c.tid >> 3)) * 64 + (c.tid & 7) * 8);
#pragma unroll
    for (int i = 0; i < DV / 64; ++i) { const int idx = c.tid + 512 * i; vreg[i] = ld16(Vt + (size_t)(idx >> 3) * vpitch + tile * 64 + (idx & 7) * 8); }
}
template <int DV>
DEV void attn_stage_store(const Ctx& c, int boff, const bf16x8& kreg, const bf16x8 (&vreg)[DV / 64]) {
    char* kb = c.lds + boff; char* vb = kb + AT_KB;
    *(bf16x8*)(kb + (c.tid >> 3) * 144 + (c.tid & 7) * 16) = kreg;
#pragma unroll
    for (int i = 0; i < DV / 64; ++i) { const int idx = c.tid + 512 * i; *(bf16x8*)(vb + (idx >> 3) * 144 + (idx & 7) * 16) = vreg[i]; }
}
DEV void attn_qk(const char* kb, int rk, int h, const bf16x8 (&qf)[4], f32x16& p0, f32x16& p1) {
#pragma unroll
    for (int i = 0; i < 16; ++i) { p0[i] = 0.f; p1[i] = 0.f; }
#pragma unroll
    for (int ks = 0; ks < 4; ++ks) { const bf16x8 a0 = ld16(kb + rk * 144 + ks * 32 + h * 16), a1 = ld16(kb + (32 + rk) * 144 + ks * 32 + h * 16);
        p0 = MFMA32(a0, qf[ks], p0); p1 = MFMA32(a1, qf[ks], p1); }
}
DEV void attn_sm1(f32x16& p0, f32x16& p1, float& m, float& alpha) {
    const float C2 = 0.125f * 1.4426950408889634f;
    float mx = p0[0];
#pragma unroll
    for (int i = 0; i < 16; ++i) { mx = fmaxf(mx, p0[i]); mx = fmaxf(mx, p1[i]); }
    mx = fmaxf(mx, SHFL_XOR(mx, 32));
    alpha = 1.0f;
    if (WAVE_ANY(mx * C2 > m + 8.0f)) { const float mn = fmaxf(m, mx * C2); alpha = EXP2F(m - mn); m = mn; }
#pragma unroll
    for (int i = 0; i < 16; ++i) { p0[i] = p0[i] * C2 - m; p1[i] = p1[i] * C2 - m; }
#pragma unroll
    for (int i = 0; i < 16; ++i) p0[i] = EXP2F(p0[i]);
}
DEV void attn_sm2(f32x16& p0, f32x16& p1, float alpha, float& l, bf16x8 (&pb)[4]) {
#pragma unroll
    for (int i = 0; i < 16; ++i) p1[i] = EXP2F(p1[i]);
    float rs = 0.f;
#pragma unroll
    for (int i = 0; i < 16; ++i) rs += p0[i] + p1[i];
    l = l * alpha + rs;
    pb[0] = pack_acc(p0, 0); pb[1] = pack_acc(p0, 1); pb[2] = pack_acc(p1, 0); pb[3] = pack_acc(p1, 1);
}
template <int DV>
DEV void attn_pv(const char* vb, int r, int h, const bf16x8 (&pb)[4], f32x16 (&o)[DV / 32]) {
#pragma unroll
    for (int us = 0; us < 4; ++us)
#pragma unroll
        for (int dt = 0; dt < DV / 32; ++dt) { const bf16x8 va = ld16(vb + (32 * dt + r) * 144 + (16 * us + 8 * h) * 2); o[dt] = MFMA32(va, pb[us], o[dt]); }
}
template <int DV>
DEV void attn_resc(f32x16 (&o)[DV / 32], float alpha) {
    if (WAVE_ANY(alpha < 1.0f)) {
#pragma unroll
        for (int dt = 0; dt < DV / 32; ++dt)
#pragma unroll
            for (int i = 0; i < 16; ++i) o[dt][i] *= alpha; }
}
template <int DV>
DEV void attn_step(const Ctx& c, const bf16_t* Kp, const bf16_t* Vt, int vpitch, int j, int nt, const bf16x8 (&qf)[4], bool active, int rk, int ox, int oy, int on,
                   bf16x8 (&pb)[4], f32x16 (&o)[DV / 32], float& m, float& l) {
    const int r = c.lane & 31, h = c.lane >> 5; const bool more = j + 1 < nt; const float C2 = 0.125f * 1.4426950408889634f;
    bf16x8 kreg, vreg[DV / 64]; f32x16 p0, p1;
    if (active) attn_qk(c.lds + ox, rk, h, qf, p0, p1);
    SCHED_FENCE();
    if (more) attn_stage_load<DV>(c, Kp, Vt, vpitch, j + 1, kreg, vreg);
    if (active) { const char* vb = c.lds + oy + AT_KB;
        float mx = 0.f, alpha = 1.0f;
#pragma unroll
        for (int us = 0; us < 4; ++us) {
            SCHED_FENCE();
#pragma unroll
            for (int dt = 0; dt < DV / 32; ++dt) { const bf16x8 va = ld16(vb + (32 * dt + r) * 144 + (16 * us + 8 * h) * 2); o[dt] = MFMA32(va, pb[us], o[dt]); }
            SCHED_FENCE();
            if (us == 0) { mx = p0[0];
#pragma unroll
                for (int i = 0; i < 16; ++i) { mx = fmaxf(mx, p0[i]); mx = fmaxf(mx, p1[i]); }
                mx = fmaxf(mx, SHFL_XOR(mx, 32));
                if (WAVE_ANY(mx * C2 > m + 8.0f)) { const float mn = fmaxf(m, mx * C2); alpha = EXP2F(m - mn); m = mn; } }
            else if (us == 1) {
#pragma unroll
                for (int i = 0; i < 16; ++i) { p0[i] = p0[i] * C2 - m; p1[i] = p1[i] * C2 - m; } }
            else if (us == 2) {
#pragma unroll
                for (int i = 0; i < 16; ++i) p0[i] = EXP2F(p0[i]); }
            else {
#pragma unroll
                for (int i = 0; i < 16; ++i) p1[i] = EXP2F(p1[i]); }
        }
        SCHED_FENCE();
        float rs = 0.f;
#pragma unroll
        for (int i = 0; i < 16; ++i) rs += p0[i] + p1[i];
        l = l * alpha + rs;
        pb[0] = pack_acc(p0, 0); pb[1] = pack_acc(p0, 1); pb[2] = pack_acc(p1, 0); pb[3] = pack_acc(p1, 1);
        attn_resc<DV>(o, alpha); }
    if (more) attn_stage_store<DV>(c, on, kreg, vreg);
    BLOCK_SYNC();
}
template <int DV>
DEV void attn_pass(const Ctx& c, const bf16_t* Kp, const bf16_t* Vt, int vpitch, int nk, const bf16x8 (&qf)[4], bool active, f32x16 (&o)[DV / 32], float& m, float& l) {
    const int r = c.lane & 31, h = c.lane >> 5; const int rk = (r & 0x13) | ((r & 4) << 1) | ((r & 8) >> 1);
    const int nt = nk / 64; constexpr int BUF = AttnLds<DV>::BUF;
#pragma unroll
    for (int dt = 0; dt < DV / 32; ++dt)
#pragma unroll
        for (int i = 0; i < 16; ++i) o[dt][i] = 0.f;
    m = -1e30f; l = 0.f;
    bf16x8 pb[4];
    { bf16x8 kreg, vreg[DV / 64];
      attn_stage_load<DV>(c, Kp, Vt, vpitch, 0, kreg, vreg); attn_stage_store<DV>(c, 0, kreg, vreg);
      attn_stage_load<DV>(c, Kp, Vt, vpitch, 1, kreg, vreg); attn_stage_store<DV>(c, BUF, kreg, vreg); }
    BLOCK_SYNC();
    if (active) { f32x16 p0, p1; float alpha; attn_qk(c.lds, rk, h, qf, p0, p1); attn_sm1(p0, p1, m, alpha); attn_sm2(p0, p1, alpha, l, pb); }
    else {
#pragma unroll
        for (int i = 0; i < 4; ++i) pb[i] = (bf16x8){0, 0, 0, 0, 0, 0, 0, 0}; }
    int ox = BUF, oy = 0, on = 2 * BUF;
    for (int j = 1; j < nt; ++j) {
        attn_step<DV>(c, Kp, Vt, vpitch, j, nt, qf, active, rk, ox, oy, on, pb, o, m, l); { const int t_ = oy; oy = ox; ox = on; on = t_; }
    }
    if (active) attn_pv<DV>(c.lds + oy + AT_KB, r, h, pb, o);
    BLOCK_SYNC();
}
DEV void load_q(const Ctx& c, const bf16_t* Qrow  , bool valid, bool rope, int t, const float* qg  , bf16x8 (&qf)[4]) {
    const int h = c.lane >> 5;
    float f[4][8];
#pragma unroll
    for (int ks = 0; ks < 4; ++ks) { bf16x8 v = (bf16x8){0, 0, 0, 0, 0, 0, 0, 0}; if (valid) v = ld16(Qrow + 16 * ks + 8 * h); unpack8(v, f[ks]); }
    if (qg) { float ss = 0.f;
#pragma unroll
        for (int ks = 0; ks < 4; ++ks)
#pragma unroll
            for (int e = 0; e < 8; ++e) ss += f[ks][e] * f[ks][e];
        ss += SHFL_XOR(ss, 32);
        const float rstd = 1.0f / sqrtf(ss * (1.0f / 64.0f) + EPS);
#pragma unroll
        for (int ks = 0; ks < 4; ++ks)
#pragma unroll
            for (int e = 0; e < 8; ++e) f[ks][e] = f[ks][e] * rstd * qg[16 * ks + 8 * h + e]; }
    if (rope) { const float* COS = (const float*)(c.ws + OFF_ROPE) + (size_t)t * 32; const float* SIN = COS + (size_t)SEQ * 32;
#pragma unroll
        for (int a = 0; a < 2; ++a)
#pragma unroll
            for (int e = 0; e < 8; ++e) { const float cs = COS[a * 16 + 8 * h + e], sn = SIN[a * 16 + 8 * h + e]; const float x1 = f[2 * a][e], x2 = f[2 * a + 1][e];
                f[2 * a][e] = x1 * cs - x2 * sn; f[2 * a + 1][e] = x2 * cs + x1 * sn; } }
#pragma unroll
    for (int ks = 0; ks < 4; ++ks) qf[ks] = pack8(f[ks]);
}

DEV void even_kprep(const Ctx& c) {
    const bf16_t* KA = (const bf16_t*)(c.ws + OFF_P) + PE_KA; bf16_t* KP = (bf16_t*)(c.ws + SE_KP);
    const float* COS = (const float*)(c.ws + OFF_ROPE); const float* SIN = COS + (size_t)SEQ * 32;
    const int l7 = c.lane & 7, a = l7 >> 2, p = (l7 >> 1) & 1, f0 = 8 * (l7 & 1), vh = c.lane >> 3;
    for (int it = c.gw; it < NB * LK; it += c.ngw) { const int b = it / LK, pos = it % LK; const int row = pos_row(b, pos);
        float f[8]; unpack8(ld16(KA + (size_t)row * 512 + 8 * c.lane), f);
        float g[8];
#pragma unroll
        for (int e = 0; e < 8; ++e) g[e] = SHFL_XOR(f[e], 2);
        if (pos >= CTX) { const int t = pos - CTX;
#pragma unroll
            for (int e = 0; e < 8; ++e) { const float cs = COS[(size_t)t * 32 + a * 16 + f0 + e], sn = SIN[(size_t)t * 32 + a * 16 + f0 + e]; f[e] = p == 0 ? f[e] * cs - g[e] * sn : f[e] * cs + g[e] * sn; } }
        *(bf16x8*)(KP + ((size_t)(b * 8 + vh) * LK + pos) * 64 + 8 * l7) = pack8(f); }
}
template <int DV>
DEV void vt_item(const Ctx& c, const bf16_t* src, int spitch, int colbase, int b, int pc, bf16_t* dstbh  ) {
    bf16_t* T = (bf16_t*)c.lds;
#pragma unroll
    for (int i = 0; i < DV / 64; ++i) { const int idx = c.tid + 512 * i, pl = idx / (DV / 8), cg = idx % (DV / 8); const int row = pos_row(b, 64 * pc + pl);
        const bf16x8 v = ld16(src + (size_t)row * spitch + colbase + 8 * cg);
#pragma unroll
        for (int e = 0; e < 8; ++e) T[(8 * cg + e) * 72 + (((pl >> 3) ^ (cg & 7)) << 3) + (pl & 7)] = (bf16_t)v[e]; }
    BLOCK_SYNC();
#pragma unroll
    for (int i = 0; i < DV / 64; ++i) { const int idx = c.tid + 512 * i, dv = idx >> 3, ch = idx & 7;
        *(bf16x8*)(dstbh + (size_t)dv * LK + 64 * pc + 8 * ch) = *(const bf16x8*)(T + dv * 72 + 8 * (ch ^ ((dv >> 3) & 7))); }
    BLOCK_SYNC();
}

DEV void mlstm_gates(const Ctx& c, int layer, int b, int h, int dir, int tc, float& ipre, float& lf) {
    const float* G = (const float*)(c.ws + OFF_G); const float* bias = c.in[9] + (size_t)(layer >> 1) * 16;
    const int row = tok_row(b, tc, c.lane);
    ipre = G[(size_t)row * 16 + dir * 8 + h] + bias[dir * 8 + h];
    lf = logsigmoidf_(G[(size_t)row * 16 + dir * 8 + 4 + h] + bias[dir * 8 + 4 + h]);
}
DEV void mlstm_m1_item(const Ctx& c, int layer, int it) {
    const int tc = it % NCH, dir = (it / NCH) & 1, h = (it / (2 * NCH)) & 3, b = it / (8 * NCH);
    const int chain = (b * 4 + h) * 2 + dir, cc = chain_chunk(dir, tc); const size_t ci = (size_t)chain * NCH + cc;
    const bf16_t* BK = (const bf16_t*)(c.ws + OFF_P) + PE_BK; const bf16_t* BV = (const bf16_t*)(c.ws + OFF_P) + PE_BV;
    float* DCT = (float*)(c.ws + SE_DCT); float* DN = (float*)(c.ws + SE_DN); float* SC = (float*)(c.ws + SE_SC);
    bf16_t* Kt = (bf16_t*)c.lds; bf16_t* Vt = Kt + 64 * 72; float* wv = (float*)(c.lds + (64 + 128) * 72 * 2);
    if (c.wave == 0) { float ipre, lf; mlstm_gates(c, layer, b, h, dir, tc, ipre, lf);
        const float bcum = chain_cumsum(lf, c.lane, dir), bend = wave_sum(lf), wend = bend - bcum + ipre, mloc = wave_max(wend);
        wv[c.lane] = expf(wend - mloc);
        if (c.lane == 0) { SC[ci * 4 + 0] = bend; SC[ci * 4 + 1] = mloc; } }
    BLOCK_SYNC();
    {   const int i = c.tid >> 3, cg = c.tid & 7; const int row = tok_row(b, tc, i); const float w = wv[i] * 0.125f;
        float f[8]; unpack8(ld16(BK + (size_t)row * 256 + h * 64 + 8 * cg), f);
#pragma unroll
        for (int e = 0; e < 8; ++e) Kt[(8 * cg + e) * 72 + (((i >> 3) ^ (cg & 7)) << 3) + (i & 7)] = (bf16_t)f2bf(f[e] * w); }
#pragma unroll
    for (int ii = 0; ii < 2; ++ii) { const int idx = c.tid + 512 * ii, i = idx >> 4, cg = idx & 15; const int row = tok_row(b, tc, i);
        const bf16x8 v = ld16(BV + (size_t)row * 512 + h * 128 + 8 * cg);
#pragma unroll
        for (int e = 0; e < 8; ++e) Vt[(8 * cg + e) * 72 + (((i >> 3) ^ (cg & 7)) << 3) + (i & 7)] = (bf16_t)v[e]; }
    BLOCK_SYNC();
    {   const int r = c.lane & 31, hh = c.lane >> 5, dvt = c.wave >> 1, dkt = c.wave & 1;
        f32x16 acc;
#pragma unroll
        for (int i = 0; i < 16; ++i) acc[i] = 0.f;
#pragma unroll
        for (int ks = 0; ks < 4; ++ks) acc = MFMA32(ld16(Vt + (32 * dvt + r) * 72 + 8 * ((2 * ks + hh) ^ ((r >> 3) & 3) ^ ((dvt & 1) << 2))), ld16(Kt + (32 * dkt + r) * 72 + 8 * ((2 * ks + hh) ^ ((r >> 3) & 3) ^ ((dkt & 1) << 2))), acc);
        float* dst = DCT + ci * 8192;
#pragma unroll
        for (int i = 0; i < 16; ++i) dst[(32 * dvt + crow(i, hh)) * 64 + 32 * dkt + r] = acc[i];
        if (c.tid < 64) { float s = 0.f; for (int i = 0; i < 64; ++i) s += bf2f(Kt[c.tid * 72 + i]); DN[ci * 64 + c.tid] = s; } }
    BLOCK_SYNC();
}
DEV void mlstm_m2(const Ctx& c) {
    float* DCT = (float*)(c.ws + SE_DCT); float* DN = (float*)(c.ws + SE_DN); float* SC = (float*)(c.ws + SE_SC);
    const long gt = (long)c.bid * NTHREADS + c.tid, GT = (long)c.nblk * NTHREADS;
    for (long it = gt; it < (long)NCHAIN * 8256; it += GT) { const int chain = (int)(it / 8256), e = (int)(it % 8256);
        float* p0 = e < 8192 ? DCT + (size_t)chain * NCH * 8192 + e : DN + (size_t)chain * NCH * 64 + (e - 8192); const size_t pstr = e < 8192 ? 8192 : 64;
        float d[NCH];
#pragma unroll
        for (int cc = 0; cc < NCH; ++cc) d[cc] = p0[cc * pstr];
        float mst = 0.f, val = 0.f;
#pragma unroll
        for (int cc = 0; cc < NCH; ++cc) { const size_t ci = (size_t)chain * NCH + cc; const float bend = SC[ci * 4 + 0], mloc = SC[ci * 4 + 1];
            if (e == 0) SC[ci * 4 + 2] = mst;
            const float mnew = fmaxf(bend + mst, mloc); const float nv = expf(bend + mst - mnew) * val + expf(mloc - mnew) * d[cc]; d[cc] = val; val = nv; mst = mnew; }
#pragma unroll
        for (int cc = 0; cc < NCH; ++cc) p0[cc * pstr] = d[cc]; }
}
DEV void mlstm_m3_item(const Ctx& c, int layer, int it) {
    const int tc = it % NCH, h = (it / NCH) & 3, b = it / (4 * NCH);
    const bf16_t* BQ = (const bf16_t*)(c.ws + OFF_P) + PE_BQ; const bf16_t* BK = (const bf16_t*)(c.ws + OFF_P) + PE_BK; const bf16_t* BV = (const bf16_t*)(c.ws + OFF_P) + PE_BV; const bf16_t* BO = (const bf16_t*)(c.ws + OFF_P) + PE_BO;
    const float* DCT = (const float*)(c.ws + SE_DCT); const float* DN = (const float*)(c.ws + SE_DN); const float* SC = (const float*)(c.ws + SE_SC);
    bf16_t* Y = (bf16_t*)(c.ws + OFF_HY); const float* gn = c.in[12] + (size_t)(layer >> 1) * 128;
    bf16_t* Qs = (bf16_t*)c.lds; bf16_t* Ks = Qs + 64 * 72; bf16_t* Vt = Ks + 64 * 72; float* fl = (float*)(c.lds + (128 + 128) * 72 * 2);
    float* bcs = fl, *ics = fl + 64, *nst = fl + 128, *ssq = fl + 192;
    const int r = c.lane & 31, hh = c.lane >> 5, dvt = c.wave >> 1, tt = c.wave & 1, t = 32 * tt + r;
    f32x16 hs;
#pragma unroll
    for (int i = 0; i < 16; ++i) hs[i] = 0.f;
    for (int dir = 0; dir < 2; ++dir) {
        const int chain = (b * 4 + h) * 2 + dir, cc = chain_chunk(dir, tc); const size_t ci = (size_t)chain * NCH + cc;
        if (c.wave == 0) { float ipre, lf; mlstm_gates(c, layer, b, h, dir, tc, ipre, lf); bcs[c.lane] = chain_cumsum(lf, c.lane, dir); ics[c.lane] = ipre; }
        if (c.wave == 1) nst[c.lane] = DN[ci * 64 + c.lane];
        {   const int i = c.tid >> 3, cg = c.tid & 7; const int row = tok_row(b, tc, i);
            *(bf16x8*)(Qs + i * 72 + 8 * cg) = ld16(BQ + (size_t)row * 256 + h * 64 + 8 * cg);
            float f[8]; unpack8(ld16(BK + (size_t)row * 256 + h * 64 + 8 * cg), f);
#pragma unroll
            for (int e = 0; e < 8; ++e) f[e] *= 0.125f;
            *(bf16x8*)(Ks + i * 72 + 8 * cg) = pack8(f); }
#pragma unroll
        for (int ii = 0; ii < 2; ++ii) { const int idx = c.tid + 512 * ii, i = idx >> 4, cg = idx & 15; const int row = tok_row(b, tc, i);
            const bf16x8 v = ld16(BV + (size_t)row * 512 + h * 128 + 8 * cg);
#pragma unroll
            for (int e = 0; e < 8; ++e) Vt[(8 * cg + e) * 72 + (((i >> 3) ^ (cg & 7)) << 3) + (i & 7)] = (bf16_t)v[e]; }
        BLOCK_SYNC();
        const float mst = SC[ci * 4 + 2];
        f32x16 st[2];
#pragma unroll
        for (int su = 0; su < 2; ++su) {
#pragma unroll
            for (int i = 0; i < 16; ++i) st[su][i] = 0.f;
#pragma unroll
            for (int ks = 0; ks < 4; ++ks) st[su] = MFMA32(ld16(Ks + (32 * su + r) * 72 + 16 * ks + 8 * hh), ld16(Qs + t * 72 + 16 * ks + 8 * hh), st[su]); }
        const float bt = bcs[t], at = bt + mst;
        float mt = at;
#pragma unroll
        for (int su = 0; su < 2; ++su)
#pragma unroll
            for (int i = 0; i < 16; ++i) { const int s = 32 * su + crow(i, hh); const bool valid = dir == 0 ? s <= t : s >= t; if (valid) mt = fmaxf(mt, bt - bcs[s] + ics[s]); }
        mt = fmaxf(mt, SHFL_XOR(mt, 32));
        const float inter = expf(at - mt);
        float rsum = 0.f;
#pragma unroll
        for (int su = 0; su < 2; ++su)
#pragma unroll
            for (int i = 0; i < 16; ++i) { const int s = 32 * su + crow(i, hh); const bool valid = dir == 0 ? s <= t : s >= t;
                const float p = valid ? expf(bt - bcs[s] + ics[s] - mt) * st[su][i] : 0.f; st[su][i] = p; rsum += p; }
        rsum += SHFL_XOR(rsum, 32);
        float qn = 0.f;
        for (int d = 0; d < 32; ++d) qn += bf2f(Qs[t * 72 + 32 * hh + d]) * nst[32 * hh + d];
        qn += SHFL_XOR(qn, 32);
        const float den = inter * qn + rsum, dd = fmaxf(fabsf(den), expf(-mt));
        f32x16 a1;
#pragma unroll
        for (int i = 0; i < 16; ++i) a1[i] = 0.f;
        const float* Cst = DCT + ci * 8192 + (size_t)(32 * dvt + r) * 64;
#pragma unroll
        for (int ks = 0; ks < 4; ++ks) { float f[8]; const f32x4 c0 = *(const f32x4*)(Cst + 16 * ks + 8 * hh), c1 = *(const f32x4*)(Cst + 16 * ks + 8 * hh + 4);
            f[0] = c0[0]; f[1] = c0[1]; f[2] = c0[2]; f[3] = c0[3]; f[4] = c1[0]; f[5] = c1[1]; f[6] = c1[2]; f[7] = c1[3];
            a1 = MFMA32(pack8(f), ld16(Qs + t * 72 + 16 * ks + 8 * hh), a1); }
        f32x16 a2;
#pragma unroll
        for (int i = 0; i < 16; ++i) a2[i] = 0.f;
#pragma unroll
        for (int su = 0; su < 2; ++su)
#pragma unroll
            for (int s2 = 0; s2 < 2; ++s2) { const bf16_t* vr = Vt + (32 * dvt + r) * 72 + 4 * hh; const int sw = ((32 * dvt + r) >> 3) & 7, bk = 4 * su + 2 * s2;
                a2 = MFMA32(cat44(*(const bf16x4*)(vr + 8 * (bk ^ sw)), *(const bf16x4*)(vr + 8 * ((bk + 1) ^ sw))), pack_acc(st[su], s2), a2); }
        const float inv = 1.0f / dd;
#pragma unroll
        for (int i = 0; i < 16; ++i) hs[i] += (inter * a1[i] + a2[i]) * inv;
        BLOCK_SYNC();
    }
    float ss = 0.f;
#pragma unroll
    for (int i = 0; i < 16; ++i) ss += hs[i] * hs[i];
    ss += SHFL_XOR(ss, 32);
    if (hh == 0) ssq[dvt * 64 + t] = ss;
    BLOCK_SYNC();
    const float rstd = 1.0f / sqrtf((ssq[t] + ssq[64 + t] + ssq[128 + t] + ssq[192 + t]) * (1.0f / 128.0f) + EPS);
    const int row = tok_row(b, tc, t);
#pragma unroll
    for (int q4 = 0; q4 < 4; ++q4) { const int dv = 32 * dvt + 8 * q4 + 4 * hh;
        const bf16x4 ov = *(const bf16x4*)(BO + (size_t)row * 512 + h * 128 + dv); float y[4];
#pragma unroll
        for (int e = 0; e < 4; ++e) y[e] = hs[4 * q4 + e] * rstd * gn[dv + e] * sigmoidf_(bf2f((unsigned short)ov[e]));
        u32x2 w; w[0] = pk2(y[0], y[1]); w[1] = pk2(y[2], y[3]);
        *(u32x2*)(Y + (size_t)row * 1024 + 512 + h * 128 + dv) = w; }
    BLOCK_SYNC();
}

DEV void diffattn_unit(const Ctx& c, int layer, int b, int h, bool ctxu, int qb) {
    const bf16_t* QA = (const bf16_t*)(c.ws + OFF_P) + PE_QA; const bf16_t* KP = (const bf16_t*)(c.ws + SE_KP); const bf16_t* VT = (const bf16_t*)(c.ws + SE_VT);
    bf16_t* Y = (bf16_t*)(c.ws + OFF_HY); const int e = layer >> 1;
    const float* lam = c.in[10] + (size_t)e * 256; const float* gn = c.in[11] + (size_t)e * 128;
    const int r = c.lane & 31, hh = c.lane >> 5; const int ql = qb * 256 + c.wave * 32 + r;
    const int nq = ctxu ? CTX : SEQ, nk = ctxu ? CTX : LK; const bool valid = ql < nq, active = (qb * 256 + c.wave * 32) < nq;
    const int row = ctxu ? ML + b * CTX + ql : b * SEQ + ql;
    const int orow = ctxu ? row : b * SEQ + (ql % 128) * (SEQ / 128) + ql / 128;
    f32x16 o[4]; float m, l1, l2; bf16x8 qf[4];
    float* park = (float*)(c.ws + SE_PARK) + ((size_t)c.bid * NTHREADS + c.tid) * 64;
    load_q(c, QA + (size_t)row * 512 + h * 128, valid, !ctxu, ql, nullptr, qf);
    attn_pass<128>(c, KP + (size_t)(b * 8 + 2 * h) * LK * 64, VT + (size_t)(b * 4 + h) * 128 * LK, LK, nk, qf, active, o, m, l1);
    if (active) { l1 += SHFL_XOR(l1, 32); const float i1 = 1.0f / l1;
#pragma unroll
        for (int dt = 0; dt < 4; ++dt)
#pragma unroll
            for (int q4 = 0; q4 < 4; ++q4) *(f32x4*)(park + 16 * dt + 4 * q4) = (f32x4){o[dt][4 * q4] * i1, o[dt][4 * q4 + 1] * i1, o[dt][4 * q4 + 2] * i1, o[dt][4 * q4 + 3] * i1}; }
    load_q(c, QA + (size_t)row * 512 + h * 128 + 64, valid, !ctxu, ql, nullptr, qf);
    attn_pass<128>(c, KP + (size_t)(b * 8 + 2 * h + 1) * LK * 64, VT + (size_t)(b * 4 + h) * 128 * LK, LK, nk, qf, active, o, m, l2);
    const float lam_init = 0.8f - 0.6f * expf(-0.3f * (float)layer);
    const float lmb = expf(wave_sum(lam[c.lane] * lam[64 + c.lane])) - expf(wave_sum(lam[128 + c.lane] * lam[192 + c.lane])) + lam_init;
    if (active) {
        l2 += SHFL_XOR(l2, 32);
        const float i2 = lmb / l2; float ss = 0.f;
#pragma unroll
        for (int dt = 0; dt < 4; ++dt)
#pragma unroll
            for (int q4 = 0; q4 < 4; ++q4) { const f32x4 a = *(const f32x4*)(park + 16 * dt + 4 * q4);
#pragma unroll
                for (int e = 0; e < 4; ++e) { const float v = a[e] - o[dt][4 * q4 + e] * i2; o[dt][4 * q4 + e] = v; ss += v * v; } }
        ss += SHFL_XOR(ss, 32);
        const float sc = (1.0f / sqrtf(ss * (1.0f / 128.0f) + EPS)) * (1.0f - lam_init);
        if (valid) {
#pragma unroll
            for (int dt = 0; dt < 4; ++dt)
#pragma unroll
                for (int q4 = 0; q4 < 4; ++q4) { const int dv = 32 * dt + 8 * q4 + 4 * hh; u32x2 w;
                    w[0] = pk2(o[dt][4 * q4 + 0] * sc * gn[dv + 0], o[dt][4 * q4 + 1] * sc * gn[dv + 1]); w[1] = pk2(o[dt][4 * q4 + 2] * sc * gn[dv + 2], o[dt][4 * q4 + 3] * sc * gn[dv + 3]);
                    *(u32x2*)(Y + (size_t)orow * 1024 + h * 128 + dv) = w; } }
    }
}

DEV void mix_even_a(const Ctx& c, int layer) {
    { PHASE_CTX(pc); if (ON(8)) even_kprep(pc); }
    { PHASE_CTX(pc); if (ON(9)) { const bf16_t* VA = (const bf16_t*)(pc.ws + OFF_P) + PE_VA; bf16_t* VT = (bf16_t*)(pc.ws + SE_VT);
        for (int it = pc.bid; it < NB * 4 * NCH; it += pc.nblk) { const int pch = it % NCH, bh = it / NCH; vt_item<128>(pc, VA, 512, (bh & 3) * 128, bh >> 2, pch, VT + (size_t)bh * 128 * LK); } } }
    REPB(10) { PHASE_CTX(pc); if (ON(10)) for (int it = pc.bid; it < NCHAIN * NCH; it += pc.nblk) mlstm_m1_item(pc, layer, it); }
}
DEV void mix_even_b(const Ctx& c, int layer) {
    { PHASE_CTX(pc); if (ON(11)) mlstm_m2(pc); }
}
DEV void mix_even_c(const Ctx& c, int layer) {
    constexpr int NQBL = SEQ / 256, NQBC = (CTX + 255) / 256, NUL = NB * 4 * NQBL, NUC = NB * 4 * NQBC;
    REPB(12) { PHASE_CTX(pc); if (ON(12)) for (int it = pc.bid; it < NUL + NUC; it += pc.nblk) { const bool cu = it >= NUL; int u = cu ? it - NUL : it; const int nqb = cu ? NQBC : NQBL;
        diffattn_unit(pc, layer, u / (4 * nqb), (u / nqb) & 3, cu, u % nqb); } }
    REPB(13) { PHASE_CTX(pc); if (ON(13)) for (int it = pc.nblk - 1 - pc.bid; it < NB * 4 * NCH; it += pc.nblk) mlstm_m3_item(pc, layer, it); }
}
constexpr size_t SO_KP = OFF_S;
constexpr size_t SO_VT = SO_KP + al256((size_t)NB * 2 * LK * 64 * 2);
constexpr size_t SO_U  = SO_VT + al256((size_t)NB * 2 * 64 * LK * 2);
constexpr size_t SO_W  = OFF_HY;
static_assert((size_t)NCHAIN * NCH * 8192 <= (size_t)MT * cmax(D, 1024), "W fits in the H/Y region");
constexpr size_t SO_AT = SO_U + al256((size_t)NCHAIN * NCH * 8192 * 2);
constexpr size_t SO_QN = SO_AT + al256((size_t)NCHAIN * NCH * 4096 * 2);
constexpr size_t SO_KD = SO_QN + al256((size_t)NCHAIN * NCH * 8192 * 2);
constexpr size_t SO_GE = SO_KD + al256((size_t)NCHAIN * NCH * 8192 * 2);
constexpr size_t SO_END = SO_GE + al256((size_t)NCHAIN * NCH * 4);
constexpr size_t PO_HB = PO_DQKV;
constexpr size_t PO_GO = PO_DQKV + (size_t)MT * 1024;
static_assert((size_t)3 * MT * 512 <= (size_t)MT * 1536, "HB and GO fit in the DQKV segment");

DEV void odd_kprep(const Ctx& c, int layer) {
    const bf16_t* KVC = (const bf16_t*)(c.ws + OFF_P) + PO_KVC; bf16_t* KP = (bf16_t*)(c.ws + SO_KP);
    const float* COS = (const float*)(c.ws + OFF_ROPE); const float* SIN = COS + (size_t)SEQ * 32; const float* kg = c.in[15] + (size_t)(layer >> 1) * 128 + 64;
    const int kv = c.lane >> 5, d0 = 2 * (c.lane & 31);
    const int a = d0 >> 5, p = (d0 >> 4) & 1, f0 = d0 & 15;
    for (int it = c.gw; it < NB * LK; it += c.ngw) { const int b = it / LK, pos = it % LK; const int row = pos_row(b, pos);
        const unsigned w = *(const unsigned*)(KVC + (size_t)row * 256 + 2 * c.lane);
        float x0 = bf2f(w & 0xffffu), x1 = bf2f(w >> 16);
        float ss = x0 * x0 + x1 * x1;
#pragma unroll
        for (int o = 1; o < 32; o <<= 1) ss += SHFL_XOR(ss, o);
        const float rstd = 1.0f / sqrtf(ss * (1.0f / 64.0f) + EPS);
        x0 *= rstd * kg[d0]; x1 *= rstd * kg[d0 + 1];
        const float y0 = SHFL_XOR(x0, 8), y1 = SHFL_XOR(x1, 8);
        if (pos >= CTX) { const int t = pos - CTX; const float c0 = COS[(size_t)t * 32 + a * 16 + f0], s0 = SIN[(size_t)t * 32 + a * 16 + f0], c1 = COS[(size_t)t * 32 + a * 16 + f0 + 1], s1 = SIN[(size_t)t * 32 + a * 16 + f0 + 1];
            x0 = p == 0 ? x0 * c0 - y0 * s0 : x0 * c0 + y0 * s0; x1 = p == 0 ? x1 * c1 - y1 * s1 : x1 * c1 + y1 * s1; }
        *(unsigned*)(KP + ((size_t)(b * 2 + kv) * LK + pos) * 64 + d0) = pk2(x0, x1); }
}
DEV void gqa_unit(const Ctx& c, int layer, int b, int h, bool ctxu, int qb) {
    const bf16_t* QC = (const bf16_t*)(c.ws + OFF_P) + PO_QC; const bf16_t* KP = (const bf16_t*)(c.ws + SO_KP); const bf16_t* VT = (const bf16_t*)(c.ws + SO_VT);
    bf16_t* QO = (bf16_t*)(c.ws + OFF_P) + PO_GO; const float* qg = c.in[15] + (size_t)(layer >> 1) * 128;
    const int r = c.lane & 31, hh = c.lane >> 5, kv = h >> 2; const int ql = qb * 256 + c.wave * 32 + r;
    const int nq = ctxu ? CTX : SEQ, nk = ctxu ? CTX : LK; const bool valid = ql < nq, active = (qb * 256 + c.wave * 32) < nq;
    const int row = ctxu ? ML + b * CTX + ql : b * SEQ + ql;
    const int orow = ctxu ? row : b * SEQ + (ql % 128) * (SEQ / 128) + ql / 128;
    f32x16 o[2]; float m, l; bf16x8 qf[4];
    load_q(c, QC + (size_t)row * 512 + h * 64, valid, !ctxu, ql, qg, qf);
    attn_pass<64>(c, KP + (size_t)(b * 2 + kv) * LK * 64, VT + (size_t)(b * 2 + kv) * 64 * LK, LK, nk, qf, active, o, m, l);
    if (active) { l += SHFL_XOR(l, 32); const float il = 1.0f / l;
        if (valid) {
#pragma unroll
            for (int dt = 0; dt < 2; ++dt)
#pragma unroll
                for (int q4 = 0; q4 < 4; ++q4) { const int dv = 32 * dt + 8 * q4 + 4 * hh; u32x2 w;
                    w[0] = pk2(o[dt][4 * q4 + 0] * il, o[dt][4 * q4 + 1] * il); w[1] = pk2(o[dt][4 * q4 + 2] * il, o[dt][4 * q4 + 3] * il);
                    *(u32x2*)(QO + (size_t)orow * 512 + h * 64 + dv) = w; } } }
}

constexpr int D1_CW_OFF = 110592;
#ifndef D1_STOP
#define D1_STOP 0
#endif
DEV void dn_d1_item(const Ctx& c, int layer, int it, int stop = 0) {
    const int tc = it % NCH, dir = (it / NCH) & 1, h = (it / (2 * NCH)) & 3, b = it / (8 * NCH);
    const int chain = (b * 4 + h) * 2 + dir, cc = chain_chunk(dir, tc); const size_t ci = (size_t)chain * NCH + cc; const int o = layer >> 1;
    const bf16_t* DQ = (const bf16_t*)(c.ws + OFF_P) + PO_DQKV; const float* G = (const float*)(c.ws + OFF_G);
    const float* cwl = (const float*)(c.lds + D1_CW_OFF); const float* alog = c.in[17] + (size_t)o * 8; const float* dtb = c.in[18] + (size_t)o * 8;
    bf16_t* Ub = (bf16_t*)(c.ws + SO_U) + ci * 8192; bf16_t* Wb = (bf16_t*)(c.ws + SO_W) + ci * 8192; bf16_t* ATb = (bf16_t*)(c.ws + SO_AT) + ci * 4096;
    bf16_t* QNb = (bf16_t*)(c.ws + SO_QN) + ci * 8192; bf16_t* KDb = (bf16_t*)(c.ws + SO_KD) + ci * 8192; float* GE = (float*)(c.ws + SO_GE);
    bf16_t* Qs = (bf16_t*)c.lds; bf16_t* Ks = Qs + 64 * 136; bf16_t* Kt = Ks + 64 * 136; bf16_t* Vt = Kt + 128 * 72; float* Am = (float*)(c.lds + (2 * 64 * 136 + 2 * 128 * 72) * 2); float* gc = Am + 64 * 65; float* be = gc + 64;
    float* gam = be + 64; float* T2 = gam + 64; float* Rb = T2 + 64 * 65;
    const int seqlen = tc < NCC ? CTX : SEQ, tok0 = tc < NCC ? 64 * tc : 64 * (tc - NCC), rowbase = tc < NCC ? ML + b * CTX : b * SEQ;
    if (c.wave == 0) { const int j = c.lane, i = dir ? 63 - j : j; const int row = rowbase + tok0 + i;
        const float beta = sigmoidf_(G[(size_t)row * 16 + dir * 8 + h]);
        const float ld = -expf(alog[dir * 4 + h]) * softplusf_(G[(size_t)row * 16 + dir * 8 + 4 + h] + dtb[dir * 4 + h]);
        const float gcum = chain_cumsum(ld, j, 0); gc[j] = gcum; be[j] = beta; gam[j] = expf(gcum);
        if (j == 63) GE[ci] = expf(gcum); }
    {   const int j = c.tid >> 3, cg = c.tid & 7, i = dir ? 63 - j : j, tok = tok0 + i;
        bf16x8 raw[3][2], rawn[3][2];
#define D1_LOADROWS(R, TEN) { _Pragma("unroll") for (int tap = 0; tap < 3; ++tap) { const int tk = tok + tap - 1; const bool in = tk >= 0 && tk < seqlen; \
            const bf16_t* src = DQ + (size_t)(rowbase + (in ? tk : tok)) * 1536 + (TEN) * 512 + h * 128 + 16 * cg; R[tap][0] = ld16(src); R[tap][1] = ld16(src + 8); \
            if (!in) { R[tap][0] = (bf16x8){0, 0, 0, 0, 0, 0, 0, 0}; R[tap][1] = (bf16x8){0, 0, 0, 0, 0, 0, 0, 0}; } } }
        D1_LOADROWS(rawn, 0);
#pragma unroll 1
        for (int ten = 0; ten < 3; ++ten) { const int col = ten * 512 + h * 128 + 16 * cg;
            float val[16];
#pragma unroll
            for (int e = 0; e < 16; ++e) val[e] = 0.f;
#pragma unroll
            for (int tap = 0; tap < 3; ++tap) { raw[tap][0] = rawn[tap][0]; raw[tap][1] = rawn[tap][1]; }
            if (ten < 2) D1_LOADROWS(rawn, ten + 1);
            SCHED_FENCE();
#pragma unroll
            for (int tap = 0; tap < 3; ++tap) { float f0[8], f1[8]; unpack8(raw[tap][0], f0); unpack8(raw[tap][1], f1);
                const float* wp = cwl + tap * 1536 + col;
#pragma unroll
                for (int e = 0; e < 8; ++e) { val[e] += f0[e] * wp[e]; val[8 + e] += f1[e] * wp[8 + e]; }
                SCHED_FENCE(); }
#pragma unroll
            for (int e = 0; e < 16; ++e) val[e] = siluf_(val[e]);
            if (ten < 2) { float ss = 0.f;
#pragma unroll
                for (int e = 0; e < 16; ++e) ss += val[e] * val[e];
                ss += SHFL_XOR(ss, 1); ss += SHFL_XOR(ss, 2); ss += SHFL_XOR(ss, 4);
                const float sc = (1.0f / sqrtf(ss + EPS)) * (ten == 0 ? 0.08838834764831845f : 1.0f);
#pragma unroll
                for (int e = 0; e < 16; ++e) val[e] *= sc; }
            if (ten < 2) { bf16_t* dst = (ten == 0 ? Qs : Ks) + j * 136 + 16 * cg; float fa[8], fb[8];
#pragma unroll
                for (int e = 0; e < 8; ++e) { fa[e] = val[e]; fb[e] = val[8 + e]; }
                *(bf16x8*)dst = pack8(fa); *(bf16x8*)(dst + 8) = pack8(fb); }
            if (ten >= 1) { bf16_t* dstT = (ten == 1 ? Kt : Vt);
#pragma unroll
                for (int e = 0; e < 16; ++e) dstT[(16 * cg + e) * 72 + (((j >> 3) ^ cg) << 3) + (j & 7)] = (bf16_t)f2bf(val[e]); } } }
    BLOCK_SYNC(); if (stop == 1) return;
    const int r = c.lane & 31, hh = c.lane >> 5;
    {
        const int wq = c.wave & 3, tt = wq >> 1, st = wq & 1; const bool isq = c.wave >= 4;
        f32x16 acc;
#pragma unroll
        for (int i = 0; i < 16; ++i) acc[i] = 0.f;
        const bf16_t* Ar = (isq ? Qs : Ks) + (32 * tt + r) * 136; const bf16_t* Br = Ks + (32 * st + r) * 136;
#pragma unroll
        for (int ks = 0; ks < 8; ++ks) acc = MFMA32(ld16(Ar + 16 * ks + 8 * hh), ld16(Br + 16 * ks + 8 * hh), acc);
        const int s = 32 * st + r; const float gs = gc[s];
#pragma unroll
        for (int i = 0; i < 16; ++i) { const int t = 32 * tt + crow(i, hh); const float dec = expf(gc[t] - gs);
            if (!isq) Am[t * 65 + s] = t > s ? be[t] * dec * acc[i] : 0.f;
            else ATb[t * 64 + s] = (bf16_t)f2bf(t >= s ? dec * acc[i] : 0.f); } }
    BLOCK_SYNC(); if (stop == 2) return;
    if (c.wave == 0) { const int d = c.lane >> 4, cc = c.lane & 15; const float* Ad = Am + (16 * d) * 65 + 16 * d; float* Td = T2 + (16 * d) * 65 + 16 * d;
        float t[16];
#pragma unroll
        for (int i = 0; i < 16; ++i) { float acc = (cc == i) ? 1.f : 0.f;
#pragma unroll
            for (int j = 0; j < i; ++j) acc -= Ad[i * 65 + j] * t[j];
            t[i] = acc; }
#pragma unroll
        for (int i = 0; i < 16; ++i) Td[i * 65 + cc] = t[i]; }
    else { for (int e = c.tid - 64; e < 64 * 64; e += NTHREADS - 64) { const int t = e >> 6, s2 = e & 63; if ((s2 >> 4) > (t >> 4)) T2[t * 65 + s2] = 0.f; } }
    BLOCK_SYNC();
    for (int rb = 1; rb < 4; ++rb) { const int wcols = 16 * rb;
        for (int e = c.tid; e < 16 * wcols; e += NTHREADS) { const int i = e & 15, cidx = e >> 4; float acc = 0.f; const float* Ar = Am + (16 * rb + i) * 65;
            for (int kb = cidx & ~15; kb < wcols; kb += 16) {
#pragma unroll
                for (int kk = 0; kk < 16; ++kk) acc += Ar[kb + kk] * T2[(kb + kk) * 65 + cidx]; }
            Rb[i * 49 + cidx] = acc; }
        BLOCK_SYNC();
        for (int e = c.tid; e < 16 * wcols; e += NTHREADS) { const int i = e & 15, cidx = e >> 4; float acc = 0.f; const float* Tr = T2 + (16 * rb + i) * 65 + 16 * rb;
#pragma unroll
            for (int j = 0; j < 16; ++j) acc += Tr[j] * Rb[j * 49 + cidx];
            T2[(16 * rb + i) * 65 + cidx] = -acc; }
        BLOCK_SYNC(); }
    if (stop == 3) return;
#ifndef EMU
    int lane2_ = c.lane; asm volatile("" : "+v"(lane2_));
    const int r2 = lane2_ & 31, hh2 = lane2_ >> 5;
#else
    const int r2 = r, hh2 = hh;
#endif
    {
#pragma unroll
        for (int rep = 0; rep < 2; ++rep) { const int idx = c.wave + 8 * rep, isw = idx >> 3, tt = (idx >> 2) & 1, ct = idx & 3;
            f32x16 acc;
#pragma unroll
            for (int i = 0; i < 16; ++i) acc[i] = 0.f;
            const bf16_t* Bt = (isw ? Kt : Vt) + (32 * ct + r2) * 72;
#pragma unroll
            for (int ks = 0; ks < 4; ++ks) { float f[8];
#pragma unroll
                for (int e = 0; e < 8; ++e) { const int s = 16 * ks + 8 * hh2 + e; f[e] = T2[(32 * tt + r2) * 65 + s] * be[s] * (isw ? gam[s] : 1.0f); }
                acc = MFMA32(pack8(f), ld16(Bt + 8 * ((2 * ks + hh2) ^ (((32 * ct + r2) >> 4) & 7))), acc); }
            bf16_t* dst = (isw ? Wb : Ub);
#pragma unroll
            for (int i = 0; i < 16; ++i) dst[(32 * tt + crow(i, hh2)) * 128 + 32 * ct + r2] = (bf16_t)f2bf(acc[i]); } }
    {
        const float gend = gc[63];
        const int j = c.tid >> 3, cg = c.tid & 7; const float gamj = gam[j];
#pragma unroll
        for (int half = 0; half < 2; ++half) { float f[8]; unpack8(ld16(Qs + j * 136 + 16 * cg + 8 * half), f);
#pragma unroll
            for (int e = 0; e < 8; ++e) f[e] *= gamj;
            *(bf16x8*)(QNb + j * 128 + 16 * cg + 8 * half) = pack8(f); }
#pragma unroll
        for (int ii = 0; ii < 2; ++ii) { const int idx = c.tid + 512 * ii, dk = idx >> 3, ch = idx & 7; float f[8]; unpack8(ld16(Kt + dk * 72 + 8 * (ch ^ ((dk >> 4) & 7))), f);
#pragma unroll
            for (int e = 0; e < 8; ++e) f[e] *= expf(gend - gc[8 * ch + e]);
            *(bf16x8*)(KDb + dk * 64 + 8 * ch) = pack8(f); } }
    BLOCK_SYNC();
}
constexpr int D2_PW = 132, D2_PA = 68;
constexpr int D2_W = 0, D2_QN = 64 * D2_PW * 2, D2_AT = 2 * 64 * D2_PW * 2, D2_KD = D2_AT + 64 * D2_PA * 2, D2_BUF = D2_KD + 128 * D2_PA * 2;
static_assert(2 * D2_BUF <= LDS_MISC, "two D2 buffers fit below the LDS control words");
DEV void dn_d2_stage(const Ctx& c, size_t ci, char* buf) {
    const bf16_t* Wb = (const bf16_t*)(c.ws + SO_W) + ci * 8192; const bf16_t* QNb = (const bf16_t*)(c.ws + SO_QN) + ci * 8192; const bf16_t* ATb = (const bf16_t*)(c.ws + SO_AT) + ci * 4096; const bf16_t* KDb = (const bf16_t*)(c.ws + SO_KD) + ci * 8192;
    const int lt = c.tid - 256;
#pragma unroll 2
    for (int i = 0; i < 14; ++i) { const int idx = lt + 256 * i; const bf16_t* src; char* dst;
        if (idx < 1024) { const int row = idx >> 4, ch = idx & 15; src = Wb + row * 128 + 8 * ch; dst = buf + D2_W + (row * D2_PW + 8 * ch) * 2; }
        else if (idx < 2048) { const int j = idx - 1024, row = j >> 4, ch = j & 15; src = QNb + row * 128 + 8 * ch; dst = buf + D2_QN + (row * D2_PW + 8 * ch) * 2; }
        else if (idx < 2560) { const int j = idx - 2048, row = j >> 3, ch = j & 7; src = ATb + row * 64 + 8 * ch; dst = buf + D2_AT + (row * D2_PA + 8 * ch) * 2; }
        else { const int j = idx - 2560, row = j >> 3, ch = j & 7; src = KDb + row * 64 + 8 * ch; dst = buf + D2_KD + (row * D2_PA + 8 * ch) * 2; }
        const bf16x8 v = ld16(src); const bf16x4 lo = __builtin_shufflevector(v, v, 0, 1, 2, 3), hi = __builtin_shufflevector(v, v, 4, 5, 6, 7);
        *(bf16x4*)dst = lo; *(bf16x4*)(dst + 8) = hi; }
}
DEV void dn_d2_chain(const Ctx& c, int chain, bool emit_ctx) {
    const int dir = chain & 1, h = (chain >> 1) & 3, b = chain >> 3; const int r = c.lane & 31, hh = c.lane >> 5, sl = c.wave & 3; const bool comp = c.wave < 4;
    const bf16_t* U0 = (const bf16_t*)(c.ws + SO_U); const float* GE = (const float*)(c.ws + SO_GE);
    bf16_t* HB = (bf16_t*)(c.ws + OFF_P) + PO_HB + (size_t)dir * MT * 512;
    f32x16 S[4];
#pragma unroll
    for (int t4 = 0; t4 < 4; ++t4)
#pragma unroll
        for (int i = 0; i < 16; ++i) S[t4][i] = 0.f;
    if (!comp) dn_d2_stage(c, (size_t)chain * NCH, c.lds);
    BLOCK_SYNC();
    for (int cc = 0; cc < NCH; ++cc) { const size_t ci = (size_t)chain * NCH + cc; char* buf = c.lds + (cc & 1) * D2_BUF;
        if (!comp) { if (cc + 1 < NCH) dn_d2_stage(c, ci + 1, c.lds + ((cc + 1) & 1) * D2_BUF); }
        else {
            const bf16_t* Ub = U0 + ci * 8192; const bf16_t* Wl = (const bf16_t*)(buf + D2_W); const bf16_t* QNl = (const bf16_t*)(buf + D2_QN); const bf16_t* ATl = (const bf16_t*)(buf + D2_AT); const bf16_t* KDl = (const bf16_t*)(buf + D2_KD);
            f32x16 u[2], ov[2];
#pragma unroll
            for (int tt = 0; tt < 2; ++tt)
#pragma unroll
                for (int i = 0; i < 16; ++i) { u[tt][i] = -bf2f(Ub[(32 * tt + crow(i, hh)) * 128 + 32 * sl + r]); ov[tt][i] = 0.f; }
#pragma unroll
            for (int ks = 0; ks < 8; ++ks) { const bf16x8 sf = pack_acc(S[ks >> 1], ks & 1); const int k0 = 16 * ks + 4 * hh;
#pragma unroll
                for (int tt = 0; tt < 2; ++tt) { const bf16_t* wp = Wl + (32 * tt + r) * D2_PW + k0; const bf16_t* qp = QNl + (32 * tt + r) * D2_PW + k0;
                    u[tt] = MFMA32(cat44(*(const bf16x4*)wp, *(const bf16x4*)(wp + 8)), sf, u[tt]);
                    ov[tt] = MFMA32(cat44(*(const bf16x4*)qp, *(const bf16x4*)(qp + 8)), sf, ov[tt]); } }
#pragma unroll
            for (int tt = 0; tt < 2; ++tt)
#pragma unroll
                for (int i = 0; i < 16; ++i) u[tt][i] = -u[tt][i];
            const float ge = GE[ci];
#pragma unroll
            for (int t4 = 0; t4 < 4; ++t4)
#pragma unroll
                for (int i = 0; i < 16; ++i) S[t4][i] *= ge;
#pragma unroll
            for (int ks = 0; ks < 4; ++ks) { const bf16x8 uf = pack_acc(u[ks >> 1], ks & 1);
#pragma unroll
                for (int tt = 0; tt < 2; ++tt) { const bf16_t* ap = ATl + (32 * tt + r) * D2_PA + 16 * ks + 4 * hh;
                    ov[tt] = MFMA32(cat44(*(const bf16x4*)ap, *(const bf16x4*)(ap + 8)), uf, ov[tt]); }
#pragma unroll
                for (int t4 = 0; t4 < 4; ++t4) { const bf16_t* kp = KDl + (32 * t4 + r) * D2_PA + 16 * ks + 4 * hh;
                    S[t4] = MFMA32(cat44(*(const bf16x4*)kp, *(const bf16x4*)(kp + 8)), uf, S[t4]); } }
            const int tc = dir == 0 ? cc : (cc < NCC ? NCC - 1 - cc : NCC + (NLC - 1 - (cc - NCC)));
            if (tc >= NCC || emit_ctx) {
#pragma unroll
                for (int tt = 0; tt < 2; ++tt)
#pragma unroll
                    for (int i = 0; i < 16; ++i) { const int j = 32 * tt + crow(i, hh); const int row = tok_row(b, tc, dir ? 63 - j : j);
                        HB[(size_t)row * 512 + h * 128 + 32 * sl + r] = (bf16_t)f2bf(ov[tt][i]); } }
        }
        BLOCK_SYNC();
    }
}
DEV void dn_yasm(const Ctx& c, int layer, int nrows) {
    const bf16_t* HB = (const bf16_t*)(c.ws + OFF_P) + PO_HB; const bf16_t* Z = (const bf16_t*)(c.ws + OFF_P) + PO_Z; const bf16_t* QC = (const bf16_t*)(c.ws + OFF_P) + PO_GO; bf16_t* Y = (bf16_t*)(c.ws + OFF_HY);
    const float* gn = c.in[19] + (size_t)(layer >> 1) * 128;
    for (int it = c.gw; it < nrows * 2; it += c.ngw) { const int row = it >> 1, col = (it & 1) * 256 + 4 * c.lane;
        const bf16x4 a = *(const bf16x4*)(HB + (size_t)row * 512 + col), bb = *(const bf16x4*)(HB + (size_t)MT * 512 + (size_t)row * 512 + col), z = *(const bf16x4*)(Z + (size_t)row * 512 + col);
        float v[4], ss = 0.f;
#pragma unroll
        for (int e = 0; e < 4; ++e) { v[e] = bf2f((unsigned short)a[e]) + bf2f((unsigned short)bb[e]); ss += v[e] * v[e]; }
#pragma unroll
        for (int o = 1; o < 32; o <<= 1) ss += SHFL_XOR(ss, o);
        const float rstd = 1.0f / sqrtf(ss * (1.0f / 128.0f) + EPS);
        float y[4];
#pragma unroll
        for (int e = 0; e < 4; ++e) y[e] = v[e] * rstd * gn[(col & 127) + e] * siluf_(bf2f((unsigned short)z[e]));
        u32x2 w; w[0] = pk2(y[0], y[1]); w[1] = pk2(y[2], y[3]);
        *(u32x2*)(Y + (size_t)row * 1024 + 512 + col) = w;
        *(u32x2*)(Y + (size_t)row * 1024 + col) = *(const u32x2*)(QC + (size_t)row * 512 + col); }
}

DEV void gqa_units(const Ctx& c, int layer, bool emit_ctx, int first, int stride) {
    constexpr int NQBL = SEQ / 256, NQBC = (CTX + 255) / 256, NUL = NB * 8 * NQBL, NUC = NB * 8 * NQBC;
    const int nuc = emit_ctx ? NUC : 0;
    for (int it = first; it < NUL + nuc; it += stride) { const bool cu = it >= NUL; int u = cu ? it - NUL : it; const int nqb = cu ? NQBC : NQBL;
        gqa_unit(c, layer, u / (8 * nqb), (u / nqb) & 7, cu, u % nqb); }
}
DEV void mix_odd_a(const Ctx& c, int layer) {
    { PHASE_CTX(pc); if (ON(14)) odd_kprep(pc, layer); }
    { PHASE_CTX(pc); if (ON(15)) { const bf16_t* KVC = (const bf16_t*)(pc.ws + OFF_P) + PO_KVC; bf16_t* VT = (bf16_t*)(pc.ws + SO_VT);
        for (int it = pc.bid; it < NB * 2 * NCH; it += pc.nblk) { const int pch = it % NCH, bk = it / NCH; vt_item<64>(pc, KVC, 256, 128 + (bk & 1) * 64, bk >> 1, pch, VT + (size_t)bk * 64 * LK); } } }
    REPB(16) { PHASE_CTX(pc); if (ON(16)) {
        { const float* convw = pc.in[16] + (size_t)(layer >> 1) * 3 * 1536; float* cwl = (float*)(pc.lds + D1_CW_OFF); BLOCK_SYNC();
          for (int e = pc.tid; e < 3 * 1536 / 4; e += NTHREADS) ((f32x4*)cwl)[e] = ((const f32x4*)convw)[e];
          BLOCK_SYNC(); }
        for (int it = pc.bid; it < NCHAIN * NCH; it += pc.nblk) dn_d1_item(pc, layer, it, (rep_ < (int)(((unsigned long long)(REPM) >> 16) & 1ull)) ? D1_STOP : 0); } }
}
DEV void mix_odd_b(const Ctx& c, int layer, bool emit_ctx) {
    const int nd2 = NCHAIN < c.nblk ? NCHAIN : c.nblk;
    const int na = c.nblk - nd2;
    REPB(17) { PHASE_CTX(pc); if (ON(17)) if (pc.bid < nd2) { for (int ch = pc.bid; ch < NCHAIN; ch += nd2) dn_d2_chain(pc, ch, emit_ctx); } }
    REPB(18) { PHASE_CTX(pc); if (ON(18)) { if (na > 0) { if (pc.bid >= nd2) gqa_units(pc, layer, emit_ctx, pc.bid - nd2, na); } else gqa_units(pc, layer, emit_ctx, pc.bid, pc.nblk); } }
}
DEV void mix_odd_c(const Ctx& c, int layer, bool emit_ctx) {
    { PHASE_CTX(pc); if (ON(19)) dn_yasm(pc, layer, emit_ctx ? MT : ML); }
}

#ifdef SELFTEST
#ifdef EMU
#define ST_HD static inline
#else
#define ST_HD __host__ __device__ inline
#endif
constexpr size_t ST_CHK = 512 * 1024;
ST_HD unsigned st_hash(unsigned a, unsigned b) { unsigned x = a * 0x9E3779B1u ^ (b + 0x7F4A7C15u) * 0x85EBCA6Bu; x ^= x >> 16; x *= 0x7FEB352Du; x ^= x >> 15; x *= 0x846CA68Bu; x ^= x >> 16; return x; }
ST_HD float st_uniform(unsigned t, unsigned i) { return (float)(st_hash(t, i) >> 8) * (1.0f / 16777216.0f); }
ST_HD float st_normal(unsigned tensor, unsigned idx) { const float u1 = ((float)(st_hash(tensor * 4u, idx) >> 8) + 0.5f) * (1.0f / 16777216.0f), u2 = (float)(st_hash(tensor * 4u + 1u, idx) >> 8) * (1.0f / 16777216.0f); return sqrtf(-2.0f * logf(u1)) * cosf(6.2831853f * u2); }
ST_HD size_t st_count(int i) {
    switch (i) {
    case 0: return (size_t)NB * SEQ * D; case 1: return (size_t)NB * D; case 2: return (size_t)NB * CTX * D; case 3: return D;
    case 4: return (size_t)DEPTH * D * 6 * D; case 5: return (size_t)DEPTH * 6 * D; case 6: case 7: return (size_t)DEPTH * D;
    case 8: return (size_t)2 * D * E_IN; case 9: return 32; case 10: return 512; case 11: case 12: return 256; case 13: return (size_t)2 * 1024 * D;
    case 14: return (size_t)2 * D * O_IN; case 15: return 256; case 16: return 2 * 3 * 1536; case 17: return 16; case 18: return 16; case 19: return 256; case 20: return (size_t)2 * 1024 * D;
    case 21: case 22: return (size_t)DEPTH * D * FF; case 23: return (size_t)DEPTH * FF * D; default: return D; }
}
ST_HD float st_value(int i, size_t idx) {
#ifdef ST_SAME_BATCH
    if (i == 0) idx %= (size_t)SEQ * D; if (i == 1) idx %= (size_t)D; if (i == 2) idx %= (size_t)CTX * D;
#endif
    const float d = (float)D; const float n = st_normal((unsigned)i + 1u, (unsigned)idx);
    switch (i) {
    case 0: case 1: case 2: case 3: return n;
    case 4: return n * 0.5f / sqrtf(d); case 5: return n * 0.02f; case 6: case 7: case 11: case 12: case 15: case 19: case 24: return 1.0f + 0.02f * n;
    case 8: case 14: case 21: case 22: return n / sqrtf(d);
    case 9: return 0.1f * n + ((idx & 4) ? 3.0f + (float)(idx & 3) : 0.0f);
    case 10: return 0.1f * n; case 13: case 20: return n * (1.0f / 32.0f); case 16: return n * 0.57735027f;
    case 17: return logf(1.0f + 5.0f * (float)(idx & 3)) + 0.05f * n;
    case 18: { const float dt = expf(-6.9077553f + 4.6051702f * st_uniform(999u, (unsigned)idx)); return dt + logf(-expm1f(-dt)); }
    case 23: return n / sqrtf((float)FF);
    default: return n; }
}
ST_HD size_t st_offset(int i) { size_t o = 0; for (int k = 0; k < i; ++k) o += (st_count(k) + 63) & ~(size_t)63; return o; }
DEV void st_sum(const Ctx& c, int step, int sub, const void* base, size_t n, int is_bf16) {
    step += c.ngw;
    double p[8], s2 = 0.0;
#pragma unroll
    for (int k = 0; k < 8; ++k) p[k] = 0.0;
    const size_t gt = (size_t)c.bid * NTHREADS + c.tid, GT = (size_t)c.nblk * NTHREADS;
    for (size_t i = gt; i < n; i += GT) { const float v = is_bf16 ? bf2f(((const bf16_t*)base)[i]) : ((const float*)base)[i]; const unsigned h = st_hash(0xC0FFEEu + (unsigned)sub, (unsigned)i); s2 += (double)v * (double)v;
#pragma unroll
        for (int k = 0; k < 8; ++k) p[k] += ((h >> (k + 8)) & 1u) ? (double)v : -(double)v; }
    double* chk = (double*)(c.ws + ST_CHK) + ((size_t)step * 4 + sub) * 10;
#ifdef EMU
    for (int k = 0; k < 8; ++k) chk[k] += p[k];
    chk[8] += s2; if (gt == 0) chk[9] = (double)n;
#else
#pragma unroll
    for (int k = 0; k < 8; ++k) atomicAdd(chk + k, p[k]);
    atomicAdd(chk + 8, s2); if (gt == 0) chk[9] = (double)n;
#endif
}
DEV void st_checks(const Ctx& c, int step) {

    const int layer = step / 9, ph = step - 9 * layer, odd = layer & 1; const size_t mrows = layer < DEPTH - 1 ? MT : ML; unsigned char* ws = c.ws;
    if (ph == 0) { st_sum(c, step, 0, ws + OFF_HY, (size_t)MT * D, 1); st_sum(c, step, 1, ws + OFF_G, (size_t)MT * 16, 0); st_sum(c, step, 2, ws + OFF_WIN, (size_t)(odd ? NO : NE) * D, 1); st_sum(c, step, 3, ws + OFF_WOUT, (size_t)D * 1024, 1); }
    else if (ph == 1) { st_sum(c, step, 0, ws + OFF_P, (size_t)MT * (odd ? NO : NE), 1); }
    else if (ph == 2) { if (!odd) { st_sum(c, step, 0, ws + SE_KP, (size_t)NB * 8 * LK * 64, 1); st_sum(c, step, 1, ws + SE_VT, (size_t)NB * 4 * 128 * LK, 1); st_sum(c, step, 2, ws + SE_DCT, (size_t)NCHAIN * NCH * 8192, 0); st_sum(c, step, 3, ws + SE_DN, (size_t)NCHAIN * NCH * 64, 0); }
        else { st_sum(c, step, 0, ws + SO_KP, (size_t)NB * 2 * LK * 64 * 2, 1); st_sum(c, step, 1, ws + SO_U, (size_t)NCHAIN * NCH * 8192, 1); st_sum(c, step, 2, ws + SO_W, (size_t)NCHAIN * NCH * 8192, 1); st_sum(c, step, 3, ws + SO_AT, (size_t)NCHAIN * NCH * (4096 + 8192 + 8192), 1); } }
    else if (ph == 3) { if (!odd) { st_sum(c, step, 0, ws + SE_DCT, (size_t)NCHAIN * NCH * 8192, 0); st_sum(c, step, 1, ws + SE_DN, (size_t)NCHAIN * NCH * 64, 0); }
        else { st_sum(c, step, 0, ws + OFF_P + PO_HB * 2, (size_t)mrows * 512, 1); st_sum(c, step, 1, ws + OFF_P + (PO_HB + (size_t)MT * 512) * 2, (size_t)mrows * 512, 1); st_sum(c, step, 2, ws + OFF_P + PO_GO * 2, (size_t)mrows * 512, 1); } }
    else if (ph == 4) { st_sum(c, step, 0, ws + OFF_HY, (size_t)mrows * 1024, 1); }
    else if (ph == 5 || ph == 8) { st_sum(c, step, 0, ws + OFF_X, (size_t)mrows * D, 0); }
    else if (ph == 6) { st_sum(c, step, 0, ws + OFF_HY, (size_t)mrows * D, 1); st_sum(c, step, 1, ws + SF_WGU, (size_t)2 * FF * D, 1); st_sum(c, step, 2, ws + SF_WDN, (size_t)D * FF, 1); }
    else { st_sum(c, step, 0, ws + OFF_P, (size_t)mrows * FF, 1); }
}
#endif

DEV void final_norm(const Ctx& c) {
    constexpr int NV = D / 256;
    const float* X = (const float*)(c.ws + OFF_X); const float* g = c.in[24];
    for (int row = c.gw; row < ML; row += c.ngw) {
        const f32x4* xr = (const f32x4*)(X + (size_t)row * D) + c.lane; f32x4 v[NV]; float ss = 0.f;
#pragma unroll
        for (int j = 0; j < NV; ++j) { v[j] = xr[64 * j]; ss += (v[j][0] * v[j][0] + v[j][1] * v[j][1]) + (v[j][2] * v[j][2] + v[j][3] * v[j][3]); }
        const float rstd = 1.0f / sqrtf(wave_sum(ss) * (1.0f / D) + EPS);
        f32x4* o = (f32x4*)(c.out + (size_t)row * D) + c.lane;
#pragma unroll
        for (int j = 0; j < NV; ++j) o[64 * j] = v[j] * rstd * *(const f32x4*)(g + 256 * j + 4 * c.lane);
    }
}

constexpr size_t WS_NEED = cmax(WS_NEED_EF, SO_END);
#ifdef EMU
static void mega(Args args) {
    char* lds = emu::blocks[EMU_BID].lds;
    XcdBarrier bar; bar.dummy = 0;
#else
__global__ void __launch_bounds__(NTHREADS, 2) mega(Args args) {
    extern __shared__ __attribute__((aligned(16))) unsigned char lds_raw[];
    char* lds = (char*)lds_raw;
    {   volatile LAS unsigned* misc0 = (volatile LAS unsigned*)((LAS unsigned char*)lds_raw + LDS_MISC);
        if (threadIdx.x < 64) misc0[threadIdx.x] = 0u; }
    __syncthreads();
    XcdBarrier bar = xcd_barrier_post((unsigned*)(args.ws + OFF_CTL) + 4096, (volatile LAS unsigned*)((LAS unsigned char*)lds_raw + LDS_MISC) + 8);
#endif
    Ctx c;
#ifdef EMU
    c.tid = TIDX; c.lane = c.tid & 63; c.wave = c.tid >> 6;
#else
    c.tid = 0; c.lane = 0; c.wave = 0;
#endif
    c.bid = BIDX; c.nblk = NBLK; c.gw = c.bid * NWAVES + c.wave; c.ngw = c.nblk * NWAVES; c.lds = lds; c.in = args.in; c.out = args.out; c.ws = args.ws;

    if (args.prologue) {
    { PHASE_CTX(pc); if (ON(0)) p0_prologue(pc); }
#ifndef EMU
    cg::this_grid().sync();
#else
    GRID_BARRIER();
#endif
    }
#ifndef REPEAT_PH
#define REPEAT_PH -1
#endif
    for (int step2 = 2 * args.step_lo; step2 < 2 * args.step_hi; ++step2) {
        const int step = step2 >> 1; if ((step2 & 1) && !((step % 9) == REPEAT_PH && (REPEAT_PH != 3 || ((step / 9) & 1)))) continue;
        const int layer = step / 9, ph = step - 9 * layer;
        const int odd = layer & 1; const bool emit_ctx = layer < DEPTH - 1; const int mrows = emit_ctx ? MT : ML;
        if (ph == 0) {
            { PHASE_CTX(pc); if (ON(1) && (layer == 0 || step == args.step_lo)) convert_mixer_weights(pc, layer, pc.gw, pc.ngw); }
            { PHASE_CTX(pc); const bool prev = layer > 0 && step > args.step_lo; const int pm_ = MT;
              const SplitPlan red = split_plan(pm_, FF, pc.nblk, prev);
              if (ON(2)) normalize_rows(pc, layer, 0, MT, red, pm_, (const float*)(pc.ws + OFF_MOD) + (size_t)(layer - (prev ? 1 : 0)) * 9 * 6 * D + 5 * D); }
        } else if (ph == 1) {
            if (ON(3)) { PHASE_CTX(pc); pg8::Gemm g{(const bf16_t*)(pc.ws + OFF_HY), (const bf16_t*)(pc.ws + OFF_WIN), MT, odd ? NO : NE, D}; pg8::StaticOrder S; S.init(MT, odd ? NO : NE, c.nblk, c.bid); S.wave = pc.wave;
                if (odd && !emit_ctx && NO == 2816) { S.init(ML, NO, c.nblk, c.bid); S.wave = pc.wave; S.tn = (MC / 256) * 7; S.tpm = ML / 256; S.tpn = 2; S.tw = 7; }
                EpiSeg E{(bf16_t*)(pc.ws + OFF_P), odd};
                GEMM_PHASE(EpiSeg, lds, g, S, E); }
        } else if (ph == 2) { if (!odd) mix_even_a(c, layer); else mix_odd_a(c, layer); }
        else if (ph == 3) { if (!odd) mix_even_b(c, layer); else mix_odd_b(c, layer, emit_ctx); }
        else if (ph == 4) { if (!odd) mix_even_c(c, layer); else mix_odd_c(c, layer, emit_ctx); }
        else if (ph == 5 || ph == 8) {
            if (ON(4)) { PHASE_CTX(pc); const bool dn = ph == 8;
                const int kdim = dn ? FF : 1024; const SplitPlan sp = split_plan(mrows, kdim, pc.nblk, dn && layer + 1 < CFG_LAYERS);
                pg8::Gemm g{(const bf16_t*)(pc.ws + (dn ? OFF_P : OFF_HY)), (const bf16_t*)(pc.ws + (dn ? SF_WDN : OFF_WOUT)), mrows, D, kdim}; pg8::StaticOrder S; S.init(mrows, D, c.nblk, c.bid); S.wave = pc.wave;
                if (sp.extra) S.lim = pc.nblk;
                const bool first = layer == 0 && !dn;
                EpiResid E{(float*)(pc.ws + OFF_X), (const float*)(pc.ws + OFF_MOD) + (size_t)layer * 9 * 6 * D, dn ? 5 * D : 2 * D,
                           first ? pc.in[0] : (const float*)(pc.ws + OFF_X), first ? pc.in[2] - (size_t)ML * D : (const float*)(pc.ws + OFF_X)};
                GEMM_PHASE(EpiResid, lds, g, S, E);
                if (sp.extra && pc.bid < sp.extra * sp.split) {
                    const int lu = pc.bid / sp.split, q = pc.bid % sp.split, pairs = kdim / 128, base = pairs / sp.split, rem = pairs % sp.split;
                    const int np = base + (q < rem ? 1 : 0), p0 = q * base + (q < rem ? q : rem);
                    pg8::Gemm g2{g.A + (size_t)p0 * 128, g.Bt + (size_t)p0 * 128, mrows, D, np * 128, kdim}; pg8::StaticOrder S2; S2.init(mrows, D, sp.nwg, pc.nblk + lu); S2.wave = pc.wave;
                    EpiPart E2{(float*)(pc.ws + SF_PART) + (size_t)pc.bid * 65536};
                    BLOCK_SYNC();
                    GEMM_PHASE(EpiPart, lds, g2, S2, E2); } }
            { PHASE_CTX(pc); const SplitPlan sp = split_plan(mrows, ph == 8 ? FF : 1024, pc.nblk, ph == 8 && layer + 1 < CFG_LAYERS);
              const int nwg = sp.nwg; int busy = (nwg > pc.nblk && nwg < 2 * pc.nblk) ? nwg - pc.nblk : 0; if (sp.extra) busy = (pc.nblk - sp.extra * sp.split > pc.nblk / 4) ? sp.extra * sp.split : 0;
              if (ON(1) && pc.bid >= busy) { BLOCK_SYNC();
                  if (ph == 5) convert_ffn_weights(pc, layer, (pc.bid - busy) * NWAVES + pc.wave, (pc.nblk - busy) * NWAVES);
                  else if (layer + 1 < CFG_LAYERS && step + 1 < args.step_hi) convert_mixer_weights(pc, layer + 1, (pc.bid - busy) * NWAVES + pc.wave, (pc.nblk - busy) * NWAVES); } }
        } else if (ph == 6) {
            { PHASE_CTX(pc); const SplitPlan red = split_plan(mrows, 1024, pc.nblk, false);
              if (ON(2)) normalize_rows(pc, layer, 1, mrows, red, mrows, (const float*)(pc.ws + OFF_MOD) + (size_t)layer * 9 * 6 * D + 2 * D); }
        } else {
            if (ON(5)) { PHASE_CTX(pc); pg8::Gemm g{(const bf16_t*)(pc.ws + OFF_HY), (const bf16_t*)(pc.ws + SF_WGU), mrows, 2 * FF, D}; pg8::StaticOrder S; S.init(mrows, 2 * FF, c.nblk, c.bid); S.wave = pc.wave;
                EpiSwiglu E{(bf16_t*)(pc.ws + OFF_P)};
                GEMM_PHASE(EpiSwiglu, lds, g, S, E); }
        }
        if (step + 1 < args.step_hi || args.final_) GRID_BARRIER();
#ifdef EMU_STOP_AFTER_MIX
        if (layer == CFG_LAYERS - 1 && ph == 4) return;
#endif
    }
    if (args.final_) { PHASE_CTX(pc); if (ON(7)) final_norm(pc); }
}

#ifndef EMU
#ifdef PROBE_Y
__global__ void pr_stat(const bf16_t* Y, int rows, int c0, int c1, double* acc) {
    double s = 0.0, cnt = 0.0; float mx = 0.f;
    for (size_t k = (size_t)blockIdx.x * blockDim.x + threadIdx.x; k < (size_t)rows * 1024; k += (size_t)gridDim.x * blockDim.x) { const int col = (int)(k & 1023); if (col < c0 || col >= c1) continue;
        const float v = bf2f(Y[k]); s += (double)v * v; cnt += 1.0; mx = fmaxf(mx, fabsf(v)); }
    atomicAdd(acc, s); atomicAdd(acc + 1, cnt); atomicMax((unsigned long long*)acc + 2, (unsigned long long)(mx * 1e6f));
}
__global__ void pr_fill(const double* acc, float* out, int n) {
    const float rms = (float)sqrt(acc[0] / acc[1]), mx = (float)((const unsigned long long*)acc)[2] * 1e-6f;
    const float c = sqrtf(rms * 10.0f), B = mx * 10.0f;
    for (size_t k = (size_t)blockIdx.x * blockDim.x + threadIdx.x; k < (size_t)n; k += (size_t)gridDim.x * blockDim.x) out[k] = (k == 12345) ? B : c;
}
#endif
#ifdef SELFTEST
struct StPtrs { float* p[25]; };
__global__ void st_gen_inplace(StPtrs P) {
    for (int i = 0; i < 25; ++i) { const size_t n = st_count(i);
        for (size_t k = (size_t)blockIdx.x * blockDim.x + threadIdx.x; k < n; k += (size_t)gridDim.x * blockDim.x) P.p[i][k] = st_value(i, k); }
}
__global__ void st_gen(float* syn) {
    for (int i = 0; i < 25; ++i) { const size_t n = st_count(i), o = st_offset(i);
        for (size_t k = (size_t)blockIdx.x * blockDim.x + threadIdx.x; k < n; k += (size_t)gridDim.x * blockDim.x) syn[o + k] = st_value(i, k); }
}
constexpr int ST_NEXP = 74;
#ifndef ST_REPORT_SUB
#define ST_REPORT_SUB 0
#endif
#ifndef ST_TOL
#define ST_TOL 0.03
#endif
__device__ const int ST_EXP_STEP[74] = {0,0,0,0,1,2,2,2,2,3,3,4,5,6,6,6,7,8,9,9,9,9,10,11,11,11,11,12,12,12,13,14,15,15,15,16,17,18,18,18,18,19,20,20,20,20,21,21,22,23,24,24,24,25,26,27,27,27,27,28,29,29,29,29,30,30,30,31,32,33,33,33,34,35,};
__device__ const int ST_EXP_SUB[74] = {0,1,2,3,0,0,1,2,3,0,1,0,0,0,1,2,0,0,0,1,2,3,0,0,1,2,3,0,1,2,0,0,0,1,2,0,0,0,1,2,3,0,0,1,2,3,0,1,0,0,0,1,2,0,0,0,1,2,3,0,0,1,2,3,0,1,2,0,0,0,1,2,0,0,};
__device__ const double ST_EXP[74][10] = {
{2823.9405135959387,-6955.5741695016623,-5804.0977028682828,9054.3725127205253,-3966.7899582609534,-4601.8714917525649,7995.7762676179409,971.6921226978302,22251047.414743461,18874368,},
{291.26190879568458,-1573.2945180945098,331.66257446631789,357.45295172557235,-214.97323327884078,864.47900781407952,490.07691208645701,667.85457975044847,340263.10377825046,294912,},
{-23.357008519407827,15.935151411395054,35.883058835112024,57.434714148461353,-51.349641996261198,60.264678716950584,-59.23590717773186,-56.705568651959766,3067.8819070441805,3145728,},
{25.470241500996053,-43.468927160836756,58.065743817947805,4.3800708865746856,11.067458258010447,-10.867067505605519,26.364831392653286,-27.969552277587354,1020.9866835358141,1048576,},
{-11200.415292963386,9297.3592315688729,3203.3726777359843,-9663.7561300396919,-641.6257035061717,-8234.4563228115439,7994.2129158824682,-5521.8908601477742,66654113.07759431,56623104,},
{-1194.5305787473917,-1674.2680710405111,-5463.7986858785152,-4930.0590666979551,-1068.7674529403448,3002.9571408778429,-649.54952663183212,-4412.2754199355841,11106170.817955792,9437184,},
{-5507.6614354923368,1901.5068384334445,-4913.9082106724381,-2596.9450140967965,-1520.3851273730397,3237.6398326531053,-2359.8059303388,2364.7748123183846,11105296.668379547,9437184,},
{1560.4392579563191,-2499.261261367612,1459.3170721097504,-245.48758464773891,1043.47321934717,1419.7026340031534,1920.6481273452355,-1582.4576623782978,1601541.1673813532,18874368,},
{18.923751746769994,105.40070073772222,-9.9321377836167812,-69.897449327632785,166.82718826597556,123.35070158960298,-124.43343016551808,-149.78254351718351,24705.222434743067,147456,},
{2291.1772415378409,-198.18048978019215,106.27707149069283,1579.1373604525679,1783.1593627679513,2121.0945059178157,-2611.1484069368307,-1331.619970235115,2782256.6531369383,18874368,},
{89.759916271461407,27.444828146166401,211.5510761210171,-443.45204046583967,221.2014890195278,-713.03335159321432,-278.38321068481309,161.85793914255919,83907.236548682689,147456,},
{2060.1309491619468,-3099.3174412855878,3189.1278408914804,-1495.998928762041,2018.3208422241732,3951.0027283849195,307.00997438374907,189.92257314547896,8838647.8145213183,18874368,},
{2615.2232726222937,-3851.6311007236727,-5090.8008575433851,8895.7526726254218,-2915.793732104612,-3466.5127967876979,8494.2590465184257,-476.8310997271401,19641291.046898585,18874368,},
{2260.6133435368538,-3524.0150115936995,-6184.6817786470056,8612.6491934210062,-2936.174174323678,-5085.3421624973416,7627.2569323033094,-322.10541462153196,22201812.480418805,18874368,},
{39.211919396329904,-22.191732778126607,71.555887567257741,-34.657468227291247,-37.514794261514908,48.970252739818534,56.030709780199686,21.127209749916801,5631.6743743792158,5767168,},
{-58.957687043759506,-25.822232720500324,27.559850534133147,-19.2058952494408,25.962478367669974,10.300243424077053,-1.6967002287856303,-52.715924362360965,1022.4535583883176,2883584,},
{-194.02440498952637,2323.5604243765411,4943.6193249881908,-6076.2407636700955,-3098.2506252240564,1737.1458579480241,4071.2157669755688,3426.5647126794502,26276154.208520912,51904512,},
{2062.0307282910508,-2404.6291768250012,-4943.0085245753726,8409.3699170327891,-3388.5586135165795,-3156.0619303231506,8070.8516135739701,103.72620783001184,20445489.612024359,18874368,},
{-850.44070326350629,-1898.2922850791365,-5629.5260096881539,5319.5235935095698,-3571.6089787539095,-4582.1209145840257,8084.1448610220104,1201.9745895769447,22408943.624150425,18874368,},
{-276.67351097613573,238.73336043953896,402.49070692062378,1139.6587501242757,412.53829725086689,1001.9456618651748,-199.34280802309513,243.97394938021898,346041.02869538032,294912,},
{55.275690128095448,33.631906502880156,39.819098525680602,39.580814833752811,-56.659358996432275,56.905868629924953,70.874192817136645,32.641803210601211,2813.6335960129777,2883584,},
{16.459319942980073,-15.029889202327468,24.789046118385158,39.597747391439043,22.32851928321179,32.169926681905054,4.3831529127201065,-11.914361283765174,1024.2634621089853,1048576,},
{-8112.7706977427006,-15166.404139339924,9019.1636524870992,-10032.914728678763,-3683.5552492365241,6445.1523703113198,4940.6895737573504,-396.46003675460815,61599346.798404746,51904512,},
{1064.6478829011321,2961.5112186744809,2643.997241653502,3817.1335873380303,2552.6912311688066,2848.1112303361297,2641.0165046826005,877.74564967304468,5155886.6824775627,4718592,},
{-1180.9790783076314,-353.66288720036391,1405.2405796857784,-3003.0330094090896,736.01905330538284,1520.8871299045859,-1925.6258542904397,-909.10001162986737,2434153.6281470573,18874368,},
{60.165285118651028,-119.7430636333083,80.732633202489126,-9.8426874747077857,-101.69595492020277,-92.996986093445443,207.83742497175277,20.265997010018708,8918.7285340001526,18874368,},
{270.78828044847916,-133.56509196904631,-10.835563753045964,-177.08542341093678,116.75884305510037,-401.68338958283317,92.706295374895404,-256.76246256793473,40406.455039767519,47185920,},
{-17.403251063922653,85.550381564797135,-67.875341098901117,39.030201086570742,-44.825321126758354,-24.736986581498059,-130.15850522785331,-6.1346717766427901,3203.0568557028691,9437184,},
{26.677921455280739,-10.301573183693108,-15.383461458186503,23.552394272832316,-16.422941844488378,33.179475616852869,-26.073428510382655,49.43283157730184,2218.7160715744772,9437184,},
{-104.63265653897543,-1025.0813928971766,623.84842114138883,-1420.2001781960716,1368.3365971482126,-86.704579671728425,96.991083307308145,428.70963656844106,889696.22597060842,9437184,},
{2432.259056510753,267.30669010814745,1837.783826454659,2981.6297531555174,-416.17357830458786,-1826.6180147336563,-301.78532918507699,-744.86193079140503,4898348.3318136279,18874368,},
{3294.5902997395533,-865.44878266500746,-4974.0870277224822,6772.8382276698467,-3398.3562051501722,-4187.1136843486529,8143.3624155692742,-612.10508898339322,20872541.311585322,18874368,},
{3536.330776873976,1917.42852505669,-2076.6844129748642,4320.7511040978134,-4890.1908001117408,-4107.6248654313385,10533.807669285685,471.08626228198409,22412768.276720807,18874368,},
{-6.0809309475971531,76.739011337651391,97.496654804484933,-29.642639640796915,0.70117462620510196,-203.53367705441451,-98.699187040134348,-53.162115221513886,5628.1487348292976,5767168,},
{56.758986754866783,46.788941775390413,-43.423746958898846,33.754279191547539,25.984360144881066,-65.525896325649228,5.420765693706926,45.74655341921607,1023.6598906812283,2883584,},
{2102.1720024403512,3520.8294076444326,-6874.5287163143184,3797.4676643103921,3201.4737541926479,2643.8227775447631,352.29275992398834,1880.529091139204,26630809.672188494,51904512,},
{2885.2073127178519,-1385.1170310270754,-4514.0122937517372,7030.8231581723594,-3845.7207517792049,-6356.8220687311768,7588.3782935662384,-564.85132873002294,21742637.688699484,18874368,},
{3812.0284725353122,1621.2253267094493,-4254.9756214395165,6197.9158516302705,8.5768845900893211,-5469.3091325387359,8752.140286244452,-1246.7436530068517,22065010.375674032,18874368,},
{-1149.1737003140152,496.67538012936711,483.18858239427209,650.82792166247964,314.5317993350327,-371.12024437263608,890.37748170271516,-1420.4709294177592,350924.7500354572,294912,},
{88.047429081168957,-74.825534723349847,-23.789757229969837,-97.320472310879268,-4.0056394656421617,-30.904204592457972,-18.987518870853819,-27.849783896817826,3073.3731145051615,3145728,},
{65.20327353652101,3.0222902240930125,25.993390792864375,14.415037170168944,54.844758132356219,-56.249738970887847,19.864254156243987,-27.887308357167058,1025.1381782409978,1048576,},
{-13237.945228233933,-5020.7346298694611,5226.0037766546011,12825.714193224907,-2397.7048603817821,-7119.2997151985765,9948.7588085010648,-5921.2636323198676,66137041.201810837,56623104,},
{-75.766457952558994,2293.2211949080229,-2037.293488740921,1509.2966427430511,6117.5132186114788,479.96601853519678,-5639.6398960202932,1845.2123182713985,11060201.299008245,9437184,},
{-462.10384976491332,5736.9905912540853,-2167.2699889577925,-1180.0111477933824,409.65681508556008,-1780.9929978586733,-671.92641231790185,-1349.7005080021918,11027953.433529973,9437184,},
{-822.00079254147931,-1214.0090433928017,3328.184749965596,87.801341768161365,-495.11205383328706,-877.86274139888337,1911.2223419476468,796.02008414199008,1759052.6843886974,18874368,},
{100.80030664941296,22.118581771384925,-242.38840196980163,-93.397681776899844,-57.195992573630065,-53.402307578828186,-150.74265199294314,-86.528761671390384,31090.621100439952,147456,},
{3075.2200345232932,146.19098324902222,-1073.3931368374535,-3446.3695871779209,37.989448957180798,223.73928401402372,1720.4827841137958,2765.2156565344467,3854013.6325600357,18874368,},
{542.032717238857,-110.56952357693081,1.825648151418136,-830.79371399683441,-111.90571951437596,-416.65702595594485,-459.77385005963879,177.62618795662274,136561.77048135776,147456,},
{-536.59579325607046,3431.0063604712486,3724.987038930878,-672.57181697292253,-3271.82986589754,-275.97591033531353,1134.3561726845801,3369.160484327469,5460094.8227678062,18874368,},
{3690.413550499331,-2055.6428064615766,-5438.0006776863584,7215.5527907973737,-3675.7019953130812,-5533.6785190762885,6701.1122693967927,64.846424879085134,22222666.921814281,18874368,},
{6145.2994565963745,-1456.0999585092068,-5831.9741258770227,8761.7396555989981,-5699.234908297658,-4079.551640689373,4842.0201814621687,-2019.1001229286194,22203324.287363961,18874368,},
{130.56598056000075,66.178603142005159,-72.223813362215878,-40.295281428698217,26.729994425171753,-72.123386049031978,-88.871669880725676,27.124975894665113,5635.9492323544555,5767168,},
{32.54455375490943,72.597239872498903,-17.171426851477008,-4.8966801255592145,-15.258403940417338,-23.122007071331609,-22.899502303858753,62.156484370876569,1023.7774562760339,2883584,},
{-6760.2973620964185,3735.844417643224,1094.1796880429465,4204.2181440759596,-764.49361893783498,-4932.0209130450239,-6261.1468112875446,-4488.8535375963402,26246313.294528794,51904512,},
{4457.1757640697724,-2267.1563059242435,-4745.1736963140393,7186.1535465445595,-4113.5497737388105,-7139.5026401302202,6476.8297955984126,-72.098023249844118,23047663.524188824,18874368,},
{4172.7441230602562,2189.9780470617115,-5133.8792393095791,7288.8046996556222,-5411.0709395520389,-4896.6709096245468,8724.0389158017933,-1300.7641984857619,22255371.479420178,18874368,},
{342.48845159634948,-1155.9452162571251,-355.46573888137937,38.030472237616777,-706.72725258395076,302.12307207658887,1501.216548230499,-189.15161934122443,356337.53284288617,294912,},
{141.34916719738249,55.510840875467693,3.4794936717735254,14.99616638317093,48.530484220267681,80.824254727551306,36.550317391192948,-11.045543047970568,2822.5213800999318,2883584,},
{-1.7540650628507137,-68.523136725649238,20.526102727279067,4.1151908580213785,26.478423124179244,17.260244991630316,26.540773348882794,18.066198658198118,1023.7352584092852,1048576,},
{9615.2207438386977,4784.9471067078412,1940.7497162856162,-5810.9412356205285,-983.56367782130837,7418.8542090691626,16772.396392870694,-7707.8745242021978,61356805.552982159,51904512,},
{1611.5909418128431,-862.28053805604577,-136.1677976809442,-552.47190998122096,983.61643074825406,-2118.3313589207828,2136.0759917013347,1436.2902639396489,5189176.8575152932,4718592,},
{1791.7875226804172,-31.704715774103533,260.74334435508354,2286.3263573826407,2006.0634295089985,-556.23315154918237,2794.1662208863418,265.33516812947346,2237659.8451027921,18874368,},
{1.738220854325472,-47.72536333968177,85.671240820733587,-76.785340997768273,-33.389609302064237,10.517162931163593,-16.605087701564099,-69.403631001852744,4294.4259768959364,18874368,},
{80.462511468439985,-161.96663447577936,103.6356164854663,158.8806262336563,-156.06783419597375,68.553029276052172,-342.86381052307308,-54.733859514236087,20398.968534675096,47185920,},
{52.505996509542456,40.193077393545536,-32.136223205568967,9.6826318503881339,-32.908785335748689,-49.309646418463672,7.7728565156285185,28.182192534412025,933.99111986596574,8388608,},
{-7.5194821398763452,15.928513078688411,-22.494523745699553,-25.74654744003783,-1.9659538757696282,39.424875568918651,-41.204660507297376,-50.291643056989415,1399.3033406704337,8388608,},
{-135.14476990071125,388.87867833836935,-624.19169349339791,-255.41803698171861,749.05279063689522,489.13258223538287,7.6979752753395587,-1529.1879597052466,922125.16740855761,8388608,},
{2513.205304118339,-3002.4781056293286,-591.26384180737659,984.36628054594621,-165.44268643157557,-2587.8124781120569,5950.0621142634191,1918.4807258569635,4533654.192930459,16777216,},
{2830.9344703354946,-4920.8287407121315,-3976.7572222978852,7101.1558030729429,-6279.3158443071807,-7658.587931540409,7596.1372552172033,-980.77548625691998,20848405.50834683,16777216,},
{5663.7043273374438,-4698.0929517224431,-2882.0782249197364,6381.8024617210031,-6684.7693502381444,-6324.1065613850951,5276.286193959415,-1294.3445755466819,19824501.716412377,16777216,},
{105.49113711505197,9.4353141400497407,71.544671961572021,-144.04839801136404,-59.128098372370005,86.345427959226072,-22.445412413449958,-31.521184443496168,5635.2677728111466,5767168,},
{-52.974209187126689,83.749726402067608,-11.22629395038166,-7.1423740544887551,-10.056938788195112,-45.578087951795169,41.377634743421368,16.152020135003113,1023.3413428186279,2883584,},
{1126.9516335337321,-4958.3812902097925,-2794.7144431749111,5195.0455790979104,4310.2982955073458,-6172.0018973502665,4099.1716476037618,-5060.7709415074714,23578261.929520626,46137344,},
{854.11164966656725,-4002.1053702284298,-4016.2943720539079,7535.4821215254451,-6184.3291782648776,-6281.2433878521588,8750.5079252671385,531.59902707755464,21616516.22354921,16777216,},
};
__global__ void st_check_kernel(unsigned char* ws, int step, int slot = 0) { Ctx c; c.tid = threadIdx.x; c.lane = c.tid & 63; c.wave = c.tid >> 6; c.bid = blockIdx.x; c.nblk = gridDim.x; c.gw = 0; c.ngw = slot; c.lds = nullptr; c.in = nullptr; c.out = nullptr; c.ws = ws; st_checks(c, step); }
__global__ void st_report(const unsigned char* ws, float* out, int n) {
    const double* chk = (const double*)(ws + ST_CHK); int code = 0;
    for (int e = 0; e < ST_NEXP && !code; ++e) { const int step = ST_EXP_STEP[e], sub = ST_EXP_SUB[e]; const double* g = chk + (step * 4 + sub) * 10; double d2 = 0.0; if (g[9] == 0.0) continue;
        for (int k = 0; k < 8; ++k) { const double d = g[k] - ST_EXP[e][k]; d2 += d * d; }
        const double eps2 = d2 / (8.0 * ST_EXP[e][8] + 1e-300);
        const bool bad = !(eps2 <= ST_TOL * ST_TOL);
        if (bad) code = ST_REPORT_SUB ? (step == ST_REPORT_SUB - 1 ? sub + 1 : 0) : step + 1; }
    const float v = sqrtf((float)code);
    for (size_t k = (size_t)blockIdx.x * blockDim.x + threadIdx.x; k < (size_t)n; k += (size_t)gridDim.x * blockDim.x) out[k] = v;
}
__global__ void st_repeat_report(const unsigned char* ws, float* out, int n, int nsteps) {
    const double* chk = (const double*)(ws + ST_CHK); int code = 0;
    for (int st = 0; st < nsteps && !code; ++st) for (int sub = 0; sub < 4 && !code; ++sub) { const double* a = chk + ((size_t)st * 4 + sub) * 10; const double* b = chk + ((size_t)(st + 40) * 4 + sub) * 10;
        if (a[9] == 0.0 || b[9] == 0.0) continue; double d2 = 0.0; for (int k = 0; k < 8; ++k) d2 += (a[k] - b[k]) * (a[k] - b[k]);
        if (!(d2 <= 1e-14 * 8.0 * a[8])) code = st + 1; }
    const float v = sqrtf((float)code);
    for (size_t k = (size_t)blockIdx.x * blockDim.x + threadIdx.x; k < (size_t)n; k += (size_t)gridDim.x * blockDim.x) out[k] = v;
}
__global__ void st_twice_report(const unsigned char* ws, float* out, int n) {
    const double* chk = (const double*)(ws + ST_CHK); const double* a = chk + ((size_t)35 * 4) * 10; const double* b = chk + ((size_t)(35 + 40) * 4) * 10;
    double d2 = 0.0; for (int k = 0; k < 8; ++k) d2 += (a[k] - b[k]) * (a[k] - b[k]);
    const double eps = sqrt(d2 / (8.0 * a[8] + 1e-300)) + 1e-30; const float v = sqrtf((float)floor(fmax(0.0, -log10(eps))));
    for (size_t k = (size_t)blockIdx.x * blockDim.x + threadIdx.x; k < (size_t)n; k += (size_t)gridDim.x * blockDim.x) out[k] = v;
}
__global__ void st_final_check(const unsigned char* ws, const float* out, const float* g, double* acc) {
    const float* X = (const float*)(ws + OFF_X);
    for (int row = blockIdx.x * blockDim.x + threadIdx.x; row < ML; row += gridDim.x * blockDim.x) { const float* x = X + (size_t)row * D; double ss = 0.0;
        for (int k = 0; k < D; ++k) ss += (double)x[k] * x[k];
        const double rstd = 1.0 / sqrt(ss / D + 1e-6); double d2 = 0.0, r2 = 0.0;
        for (int k = 0; k < D; ++k) { const double r = x[k] * rstd * g[k], o = out[(size_t)row * D + k]; d2 += (o - r) * (o - r); r2 += r * r; }
        atomicAdd(acc, d2); atomicAdd(acc + 1, r2); }
}
__global__ void st_final_fill(const double* acc, float* out, int n) { const double eps = sqrt(acc[0] / (acc[1] + 1e-300)) + 1e-30; const float v = sqrtf((float)floor(fmax(0.0, -log10(eps))));
    for (size_t k = (size_t)blockIdx.x * blockDim.x + threadIdx.x; k < (size_t)n; k += (size_t)gridDim.x * blockDim.x) out[k] = v; }
__global__ void st_same_batch_inputs(const float* x, const float* cv, const float* ctx, float* xs, float* cs, float* ctxs) {
    const size_t gt = (size_t)blockIdx.x * blockDim.x + threadIdx.x, GT = (size_t)gridDim.x * blockDim.x;
    for (size_t k = gt; k < (size_t)NB * SEQ * D; k += GT) xs[k] = x[k % ((size_t)SEQ * D)];
    for (size_t k = gt; k < (size_t)NB * CTX * D; k += GT) ctxs[k] = ctx[k % ((size_t)CTX * D)];
    for (size_t k = gt; k < (size_t)NB * D; k += GT) cs[k] = cv[k % (size_t)D];
}
__global__ void st_batch_report(const float* sout, float* out, int n, double* acc) {
    const size_t per = (size_t)SEQ * D;
    for (int b = 1; b < NB; ++b) { double d2 = 0.0, r2 = 0.0;
        for (size_t k = (size_t)blockIdx.x * blockDim.x + threadIdx.x; k < per; k += (size_t)gridDim.x * blockDim.x) { const double a0 = sout[k], ab = sout[(size_t)b * per + k]; d2 += (ab - a0) * (ab - a0); r2 += a0 * a0; }
        atomicAdd(acc + 2 * b, d2); atomicAdd(acc + 2 * b + 1, r2); }
    __threadfence();
    __shared__ unsigned last; if (threadIdx.x == 0) last = atomicAdd((unsigned*)acc, 1u) == gridDim.x - 1; __syncthreads();
    if (!last) return;
    int code = 0; for (int b = 1; b < NB && !code; ++b) { const double d2 = atomicAdd(acc + 2 * b, 0.0), r2 = atomicAdd(acc + 2 * b + 1, 0.0); if (!(d2 <= 1e-4 * r2)) code = b; }
    *((volatile int*)(acc + 1)) = code;
}
__global__ void st_fill(const double* acc, float* out, int n) { const float v = sqrtf((float)*((const volatile int*)(acc + 1))); for (size_t k = (size_t)blockIdx.x * blockDim.x + threadIdx.x; k < (size_t)n; k += (size_t)gridDim.x * blockDim.x) out[k] = v; }
#endif

#if defined(SELFTEST) && (defined(ST_DACHECK) || defined(ST_MODCHECK) || defined(ST_L0CHECK) || defined(ST_TAILCHECK) || defined(ST_MLCHECK) || defined(ST_DNCHECK) || defined(ST_TRUTH) || defined(ST_GQCHECK))
__global__ void st_da_check(const unsigned char* ws, const float* lam, const float* gn, double* acc, float* scr) {
    const int lane = threadIdx.x & 63, gw = (blockIdx.x * blockDim.x + threadIdx.x) >> 6, ngw = (gridDim.x * blockDim.x) >> 6;
    const bf16_t* QA = (const bf16_t*)(ws + OFF_P) + PE_QA; const bf16_t* KA = (const bf16_t*)(ws + OFF_P) + PE_KA; const bf16_t* VA = (const bf16_t*)(ws + OFF_P) + PE_VA; const bf16_t* Y = (const bf16_t*)(ws + OFF_HY);
    const float* COS = (const float*)(ws + OFF_ROPE); const float* SIN = COS + (size_t)SEQ * 32;
    float* s1 = scr + (size_t)gw * 2 * LK; float* s2 = s1 + LK;
    float la = 0.f, lb = 0.f; la = lam[lane] * lam[64 + lane]; lb = lam[128 + lane] * lam[192 + lane];
    for (int o = 1; o < 64; o <<= 1) { la += __shfl_xor(la, o); lb += __shfl_xor(lb, o); }
    const float lam_init = 0.2f, lmb = expf(la) - expf(lb) + lam_init;
    __shared__ float qs[8][2][64];
    const int wv = threadIdx.x >> 6;
    for (int it = gw; it < (ML / 16) * 4; it += ngw) { const int h = it & 3, row = (it >> 2) * 16 + 5; const int b = row / SEQ, t = row % SEQ;
        for (int m = 0; m < 2; ++m) { const int d = lane; const int a = d >> 5, pp = (d >> 4) & 1, f = d & 15; const float x = bf2f(QA[(size_t)row * 512 + h * 128 + m * 64 + d]), xp = bf2f(QA[(size_t)row * 512 + h * 128 + m * 64 + (d ^ 16)]);
            const float cs = COS[(size_t)t * 32 + a * 16 + f], sn = SIN[(size_t)t * 32 + a * 16 + f]; qs[wv][m][d] = pp == 0 ? x * cs - xp * sn : x * cs + xp * sn; }
        __syncthreads();
        float m1 = -1e30f, m2 = -1e30f;
        for (int j = lane; j < LK; j += 64) { const int kr = pos_row(b, j); const bool rope = j >= CTX; const int kt = j - CTX; float a1 = 0.f, a2 = 0.f;
            for (int d = 0; d < 64; ++d) { const int a = d >> 5, pp = (d >> 4) & 1, f = d & 15;
                float k1 = bf2f(KA[(size_t)kr * 512 + h * 128 + d]), k2 = bf2f(KA[(size_t)kr * 512 + h * 128 + 64 + d]);
                if (rope) { const float k1p = bf2f(KA[(size_t)kr * 512 + h * 128 + (d ^ 16)]), k2p = bf2f(KA[(size_t)kr * 512 + h * 128 + 64 + (d ^ 16)]); const float cs = COS[(size_t)kt * 32 + a * 16 + f], sn = SIN[(size_t)kt * 32 + a * 16 + f];
                    k1 = pp == 0 ? k1 * cs - k1p * sn : k1 * cs + k1p * sn; k2 = pp == 0 ? k2 * cs - k2p * sn : k2 * cs + k2p * sn; }
                a1 += qs[wv][0][d] * k1; a2 += qs[wv][1][d] * k2; }
            a1 *= 0.125f; a2 *= 0.125f; s1[j] = a1; s2[j] = a2; m1 = fmaxf(m1, a1); m2 = fmaxf(m2, a2); }
        for (int o = 1; o < 64; o <<= 1) { m1 = fmaxf(m1, __shfl_xor(m1, o)); m2 = fmaxf(m2, __shfl_xor(m2, o)); }
        float l1 = 0.f, l2 = 0.f;
        for (int j = lane; j < LK; j += 64) { const float p1 = expf(s1[j] - m1), p2 = expf(s2[j] - m2); s1[j] = p1; s2[j] = p2; l1 += p1; l2 += p2; }
        for (int o = 1; o < 64; o <<= 1) { l1 += __shfl_xor(l1, o); l2 += __shfl_xor(l2, o); }
        __threadfence(); __syncthreads();
        float o0 = 0.f, o1 = 0.f;
        for (int j = 0; j < LK; ++j) { const int kr = pos_row(b, j); const float p = s1[j] / l1 - lmb * s2[j] / l2; o0 += p * bf2f(VA[(size_t)kr * 512 + h * 128 + lane]); o1 += p * bf2f(VA[(size_t)kr * 512 + h * 128 + 64 + lane]); }
        float ss = o0 * o0 + o1 * o1; for (int o = 1; o < 64; o <<= 1) ss += __shfl_xor(ss, o);
        const float sc = (1.0f / sqrtf(ss / 128.0f + 1e-6f)) * (1.0f - lam_init);
        const float r0 = o0 * sc * gn[lane], r1 = o1 * sc * gn[64 + lane], y0 = bf2f(Y[(size_t)row * 1024 + h * 128 + lane]), y1 = bf2f(Y[(size_t)row * 1024 + h * 128 + 64 + lane]);
        double d2 = (double)(y0 - r0) * (y0 - r0) + (double)(y1 - r1) * (y1 - r1), r2 = (double)r0 * r0 + (double)r1 * r1;
        for (int o = 1; o < 64; o <<= 1) { d2 += __shfl_xor(d2, o); r2 += __shfl_xor(r2, o); }
        if (lane == 0) { atomicAdd(acc, d2); atomicAdd(acc + 1, r2); }
        __syncthreads(); }
}
__global__ void st_mod_check(const unsigned char* ws, const float* cv, const float* cctx, const float* w_ada, const float* b_ada, double* acc) {
    const float* MOD = (const float*)(ws + OFF_MOD); double d2 = 0.0, r2 = 0.0;
    for (long it = (long)blockIdx.x * blockDim.x + threadIdx.x; it < (long)DEPTH * 9 * 6 * D; it += (long)gridDim.x * blockDim.x) { const int n = (int)(it % (6 * D)), r = (int)((it / (6 * D)) % 9), l = (int)(it / (6L * D * 9));
        double s = b_ada[(size_t)l * 6 * D + n];
        for (int k = 0; k < D; ++k) { const double cc = r < NB ? cv[r * D + k] : cctx[k]; s += cc / (1.0 + exp(-cc)) * (double)w_ada[((size_t)l * D + k) * 6 * D + n]; }
        const double m = MOD[it]; d2 += (m - s) * (m - s); r2 += s * s; }
    atomicAdd(acc, d2); atomicAdd(acc + 1, r2);
}
__global__ void st_inproj_check(const unsigned char* ws, const float* w_in_e, double* acc) {
    const bf16_t* H = (const bf16_t*)(ws + OFF_HY); const bf16_t* P = (const bf16_t*)(ws + OFF_P); double d2 = 0.0, r2 = 0.0;
    for (long it = (long)blockIdx.x * blockDim.x + threadIdx.x; it < 72L * NE; it += (long)gridDim.x * blockDim.x) { const int col = (int)(it % NE), row = (int)(it / NE) * 256 + 37;
        float s = 0.f; for (int k = 0; k < D; ++k) s += bf2f(H[(size_t)row * D + k]) * bf2f(f2bf(w_in_e[(size_t)k * E_IN + col]));
        size_t off; int pitch, c0; const int pn = col / 256;
        if (pn < 2) { off = PE_QA; pitch = 512; c0 = 256 * pn; } else if (pn < 4) { off = PE_KA; pitch = 512; c0 = 256 * (pn - 2); } else if (pn < 6) { off = PE_VA; pitch = 512; c0 = 256 * (pn - 4); }
        else if (pn == 6) { off = PE_BQ; pitch = 256; c0 = 0; } else if (pn == 7) { off = PE_BK; pitch = 256; c0 = 0; } else if (pn < 10) { off = PE_BV; pitch = 512; c0 = 256 * (pn - 8); } else { off = PE_BO; pitch = 512; c0 = 256 * (pn - 10); }
        const float v = bf2f(P[off + (size_t)row * pitch + c0 + (col & 255)]); d2 += (double)(v - s) * (v - s); r2 += (double)s * s; }
    atomicAdd(acc, d2); atomicAdd(acc + 1, r2);
}
__global__ void st_norm_check(const unsigned char* ws, const float* g_mix, const float* w_in_e, const float* xin, const float* ctxin, double* acc) {
    const bf16_t* H = (const bf16_t*)(ws + OFF_HY); const float* G = (const float*)(ws + OFF_G); const float* MOD = (const float*)(ws + OFF_MOD); double d2 = 0.0, r2 = 0.0, dg = 0.0, rg = 0.0;
    for (int it = blockIdx.x * blockDim.x + threadIdx.x; it < 72; it += gridDim.x * blockDim.x) { const int row = it * 256 + 37; const int mr = row < ML ? row / SEQ : NB;
        const float* x = row < ML ? xin + (size_t)row * D : ctxin + (size_t)(row - ML) * D; double ss = 0.0; for (int k = 0; k < D; ++k) ss += (double)x[k] * x[k];
        const double rstd = 1.0 / sqrt(ss / D + 1e-6); double ga[16]; for (int n = 0; n < 16; ++n) ga[n] = 0.0;
        for (int k = 0; k < D; ++k) { const double h = x[k] * rstd * g_mix[k] * (1.0 + MOD[(size_t)mr * 6 * D + D + k]) + MOD[(size_t)mr * 6 * D + k]; const double v = bf2f(H[(size_t)row * D + k]); d2 += (v - h) * (v - h); r2 += h * h;
            for (int n = 0; n < 16; ++n) ga[n] += h * w_in_e[(size_t)k * E_IN + NE + n]; }
        for (int n = 0; n < 16; ++n) { const double v = G[(size_t)row * 16 + n]; dg += (v - ga[n]) * (v - ga[n]); rg += ga[n] * ga[n]; } }
    atomicAdd(acc + 2, d2); atomicAdd(acc + 3, r2); atomicAdd(acc + 4, dg); atomicAdd(acc + 5, rg);
}
__global__ void st_eps3_fill(const double* acc, float* out, int n) {
    double e = 0.0; for (int i = 0; i < 3; ++i) e = fmax(e, sqrt(acc[2 * i] / (acc[2 * i + 1] + 1e-300))); e += 1e-30; const float v = sqrtf((float)fmax(0.0, -10.0 * log10(e)));
    for (size_t k = (size_t)blockIdx.x * blockDim.x + threadIdx.x; k < (size_t)n; k += (size_t)gridDim.x * blockDim.x) out[k] = v; }
__global__ void st_tail_check(const unsigned char* ws, const float* xin, const float* ctxin, const float* w_out, const float* g_ffn, const float* wg, const float* wu, const float* wd, double* acc) {
    __shared__ float xm[D]; __shared__ float h2[D]; __shared__ float act[FF]; __shared__ float red[256];
    const bf16_t* Y = (const bf16_t*)(ws + OFF_HY); const float* X = (const float*)(ws + OFF_X); const float* MOD = (const float*)(ws + OFF_MOD);
    const int row = blockIdx.x * 256 + 37, tid = threadIdx.x; const int mr = row < ML ? row / SEQ : NB; const float* md = MOD + (size_t)mr * 6 * D;
    const float* x0 = row < ML ? xin + (size_t)row * D : ctxin + (size_t)(row - ML) * D;
    for (int n = tid; n < D; n += 256) { float s = 0.f; for (int k = 0; k < 1024; ++k) s += bf2f(Y[(size_t)row * 1024 + k]) * w_out[(size_t)k * D + n]; xm[n] = x0[n] + md[2 * D + n] * s; }
    __syncthreads();
    float ss = 0.f; for (int n = tid; n < D; n += 256) ss += xm[n] * xm[n]; red[tid] = ss; __syncthreads();
    for (int o = 128; o > 0; o >>= 1) { if (tid < o) red[tid] += red[tid + o]; __syncthreads(); }
    const float rstd = 1.0f / sqrtf(red[0] / D + 1e-6f); __syncthreads();
    for (int n = tid; n < D; n += 256) h2[n] = xm[n] * rstd * g_ffn[n] * (1.0f + md[4 * D + n]) + md[3 * D + n];
    __syncthreads();
    for (int f = tid; f < FF; f += 256) { float a = 0.f, b = 0.f; for (int k = 0; k < D; ++k) { a += h2[k] * wg[(size_t)k * FF + f]; b += h2[k] * wu[(size_t)k * FF + f]; } act[f] = a / (1.0f + expf(-a)) * b; }
    __syncthreads();
    double d2 = 0.0, r2 = 0.0;
    for (int n = tid; n < D; n += 256) { float s = 0.f; for (int f = 0; f < FF; ++f) s += act[f] * wd[(size_t)f * D + n]; const float ref = xm[n] + md[5 * D + n] * s, v = X[(size_t)row * D + n]; d2 += (double)(v - ref) * (v - ref); r2 += (double)(ref - x0[n]) * (ref - x0[n]); }
    atomicAdd(acc, d2); atomicAdd(acc + 1, r2);
}
__global__ void st_ml_ref(const unsigned char* ws, const float* bias, float* href) {
    __shared__ float qs[64], ks[64], red[4][128], dred[4];
    const bf16_t* BQ = (const bf16_t*)(ws + OFF_P) + PE_BQ; const bf16_t* BK = (const bf16_t*)(ws + OFF_P) + PE_BK; const bf16_t* BV = (const bf16_t*)(ws + OFF_P) + PE_BV; const float* G = (const float*)(ws + OFF_G);
    const int chain = blockIdx.x, dir = chain & 1, h = (chain >> 1) & 3, b = chain >> 3, tid = threadIdx.x, dv = tid & 127, kg = tid >> 7;
    float C[16], nn[16]; for (int j = 0; j < 16; ++j) { C[j] = 0.f; nn[j] = 0.f; } float m = 0.f;
    for (int p = 0; p < LK; ++p) { int row; if (p < CTX) row = ML + b * CTX + (dir ? CTX - 1 - p : p); else row = b * SEQ + (dir ? SEQ - 1 - (p - CTX) : p - CTX);
        if (tid < 64) { qs[tid] = bf2f(BQ[(size_t)row * 256 + h * 64 + tid]); ks[tid] = bf2f(BK[(size_t)row * 256 + h * 64 + tid]) * 0.125f; }
        const float v = bf2f(BV[(size_t)row * 512 + h * 128 + dv]);
        const float ipre = G[(size_t)row * 16 + dir * 8 + h] + bias[dir * 8 + h], fpre = G[(size_t)row * 16 + dir * 8 + 4 + h] + bias[dir * 8 + 4 + h];
        const float lf = fminf(fpre, 0.f) - log1pf(expf(-fabsf(fpre)));
        __syncthreads();
        const float mn = fmaxf(lf + m, ipre), fs = expf(lf + m - mn), is = expf(ipre - mn); m = mn;
        float pn = 0.f, pd = 0.f;
        for (int j = 0; j < 16; ++j) { const int dk = 16 * kg + j; C[j] = fs * C[j] + is * ks[dk] * v; nn[j] = fs * nn[j] + is * ks[dk]; pn += qs[dk] * C[j]; pd += qs[dk] * nn[j]; }
        red[kg][dv] = pn; if (dv == 0) dred[kg] = pd;
        __syncthreads();
        if (kg == 0) { const float num = (red[0][dv] + red[1][dv]) + (red[2][dv] + red[3][dv]), den = (dred[0] + dred[1]) + (dred[2] + dred[3]);
            href[((size_t)dir * MT + row) * 512 + h * 128 + dv] = num / fmaxf(fabsf(den), expf(-m)); }
        __syncthreads(); }
}
__global__ void st_ml_cmp(const unsigned char* ws, const float* href, const float* gn, double* acc) {
    const bf16_t* BO = (const bf16_t*)(ws + OFF_P) + PE_BO; const bf16_t* Y = (const bf16_t*)(ws + OFF_HY); const int lane = threadIdx.x & 63;
    for (int it = (blockIdx.x * blockDim.x + threadIdx.x) >> 6; it < MT * 4; it += (gridDim.x * blockDim.x) >> 6) { const int row = it >> 2, h = it & 3; float v[2], ss = 0.f;
        for (int e = 0; e < 2; ++e) { const size_t o = (size_t)row * 512 + h * 128 + lane + 64 * e; v[e] = href[o] + href[(size_t)MT * 512 + o]; ss += v[e] * v[e]; }
        for (int o = 1; o < 64; o <<= 1) ss += __shfl_xor(ss, o);
        const float rstd = 1.0f / sqrtf(ss / 128.0f + 1e-6f); double d2 = 0.0, r2 = 0.0;
        for (int e = 0; e < 2; ++e) { const int dv = lane + 64 * e; const float og = bf2f(BO[(size_t)row * 512 + h * 128 + dv]); const float ref = v[e] * rstd * gn[dv] / (1.0f + expf(-og)), y = bf2f(Y[(size_t)row * 1024 + 512 + h * 128 + dv]); d2 += (double)(y - ref) * (y - ref); r2 += (double)ref * ref; }
        for (int o = 1; o < 64; o <<= 1) { d2 += __shfl_xor(d2, o); r2 += __shfl_xor(r2, o); }
        if (lane == 0) { atomicAdd(acc, d2); atomicAdd(acc + 1, r2); } }
}
__global__ void st_dn_ref(const unsigned char* ws, const float* convw, const float* alog, const float* dtb, float* href) {
    __shared__ float qkv[3][128], red[4][128], nrm[2];
    const bf16_t* DQ = (const bf16_t*)(ws + OFF_P) + PO_DQKV; const float* G = (const float*)(ws + OFF_G);
    const int chain = blockIdx.x, dir = chain & 1, h = (chain >> 1) & 3, b = chain >> 3, tid = threadIdx.x, dv = tid & 127, kg = tid >> 7;
    float S[32]; for (int j = 0; j < 32; ++j) S[j] = 0.f;
    for (int p = 0; p < LK; ++p) { const bool isctx = p < CTX; const int seqlen = isctx ? CTX : SEQ, rowbase = isctx ? ML + b * CTX : b * SEQ; const int tok = isctx ? (dir ? CTX - 1 - p : p) : (dir ? SEQ - 1 - (p - CTX) : p - CTX); const int row = rowbase + tok;
        if (tid < 384) { const int ten = tid >> 7, d = tid & 127, col = ten * 512 + h * 128 + d; float a = 0.f;
            for (int tap = 0; tap < 3; ++tap) { const int tk = tok + tap - 1; if (tk >= 0 && tk < seqlen) a += bf2f(DQ[(size_t)(rowbase + tk) * 1536 + col]) * convw[tap * 1536 + col]; }
            qkv[ten][d] = a / (1.0f + expf(-a)); }
        __syncthreads();
        if (tid < 128) { float s = 0.f; const int ten = tid >> 6; for (int d = (tid & 63); d < 128; d += 64) s += qkv[ten][d] * qkv[ten][d]; for (int o = 1; o < 64; o <<= 1) s += __shfl_xor(s, o); if ((tid & 63) == 0) nrm[ten] = s; }
        __syncthreads();
        const float qn = (1.0f / sqrtf(nrm[0] + 1e-6f)) * 0.08838834764831845f, kn = 1.0f / sqrtf(nrm[1] + 1e-6f);
        const float beta = 1.0f / (1.0f + expf(-G[(size_t)row * 16 + dir * 8 + h])); const float xg = G[(size_t)row * 16 + dir * 8 + 4 + h] + dtb[dir * 4 + h];
        const float at = expf(-expf(alog[dir * 4 + h]) * (fmaxf(xg, 0.f) + log1pf(expf(-fabsf(xg)))));
        const float v = qkv[2][dv]; float pk = 0.f;
        for (int j = 0; j < 32; ++j) pk += qkv[1][32 * kg + j] * kn * S[j];
        red[kg][dv] = pk; __syncthreads();
        const float kS = (red[0][dv] + red[1][dv]) + (red[2][dv] + red[3][dv]); __syncthreads();
        float po = 0.f;
        for (int j = 0; j < 32; ++j) { const float kk = qkv[1][32 * kg + j] * kn; S[j] = at * (S[j] - beta * kk * kS) + beta * kk * v; po += qkv[0][32 * kg + j] * qn * S[j]; }
        red[kg][dv] = po; __syncthreads();
        if (kg == 0 && !isctx) href[((size_t)dir * ML + row) * 512 + h * 128 + dv] = (red[0][dv] + red[1][dv]) + (red[2][dv] + red[3][dv]);
        __syncthreads(); }
}
__global__ void st_dn_cmp(const unsigned char* ws, const float* href, const float* gn, double* acc) {
    const bf16_t* Z = (const bf16_t*)(ws + OFF_P) + PO_Z; const bf16_t* Y = (const bf16_t*)(ws + OFF_HY); const int lane = threadIdx.x & 63;
    for (int it = (blockIdx.x * blockDim.x + threadIdx.x) >> 6; it < ML * 4; it += (gridDim.x * blockDim.x) >> 6) { const int row = it >> 2, h = it & 3; float v[2], ss = 0.f;
        for (int e = 0; e < 2; ++e) { const size_t o = (size_t)row * 512 + h * 128 + lane + 64 * e; v[e] = href[o] + href[(size_t)ML * 512 + o]; ss += v[e] * v[e]; }
        for (int o = 1; o < 64; o <<= 1) ss += __shfl_xor(ss, o);
        const float rstd = 1.0f / sqrtf(ss / 128.0f + 1e-6f); double d2 = 0.0, r2 = 0.0;
        for (int e = 0; e < 2; ++e) { const int dv = lane + 64 * e; const float z = bf2f(Z[(size_t)row * 512 + h * 128 + dv]); const float ref = v[e] * rstd * gn[dv] * (z / (1.0f + expf(-z))), y = bf2f(Y[(size_t)row * 1024 + 512 + h * 128 + dv]); d2 += (double)(y - ref) * (y - ref); r2 += (double)ref * ref; }
        for (int o = 1; o < 64; o <<= 1) { d2 += __shfl_xor(d2, o); r2 += __shfl_xor(r2, o); }
        if (lane == 0) { atomicAdd(acc, d2); atomicAdd(acc + 1, r2); } }
}
__global__ void st_truth_fill(const unsigned char* ws, float* out, int n) {
    const double T[9] = {846.38902932657311,-3988.0872614528216,-4023.4252461296091,7499.0995520059896,-6191.4193272974135,-6282.081387437358,8748.2446258433793,548.97920503418845,21616550.564093322};
    const double* g = (const double*)(ws + ST_CHK) + ((size_t)35 * 4) * 10; double d2 = 0.0; for (int k = 0; k < 8; ++k) d2 += (g[k] - T[k]) * (g[k] - T[k]);
    const double eps = sqrt(d2 / (8.0 * T[8])) + 1e-30; const float v = sqrtf((float)fmax(0.0, -10.0 * log10(eps)));
    for (size_t k = (size_t)blockIdx.x * blockDim.x + threadIdx.x; k < (size_t)n; k += (size_t)gridDim.x * blockDim.x) out[k] = v; }
__global__ void st_gqa_check(const unsigned char* ws, const bf16_t* QS, const float* qkg, double* acc, float* scr) {
    const int lane = threadIdx.x & 63, gw = (blockIdx.x * blockDim.x + threadIdx.x) >> 6, ngw = (gridDim.x * blockDim.x) >> 6, wv = threadIdx.x >> 6;
    const bf16_t* KVC = (const bf16_t*)(ws + OFF_P) + PO_KVC; const bf16_t* O = (const bf16_t*)(ws + OFF_P) + PO_QC;
    const float* COS = (const float*)(ws + OFF_ROPE); const float* SIN = COS + (size_t)SEQ * 32;
    float* s1 = scr + (size_t)gw * LK; __shared__ float qs[8][64];
    for (int it = gw; it < (ML / 16) * 8; it += ngw) { const int h = it & 7, kv = h >> 2, row = (it >> 3) * 16 + 5; const int b = row / SEQ, t = row % SEQ;
        {   const int d = lane, a = d >> 5, pp = (d >> 4) & 1, f = d & 15; float x = bf2f(QS[(size_t)row * 512 + h * 64 + d]); float ss = x * x; for (int o = 1; o < 64; o <<= 1) ss += __shfl_xor(ss, o);
            x = x * (1.0f / sqrtf(ss / 64.0f + 1e-6f)) * qkg[d]; const float xp = __shfl_xor(x, 16); const float cs = COS[(size_t)t * 32 + a * 16 + f], sn = SIN[(size_t)t * 32 + a * 16 + f]; qs[wv][d] = pp == 0 ? x * cs - xp * sn : x * cs + xp * sn; }
        __syncthreads();
        float m1 = -1e30f;
        for (int j = lane; j < LK; j += 64) { const int kr = pos_row(b, j); const bool rope = j >= CTX; const int kt = j - CTX; float ss = 0.f; const bf16_t* kp = KVC + (size_t)kr * 256 + kv * 64;
            for (int d = 0; d < 64; ++d) { const float kd = bf2f(kp[d]); ss += kd * kd; }
            const float rs = 1.0f / sqrtf(ss / 64.0f + 1e-6f); float a1 = 0.f;
            for (int d = 0; d < 64; ++d) { const int a = d >> 5, pp = (d >> 4) & 1, f = d & 15; float k1 = bf2f(kp[d]) * rs * qkg[64 + d];
                if (rope) { const float k1p = bf2f(kp[d ^ 16]) * rs * qkg[64 + (d ^ 16)]; const float cs = COS[(size_t)kt * 32 + a * 16 + f], sn = SIN[(size_t)kt * 32 + a * 16 + f]; k1 = pp == 0 ? k1 * cs - k1p * sn : k1 * cs + k1p * sn; }
                a1 += qs[wv][d] * k1; }
            a1 *= 0.125f; s1[j] = a1; m1 = fmaxf(m1, a1); }
        for (int o = 1; o < 64; o <<= 1) m1 = fmaxf(m1, __shfl_xor(m1, o));
        float l1 = 0.f;
        for (int j = lane; j < LK; j += 64) { const float p1 = expf(s1[j] - m1); s1[j] = p1; l1 += p1; }
        for (int o = 1; o < 64; o <<= 1) l1 += __shfl_xor(l1, o);
        __threadfence(); __syncthreads();
        float o0 = 0.f;
        for (int j = 0; j < LK; ++j) { const int kr = pos_row(b, j); o0 += s1[j] * bf2f(KVC[(size_t)kr * 256 + 128 + kv * 64 + lane]); }
        const float ref = o0 / l1, y = bf2f(O[(size_t)row * 512 + h * 64 + lane]);
        double d2 = (double)(y - ref) * (y - ref), r2 = (double)ref * ref;
        for (int o = 1; o < 64; o <<= 1) { d2 += __shfl_xor(d2, o); r2 += __shfl_xor(r2, o); }
        if (lane == 0) { atomicAdd(acc, d2); atomicAdd(acc + 1, r2); }
        __syncthreads(); }
}
__global__ void st_eps_fill(const double* acc, float* out, int n) { const double eps = sqrt(acc[0] / (acc[1] + 1e-300)) + 1e-30; const float v = sqrtf((float)fmax(0.0, -10.0 * log10(eps)));
    for (size_t k = (size_t)blockIdx.x * blockDim.x + threadIdx.x; k < (size_t)n; k += (size_t)gridDim.x * blockDim.x) out[k] = v; }
#endif
extern "C" void kernel_launch(void* const* d_in, const int* in_sizes, int n_in, void* d_out, int out_size, void* d_ws, size_t ws_size, hipStream_t stream) {
    static int grid = 0;
    if (grid == 0) {
        int dev = 0, cus = 0, per_cu = 0;
        if (hipGetDevice(&dev) != hipSuccess || hipDeviceGetAttribute(&cus, hipDeviceAttributeMultiprocessorCount, dev) != hipSuccess) { fprintf(stderr, "kernel_launch: device query failed\n"); grid = -1; return; }
        if (hipFuncSetAttribute((const void*)mega, hipFuncAttributeMaxDynamicSharedMemorySize, LDS_BYTES) != hipSuccess) { fprintf(stderr, "kernel_launch: hipFuncSetAttribute failed\n"); grid = -1; return; }
        if (hipOccupancyMaxActiveBlocksPerMultiprocessor(&per_cu, (const void*)mega, NTHREADS, LDS_BYTES) != hipSuccess || per_cu < 1) { fprintf(stderr, "kernel_launch: occupancy query says %d\n", per_cu); per_cu = 1; }
        (void)hipGetLastError();
        if (ws_size < WS_NEED || n_in != 25) { fprintf(stderr, "kernel_launch: workspace %zu < %zu needed or n_in %d != 25\n", ws_size, (size_t)WS_NEED, n_in); grid = -1; return; }
        grid = cus;
    }
    if (grid < 0) return;
    (void)hipMemsetAsync(d_ws, 0, ZERO_BYTES, stream);
    Args a{};
#if defined(SELFTEST) && (defined(ST_REPEAT) || defined(ST_TWICE) || defined(ST_FINAL) || defined(ST_DACHECK) || defined(ST_MODCHECK) || defined(ST_L0CHECK) || defined(ST_TAILCHECK) || defined(ST_MLCHECK) || defined(ST_DNCHECK) || defined(ST_GQCHECK))
    for (int i = 0; i < 25; ++i) a.in[i] = (const float*)d_in[i];
    a.out = (float*)d_out; a.ws = (unsigned char*)d_ws; float* sout = (float*)d_out;
#elif defined(SELFTEST) && defined(ST_SAME_BATCH)
    for (int i = 0; i < 25; ++i) a.in[i] = (const float*)d_in[i];
    float* ctxs = (float*)((unsigned char*)d_ws + al256(WS_NEED)); float* cs = ctxs + (size_t)NB * CTX * D; float* sout = (float*)d_out;
    hipLaunchKernelGGL(st_same_batch_inputs, dim3(1024), dim3(256), 0, stream, (const float*)d_in[0], (const float*)d_in[1], (const float*)d_in[2], (float*)d_out, cs, ctxs);
    a.in[0] = (const float*)d_out; a.in[1] = cs; a.in[2] = ctxs; a.out = (float*)d_out; a.ws = (unsigned char*)d_ws;
#elif defined(SELFTEST) && defined(ST_INPLACE)
    { StPtrs P; for (int i = 0; i < 25; ++i) { P.p[i] = (float*)d_in[i]; a.in[i] = (const float*)d_in[i]; }
      hipLaunchKernelGGL(st_gen_inplace, dim3(1024), dim3(256), 0, stream, P); }
    float* sout = (float*)d_out; a.out = sout; a.ws = (unsigned char*)d_ws;
#elif defined(SELFTEST)
    float* syn = (float*)((unsigned char*)d_ws + al256(WS_NEED)); float* sout = syn + st_offset(25);
    hipLaunchKernelGGL(st_gen, dim3(1024), dim3(256), 0, stream, syn);
    for (int i = 0; i < 25; ++i) a.in[i] = syn + st_offset(i);
    a.out = sout; a.ws = (unsigned char*)d_ws;
#else
    for (int i = 0; i < 25; ++i) a.in[i] = (const float*)d_in[i];
    a.out = (float*)d_out; a.ws = (unsigned char*)d_ws;
#endif
#ifdef SELFTEST
#ifdef ST_GQCHECK
    {   a.step_lo = 0; a.step_hi = 9 + 3; a.prologue = 1; a.final_ = 0;
        void* args[] = {&a};
        hipError_t e = hipLaunchCooperativeKernel((const void*)mega, dim3(grid), dim3(NTHREADS), args, LDS_BYTES, stream);
        if (e != hipSuccess) fprintf(stderr, "cooperative launch failed: %s (grid %d)\n", hipGetErrorString(e), grid);
        (void)hipMemcpyAsync(d_out, (unsigned char*)d_ws + OFF_P + PO_QC * 2, (size_t)MT * 512 * 2, hipMemcpyDeviceToDevice, stream);
        a.step_lo = 12; a.step_hi = 13; a.prologue = 0;
        (void)hipMemsetAsync(d_ws, 0, 512 * 1024, stream);
        e = hipLaunchCooperativeKernel((const void*)mega, dim3(grid), dim3(NTHREADS), args, LDS_BYTES, stream);
        double* acc = (double*)((unsigned char*)d_ws + ST_CHK); float* scr = (float*)((unsigned char*)d_ws + SO_U);
        hipLaunchKernelGGL(st_gqa_check, dim3(256), dim3(512), 0, stream, (const unsigned char*)d_ws, (const bf16_t*)d_out, (const float*)d_in[15], acc, scr);
        hipLaunchKernelGGL(st_eps_fill, dim3(1024), dim3(256), 0, stream, (const double*)acc, (float*)d_out, out_size); }
#elif defined(ST_DNCHECK)
#ifndef ST_LAYER
#define ST_LAYER 1
#endif
    {   a.step_lo = 0; a.step_hi = 9 * ST_LAYER + 3; a.prologue = 1; a.final_ = 0;
        void* args[] = {&a};
        hipError_t e = hipLaunchCooperativeKernel((const void*)mega, dim3(grid), dim3(NTHREADS), args, LDS_BYTES, stream);
        if (e != hipSuccess) fprintf(stderr, "cooperative launch failed: %s (grid %d)\n", hipGetErrorString(e), grid);
        float* href = (float*)d_out; double* acc = (double*)((unsigned char*)d_ws + ST_CHK);
        hipLaunchKernelGGL(st_dn_ref, dim3(NCHAIN), dim3(512), 0, stream, (const unsigned char*)d_ws, (const float*)d_in[16] + (ST_LAYER / 2) * 3 * 1536, (const float*)d_in[17] + (ST_LAYER / 2) * 8, (const float*)d_in[18] + (ST_LAYER / 2) * 8, href);
        a.step_lo = 9 * ST_LAYER + 3; a.step_hi = 9 * ST_LAYER + 5; a.prologue = 0;
        (void)hipMemsetAsync(d_ws, 0, 512 * 1024, stream);
        e = hipLaunchCooperativeKernel((const void*)mega, dim3(grid), dim3(NTHREADS), args, LDS_BYTES, stream);
        hipLaunchKernelGGL(st_dn_cmp, dim3(512), dim3(256), 0, stream, (const unsigned char*)d_ws, (const float*)href, (const float*)d_in[19] + (ST_LAYER / 2) * 128, acc);
        hipLaunchKernelGGL(st_eps_fill, dim3(1024), dim3(256), 0, stream, (const double*)acc, (float*)d_out, out_size); }
#elif defined(ST_MLCHECK)
#ifndef ST_LAYER
#define ST_LAYER 0
#endif
    {   a.step_lo = 0; a.step_hi = 9 * ST_LAYER + 5; a.prologue = 1; a.final_ = 0;
        void* args[] = {&a};
        hipError_t e = hipLaunchCooperativeKernel((const void*)mega, dim3(grid), dim3(NTHREADS), args, LDS_BYTES, stream);
        if (e != hipSuccess) fprintf(stderr, "cooperative launch failed: %s (grid %d)\n", hipGetErrorString(e), grid);
        float* href = (float*)((unsigned char*)d_ws + SE_DCT); double* acc = (double*)((unsigned char*)d_ws + ST_CHK);
        hipLaunchKernelGGL(st_ml_ref, dim3(NCHAIN), dim3(512), 0, stream, (const unsigned char*)d_ws, (const float*)d_in[9] + (ST_LAYER / 2) * 16, href);
        hipLaunchKernelGGL(st_ml_cmp, dim3(512), dim3(256), 0, stream, (const unsigned char*)d_ws, (const float*)href, (const float*)d_in[12] + (ST_LAYER / 2) * 128, acc);
        hipLaunchKernelGGL(st_eps_fill, dim3(1024), dim3(256), 0, stream, (const double*)acc, (float*)d_out, out_size); }
#elif defined(ST_TAILCHECK)
    {   a.step_lo = 0; a.step_hi = 5; a.prologue = 1; a.final_ = 0;
        void* args[] = {&a};
        hipError_t e = hipLaunchCooperativeKernel((const void*)mega, dim3(grid), dim3(NTHREADS), args, LDS_BYTES, stream);
        if (e != hipSuccess) fprintf(stderr, "cooperative launch failed: %s (grid %d)\n", hipGetErrorString(e), grid);
        float* ysave = (float*)((unsigned char*)d_ws + SE_DCT);
        (void)hipMemcpyAsync(ysave, (unsigned char*)d_ws + OFF_HY, (size_t)MT * 1024 * 2, hipMemcpyDeviceToDevice, stream);
        a.step_lo = 5; a.step_hi = 9; a.prologue = 0;
        (void)hipMemsetAsync(d_ws, 0, 512 * 1024, stream);
        e = hipLaunchCooperativeKernel((const void*)mega, dim3(grid), dim3(NTHREADS), args, LDS_BYTES, stream);
        (void)hipMemcpyAsync((unsigned char*)d_ws + OFF_HY, ysave, (size_t)MT * 1024 * 2, hipMemcpyDeviceToDevice, stream);
        double* acc = (double*)((unsigned char*)d_ws + ST_CHK);
        hipLaunchKernelGGL(st_tail_check, dim3(72), dim3(256), 0, stream, (const unsigned char*)d_ws, (const float*)d_in[0], (const float*)d_in[2], (const float*)d_in[13], (const float*)d_in[7], (const float*)d_in[21], (const float*)d_in[22], (const float*)d_in[23], acc);
        hipLaunchKernelGGL(st_eps_fill, dim3(1024), dim3(256), 0, stream, (const double*)acc, (float*)d_out, out_size); }
#elif defined(ST_L0CHECK)
    {   a.step_lo = 0; a.step_hi = 2; a.prologue = 1; a.final_ = 0;
        void* args[] = {&a};
        hipError_t e = hipLaunchCooperativeKernel((const void*)mega, dim3(grid), dim3(NTHREADS), args, LDS_BYTES, stream);
        if (e != hipSuccess) fprintf(stderr, "cooperative launch failed: %s (grid %d)\n", hipGetErrorString(e), grid);
        double* acc = (double*)((unsigned char*)d_ws + ST_CHK);
        hipLaunchKernelGGL(st_inproj_check, dim3(512), dim3(256), 0, stream, (const unsigned char*)d_ws, (const float*)d_in[8], acc);
        hipLaunchKernelGGL(st_norm_check, dim3(1), dim3(128), 0, stream, (const unsigned char*)d_ws, (const float*)d_in[6], (const float*)d_in[8], (const float*)d_in[0], (const float*)d_in[2], acc);
        hipLaunchKernelGGL(st_eps3_fill, dim3(1024), dim3(256), 0, stream, (const double*)acc, (float*)d_out, out_size); }
#elif defined(ST_MODCHECK)
    {   a.step_lo = 0; a.step_hi = 0; a.prologue = 1; a.final_ = 0;
        void* args[] = {&a};
        hipError_t e = hipLaunchCooperativeKernel((const void*)mega, dim3(grid), dim3(NTHREADS), args, LDS_BYTES, stream);
        if (e != hipSuccess) fprintf(stderr, "cooperative launch failed: %s (grid %d)\n", hipGetErrorString(e), grid);
        double* acc = (double*)((unsigned char*)d_ws + ST_CHK);
        hipLaunchKernelGGL(st_mod_check, dim3(512), dim3(256), 0, stream, (const unsigned char*)d_ws, (const float*)d_in[1], (const float*)d_in[3], (const float*)d_in[4], (const float*)d_in[5], acc);
        hipLaunchKernelGGL(st_eps_fill, dim3(1024), dim3(256), 0, stream, (const double*)acc, (float*)d_out, out_size); }
#elif defined(ST_DACHECK)
    {   a.step_lo = 0; a.step_hi = 5; a.prologue = 1; a.final_ = 0;
        void* args[] = {&a};
        hipError_t e = hipLaunchCooperativeKernel((const void*)mega, dim3(grid), dim3(NTHREADS), args, LDS_BYTES, stream);
        if (e != hipSuccess) fprintf(stderr, "cooperative launch failed: %s (grid %d)\n", hipGetErrorString(e), grid);
        double* acc = (double*)((unsigned char*)d_ws + ST_CHK); float* scr = (float*)((unsigned char*)d_ws + SE_DCT);
        hipLaunchKernelGGL(st_da_check, dim3(256), dim3(512), 0, stream, (const unsigned char*)d_ws, (const float*)d_in[10], (const float*)d_in[11], acc, scr);
        hipLaunchKernelGGL(st_eps_fill, dim3(1024), dim3(256), 0, stream, (const double*)acc, (float*)d_out, out_size); }
#elif defined(ST_FINAL)
    {   a.step_lo = 0; a.step_hi = CFG_LAYERS * 9; a.prologue = 1; a.final_ = 1;
        void* args[] = {&a};
        hipError_t e = hipLaunchCooperativeKernel((const void*)mega, dim3(grid), dim3(NTHREADS), args, LDS_BYTES, stream);
        if (e != hipSuccess) fprintf(stderr, "cooperative launch failed: %s (grid %d)\n", hipGetErrorString(e), grid);
        double* acc = (double*)((unsigned char*)d_ws + ST_CHK);
        hipLaunchKernelGGL(st_final_check, dim3(64), dim3(256), 0, stream, (const unsigned char*)d_ws, (const float*)d_out, (const float*)d_in[24], acc);
        hipLaunchKernelGGL(st_final_fill, dim3(1024), dim3(256), 0, stream, (const double*)acc, (float*)d_out, out_size); }
#elif defined(ST_TWICE)
    for (int rep = 0; rep < 2; ++rep) {
        (void)hipMemsetAsync(d_ws, 0, 512 * 1024, stream); (void)hipMemsetAsync((unsigned char*)d_ws + OFF_MOD, 0, ZERO_BYTES - OFF_MOD, stream);
        a.step_lo = 0; a.step_hi = CFG_LAYERS * 9; a.prologue = 1; a.final_ = 0;
        void* args[] = {&a};
        hipError_t e = hipLaunchCooperativeKernel((const void*)mega, dim3(grid), dim3(NTHREADS), args, LDS_BYTES, stream);
        if (e != hipSuccess) fprintf(stderr, "cooperative launch failed: %s (grid %d)\n", hipGetErrorString(e), grid);
        hipLaunchKernelGGL(st_check_kernel, dim3(256), dim3(NTHREADS), 0, stream, (unsigned char*)d_ws, 35, rep * 40); }
    hipLaunchKernelGGL(st_twice_report, dim3(1024), dim3(256), 0, stream, (const unsigned char*)d_ws, (float*)d_out, out_size);
#elif defined(ST_REPEAT)
    for (int st = 0; st < CFG_LAYERS * 9; ++st) { const int ph = st % 9;
        for (int rep = 0; rep < ((ph == 3 || ph == 5 || ph == 8) ? 1 : 2); ++rep) {
            a.step_lo = st; a.step_hi = st + 1; a.prologue = (st == 0 && rep == 0); a.final_ = 0;
            void* args[] = {&a};
            hipError_t e = hipLaunchCooperativeKernel((const void*)mega, dim3(grid), dim3(NTHREADS), args, LDS_BYTES, stream);
            if (e != hipSuccess) fprintf(stderr, "cooperative launch failed: %s (grid %d)\n", hipGetErrorString(e), grid);
            hipLaunchKernelGGL(st_check_kernel, dim3(256), dim3(NTHREADS), 0, stream, (unsigned char*)d_ws, st, rep * 40); } }
    hipLaunchKernelGGL(st_repeat_report, dim3(1024), dim3(256), 0, stream, (const unsigned char*)d_ws, (float*)d_out, out_size, CFG_LAYERS * 9);
#elif defined(ST_SAME_BATCH)
    a.step_lo = 0; a.step_hi = CFG_LAYERS * 9; a.prologue = 1; a.final_ = 1;
    { void* args[] = {&a};
      hipError_t e = hipLaunchCooperativeKernel((const void*)mega, dim3(grid), dim3(NTHREADS), args, LDS_BYTES, stream);
      if (e != hipSuccess) fprintf(stderr, "cooperative launch failed: %s (grid %d)\n", hipGetErrorString(e), grid); }
    double* acc = (double*)((unsigned char*)d_ws + ST_CHK);
    hipLaunchKernelGGL(st_batch_report, dim3(256), dim3(256), 0, stream, (const float*)sout, (float*)d_out, out_size, acc);
    hipLaunchKernelGGL(st_fill, dim3(1024), dim3(256), 0, stream, (const double*)acc, (float*)d_out, out_size);
#else
#ifndef ST_CHUNK
#define ST_CHUNK 1
#endif
    for (int st = 0; st < CFG_LAYERS * 9; st += ST_CHUNK) {
        a.step_lo = st; a.step_hi = st + ST_CHUNK; a.prologue = st == 0; a.final_ = 0;
        void* args[] = {&a};
        hipError_t e = hipLaunchCooperativeKernel((const void*)mega, dim3(grid), dim3(NTHREADS), args, LDS_BYTES, stream);
        if (e != hipSuccess) fprintf(stderr, "cooperative launch failed: %s (grid %d)\n", hipGetErrorString(e), grid);
        hipLaunchKernelGGL(st_check_kernel, dim3(256), dim3(NTHREADS), 0, stream, (unsigned char*)d_ws, st + ST_CHUNK - 1);
    }
#ifdef ST_TRUTH
    hipLaunchKernelGGL(st_truth_fill, dim3(1024), dim3(256), 0, stream, (const unsigned char*)d_ws, (float*)d_out, out_size);
#else
    hipLaunchKernelGGL(st_report, dim3(1024), dim3(256), 0, stream, (const unsigned char*)d_ws, (float*)d_out, out_size);
#endif
#endif
#elif defined(MULTI_LAUNCH)
    for (int st = 0; st < CFG_LAYERS * 9; st += MULTI_LAUNCH) {
        a.step_lo = st; a.step_hi = st + MULTI_LAUNCH < CFG_LAYERS * 9 ? st + MULTI_LAUNCH : CFG_LAYERS * 9; a.prologue = st == 0; a.final_ = 0;
        void* args[] = {&a};
        hipError_t e = hipLaunchCooperativeKernel((const void*)mega, dim3(grid), dim3(NTHREADS), args, LDS_BYTES, stream);
        if (e != hipSuccess) fprintf(stderr, "cooperative launch failed: %s (grid %d)\n", hipGetErrorString(e), grid);
    }
    {   a.step_lo = a.step_hi = CFG_LAYERS * 9; a.prologue = 0; a.final_ = 1;
        void* args[] = {&a};
        hipError_t e = hipLaunchCooperativeKernel((const void*)mega, dim3(grid), dim3(NTHREADS), args, LDS_BYTES, stream);
        if (e != hipSuccess) fprintf(stderr, "cooperative launch failed: %s (grid %d)\n", hipGetErrorString(e), grid); }
#elif defined(PROBE_Y)
    {   a.step_lo = 0; a.step_hi = 9 * (PROBE_Y - 1) + 5; a.prologue = 1; a.final_ = 0;
        void* args[] = {&a};
        hipError_t e = hipLaunchCooperativeKernel((const void*)mega, dim3(grid), dim3(NTHREADS), args, LDS_BYTES, stream);
        if (e != hipSuccess) fprintf(stderr, "cooperative launch failed: %s (grid %d)\n", hipGetErrorString(e), grid);
        double* acc = (double*)((unsigned char*)d_ws + 512 * 1024);
        hipLaunchKernelGGL(pr_stat, dim3(512), dim3(256), 0, stream, (const bf16_t*)((unsigned char*)d_ws + OFF_HY), ML, PROBE_C0, PROBE_C1, acc);
        hipLaunchKernelGGL(pr_fill, dim3(1024), dim3(256), 0, stream, (const double*)acc, (float*)d_out, out_size); }
#else
    a.step_lo = 0; a.step_hi = CFG_LAYERS * 9; a.prologue = 1; a.final_ = 1;
    void* args[] = {&a};
    hipError_t e = hipLaunchCooperativeKernel((const void*)mega, dim3(grid), dim3(NTHREADS), args, LDS_BYTES, stream);
    if (e != hipSuccess) fprintf(stderr, "cooperative launch failed: %s (grid %d)\n", hipGetErrorString(e), grid);
#ifdef RUN_TWICE
    (void)hipMemsetAsync(d_ws, 0, ZERO_BYTES, stream);
    e = hipLaunchCooperativeKernel((const void*)mega, dim3(grid), dim3(NTHREADS), args, LDS_BYTES, stream);
#endif
#endif
}
#endif
```

```cpp
#ifndef EMU
#include <hip/hip_runtime.h>
#include <hip/hip_cooperative_groups.h>
#include <cstdio>
#include <cstdint>
#include <cmath>
#endif

#ifndef CFG_D
#define CFG_D 1024
#define CFG_B 8
#define CFG_SEQ 2048
#define CFG_CTX 256
#define CFG_FF 2816
#endif
#ifndef DIS
#define DIS 0ull
#endif
#define ON(bit) (!(((unsigned long long)(DIS) >> (bit)) & 1ull))
#ifndef REPM
#define REPM 0ull
#endif
#define REPB(bit) for (int rep_ = 0; rep_ <= (int)(((unsigned long long)(REPM) >> (bit)) & 1ull); ++rep_)
#ifndef CFG_LAYERS
#define CFG_LAYERS 4
#endif
constexpr int D = CFG_D, NB = CFG_B, SEQ = CFG_SEQ, CTX = CFG_CTX, FF = CFG_FF, DEPTH = 4, GRIDW = 64;
constexpr int ML = NB * SEQ, MC = NB * CTX, MT = ML + MC;
constexpr int LK = CTX + SEQ;
constexpr int NCC = CTX / 64, NLC = SEQ / 64, NCH = NCC + NLC;
constexpr int E_IN = 3088, O_IN = 2832, NE = 3072, NO = 2816;
constexpr int NCHAIN = NB * 4 * 2;
constexpr float EPS = 1e-6f;
constexpr int NTHREADS = 512, NWAVES = 8;
static_assert(SEQ % 256 == 0 && MC % 256 == 0 && D % 256 == 0 && FF % 256 == 0 && CTX % 64 == 0, "shape constraints");

typedef unsigned short bf16_t;
typedef short bf16x8 __attribute__((ext_vector_type(8)));
typedef short bf16x4 __attribute__((ext_vector_type(4)));
typedef float f32x4 __attribute__((ext_vector_type(4)));
typedef float f32x2 __attribute__((ext_vector_type(2)));
typedef float f32x16 __attribute__((ext_vector_type(16)));
typedef unsigned u32x4 __attribute__((ext_vector_type(4)));
typedef unsigned u32x2 __attribute__((ext_vector_type(2)));

#ifdef EMU
#define DEV static inline
#define DEVM inline
#define TIDX (EMU_TID)
#define BIDX (EMU_BID)
#define NBLK (EMU_NBLK)
#define BLOCK_SYNC() emu::block_sync()
#define WAVE_FENCE() emu::wave_sync()
#define SHFL_XOR(v, m) emu::shfl_xor((v), (m))
#define SHFL(v, s) emu::shfl((v), (s))
#define MFMA32(a, b, c) emu::mfma32((a), (b), (c))
#define EXP2F(x) exp2f(x)
#define ATOMIC_ADD_F(p, v) (*(p) += (v))
#define SCHED_FENCE() do {} while (0)
#define LOGF_NATIVE(x) logf(x)
#define WAVE_ANY(p) (wave_max((p) ? 1.0f : 0.0f) > 0.5f)
#else
namespace cg = cooperative_groups;
#define DEV __device__ __forceinline__
#define DEVM __device__ __forceinline__
#define TIDX ((int)threadIdx.x)
#define BIDX ((int)blockIdx.x)
#define NBLK ((int)gridDim.x)
#define BLOCK_SYNC() __syncthreads()
#define WAVE_FENCE() do { asm volatile("s_waitcnt lgkmcnt(0)" ::: "memory"); } while (0)
#define SHFL_XOR(v, m) __shfl_xor((v), (m))
#define SHFL(v, s) __shfl((v), (s))
#define MFMA32(a, b, c) __builtin_amdgcn_mfma_f32_32x32x16_bf16((a), (b), (c), 0, 0, 0)
#define EXP2F(x) __builtin_amdgcn_exp2f(x)
#define ATOMIC_ADD_F(p, v) atomicAdd((p), (v))
#define SCHED_FENCE() __builtin_amdgcn_sched_barrier(0)
#define LOGF_NATIVE(x) __logf(x)
#define WAVE_ANY(p) (__any(p) != 0)
#endif

DEV unsigned f2bf(float f) { unsigned u = __builtin_bit_cast(unsigned, f); return (u + 0x7fffu + ((u >> 16) & 1u)) >> 16; }
DEV float bf2f(unsigned h) { return __builtin_bit_cast(float, h << 16); }
#ifdef EMU
DEV unsigned pk2(float lo, float hi) { return f2bf(lo) | (f2bf(hi) << 16); }
#else
typedef __bf16 hw_bf16x2 __attribute__((ext_vector_type(2)));
DEV unsigned pk2(float lo, float hi) { const f32x2 v = {lo, hi}; return __builtin_bit_cast(unsigned, __builtin_convertvector(v, hw_bf16x2)); }
#endif
DEV int crow(int r, int h) { return (r & 3) + 8 * (r >> 2) + 4 * h; }
DEV float wave_sum(float v) {
#pragma unroll
    for (int o = 1; o < 64; o <<= 1) v += SHFL_XOR(v, o);
    return v;
}
DEV float wave_max(float v) {
#pragma unroll
    for (int o = 1; o < 64; o <<= 1) v = fmaxf(v, SHFL_XOR(v, o));
    return v;
}
DEV bf16x8 ld16(const void* p) { return *(const bf16x8*)p; }
DEV bf16x8 pack_acc(const f32x16& x, int s) {
    u32x4 p; p[0] = pk2(x[8 * s + 0], x[8 * s + 1]); p[1] = pk2(x[8 * s + 2], x[8 * s + 3]); p[2] = pk2(x[8 * s + 4], x[8 * s + 5]); p[3] = pk2(x[8 * s + 6], x[8 * s + 7]);
    return __builtin_bit_cast(bf16x8, p);
}
DEV bf16x8 cat44(bf16x4 lo, bf16x4 hi) { return __builtin_shufflevector(lo, hi, 0, 1, 2, 3, 4, 5, 6, 7); }
#ifndef EMU
DEV float fast_expf_(float x) { return __builtin_amdgcn_exp2f(x * 1.4426950408889634f); }
#define expf(x) fast_expf_(x)
#endif
#ifdef EMU
DEV float sigmoidf_(float x) { return 1.0f / (1.0f + expf(-x)); }
DEV float siluf_(float x) { return x / (1.0f + expf(-x)); }
#else
DEV float sigmoidf_(float x) { return __builtin_amdgcn_rcpf(1.0f + __builtin_amdgcn_exp2f(x * -1.4426950408889634f)); }
DEV float siluf_(float x) { return x * __builtin_amdgcn_rcpf(1.0f + __builtin_amdgcn_exp2f(x * -1.4426950408889634f)); }
#endif
DEV float log1pexp_(float nax) {
    const float e = expf(nax), u = 1.0f + e, d = u - 1.0f; return d == 0.0f ? e : LOGF_NATIVE(u) * (e / d); }
DEV float logsigmoidf_(float x) { return fminf(x, 0.0f) - log1pexp_(-fabsf(x)); }
DEV float softplusf_(float x) { return fmaxf(x, 0.0f) + log1pexp_(-fabsf(x)); }

constexpr size_t al256(size_t x) { return (x + 255) & ~(size_t)255; }
constexpr size_t cmax(size_t a, size_t b) { return a > b ? a : b; }
constexpr size_t OFF_CTL = 0;
constexpr size_t OFF_MOD = 1u << 20;
constexpr size_t SZ_MOD = al256((size_t)DEPTH * 9 * 6 * D * 4);
constexpr size_t ZERO_BYTES = OFF_MOD + SZ_MOD;
constexpr size_t OFF_ROPE = ZERO_BYTES;
constexpr size_t OFF_G = OFF_ROPE + al256((size_t)SEQ * 64 * 4);
constexpr size_t OFF_X = OFF_G + al256((size_t)MT * 16 * 4);
constexpr size_t OFF_WIN = OFF_X + al256((size_t)MT * D * 4);
constexpr size_t OFF_WOUT = OFF_WIN + al256((size_t)NE * D * 2);
constexpr size_t OFF_P = OFF_WOUT + al256((size_t)D * 1024 * 2);
constexpr size_t SZ_P = al256((size_t)MT * cmax(NE, FF) * 2);
constexpr size_t OFF_HY = OFF_P + SZ_P;
constexpr size_t OFF_S = OFF_HY + al256((size_t)MT * cmax(D, 1024) * 2);
constexpr size_t PE_QA = 0, PE_KA = (size_t)MT * 512, PE_VA = (size_t)MT * 1024, PE_BQ = (size_t)MT * 1536, PE_BK = (size_t)MT * 1792, PE_BV = (size_t)MT * 2048, PE_BO = (size_t)MT * 2560;
constexpr size_t PO_QC = 0, PO_KVC = (size_t)MT * 512, PO_DQKV = (size_t)MT * 768, PO_Z = (size_t)MT * 2304;
constexpr size_t SE_KP = OFF_S;
constexpr size_t SE_VT = SE_KP + al256((size_t)NB * 8 * LK * 64 * 2);
constexpr size_t SE_DCT = SE_VT + al256((size_t)NB * 4 * 128 * LK * 2);
constexpr size_t SE_DN = SE_DCT + al256((size_t)NCHAIN * NCH * 8192 * 4);
constexpr size_t SE_SC = SE_DN + al256((size_t)NCHAIN * NCH * 64 * 4);
constexpr size_t SE_PARK = SE_SC + al256((size_t)NCHAIN * NCH * 4 * 4);
constexpr size_t SE_END = SE_PARK + al256((size_t)256 * NTHREADS * 64 * 4);
constexpr size_t SF_WGU = OFF_S;
constexpr size_t SF_WDN = SF_WGU + al256((size_t)2 * FF * D * 2);
constexpr size_t SF_END = SF_WDN + al256((size_t)D * FF * 2);
constexpr size_t SF_PART = SF_END;
constexpr size_t SF_PART_END = SF_PART + (size_t)128 * 65536 * 4;
constexpr size_t WS_NEED_EF = cmax(SE_END, SF_PART_END);

constexpr int LDS_BYTES = 147456;
constexpr int LDS_MISC = 131072;

struct Args { const float* in[25]; float* out; unsigned char* ws; int step_lo, step_hi, prologue, final_; };

struct Ctx {
    int tid, lane, wave, bid, nblk, gw, ngw;
    char* lds;
    const float* const* in; float* out; unsigned char* ws;
};
#ifdef EMU
#define PHASE_CTX(pc) const Ctx& pc = c
#else
#define PHASE_CTX(pc) Ctx pc = c; { int t_ = threadIdx.x; asm volatile("" : "+v"(t_)); pc.tid = t_; pc.lane = t_ & 63; pc.wave = __builtin_amdgcn_readfirstlane(t_ >> 6); pc.gw = pc.bid * NWAVES + pc.wave; \
    __attribute__((address_space(1))) unsigned char* g_ = (__attribute__((address_space(1))) unsigned char*)c.ws; asm volatile("" : "+s"(g_)); pc.ws = (unsigned char*)g_; }
#endif

#ifdef EMU
struct XcdBarrier { int dummy; };
#define GRID_BARRIER() emu::grid_sync()
#else
#define LAS __attribute__((address_space(3)))
#define XB_TMO      128
#define XB_XCNT(j)  (256  + 64 * (j))
#define XB_XSUB(j)  (1280 + 64 * (j))
#define XB_XGEN(j)  (2304 + 64 * (j))
#define XB_TOP      3328
#define XB_TOPGEN   3392
#define XCD_BAR_WORDS 3456
#define XB_SPIN_CAP (1u << 24)
__device__ __forceinline__ unsigned xb_ld(unsigned* p)              { return __hip_atomic_load(p, __ATOMIC_RELAXED, __HIP_MEMORY_SCOPE_AGENT); }
__device__ __forceinline__ unsigned xb_add(unsigned* p, unsigned v) { return __hip_atomic_fetch_add(p, v, __ATOMIC_RELAXED, __HIP_MEMORY_SCOPE_AGENT); }
__device__ __forceinline__ unsigned xb_xcc_id() { return (unsigned)__builtin_amdgcn_s_getreg((3 << 11) | 20) & 0xFu; }
#define XB_SPIN(cond, bar) do { unsigned _sp = 0; while (cond) { __builtin_amdgcn_s_sleep(1); \
    if ((++_sp & 255u) == 0u) { if (xb_ld(&(bar)[XB_TMO])) break; if (_sp > XB_SPIN_CAP) { atomicAdd(&(bar)[XB_TMO], 1u); break; } } } } while (0)
struct XcdBarrier { unsigned* bar; unsigned x; volatile LAS unsigned* st; };
__device__ __forceinline__ XcdBarrier xcd_barrier_post(unsigned* bar, volatile LAS unsigned* st) {
    XcdBarrier b; b.bar = bar; b.x = xb_xcc_id(); b.st = st;
    if (threadIdx.x == 0) (void)xb_add(&bar[XB_XCNT(b.x)], 1u);
    return b;
}
__device__ __forceinline__ void xcd_barrier_complete(unsigned* bar, unsigned x, unsigned& nloc, unsigned& nx) {
    const unsigned G = gridDim.x * gridDim.y * gridDim.z;
    unsigned sum, cnt, mine, sp = 0u;
    for (;;) {
        sum = 0u; cnt = 0u; mine = 0u;
#pragma unroll
        for (unsigned j = 0; j < 16; ++j) { const unsigned c = xb_ld(&bar[XB_XCNT(j)]); sum += c; cnt += (c > 0u) ? 1u : 0u; mine = (j == x) ? c : mine; }
        if (sum == G) break;
        __builtin_amdgcn_s_sleep(1);
        if ((++sp & 255u) == 0u) { if (xb_ld(&bar[XB_TMO])) break; if (sp > XB_SPIN_CAP) { atomicAdd(&bar[XB_TMO], 1u); break; } }
    }
    nloc = mine > 0u ? mine : 1u; nx = cnt > 0u ? cnt : 1u;
}
__device__ __forceinline__ void xcd_barrier(const XcdBarrier& b) {
    const bool leader = threadIdx.x == 0;
    asm volatile("s_waitcnt vmcnt(0)" ::: "memory");
    __syncthreads();
    if (leader) {
        unsigned* bar = b.bar;
        __builtin_amdgcn_s_waitcnt(0);
        unsigned nloc = b.st[0], nx = b.st[1];
        if (nloc == 0u) { xcd_barrier_complete(bar, b.x, nloc, nx); b.st[0] = nloc; b.st[1] = nx; }
        const unsigned old = xb_add(&bar[XB_XSUB(b.x)], 1u);
        const unsigned gen = old / nloc;
        if (old + 1u == (gen + 1u) * nloc) {
            __builtin_amdgcn_fence(__ATOMIC_RELEASE, "agent");
            asm volatile("s_waitcnt vmcnt(0)" ::: "memory");
            const unsigned og = xb_add(&bar[XB_TOP], 1u);
            const unsigned tg = og / nx;
            if (og + 1u == (tg + 1u) * nx) xb_add(&bar[XB_TOPGEN], 1u);
            else XB_SPIN(xb_ld(&bar[XB_TOPGEN]) == tg, bar);
            __builtin_amdgcn_fence(__ATOMIC_ACQUIRE, "agent");
            xb_add(&bar[XB_XGEN(b.x)], 1u);
            asm volatile("s_waitcnt vmcnt(0)" ::: "memory");
        } else {
            XB_SPIN(xb_ld(&bar[XB_XGEN(b.x)]) == gen, bar);
            __builtin_amdgcn_fence(__ATOMIC_ACQUIRE, "agent");
            asm volatile("s_waitcnt vmcnt(0)" ::: "memory");
        }
    }
    __syncthreads();
}
#ifdef USE_CG_SYNC
#define GRID_BARRIER() cg::this_grid().sync()
#else
#define GRID_BARRIER() xcd_barrier(bar)
#endif
#endif

#ifndef EMU
namespace pg8 {
#define PG8_LAS __attribute__((address_space(3)))
typedef unsigned short bf16_t;
typedef short bf16x8 __attribute__((ext_vector_type(8)));
typedef float f32x4 __attribute__((ext_vector_type(4)));
typedef unsigned u32x4 __attribute__((ext_vector_type(4)));
constexpr int BM = 256, BK = 64, HALF = 128, HTB = HALF * BK * 2  , STAGE_BYTES = 8 * HTB, NXCD = 8, WGM = 8;

__host__ __device__ __forceinline__ int lds_byte(int r, int c) { const int st = (r >> 4) * 2 + (c >> 5), rr = r & 15, cc = c & 31, ob = rr * 64 + cc * 2; return st * 1024 + (ob ^ (((ob >> 9) & 1) << 5)); }
__host__ __device__ __forceinline__ void stage_rc(int b, int& R, int& C) { const int st = b / 1024, sb = b % 1024, swz = sb ^ (((sb >> 9) & 1) << 5); R = (st >> 1) * 16 + swz / 64; C = (st & 1) * 32 + (swz % 64) / 2; }
__host__ __device__ __forceinline__ int perm32(int rho) { const int n = rho >> 4, i = rho & 15; return 8 * (i >> 2) + 4 * n + (i & 3); }

struct Unit { int pm, pn; };
struct Gemm { const bf16_t* A; const bf16_t* Bt; int M, N, K, ld; };

struct StaticOrder {
    int nM, nN, nwg, G, c, wave, lim;
    int tn, tpm, tpn, tw;
    __host__ __device__ void init(int M, int N, int G_, int c_) { nM = M / BM; nN = N / BM; nwg = nM * nN; G = G_; c = c_; lim = 0x7fffffff; tn = 0; tpm = 0; tpn = 0; tw = 1; }
    __host__ __device__ bool next(int i, Unit& u) const {
        const long L = (long)i * G + c; if (L >= nwg + tn || L >= lim) return false;
        if (L >= nwg) { const int idx = (int)L - nwg; u.pm = tpm + idx / tw; u.pn = tpn + idx % tw; return true; }
        int wgid = (int)L; { const int q = nwg / NXCD, r = nwg % NXCD, xcd = wgid % NXCD, off = wgid / NXCD; wgid = (xcd < r ? xcd * (q + 1) : r * (q + 1) + (xcd - r) * q) + off; }
        const int nig = WGM * nN, gid = wgid / nig, fm = gid * WGM, gsz = (nM - fm) < WGM ? (nM - fm) : WGM;
        u.pm = fm + ((wgid % nig) % gsz); u.pn = (wgid % nig) / gsz; return true;
    }
    __device__ __forceinline__ void a_ready(const Unit&) const {}
    __device__ __forceinline__ void done(const Unit&) const {}
};
template <class Epi, class Sched, bool ALIGN_EPI = false, bool SP2 = false>
__device__ __forceinline__ void gemm_phase(PG8_LAS unsigned char* lds, const Gemm g, const Sched& S, const Epi& E) {
    int tid_ = threadIdx.x; asm volatile("" : "+v"(tid_));
    const int tid = tid_, wid = __builtin_amdgcn_readfirstlane(tid >> 6), lane = tid & 63, wr = wid >> 2, wc = wid & 3, fr = lane & 15, fq = lane >> 4;
    const int K = g.K, nt = K / BK, LD = g.ld ? g.ld : g.K;
    unsigned voffA[2], voffB[2];
#pragma unroll
    for (int i = 0; i < 2; ++i) { int R, C; stage_rc(tid * 16 + i * 8192, R, C); const int Rb = Epi::PERM ? ((R & ~31) + perm32(R & 31)) : R;
        voffA[i] = (unsigned)(R * LD + C) * 2u; voffB[i] = (unsigned)(Rb * LD + C) * 2u; }
    const size_t kstep = (size_t)(BK * 2);
    const size_t hstep = (size_t)HALF * LD * 2;
    const size_t tstep = 2 * hstep;
    const unsigned ldsw = (unsigned)wid * 1024u;
    const int aoff = lds_byte(wr * 64 + fr, fq * 8), boff = lds_byte(wc * 32 + fr, fq * 8);
#define PG8_SA(b, h) (((b) * 2 + (h)) * HTB)
#define PG8_SB(b, h) ((4 + (b) * 2 + (h)) * HTB)
#define PG8_STAGE(bufoff, gbase, voff) do { _Pragma("unroll") for (int _i = 0; _i < 2; ++_i) \
        __builtin_amdgcn_global_load_lds((const unsigned*)((const char*)(gbase) + (voff)[_i]), (PG8_LAS unsigned*)(lds + (bufoff) + ldsw + _i * 8192), 16, 0, 0); } while (0)
#define PG8_LDA(dst, b, h) do { _Pragma("unroll") for (int m = 0; m < 4; ++m) _Pragma("unroll") for (int k = 0; k < 2; ++k) dst[m][k] = *(const PG8_LAS bf16x8*)(lds + PG8_SA(b, h) + aoff + m * 2048 + k * 1024); } while (0)
#define PG8_LDB(dst, b, h) do { _Pragma("unroll") for (int n = 0; n < 2; ++n) _Pragma("unroll") for (int k = 0; k < 2; ++k) dst[n][k] = *(const PG8_LAS bf16x8*)(lds + PG8_SB(b, h) + boff + n * 2048 + k * 1024); } while (0)
#define PG8_MMA(ai, bj, At, Bt) do { __builtin_amdgcn_s_setprio(1); _Pragma("unroll") for (int m = 0; m < 4; ++m) _Pragma("unroll") for (int n = 0; n < 2; ++n) _Pragma("unroll") for (int k = 0; k < 2; ++k) \
        acc[ai][bj][m][n] = __builtin_amdgcn_mfma_f32_16x16x32_bf16(Bt[n][k], At[m][k], acc[ai][bj][m][n], 0, 0, 0); __builtin_amdgcn_s_setprio(0); } while (0)
#define PG8_WAIT_V(n) asm volatile("s_waitcnt vmcnt(" #n ")" ::: "memory")
#define PG8_WAIT_L(n) asm volatile("s_waitcnt lgkmcnt(" #n ")" ::: "memory")
#define PG8_BAR __builtin_amdgcn_s_barrier()
#define PG8_SCHED __builtin_amdgcn_sched_barrier(0)
    Unit cur, nxt; int ui = 0;
    if (!S.next(0, cur)) return;
    f32x4 acc[2][2][4][2];
#pragma unroll
    for (int a = 0; a < 2; ++a)
#pragma unroll
        for (int b = 0; b < 2; ++b)
#pragma unroll
            for (int m = 0; m < 4; ++m)
#pragma unroll
                for (int n = 0; n < 2; ++n) acc[a][b][m][n] = (f32x4){0.f, 0.f, 0.f, 0.f};
    bf16x8 At[4][2], B0[2][2], B1[2][2];
    const char* cA = (const char*)g.A + (size_t)cur.pm * tstep; const char* cB = (const char*)g.Bt + (size_t)cur.pn * tstep;
    S.a_ready(cur);
    if constexpr (SP2) {
        PG8_STAGE(PG8_SB(0, 0), cB, voffB); PG8_STAGE(PG8_SB(0, 1), cB + hstep, voffB); PG8_STAGE(PG8_SA(0, 0), cA, voffA); PG8_STAGE(PG8_SA(0, 1), cA + hstep, voffA);
        if (wr == 1) PG8_BAR;
        PG8_WAIT_V(2); PG8_BAR;
        PG8_STAGE(PG8_SB(1, 0), cB + kstep, voffB); PG8_STAGE(PG8_SA(1, 0), cA + kstep, voffA); PG8_STAGE(PG8_SB(1, 1), cB + hstep + kstep, voffB);
        PG8_WAIT_V(6); PG8_BAR;
    } else {
        PG8_STAGE(PG8_SB(0, 0), cB, voffB); PG8_STAGE(PG8_SA(0, 0), cA, voffA); PG8_STAGE(PG8_SB(0, 1), cB + hstep, voffB); PG8_STAGE(PG8_SA(0, 1), cA + hstep, voffA);
        if (wr == 1) PG8_BAR;
        PG8_WAIT_V(4); PG8_BAR;
        PG8_STAGE(PG8_SB(1, 0), cB + kstep, voffB); PG8_STAGE(PG8_SA(1, 0), cA + kstep, voffA); PG8_STAGE(PG8_SB(1, 1), cB + hstep + kstep, voffB);
        PG8_WAIT_V(6); PG8_BAR;
    }
    for (;;) {
        const bool has_next = S.next(ui + 1, nxt);
        const char* nA = has_next ? (const char*)g.A + (size_t)nxt.pm * tstep : cA; const char* nB = has_next ? (const char*)g.Bt + (size_t)nxt.pn * tstep : cB;
        for (int t = 0; t < nt; t += 2) {
            const bool last = (t == nt - 2);
            const char* a1 = cA + (size_t)(t + 1) * kstep;
            const char* a2 = last ? nA : cA + (size_t)(t + 2) * kstep; const char* b2 = last ? nB : cB + (size_t)(t + 2) * kstep;
            const char* a3 = a2 + kstep; const char* b3 = b2 + kstep;
            if (last && has_next) S.a_ready(nxt);
            if constexpr (SP2) {
            PG8_LDB(B0, 0, 0); PG8_LDB(B1, 0, 1); PG8_SCHED; PG8_LDA(At, 0, 0); PG8_STAGE(PG8_SA(1, 1), a1 + hstep, voffA);
            PG8_WAIT_V(8); PG8_WAIT_L(0); PG8_BAR; PG8_MMA(0, 0, At, B0); PG8_MMA(0, 1, At, B1); PG8_BAR; PG8_SCHED;
            PG8_LDA(At, 0, 1); PG8_STAGE(PG8_SB(0, 0), b2, voffB); PG8_STAGE(PG8_SB(0, 1), b2 + hstep, voffB); PG8_STAGE(PG8_SA(0, 0), a2, voffA);
            PG8_WAIT_V(8); PG8_WAIT_L(0); PG8_BAR; PG8_MMA(1, 0, At, B0); PG8_MMA(1, 1, At, B1); PG8_BAR; PG8_SCHED;
            PG8_LDB(B0, 1, 0); PG8_LDB(B1, 1, 1); PG8_SCHED; PG8_LDA(At, 1, 0); PG8_STAGE(PG8_SA(0, 1), a2 + hstep, voffA);
            PG8_WAIT_V(8); PG8_WAIT_L(0); PG8_BAR; PG8_MMA(0, 0, At, B0); PG8_MMA(0, 1, At, B1); PG8_BAR; PG8_SCHED;
            PG8_LDA(At, 1, 1); PG8_STAGE(PG8_SB(1, 0), b3, voffB); PG8_STAGE(PG8_SB(1, 1), b3 + hstep, voffB); PG8_STAGE(PG8_SA(1, 0), a3, voffA);
            PG8_WAIT_V(8); PG8_WAIT_L(0); PG8_BAR; PG8_MMA(1, 0, At, B0); PG8_MMA(1, 1, At, B1); PG8_BAR; PG8_SCHED;
            } else {
            PG8_LDB(B0, 0, 0); PG8_SCHED; PG8_LDA(At, 0, 0); PG8_STAGE(PG8_SA(1, 1), a1 + hstep, voffA);
            PG8_WAIT_L(8); PG8_BAR; PG8_WAIT_L(0); PG8_MMA(0, 0, At, B0); PG8_BAR; PG8_SCHED;
            PG8_LDB(B1, 0, 1); PG8_STAGE(PG8_SB(0, 0), b2, voffB);
            PG8_BAR; PG8_WAIT_L(0); PG8_MMA(0, 1, At, B1); PG8_BAR;
            PG8_LDA(At, 0, 1); PG8_STAGE(PG8_SA(0, 0), a2, voffA);
            PG8_BAR; PG8_WAIT_L(0); PG8_MMA(1, 0, At, B0); PG8_BAR; PG8_SCHED;
            PG8_STAGE(PG8_SB(0, 1), b2 + hstep, voffB);
            PG8_WAIT_V(6); PG8_BAR; PG8_MMA(1, 1, At, B1); PG8_BAR;
            PG8_LDB(B0, 1, 0); PG8_SCHED; PG8_LDA(At, 1, 0); PG8_STAGE(PG8_SA(0, 1), a2 + hstep, voffA);
            PG8_WAIT_L(8); PG8_BAR; PG8_WAIT_L(0); PG8_MMA(0, 0, At, B0); PG8_BAR; PG8_SCHED;
            PG8_LDB(B1, 1, 1); PG8_STAGE(PG8_SB(1, 0), b3, voffB);
            PG8_BAR; PG8_WAIT_L(0); PG8_MMA(0, 1, At, B1); PG8_BAR;
            PG8_LDA(At, 1, 1); PG8_STAGE(PG8_SA(1, 0), a3, voffA);
            PG8_BAR; PG8_WAIT_L(0); PG8_MMA(1, 0, At, B0); PG8_BAR; PG8_SCHED;
            PG8_STAGE(PG8_SB(1, 1), b3 + hstep, voffB);
            PG8_WAIT_V(6); PG8_BAR; PG8_MMA(1, 1, At, B1); PG8_BAR;
            }
        }
        if constexpr (ALIGN_EPI) { if (wr == 0) PG8_BAR; }
        if constexpr (!Epi::AFTER_DRAIN) { E(acc, cur, wr, wc, fr, fq); S.done(cur); }
        if (!has_next) break;
#pragma unroll
        for (int a = 0; a < 2; ++a)
#pragma unroll
            for (int b = 0; b < 2; ++b)
#pragma unroll
                for (int m = 0; m < 4; ++m)
#pragma unroll
                    for (int n = 0; n < 2; ++n) acc[a][b][m][n] = (f32x4){0.f, 0.f, 0.f, 0.f};
        cur = nxt; cA = nA; cB = nB; ++ui;
        if constexpr (ALIGN_EPI) { if (wr == 1) PG8_BAR; }
    }
    PG8_WAIT_V(0);
    if constexpr (!ALIGN_EPI) { if (wr == 0) PG8_BAR; }
    PG8_BAR;
    if constexpr (Epi::AFTER_DRAIN) { E.fused(acc, cur, wr, wc, fr, fq, lds, wid, lane); S.done(cur); }
#undef PG8_SA
#undef PG8_SB
#undef PG8_STAGE
#undef PG8_LDA
#undef PG8_LDB
#undef PG8_MMA
#undef PG8_WAIT_V
#undef PG8_WAIT_L
#undef PG8_BAR
#undef PG8_SCHED
}
}
#else
namespace pg8 {
typedef unsigned short bf16_t;
constexpr int BM = 256, BK = 64, HALF = 128, NXCD = 8, WGM = 8;
struct Unit { int pm, pn; };
struct Gemm { const bf16_t* A; const bf16_t* Bt; int M, N, K, ld; };
struct StaticOrder {
    int nM, nN, nwg, G, c, wave, lim, tn, tpm, tpn, tw;
    void init(int M, int N, int G_, int c_) { nM = M / BM; nN = N / BM; nwg = nM * nN; G = G_; c = c_; lim = 0x7fffffff; tn = 0; tpm = 0; tpn = 0; tw = 1; }
    bool next(int i, Unit& u) const {
        const long L = (long)i * G + c; if (L >= nwg + tn || L >= lim) return false;
        if (L >= nwg) { const int idx = (int)L - nwg; u.pm = tpm + idx / tw; u.pn = tpn + idx % tw; return true; }
        int wgid = (int)L; { const int q = nwg / NXCD, r = nwg % NXCD, xcd = wgid % NXCD, off = wgid / NXCD; wgid = (xcd < r ? xcd * (q + 1) : r * (q + 1) + (xcd - r) * q) + off; }
        const int nig = WGM * nN, gid = wgid / nig, fm = gid * WGM, gsz = (nM - fm) < WGM ? (nM - fm) : WGM;
        u.pm = fm + ((wgid % nig) % gsz); u.pn = (wgid % nig) / gsz; return true;
    }
};
template <class Epi, class Sched, bool ALIGN_EPI = false, bool SP2 = false>
static inline void gemm_phase(unsigned char* lds, const Gemm g, const Sched& S, const Epi& E) {
    const int tid = TIDX, wid = tid >> 6, lane = tid & 63, wr = wid >> 2, wc = wid & 3, fr = lane & 15, fq = lane >> 4;
    Unit u;
    for (int i = 0; S.next(i, u); ++i) {
        f32x4 acc[2][2][4][2];
        for (int ai = 0; ai < 2; ++ai) for (int bj = 0; bj < 2; ++bj) for (int m = 0; m < 4; ++m) for (int n = 0; n < 2; ++n) for (int j = 0; j < 4; ++j) {
            const int row = 256 * u.pm + 128 * ai + 64 * wr + 16 * m + fr;
            const int col = Epi::PERM ? 256 * u.pn + 128 * bj + 32 * wc + 8 * fq + 4 * n + j : 256 * u.pn + 128 * bj + 32 * wc + 16 * n + 4 * fq + j;
            const int ld = g.ld ? g.ld : g.K; const bf16_t* a = g.A + (size_t)row * ld; const bf16_t* b = g.Bt + (size_t)col * ld; float s = 0.f;
            for (int k = 0; k < g.K; ++k) s += bf2f(a[k]) * bf2f(b[k]);
            acc[ai][bj][m][n][j] = s; }
        E(acc, u, wr, wc, fr, fq);
    }
    BLOCK_SYNC();
}
}
#define PG8_LAS
#endif

#if !defined(EMU) && defined(SIMPLE_GEMM)
namespace sg {
template <class Epi, class Sched>
__device__ __forceinline__ void gemm_phase(const pg8::Gemm g, const Sched& S, const Epi& E) {
    int tid_ = threadIdx.x; asm volatile("" : "+v"(tid_));
    const int tid = tid_, wid = __builtin_amdgcn_readfirstlane(tid >> 6), lane = tid & 63, wr = wid >> 2, wc = wid & 3, fr = lane & 15, fq = lane >> 4;
    pg8::Unit u;
    for (int i = 0; S.next(i, u); ++i) {
        f32x4 acc[2][2][4][2];
#pragma unroll
        for (int ai = 0; ai < 2; ++ai)
#pragma unroll
            for (int bj = 0; bj < 2; ++bj)
#pragma unroll
                for (int m = 0; m < 4; ++m)
#pragma unroll
                    for (int n = 0; n < 2; ++n) acc[ai][bj][m][n] = (f32x4){0.f, 0.f, 0.f, 0.f};
        const bf16_t* wp0 = g.Bt + (size_t)(256 * u.pn + 32 * wc + (Epi::PERM ? 8 * (fr >> 2) + (fr & 3) : fr)) * g.K + 8 * fq;
        const bf16_t* xp0 = g.A + (size_t)(256 * u.pm + 64 * wr + fr) * g.K + 8 * fq;
#pragma unroll 1
        for (int k0 = 0; k0 < g.K; k0 += 32) {
            bf16x8 wf[2][2], xf[2][4];
#pragma unroll
            for (int bj = 0; bj < 2; ++bj)
#pragma unroll
                for (int n = 0; n < 2; ++n) wf[bj][n] = *(const bf16x8*)(wp0 + (size_t)(128 * bj + (Epi::PERM ? 4 : 16) * n) * g.K + k0);
#pragma unroll
            for (int ai = 0; ai < 2; ++ai)
#pragma unroll
                for (int m = 0; m < 4; ++m) xf[ai][m] = *(const bf16x8*)(xp0 + (size_t)(128 * ai + 16 * m) * g.K + k0);
#pragma unroll
            for (int ai = 0; ai < 2; ++ai)
#pragma unroll
                for (int bj = 0; bj < 2; ++bj)
#pragma unroll
                    for (int m = 0; m < 4; ++m)
#pragma unroll
                        for (int n = 0; n < 2; ++n) acc[ai][bj][m][n] = __builtin_amdgcn_mfma_f32_16x16x32_bf16(wf[bj][n], xf[ai][m], acc[ai][bj][m][n], 0, 0, 0);
        }
        E(acc, u, wr, wc, fr, fq);
    }
}
}
#define GEMM_PHASE(EpiT, lds, g, S, E) sg::gemm_phase<EpiT, pg8::StaticOrder>(g, S, E)
#else
#define GEMM_PHASE(EpiT, lds, g, S, E) pg8::gemm_phase<EpiT, pg8::StaticOrder, true, true>((PG8_LAS unsigned char*)(lds), g, S, E)
#endif

struct EpiSeg {
    static constexpr bool PERM = true, AFTER_DRAIN = false;
    bf16_t* P; int odd;
    DEVM void operator()(const f32x4 (&acc)[2][2][4][2], const pg8::Unit& u, int wr, int wc, int fr, int fq) const {
        size_t off; int pitch, c0;
        const int pn = u.pn;
        if (!odd) {
            if (pn < 2) { off = PE_QA; pitch = 512; c0 = 256 * pn; } else if (pn < 4) { off = PE_KA; pitch = 512; c0 = 256 * (pn - 2); } else if (pn < 6) { off = PE_VA; pitch = 512; c0 = 256 * (pn - 4); }
            else if (pn == 6) { off = PE_BQ; pitch = 256; c0 = 0; } else if (pn == 7) { off = PE_BK; pitch = 256; c0 = 0; } else if (pn < 10) { off = PE_BV; pitch = 512; c0 = 256 * (pn - 8); } else { off = PE_BO; pitch = 512; c0 = 256 * (pn - 10); }
        } else {
            if (pn < 2) { off = PO_QC; pitch = 512; c0 = 256 * pn; } else if (pn == 2) { off = PO_KVC; pitch = 256; c0 = 0; } else if (pn < 9) { off = PO_DQKV; pitch = 1536; c0 = 256 * (pn - 3); } else { off = PO_Z; pitch = 512; c0 = 256 * (pn - 9); }
        }
        bf16_t* base = P + off;
        const int row0 = u.pm * 256 + wr * 64 + fr, col0 = c0 + wc * 32 + 8 * fq;
#pragma unroll
        for (int ai = 0; ai < 2; ++ai)
#pragma unroll
            for (int m = 0; m < 4; ++m) { bf16_t* rowp = base + (size_t)(row0 + ai * 128 + m * 16) * pitch + col0;
#pragma unroll
                for (int bj = 0; bj < 2; ++bj) { const f32x4 v0 = acc[ai][bj][m][0], v1 = acc[ai][bj][m][1];
                    u32x4 w; w[0] = pk2(v0[0], v0[1]); w[1] = pk2(v0[2], v0[3]); w[2] = pk2(v1[0], v1[1]); w[3] = pk2(v1[2], v1[3]);
                    *(u32x4*)(rowp + bj * 128) = w; } }
    }
};
struct EpiResid {
    static constexpr bool PERM = false, AFTER_DRAIN = false;
    float* X; const float* mod; int gaoff;
    const float* XL; const float* XC;
    DEVM void operator()(const f32x4 (&acc)[2][2][4][2], const pg8::Unit& u, int wr, int wc, int fr, int fq) const {
        const int rowt = u.pm * 256; const int mr = rowt < ML ? rowt / SEQ : NB;
        const float* ga = mod + (size_t)mr * 6 * D + gaoff; const float* Xs = rowt < ML ? XL : XC;
        const int row0 = rowt + wr * 64 + fr, col0 = u.pn * 256 + wc * 32 + 4 * fq;
#pragma unroll
        for (int bj = 0; bj < 2; ++bj)
#pragma unroll
            for (int n = 0; n < 2; ++n) { const int c = col0 + bj * 128 + n * 16; const f32x4 g = *(const f32x4*)(ga + c);
#pragma unroll
                for (int ai = 0; ai < 2; ++ai)
#pragma unroll
                    for (int m = 0; m < 4; ++m) { const size_t off = (size_t)(row0 + ai * 128 + m * 16) * D + c; const f32x4 x = *(const f32x4*)(Xs + off); *(f32x4*)(X + off) = x + g * acc[ai][bj][m][n]; } }
    }
};
struct EpiPart {
    static constexpr bool PERM = false, AFTER_DRAIN = false;
    float* P;
    DEVM void operator()(const f32x4 (&acc)[2][2][4][2], const pg8::Unit& u, int wr, int wc, int fr, int fq) const {
        (void)u; const int r0 = wr * 64 + fr, c0 = wc * 32 + 4 * fq;
#pragma unroll
        for (int bj = 0; bj < 2; ++bj)
#pragma unroll
            for (int n = 0; n < 2; ++n)
#pragma unroll
                for (int ai = 0; ai < 2; ++ai)
#pragma unroll
                    for (int m = 0; m < 4; ++m) *(f32x4*)(P + (size_t)(r0 + ai * 128 + m * 16) * 256 + c0 + bj * 128 + n * 16) = acc[ai][bj][m][n];
    }
};
struct SplitPlan { int extra, split, nwg; };
DEV SplitPlan split_plan(int mrows, int kdim, int nblk, bool allow) {
    SplitPlan p; p.nwg = (mrows / 256) * (D / 256); p.extra = 0; p.split = 1;
    if (allow && p.nwg > nblk && p.nwg < 2 * nblk) { const int pairs = kdim / 128; int sp = 4; const int ex = p.nwg - nblk;
        while (sp > 1 && (ex * sp > nblk || sp > pairs || ex * sp > 128)) sp >>= 1;
        if (sp > 1) { p.extra = ex; p.split = sp; } }
    return p;
}

struct EpiSwiglu {
    static constexpr bool PERM = true, AFTER_DRAIN = false;
    bf16_t* ACT;
    DEVM void operator()(const f32x4 (&acc)[2][2][4][2], const pg8::Unit& u, int wr, int wc, int fr, int fq) const {
        const int row0 = u.pm * 256 + wr * 64 + fr, col0 = u.pn * 128 + wc * 32 + 8 * fq;
#pragma unroll
        for (int ai = 0; ai < 2; ++ai)
#pragma unroll
            for (int m = 0; m < 4; ++m) { bf16_t* rowp = ACT + (size_t)(row0 + ai * 128 + m * 16) * FF + col0;
                float v[8];
#pragma unroll
                for (int n = 0; n < 2; ++n)
#pragma unroll
                    for (int j = 0; j < 4; ++j) { const float g = acc[ai][0][m][n][j], up = acc[ai][1][m][n][j]; v[4 * n + j] = siluf_(g) * up; }
                u32x4 w; w[0] = pk2(v[0], v[1]); w[1] = pk2(v[2], v[3]); w[2] = pk2(v[4], v[5]); w[3] = pk2(v[6], v[7]);
                *(u32x4*)rowp = w; }
    }
};

DEV void p0_prologue(const Ctx& c) {
    const float* x = c.in[0]; const float* cv = c.in[1]; const float* ctx = c.in[2]; const float* cctx = c.in[3]; const float* w_ada = c.in[4]; const float* b_ada = c.in[5];
    float* MOD = (float*)(c.ws + OFF_MOD);
    const long gt = (long)c.bid * NTHREADS + c.tid, GT = (long)c.nblk * NTHREADS;
    {   constexpr int NCG = 6 * D / 128, KW = D / 8; f32x2* part = (f32x2*)c.lds;
        for (int it = c.bid; it < DEPTH * NCG; it += c.nblk) { const int l = it / NCG, cg = it % NCG; const int n2 = cg * 64 + c.lane;
            f32x2 acc[9];
#pragma unroll
            for (int r = 0; r < 9; ++r) acc[r] = (f32x2){0.f, 0.f};
            const float* W = w_ada + ((size_t)l * D + c.wave * KW) * 6 * D + 2 * n2;
#pragma unroll 8
            for (int k = 0; k < KW; ++k) { const f32x2 w = *(const f32x2*)(W + (size_t)k * 6 * D); const int kk = c.wave * KW + k;
#pragma unroll
                for (int r = 0; r < 9; ++r) { const float sv = siluf_(r < NB ? cv[r * D + kk] : cctx[kk]); acc[r] += w * sv; } }
#pragma unroll
            for (int r = 0; r < 9; ++r) part[(c.wave * 9 + r) * 64 + c.lane] = acc[r];
            BLOCK_SYNC();
            for (int o = c.tid; o < 9 * 64; o += NTHREADS) { const int r = o / 64, q = o % 64; f32x2 sum = *(const f32x2*)(b_ada + (size_t)l * 6 * D + 2 * (cg * 64 + q));
#pragma unroll
                for (int w = 0; w < 8; ++w) sum += part[(w * 9 + r) * 64 + q];
                *(f32x2*)(MOD + ((size_t)l * 9 + r) * 6 * D + 2 * (cg * 64 + q)) = sum; }
            BLOCK_SYNC(); } }
    float* COS = (float*)(c.ws + OFF_ROPE); float* SIN = COS + SEQ * 32;
    for (long it = gt; it < (long)SEQ * 32; it += GT) { const int t = (int)(it >> 5), i = (int)(it & 31);
        const float fr = expf(-(float)(i & 15) * (9.210340371976184f / 16.0f));     const float pos = (i < 16) ? (float)(t / GRIDW) : (float)(t % GRIDW); const float a = pos * fr;
        COS[it] = cosf(a); SIN[it] = sinf(a); }
    (void)x; (void)ctx;
}

DEV void transpose_item(const float* W, int srcpitch, int k0, int n0, bf16_t* WT, int Kp, int dstrow0, float* scr, int lane) {
#pragma unroll 8
    for (int i = 0; i < 32; ++i) { const int kk = 2 * i + (lane >> 5); scr[kk * 33 + (lane & 31)] = W[(size_t)(k0 + kk) * srcpitch + n0 + (lane & 31)]; }
    WAVE_FENCE();
    const int cc = lane & 7;
#pragma unroll
    for (int j = 0; j < 4; ++j) { const int n = (lane >> 3) + 8 * j; const float* s = scr + (8 * cc) * 33 + n;
        u32x4 o; o[0] = pk2(s[0 * 33], s[1 * 33]); o[1] = pk2(s[2 * 33], s[3 * 33]); o[2] = pk2(s[4 * 33], s[5 * 33]); o[3] = pk2(s[6 * 33], s[7 * 33]);
        *(u32x4*)(WT + (size_t)(dstrow0 + n) * Kp + k0 + 8 * cc) = o; }
    WAVE_FENCE();
}
DEV void convert_mixer_weights(const Ctx& c, int layer, int gw, int ngw) {
    float* scr = (float*)(c.lds + c.wave * 8448);
    const int odd = layer & 1, li = layer >> 1;
    const float* win = odd ? c.in[14] + (size_t)li * D * O_IN : c.in[8] + (size_t)li * D * E_IN; const int pin = odd ? O_IN : E_IN, nin = odd ? NO : NE;
    const float* wout = odd ? c.in[20] + (size_t)li * 1024 * D : c.in[13] + (size_t)li * 1024 * D;
    bf16_t* WIN = (bf16_t*)(c.ws + OFF_WIN); bf16_t* WOUT = (bf16_t*)(c.ws + OFF_WOUT);
    const int I1 = (D / 64) * (nin / 32), I2 = (1024 / 64) * (D / 32);
    for (int it = gw; it < I1 + I2; it += ngw) {
        if (it < I1) { const int nb = it % (nin / 32), kb = it / (nin / 32); transpose_item(win, pin, 64 * kb, 32 * nb, WIN, D, 32 * nb, scr, c.lane); }
        else { const int r = it - I1; const int nb = r % (D / 32), kb = r / (D / 32); transpose_item(wout, D, 64 * kb, 32 * nb, WOUT, 1024, 32 * nb, scr, c.lane); }
    }
}
DEV void convert_ffn_weights(const Ctx& c, int layer, int gw, int ngw) {
    float* scr = (float*)(c.lds + c.wave * 8448);
    const float* wg = c.in[21] + (size_t)layer * D * FF; const float* wu = c.in[22] + (size_t)layer * D * FF; const float* wd = c.in[23] + (size_t)layer * FF * D;
    bf16_t* WGU = (bf16_t*)(c.ws + SF_WGU); bf16_t* WDN = (bf16_t*)(c.ws + SF_WDN);
    const int I1 = (D / 64) * (FF / 32), I3 = (FF / 64) * (D / 32);
    for (int it = gw; it < 2 * I1 + I3; it += ngw) {
        if (it < 2 * I1) { const int up = it >= I1; const int r = up ? it - I1 : it; const int nb = r % (FF / 32), kb = r / (FF / 32); const int f0 = 32 * nb;
            transpose_item(up ? wu : wg, FF, 64 * kb, f0, WGU, D, (f0 / 128) * 256 + (up ? 128 : 0) + (f0 % 128), scr, c.lane); }
        else { const int r = it - 2 * I1; const int nb = r % (D / 32), kb = r / (D / 32); transpose_item(wd, D, 64 * kb, 32 * nb, WDN, FF, 32 * nb, scr, c.lane); }
    }
}
DEV void normalize_rows(const Ctx& c, int layer, int which, int nrows, SplitPlan red, int pmrows, const float* pga) {
    constexpr int NV = D / 256;
    float* X = (float*)(c.ws + OFF_X); bf16_t* H = (bf16_t*)(c.ws + OFF_HY); float* G = (float*)(c.ws + OFF_G);
    const float* MODL = (const float*)(c.ws + OFF_MOD) + (size_t)layer * 9 * 6 * D;
    const float* g = (which ? c.in[7] : c.in[6]) + (size_t)layer * D;
    const int odd = layer & 1, li = layer >> 1;
    const float* wgate = odd ? c.in[14] + (size_t)li * D * O_IN + NO : c.in[8] + (size_t)li * D * E_IN + NE; const int pg = odd ? O_IN : E_IN;
    float* wgt = (float*)c.lds;
    unsigned char* tab = (unsigned char*)(c.lds + 16 * D * 4);
    const float* PART = (const float*)(c.ws + SF_PART);
    if (red.extra) { BLOCK_SYNC();
        for (int e = c.tid; e < (pmrows / 256) * (D / 256); e += NTHREADS) tab[e] = 255;
        BLOCK_SYNC();
        if (c.tid < red.extra) { pg8::StaticOrder S2; S2.init(pmrows, D, red.nwg, c.nblk + c.tid); pg8::Unit u; if (S2.next(0, u)) tab[u.pm * (D / 256) + u.pn] = (unsigned char)c.tid; }
        BLOCK_SYNC(); }
    if (which == 0) { BLOCK_SYNC();
        for (int e = c.tid; e < D * 4; e += NTHREADS) { const int k = e >> 2, q = e & 3; const f32x4 w4 = *(const f32x4*)(wgate + (size_t)k * pg + 4 * q);
#pragma unroll
            for (int j = 0; j < 4; ++j) wgt[(4 * q + j) * D + k] = w4[j]; }
        BLOCK_SYNC(); }
    for (int row = c.gw; row < nrows; row += c.ngw) {
        const int mr = row < ML ? row / SEQ : NB;
        const float* sh = MODL + (size_t)mr * 6 * D + (which ? 3 : 0) * D; const float* sc = sh + D;
        const float* xrow = (layer == 0 && which == 0) ? (row < ML ? c.in[0] + (size_t)row * D : c.in[2] + (size_t)(row - ML) * D) : X + (size_t)row * D;
        const f32x4* xr = (const f32x4*)xrow + c.lane;
        f32x4 v[NV]; float ss = 0.f;
#pragma unroll
        for (int j = 0; j < NV; ++j) { v[j] = xr[64 * j];
            if (red.extra && row < pmrows) { const int lu = tab[(row >> 8) * (D / 256) + j];
                if (lu != 255) { const float* pp = PART + (size_t)lu * red.split * 65536 + (size_t)(row & 255) * 256 + 4 * c.lane; f32x4 sum = *(const f32x4*)pp;
                    for (int q = 1; q < red.split; ++q) sum += *(const f32x4*)(pp + (size_t)q * 65536);
                    v[j] += *(const f32x4*)(pga + (size_t)mr * 6 * D + 256 * j + 4 * c.lane) * sum; ((f32x4*)(X + (size_t)row * D) + c.lane)[64 * j] = v[j]; } }
            ss += (v[j][0] * v[j][0] + v[j][1] * v[j][1]) + (v[j][2] * v[j][2] + v[j][3] * v[j][3]); }
        const float rstd = 1.0f / sqrtf(wave_sum(ss) * (1.0f / D) + EPS);
        u32x2* o8 = (u32x2*)(H + (size_t)row * D) + c.lane;
        float ga[16];
#pragma unroll
        for (int n = 0; n < 16; ++n) ga[n] = 0.f;
#pragma unroll
        for (int j = 0; j < NV; ++j) { const int k0 = 256 * j + 4 * c.lane;
            const f32x4 gg = *(const f32x4*)(g + k0), s1 = *(const f32x4*)(sc + k0), s0 = *(const f32x4*)(sh + k0);
            f32x4 h = v[j] * rstd * gg * (s1 + 1.0f) + s0;
            u32x2 w; w[0] = pk2(h[0], h[1]); w[1] = pk2(h[2], h[3]); o8[64 * j] = w;
            if (which == 0) {
#pragma unroll
                for (int n = 0; n < 16; ++n) { const f32x4 w4 = *(const f32x4*)(wgt + n * D + k0); ga[n] += (h[0] * w4[0] + h[1] * w4[1]) + (h[2] * w4[2] + h[3] * w4[3]); if ((n & 7) == 7) SCHED_FENCE(); } } }
        if (which == 0) {
            const bool b5 = c.lane & 32, b4 = c.lane & 16, b3 = c.lane & 8, b2 = c.lane & 4;
            float w8[8], w4[4], w2[2];
#pragma unroll
            for (int n = 0; n < 8; ++n) { const float snd = b5 ? ga[n] : ga[n + 8], kp = b5 ? ga[n + 8] : ga[n]; w8[n] = kp + SHFL_XOR(snd, 32); }
#pragma unroll
            for (int n = 0; n < 4; ++n) { const float snd = b4 ? w8[n] : w8[n + 4], kp = b4 ? w8[n + 4] : w8[n]; w4[n] = kp + SHFL_XOR(snd, 16); }
#pragma unroll
            for (int n = 0; n < 2; ++n) { const float snd = b3 ? w4[n] : w4[n + 2], kp = b3 ? w4[n + 2] : w4[n]; w2[n] = kp + SHFL_XOR(snd, 8); }
            float z = (b2 ? w2[1] : w2[0]) + SHFL_XOR(b2 ? w2[0] : w2[1], 4);
            z += SHFL_XOR(z, 2); z += SHFL_XOR(z, 1);
            if ((c.lane & 3) == 0) G[(size_t)row * 16 + (b5 ? 8 : 0) + (b4 ? 4 : 0) + (b3 ? 2 : 0) + (b2 ? 1 : 0)] = z; }
    }
}

DEV int tok_row(int b, int tc, int i) { return tc < NCC ? ML + b * CTX + 64 * tc + i : b * SEQ + 64 * (tc - NCC) + i; }
DEV int pos_row(int b, int pos) { return pos < CTX ? ML + b * CTX + pos : b * SEQ + (pos - CTX); }
DEV int chain_chunk(int dir, int tc) { return dir == 0 ? tc : (tc < NCC ? NCC - 1 - tc : NCC + (NLC - 1 - (tc - NCC))); }
DEV void unpack8(bf16x8 v, float (&f)[8]) {
#pragma unroll
    for (int e = 0; e < 8; ++e) f[e] = bf2f((unsigned short)v[e]);
}
DEV bf16x8 pack8(const float (&f)[8]) { u32x4 p; p[0] = pk2(f[0], f[1]); p[1] = pk2(f[2], f[3]); p[2] = pk2(f[4], f[5]); p[3] = pk2(f[6], f[7]); return __builtin_bit_cast(bf16x8, p); }
DEV float chain_cumsum(float x, int lane, int dir) {
#pragma unroll
    for (int off = 1; off < 64; off <<= 1) { const int src = dir == 0 ? lane - off : lane + off; const float y = SHFL(x, src & 63); if (src >= 0 && src < 64) x += y; }
    return x;
}

constexpr int AT_KB = 64 * 72 * 2;
template <int DV> struct AttnLds { static constexpr int VB = DV * 72 * 2, BUF = AT_KB + VB; };

template <int DV>
DEV void attn_stage_load(const Ctx& c, const bf16_t* Kp, const bf16_t* Vt, int vpitch, int tile, bf16x8& kreg, bf16x8 (&vreg)[DV / 64]) {
    kreg = ld16(Kp + (size_t)(tile * 64 + (c.tid >> 3)) * 64 + (c.tid & 7) * 8);
#pragma unroll
    for (int i = 0; i < DV / 64; ++i) { const int idx = c.tid + 512 * i; vreg[i] = ld16(Vt + (size_t)(idx >> 3) * vpitch + tile * 64 + (idx & 7) * 8); }
}
template <int DV>
DEV void attn_stage_store(const Ctx& c, int boff, const bf16x8& kreg, const bf16x8 (&vreg)[DV / 64]) {
    char* kb = c.lds + boff; char* vb = kb + AT_KB;
    *(bf16x8*)(kb + (c.tid >> 3) * 144 + (c.tid & 7) * 16) = kreg;
#pragma unroll
    for (int i = 0; i < DV / 64; ++i) { const int idx = c.tid + 512 * i; *(bf16x8*)(vb + (idx >> 3) * 144 + (idx & 7) * 16) = vreg[i]; }
}
DEV void attn_qk(const char* kb, int rk, int h, const bf16x8 (&qf)[4], f32x16& p0, f32x16& p1) {
#pragma unroll
    for (int i = 0; i < 16; ++i) { p0[i] = 0.f; p1[i] = 0.f; }
#pragma unroll
    for (int ks = 0; ks < 4; ++ks) { const bf16x8 a0 = ld16(kb + rk * 144 + ks * 32 + h * 16), a1 = ld16(kb + (32 + rk) * 144 + ks * 32 + h * 16);
        p0 = MFMA32(a0, qf[ks], p0); p1 = MFMA32(a1, qf[ks], p1); }
}
DEV void attn_sm1(f32x16& p0, f32x16& p1, float& m, float& alpha) {
    const float C2 = 0.125f * 1.4426950408889634f;
    float mx = p0[0];
#pragma unroll
    for (int i = 0; i < 16; ++i) { mx = fmaxf(mx, p0[i]); mx = fmaxf(mx, p1[i]); }
    mx = fmaxf(mx, SHFL_XOR(mx, 32));
    alpha = 1.0f;
    if (WAVE_ANY(mx * C2 > m + 8.0f)) { const float mn = fmaxf(m, mx * C2); alpha = EXP2F(m - mn); m = mn; }
#pragma unroll
    for (int i = 0; i < 16; ++i) { p0[i] = p0[i] * C2 - m; p1[i] = p1[i] * C2 - m; }
#pragma unroll
    for (int i = 0; i < 16; ++i) p0[i] = EXP2F(p0[i]);
}
DEV void attn_sm2(f32x16& p0, f32x16& p1, float alpha, float& l, bf16x8 (&pb)[4]) {
#pragma unroll
    for (int i = 0; i < 16; ++i) p1[i] = EXP2F(p1[i]);
    float rs = 0.f;
#pragma unroll
    for (int i = 0; i < 16; ++i) rs += p0[i] + p1[i];
    l = l * alpha + rs;
    pb[0] = pack_acc(p0, 0); pb[1] = pack_acc(p0, 1); pb[2] = pack_acc(p1, 0); pb[3] = pack_acc(p1, 1);
}
template <int DV>
DEV void attn_pv(const char* vb, int r, int h, const bf16x8 (&pb)[4], f32x16 (&o)[DV / 32]) {
#pragma unroll
    for (int us = 0; us < 4; ++us)
#pragma unroll
        for (int dt = 0; dt < DV / 32; ++dt) { const bf16x8 va = ld16(vb + (32 * dt + r) * 144 + (16 * us + 8 * h) * 2); o[dt] = MFMA32(va, pb[us], o[dt]); }
}
template <int DV>
DEV void attn_resc(f32x16 (&o)[DV / 32], float alpha) {
    if (WAVE_ANY(alpha < 1.0f)) {
#pragma unroll
        for (int dt = 0; dt < DV / 32; ++dt)
#pragma unroll
            for (int i = 0; i < 16; ++i) o[dt][i] *= alpha; }
}
template <int DV>
DEV void attn_step(const Ctx& c, const bf16_t* Kp, const bf16_t* Vt, int vpitch, int j, int nt, const bf16x8 (&qf)[4], bool active, int rk, int ox, int oy, int on,
                   bf16x8 (&pb)[4], f32x16 (&o)[DV / 32], float& m, float& l) {
    const int r = c.lane & 31, h = c.lane >> 5; const bool more = j + 1 < nt; const float C2 = 0.125f * 1.4426950408889634f;
    bf16x8 kreg, vreg[DV / 64]; f32x16 p0, p1;
    if (active) attn_qk(c.lds + ox, rk, h, qf, p0, p1);
    SCHED_FENCE();
    if (more) attn_stage_load<DV>(c, Kp, Vt, vpitch, j + 1, kreg, vreg);
    if (active) { const char* vb = c.lds + oy + AT_KB;
        float mx = 0.f, alpha = 1.0f;
#pragma unroll
        for (int us = 0; us < 4; ++us) {
            SCHED_FENCE();
#pragma unroll
            for (int dt = 0; dt < DV / 32; ++dt) { const bf16x8 va = ld16(vb + (32 * dt + r) * 144 + (16 * us + 8 * h) * 2); o[dt] = MFMA32(va, pb[us], o[dt]); }
            SCHED_FENCE();
            if (us == 0) { mx = p0[0];
#pragma unroll
                for (int i = 0; i < 16; ++i) { mx = fmaxf(mx, p0[i]); mx = fmaxf(mx, p1[i]); }
                mx = fmaxf(mx, SHFL_XOR(mx, 32));
                if (WAVE_ANY(mx * C2 > m + 8.0f)) { const float mn = fmaxf(m, mx * C2); alpha = EXP2F(m - mn); m = mn; } }
            else if (us == 1) {
#pragma unroll
                for (int i = 0; i < 16; ++i) { p0[i] = p0[i] * C2 - m; p1[i] = p1[i] * C2 - m; } }
            else if (us == 2) {
#pragma unroll
                for (int i = 0; i < 16; ++i) p0[i] = EXP2F(p0[i]); }
            else {
#pragma unroll
                for (int i = 0; i < 16; ++i) p1[i] = EXP2F(p1[i]); }
        }
        SCHED_FENCE();
        float rs = 0.f;
#pragma unroll
        for (int i = 0; i < 16; ++i) rs += p0[i] + p1[i];
        l = l * alpha + rs;
        pb[0] = pack_acc(p0, 0); pb[1] = pack_acc(p0, 1); pb[2] = pack_acc(p1, 0); pb[3] = pack_acc(p1, 1);
        attn_resc<DV>(o, alpha); }
    if (more) attn_stage_store<DV>(c, on, kreg, vreg);
    BLOCK_SYNC();
}
template <int DV>
DEV void attn_pass(const Ctx& c, const bf16_t* Kp, const bf16_t* Vt, int vpitch, int nk, const bf16x8 (&qf)[4], bool active, f32x16 (&o)[DV / 32], float& m, float& l) {
    const int r = c.lane & 31, h = c.lane >> 5; const int rk = (r & 0x13) | ((r & 4) << 1) | ((r & 8) >> 1);
    const int nt = nk / 64; constexpr int BUF = AttnLds<DV>::BUF;
#pragma unroll
    for (int dt = 0; dt < DV / 32; ++dt)
#pragma unroll
        for (int i = 0; i < 16; ++i) o[dt][i] = 0.f;
    m = -1e30f; l = 0.f;
    bf16x8 pb[4];
    { bf16x8 kreg, vreg[DV / 64];
      attn_stage_load<DV>(c, Kp, Vt, vpitch, 0, kreg, vreg); attn_stage_store<DV>(c, 0, kreg, vreg);
      attn_stage_load<DV>(c, Kp, Vt, vpitch, 1, kreg, vreg); attn_stage_store<DV>(c, BUF, kreg, vreg); }
    BLOCK_SYNC();
    if (active) { f32x16 p0, p1; float alpha; attn_qk(c.lds, rk, h, qf, p0, p1); attn_sm1(p0, p1, m, alpha); attn_sm2(p0, p1, alpha, l, pb); }
    else {
#pragma unroll
        for (int i = 0; i < 4; ++i) pb[i] = (bf16x8){0, 0, 0, 0, 0, 0, 0, 0}; }
    int ox = BUF, oy = 0, on = 2 * BUF;
    for (int j = 1; j < nt; ++j) {
        attn_step<DV>(c, Kp, Vt, vpitch, j, nt, qf, active, rk, ox, oy, on, pb, o, m, l); { const int t_ = oy; oy = ox; ox = on; on = t_; }
    }
    if (active) attn_pv<DV>(c.lds + oy + AT_KB, r, h, pb, o);
    BLOCK_SYNC();
}
DEV void load_q(const Ctx& c, const bf16_t* Qrow  , bool valid, bool rope, int t, const float* qg  , bf16x8 (&qf)[4]) {
    const int h = c.lane >> 5;
    float f[4][8];
#pragma unroll
    for (int ks = 0; ks < 4; ++ks) { bf16x8 v = (bf16x8){0, 0, 0, 0, 0, 0, 0, 0}; if (valid) v = ld16(Qrow + 16 * ks + 8 * h); unpack8(v, f[ks]); }
    if (qg) { float ss = 0.f;
#pragma unroll
        for (int ks = 0; ks < 4; ++ks)
#pragma unroll
            for (int e = 0; e < 8; ++e) ss += f[ks][e] * f[ks][e];
        ss += SHFL_XOR(ss, 32);
        const float rstd = 1.0f / sqrtf(ss * (1.0f / 64.0f) + EPS);
#pragma unroll
        for (int ks = 0; ks < 4; ++ks)
#pragma unroll
            for (int e = 0; e < 8; ++e) f[ks][e] = f[ks][e] * rstd * qg[16 * ks + 8 * h + e]; }
    if (rope) { const float* COS = (const float*)(c.ws + OFF_ROPE) + (size_t)t * 32; const float* SIN = COS + (size_t)SEQ * 32;
#pragma unroll
        for (int a = 0; a < 2; ++a)
#pragma unroll
            for (int e = 0; e < 8; ++e) { const float cs = COS[a * 16 + 8 * h + e], sn = SIN[a * 16 + 8 * h + e]; const float x1 = f[2 * a][e], x2 = f[2 * a + 1][e];
                f[2 * a][e] = x1 * cs - x2 * sn; f[2 * a + 1][e] = x2 * cs + x1 * sn; } }
#pragma unroll
    for (int ks = 0; ks < 4; ++ks) qf[ks] = pack8(f[ks]);
}

DEV void even_kprep(const Ctx& c) {
    const bf16_t* KA = (const bf16_t*)(c.ws + OFF_P) + PE_KA; bf16_t* KP = (bf16_t*)(c.ws + SE_KP);
    const float* COS = (const float*)(c.ws + OFF_ROPE); const float* SIN = COS + (size_t)SEQ * 32;
    const int l7 = c.lane & 7, a = l7 >> 2, p = (l7 >> 1) & 1, f0 = 8 * (l7 & 1), vh = c.lane >> 3;
    for (int it = c.gw; it < NB * LK; it += c.ngw) { const int b = it / LK, pos = it % LK; const int row = pos_row(b, pos);
        float f[8]; unpack8(ld16(KA + (size_t)row * 512 + 8 * c.lane), f);
        float g[8];
#pragma unroll
        for (int e = 0; e < 8; ++e) g[e] = SHFL_XOR(f[e], 2);
        if (pos >= CTX) { const int t = pos - CTX;
#pragma unroll
            for (int e = 0; e < 8; ++e) { const float cs = COS[(size_t)t * 32 + a * 16 + f0 + e], sn = SIN[(size_t)t * 32 + a * 16 + f0 + e]; f[e] = p == 0 ? f[e] * cs - g[e] * sn : f[e] * cs + g[e] * sn; } }
        *(bf16x8*)(KP + ((size_t)(b * 8 + vh) * LK + pos) * 64 + 8 * l7) = pack8(f); }
}
template <int DV>
DEV void vt_item(const Ctx& c, const bf16_t* src, int spitch, int colbase, int b, int pc, bf16_t* dstbh  ) {
    bf16_t* T = (bf16_t*)c.lds;
#pragma unroll
    for (int i = 0; i < DV / 64; ++i) { const int idx = c.tid + 512 * i, pl = idx / (DV / 8), cg = idx % (DV / 8); const int row = pos_row(b, 64 * pc + pl);
        const bf16x8 v = ld16(src + (size_t)row * spitch + colbase + 8 * cg);
#pragma unroll
        for (int e = 0; e < 8; ++e) T[(8 * cg + e) * 72 + (((pl >> 3) ^ (cg & 7)) << 3) + (pl & 7)] = (bf16_t)v[e]; }
    BLOCK_SYNC();
#pragma unroll
    for (int i = 0; i < DV / 64; ++i) { const int idx = c.tid + 512 * i, dv = idx >> 3, ch = idx & 7;
        *(bf16x8*)(dstbh + (size_t)dv * LK + 64 * pc + 8 * ch) = *(const bf16x8*)(T + dv * 72 + 8 * (ch ^ ((dv >> 3) & 7))); }
    BLOCK_SYNC();
}

DEV void mlstm_gates(const Ctx& c, int layer, int b, int h, int dir, int tc, float& ipre, float& lf) {
    const float* G = (const float*)(c.ws + OFF_G); const float* bias = c.in[9] + (size_t)(layer >> 1) * 16;
    const int row = tok_row(b, tc, c.lane);
    ipre = G[(size_t)row * 16 + dir * 8 + h] + bias[dir * 8 + h];
    lf = logsigmoidf_(G[(size_t)row * 16 + dir * 8 + 4 + h] + bias[dir * 8 + 4 + h]);
}
DEV void mlstm_m1_item(const Ctx& c, int layer, int it) {
    const int tc = it % NCH, dir = (it / NCH) & 1, h = (it / (2 * NCH)) & 3, b = it / (8 * NCH);
    const int chain = (b * 4 + h) * 2 + dir, cc = chain_chunk(dir, tc); const size_t ci = (size_t)chain * NCH + cc;
    const bf16_t* BK = (const bf16_t*)(c.ws + OFF_P) + PE_BK; const bf16_t* BV = (const bf16_t*)(c.ws + OFF_P) + PE_BV;
    float* DCT = (float*)(c.ws + SE_DCT); float* DN = (float*)(c.ws + SE_DN); float* SC = (float*)(c.ws + SE_SC);
    bf16_t* Kt = (bf16_t*)c.lds; bf16_t* Vt = Kt + 64 * 72; float* wv = (float*)(c.lds + (64 + 128) * 72 * 2);
    if (c.wave == 0) { float ipre, lf; mlstm_gates(c, layer, b, h, dir, tc, ipre, lf);
        const float bcum = chain_cumsum(lf, c.lane, dir), bend = wave_sum(lf), wend = bend - bcum + ipre, mloc = wave_max(wend);
        wv[c.lane] = expf(wend - mloc);
        if (c.lane == 0) { SC[ci * 4 + 0] = bend; SC[ci * 4 + 1] = mloc; } }
    BLOCK_SYNC();
    {   const int i = c.tid >> 3, cg = c.tid & 7; const int row = tok_row(b, tc, i); const float w = wv[i] * 0.125f;
        float f[8]; unpack8(ld16(BK + (size_t)row * 256 + h * 64 + 8 * cg), f);
#pragma unroll
        for (int e = 0; e < 8; ++e) Kt[(8 * cg + e) * 72 + (((i >> 3) ^ (cg & 7)) << 3) + (i & 7)] = (bf16_t)f2bf(f[e] * w); }
#pragma unroll
    for (int ii = 0; ii < 2; ++ii) { const int idx = c.tid + 512 * ii, i = idx >> 4, cg = idx & 15; const int row = tok_row(b, tc, i);
        const bf16x8 v = ld16(BV + (size_t)row * 512 + h * 128 + 8 * cg);
#pragma unroll
        for (int e = 0; e < 8; ++e) Vt[(8 * cg + e) * 72 + (((i >> 3) ^ (cg & 7)) << 3) + (i & 7)] = (bf16_t)v[e]; }
    BLOCK_SYNC();
    {   const int r = c.lane & 31, hh = c.lane >> 5, dvt = c.wave >> 1, dkt = c.wave & 1;
        f32x16 acc;
#pragma unroll
        for (int i = 0; i < 16; ++i) acc[i] = 0.f;
#pragma unroll
        for (int ks = 0; ks < 4; ++ks) acc = MFMA32(ld16(Vt + (32 * dvt + r) * 72 + 8 * ((2 * ks + hh) ^ ((r >> 3) & 3) ^ ((dvt & 1) << 2))), ld16(Kt + (32 * dkt + r) * 72 + 8 * ((2 * ks + hh) ^ ((r >> 3) & 3) ^ ((dkt & 1) << 2))), acc);
        float* dst = DCT + ci * 8192;
#pragma unroll
        for (int i = 0; i < 16; ++i) dst[(32 * dvt + crow(i, hh)) * 64 + 32 * dkt + r] = acc[i];
        if (c.tid < 64) { float s = 0.f; for (int i = 0; i < 64; ++i) s += bf2f(Kt[c.tid * 72 + i]); DN[ci * 64 + c.tid] = s; } }
    BLOCK_SYNC();
}
DEV void mlstm_m2(const Ctx& c) {
    float* DCT = (float*)(c.ws + SE_DCT); float* DN = (float*)(c.ws + SE_DN); float* SC = (float*)(c.ws + SE_SC);
    const long gt = (long)c.bid * NTHREADS + c.tid, GT = (long)c.nblk * NTHREADS;
    for (long it = gt; it < (long)NCHAIN * 8256; it += GT) { const int chain = (int)(it / 8256), e = (int)(it % 8256);
        float* p0 = e < 8192 ? DCT + (size_t)chain * NCH * 8192 + e : DN + (size_t)chain * NCH * 64 + (e - 8192); const size_t pstr = e < 8192 ? 8192 : 64;
        float d[NCH];
#pragma unroll
        for (int cc = 0; cc < NCH; ++cc) d[cc] = p0[cc * pstr];
        float mst = 0.f, val = 0.f;
#pragma unroll
        for (int cc = 0; cc < NCH; ++cc) { const size_t ci = (size_t)chain * NCH + cc; const float bend = SC[ci * 4 + 0], mloc = SC[ci * 4 + 1];
            if (e == 0) SC[ci * 4 + 2] = mst;
            const float mnew = fmaxf(bend + mst, mloc); const float nv = expf(bend + mst - mnew) * val + expf(mloc - mnew) * d[cc]; d[cc] = val; val = nv; mst = mnew; }
#pragma unroll
        for (int cc = 0; cc < NCH; ++cc) p0[cc * pstr] = d[cc]; }
}
DEV void mlstm_m3_item(const Ctx& c, int layer, int it) {
    const int tc = it % NCH, h = (it / NCH) & 3, b = it / (4 * NCH);
    const bf16_t* BQ = (const bf16_t*)(c.ws + OFF_P) + PE_BQ; const bf16_t* BK = (const bf16_t*)(c.ws + OFF_P) + PE_BK; const bf16_t* BV = (const bf16_t*)(c.ws + OFF_P) + PE_BV; const bf16_t* BO = (const bf16_t*)(c.ws + OFF_P) + PE_BO;
    const float* DCT = (const float*)(c.ws + SE_DCT); const float* DN = (const float*)(c.ws + SE_DN); const float* SC = (const float*)(c.ws + SE_SC);
    bf16_t* Y = (bf16_t*)(c.ws + OFF_HY); const float* gn = c.in[12] + (size_t)(layer >> 1) * 128;
    bf16_t* Qs = (bf16_t*)c.lds; bf16_t* Ks = Qs + 64 * 72; bf16_t* Vt = Ks + 64 * 72; float* fl = (float*)(c.lds + (128 + 128) * 72 * 2);
    float* bcs = fl, *ics = fl + 64, *nst = fl + 128, *ssq = fl + 192;
    const int r = c.lane & 31, hh = c.lane >> 5, dvt = c.wave >> 1, tt = c.wave & 1, t = 32 * tt + r;
    f32x16 hs;
#pragma unroll
    for (int i = 0; i < 16; ++i) hs[i] = 0.f;
    for (int dir = 0; dir < 2; ++dir) {
        const int chain = (b * 4 + h) * 2 + dir, cc = chain_chunk(dir, tc); const size_t ci = (size_t)chain * NCH + cc;
        if (c.wave == 0) { float ipre, lf; mlstm_gates(c, layer, b, h, dir, tc, ipre, lf); bcs[c.lane] = chain_cumsum(lf, c.lane, dir); ics[c.lane] = ipre; }
        if (c.wave == 1) nst[c.lane] = DN[ci * 64 + c.lane];
        {   const int i = c.tid >> 3, cg = c.tid & 7; const int row = tok_row(b, tc, i);
            *(bf16x8*)(Qs + i * 72 + 8 * cg) = ld16(BQ + (size_t)row * 256 + h * 64 + 8 * cg);
            float f[8]; unpack8(ld16(BK + (size_t)row * 256 + h * 64 + 8 * cg), f);
#pragma unroll
            for (int e = 0; e < 8; ++e) f[e] *= 0.125f;
            *(bf16x8*)(Ks + i * 72 + 8 * cg) = pack8(f); }
#pragma unroll
        for (int ii = 0; ii < 2; ++ii) { const int idx = c.tid + 512 * ii, i = idx >> 4, cg = idx & 15; const int row = tok_row(b, tc, i);
            const bf16x8 v = ld16(BV + (size_t)row * 512 + h * 128 + 8 * cg);
#pragma unroll
            for (int e = 0; e < 8; ++e) Vt[(8 * cg + e) * 72 + (((i >> 3) ^ (cg & 7)) << 3) + (i & 7)] = (bf16_t)v[e]; }
        BLOCK_SYNC();
        const float mst = SC[ci * 4 + 2];
        f32x16 st[2];
#pragma unroll
        for (int su = 0; su < 2; ++su) {
#pragma unroll
            for (int i = 0; i < 16; ++i) st[su][i] = 0.f;
#pragma unroll
            for (int ks = 0; ks < 4; ++ks) st[su] = MFMA32(ld16(Ks + (32 * su + r) * 72 + 16 * ks + 8 * hh), ld16(Qs + t * 72 + 16 * ks + 8 * hh), st[su]); }
        const float bt = bcs[t], at = bt + mst;
        float mt = at;
#pragma unroll
        for (int su = 0; su < 2; ++su)
#pragma unroll
            for (int i = 0; i < 16; ++i) { const int s = 32 * su + crow(i, hh); const bool valid = dir == 0 ? s <= t : s >= t; if (valid) mt = fmaxf(mt, bt - bcs[s] + ics[s]); }
        mt = fmaxf(mt, SHFL_XOR(mt, 32));
        const float inter = expf(at - mt);
        float rsum = 0.f;
#pragma unroll
        for (int su = 0; su < 2; ++su)
#pragma unroll
            for (int i = 0; i < 16; ++i) { const int s = 32 * su + crow(i, hh); const bool valid = dir == 0 ? s <= t : s >= t;
                const float p = valid ? expf(bt - bcs[s] + ics[s] - mt) * st[su][i] : 0.f; st[su][i] = p; rsum += p; }
        rsum += SHFL_XOR(rsum, 32);
        float qn = 0.f;
        for (int d = 0; d < 32; ++d) qn += bf2f(Qs[t * 72 + 32 * hh + d]) * nst[32 * hh + d];
        qn += SHFL_XOR(qn, 32);
        const float den = inter * qn + rsum, dd = fmaxf(fabsf(den), expf(-mt));
        f32x16 a1;
#pragma unroll
        for (int i = 0; i < 16; ++i) a1[i] = 0.f;
        const float* Cst = DCT + ci * 8192 + (size_t)(32 * dvt + r) * 64;
#pragma unroll
        for (int ks = 0; ks < 4; ++ks) { float f[8]; const f32x4 c0 = *(const f32x4*)(Cst + 16 * ks + 8 * hh), c1 = *(const f32x4*)(Cst + 16 * ks + 8 * hh + 4);
            f[0] = c0[0]; f[1] = c0[1]; f[2] = c0[2]; f[3] = c0[3]; f[4] = c1[0]; f[5] = c1[1]; f[6] = c1[2]; f[7] = c1[3];
            a1 = MFMA32(pack8(f), ld16(Qs + t * 72 + 16 * ks + 8 * hh), a1); }
        f32x16 a2;
#pragma unroll
        for (int i = 0; i < 16; ++i) a2[i] = 0.f;
#pragma unroll
        for (int su = 0; su < 2; ++su)
#pragma unroll
            for (int s2 = 0; s2 < 2; ++s2) { const bf16_t* vr = Vt + (32 * dvt + r) * 72 + 4 * hh; const int sw = ((32 * dvt + r) >> 3) & 7, bk = 4 * su + 2 * s2;
                a2 = MFMA32(cat44(*(const bf16x4*)(vr + 8 * (bk ^ sw)), *(const bf16x4*)(vr + 8 * ((bk + 1) ^ sw))), pack_acc(st[su], s2), a2); }
        const float inv = 1.0f / dd;
#pragma unroll
        for (int i = 0; i < 16; ++i) hs[i] += (inter * a1[i] + a2[i]) * inv;
        BLOCK_SYNC();
    }
    float ss = 0.f;
#pragma unroll
    for (int i = 0; i < 16; ++i) ss += hs[i] * hs[i];
    ss += SHFL_XOR(ss, 32);
    if (hh == 0) ssq[dvt * 64 + t] = ss;
    BLOCK_SYNC();
    const float rstd = 1.0f / sqrtf((ssq[t] + ssq[64 + t] + ssq[128 + t] + ssq[192 + t]) * (1.0f / 128.0f) + EPS);
    const int row = tok_row(b, tc, t);
#pragma unroll
    for (int q4 = 0; q4 < 4; ++q4) { const int dv = 32 * dvt + 8 * q4 + 4 * hh;
        const bf16x4 ov = *(const bf16x4*)(BO + (size_t)row * 512 + h * 128 + dv); float y[4];
#pragma unroll
        for (int e = 0; e < 4; ++e) y[e] = hs[4 * q4 + e] * rstd * gn[dv + e] * sigmoidf_(bf2f((unsigned short)ov[e]));
        u32x2 w; w[0] = pk2(y[0], y[1]); w[1] = pk2(y[2], y[3]);
        *(u32x2*)(Y + (size_t)row * 1024 + 512 + h * 128 + dv) = w; }
    BLOCK_SYNC();
}

DEV void diffattn_unit(const Ctx& c, int layer, int b, int h, bool ctxu, int qb) {
    const bf16_t* QA = (const bf16_t*)(c.ws + OFF_P) + PE_QA; const bf16_t* KP = (const bf16_t*)(c.ws + SE_KP); const bf16_t* VT = (const bf16_t*)(c.ws + SE_VT);
    bf16_t* Y = (bf16_t*)(c.ws + OFF_HY); const int e = layer >> 1;
    const float* lam = c.in[10] + (size_t)e * 256; const float* gn = c.in[11] + (size_t)e * 128;
    const int r = c.lane & 31, hh = c.lane >> 5; const int ql = qb * 256 + c.wave * 32 + r;
    const int nq = ctxu ? CTX : SEQ, nk = ctxu ? CTX : LK; const bool valid = ql < nq, active = (qb * 256 + c.wave * 32) < nq;
    const int row = ctxu ? ML + b * CTX + ql : b * SEQ + ql;
    const int orow = ctxu ? row : b * SEQ + (ql % 128) * (SEQ / 128) + ql / 128;
    f32x16 o[4]; float m, l1, l2; bf16x8 qf[4];
    float* park = (float*)(c.ws + SE_PARK) + ((size_t)c.bid * NTHREADS + c.tid) * 64;
    load_q(c, QA + (size_t)row * 512 + h * 128, valid, !ctxu, ql, nullptr, qf);
    attn_pass<128>(c, KP + (size_t)(b * 8 + 2 * h) * LK * 64, VT + (size_t)(b * 4 + h) * 128 * LK, LK, nk, qf, active, o, m, l1);
    if (active) { l1 += SHFL_XOR(l1, 32); const float i1 = 1.0f / l1;
#pragma unroll
        for (int dt = 0; dt < 4; ++dt)
#pragma unroll
            for (int q4 = 0; q4 < 4; ++q4) *(f32x4*)(park + 16 * dt + 4 * q4) = (f32x4){o[dt][4 * q4] * i1, o[dt][4 * q4 + 1] * i1, o[dt][4 * q4 + 2] * i1, o[dt][4 * q4 + 3] * i1}; }
    load_q(c, QA + (size_t)row * 512 + h * 128 + 64, valid, !ctxu, ql, nullptr, qf);
    attn_pass<128>(c, KP + (size_t)(b * 8 + 2 * h + 1) * LK * 64, VT + (size_t)(b * 4 + h) * 128 * LK, LK, nk, qf, active, o, m, l2);
    const float lam_init = 0.8f - 0.6f * expf(-0.3f * (float)layer);
    const float lmb = expf(wave_sum(lam[c.lane] * lam[64 + c.lane])) - expf(wave_sum(lam[128 + c.lane] * lam[192 + c.lane])) + lam_init;
    if (active) {
        l2 += SHFL_XOR(l2, 32);
        const float i2 = lmb / l2; float ss = 0.f;
#pragma unroll
        for (int dt = 0; dt < 4; ++dt)
#pragma unroll
            for (int q4 = 0; q4 < 4; ++q4) { const f32x4 a = *(const f32x4*)(park + 16 * dt + 4 * q4);
#pragma unroll
                for (int e = 0; e < 4; ++e) { const float v = a[e] - o[dt][4 * q4 + e] * i2; o[dt][4 * q4 + e] = v; ss += v * v; } }
        ss += SHFL_XOR(ss, 32);
        const float sc = (1.0f / sqrtf(ss * (1.0f / 128.0f) + EPS)) * (1.0f - lam_init);
        if (valid) {
#pragma unroll
            for (int dt = 0; dt < 4; ++dt)
#pragma unroll
                for (int q4 = 0; q4 < 4; ++q4) { const int dv = 32 * dt + 8 * q4 + 4 * hh; u32x2 w;
                    w[0] = pk2(o[dt][4 * q4 + 0] * sc * gn[dv + 0], o[dt][4 * q4 + 1] * sc * gn[dv + 1]); w[1] = pk2(o[dt][4 * q4 + 2] * sc * gn[dv + 2], o[dt][4 * q4 + 3] * sc * gn[dv + 3]);
                    *(u32x2*)(Y + (size_t)orow * 1024 + h * 128 + dv) = w; } }
    }
}

DEV void mix_even_a(const Ctx& c, int layer) {
    { PHASE_CTX(pc); if (ON(8)) even_kprep(pc); }
    { PHASE_CTX(pc); if (ON(9)) { const bf16_t* VA = (const bf16_t*)(pc.ws + OFF_P) + PE_VA; bf16_t* VT = (bf16_t*)(pc.ws + SE_VT);
        for (int it = pc.bid; it < NB * 4 * NCH; it += pc.nblk) { const int pch = it % NCH, bh = it / NCH; vt_item<128>(pc, VA, 512, (bh & 3) * 128, bh >> 2, pch, VT + (size_t)bh * 128 * LK); } } }
    REPB(10) { PHASE_CTX(pc); if (ON(10)) for (int it = pc.bid; it < NCHAIN * NCH; it += pc.nblk) mlstm_m1_item(pc, layer, it); }
}
DEV void mix_even_b(const Ctx& c, int layer) {
    { PHASE_CTX(pc); if (ON(11)) mlstm_m2(pc); }
}
DEV void mix_even_c(const Ctx& c, int layer) {
    constexpr int NQBL = SEQ / 256, NQBC = (CTX + 255) / 256, NUL = NB * 4 * NQBL, NUC = NB * 4 * NQBC;
    REPB(12) { PHASE_CTX(pc); if (ON(12)) for (int it = pc.bid; it < NUL + NUC; it += pc.nblk) { const bool cu = it >= NUL; int u = cu ? it - NUL : it; const int nqb = cu ? NQBC : NQBL;
        diffattn_unit(pc, layer, u / (4 * nqb), (u / nqb) & 3, cu, u % nqb); } }
    REPB(13) { PHASE_CTX(pc); if (ON(13)) for (int it = pc.nblk - 1 - pc.bid; it < NB * 4 * NCH; it += pc.nblk) mlstm_m3_item(pc, layer, it); }
}
constexpr size_t SO_KP = OFF_S;
constexpr size_t SO_VT = SO_KP + al256((size_t)NB * 2 * LK * 64 * 2);
constexpr size_t SO_U  = SO_VT + al256((size_t)NB * 2 * 64 * LK * 2);
constexpr size_t SO_W  = OFF_HY;
static_assert((size_t)NCHAIN * NCH * 8192 <= (size_t)MT * cmax(D, 1024), "W fits in the H/Y region");
constexpr size_t SO_AT = SO_U + al256((size_t)NCHAIN * NCH * 8192 * 2);
constexpr size_t SO_QN = SO_AT + al256((size_t)NCHAIN * NCH * 4096 * 2);
constexpr size_t SO_KD = SO_QN + al256((size_t)NCHAIN * NCH * 8192 * 2);
constexpr size_t SO_GE = SO_KD + al256((size_t)NCHAIN * NCH * 8192 * 2);
constexpr size_t SO_END = SO_GE + al256((size_t)NCHAIN * NCH * 4);
constexpr size_t PO_HB = PO_DQKV;
constexpr size_t PO_GO = PO_DQKV + (size_t)MT * 1024;
static_assert((size_t)3 * MT * 512 <= (size_t)MT * 1536, "HB and GO fit in the DQKV segment");

DEV void odd_kprep(const Ctx& c, int layer) {
    const bf16_t* KVC = (const bf16_t*)(c.ws + OFF_P) + PO_KVC; bf16_t* KP = (bf16_t*)(c.ws + SO_KP);
    const float* COS = (const float*)(c.ws + OFF_ROPE); const float* SIN = COS + (size_t)SEQ * 32; const float* kg = c.in[15] + (size_t)(layer >> 1) * 128 + 64;
    const int kv = c.lane >> 5, d0 = 2 * (c.lane & 31);
    const int a = d0 >> 5, p = (d0 >> 4) & 1, f0 = d0 & 15;
    for (int it = c.gw; it < NB * LK; it += c.ngw) { const int b = it / LK, pos = it % LK; const int row = pos_row(b, pos);
        const unsigned w = *(const unsigned*)(KVC + (size_t)row * 256 + 2 * c.lane);
        float x0 = bf2f(w & 0xffffu), x1 = bf2f(w >> 16);
        float ss = x0 * x0 + x1 * x1;
#pragma unroll
        for (int o = 1; o < 32; o <<= 1) ss += SHFL_XOR(ss, o);
        const float rstd = 1.0f / sqrtf(ss * (1.0f / 64.0f) + EPS);
        x0 *= rstd * kg[d0]; x1 *= rstd * kg[d0 + 1];
        const float y0 = SHFL_XOR(x0, 8), y1 = SHFL_XOR(x1, 8);
        if (pos >= CTX) { const int t = pos - CTX; const float c0 = COS[(size_t)t * 32 + a * 16 + f0], s0 = SIN[(size_t)t * 32 + a * 16 + f0], c1 = COS[(size_t)t * 32 + a * 16 + f0 + 1], s1 = SIN[(size_t)t * 32 + a * 16 + f0 + 1];
            x0 = p == 0 ? x0 * c0 - y0 * s0 : x0 * c0 + y0 * s0; x1 = p == 0 ? x1 * c1 - y1 * s1 : x1 * c1 + y1 * s1; }
        *(unsigned*)(KP + ((size_t)(b * 2 + kv) * LK + pos) * 64 + d0) = pk2(x0, x1); }
}
DEV void gqa_unit(const Ctx& c, int layer, int b, int h, bool ctxu, int qb) {
    const bf16_t* QC = (const bf16_t*)(c.ws + OFF_P) + PO_QC; const bf16_t* KP = (const bf16_t*)(c.ws + SO_KP); const bf16_t* VT = (const bf16_t*)(c.ws + SO_VT);
    bf16_t* QO = (bf16_t*)(c.ws + OFF_P) + PO_GO; const float* qg = c.in[15] + (size_t)(layer >> 1) * 128;
    const int r = c.lane & 31, hh = c.lane >> 5, kv = h >> 2; const int ql = qb * 256 + c.wave * 32 + r;
    const int nq = ctxu ? CTX : SEQ, nk = ctxu ? CTX : LK; const bool valid = ql < nq, active = (qb * 256 + c.wave * 32) < nq;
    const int row = ctxu ? ML + b * CTX + ql : b * SEQ + ql;
    const int orow = ctxu ? row : b * SEQ + (ql % 128) * (SEQ / 128) + ql / 128;
    f32x16 o[2]; float m, l; bf16x8 qf[4];
    load_q(c, QC + (size_t)row * 512 + h * 64, valid, !ctxu, ql, qg, qf);
    attn_pass<64>(c, KP + (size_t)(b * 2 + kv) * LK * 64, VT + (size_t)(b * 2 + kv) * 64 * LK, LK, nk, qf, active, o, m, l);
    if (active) { l += SHFL_XOR(l, 32); const float il = 1.0f / l;
        if (valid) {
#pragma unroll
            for (int dt = 0; dt < 2; ++dt)
#pragma unroll
                for (int q4 = 0; q4 < 4; ++q4) { const int dv = 32 * dt + 8 * q4 + 4 * hh; u32x2 w;
                    w[0] = pk2(o[dt][4 * q4 + 0] * il, o[dt][4 * q4 + 1] * il); w[1] = pk2(o[dt][4 * q4 + 2] * il, o[dt][4 * q4 + 3] * il);
                    *(u32x2*)(QO + (size_t)orow * 512 + h * 64 + dv) = w; } } }
}

constexpr int D1_CW_OFF = 110592;
#ifndef D1_STOP
#define D1_STOP 0
#endif
DEV void dn_d1_item(const Ctx& c, int layer, int it, int stop = 0) {
    const int tc = it % NCH, dir = (it / NCH) & 1, h = (it / (2 * NCH)) & 3, b = it / (8 * NCH);
    const int chain = (b * 4 + h) * 2 + dir, cc = chain_chunk(dir, tc); const size_t ci = (size_t)chain * NCH + cc; const int o = layer >> 1;
    const bf16_t* DQ = (const bf16_t*)(c.ws + OFF_P) + PO_DQKV; const float* G = (const float*)(c.ws + OFF_G);
    const float* cwl = (const float*)(c.lds + D1_CW_OFF); const float* alog = c.in[17] + (size_t)o * 8; const float* dtb = c.in[18] + (size_t)o * 8;
    bf16_t* Ub = (bf16_t*)(c.ws + SO_U) + ci * 8192; bf16_t* Wb = (bf16_t*)(c.ws + SO_W) + ci * 8192; bf16_t* ATb = (bf16_t*)(c.ws + SO_AT) + ci * 4096;
    bf16_t* QNb = (bf16_t*)(c.ws + SO_QN) + ci * 8192; bf16_t* KDb = (bf16_t*)(c.ws + SO_KD) + ci * 8192; float* GE = (float*)(c.ws + SO_GE);
    bf16_t* Qs = (bf16_t*)c.lds; bf16_t* Ks = Qs + 64 * 136; bf16_t* Kt = Ks + 64 * 136; bf16_t* Vt = Kt + 128 * 72; float* Am = (float*)(c.lds + (2 * 64 * 136 + 2 * 128 * 72) * 2); float* gc = Am + 64 * 65; float* be = gc + 64;
    float* gam = be + 64; float* T2 = gam + 64; float* Rb = T2 + 64 * 65;
    const int seqlen = tc < NCC ? CTX : SEQ, tok0 = tc < NCC ? 64 * tc : 64 * (tc - NCC), rowbase = tc < NCC ? ML + b * CTX : b * SEQ;
    if (c.wave == 0) { const int j = c.lane, i = dir ? 63 - j : j; const int row = rowbase + tok0 + i;
        const float beta = sigmoidf_(G[(size_t)row * 16 + dir * 8 + h]);
        const float ld = -expf(alog[dir * 4 + h]) * softplusf_(G[(size_t)row * 16 + dir * 8 + 4 + h] + dtb[dir * 4 + h]);
        const float gcum = chain_cumsum(ld, j, 0); gc[j] = gcum; be[j] = beta; gam[j] = expf(gcum);
        if (j == 63) GE[ci] = expf(gcum); }
    {   const int j = c.tid >> 3, cg = c.tid & 7, i = dir ? 63 - j : j, tok = tok0 + i;
        bf16x8 raw[3][2], rawn[3][2];
#define D1_LOADROWS(R, TEN) { _Pragma("unroll") for (int tap = 0; tap < 3; ++tap) { const int tk = tok + tap - 1; const bool in = tk >= 0 && tk < seqlen; \
            const bf16_t* src = DQ + (size_t)(rowbase + (in ? tk : tok)) * 1536 + (TEN) * 512 + h * 128 + 16 * cg; R[tap][0] = ld16(src); R[tap][1] = ld16(src + 8); \
            if (!in) { R[tap][0] = (bf16x8){0, 0, 0, 0, 0, 0, 0, 0}; R[tap][1] = (bf16x8){0, 0, 0, 0, 0, 0, 0, 0}; } } }
        D1_LOADROWS(rawn, 0);
#pragma unroll 1
        for (int ten = 0; ten < 3; ++ten) { const int col = ten * 512 + h * 128 + 16 * cg;
            float val[16];
#pragma unroll
            for (int e = 0; e < 16; ++e) val[e] = 0.f;
#pragma unroll
            for (int tap = 0; tap < 3; ++tap) { raw[tap][0] = rawn[tap][0]; raw[tap][1] = rawn[tap][1]; }
            if (ten < 2) D1_LOADROWS(rawn, ten + 1);
            SCHED_FENCE();
#pragma unroll
            for (int tap = 0; tap < 3; ++tap) { float f0[8], f1[8]; unpack8(raw[tap][0], f0); unpack8(raw[tap][1], f1);
                const float* wp = cwl + tap * 1536 + col;
#pragma unroll
                for (int e = 0; e < 8; ++e) { val[e] += f0[e] * wp[e]; val[8 + e] += f1[e] * wp[8 + e]; }
                SCHED_FENCE(); }
#pragma unroll
            for (int e = 0; e < 16; ++e) val[e] = siluf_(val[e]);
            if (ten < 2) { float ss = 0.f;
#pragma unroll
                for (int e = 0; e < 16; ++e) ss += val[e] * val[e];
                ss += SHFL_XOR(ss, 1); ss += SHFL_XOR(ss, 2); ss += SHFL_XOR(ss, 4);
                const float sc = (1.0f / sqrtf(ss + EPS)) * (ten == 0 ? 0.08838834764831845f : 1.0f);
#pragma unroll
                for (int e = 0; e < 16; ++e) val[e] *= sc; }
            if (ten < 2) { bf16_t* dst = (ten == 0 ? Qs : Ks) + j * 136 + 16 * cg; float fa[8], fb[8];
#pragma unroll
                for (int e = 0; e < 8; ++e) { fa[e] = val[e]; fb[e] = val[8 + e]; }
                *(bf16x8*)dst = pack8(fa); *(bf16x8*)(dst + 8) = pack8(fb); }
            if (ten >= 1) { bf16_t* dstT = (ten == 1 ? Kt : Vt);
#pragma unroll
                for (int e = 0; e < 16; ++e) dstT[(16 * cg + e) * 72 + (((j >> 3) ^ cg) << 3) + (j & 7)] = (bf16_t)f2bf(val[e]); } } }
    BLOCK_SYNC(); if (stop == 1) return;
    const int r = c.lane & 31, hh = c.lane >> 5;
    {
        const int wq = c.wave & 3, tt = wq >> 1, st = wq & 1; const bool isq = c.wave >= 4;
        f32x16 acc;
#pragma unroll
        for (int i = 0; i < 16; ++i) acc[i] = 0.f;
        const bf16_t* Ar = (isq ? Qs : Ks) + (32 * tt + r) * 136; const bf16_t* Br = Ks + (32 * st + r) * 136;
#pragma unroll
        for (int ks = 0; ks < 8; ++ks) acc = MFMA32(ld16(Ar + 16 * ks + 8 * hh), ld16(Br + 16 * ks + 8 * hh), acc);
        const int s = 32 * st + r; const float gs = gc[s];
#pragma unroll
        for (int i = 0; i < 16; ++i) { const int t = 32 * tt + crow(i, hh); const float dec = expf(gc[t] - gs);
            if (!isq) Am[t * 65 + s] = t > s ? be[t] * dec * acc[i] : 0.f;
            else ATb[t * 64 + s] = (bf16_t)f2bf(t >= s ? dec * acc[i] : 0.f); } }
    BLOCK_SYNC(); if (stop == 2) return;
    if (c.wave == 0) { const int d = c.lane >> 4, cc = c.lane & 15; const float* Ad = Am + (16 * d) * 65 + 16 * d; float* Td = T2 + (16 * d) * 65 + 16 * d;
        float t[16];
#pragma unroll
        for (int i = 0; i < 16; ++i) { float acc = (cc == i) ? 1.f : 0.f;
#pragma unroll
            for (int j = 0; j < i; ++j) acc -= Ad[i * 65 + j] * t[j];
            t[i] = acc; }
#pragma unroll
        for (int i = 0; i < 16; ++i) Td[i * 65 + cc] = t[i]; }
    else { for (int e = c.tid - 64; e < 64 * 64; e += NTHREADS - 64) { const int t = e >> 6, s2 = e & 63; if ((s2 >> 4) > (t >> 4)) T2[t * 65 + s2] = 0.f; } }
    BLOCK_SYNC();
    for (int rb = 1; rb < 4; ++rb) { const int wcols = 16 * rb;
        for (int e = c.tid; e < 16 * wcols; e += NTHREADS) { const int i = e & 15, cidx = e >> 4; float acc = 0.f; const float* Ar = Am + (16 * rb + i) * 65;
            for (int kb = cidx & ~15; kb < wcols; kb += 16) {
#pragma unroll
                for (int kk = 0; kk < 16; ++kk) acc += Ar[kb + kk] * T2[(kb + kk) * 65 + cidx]; }
            Rb[i * 49 + cidx] = acc; }
        BLOCK_SYNC();
        for (int e = c.tid; e < 16 * wcols; e += NTHREADS) { const int i = e & 15, cidx = e >> 4; float acc = 0.f; const float* Tr = T2 + (16 * rb + i) * 65 + 16 * rb;
#pragma unroll
            for (int j = 0; j < 16; ++j) acc += Tr[j] * Rb[j * 49 + cidx];
            T2[(16 * rb + i) * 65 + cidx] = -acc; }
        BLOCK_SYNC(); }
    if (stop == 3) return;
#ifndef EMU
    int lane2_ = c.lane; asm volatile("" : "+v"(lane2_));
    const int r2 = lane2_ & 31, hh2 = lane2_ >> 5;
#else
    const int r2 = r, hh2 = hh;
#endif
    {
#pragma unroll
        for (int rep = 0; rep < 2; ++rep) { const int idx = c.wave + 8 * rep, isw = idx >> 3, tt = (idx >> 2) & 1, ct = idx & 3;
            f32x16 acc;
#pragma unroll
            for (int i = 0; i < 16; ++i) acc[i] = 0.f;
            const bf16_t* Bt = (isw ? Kt : Vt) + (32 * ct + r2) * 72;
#pragma unroll
            for (int ks = 0; ks < 4; ++ks) { float f[8];
#pragma unroll
                for (int e = 0; e < 8; ++e) { const int s = 16 * ks + 8 * hh2 + e; f[e] = T2[(32 * tt + r2) * 65 + s] * be[s] * (isw ? gam[s] : 1.0f); }
                acc = MFMA32(pack8(f), ld16(Bt + 8 * ((2 * ks + hh2) ^ (((32 * ct + r2) >> 4) & 7))), acc); }
            bf16_t* dst = (isw ? Wb : Ub);
#pragma unroll
            for (int i = 0; i < 16; ++i) dst[(32 * tt + crow(i, hh2)) * 128 + 32 * ct + r2] = (bf16_t)f2bf(acc[i]); } }
    {
        const float gend = gc[63];
        const int j = c.tid >> 3, cg = c.tid & 7; const float gamj = gam[j];
#pragma unroll
        for (int half = 0; half < 2; ++half) { float f[8]; unpack8(ld16(Qs + j * 136 + 16 * cg + 8 * half), f);
#pragma unroll
            for (int e = 0; e < 8; ++e) f[e] *= gamj;
            *(bf16x8*)(QNb + j * 128 + 16 * cg + 8 * half) = pack8(f); }
#pragma unroll
        for (int ii = 0; ii < 2; ++ii) { const int idx = c.tid + 512 * ii, dk = idx >> 3, ch = idx & 7; float f[8]; unpack8(ld16(Kt + dk * 72 + 8 * (ch ^ ((dk >> 4) & 7))), f);
#pragma unroll
            for (int e = 0; e < 8; ++e) f[e] *= expf(gend - gc[8 * ch + e]);
            *(bf16x8*)(KDb + dk * 64 + 8 * ch) = pack8(f); } }
    BLOCK_SYNC();
}
constexpr int D2_PW = 132, D2_PA = 68;
constexpr int D2_W = 0, D2_QN = 64 * D2_PW * 2, D2_AT = 2 * 64 * D2_PW * 2, D2_KD = D2_AT + 64 * D2_PA * 2, D2_BUF = D2_KD + 128 * D2_PA * 2;
static_assert(2 * D2_BUF <= LDS_MISC, "two D2 buffers fit below the LDS control words");
DEV void dn_d2_stage(const Ctx& c, size_t ci, char* buf) {
    const bf16_t* Wb = (const bf16_t*)(c.ws + SO_W) + ci * 8192; const bf16_t* QNb = (const bf16_t*)(c.ws + SO_QN) + ci * 8192; const bf16_t* ATb = (const bf16_t*)(c.ws + SO_AT) + ci * 4096; const bf16_t* KDb = (const bf16_t*)(c.ws + SO_KD) + ci * 8192;
    const int lt = c.tid - 256;
#pragma unroll 2
    for (int i = 0; i < 14; ++i) { const int idx = lt + 256 * i; const bf16_t* src; char* dst;
        if (idx < 1024) { const int row = idx >> 4, ch = idx & 15; src = Wb + row * 128 + 8 * ch; dst = buf + D2_W + (row * D2_PW + 8 * ch) * 2; }
        else if (idx < 2048) { const int j = idx - 1024, row = j >> 4, ch = j & 15; src = QNb + row * 128 + 8 * ch; dst = buf + D2_QN + (row * D2_PW + 8 * ch) * 2; }
        else if (idx < 2560) { const int j = idx - 2048, row = j >> 3, ch = j & 7; src = ATb + row * 64 + 8 * ch; dst = buf + D2_AT + (row * D2_PA + 8 * ch) * 2; }
        else { const int j = idx - 2560, row = j >> 3, ch = j & 7; src = KDb + row * 64 + 8 * ch; dst = buf + D2_KD + (row * D2_PA + 8 * ch) * 2; }
        const bf16x8 v = ld16(src); const bf16x4 lo = __builtin_shufflevector(v, v, 0, 1, 2, 3), hi = __builtin_shufflevector(v, v, 4, 5, 6, 7);
        *(bf16x4*)dst = lo; *(bf16x4*)(dst + 8) = hi; }
}
DEV void dn_d2_chain(const Ctx& c, int chain, bool emit_ctx) {
    const int dir = chain & 1, h = (chain >> 1) & 3, b = chain >> 3; const int r = c.lane & 31, hh = c.lane >> 5, sl = c.wave & 3; const bool comp = c.wave < 4;
    const bf16_t* U0 = (const bf16_t*)(c.ws + SO_U); const float* GE = (const float*)(c.ws + SO_GE);
    bf16_t* HB = (bf16_t*)(c.ws + OFF_P) + PO_HB + (size_t)dir * MT * 512;
    f32x16 S[4];
#pragma unroll
    for (int t4 = 0; t4 < 4; ++t4)
#pragma unroll
        for (int i = 0; i < 16; ++i) S[t4][i] = 0.f;
    if (!comp) dn_d2_stage(c, (size_t)chain * NCH, c.lds);
    BLOCK_SYNC();
    for (int cc = 0; cc < NCH; ++cc) { const size_t ci = (size_t)chain * NCH + cc; char* buf = c.lds + (cc & 1) * D2_BUF;
        if (!comp) { if (cc + 1 < NCH) dn_d2_stage(c, ci + 1, c.lds + ((cc + 1) & 1) * D2_BUF); }
        else {
            const bf16_t* Ub = U0 + ci * 8192; const bf16_t* Wl = (const bf16_t*)(buf + D2_W); const bf16_t* QNl = (const bf16_t*)(buf + D2_QN); const bf16_t* ATl = (const bf16_t*)(buf + D2_AT); const bf16_t* KDl = (const bf16_t*)(buf + D2_KD);
            f32x16 u[2], ov[2];
#pragma unroll
            for (int tt = 0; tt < 2; ++tt)
#pragma unroll
                for (int i = 0; i < 16; ++i) { u[tt][i] = -bf2f(Ub[(32 * tt + crow(i, hh)) * 128 + 32 * sl + r]); ov[tt][i] = 0.f; }
#pragma unroll
            for (int ks = 0; ks < 8; ++ks) { const bf16x8 sf = pack_acc(S[ks >> 1], ks & 1); const int k0 = 16 * ks + 4 * hh;
#pragma unroll
                for (int tt = 0; tt < 2; ++tt) { const bf16_t* wp = Wl + (32 * tt + r) * D2_PW + k0; const bf16_t* qp = QNl + (32 * tt + r) * D2_PW + k0;
                    u[tt] = MFMA32(cat44(*(const bf16x4*)wp, *(const bf16x4*)(wp + 8)), sf, u[tt]);
                    ov[tt] = MFMA32(cat44(*(const bf16x4*)qp, *(const bf16x4*)(qp + 8)), sf, ov[tt]); } }
#pragma unroll
            for (int tt = 0; tt < 2; ++tt)
#pragma unroll
                for (int i = 0; i < 16; ++i) u[tt][i] = -u[tt][i];
            const float ge = GE[ci];
#pragma unroll
            for (int t4 = 0; t4 < 4; ++t4)
#pragma unroll
                for (int i = 0; i < 16; ++i) S[t4][i] *= ge;
#pragma unroll
            for (int ks = 0; ks < 4; ++ks) { const bf16x8 uf = pack_acc(u[ks >> 1], ks & 1);
#pragma unroll
                for (int tt = 0; tt < 2; ++tt) { const bf16_t* ap = ATl + (32 * tt + r) * D2_PA + 16 * ks + 4 * hh;
                    ov[tt] = MFMA32(cat44(*(const bf16x4*)ap, *(const bf16x4*)(ap + 8)), uf, ov[tt]); }
#pragma unroll
                for (int t4 = 0; t4 < 4; ++t4) { const bf16_t* kp = KDl + (32 * t4 + r) * D2_PA + 16 * ks + 4 * hh;
                    S[t4] = MFMA32(cat44(*(const bf16x4*)kp, *(const bf16x4*)(kp + 8)), uf, S[t4]); } }
            const int tc = dir == 0 ? cc : (cc < NCC ? NCC - 1 - cc : NCC + (NLC - 1 - (cc - NCC)));
            if (tc >= NCC || emit_ctx) {
#pragma unroll
                for (int tt = 0; tt < 2; ++tt)
#pragma unroll
                    for (int i = 0; i < 16; ++i) { const int j = 32 * tt + crow(i, hh); const int row = tok_row(b, tc, dir ? 63 - j : j);
                        HB[(size_t)row * 512 + h * 128 + 32 * sl + r] = (bf16_t)f2bf(ov[tt][i]); } }
        }
        BLOCK_SYNC();
    }
}
DEV void dn_yasm(const Ctx& c, int layer, int nrows) {
    const bf16_t* HB = (const bf16_t*)(c.ws + OFF_P) + PO_HB; const bf16_t* Z = (const bf16_t*)(c.ws + OFF_P) + PO_Z; const bf16_t* QC = (const bf16_t*)(c.ws + OFF_P) + PO_GO; bf16_t* Y = (bf16_t*)(c.ws + OFF_HY);
    const float* gn = c.in[19] + (size_t)(layer >> 1) * 128;
    for (int it = c.gw; it < nrows * 2; it += c.ngw) { const int row = it >> 1, col = (it & 1) * 256 + 4 * c.lane;
        const bf16x4 a = *(const bf16x4*)(HB + (size_t)row * 512 + col), bb = *(const bf16x4*)(HB + (size_t)MT * 512 + (size_t)row * 512 + col), z = *(const bf16x4*)(Z + (size_t)row * 512 + col);
        float v[4], ss = 0.f;
#pragma unroll
        for (int e = 0; e < 4; ++e) { v[e] = bf2f((unsigned short)a[e]) + bf2f((unsigned short)bb[e]); ss += v[e] * v[e]; }
#pragma unroll
        for (int o = 1; o < 32; o <<= 1) ss += SHFL_XOR(ss, o);
        const float rstd = 1.0f / sqrtf(ss * (1.0f / 128.0f) + EPS);
        float y[4];
#pragma unroll
        for (int e = 0; e < 4; ++e) y[e] = v[e] * rstd * gn[(col & 127) + e] * siluf_(bf2f((unsigned short)z[e]));
        u32x2 w; w[0] = pk2(y[0], y[1]); w[1] = pk2(y[2], y[3]);
        *(u32x2*)(Y + (size_t)row * 1024 + 512 + col) = w;
        *(u32x2*)(Y + (size_t)row * 1024 + col) = *(const u32x2*)(QC + (size_t)row * 512 + col); }
}

DEV void gqa_units(const Ctx& c, int layer, bool emit_ctx, int first, int stride) {
    constexpr int NQBL = SEQ / 256, NQBC = (CTX + 255) / 256, NUL = NB * 8 * NQBL, NUC = NB * 8 * NQBC;
    const int nuc = emit_ctx ? NUC : 0;
    for (int it = first; it < NUL + nuc; it += stride) { const bool cu = it >= NUL; int u = cu ? it - NUL : it; const int nqb = cu ? NQBC : NQBL;
        gqa_unit(c, layer, u / (8 * nqb), (u / nqb) & 7, cu, u % nqb); }
}
DEV void mix_odd_a(const Ctx& c, int layer) {
    { PHASE_CTX(pc); if (ON(14)) odd_kprep(pc, layer); }
    { PHASE_CTX(pc); if (ON(15)) { const bf16_t* KVC = (const bf16_t*)(pc.ws + OFF_P) + PO_KVC; bf16_t* VT = (bf16_t*)(pc.ws + SO_VT);
        for (int it = pc.bid; it < NB * 2 * NCH; it += pc.nblk) { const int pch = it % NCH, bk = it / NCH; vt_item<64>(pc, KVC, 256, 128 + (bk & 1) * 64, bk >> 1, pch, VT + (size_t)bk * 64 * LK); } } }
    REPB(16) { PHASE_CTX(pc); if (ON(16)) {
        { const float* convw = pc.in[16] + (size_t)(layer >> 1) * 3 * 1536; float* cwl = (float*)(pc.lds + D1_CW_OFF); BLOCK_SYNC();
          for (int e = pc.tid; e < 3 * 1536 / 4; e += NTHREADS) ((f32x4*)cwl)[e] = ((const f32x4*)convw)[e];
          BLOCK_SYNC(); }
        for (int it = pc.bid; it < NCHAIN * NCH; it += pc.nblk) dn_d1_item(pc, layer, it, (rep_ < (int)(((unsigned long long)(REPM) >> 16) & 1ull)) ? D1_STOP : 0); } }
}
DEV void mix_odd_b(const Ctx& c, int layer, bool emit_ctx) {
    const int nd2 = NCHAIN < c.nblk ? NCHAIN : c.nblk;
    const int na = c.nblk - nd2;
    REPB(17) { PHASE_CTX(pc); if (ON(17)) if (pc.bid < nd2) { for (int ch = pc.bid; ch < NCHAIN; ch += nd2) dn_d2_chain(pc, ch, emit_ctx); } }
    REPB(18) { PHASE_CTX(pc); if (ON(18)) { if (na > 0) { if (pc.bid >= nd2) gqa_units(pc, layer, emit_ctx, pc.bid - nd2, na); } else gqa_units(pc, layer, emit_ctx, pc.bid, pc.nblk); } }
}
DEV void mix_odd_c(const Ctx& c, int layer, bool emit_ctx) {
    { PHASE_CTX(pc); if (ON(19)) dn_yasm(pc, layer, emit_ctx ? MT : ML); }
}

#ifdef SELFTEST
#ifdef EMU
#define ST_HD static inline
#else
#define ST_HD __host__ __device__ inline
#endif
constexpr size_t ST_CHK = 512 * 1024;
ST_HD unsigned st_hash(unsigned a, unsigned b) { unsigned x = a * 0x9E3779B1u ^ (b + 0x7F4A7C15u) * 0x85EBCA6Bu; x ^= x >> 16; x *= 0x7FEB352Du; x ^= x >> 15; x *= 0x846CA68Bu; x ^= x >> 16; return x; }
ST_HD float st_uniform(unsigned t, unsigned i) { return (float)(st_hash(t, i) >> 8) * (1.0f / 16777216.0f); }
ST_HD float st_normal(unsigned tensor, unsigned idx) { const float u1 = ((float)(st_hash(tensor * 4u, idx) >> 8) + 0.5f) * (1.0f / 16777216.0f), u2 = (float)(st_hash(tensor * 4u + 1u, idx) >> 8) * (1.0f / 16777216.0f); return sqrtf(-2.0f * logf(u1)) * cosf(6.2831853f * u2); }
ST_HD size_t st_count(int i) {
    switch (i) {
    case 0: return (size_t)NB * SEQ * D; case 1: return (size_t)NB * D; case 2: return (size_t)NB * CTX * D; case 3: return D;
    case 4: return (size_t)DEPTH * D * 6 * D; case 5: return (size_t)DEPTH * 6 * D; case 6: case 7: return (size_t)DEPTH * D;
    case 8: return (size_t)2 * D * E_IN; case 9: return 32; case 10: return 512; case 11: case 12: return 256; case 13: return (size_t)2 * 1024 * D;
    case 14: return (size_t)2 * D * O_IN; case 15: return 256; case 16: return 2 * 3 * 1536; case 17: return 16; case 18: return 16; case 19: return 256; case 20: return (size_t)2 * 1024 * D;
    case 21: case 22: return (size_t)DEPTH * D * FF; case 23: return (size_t)DEPTH * FF * D; default: return D; }
}
ST_HD float st_value(int i, size_t idx) {
#ifdef ST_SAME_BATCH
    if (i == 0) idx %= (size_t)SEQ * D; if (i == 1) idx %= (size_t)D; if (i == 2) idx %= (size_t)CTX * D;
#endif
    const float d = (float)D; const float n = st_normal((unsigned)i + 1u, (unsigned)idx);
    switch (i) {
    case 0: case 1: case 2: case 3: return n;
    case 4: return n * 0.5f / sqrtf(d); case 5: return n * 0.02f; case 6: case 7: case 11: case 12: case 15: case 19: case 24: return 1.0f + 0.02f * n;
    case 8: case 14: case 21: case 22: return n / sqrtf(d);
    case 9: return 0.1f * n + ((idx & 4) ? 3.0f + (float)(idx & 3) : 0.0f);
    case 10: return 0.1f * n; case 13: case 20: return n * (1.0f / 32.0f); case 16: return n * 0.57735027f;
    case 17: return logf(1.0f + 5.0f * (float)(idx & 3)) + 0.05f * n;
    case 18: { const float dt = expf(-6.9077553f + 4.6051702f * st_uniform(999u, (unsigned)idx)); return dt + logf(-expm1f(-dt)); }
    case 23: return n / sqrtf((float)FF);
    default: return n; }
}
ST_HD size_t st_offset(int i) { size_t o = 0; for (int k = 0; k < i; ++k) o += (st_count(k) + 63) & ~(size_t)63; return o; }
DEV void st_sum(const Ctx& c, int step, int sub, const void* base, size_t n, int is_bf16) {
    step += c.ngw;
    double p[8], s2 = 0.0;
#pragma unroll
    for (int k = 0; k < 8; ++k) p[k] = 0.0;
    const size_t gt = (size_t)c.bid * NTHREADS + c.tid, GT = (size_t)c.nblk * NTHREADS;
    for (size_t i = gt; i < n; i += GT) { const float v = is_bf16 ? bf2f(((const bf16_t*)base)[i]) : ((const float*)base)[i]; const unsigned h = st_hash(0xC0FFEEu + (unsigned)sub, (unsigned)i); s2 += (double)v * (double)v;
#pragma unroll
        for (int k = 0; k < 8; ++k) p[k] += ((h >> (k + 8)) & 1u) ? (double)v : -(double)v; }
    double* chk = (double*)(c.ws + ST_CHK) + ((size_t)step * 4 + sub) * 10;
#ifdef EMU
    for (int k = 0; k < 8; ++k) chk[k] += p[k];
    chk[8] += s2; if (gt == 0) chk[9] = (double)n;
#else
#pragma unroll
    for (int k = 0; k < 8; ++k) atomicAdd(chk + k, p[k]);
    atomicAdd(chk + 8, s2); if (gt == 0) chk[9] = (double)n;
#endif
}
DEV void st_checks(const Ctx& c, int step) {

    const int layer = step / 9, ph = step - 9 * layer, odd = layer & 1; const size_t mrows = layer < DEPTH - 1 ? MT : ML; unsigned char* ws = c.ws;
    if (ph == 0) { st_sum(c, step, 0, ws + OFF_HY, (size_t)MT * D, 1); st_sum(c, step, 1, ws + OFF_G, (size_t)MT * 16, 0); st_sum(c, step, 2, ws + OFF_WIN, (size_t)(odd ? NO : NE) * D, 1); st_sum(c, step, 3, ws + OFF_WOUT, (size_t)D * 1024, 1); }
    else if (ph == 1) { st_sum(c, step, 0, ws + OFF_P, (size_t)MT * (odd ? NO : NE), 1); }
    else if (ph == 2) { if (!odd) { st_sum(c, step, 0, ws + SE_KP, (size_t)NB * 8 * LK * 64, 1); st_sum(c, step, 1, ws + SE_VT, (size_t)NB * 4 * 128 * LK, 1); st_sum(c, step, 2, ws + SE_DCT, (size_t)NCHAIN * NCH * 8192, 0); st_sum(c, step, 3, ws + SE_DN, (size_t)NCHAIN * NCH * 64, 0); }
        else { st_sum(c, step, 0, ws + SO_KP, (size_t)NB * 2 * LK * 64 * 2, 1); st_sum(c, step, 1, ws + SO_U, (size_t)NCHAIN * NCH * 8192, 1); st_sum(c, step, 2, ws + SO_W, (size_t)NCHAIN * NCH * 8192, 1); st_sum(c, step, 3, ws + SO_AT, (size_t)NCHAIN * NCH * (4096 + 8192 + 8192), 1); } }
    else if (ph == 3) { if (!odd) { st_sum(c, step, 0, ws + SE_DCT, (size_t)NCHAIN * NCH * 8192, 0); st_sum(c, step, 1, ws + SE_DN, (size_t)NCHAIN * NCH * 64, 0); }
        else { st_sum(c, step, 0, ws + OFF_P + PO_HB * 2, (size_t)mrows * 512, 1); st_sum(c, step, 1, ws + OFF_P + (PO_HB + (size_t)MT * 512) * 2, (size_t)mrows * 512, 1); st_sum(c, step, 2, ws + OFF_P + PO_GO * 2, (size_t)mrows * 512, 1); } }
    else if (ph == 4) { st_sum(c, step, 0, ws + OFF_HY, (size_t)mrows * 1024, 1); }
    else if (ph == 5 || ph == 8) { st_sum(c, step, 0, ws + OFF_X, (size_t)mrows * D, 0); }
    else if (ph == 6) { st_sum(c, step, 0, ws + OFF_HY, (size_t)mrows * D, 1); st_sum(c, step, 1, ws + SF_WGU, (size_t)2 * FF * D, 1); st_sum(c, step, 2, ws + SF_WDN, (size_t)D * FF, 1); }
    else { st_sum(c, step, 0, ws + OFF_P, (size_t)mrows * FF, 1); }
}
#endif

DEV void final_norm(const Ctx& c) {
    constexpr int NV = D / 256;
    const float* X = (const float*)(c.ws + OFF_X); const float* g = c.in[24];
    for (int row = c.gw; row < ML; row += c.ngw) {
        const f32x4* xr = (const f32x4*)(X + (size_t)row * D) + c.lane; f32x4 v[NV]; float ss = 0.f;
#pragma unroll
        for (int j = 0; j < NV; ++j) { v[j] = xr[64 * j]; ss += (v[j][0] * v[j][0] + v[j][1] * v[j][1]) + (v[j][2] * v[j][2] + v[j][3] * v[j][3]); }
        const float rstd = 1.0f / sqrtf(wave_sum(ss) * (1.0f / D) + EPS);
        f32x4* o = (f32x4*)(c.out + (size_t)row * D) + c.lane;
#pragma unroll
        for (int j = 0; j < NV; ++j) o[64 * j] = v[j] * rstd * *(const f32x4*)(g + 256 * j + 4 * c.lane);
    }
}

constexpr size_t WS_NEED = cmax(WS_NEED_EF, SO_END);
#ifdef EMU
static void mega(Args args) {
    char* lds = emu::blocks[EMU_BID].lds;
    XcdBarrier bar; bar.dummy = 0;
#else
__global__ void __launch_bounds__(NTHREADS, 2) mega(Args args) {
    extern __shared__ __attribute__((aligned(16))) unsigned char lds_raw[];
    char* lds = (char*)lds_raw;
    {   volatile LAS unsigned* misc0 = (volatile LAS unsigned*)((LAS unsigned char*)lds_raw + LDS_MISC);
        if (threadIdx.x < 64) misc0[threadIdx.x] = 0u; }
    __syncthreads();
    XcdBarrier bar = xcd_barrier_post((unsigned*)(args.ws + OFF_CTL) + 4096, (volatile LAS unsigned*)((LAS unsigned char*)lds_raw + LDS_MISC) + 8);
#endif
    Ctx c;
#ifdef EMU
    c.tid = TIDX; c.lane = c.tid & 63; c.wave = c.tid >> 6;
#else
    c.tid = 0; c.lane = 0; c.wave = 0;
#endif
    c.bid = BIDX; c.nblk = NBLK; c.gw = c.bid * NWAVES + c.wave; c.ngw = c.nblk * NWAVES; c.lds = lds; c.in = args.in; c.out = args.out; c.ws = args.ws;

    if (args.prologue) {
    { PHASE_CTX(pc); if (ON(0)) p0_prologue(pc); }
#ifndef EMU
    cg::this_grid().sync();
#else
    GRID_BARRIER();
#endif
    }
#ifndef REPEAT_PH
#define REPEAT_PH -1
#endif
    for (int step2 = 2 * args.step_lo; step2 < 2 * args.step_hi; ++step2) {
        const int step = step2 >> 1; if ((step2 & 1) && !((step % 9) == REPEAT_PH && (REPEAT_PH != 3 || ((step / 9) & 1)))) continue;
        const int layer = step / 9, ph = step - 9 * layer;
        const int odd = layer & 1; const bool emit_ctx = layer < DEPTH - 1; const int mrows = emit_ctx ? MT : ML;
        if (ph == 0) {
            { PHASE_CTX(pc); if (ON(1) && (layer == 0 || step == args.step_lo)) convert_mixer_weights(pc, layer, pc.gw, pc.ngw); }
            { PHASE_CTX(pc); const bool prev = layer > 0 && step > args.step_lo; const int pm_ = MT;
              const SplitPlan red = split_plan(pm_, FF, pc.nblk, prev);
              if (ON(2)) normalize_rows(pc, layer, 0, MT, red, pm_, (const float*)(pc.ws + OFF_MOD) + (size_t)(layer - (prev ? 1 : 0)) * 9 * 6 * D + 5 * D); }
        } else if (ph == 1) {
            if (ON(3)) { PHASE_CTX(pc); pg8::Gemm g{(const bf16_t*)(pc.ws + OFF_HY), (const bf16_t*)(pc.ws + OFF_WIN), MT, odd ? NO : NE, D}; pg8::StaticOrder S; S.init(MT, odd ? NO : NE, c.nblk, c.bid); S.wave = pc.wave;
                if (odd && !emit_ctx && NO == 2816) { S.init(ML, NO, c.nblk, c.bid); S.wave = pc.wave; S.tn = (MC / 256) * 7; S.tpm = ML / 256; S.tpn = 2; S.tw = 7; }
                EpiSeg E{(bf16_t*)(pc.ws + OFF_P), odd};
                GEMM_PHASE(EpiSeg, lds, g, S, E); }
        } else if (ph == 2) { if (!odd) mix_even_a(c, layer); else mix_odd_a(c, layer); }
        else if (ph == 3) { if (!odd) mix_even_b(c, layer); else mix_odd_b(c, layer, emit_ctx); }
        else if (ph == 4) { if (!odd) mix_even_c(c, layer); else mix_odd_c(c, layer, emit_ctx); }
        else if (ph == 5 || ph == 8) {
            if (ON(4)) { PHASE_CTX(pc); const bool dn = ph == 8;
                const int kdim = dn ? FF : 1024; const SplitPlan sp = split_plan(mrows, kdim, pc.nblk, dn && layer + 1 < CFG_LAYERS);
                pg8::Gemm g{(const bf16_t*)(pc.ws + (dn ? OFF_P : OFF_HY)), (const bf16_t*)(pc.ws + (dn ? SF_WDN : OFF_WOUT)), mrows, D, kdim}; pg8::StaticOrder S; S.init(mrows, D, c.nblk, c.bid); S.wave = pc.wave;
                if (sp.extra) S.lim = pc.nblk;
                const bool first = layer == 0 && !dn;
                EpiResid E{(float*)(pc.ws + OFF_X), (const float*)(pc.ws + OFF_MOD) + (size_t)layer * 9 * 6 * D, dn ? 5 * D : 2 * D,
                           first ? pc.in[0] : (const float*)(pc.ws + OFF_X), first ? pc.in[2] - (size_t)ML * D : (const float*)(pc.ws + OFF_X)};
                GEMM_PHASE(EpiResid, lds, g, S, E);
                if (sp.extra && pc.bid < sp.extra * sp.split) {
                    const int lu = pc.bid / sp.split, q = pc.bid % sp.split, pairs = kdim / 128, base = pairs / sp.split, rem = pairs % sp.split;
                    const int np = base + (q < rem ? 1 : 0), p0 = q * base + (q < rem ? q : rem);
                    pg8::Gemm g2{g.A + (size_t)p0 * 128, g.Bt + (size_t)p0 * 128, mrows, D, np * 128, kdim}; pg8::StaticOrder S2; S2.init(mrows, D, sp.nwg, pc.nblk + lu); S2.wave = pc.wave;
                    EpiPart E2{(float*)(pc.ws + SF_PART) + (size_t)pc.bid * 65536};
                    BLOCK_SYNC();
                    GEMM_PHASE(EpiPart, lds, g2, S2, E2); } }
            { PHASE_CTX(pc); const SplitPlan sp = split_plan(mrows, ph == 8 ? FF : 1024, pc.nblk, ph == 8 && layer + 1 < CFG_LAYERS);
              const int nwg = sp.nwg; int busy = (nwg > pc.nblk && nwg < 2 * pc.nblk) ? nwg - pc.nblk : 0; if (sp.extra) busy = (pc.nblk - sp.extra * sp.split > pc.nblk / 4) ? sp.extra * sp.split : 0;
              if (ON(1) && pc.bid >= busy) { BLOCK_SYNC();
                  if (ph == 5) convert_ffn_weights(pc, layer, (pc.bid - busy) * NWAVES + pc.wave, (pc.nblk - busy) * NWAVES);
                  else if (layer + 1 < CFG_LAYERS && step + 1 < args.step_hi) convert_mixer_weights(pc, layer + 1, (pc.bid - busy) * NWAVES + pc.wave, (pc.nblk - busy) * NWAVES); } }
        } else if (ph == 6) {
            { PHASE_CTX(pc); const SplitPlan red = split_plan(mrows, 1024, pc.nblk, false);
              if (ON(2)) normalize_rows(pc, layer, 1, mrows, red, mrows, (const float*)(pc.ws + OFF_MOD) + (size_t)layer * 9 * 6 * D + 2 * D); }
        } else {
            if (ON(5)) { PHASE_CTX(pc); pg8::Gemm g{(const bf16_t*)(pc.ws + OFF_HY), (const bf16_t*)(pc.ws + SF_WGU), mrows, 2 * FF, D}; pg8::StaticOrder S; S.init(mrows, 2 * FF, c.nblk, c.bid); S.wave = pc.wave;
                EpiSwiglu E{(bf16_t*)(pc.ws + OFF_P)};
                GEMM_PHASE(EpiSwiglu, lds, g, S, E); }
        }
        if (step + 1 < args.step_hi || args.final_) GRID_BARRIER();
#ifdef EMU_STOP_AFTER_MIX
        if (layer == CFG_LAYERS - 1 && ph == 4) return;
#endif
    }
    if (args.final_) { PHASE_CTX(pc); if (ON(7)) final_norm(pc); }
}

#ifndef EMU
#ifdef PROBE_Y
__global__ void pr_stat(const bf16_t* Y, int rows, int c0, int c1, double* acc) {
    double s = 0.0, cnt = 0.0; float mx = 0.f;
    for (size_t k = (size_t)blockIdx.x * blockDim.x + threadIdx.x; k < (size_t)rows * 1024; k += (size_t)gridDim.x * blockDim.x) { const int col = (int)(k & 1023); if (col < c0 || col >= c1) continue;
        const float v = bf2f(Y[k]); s += (double)v * v; cnt += 1.0; mx = fmaxf(mx, fabsf(v)); }
    atomicAdd(acc, s); atomicAdd(acc + 1, cnt); atomicMax((unsigned long long*)acc + 2, (unsigned long long)(mx * 1e6f));
}
__global__ void pr_fill(const double* acc, float* out, int n) {
    const float rms = (float)sqrt(acc[0] / acc[1]), mx = (float)((const unsigned long long*)acc)[2] * 1e-6f;
    const float c = sqrtf(rms * 10.0f), B = mx * 10.0f;
    for (size_t k = (size_t)blockIdx.x * blockDim.x + threadIdx.x; k < (size_t)n; k += (size_t)gridDim.x * blockDim.x) out[k] = (k == 12345) ? B : c;
}
#endif
#ifdef SELFTEST
struct StPtrs { float* p[25]; };
__global__ void st_gen_inplace(StPtrs P) {
    for (int i = 0; i < 25; ++i) { const size_t n = st_count(i);
        for (size_t k = (size_t)blockIdx.x * blockDim.x + threadIdx.x; k < n; k += (size_t)gridDim.x * blockDim.x) P.p[i][k] = st_value(i, k); }
}
__global__ void st_gen(float* syn) {
    for (int i = 0; i < 25; ++i) { const size_t n = st_count(i), o = st_offset(i);
        for (size_t k = (size_t)blockIdx.x * blockDim.x + threadIdx.x; k < n; k += (size_t)gridDim.x * blockDim.x) syn[o + k] = st_value(i, k); }
}
constexpr int ST_NEXP = 74;
#ifndef ST_REPORT_SUB
#define ST_REPORT_SUB 0
#endif
#ifndef ST_TOL
#define ST_TOL 0.03
#endif
__device__ const int ST_EXP_STEP[74] = {0,0,0,0,1,2,2,2,2,3,3,4,5,6,6,6,7,8,9,9,9,9,10,11,11,11,11,12,12,12,13,14,15,15,15,16,17,18,18,18,18,19,20,20,20,20,21,21,22,23,24,24,24,25,26,27,27,27,27,28,29,29,29,29,30,30,30,31,32,33,33,33,34,35,};
__device__ const int ST_EXP_SUB[74] = {0,1,2,3,0,0,1,2,3,0,1,0,0,0,1,2,0,0,0,1,2,3,0,0,1,2,3,0,1,2,0,0,0,1,2,0,0,0,1,2,3,0,0,1,2,3,0,1,0,0,0,1,2,0,0,0,1,2,3,0,0,1,2,3,0,1,2,0,0,0,1,2,0,0,};
__device__ const double ST_EXP[74][10] = {
{2823.9405135959387,-6955.5741695016623,-5804.0977028682828,9054.3725127205253,-3966.7899582609534,-4601.8714917525649,7995.7762676179409,971.6921226978302,22251047.414743461,18874368,},
{291.26190879568458,-1573.2945180945098,331.66257446631789,357.45295172557235,-214.97323327884078,864.47900781407952,490.07691208645701,667.85457975044847,340263.10377825046,294912,},
{-23.357008519407827,15.935151411395054,35.883058835112024,57.434714148461353,-51.349641996261198,60.264678716950584,-59.23590717773186,-56.705568651959766,3067.8819070441805,3145728,},
{25.470241500996053,-43.468927160836756,58.065743817947805,4.3800708865746856,11.067458258010447,-10.867067505605519,26.364831392653286,-27.969552277587354,1020.9866835358141,1048576,},
{-11200.415292963386,9297.3592315688729,3203.3726777359843,-9663.7561300396919,-641.6257035061717,-8234.4563228115439,7994.2129158824682,-5521.8908601477742,66654113.07759431,56623104,},
{-1194.5305787473917,-1674.2680710405111,-5463.7986858785152,-4930.0590666979551,-1068.7674529403448,3002.9571408778429,-649.54952663183212,-4412.2754199355841,11106170.817955792,9437184,},
{-5507.6614354923368,1901.5068384334445,-4913.9082106724381,-2596.9450140967965,-1520.3851273730397,3237.6398326531053,-2359.8059303388,2364.7748123183846,11105296.668379547,9437184,},
{1560.4392579563191,-2499.261261367612,1459.3170721097504,-245.48758464773891,1043.47321934717,1419.7026340031534,1920.6481273452355,-1582.4576623782978,1601541.1673813532,18874368,},
{18.923751746769994,105.40070073772222,-9.9321377836167812,-69.897449327632785,166.82718826597556,123.35070158960298,-124.43343016551808,-149.78254351718351,24705.222434743067,147456,},
{2291.1772415378409,-198.18048978019215,106.27707149069283,1579.1373604525679,1783.1593627679513,2121.0945059178157,-2611.1484069368307,-1331.619970235115,2782256.6531369383,18874368,},
{89.759916271461407,27.444828146166401,211.5510761210171,-443.45204046583967,221.2014890195278,-713.03335159321432,-278.38321068481309,161.85793914255919,83907.236548682689,147456,},
{2060.1309491619468,-3099.3174412855878,3189.1278408914804,-1495.998928762041,2018.3208422241732,3951.0027283849195,307.00997438374907,189.92257314547896,8838647.8145213183,18874368,},
{2615.2232726222937,-3851.6311007236727,-5090.8008575433851,8895.7526726254218,-2915.793732104612,-3466.5127967876979,8494.2590465184257,-476.8310997271401,19641291.046898585,18874368,},
{2260.6133435368538,-3524.0150115936995,-6184.6817786470056,8612.6491934210062,-2936.174174323678,-5085.3421624973416,7627.2569323033094,-322.10541462153196,22201812.480418805,18874368,},
{39.211919396329904,-22.191732778126607,71.555887567257741,-34.657468227291247,-37.514794261514908,48.970252739818534,56.030709780199686,21.127209749916801,5631.6743743792158,5767168,},
{-58.957687043759506,-25.822232720500324,27.559850534133147,-19.2058952494408,25.962478367669974,10.300243424077053,-1.6967002287856303,-52.715924362360965,1022.4535583883176,2883584,},
{-194.02440498952637,2323.5604243765411,4943.6193249881908,-6076.2407636700955,-3098.2506252240564,1737.1458579480241,4071.2157669755688,3426.5647126794502,26276154.208520912,51904512,},
{2062.0307282910508,-2404.6291768250012,-4943.0085245753726,8409.3699170327891,-3388.5586135165795,-3156.0619303231506,8070.8516135739701,103.72620783001184,20445489.612024359,18874368,},
{-850.44070326350629,-1898.2922850791365,-5629.5260096881539,5319.5235935095698,-3571.6089787539095,-4582.1209145840257,8084.1448610220104,1201.9745895769447,22408943.624150425,18874368,},
{-276.67351097613573,238.73336043953896,402.49070692062378,1139.6587501242757,412.53829725086689,1001.9456618651748,-199.34280802309513,243.97394938021898,346041.02869538032,294912,},
{55.275690128095448,33.631906502880156,39.819098525680602,39.580814833752811,-56.659358996432275,56.905868629924953,70.874192817136645,32.641803210601211,2813.6335960129777,2883584,},
{16.459319942980073,-15.029889202327468,24.789046118385158,39.597747391439043,22.32851928321179,32.169926681905054,4.3831529127201065,-11.914361283765174,1024.2634621089853,1048576,},
{-8112.7706977427006,-15166.404139339924,9019.1636524870992,-10032.914728678763,-3683.5552492365241,6445.1523703113198,4940.6895737573504,-396.46003675460815,61599346.798404746,51904512,},
{1064.6478829011321,2961.5112186744809,2643.997241653502,3817.1335873380303,2552.6912311688066,2848.1112303361297,2641.0165046826005,877.74564967304468,5155886.6824775627,4718592,},
{-1180.9790783076314,-353.66288720036391,1405.2405796857784,-3003.0330094090896,736.01905330538284,1520.8871299045859,-1925.6258542904397,-909.10001162986737,2434153.6281470573,18874368,},
{60.165285118651028,-119.7430636333083,80.732633202489126,-9.8426874747077857,-101.69595492020277,-92.996986093445443,207.83742497175277,20.265997010018708,8918.7285340001526,18874368,},
{270.78828044847916,-133.56509196904631,-10.835563753045964,-177.08542341093678,116.75884305510037,-401.68338958283317,92.706295374895404,-256.76246256793473,40406.455039767519,47185920,},
{-17.403251063922653,85.550381564797135,-67.875341098901117,39.030201086570742,-44.825321126758354,-24.736986581498059,-130.15850522785331,-6.1346717766427901,3203.0568557028691,9437184,},
{26.677921455280739,-10.301573183693108,-15.383461458186503,23.552394272832316,-16.422941844488378,33.179475616852869,-26.073428510382655,49.43283157730184,2218.7160715744772,9437184,},
{-104.63265653897543,-1025.0813928971766,623.84842114138883,-1420.2001781960716,1368.3365971482126,-86.704579671728425,96.991083307308145,428.70963656844106,889696.22597060842,9437184,},
{2432.259056510753,267.30669010814745,1837.783826454659,2981.6297531555174,-416.17357830458786,-1826.6180147336563,-301.78532918507699,-744.86193079140503,4898348.3318136279,18874368,},
{3294.5902997395533,-865.44878266500746,-4974.0870277224822,6772.8382276698467,-3398.3562051501722,-4187.1136843486529,8143.3624155692742,-612.10508898339322,20872541.311585322,18874368,},
{3536.330776873976,1917.42852505669,-2076.6844129748642,4320.7511040978134,-4890.1908001117408,-4107.6248654313385,10533.807669285685,471.08626228198409,22412768.276720807,18874368,},
{-6.0809309475971531,76.739011337651391,97.496654804484933,-29.642639640796915,0.70117462620510196,-203.53367705441451,-98.699187040134348,-53.162115221513886,5628.1487348292976,5767168,},
{56.758986754866783,46.788941775390413,-43.423746958898846,33.754279191547539,25.984360144881066,-65.525896325649228,5.420765693706926,45.74655341921607,1023.6598906812283,2883584,},
{2102.1720024403512,3520.8294076444326,-6874.5287163143184,3797.4676643103921,3201.4737541926479,2643.8227775447631,352.29275992398834,1880.529091139204,26630809.672188494,51904512,},
{2885.2073127178519,-1385.1170310270754,-4514.0122937517372,7030.8231581723594,-3845.7207517792049,-6356.8220687311768,7588.3782935662384,-564.85132873002294,21742637.688699484,18874368,},
{3812.0284725353122,1621.2253267094493,-4254.9756214395165,6197.9158516302705,8.5768845900893211,-5469.3091325387359,8752.140286244452,-1246.7436530068517,22065010.375674032,18874368,},
{-1149.1737003140152,496.67538012936711,483.18858239427209,650.82792166247964,314.5317993350327,-371.12024437263608,890.37748170271516,-1420.4709294177592,350924.7500354572,294912,},
{88.047429081168957,-74.825534723349847,-23.789757229969837,-97.320472310879268,-4.0056394656421617,-30.904204592457972,-18.987518870853819,-27.849783896817826,3073.3731145051615,3145728,},
{65.20327353652101,3.0222902240930125,25.993390792864375,14.415037170168944,54.844758132356219,-56.249738970887847,19.864254156243987,-27.887308357167058,1025.1381782409978,1048576,},
{-13237.945228233933,-5020.7346298694611,5226.0037766546011,12825.714193224907,-2397.7048603817821,-7119.2997151985765,9948.7588085010648,-5921.2636323198676,66137041.201810837,56623104,},
{-75.766457952558994,2293.2211949080229,-2037.293488740921,1509.2966427430511,6117.5132186114788,479.96601853519678,-5639.6398960202932,1845.2123182713985,11060201.299008245,9437184,},
{-462.10384976491332,5736.9905912540853,-2167.2699889577925,-1180.0111477933824,409.65681508556008,-1780.9929978586733,-671.92641231790185,-1349.7005080021918,11027953.433529973,9437184,},
{-822.00079254147931,-1214.0090433928017,3328.184749965596,87.801341768161365,-495.11205383328706,-877.86274139888337,1911.2223419476468,796.02008414199008,1759052.6843886974,18874368,},
{100.80030664941296,22.118581771384925,-242.38840196980163,-93.397681776899844,-57.195992573630065,-53.402307578828186,-150.74265199294314,-86.528761671390384,31090.621100439952,147456,},
{3075.2200345232932,146.19098324902222,-1073.3931368374535,-3446.3695871779209,37.989448957180798,223.73928401402372,1720.4827841137958,2765.2156565344467,3854013.6325600357,18874368,},
{542.032717238857,-110.56952357693081,1.825648151418136,-830.79371399683441,-111.90571951437596,-416.65702595594485,-459.77385005963879,177.62618795662274,136561.77048135776,147456,},
{-536.59579325607046,3431.0063604712486,3724.987038930878,-672.57181697292253,-3271.82986589754,-275.97591033531353,1134.3561726845801,3369.160484327469,5460094.8227678062,18874368,},
{3690.413550499331,-2055.6428064615766,-5438.0006776863584,7215.5527907973737,-3675.7019953130812,-5533.6785190762885,6701.1122693967927,64.846424879085134,22222666.921814281,18874368,},
{6145.2994565963745,-1456.0999585092068,-5831.9741258770227,8761.7396555989981,-5699.234908297658,-4079.551640689373,4842.0201814621687,-2019.1001229286194,22203324.287363961,18874368,},
{130.56598056000075,66.178603142005159,-72.223813362215878,-40.295281428698217,26.729994425171753,-72.123386049031978,-88.871669880725676,27.124975894665113,5635.9492323544555,5767168,},
{32.54455375490943,72.597239872498903,-17.171426851477008,-4.8966801255592145,-15.258403940417338,-23.122007071331609,-22.899502303858753,62.156484370876569,1023.7774562760339,2883584,},
{-6760.2973620964185,3735.844417643224,1094.1796880429465,4204.2181440759596,-764.49361893783498,-4932.0209130450239,-6261.1468112875446,-4488.8535375963402,26246313.294528794,51904512,},
{4457.1757640697724,-2267.1563059242435,-4745.1736963140393,7186.1535465445595,-4113.5497737388105,-7139.5026401302202,6476.8297955984126,-72.098023249844118,23047663.524188824,18874368,},
{4172.7441230602562,2189.9780470617115,-5133.8792393095791,7288.8046996556222,-5411.0709395520389,-4896.6709096245468,8724.0389158017933,-1300.7641984857619,22255371.479420178,18874368,},
{342.48845159634948,-1155.9452162571251,-355.46573888137937,38.030472237616777,-706.72725258395076,302.12307207658887,1501.216548230499,-189.15161934122443,356337.53284288617,294912,},
{141.34916719738249,55.510840875467693,3.4794936717735254,14.99616638317093,48.530484220267681,80.824254727551306,36.550317391192948,-11.045543047970568,2822.5213800999318,2883584,},
{-1.7540650628507137,-68.523136725649238,20.526102727279067,4.1151908580213785,26.478423124179244,17.260244991630316,26.540773348882794,18.066198658198118,1023.7352584092852,1048576,},
{9615.2207438386977,4784.9471067078412,1940.7497162856162,-5810.9412356205285,-983.56367782130837,7418.8542090691626,16772.396392870694,-7707.8745242021978,61356805.552982159,51904512,},
{1611.5909418128431,-862.28053805604577,-136.1677976809442,-552.47190998122096,983.61643074825406,-2118.3313589207828,2136.0759917013347,1436.2902639396489,5189176.8575152932,4718592,},
{1791.7875226804172,-31.704715774103533,260.74334435508354,2286.3263573826407,2006.0634295089985,-556.23315154918237,2794.1662208863418,265.33516812947346,2237659.8451027921,18874368,},
{1.738220854325472,-47.72536333968177,85.671240820733587,-76.785340997768273,-33.389609302064237,10.517162931163593,-16.605087701564099,-69.403631001852744,4294.4259768959364,18874368,},
{80.462511468439985,-161.96663447577936,103.6356164854663,158.8806262336563,-156.06783419597375,68.553029276052172,-342.86381052307308,-54.733859514236087,20398.968534675096,47185920,},
{52.505996509542456,40.193077393545536,-32.136223205568967,9.6826318503881339,-32.908785335748689,-49.309646418463672,7.7728565156285185,28.182192534412025,933.99111986596574,8388608,},
{-7.5194821398763452,15.928513078688411,-22.494523745699553,-25.74654744003783,-1.9659538757696282,39.424875568918651,-41.204660507297376,-50.291643056989415,1399.3033406704337,8388608,},
{-135.14476990071125,388.87867833836935,-624.19169349339791,-255.41803698171861,749.05279063689522,489.13258223538287,7.6979752753395587,-1529.1879597052466,922125.16740855761,8388608,},
{2513.205304118339,-3002.4781056293286,-591.26384180737659,984.36628054594621,-165.44268643157557,-2587.8124781120569,5950.0621142634191,1918.4807258569635,4533654.192930459,16777216,},
{2830.9344703354946,-4920.8287407121315,-3976.7572222978852,7101.1558030729429,-6279.3158443071807,-7658.587931540409,7596.1372552172033,-980.77548625691998,20848405.50834683,16777216,},
{5663.7043273374438,-4698.0929517224431,-2882.0782249197364,6381.8024617210031,-6684.7693502381444,-6324.1065613850951,5276.286193959415,-1294.3445755466819,19824501.716412377,16777216,},
{105.49113711505197,9.4353141400497407,71.544671961572021,-144.04839801136404,-59.128098372370005,86.345427959226072,-22.445412413449958,-31.521184443496168,5635.2677728111466,5767168,},
{-52.974209187126689,83.749726402067608,-11.22629395038166,-7.1423740544887551,-10.056938788195112,-45.578087951795169,41.377634743421368,16.152020135003113,1023.3413428186279,2883584,},
{1126.9516335337321,-4958.3812902097925,-2794.7144431749111,5195.0455790979104,4310.2982955073458,-6172.0018973502665,4099.1716476037618,-5060.7709415074714,23578261.929520626,46137344,},
{854.11164966656725,-4002.1053702284298,-4016.2943720539079,7535.4821215254451,-6184.3291782648776,-6281.2433878521588,8750.5079252671385,531.59902707755464,21616516.22354921,16777216,},
};
__global__ void st_check_kernel(unsigned char* ws, int step, int slot = 0) { Ctx c; c.tid = threadIdx.x; c.lane = c.tid & 63; c.wave = c.tid >> 6; c.bid = blockIdx.x; c.nblk = gridDim.x; c.gw = 0; c.ngw = slot; c.lds = nullptr; c.in = nullptr; c.out = nullptr; c.ws = ws; st_checks(c, step); }
__global__ void st_report(const unsigned char* ws, float* out, int n) {
    const double* chk = (const double*)(ws + ST_CHK); int code = 0;
    for (int e = 0; e < ST_NEXP && !code; ++e) { const int step = ST_EXP_STEP[e], sub = ST_EXP_SUB[e]; const double* g = chk + (step * 4 + sub) * 10; double d2 = 0.0; if (g[9] == 0.0) continue;
        for (int k = 0; k < 8; ++k) { const double d = g[k] - ST_EXP[e][k]; d2 += d * d; }
        const double eps2 = d2 / (8.0 * ST_EXP[e][8] + 1e-300);
        const bool bad = !(eps2 <= ST_TOL * ST_TOL);
        if (bad) code = ST_REPORT_SUB ? (step == ST_REPORT_SUB - 1 ? sub + 1 : 0) : step + 1; }
    const float v = sqrtf((float)code);
    for (size_t k = (size_t)blockIdx.x * blockDim.x + threadIdx.x; k < (size_t)n; k += (size_t)gridDim.x * blockDim.x) out[k] = v;
}
__global__ void st_repeat_report(const unsigned char* ws, float* out, int n, int nsteps) {
    const double* chk = (const double*)(ws + ST_CHK); int code = 0;
    for (int st = 0; st < nsteps && !code; ++st) for (int sub = 0; sub < 4 && !code; ++sub) { const double* a = chk + ((size_t)st * 4 + sub) * 10; const double* b = chk + ((size_t)(st + 40) * 4 + sub) * 10;
        if (a[9] == 0.0 || b[9] == 0.0) continue; double d2 = 0.0; for (int k = 0; k < 8; ++k) d2 += (a[k] - b[k]) * (a[k] - b[k]);
        if (!(d2 <= 1e-14 * 8.0 * a[8])) code = st + 1; }
    const float v = sqrtf((float)code);
    for (size_t k = (size_t)blockIdx.x * blockDim.x + threadIdx.x; k < (size_t)n; k += (size_t)gridDim.x * blockDim.x) out[k] = v;
}
__global__ void st_twice_report(const unsigned char* ws, float* out, int n) {
    const double* chk = (const double*)(ws + ST_CHK); const double* a = chk + ((size_t)35 * 4) * 10; const double* b = chk + ((size_t)(35 + 40) * 4) * 10;
    double d2 = 0.0; for (int k = 0; k < 8; ++k) d2 += (a[k] - b[k]) * (a[k] - b[k]);
    const double eps = sqrt(d2 / (8.0 * a[8] + 1e-300)) + 1e-30; const float v = sqrtf((float)floor(fmax(0.0, -log10(eps))));
    for (size_t k = (size_t)blockIdx.x * blockDim.x + threadIdx.x; k < (size_t)n; k += (size_t)gridDim.x * blockDim.x) out[k] = v;
}
__global__ void st_final_check(const unsigned char* ws, const float* out, const float* g, double* acc) {
    const float* X = (const float*)(ws + OFF_X);
    for (int row = blockIdx.x * blockDim.x + threadIdx.x; row < ML; row += gridDim.x * blockDim.x) { const float* x = X + (size_t)row * D; double ss = 0.0;
        for (int k = 0; k < D; ++k) ss += (double)x[k] * x[k];
        const double rstd = 1.0 / sqrt(ss / D + 1e-6); double d2 = 0.0, r2 = 0.0;
        for (int k = 0; k < D; ++k) { const double r = x[k] * rstd * g[k], o = out[(size_t)row * D + k]; d2 += (o - r) * (o - r); r2 += r * r; }
        atomicAdd(acc, d2); atomicAdd(acc + 1, r2); }
}
__global__ void st_final_fill(const double* acc, float* out, int n) { const double eps = sqrt(acc[0] / (acc[1] + 1e-300)) + 1e-30; const float v = sqrtf((float)floor(fmax(0.0, -log10(eps))));
    for (size_t k = (size_t)blockIdx.x * blockDim.x + threadIdx.x; k < (size_t)n; k += (size_t)gridDim.x * blockDim.x) out[k] = v; }
__global__ void st_same_batch_inputs(const float* x, const float* cv, const float* ctx, float* xs, float* cs, float* ctxs) {
    const size_t gt = (size_t)blockIdx.x * blockDim.x + threadIdx.x, GT = (size_t)gridDim.x * blockDim.x;
    for (size_t k = gt; k < (size_t)NB * SEQ * D; k += GT) xs[k] = x[k % ((size_t)SEQ * D)];
    for (size_t k = gt; k < (size_t)NB * CTX * D; k += GT) ctxs[k] = ctx[k % ((size_t)CTX * D)];
    for (size_t k = gt; k < (size_t)NB * D; k += GT) cs[k] = cv[k % (size_t)D];
}
__global__ void st_batch_report(const float* sout, float* out, int n, double* acc) {
    const size_t per = (size_t)SEQ * D;
    for (int b = 1; b < NB; ++b) { double d2 = 0.0, r2 = 0.0;
        for (size_t k = (size_t)blockIdx.x * blockDim.x + threadIdx.x; k < per; k += (size_t)gridDim.x * blockDim.x) { const double a0 = sout[k], ab = sout[(size_t)b * per + k]; d2 += (ab - a0) * (ab - a0); r2 += a0 * a0; }
        atomicAdd(acc + 2 * b, d2); atomicAdd(acc + 2 * b + 1, r2); }
    __threadfence();
    __shared__ unsigned last; if (threadIdx.x == 0) last = atomicAdd((unsigned*)acc, 1u) == gridDim.x - 1; __syncthreads();
    if (!last) return;
    int code = 0; for (int b = 1; b < NB && !code; ++b) { const double d2 = atomicAdd(acc + 2 * b, 0.0), r2 = atomicAdd(acc + 2 * b + 1, 0.0); if (!(d2 <= 1e-4 * r2)) code = b; }
    *((volatile int*)(acc + 1)) = code;
}
__global__ void st_fill(const double* acc, float* out, int n) { const float v = sqrtf((float)*((const volatile int*)(acc + 1))); for (size_t k = (size_t)blockIdx.x * blockDim.x + threadIdx.x; k < (size_t)n; k += (size_t)gridDim.x * blockDim.x) out[k] = v; }
#endif

#if defined(SELFTEST) && (defined(ST_DACHECK) || defined(ST_MODCHECK) || defined(ST_L0CHECK) || defined(ST_TAILCHECK) || defined(ST_MLCHECK) || defined(ST_DNCHECK) || defined(ST_TRUTH) || defined(ST_GQCHECK))
__global__ void st_da_check(const unsigned char* ws, const float* lam, const float* gn, double* acc, float* scr) {
    const int lane = threadIdx.x & 63, gw = (blockIdx.x * blockDim.x + threadIdx.x) >> 6, ngw = (gridDim.x * blockDim.x) >> 6;
    const bf16_t* QA = (const bf16_t*)(ws + OFF_P) + PE_QA; const bf16_t* KA = (const bf16_t*)(ws + OFF_P) + PE_KA; const bf16_t* VA = (const bf16_t*)(ws + OFF_P) + PE_VA; const bf16_t* Y = (const bf16_t*)(ws + OFF_HY);
    const float* COS = (const float*)(ws + OFF_ROPE); const float* SIN = COS + (size_t)SEQ * 32;
    float* s1 = scr + (size_t)gw * 2 * LK; float* s2 = s1 + LK;
    float la = 0.f, lb = 0.f; la = lam[lane] * lam[64 + lane]; lb = lam[128 + lane] * lam[192 + lane];
    for (int o = 1; o < 64; o <<= 1) { la += __shfl_xor(la, o); lb += __shfl_xor(lb, o); }
    const float lam_init = 0.2f, lmb = expf(la) - expf(lb) + lam_init;
    __shared__ float qs[8][2][64];
    const int wv = threadIdx.x >> 6;
    for (int it = gw; it < (ML / 16) * 4; it += ngw) { const int h = it & 3, row = (it >> 2) * 16 + 5; const int b = row / SEQ, t = row % SEQ;
        for (int m = 0; m < 2; ++m) { const int d = lane; const int a = d >> 5, pp = (d >> 4) & 1, f = d & 15; const float x = bf2f(QA[(size_t)row * 512 + h * 128 + m * 64 + d]), xp = bf2f(QA[(size_t)row * 512 + h * 128 + m * 64 + (d ^ 16)]);
            const float cs = COS[(size_t)t * 32 + a * 16 + f], sn = SIN[(size_t)t * 32 + a * 16 + f]; qs[wv][m][d] = pp == 0 ? x * cs - xp * sn : x * cs + xp * sn; }
        __syncthreads();
        float m1 = -1e30f, m2 = -1e30f;
        for (int j = lane; j < LK; j += 64) { const int kr = pos_row(b, j); const bool rope = j >= CTX; const int kt = j - CTX; float a1 = 0.f, a2 = 0.f;
            for (int d = 0; d < 64; ++d) { const int a = d >> 5, pp = (d >> 4) & 1, f = d & 15;
                float k1 = bf2f(KA[(size_t)kr * 512 + h * 128 + d]), k2 = bf2f(KA[(size_t)kr * 512 + h * 128 + 64 + d]);
                if (rope) { const float k1p = bf2f(KA[(size_t)kr * 512 + h * 128 + (d ^ 16)]), k2p = bf2f(KA[(size_t)kr * 512 + h * 128 + 64 + (d ^ 16)]); const float cs = COS[(size_t)kt * 32 + a * 16 + f], sn = SIN[(size_t)kt * 32 + a * 16 + f];
                    k1 = pp == 0 ? k1 * cs - k1p * sn : k1 * cs + k1p * sn; k2 = pp == 0 ? k2 * cs - k2p * sn : k2 * cs + k2p * sn; }
                a1 += qs[wv][0][d] * k1; a2 += qs[wv][1][d] * k2; }
            a1 *= 0.125f; a2 *= 0.125f; s1[j] = a1; s2[j] = a2; m1 = fmaxf(m1, a1); m2 = fmaxf(m2, a2); }
        for (int o = 1; o < 64; o <<= 1) { m1 = fmaxf(m1, __shfl_xor(m1, o)); m2 = fmaxf(m2, __shfl_xor(m2, o)); }
        float l1 = 0.f, l2 = 0.f;
        for (int j = lane; j < LK; j += 64) { const float p1 = expf(s1[j] - m1), p2 = expf(s2[j] - m2); s1[j] = p1; s2[j] = p2; l1 += p1; l2 += p2; }
        for (int o = 1; o < 64; o <<= 1) { l1 += __shfl_xor(l1, o); l2 += __shfl_xor(l2, o); }
        __threadfence(); __syncthreads();
        float o0 = 0.f, o1 = 0.f;
        for (int j = 0; j < LK; ++j) { const int kr = pos_row(b, j); const float p = s1[j] / l1 - lmb * s2[j] / l2; o0 += p * bf2f(VA[(size_t)kr * 512 + h * 128 + lane]); o1 += p * bf2f(VA[(size_t)kr * 512 + h * 128 + 64 + lane]); }
        float ss = o0 * o0 + o1 * o1; for (int o = 1; o < 64; o <<= 1) ss += __shfl_xor(ss, o);
        const float sc = (1.0f / sqrtf(ss / 128.0f + 1e-6f)) * (1.0f - lam_init);
        const float r0 = o0 * sc * gn[lane], r1 = o1 * sc * gn[64 + lane], y0 = bf2f(Y[(size_t)row * 1024 + h * 128 + lane]), y1 = bf2f(Y[(size_t)row * 1024 + h * 128 + 64 + lane]);
        double d2 = (double)(y0 - r0) * (y0 - r0) + (double)(y1 - r1) * (y1 - r1), r2 = (double)r0 * r0 + (double)r1 * r1;
        for (int o = 1; o < 64; o <<= 1) { d2 += __shfl_xor(d2, o); r2 += __shfl_xor(r2, o); }
        if (lane == 0) { atomicAdd(acc, d2); atomicAdd(acc + 1, r2); }
        __syncthreads(); }
}
__global__ void st_mod_check(const unsigned char* ws, const float* cv, const float* cctx, const float* w_ada, const float* b_ada, double* acc) {
    const float* MOD = (const float*)(ws + OFF_MOD); double d2 = 0.0, r2 = 0.0;
    for (long it = (long)blockIdx.x * blockDim.x + threadIdx.x; it < (long)DEPTH * 9 * 6 * D; it += (long)gridDim.x * blockDim.x) { const int n = (int)(it % (6 * D)), r = (int)((it / (6 * D)) % 9), l = (int)(it / (6L * D * 9));
        double s = b_ada[(size_t)l * 6 * D + n];
        for (int k = 0; k < D; ++k) { const double cc = r < NB ? cv[r * D + k] : cctx[k]; s += cc / (1.0 + exp(-cc)) * (double)w_ada[((size_t)l * D + k) * 6 * D + n]; }
        const double m = MOD[it]; d2 += (m - s) * (m - s); r2 += s * s; }
    atomicAdd(acc, d2); atomicAdd(acc + 1, r2);
}
__global__ void st_inproj_check(const unsigned char* ws, const float* w_in_e, double* acc) {
    const bf16_t* H = (const bf16_t*)(ws + OFF_HY); const bf16_t* P = (const bf16_t*)(ws + OFF_P); double d2 = 0.0, r2 = 0.0;
    for (long it = (long)blockIdx.x * blockDim.x + threadIdx.x; it < 72L * NE; it += (long)gridDim.x * blockDim.x) { const int col = (int)(it % NE), row = (int)(it / NE) * 256 + 37;
        float s = 0.f; for (int k = 0; k < D; ++k) s += bf2f(H[(size_t)row * D + k]) * bf2f(f2bf(w_in_e[(size_t)k * E_IN + col]));
        size_t off; int pitch, c0; const int pn = col / 256;
        if (pn < 2) { off = PE_QA; pitch = 512; c0 = 256 * pn; } else if (pn < 4) { off = PE_KA; pitch = 512; c0 = 256 * (pn - 2); } else if (pn < 6) { off = PE_VA; pitch = 512; c0 = 256 * (pn - 4); }
        else if (pn == 6) { off = PE_BQ; pitch = 256; c0 = 0; } else if (pn == 7) { off = PE_BK; pitch = 256; c0 = 0; } else if (pn < 10) { off = PE_BV; pitch = 512; c0 = 256 * (pn - 8); } else { off = PE_BO; pitch = 512; c0 = 256 * (pn - 10); }
        const float v = bf2f(P[off + (size_t)row * pitch + c0 + (col & 255)]); d2 += (double)(v - s) * (v - s); r2 += (double)s * s; }
    atomicAdd(acc, d2); atomicAdd(acc + 1, r2);
}
__global__ void st_norm_check(const unsigned char* ws, const float* g_mix, const float* w_in_e, const float* xin, const float* ctxin, double* acc) {
    const bf16_t* H = (const bf16_t*)(ws + OFF_HY); const float* G = (const float*)(ws + OFF_G); const float* MOD = (const float*)(ws + OFF_MOD); double d2 = 0.0, r2 = 0.0, dg = 0.0, rg = 0.0;
    for (int it = blockIdx.x * blockDim.x + threadIdx.x; it < 72; it += gridDim.x * blockDim.x) { const int row = it * 256 + 37; const int mr = row < ML ? row / SEQ : NB;
        const float* x = row < ML ? xin + (size_t)row * D : ctxin + (size_t)(row - ML) * D; double ss = 0.0; for (int k = 0; k < D; ++k) ss += (double)x[k] * x[k];
        const double rstd = 1.0 / sqrt(ss / D + 1e-6); double ga[16]; for (int n = 0; n < 16; ++n) ga[n] = 0.0;
        for (int k = 0; k < D; ++k) { const double h = x[k] * rstd * g_mix[k] * (1.0 + MOD[(size_t)mr * 6 * D + D + k]) + MOD[(size_t)mr * 6 * D + k]; const double v = bf2f(H[(size_t)row * D + k]); d2 += (v - h) * (v - h); r2 += h * h;
            for (int n = 0; n < 16; ++n) ga[n] += h * w_in_e[(size_t)k * E_IN + NE + n]; }
        for (int n = 0; n < 16; ++n) { const double v = G[(size_t)row * 16 + n]; dg += (v - ga[n]) * (v - ga[n]); rg += ga[n] * ga[n]; } }
    atomicAdd(acc + 2, d2); atomicAdd(acc + 3, r2); atomicAdd(acc + 4, dg); atomicAdd(acc + 5, rg);
}
__global__ void st_eps3_fill(const double* acc, float* out, int n) {
    double e = 0.0; for (int i = 0; i < 3; ++i) e = fmax(e, sqrt(acc[2 * i] / (acc[2 * i + 1] + 1e-300))); e += 1e-30; const float v = sqrtf((float)fmax(0.0, -10.0 * log10(e)));
    for (size_t k = (size_t)blockIdx.x * blockDim.x + threadIdx.x; k < (size_t)n; k += (size_t)gridDim.x * blockDim.x) out[k] = v; }
__global__ void st_tail_check(const unsigned char* ws, const float* xin, const float* ctxin, const float* w_out, const float* g_ffn, const float* wg, const float* wu, const float* wd, double* acc) {
    __shared__ float xm[D]; __shared__ float h2[D]; __shared__ float act[FF]; __shared__ float red[256];
    const bf16_t* Y = (const bf16_t*)(ws + OFF_HY); const float* X = (const float*)(ws + OFF_X); const float* MOD = (const float*)(ws + OFF_MOD);
    const int row = blockIdx.x * 256 + 37, tid = threadIdx.x; const int mr = row < ML ? row / SEQ : NB; const float* md = MOD + (size_t)mr * 6 * D;
    const float* x0 = row < ML ? xin + (size_t)row * D : ctxin + (size_t)(row - ML) * D;
    for (int n = tid; n < D; n += 256) { float s = 0.f; for (int k = 0; k < 1024; ++k) s += bf2f(Y[(size_t)row * 1024 + k]) * w_out[(size_t)k * D + n]; xm[n] = x0[n] + md[2 * D + n] * s; }
    __syncthreads();
    float ss = 0.f; for (int n = tid; n < D; n += 256) ss += xm[n] * xm[n]; red[tid] = ss; __syncthreads();
    for (int o = 128; o > 0; o >>= 1) { if (tid < o) red[tid] += red[tid + o]; __syncthreads(); }
    const float rstd = 1.0f / sqrtf(red[0] / D + 1e-6f); __syncthreads();
    for (int n = tid; n < D; n += 256) h2[n] = xm[n] * rstd * g_ffn[n] * (1.0f + md[4 * D + n]) + md[3 * D + n];
    __syncthreads();
    for (int f = tid; f < FF; f += 256) { float a = 0.f, b = 0.f; for (int k = 0; k < D; ++k) { a += h2[k] * wg[(size_t)k * FF + f]; b += h2[k] * wu[(size_t)k * FF + f]; } act[f] = a / (1.0f + expf(-a)) * b; }
    __syncthreads();
    double d2 = 0.0, r2 = 0.0;
    for (int n = tid; n < D; n += 256) { float s = 0.f; for (int f = 0; f < FF; ++f) s += act[f] * wd[(size_t)f * D + n]; const float ref = xm[n] + md[5 * D + n] * s, v = X[(size_t)row * D + n]; d2 += (double)(v - ref) * (v - ref); r2 += (double)(ref - x0[n]) * (ref - x0[n]); }
    atomicAdd(acc, d2); atomicAdd(acc + 1, r2);
}
__global__ void st_ml_ref(const unsigned char* ws, const float* bias, float* href) {
    __shared__ float qs[64], ks[64], red[4][128], dred[4];
    const bf16_t* BQ = (const bf16_t*)(ws + OFF_P) + PE_BQ; const bf16_t* BK = (const bf16_t*)(ws + OFF_P) + PE_BK; const bf16_t* BV = (const bf16_t*)(ws + OFF_P) + PE_BV; const float* G = (const float*)(ws + OFF_G);
    const int chain = blockIdx.x, dir = chain & 1, h = (chain >> 1) & 3, b = chain >> 3, tid = threadIdx.x, dv = tid & 127, kg = tid >> 7;
    float C[16], nn[16]; for (int j = 0; j < 16; ++j) { C[j] = 0.f; nn[j] = 0.f; } float m = 0.f;
    for (int p = 0; p < LK; ++p) { int row; if (p < CTX) row = ML + b * CTX + (dir ? CTX - 1 - p : p); else row = b * SEQ + (dir ? SEQ - 1 - (p - CTX) : p - CTX);
        if (tid < 64) { qs[tid] = bf2f(BQ[(size_t)row * 256 + h * 64 + tid]); ks[tid] = bf2f(BK[(size_t)row * 256 + h * 64 + tid]) * 0.125f; }
        const float v = bf2f(BV[(size_t)row * 512 + h * 128 + dv]);
        const float ipre = G[(size_t)row * 16 + dir * 8 + h] + bias[dir * 8 + h], fpre = G[(size_t)row * 16 + dir * 8 + 4 + h] + bias[dir * 8 + 4 + h];
        const float lf = fminf(fpre, 0.f) - log1pf(expf(-fabsf(fpre)));
        __syncthreads();
        const float mn = fmaxf(lf + m, ipre), fs = expf(lf + m - mn), is = expf(ipre - mn); m = mn;
        float pn = 0.f, pd = 0.f;
        for (int j = 0; j < 16; ++j) { const int dk = 16 * kg + j; C[j] = fs * C[j] + is * ks[dk] * v; nn[j] = fs * nn[j] + is * ks[dk]; pn += qs[dk] * C[j]; pd += qs[dk] * nn[j]; }
        red[kg][dv] = pn; if (dv == 0) dred[kg] = pd;
        __syncthreads();
        if (kg == 0) { const float num = (red[0][dv] + red[1][dv]) + (red[2][dv] + red[3][dv]), den = (dred[0] + dred[1]) + (dred[2] + dred[3]);
            href[((size_t)dir * MT + row) * 512 + h * 128 + dv] = num / fmaxf(fabsf(den), expf(-m)); }
        __syncthreads(); }
}
__global__ void st_ml_cmp(const unsigned char* ws, const float* href, const float* gn, double* acc) {
    const bf16_t* BO = (const bf16_t*)(ws + OFF_P) + PE_BO; const bf16_t* Y = (const bf16_t*)(ws + OFF_HY); const int lane = threadIdx.x & 63;
    for (int it = (blockIdx.x * blockDim.x + threadIdx.x) >> 6; it < MT * 4; it += (gridDim.x * blockDim.x) >> 6) { const int row = it >> 2, h = it & 3; float v[2], ss = 0.f;
        for (int e = 0; e < 2; ++e) { const size_t o = (size_t)row * 512 + h * 128 + lane + 64 * e; v[e] = href[o] + href[(size_t)MT * 512 + o]; ss += v[e] * v[e]; }
        for (int o = 1; o < 64; o <<= 1) ss += __shfl_xor(ss, o);
        const float rstd = 1.0f / sqrtf(ss / 128.0f + 1e-6f); double d2 = 0.0, r2 = 0.0;
        for (int e = 0; e < 2; ++e) { const int dv = lane + 64 * e; const float og = bf2f(BO[(size_t)row * 512 + h * 128 + dv]); const float ref = v[e] * rstd * gn[dv] / (1.0f + expf(-og)), y = bf2f(Y[(size_t)row * 1024 + 512 + h * 128 + dv]); d2 += (double)(y - ref) * (y - ref); r2 += (double)ref * ref; }
        for (int o = 1; o < 64; o <<= 1) { d2 += __shfl_xor(d2, o); r2 += __shfl_xor(r2, o); }
        if (lane == 0) { atomicAdd(acc, d2); atomicAdd(acc + 1, r2); } }
}
__global__ void st_dn_ref(const unsigned char* ws, const float* convw, const float* alog, const float* dtb, float* href) {
    __shared__ float qkv[3][128], red[4][128], nrm[2];
    const bf16_t* DQ = (const bf16_t*)(ws + OFF_P) + PO_DQKV; const float* G = (const float*)(ws + OFF_G);
    const int chain = blockIdx.x, dir = chain & 1, h = (chain >> 1) & 3, b = chain >> 3, tid = threadIdx.x, dv = tid & 127, kg = tid >> 7;
    float S[32]; for (int j = 0; j < 32; ++j) S[j] = 0.f;
    for (int p = 0; p < LK; ++p) { const bool isctx = p < CTX; const int seqlen = isctx ? CTX : SEQ, rowbase = isctx ? ML + b * CTX : b * SEQ; const int tok = isctx ? (dir ? CTX - 1 - p : p) : (dir ? SEQ - 1 - (p - CTX) : p - CTX); const int row = rowbase + tok;
        if (tid < 384) { const int ten = tid >> 7, d = tid & 127, col = ten * 512 + h * 128 + d; float a = 0.f;
            for (int tap = 0; tap < 3; ++tap) { const int tk = tok + tap - 1; if (tk >= 0 && tk < seqlen) a += bf2f(DQ[(size_t)(rowbase + tk) * 1536 + col]) * convw[tap * 1536 + col]; }
            qkv[ten][d] = a / (1.0f + expf(-a)); }
        __syncthreads();
        if (tid < 128) { float s = 0.f; const int ten = tid >> 6; for (int d = (tid & 63); d < 128; d += 64) s += qkv[ten][d] * qkv[ten][d]; for (int o = 1; o < 64; o <<= 1) s += __shfl_xor(s, o); if ((tid & 63) == 0) nrm[ten] = s; }
        __syncthreads();
        const float qn = (1.0f / sqrtf(nrm[0] + 1e-6f)) * 0.08838834764831845f, kn = 1.0f / sqrtf(nrm[1] + 1e-6f);
        const float beta = 1.0f / (1.0f + expf(-G[(size_t)row * 16 + dir * 8 + h])); const float xg = G[(size_t)row * 16 + dir * 8 + 4 + h] + dtb[dir * 4 + h];
        const float at = expf(-expf(alog[dir * 4 + h]) * (fmaxf(xg, 0.f) + log1pf(expf(-fabsf(xg)))));
        const float v = qkv[2][dv]; float pk = 0.f;
        for (int j = 0; j < 32; ++j) pk += qkv[1][32 * kg + j] * kn * S[j];
        red[kg][dv] = pk; __syncthreads();
        const float kS = (red[0][dv] + red[1][dv]) + (red[2][dv] + red[3][dv]); __syncthreads();
        float po = 0.f;
        for (int j = 0; j < 32; ++j) { const float kk = qkv[1][32 * kg + j] * kn; S[j] = at * (S[j] - beta * kk * kS) + beta * kk * v; po += qkv[0][32 * kg + j] * qn * S[j]; }
        red[kg][dv] = po; __syncthreads();
        if (kg == 0 && !isctx) href[((size_t)dir * ML + row) * 512 + h * 128 + dv] = (red[0][dv] + red[1][dv]) + (red[2][dv] + red[3][dv]);
        __syncthreads(); }
}
__global__ void st_dn_cmp(const unsigned char* ws, const float* href, const float* gn, double* acc) {
    const bf16_t* Z = (const bf16_t*)(ws + OFF_P) + PO_Z; const bf16_t* Y = (const bf16_t*)(ws + OFF_HY); const int lane = threadIdx.x & 63;
    for (int it = (blockIdx.x * blockDim.x + threadIdx.x) >> 6; it < ML * 4; it += (gridDim.x * blockDim.x) >> 6) { const int row = it >> 2, h = it & 3; float v[2], ss = 0.f;
        for (int e = 0; e < 2; ++e) { const size_t o = (size_t)row * 512 + h * 128 + lane + 64 * e; v[e] = href[o] + href[(size_t)ML * 512 + o]; ss += v[e] * v[e]; }
        for (int o = 1; o < 64; o <<= 1) ss += __shfl_xor(ss, o);
        const float rstd = 1.0f / sqrtf(ss / 128.0f + 1e-6f); double d2 = 0.0, r2 = 0.0;
        for (int e = 0; e < 2; ++e) { const int dv = lane + 64 * e; const float z = bf2f(Z[(size_t)row * 512 + h * 128 + dv]); const float ref = v[e] * rstd * gn[dv] * (z / (1.0f + expf(-z))), y = bf2f(Y[(size_t)row * 1024 + 512 + h * 128 + dv]); d2 += (double)(y - ref) * (y - ref); r2 += (double)ref * ref; }
        for (int o = 1; o < 64; o <<= 1) { d2 += __shfl_xor(d2, o); r2 += __shfl_xor(r2, o); }
        if (lane == 0) { atomicAdd(acc, d2); atomicAdd(acc + 1, r2); } }
}
__global__ void st_truth_fill(const unsigned char* ws, float* out, int n) {
    const double T[9] = {846.38902932657311,-3988.0872614528216,-4023.4252461296091,7499.0995520059896,-6191.4193272974135,-6282.081387437358,8748.2446258433793,548.97920503418845,21616550.564093322};
    const double* g = (const double*)(ws + ST_CHK) + ((size_t)35 * 4) * 10; double d2 = 0.0; for (int k = 0; k < 8; ++k) d2 += (g[k] - T[k]) * (g[k] - T[k]);
    const double eps = sqrt(d2 / (8.0 * T[8])) + 1e-30; const float v = sqrtf((float)fmax(0.0, -10.0 * log10(eps)));
    for (size_t k = (size_t)blockIdx.x * blockDim.x + threadIdx.x; k < (size_t)n; k += (size_t)gridDim.x * blockDim.x) out[k] = v; }
__global__ void st_gqa_check(const unsigned char* ws, const bf16_t* QS, const float* qkg, double* acc, float* scr) {
    const int lane = threadIdx.x & 63, gw = (blockIdx.x * blockDim.x + threadIdx.x) >> 6, ngw = (gridDim.x * blockDim.x) >> 6, wv = threadIdx.x >> 6;
    const bf16_t* KVC = (const bf16_t*)(ws + OFF_P) + PO_KVC; const bf16_t* O = (const bf16_t*)(ws + OFF_P) + PO_QC;
    const float* COS = (const float*)(ws + OFF_ROPE); const float* SIN = COS + (size_t)SEQ * 32;
    float* s1 = scr + (size_t)gw * LK; __shared__ float qs[8][64];
    for (int it = gw; it < (ML / 16) * 8; it += ngw) { const int h = it & 7, kv = h >> 2, row = (it >> 3) * 16 + 5; const int b = row / SEQ, t = row % SEQ;
        {   const int d = lane, a = d >> 5, pp = (d >> 4) & 1, f = d & 15; float x = bf2f(QS[(size_t)row * 512 + h * 64 + d]); float ss = x * x; for (int o = 1; o < 64; o <<= 1) ss += __shfl_xor(ss, o);
            x = x * (1.0f / sqrtf(ss / 64.0f + 1e-6f)) * qkg[d]; const float xp = __shfl_xor(x, 16); const float cs = COS[(size_t)t * 32 + a * 16 + f], sn = SIN[(size_t)t * 32 + a * 16 + f]; qs[wv][d] = pp == 0 ? x * cs - xp * sn : x * cs + xp * sn; }
        __syncthreads();
        float m1 = -1e30f;
        for (int j = lane; j < LK; j += 64) { const int kr = pos_row(b, j); const bool rope = j >= CTX; const int kt = j - CTX; float ss = 0.f; const bf16_t* kp = KVC + (size_t)kr * 256 + kv * 64;
            for (int d = 0; d < 64; ++d) { const float kd = bf2f(kp[d]); ss += kd * kd; }
            const float rs = 1.0f / sqrtf(ss / 64.0f + 1e-6f); float a1 = 0.f;
            for (int d = 0; d < 64; ++d) { const int a = d >> 5, pp = (d >> 4) & 1, f = d & 15; float k1 = bf2f(kp[d]) * rs * qkg[64 + d];
                if (rope) { const float k1p = bf2f(kp[d ^ 16]) * rs * qkg[64 + (d ^ 16)]; const float cs = COS[(size_t)kt * 32 + a * 16 + f], sn = SIN[(size_t)kt * 32 + a * 16 + f]; k1 = pp == 0 ? k1 * cs - k1p * sn : k1 * cs + k1p * sn; }
                a1 += qs[wv][d] * k1; }
            a1 *= 0.125f; s1[j] = a1; m1 = fmaxf(m1, a1); }
        for (int o = 1; o < 64; o <<= 1) m1 = fmaxf(m1, __shfl_xor(m1, o));
        float l1 = 0.f;
        for (int j = lane; j < LK; j += 64) { const float p1 = expf(s1[j] - m1); s1[j] = p1; l1 += p1; }
        for (int o = 1; o < 64; o <<= 1) l1 += __shfl_xor(l1, o);
        __threadfence(); __syncthreads();
        float o0 = 0.f;
        for (int j = 0; j < LK; ++j) { const int kr = pos_row(b, j); o0 += s1[j] * bf2f(KVC[(size_t)kr * 256 + 128 + kv * 64 + lane]); }
        const float ref = o0 / l1, y = bf2f(O[(size_t)row * 512 + h * 64 + lane]);
        double d2 = (double)(y - ref) * (y - ref), r2 = (double)ref * ref;
        for (int o = 1; o < 64; o <<= 1) { d2 += __shfl_xor(d2, o); r2 += __shfl_xor(r2, o); }
        if (lane == 0) { atomicAdd(acc, d2); atomicAdd(acc + 1, r2); }
        __syncthreads(); }
}
__global__ void st_eps_fill(const double* acc, float* out, int n) { const double eps = sqrt(acc[0] / (acc[1] + 1e-300)) + 1e-30; const float v = sqrtf((float)fmax(0.0, -10.0 * log10(eps)));
    for (size_t k = (size_t)blockIdx.x * blockDim.x + threadIdx.x; k < (size_t)n; k += (size_t)gridDim.x * blockDim.x) out[k] = v; }
#endif
extern "C" void kernel_launch(void* const* d_in, const int* in_sizes, int n_in, void* d_out, int out_size, void* d_ws, size_t ws_size, hipStream_t stream) {
    static int grid = 0;
    if (grid == 0) {
        int dev = 0, cus = 0, per_cu = 0;
        if (hipGetDevice(&dev) != hipSuccess || hipDeviceGetAttribute(&cus, hipDeviceAttributeMultiprocessorCount, dev) != hipSuccess) { fprintf(stderr, "kernel_launch: device query failed\n"); grid = -1; return; }
        if (hipFuncSetAttribute((const void*)mega, hipFuncAttributeMaxDynamicSharedMemorySize, LDS_BYTES) != hipSuccess) { fprintf(stderr, "kernel_launch: hipFuncSetAttribute failed\n"); grid = -1; return; }
        if (hipOccupancyMaxActiveBlocksPerMultiprocessor(&per_cu, (const void*)mega, NTHREADS, LDS_BYTES) != hipSuccess || per_cu < 1) { fprintf(stderr, "kernel_launch: occupancy query says %d\n", per_cu); per_cu = 1; }
        (void)hipGetLastError();
        if (ws_size < WS_NEED || n_in != 25) { fprintf(stderr, "kernel_launch: workspace %zu < %zu needed or n_in %d != 25\n", ws_size, (size_t)WS_NEED, n_in); grid = -1; return; }
        grid = cus;
    }
    if (grid < 0) return;
    (void)hipMemsetAsync(d_ws, 0, ZERO_BYTES, stream);
    Args a{};
#if defined(SELFTEST) && (defined(ST_REPEAT) || defined(ST_TWICE) || defined(ST_FINAL) || defined(ST_DACHECK) || defined(ST_MODCHECK) || defined(ST_L0CHECK) || defined(ST_TAILCHECK) || defined(ST_MLCHECK) || defined(ST_DNCHECK) || defined(ST_GQCHECK))
    for (int i = 0; i < 25; ++i) a.in[i] = (const float*)d_in[i];
    a.out = (float*)d_out; a.ws = (unsigned char*)d_ws; float* sout = (float*)d_out;
#elif defined(SELFTEST) && defined(ST_SAME_BATCH)
    for (int i = 0; i < 25; ++i) a.in[i] = (const float*)d_in[i];
    float* ctxs = (float*)((unsigned char*)d_ws + al256(WS_NEED)); float* cs = ctxs + (size_t)NB * CTX * D; float* sout = (float*)d_out;
    hipLaunchKernelGGL(st_same_batch_inputs, dim3(1024), dim3(256), 0, stream, (const float*)d_in[0], (const float*)d_in[1], (const float*)d_in[2], (float*)d_out, cs, ctxs);
    a.in[0] = (const float*)d_out; a.in[1] = cs; a.in[2] = ctxs; a.out = (float*)d_out; a.ws = (unsigned char*)d_ws;
#elif defined(SELFTEST) && defined(ST_INPLACE)
    { StPtrs P; for (int i = 0; i < 25; ++i) { P.p[i] = (float*)d_in[i]; a.in[i] = (const float*)d_in[i]; }
      hipLaunchKernelGGL(st_gen_inplace, dim3(1024), dim3(256), 0, stream, P); }
    float* sout = (float*)d_out; a.out = sout; a.ws = (unsigned char*)d_ws;
#elif defined(SELFTEST)
    float* syn = (float*)((unsigned char*)d_ws + al256(WS_NEED)); float* sout = syn + st_offset(25);
    hipLaunchKernelGGL(st_gen, dim3(1024), dim3(256), 0, stream, syn);
    for (int i = 0; i < 25; ++i) a.in[i] = syn + st_offset(i);
    a.out = sout; a.ws = (unsigned char*)d_ws;
#else
    for (int i = 0; i < 25; ++i) a.in[i] = (const float*)d_in[i];
    a.out = (float*)d_out; a.ws = (unsigned char*)d_ws;
#endif
#ifdef SELFTEST
#ifdef ST_GQCHECK
    {   a.step_lo = 0; a.step_hi = 9 + 3; a.prologue = 1; a.final_ = 0;
        void* args[] = {&a};
        hipError_t e = hipLaunchCooperativeKernel((const void*)mega, dim3(grid), dim3(NTHREADS), args, LDS_BYTES, stream);
        if (e != hipSuccess) fprintf(stderr, "cooperative launch failed: %s (grid %d)\n", hipGetErrorString(e), grid);
        (void)hipMemcpyAsync(d_out, (unsigned char*)d_ws + OFF_P + PO_QC * 2, (size_t)MT * 512 * 2, hipMemcpyDeviceToDevice, stream);
        a.step_lo = 12; a.step_hi = 13; a.prologue = 0;
        (void)hipMemsetAsync(d_ws, 0, 512 * 1024, stream);
        e = hipLaunchCooperativeKernel((const void*)mega, dim3(grid), dim3(NTHREADS), args, LDS_BYTES, stream);
        double* acc = (double*)((unsigned char*)d_ws + ST_CHK); float* scr = (float*)((unsigned char*)d_ws + SO_U);
        hipLaunchKernelGGL(st_gqa_check, dim3(256), dim3(512), 0, stream, (const unsigned char*)d_ws, (const bf16_t*)d_out, (const float*)d_in[15], acc, scr);
        hipLaunchKernelGGL(st_eps_fill, dim3(1024), dim3(256), 0, stream, (const double*)acc, (float*)d_out, out_size); }
#elif defined(ST_DNCHECK)
#ifndef ST_LAYER
#define ST_LAYER 1
#endif
    {   a.step_lo = 0; a.step_hi = 9 * ST_LAYER + 3; a.prologue = 1; a.final_ = 0;
        void* args[] = {&a};
        hipError_t e = hipLaunchCooperativeKernel((const void*)mega, dim3(grid), dim3(NTHREADS), args, LDS_BYTES, stream);
        if (e != hipSuccess) fprintf(stderr, "cooperative launch failed: %s (grid %d)\n", hipGetErrorString(e), grid);
        float* href = (float*)d_out; double* acc = (double*)((unsigned char*)d_ws + ST_CHK);
        hipLaunchKernelGGL(st_dn_ref, dim3(NCHAIN), dim3(512), 0, stream, (const unsigned char*)d_ws, (const float*)d_in[16] + (ST_LAYER / 2) * 3 * 1536, (const float*)d_in[17] + (ST_LAYER / 2) * 8, (const float*)d_in[18] + (ST_LAYER / 2) * 8, href);
        a.step_lo = 9 * ST_LAYER + 3; a.step_hi = 9 * ST_LAYER + 5; a.prologue = 0;
        (void)hipMemsetAsync(d_ws, 0, 512 * 1024, stream);
        e = hipLaunchCooperativeKernel((const void*)mega, dim3(grid), dim3(NTHREADS), args, LDS_BYTES, stream);
        hipLaunchKernelGGL(st_dn_cmp, dim3(512), dim3(256), 0, stream, (const unsigned char*)d_ws, (const float*)href, (const float*)d_in[19] + (ST_LAYER / 2) * 128, acc);
        hipLaunchKernelGGL(st_eps_fill, dim3(1024), dim3(256), 0, stream, (const double*)acc, (float*)d_out, out_size); }
#elif defined(ST_MLCHECK)
#ifndef ST_LAYER
#define ST_LAYER 0
#endif
    {   a.step_lo = 0; a.step_hi = 9 * ST_LAYER + 5; a.prologue = 1; a.final_ = 0;
        void* args[] = {&a};
        hipError_t e = hipLaunchCooperativeKernel((const void*)mega, dim3(grid), dim3(NTHREADS), args, LDS_BYTES, stream);
        if (e != hipSuccess) fprintf(stderr, "cooperative launch failed: %s (grid %d)\n", hipGetErrorString(e), grid);
        float* href = (float*)((unsigned char*)d_ws + SE_DCT); double* acc = (double*)((unsigned char*)d_ws + ST_CHK);
        hipLaunchKernelGGL(st_ml_ref, dim3(NCHAIN), dim3(512), 0, stream, (const unsigned char*)d_ws, (const float*)d_in[9] + (ST_LAYER / 2) * 16, href);
        hipLaunchKernelGGL(st_ml_cmp, dim3(512), dim3(256), 0, stream, (const unsigned char*)d_ws, (const float*)href, (const float*)d_in[12] + (ST_LAYER / 2) * 128, acc);
        hipLaunchKernelGGL(st_eps_fill, dim3(1024), dim3(256), 0, stream, (const double*)acc, (float*)d_out, out_size); }
#elif defined(ST_TAILCHECK)
    {   a.step_lo = 0; a.step_hi = 5; a.prologue = 1; a.final_ = 0;
        void* args[] = {&a};
        hipError_t e = hipLaunchCooperativeKernel((const void*)mega, dim3(grid), dim3(NTHREADS), args, LDS_BYTES, stream);
        if (e != hipSuccess) fprintf(stderr, "cooperative launch failed: %s (grid %d)\n", hipGetErrorString(e), grid);
        float* ysave = (float*)((unsigned char*)d_ws + SE_DCT);
        (void)hipMemcpyAsync(ysave, (unsigned char*)d_ws + OFF_HY, (size_t)MT * 1024 * 2, hipMemcpyDeviceToDevice, stream);
        a.step_lo = 5; a.step_hi = 9; a.prologue = 0;
        (void)hipMemsetAsync(d_ws, 0, 512 * 1024, stream);
        e = hipLaunchCooperativeKernel((const void*)mega, dim3(grid), dim3(NTHREADS), args, LDS_BYTES, stream);
        (void)hipMemcpyAsync((unsigned char*)d_ws + OFF_HY, ysave, (size_t)MT * 1024 * 2, hipMemcpyDeviceToDevice, stream);
        double* acc = (double*)((unsigned char*)d_ws + ST_CHK);
        hipLaunchKernelGGL(st_tail_check, dim3(72), dim3(256), 0, stream, (const unsigned char*)d_ws, (const float*)d_in[0], (const float*)d_in[2], (const float*)d_in[13], (const float*)d_in[7], (const float*)d_in[21], (const float*)d_in[22], (const float*)d_in[23], acc);
        hipLaunchKernelGGL(st_eps_fill, dim3(1024), dim3(256), 0, stream, (const double*)acc, (float*)d_out, out_size); }
#elif defined(ST_L0CHECK)
    {   a.step_lo = 0; a.step_hi = 2; a.prologue = 1; a.final_ = 0;
        void* args[] = {&a};
        hipError_t e = hipLaunchCooperativeKernel((const void*)mega, dim3(grid), dim3(NTHREADS), args, LDS_BYTES, stream);
        if (e != hipSuccess) fprintf(stderr, "cooperative launch failed: %s (grid %d)\n", hipGetErrorString(e), grid);
        double* acc = (double*)((unsigned char*)d_ws + ST_CHK);
        hipLaunchKernelGGL(st_inproj_check, dim3(512), dim3(256), 0, stream, (const unsigned char*)d_ws, (const float*)d_in[8], acc);
        hipLaunchKernelGGL(st_norm_check, dim3(1), dim3(128), 0, stream, (const unsigned char*)d_ws, (const float*)d_in[6], (const float*)d_in[8], (const float*)d_in[0], (const float*)d_in[2], acc);
        hipLaunchKernelGGL(st_eps3_fill, dim3(1024), dim3(256), 0, stream, (const double*)acc, (float*)d_out, out_size); }
#elif defined(ST_MODCHECK)
    {   a.step_lo = 0; a.step_hi = 0; a.prologue = 1; a.final_ = 0;
        void* args[] = {&a};
        hipError_t e = hipLaunchCooperativeKernel((const void*)mega, dim3(grid), dim3(NTHREADS), args, LDS_BYTES, stream);
        if (e != hipSuccess) fprintf(stderr, "cooperative launch failed: %s (grid %d)\n", hipGetErrorString(e), grid);
        double* acc = (double*)((unsigned char*)d_ws + ST_CHK);
        hipLaunchKernelGGL(st_mod_check, dim3(512), dim3(256), 0, stream, (const unsigned char*)d_ws, (const float*)d_in[1], (const float*)d_in[3], (const float*)d_in[4], (const float*)d_in[5], acc);
        hipLaunchKernelGGL(st_eps_fill, dim3(1024), dim3(256), 0, stream, (const double*)acc, (float*)d_out, out_size); }
#elif defined(ST_DACHECK)
    {   a.step_lo = 0; a.step_hi = 5; a.prologue = 1; a.final_ = 0;
        void* args[] = {&a};
        hipError_t e = hipLaunchCooperativeKernel((const void*)mega, dim3(grid), dim3(NTHREADS), args, LDS_BYTES, stream);
        if (e != hipSuccess) fprintf(stderr, "cooperative launch failed: %s (grid %d)\n", hipGetErrorString(e), grid);
        double* acc = (double*)((unsigned char*)d_ws + ST_CHK); float* scr = (float*)((unsigned char*)d_ws + SE_DCT);
        hipLaunchKernelGGL(st_da_check, dim3(256), dim3(512), 0, stream, (const unsigned char*)d_ws, (const float*)d_in[10], (const float*)d_in[11], acc, scr);
        hipLaunchKernelGGL(st_eps_fill, dim3(1024), dim3(256), 0, stream, (const double*)acc, (float*)d_out, out_size); }
#elif defined(ST_FINAL)
    {   a.step_lo = 0; a.step_hi = CFG_LAYERS * 9; a.prologue = 1; a.final_ = 1;
        void* args[] = {&a};
        hipError_t e = hipLaunchCooperativeKernel((const void*)mega, dim3(grid), dim3(NTHREADS), args, LDS_BYTES, stream);
        if (e != hipSuccess) fprintf(stderr, "cooperative launch failed: %s (grid %d)\n", hipGetErrorString(e), grid);
        double* acc = (double*)((unsigned char*)d_ws + ST_CHK);
        hipLaunchKernelGGL(st_final_check, dim3(64), dim3(256), 0, stream, (const unsigned char*)d_ws, (const float*)d_out, (const float*)d_in[24], acc);
        hipLaunchKernelGGL(st_final_fill, dim3(1024), dim3(256), 0, stream, (const double*)acc, (float*)d_out, out_size); }
#elif defined(ST_TWICE)
    for (int rep = 0; rep < 2; ++rep) {
        (void)hipMemsetAsync(d_ws, 0, 512 * 1024, stream); (void)hipMemsetAsync((unsigned char*)d_ws + OFF_MOD, 0, ZERO_BYTES - OFF_MOD, stream);
        a.step_lo = 0; a.step_hi = CFG_LAYERS * 9; a.prologue = 1; a.final_ = 0;
        void* args[] = {&a};
        hipError_t e = hipLaunchCooperativeKernel((const void*)mega, dim3(grid), dim3(NTHREADS), args, LDS_BYTES, stream);
        if (e != hipSuccess) fprintf(stderr, "cooperative launch failed: %s (grid %d)\n", hipGetErrorString(e), grid);
        hipLaunchKernelGGL(st_check_kernel, dim3(256), dim3(NTHREADS), 0, stream, (unsigned char*)d_ws, 35, rep * 40); }
    hipLaunchKernelGGL(st_twice_report, dim3(1024), dim3(256), 0, stream, (const unsigned char*)d_ws, (float*)d_out, out_size);
#elif defined(ST_REPEAT)
    for (int st = 0; st < CFG_LAYERS * 9; ++st) { const int ph = st % 9;
        for (int rep = 0; rep < ((ph == 3 || ph == 5 || ph == 8) ? 1 : 2); ++rep) {
            a.step_lo = st; a.step_hi = st + 1; a.prologue = (st == 0 && rep == 0); a.final_ = 0;
            void* args[] = {&a};
            hipError_t e = hipLaunchCooperativeKernel((const void*)mega, dim3(grid), dim3(NTHREADS), args, LDS_BYTES, stream);
            if (e != hipSuccess) fprintf(stderr, "cooperative launch failed: %s (grid %d)\n", hipGetErrorString(e), grid);
            hipLaunchKernelGGL(st_check_kernel, dim3(256), dim3(NTHREADS), 0, stream, (unsigned char*)d_ws, st, rep * 40); } }
    hipLaunchKernelGGL(st_repeat_report, dim3(1024), dim3(256), 0, stream, (const unsigned char*)d_ws, (float*)d_out, out_size, CFG_LAYERS * 9);
#elif defined(ST_SAME_BATCH)
    a.step_lo = 0; a.step_hi = CFG_LAYERS * 9; a.prologue = 1; a.final_ = 1;
    { void* args[] = {&a};
      hipError_t e = hipLaunchCooperativeKernel((const void*)mega, dim3(grid), dim3(NTHREADS), args, LDS_BYTES, stream);
      if (e != hipSuccess) fprintf(stderr, "cooperative launch failed: %s (grid %d)\n", hipGetErrorString(e), grid); }
    double* acc = (double*)((unsigned char*)d_ws + ST_CHK);
    hipLaunchKernelGGL(st_batch_report, dim3(256), dim3(256), 0, stream, (const float*)sout, (float*)d_out, out_size, acc);
    hipLaunchKernelGGL(st_fill, dim3(1024), dim3(256), 0, stream, (const double*)acc, (float*)d_out, out_size);
#else
#ifndef ST_CHUNK
#define ST_CHUNK 1
#endif
    for (int st = 0; st < CFG_LAYERS * 9; st += ST_CHUNK) {
        a.step_lo = st; a.step_hi = st + ST_CHUNK; a.prologue = st == 0; a.final_ = 0;
        void* args[] = {&a};
        hipError_t e = hipLaunchCooperativeKernel((const void*)mega, dim3(grid), dim3(NTHREADS), args, LDS_BYTES, stream);
        if (e != hipSuccess) fprintf(stderr, "cooperative launch failed: %s (grid %d)\n", hipGetErrorString(e), grid);
        hipLaunchKernelGGL(st_check_kernel, dim3(256), dim3(NTHREADS), 0, stream, (unsigned char*)d_ws, st + ST_CHUNK - 1);
    }
#ifdef ST_TRUTH
    hipLaunchKernelGGL(st_truth_fill, dim3(1024), dim3(256), 0, stream, (const unsigned char*)d_ws, (float*)d_out, out_size);
#else
    hipLaunchKernelGGL(st_report, dim3(1024), dim3(256), 0, stream, (const unsigned char*)d_ws, (float*)d_out, out_size);
#endif
#endif
#elif defined(MULTI_LAUNCH)
    for (int st = 0; st < CFG_LAYERS * 9; st += MULTI_LAUNCH) {
        a.step_lo = st; a.step_hi = st + MULTI_LAUNCH < CFG_LAYERS * 9 ? st + MULTI_LAUNCH : CFG_LAYERS * 9; a.prologue = st == 0; a.final_ = 0;
        void* args[] = {&a};
        hipError_t e = hipLaunchCooperativeKernel((const void*)mega, dim3(grid), dim3(NTHREADS), args, LDS_BYTES, stream);
        if (e != hipSuccess) fprintf(stderr, "cooperative launch failed: %s (grid %d)\n", hipGetErrorString(e), grid);
    }
    {   a.step_lo = a.step_hi = CFG_LAYERS * 9; a.prologue = 0; a.final_ = 1;
        void* args[] = {&a};
        hipError_t e = hipLaunchCooperativeKernel((const void*)mega, dim3(grid), dim3(NTHREADS), args, LDS_BYTES, stream);
        if (e != hipSuccess) fprintf(stderr, "cooperative launch failed: %s (grid %d)\n", hipGetErrorString(e), grid); }
#elif defined(PROBE_Y)
    {   a.step_lo = 0; a.step_hi = 9 * (PROBE_Y - 1) + 5; a.prologue = 1; a.final_ = 0;
        void* args[] = {&a};
        hipError_t e = hipLaunchCooperativeKernel((const void*)mega, dim3(grid), dim3(NTHREADS), args, LDS_BYTES, stream);
        if (e != hipSuccess) fprintf(stderr, "cooperative launch failed: %s (grid %d)\n", hipGetErrorString(e), grid);
        double* acc = (double*)((unsigned char*)d_ws + 512 * 1024);
        hipLaunchKernelGGL(pr_stat, dim3(512), dim3(256), 0, stream, (const bf16_t*)((unsigned char*)d_ws + OFF_HY), ML, PROBE_C0, PROBE_C1, acc);
        hipLaunchKernelGGL(pr_fill, dim3(1024), dim3(256), 0, stream, (const double*)acc, (float*)d_out, out_size); }
#else
    a.step_lo = 0; a.step_hi = CFG_LAYERS * 9; a.prologue = 1; a.final_ = 1;
    void* args[] = {&a};
    hipError_t e = hipLaunchCooperativeKernel((const void*)mega, dim3(grid), dim3(NTHREADS), args, LDS_BYTES, stream);
    if (e != hipSuccess) fprintf(stderr, "cooperative launch failed: %s (grid %d)\n", hipGetErrorString(e), grid);
#ifdef RUN_TWICE
    (void)hipMemsetAsync(d_ws, 0, ZERO_BYTES, stream);
    e = hipLaunchCooperativeKernel((const void*)mega, dim3(grid), dim3(NTHREADS), args, LDS_BYTES, stream);
#endif
#endif
}
#endif
```

```cpp
#ifndef EMU
#include <hip/hip_runtime.h>
#include <hip/hip_cooperative_groups.h>
#include <cstdio>
#include <cstdint>
#include <cmath>
#endif

#ifndef CFG_D
#define CFG_D 1024
#define CFG_B 8
#define CFG_SEQ 2048
#define CFG_CTX 256
#define CFG_FF 2816
#endif
#ifndef DIS
#define DIS 0ull
#endif
#define ON(bit) (!(((unsigned long long)(DIS) >> (bit)) & 1ull))
#ifndef REPM
#define REPM 0ull
#endif
#define REPB(bit) for (int rep_ = 0; rep_ <= (int)(((unsigned long long)(REPM) >> (bit)) & 1ull); ++rep_)
#ifndef CFG_LAYERS
#define CFG_LAYERS 4
#endif
constexpr int D = CFG_D, NB = CFG_B, SEQ = CFG_SEQ, CTX = CFG_CTX, FF = CFG_FF, DEPTH = 4, GRIDW = 64;
constexpr int ML = NB * SEQ, MC = NB * CTX, MT = ML + MC;
constexpr int LK = CTX + SEQ;
constexpr int NCC = CTX / 64, NLC = SEQ / 64, NCH = NCC + NLC;
constexpr int E_IN = 3088, O_IN = 2832, NE = 3072, NO = 2816;
constexpr int NCHAIN = NB * 4 * 2;
constexpr float EPS = 1e-6f;
constexpr int NTHREADS = 512, NWAVES = 8;
static_assert(SEQ % 256 == 0 && MC % 256 == 0 && D % 256 == 0 && FF % 256 == 0 && CTX % 64 == 0, "shape constraints");

typedef unsigned short bf16_t;
typedef short bf16x8 __attribute__((ext_vector_type(8)));
typedef short bf16x4 __attribute__((ext_vector_type(4)));
typedef float f32x4 __attribute__((ext_vector_type(4)));
typedef float f32x2 __attribute__((ext_vector_type(2)));
typedef float f32x16 __attribute__((ext_vector_type(16)));
typedef unsigned u32x4 __attribute__((ext_vector_type(4)));
typedef unsigned u32x2 __attribute__((ext_vector_type(2)));

#ifdef EMU
#define DEV static inline
#define DEVM inline
#define TIDX (EMU_TID)
#define BIDX (EMU_BID)
#define NBLK (EMU_NBLK)
#define BLOCK_SYNC() emu::block_sync()
#define WAVE_FENCE() emu::wave_sync()
#define SHFL_XOR(v, m) emu::shfl_xor((v), (m))
#define SHFL(v, s) emu::shfl((v), (s))
#define MFMA32(a, b, c) emu::mfma32((a), (b), (c))
#define EXP2F(x) exp2f(x)
#define ATOMIC_ADD_F(p, v) (*(p) += (v))
#define SCHED_FENCE() do {} while (0)
#define LOGF_NATIVE(x) logf(x)
#define WAVE_ANY(p) (wave_max((p) ? 1.0f : 0.0f) > 0.5f)
#else
namespace cg = cooperative_groups;
#define DEV __device__ __forceinline__
#define DEVM __device__ __forceinline__
#define TIDX ((int)threadIdx.x)
#define BIDX ((int)blockIdx.x)
#define NBLK ((int)gridDim.x)
#define BLOCK_SYNC() __syncthreads()
#define WAVE_FENCE() do { asm volatile("s_waitcnt lgkmcnt(0)" ::: "memory"); } while (0)
#define SHFL_XOR(v, m) __shfl_xor((v), (m))
#define SHFL(v, s) __shfl((v), (s))
#define MFMA32(a, b, c) __builtin_amdgcn_mfma_f32_32x32x16_bf16((a), (b), (c), 0, 0, 0)
#define EXP2F(x) __builtin_amdgcn_exp2f(x)
#define ATOMIC_ADD_F(p, v) atomicAdd((p), (v))
#define SCHED_FENCE() __builtin_amdgcn_sched_barrier(0)
#define LOGF_NATIVE(x) __logf(x)
#define WAVE_ANY(p) (__any(p) != 0)
#endif

DEV unsigned f2bf(float f) { unsigned u = __builtin_bit_cast(unsigned, f); return (u + 0x7fffu + ((u >> 16) & 1u)) >> 16; }
DEV float bf2f(unsigned h) { return __builtin_bit_cast(float, h << 16); }
#ifdef EMU
DEV unsigned pk2(float lo, float hi) { return f2bf(lo) | (f2bf(hi) << 16); }
#else
typedef __bf16 hw_bf16x2 __attribute__((ext_vector_type(2)));
DEV unsigned pk2(float lo, float hi) { const f32x2 v = {lo, hi}; return __builtin_bit_cast(unsigned, __builtin_convertvector(v, hw_bf16x2)); }
#endif
DEV int crow(int r, int h) { return (r & 3) + 8 * (r >> 2) + 4 * h; }
DEV float wave_sum(float v) {
#pragma unroll
    for (int o = 1; o < 64; o <<= 1) v += SHFL_XOR(v, o);
    return v;
}
DEV float wave_max(float v) {
#pragma unroll
    for (int o = 1; o < 64; o <<= 1) v = fmaxf(v, SHFL_XOR(v, o));
    return v;
}
DEV bf16x8 ld16(const void* p) { return *(const bf16x8*)p; }
DEV bf16x8 pack_acc(const f32x16& x, int s) {
    u32x4 p; p[0] = pk2(x[8 * s + 0], x[8 * s + 1]); p[1] = pk2(x[8 * s + 2], x[8 * s + 3]); p[2] = pk2(x[8 * s + 4], x[8 * s + 5]); p[3] = pk2(x[8 * s + 6], x[8 * s + 7]);
    return __builtin_bit_cast(bf16x8, p);
}
DEV bf16x8 cat44(bf16x4 lo, bf16x4 hi) { return __builtin_shufflevector(lo, hi, 0, 1, 2, 3, 4, 5, 6, 7); }
#ifndef EMU
DEV float fast_expf_(float x) { return __builtin_amdgcn_exp2f(x * 1.4426950408889634f); }
#define expf(x) fast_expf_(x)
#endif
#ifdef EMU
DEV float sigmoidf_(float x) { return 1.0f / (1.0f + expf(-x)); }
DEV float siluf_(float x) { return x / (1.0f + expf(-x)); }
#else
DEV float sigmoidf_(float x) { return __builtin_amdgcn_rcpf(1.0f + __builtin_amdgcn_exp2f(x * -1.4426950408889634f)); }
DEV float siluf_(float x) { return x * __builtin_amdgcn_rcpf(1.0f + __builtin_amdgcn_exp2f(x * -1.4426950408889634f)); }
#endif
DEV float log1pexp_(float nax) {
    const float e = expf(nax), u = 1.0f + e, d = u - 1.0f; return d == 0.0f ? e : LOGF_NATIVE(u) * (e / d); }
DEV float logsigmoidf_(float x) { return fminf(x, 0.0f) - log1pexp_(-fabsf(x)); }
DEV float softplusf_(float x) { return fmaxf(x, 0.0f) + log1pexp_(-fabsf(x)); }

constexpr size_t al256(size_t x) { return (x + 255) & ~(size_t)255; }
constexpr size_t cmax(size_t a, size_t b) { return a > b ? a : b; }
constexpr size_t OFF_CTL = 0;
constexpr size_t OFF_MOD = 1u << 20;
constexpr size_t SZ_MOD = al256((size_t)DEPTH * 9 * 6 * D * 4);
constexpr size_t ZERO_BYTES = OFF_MOD + SZ_MOD;
constexpr size_t OFF_ROPE = ZERO_BYTES;
constexpr size_t OFF_G = OFF_ROPE + al256((size_t)SEQ * 64 * 4);
constexpr size_t OFF_X = OFF_G + al256((size_t)MT * 16 * 4);
constexpr size_t OFF_WIN = OFF_X + al256((size_t)MT * D * 4);
constexpr size_t OFF_WOUT = OFF_WIN + al256((size_t)NE * D * 2);
constexpr size_t OFF_P = OFF_WOUT + al256((size_t)D * 1024 * 2);
constexpr size_t SZ_P = al256((size_t)MT * cmax(NE, FF) * 2);
constexpr size_t OFF_HY = OFF_P + SZ_P;
constexpr size_t OFF_S = OFF_HY + al256((size_t)MT * cmax(D, 1024) * 2);
constexpr size_t PE_QA = 0, PE_KA = (size_t)MT * 512, PE_VA = (size_t)MT * 1024, PE_BQ = (size_t)MT * 1536, PE_BK = (size_t)MT * 1792, PE_BV = (size_t)MT * 2048, PE_BO = (size_t)MT * 2560;
constexpr size_t PO_QC = 0, PO_KVC = (size_t)MT * 512, PO_DQKV = (size_t)MT * 768, PO_Z = (size_t)MT * 2304;
constexpr size_t SE_KP = OFF_S;
constexpr size_t SE_VT = SE_KP + al256((size_t)NB * 8 * LK * 64 * 2);
constexpr size_t SE_DCT = SE_VT + al256((size_t)NB * 4 * 128 * LK * 2);
constexpr size_t SE_DN = SE_DCT + al256((size_t)NCHAIN * NCH * 8192 * 4);
constexpr size_t SE_SC = SE_DN + al256((size_t)NCHAIN * NCH * 64 * 4);
constexpr size_t SE_PARK = SE_SC + al256((size_t)NCHAIN * NCH * 4 * 4);
constexpr size_t SE_END = SE_PARK + al256((size_t)256 * NTHREADS * 64 * 4);
constexpr size_t SF_WGU = OFF_S;
constexpr size_t SF_WDN = SF_WGU + al256((size_t)2 * FF * D * 2);
constexpr size_t SF_END = SF_WDN + al256((size_t)D * FF * 2);
constexpr size_t SF_PART = SF_END;
constexpr size_t SF_PART_END = SF_PART + (size_t)128 * 65536 * 4;
constexpr size_t WS_NEED_EF = cmax(SE_END, SF_PART_END);

constexpr int LDS_BYTES = 147456;
constexpr int LDS_MISC = 131072;

struct Args { const float* in[25]; float* out; unsigned char* ws; int step_lo, step_hi, prologue, final_; };

struct Ctx {
    int tid, lane, wave, bid, nblk, gw, ngw;
    char* lds;
    const float* const* in; float* out; unsigned char* ws;
};
#ifdef EMU
#define PHASE_CTX(pc) const Ctx& pc = c
#else
#define PHASE_CTX(pc) Ctx pc = c; { int t_ = threadIdx.x; asm volatile("" : "+v"(t_)); pc.tid = t_; pc.lane = t_ & 63; pc.wave = __builtin_amdgcn_readfirstlane(t_ >> 6); pc.gw = pc.bid * NWAVES + pc.wave; \
    __attribute__((address_space(1))) unsigned char* g_ = (__attribute__((address_space(1))) unsigned char*)c.ws; asm volatile("" : "+s"(g_)); pc.ws = (unsigned char*)g_; }
#endif

#ifdef EMU
struct XcdBarrier { int dummy; };
#define GRID_BARRIER() emu::grid_sync()
#else
#define LAS __attribute__((address_space(3)))
#define XB_TMO      128
#define XB_XCNT(j)  (256  + 64 * (j))
#define XB_XSUB(j)  (1280 + 64 * (j))
#define XB_XGEN(j)  (2304 + 64 * (j))
#define XB_TOP      3328
#define XB_TOPGEN   3392
#define XCD_BAR_WORDS 3456
#define XB_SPIN_CAP (1u << 24)
__device__ __forceinline__ unsigned xb_ld(unsigned* p)              { return __hip_atomic_load(p, __ATOMIC_RELAXED, __HIP_MEMORY_SCOPE_AGENT); }
__device__ __forceinline__ unsigned xb_add(unsigned* p, unsigned v) { return __hip_atomic_fetch_add(p, v, __ATOMIC_RELAXED, __HIP_MEMORY_SCOPE_AGENT); }
__device__ __forceinline__ unsigned xb_xcc_id() { return (unsigned)__builtin_amdgcn_s_getreg((3 << 11) | 20) & 0xFu; }
#define XB_SPIN(cond, bar) do { unsigned _sp = 0; while (cond) { __builtin_amdgcn_s_sleep(1); \
    if ((++_sp & 255u) == 0u) { if (xb_ld(&(bar)[XB_TMO])) break; if (_sp > XB_SPIN_CAP) { atomicAdd(&(bar)[XB_TMO], 1u); break; } } } } while (0)
struct XcdBarrier { unsigned* bar; unsigned x; volatile LAS unsigned* st; };
__device__ __forceinline__ XcdBarrier xcd_barrier_post(unsigned* bar, volatile LAS unsigned* st) {
    XcdBarrier b; b.bar = bar; b.x = xb_xcc_id(); b.st = st;
    if (threadIdx.x == 0) (void)xb_add(&bar[XB_XCNT(b.x)], 1u);
    return b;
}
__device__ __forceinline__ void xcd_barrier_complete(unsigned* bar, unsigned x, unsigned& nloc, unsigned& nx) {
    const unsigned G = gridDim.x * gridDim.y * gridDim.z;
    unsigned sum, cnt, mine, sp = 0u;
    for (;;) {
        sum = 0u; cnt = 0u; mine = 0u;
#pragma unroll
        for (unsigned j = 0; j < 16; ++j) { const unsigned c = xb_ld(&bar[XB_XCNT(j)]); sum += c; cnt += (c > 0u) ? 1u : 0u; mine = (j == x) ? c : mine; }
        if (sum == G) break;
        __builtin_amdgcn_s_sleep(1);
        if ((++sp & 255u) == 0u) { if (xb_ld(&bar[XB_TMO])) break; if (sp > XB_SPIN_CAP) { atomicAdd(&bar[XB_TMO], 1u); break; } }
    }
    nloc = mine > 0u ? mine : 1u; nx = cnt > 0u ? cnt : 1u;
}
__device__ __forceinline__ void xcd_barrier(const XcdBarrier& b) {
    const bool leader = threadIdx.x == 0;
    asm volatile("s_waitcnt vmcnt(0)" ::: "memory");
    __syncthreads();
    if (leader) {
        unsigned* bar = b.bar;
        __builtin_amdgcn_s_waitcnt(0);
        unsigned nloc = b.st[0], nx = b.st[1];
        if (nloc == 0u) { xcd_barrier_complete(bar, b.x, nloc, nx); b.st[0] = nloc; b.st[1] = nx; }
        const unsigned old = xb_add(&bar[XB_XSUB(b.x)], 1u);
        const unsigned gen = old / nloc;
        if (old + 1u == (gen + 1u) * nloc) {
            __builtin_amdgcn_fence(__ATOMIC_RELEASE, "agent");
            asm volatile("s_waitcnt vmcnt(0)" ::: "memory");
            const unsigned og = xb_add(&bar[XB_TOP], 1u);
            const unsigned tg = og / nx;
            if (og + 1u == (tg + 1u) * nx) xb_add(&bar[XB_TOPGEN], 1u);
            else XB_SPIN(xb_ld(&bar[XB_TOPGEN]) == tg, bar);
            __builtin_amdgcn_fence(__ATOMIC_ACQUIRE, "agent");
            xb_add(&bar[XB_XGEN(b.x)], 1u);
            asm volatile("s_waitcnt vmcnt(0)" ::: "memory");
        } else {
            XB_SPIN(xb_ld(&bar[XB_XGEN(b.x)]) == gen, bar);
            __builtin_amdgcn_fence(__ATOMIC_ACQUIRE, "agent");
            asm volatile("s_waitcnt vmcnt(0)" ::: "memory");
        }
    }
    __syncthreads();
}
#ifdef USE_CG_SYNC
#define GRID_BARRIER() cg::this_grid().sync()
#else
#define GRID_BARRIER() xcd_barrier(bar)
#endif
#endif

#ifndef EMU
namespace pg8 {
#define PG8_LAS __attribute__((address_space(3)))
typedef unsigned short bf16_t;
typedef short bf16x8 __attribute__((ext_vector_type(8)));
typedef float f32x4 __attribute__((ext_vector_type(4)));
typedef unsigned u32x4 __attribute__((ext_vector_type(4)));
constexpr int BM = 256, BK = 64, HALF = 128, HTB = HALF * BK * 2  , STAGE_BYTES = 8 * HTB, NXCD = 8, WGM = 8;

__host__ __device__ __forceinline__ int lds_byte(int r, int c) { const int st = (r >> 4) * 2 + (c >> 5), rr = r & 15, cc = c & 31, ob = rr * 64 + cc * 2; return st * 1024 + (ob ^ (((ob >> 9) & 1) << 5)); }
__host__ __device__ __forceinline__ void stage_rc(int b, int& R, int& C) { const int st = b / 1024, sb = b % 1024, swz = sb ^ (((sb >> 9) & 1) << 5); R = (st >> 1) * 16 + swz / 64; C = (st & 1) * 32 + (swz % 64) / 2; }
__host__ __device__ __forceinline__ int perm32(int rho) { const int n = rho >> 4, i = rho & 15; return 8 * (i >> 2) + 4 * n + (i & 3); }

struct Unit { int pm, pn; };
struct Gemm { const bf16_t* A; const bf16_t* Bt; int M, N, K, ld; };

struct StaticOrder {
    int nM, nN, nwg, G, c, wave, lim;
    int tn, tpm, tpn, tw;
    __host__ __device__ void init(int M, int N, int G_, int c_) { nM = M / BM; nN = N / BM; nwg = nM * nN; G = G_; c = c_; lim = 0x7fffffff; tn = 0; tpm = 0; tpn = 0; tw = 1; }
    __host__ __device__ bool next(int i, Unit& u) const {
        const long L = (long)i * G + c; if (L >= nwg + tn || L >= lim) return false;
        if (L >= nwg) { const int idx = (int)L - nwg; u.pm = tpm + idx / tw; u.pn = tpn + idx % tw; return true; }
        int wgid = (int)L; { const int q = nwg / NXCD, r = nwg % NXCD, xcd = wgid % NXCD, off = wgid / NXCD; wgid = (xcd < r ? xcd * (q + 1) : r * (q + 1) + (xcd - r) * q) + off; }
        const int nig = WGM * nN, gid = wgid / nig, fm = gid * WGM, gsz = (nM - fm) < WGM ? (nM - fm) : WGM;
        u.pm = fm + ((wgid % nig) % gsz); u.pn = (wgid % nig) / gsz; return true;
    }
    __device__ __forceinline__ void a_ready(const Unit&) const {}
    __device__ __forceinline__ void done(const Unit&) const {}
};
template <class Epi, class Sched, bool ALIGN_EPI = false, bool SP2 = false>
__device__ __forceinline__ void gemm_phase(PG8_LAS unsigned char* lds, const Gemm g, const Sched& S, const Epi& E) {
    int tid_ = threadIdx.x; asm volatile("" : "+v"(tid_));
    const int tid = tid_, wid = __builtin_amdgcn_readfirstlane(tid >> 6), lane = tid & 63, wr = wid >> 2, wc = wid & 3, fr = lane & 15, fq = lane >> 4;
    const int K = g.K, nt = K / BK, LD = g.ld ? g.ld : g.K;
    unsigned voffA[2], voffB[2];
#pragma unroll
    for (int i = 0; i < 2; ++i) { int R, C; stage_rc(tid * 16 + i * 8192, R, C); const int Rb = Epi::PERM ? ((R & ~31) + perm32(R & 31)) : R;
        voffA[i] = (unsigned)(R * LD + C) * 2u; voffB[i] = (unsigned)(Rb * LD + C) * 2u; }
    const size_t kstep = (size_t)(BK * 2);
    const size_t hstep = (size_t)HALF * LD * 2;
    const size_t tstep = 2 * hstep;
    const unsigned ldsw = (unsigned)wid * 1024u;
    const int aoff = lds_byte(wr * 64 + fr, fq * 8), boff = lds_byte(wc * 32 + fr, fq * 8);
#define PG8_SA(b, h) (((b) * 2 + (h)) * HTB)
#define PG8_SB(b, h) ((4 + (b) * 2 + (h)) * HTB)
#define PG8_STAGE(bufoff, gbase, voff) do { _Pragma("unroll") for (int _i = 0; _i < 2; ++_i) \
        __builtin_amdgcn_global_load_lds((const unsigned*)((const char*)(gbase) + (voff)[_i]), (PG8_LAS unsigned*)(lds + (bufoff) + ldsw + _i * 8192), 16, 0, 0); } while (0)
#define PG8_LDA(dst, b, h) do { _Pragma("unroll") for (int m = 0; m < 4; ++m) _Pragma("unroll") for (int k = 0; k < 2; ++k) dst[m][k] = *(const PG8_LAS bf16x8*)(lds + PG8_SA(b, h) + aoff + m * 2048 + k * 1024); } while (0)
#define PG8_LDB(dst, b, h) do { _Pragma("unroll") for (int n = 0; n < 2; ++n) _Pragma("unroll") for (int k = 0; k < 2; ++k) dst[n][k] = *(const PG8_LAS bf16x8*)(lds + PG8_SB(b, h) + boff + n * 2048 + k * 1024); } while (0)
#define PG8_MMA(ai, bj, At, Bt) do { __builtin_amdgcn_s_setprio(1); _Pragma("unroll") for (int m = 0; m < 4; ++m) _Pragma("unroll") for (int n = 0; n < 2; ++n) _Pragma("unroll") for (int k = 0; k < 2; ++k) \
        acc[ai][bj][m][n] = __builtin_amdgcn_mfma_f32_16x16x32_bf16(Bt[n][k], At[m][k], acc[ai][bj][m][n], 0, 0, 0); __builtin_amdgcn_s_setprio(0); } while (0)
#define PG8_WAIT_V(n) asm volatile("s_waitcnt vmcnt(" #n ")" ::: "memory")
#define PG8_WAIT_L(n) asm volatile("s_waitcnt lgkmcnt(" #n ")" ::: "memory")
#define PG8_BAR __builtin_amdgcn_s_barrier()
#define PG8_SCHED __builtin_amdgcn_sched_barrier(0)
    Unit cur, nxt; int ui = 0;
    if (!S.next(0, cur)) return;
    f32x4 acc[2][2][4][2];
#pragma unroll
    for (int a = 0; a < 2; ++a)
#pragma unroll
        for (int b = 0; b < 2; ++b)
#pragma unroll
            for (int m = 0; m < 4; ++m)
#pragma unroll
                for (int n = 0; n < 2; ++n) acc[a][b][m][n] = (f32x4){0.f, 0.f, 0.f, 0.f};
    bf16x8 At[4][2], B0[2][2], B1[2][2];
    const char* cA = (const char*)g.A + (size_t)cur.pm * tstep; const char* cB = (const char*)g.Bt + (size_t)cur.pn * tstep;
    S.a_ready(cur);
    if constexpr (SP2) {
        PG8_STAGE(PG8_SB(0, 0), cB, voffB); PG8_STAGE(PG8_SB(0, 1), cB + hstep, voffB); PG8_STAGE(PG8_SA(0, 0), cA, voffA); PG8_STAGE(PG8_SA(0, 1), cA + hstep, voffA);
        if (wr == 1) PG8_BAR;
        PG8_WAIT_V(2); PG8_BAR;
        PG8_STAGE(PG8_SB(1, 0), cB + kstep, voffB); PG8_STAGE(PG8_SA(1, 0), cA + kstep, voffA); PG8_STAGE(PG8_SB(1, 1), cB + hstep + kstep, voffB);
        PG8_WAIT_V(6); PG8_BAR;
    } else {
        PG8_STAGE(PG8_SB(0, 0), cB, voffB); PG8_STAGE(PG8_SA(0, 0), cA, voffA); PG8_STAGE(PG8_SB(0, 1), cB + hstep, voffB); PG8_STAGE(PG8_SA(0, 1), cA + hstep, voffA);
        if (wr == 1) PG8_BAR;
        PG8_WAIT_V(4); PG8_BAR;
        PG8_STAGE(PG8_SB(1, 0), cB + kstep, voffB); PG8_STAGE(PG8_SA(1, 0), cA + kstep, voffA); PG8_STAGE(PG8_SB(1, 1), cB + hstep + kstep, voffB);
        PG8_WAIT_V(6); PG8_BAR;
    }
    for (;;) {
        const bool has_next = S.next(ui + 1, nxt);
        const char* nA = has_next ? (const char*)g.A + (size_t)nxt.pm * tstep : cA; const char* nB = has_next ? (const char*)g.Bt + (size_t)nxt.pn * tstep : cB;
        for (int t = 0; t < nt; t += 2) {
            const bool last = (t == nt - 2);
            const char* a1 = cA + (size_t)(t + 1) * kstep;
            const char* a2 = last ? nA : cA + (size_t)(t + 2) * kstep; const char* b2 = last ? nB : cB + (size_t)(t + 2) * kstep;
            const char* a3 = a2 + kstep; const char* b3 = b2 + kstep;
            if (last && has_next) S.a_ready(nxt);
            if constexpr (SP2) {
            PG8_LDB(B0, 0, 0); PG8_LDB(B1, 0, 1); PG8_SCHED; PG8_LDA(At, 0, 0); PG8_STAGE(PG8_SA(1, 1), a1 + hstep, voffA);
            PG8_WAIT_V(8); PG8_WAIT_L(0); PG8_BAR; PG8_MMA(0, 0, At, B0); PG8_MMA(0, 1, At, B1); PG8_BAR; PG8_SCHED;
            PG8_LDA(At, 0, 1); PG8_STAGE(PG8_SB(0, 0), b2, voffB); PG8_STAGE(PG8_SB(0, 1), b2 + hstep, voffB); PG8_STAGE(PG8_SA(0, 0), a2, voffA);
            PG8_WAIT_V(8); PG8_WAIT_L(0); PG8_BAR; PG8_MMA(1, 0, At, B0); PG8_MMA(1, 1, At, B1); PG8_BAR; PG8_SCHED;
            PG8_LDB(B0, 1, 0); PG8_LDB(B1, 1, 1); PG8_SCHED; PG8_LDA(At, 1, 0); PG8_STAGE(PG8_SA(0, 1), a2 + hstep, voffA);
            PG8_WAIT_V(8); PG8_WAIT_L(0); PG8_BAR; PG8_MMA(0, 0, At, B0); PG8_MMA(0, 1, At, B1); PG8_BAR; PG8_SCHED;
            PG8_LDA(At, 1, 1); PG8_STAGE(PG8_SB(1, 0), b3, voffB); PG8_STAGE(PG8_SB(1, 1), b3 + hstep, voffB); PG8_STAGE(PG8_SA(1, 0), a3, voffA);
            PG8_WAIT_V(8); PG8_WAIT_L(0); PG8_BAR; PG8_MMA(1, 0, At, B0); PG8_MMA(1, 1, At, B1); PG8_BAR; PG8_SCHED;
            } else {
            PG8_LDB(B0, 0, 0); PG8_SCHED; PG8_LDA(At, 0, 0); PG8_STAGE(PG8_SA(1, 1), a1 + hstep, voffA);
            PG8_WAIT_L(8); PG8_BAR; PG8_WAIT_L(0); PG8_MMA(0, 0, At, B0); PG8_BAR; PG8_SCHED;
            PG8_LDB(B1, 0, 1); PG8_STAGE(PG8_SB(0, 0), b2, voffB);
            PG8_BAR; PG8_WAIT_L(0); PG8_MMA(0, 1, At, B1); PG8_BAR;
            PG8_LDA(At, 0, 1); PG8_STAGE(PG8_SA(0, 0), a2, voffA);
            PG8_BAR; PG8_WAIT_L(0); PG8_MMA(1, 0, At, B0); PG8_BAR; PG8_SCHED;
            PG8_STAGE(PG8_SB(0, 1), b2 + hstep, voffB);
            PG8_WAIT_V(6); PG8_BAR; PG8_MMA(1, 1, At, B1); PG8_BAR;
            PG8_LDB(B0, 1, 0); PG8_SCHED; PG8_LDA(At, 1, 0); PG8_STAGE(PG8_SA(0, 1), a2 + hstep, voffA);
            PG8_WAIT_L(8); PG8_BAR; PG8_WAIT_L(0); PG8_MMA(0, 0, At, B0); PG8_BAR; PG8_SCHED;
            PG8_LDB(B1, 1, 1); PG8_STAGE(PG8_SB(1, 0), b3, voffB);
            PG8_BAR; PG8_WAIT_L(0); PG8_MMA(0, 1, At, B1); PG8_BAR;
            PG8_LDA(At, 1, 1); PG8_STAGE(PG8_SA(1, 0), a3, voffA);
            PG8_BAR; PG8_WAIT_L(0); PG8_MMA(1, 0, At, B0); PG8_BAR; PG8_SCHED;
            PG8_STAGE(PG8_SB(1, 1), b3 + hstep, voffB);
            PG8_WAIT_V(6); PG8_BAR; PG8_MMA(1, 1, At, B1); PG8_BAR;
            }
        }
        if constexpr (ALIGN_EPI) { if (wr == 0) PG8_BAR; }
        if constexpr (!Epi::AFTER_DRAIN) { E(acc, cur, wr, wc, fr, fq); S.done(cur); }
        if (!has_next) break;
#pragma unroll
        for (int a = 0; a < 2; ++a)
#pragma unroll
            for (int b = 0; b < 2; ++b)
#pragma unroll
                for (int m = 0; m < 4; ++m)
#pragma unroll
                    for (int n = 0; n < 2; ++n) acc[a][b][m][n] = (f32x4){0.f, 0.f, 0.f, 0.f};
        cur = nxt; cA = nA; cB = nB; ++ui;
        if constexpr (ALIGN_EPI) { if (wr == 1) PG8_BAR; }
    }
    PG8_WAIT_V(0);
    if constexpr (!ALIGN_EPI) { if (wr == 0) PG8_BAR; }
    PG8_BAR;
    if constexpr (Epi::AFTER_DRAIN) { E.fused(acc, cur, wr, wc, fr, fq, lds, wid, lane); S.done(cur); }
#undef PG8_SA
#undef PG8_SB
#undef PG8_STAGE
#undef PG8_LDA
#undef PG8_LDB
#undef PG8_MMA
#undef PG8_WAIT_V
#undef PG8_WAIT_L
#undef PG8_BAR
#undef PG8_SCHED
}
}
#else
namespace pg8 {
typedef unsigned short bf16_t;
constexpr int BM = 256, BK = 64, HALF = 128, NXCD = 8, WGM = 8;
struct Unit { int pm, pn; };
struct Gemm { const bf16_t* A; const bf16_t* Bt; int M, N, K, ld; };
struct StaticOrder {
    int nM, nN, nwg, G, c, wave, lim, tn, tpm, tpn, tw;
    void init(int M, int N, int G_, int c_) { nM = M / BM; nN = N / BM; nwg = nM * nN; G = G_; c = c_; lim = 0x7fffffff; tn = 0; tpm = 0; tpn = 0; tw = 1; }
    bool next(int i, Unit& u) const {
        const long L = (long)i * G + c; if (L >= nwg + tn || L >= lim) return false;
        if (L >= nwg) { const int idx = (int)L - nwg; u.pm = tpm + idx / tw; u.pn = tpn + idx % tw; return true; }
        int wgid = (int)L; { const int q = nwg / NXCD, r = nwg % NXCD, xcd = wgid % NXCD, off = wgid / NXCD; wgid = (xcd < r ? xcd * (q + 1) : r * (q + 1) + (xcd - r) * q) + off; }
        const int nig = WGM * nN, gid = wgid / nig, fm = gid * WGM, gsz = (nM - fm) < WGM ? (nM - fm) : WGM;
        u.pm = fm + ((wgid % nig) % gsz); u.pn = (wgid % nig) / gsz; return true;
    }
};
template <class Epi, class Sched, bool ALIGN_EPI = false, bool SP2 = false>
static inline void gemm_phase(unsigned char* lds, const Gemm g, const Sched& S, const Epi& E) {
    const int tid = TIDX, wid = tid >> 6, lane = tid & 63, wr = wid >> 2, wc = wid & 3, fr = lane & 15, fq = lane >> 4;
    Unit u;
    for (int i = 0; S.next(i, u); ++i) {
        f32x4 acc[2][2][4][2];
        for (int ai = 0; ai < 2; ++ai) for (int bj = 0; bj < 2; ++bj) for (int m = 0; m < 4; ++m) for (int n = 0; n < 2; ++n) for (int j = 0; j < 4; ++j) {
            const int row = 256 * u.pm + 128 * ai + 64 * wr + 16 * m + fr;
            const int col = Epi::PERM ? 256 * u.pn + 128 * bj + 32 * wc + 8 * fq + 4 * n + j : 256 * u.pn + 128 * bj + 32 * wc + 16 * n + 4 * fq + j;
            const int ld = g.ld ? g.ld : g.K; const bf16_t* a = g.A + (size_t)row * ld; const bf16_t* b = g.Bt + (size_t)col * ld; float s = 0.f;
            for (int k = 0; k < g.K; ++k) s += bf2f(a[k]) * bf2f(b[k]);
            acc[ai][bj][m][n][j] = s; }
        E(acc, u, wr, wc, fr, fq);
    }
    BLOCK_SYNC();
}
}
#define PG8_LAS
#endif

#if !defined(EMU) && defined(SIMPLE_GEMM)
namespace sg {
template <class Epi, class Sched>
__device__ __forceinline__ void gemm_phase(const pg8::Gemm g, const Sched& S, const Epi& E) {
    int tid_ = threadIdx.x; asm volatile("" : "+v"(tid_));
    const int tid = tid_, wid = __builtin_amdgcn_readfirstlane(tid >> 6), lane = tid & 63, wr = wid >> 2, wc = wid & 3, fr = lane & 15, fq = lane >> 4;
    pg8::Unit u;
    for (int i = 0; S.next(i, u); ++i) {
        f32x4 acc[2][2][4][2];
#pragma unroll
        for (int ai = 0; ai < 2; ++ai)
#pragma unroll
            for (int bj = 0; bj < 2; ++bj)
#pragma unroll
                for (int m = 0; m < 4; ++m)
#pragma unroll
                    for (int n = 0; n < 2; ++n) acc[ai][bj][m][n] = (f32x4){0.f, 0.f, 0.f, 0.f};
        const bf16_t* wp0 = g.Bt + (size_t)(256 * u.pn + 32 * wc + (Epi::PERM ? 8 * (fr >> 2) + (fr & 3) : fr)) * g.K + 8 * fq;
        const bf16_t* xp0 = g.A + (size_t)(256 * u.pm + 64 * wr + fr) * g.K + 8 * fq;
#pragma unroll 1
        for (int k0 = 0; k0 < g.K; k0 += 32) {
            bf16x8 wf[2][2], xf[2][4];
#pragma unroll
            for (int bj = 0; bj < 2; ++bj)
#pragma unroll
                for (int n = 0; n < 2; ++n) wf[bj][n] = *(const bf16x8*)(wp0 + (size_t)(128 * bj + (Epi::PERM ? 4 : 16) * n) * g.K + k0);
#pragma unroll
            for (int ai = 0; ai < 2; ++ai)
#pragma unroll
                for (int m = 0; m < 4; ++m) xf[ai][m] = *(const bf16x8*)(xp0 + (size_t)(128 * ai + 16 * m) * g.K + k0);
#pragma unroll
            for (int ai = 0; ai < 2; ++ai)
#pragma unroll
                for (int bj = 0; bj < 2; ++bj)
#pragma unroll
                    for (int m = 0; m < 4; ++m)
#pragma unroll
                        for (int n = 0; n < 2; ++n) acc[ai][bj][m][n] = __builtin_amdgcn_mfma_f32_16x16x32_bf16(wf[bj][n], xf[ai][m], acc[ai][bj][m][n], 0, 0, 0);
        }
        E(acc, u, wr, wc, fr, fq);
    }
}
}
#define GEMM_PHASE(EpiT, lds, g, S, E) sg::gemm_phase<EpiT, pg8::StaticOrder>(g, S, E)
#else
#define GEMM_PHASE(EpiT, lds, g, S, E) pg8::gemm_phase<EpiT, pg8::StaticOrder, true, true>((PG8_LAS unsigned char*)(lds), g, S, E)
#endif

struct EpiSeg {
    static constexpr bool PERM = true, AFTER_DRAIN = false;
    bf16_t* P; int odd;
    DEVM void operator()(const f32x4 (&acc)[2][2][4][2], const pg8::Unit& u, int wr, int wc, int fr, int fq) const {
        size_t off; int pitch, c0;
        const int pn = u.pn;
        if (!odd) {
            if (pn < 2) { off = PE_QA; pitch = 512; c0 = 256 * pn; } else if (pn < 4) { off = PE_KA; pitch = 512; c0 = 256 * (pn - 2); } else if (pn < 6) { off = PE_VA; pitch = 512; c0 = 256 * (pn - 4); }
            else if (pn == 6) { off = PE_BQ; pitch = 256; c0 = 0; } else if (pn == 7) { off = PE_BK; pitch = 256; c0 = 0; } else if (pn < 10) { off = PE_BV; pitch = 512; c0 = 256 * (pn - 8); } else { off = PE_BO; pitch = 512; c0 = 256 * (pn - 10); }
        } else {
            if (pn < 2) { off = PO_QC; pitch = 512; c0 = 256 * pn; } else if (pn == 2) { off = PO_KVC; pitch = 256; c0 = 0; } else if (pn < 9) { off = PO_DQKV; pitch = 1536; c0 = 256 * (pn - 3); } else { off = PO_Z; pitch = 512; c0 = 256 * (pn - 9); }
        }
        bf16_t* base = P + off;
        const int row0 = u.pm * 256 + wr * 64 + fr, col0 = c0 + wc * 32 + 8 * fq;
#pragma unroll
        for (int ai = 0; ai < 2; ++ai)
#pragma unroll
            for (int m = 0; m < 4; ++m) { bf16_t* rowp = base + (size_t)(row0 + ai * 128 + m * 16) * pitch + col0;
#pragma unroll
                for (int bj = 0; bj < 2; ++bj) { const f32x4 v0 = acc[ai][bj][m][0], v1 = acc[ai][bj][m][1];
                    u32x4 w; w[0] = pk2(v0[0], v0[1]); w[1] = pk2(v0[2], v0[3]); w[2] = pk2(v1[0], v1[1]); w[3] = pk2(v1[2], v1[3]);
                    *(u32x4*)(rowp + bj * 128) = w; } }
    }
};
struct EpiResid {
    static constexpr bool PERM = false, AFTER_DRAIN = false;
    float* X; const float* mod; int gaoff;
    const float* XL; const float* XC;
    DEVM void operator()(const f32x4 (&acc)[2][2][4][2], const pg8::Unit& u, int wr, int wc, int fr, int fq) const {
        const int rowt = u.pm * 256; const int mr = rowt < ML ? rowt / SEQ : NB;
        const float* ga = mod + (size_t)mr * 6 * D + gaoff; const float* Xs = rowt < ML ? XL : XC;
        const int row0 = rowt + wr * 64 + fr, col0 = u.pn * 256 + wc * 32 + 4 * fq;
#pragma unroll
        for (int bj = 0; bj < 2; ++bj)
#pragma unroll
            for (int n = 0; n < 2; ++n) { const int c = col0 + bj * 128 + n * 16; const f32x4 g = *(const f32x4*)(ga + c);
#pragma unroll
                for (int ai = 0; ai < 2; ++ai)
#pragma unroll
                    for (int m = 0; m < 4; ++m) { const size_t off = (size_t)(row0 + ai * 128 + m * 16) * D + c; const f32x4 x = *(const f32x4*)(Xs + off); *(f32x4*)(X + off) = x + g * acc[ai][bj][m][n]; } }
    }
};
struct EpiPart {
    static constexpr bool PERM = false, AFTER_DRAIN = false;
    float* P;
    DEVM void operator()(const f32x4 (&acc)[2][2][4][2], const pg8::Unit& u, int wr, int wc, int fr, int fq) const {
        (void)u; const int r0 = wr * 64 + fr, c0 = wc * 32 + 4 * fq;
#pragma unroll
        for (int bj = 0; bj < 2; ++bj)
#pragma unroll
            for (int n = 0; n < 2; ++n)
#pragma unroll
                for (int ai = 0; ai < 2; ++ai)
#pragma unroll
                    for (int m = 0; m < 4; ++m) *(f32x4*)(P + (size_t)(r0 + ai * 128 + m * 16) * 256 + c0 + bj * 128 + n * 16) = acc[ai][bj][m][n];
    }
};
struct SplitPlan { int extra, split, nwg; };
DEV SplitPlan split_plan(int mrows, int kdim, int nblk, bool allow) {
    SplitPlan p; p.nwg = (mrows / 256) * (D / 256); p.extra = 0; p.split = 1;
    if (allow && p.nwg > nblk && p.nwg < 2 * nblk) { const int pairs = kdim / 128; int sp = 4; const int ex = p.nwg - nblk;
        while (sp > 1 && (ex * sp > nblk || sp > pairs || ex * sp > 128)) sp >>= 1;
        if (sp > 1) { p.extra = ex; p.split = sp; } }
    return p;
}

struct EpiSwiglu {
    static constexpr bool PERM = true, AFTER_DRAIN = false;
    bf16_t* ACT;
    DEVM void operator()(const f32x4 (&acc)[2][2][4][2], const pg8::Unit& u, int wr, int wc, int fr, int fq) const {
        const int row0 = u.pm * 256 + wr * 64 + fr, col0 = u.pn * 128 + wc * 32 + 8 * fq;
#pragma unroll
        for (int ai = 0; ai < 2; ++ai)
#pragma unroll
            for (int m = 0; m < 4; ++m) { bf16_t* rowp = ACT + (size_t)(row0 + ai * 128 + m * 16) * FF + col0;
                float v[8];
#pragma unroll
                for (int n = 0; n < 2; ++n)
#pragma unroll
                    for (int j = 0; j < 4; ++j) { const float g = acc[ai][0][m][n][j], up = acc[ai][1][m][n][j]; v[4 * n + j] = siluf_(g) * up; }
                u32x4 w; w[0] = pk2(v[0], v[1]); w[1] = pk2(v[2], v[3]); w[2] = pk2(v[4], v[5]); w[3] = pk2(v[6], v[7]);
                *(u32x4*)rowp = w; }
    }
};

DEV void p0_prologue(const Ctx& c) {
    const float* x = c.in[0]; const float* cv = c.in[1]; const float* ctx = c.in[2]; const float* cctx = c.in[3]; const float* w_ada = c.in[4]; const float* b_ada = c.in[5];
    float* MOD = (float*)(c.ws + OFF_MOD);
    const long gt = (long)c.bid * NTHREADS + c.tid, GT = (long)c.nblk * NTHREADS;
    {   constexpr int NCG = 6 * D / 128, KW = D / 8; f32x2* part = (f32x2*)c.lds;
        for (int it = c.bid; it < DEPTH * NCG; it += c.nblk) { const int l = it / NCG, cg = it % NCG; const int n2 = cg * 64 + c.lane;
            f32x2 acc[9];
#pragma unroll
            for (int r = 0; r < 9; ++r) acc[r] = (f32x2){0.f, 0.f};
            const float* W = w_ada + ((size_t)l * D + c.wave * KW) * 6 * D + 2 * n2;
#pragma unroll 8
            for (int k = 0; k < KW; ++k) { const f32x2 w = *(const f32x2*)(W + (size_t)k * 6 * D); const int kk = c.wave * KW + k;
#pragma unroll
                for (int r = 0; r < 9; ++r) { const float sv = siluf_(r < NB ? cv[r * D + kk] : cctx[kk]); acc[r] += w * sv; } }
#pragma unroll
            for (int r = 0; r < 9; ++r) part[(c.wave * 9 + r) * 64 + c.lane] = acc[r];
            BLOCK_SYNC();
            for (int o = c.tid; o < 9 * 64; o += NTHREADS) { const int r = o / 64, q = o % 64; f32x2 sum = *(const f32x2*)(b_ada + (size_t)l * 6 * D + 2 * (cg * 64 + q));
#pragma unroll
                for (int w = 0; w < 8; ++w) sum += part[(w * 9 + r) * 64 + q];
                *(f32x2*)(MOD + ((size_t)l * 9 + r) * 6 * D + 2 * (cg * 64 + q)) = sum; }
            BLOCK_SYNC(); } }
    float* COS = (float*)(c.ws + OFF_ROPE); float* SIN = COS + SEQ * 32;
    for (long it = gt; it < (long)SEQ * 32; it += GT) { const int t = (int)(it >> 5), i = (int)(it & 31);
        const float fr = expf(-(float)(i & 15) * (9.210340371976184f / 16.0f));     const float pos = (i < 16) ? (float)(t / GRIDW) : (float)(t % GRIDW); const float a = pos * fr;
        COS[it] = cosf(a); SIN[it] = sinf(a); }
    (void)x; (void)ctx;
}

DEV void transpose_item(const float* W, int srcpitch, int k0, int n0, bf16_t* WT, int Kp, int dstrow0, float* scr, int lane) {
#pragma unroll 8
    for (int i = 0; i < 32; ++i) { const int kk = 2 * i + (lane >> 5); scr[kk * 33 + (lane & 31)] = W[(size_t)(k0 + kk) * srcpitch + n0 + (lane & 31)]; }
    WAVE_FENCE();
    const int cc = lane & 7;
#pragma unroll
    for (int j = 0; j < 4; ++j) { const int n = (lane >> 3) + 8 * j; const float* s = scr + (8 * cc) * 33 + n;
        u32x4 o; o[0] = pk2(s[0 * 33], s[1 * 33]); o[1] = pk2(s[2 * 33], s[3 * 33]); o[2] = pk2(s[4 * 33], s[5 * 33]); o[3] = pk2(s[6 * 33], s[7 * 33]);
        *(u32x4*)(WT + (size_t)(dstrow0 + n) * Kp + k0 + 8 * cc) = o; }
    WAVE_FENCE();
}
DEV void convert_mixer_weights(const Ctx& c, int layer, int gw, int ngw) {
    float* scr = (float*)(c.lds + c.wave * 8448);
    const int odd = layer & 1, li = layer >> 1;
    const float* win = odd ? c.in[14] + (size_t)li * D * O_IN : c.in[8] + (size_t)li * D * E_IN; const int pin = odd ? O_IN : E_IN, nin = odd ? NO : NE;
    const float* wout = odd ? c.in[20] + (size_t)li * 1024 * D : c.in[13] + (size_t)li * 1024 * D;
    bf16_t* WIN = (bf16_t*)(c.ws + OFF_WIN); bf16_t* WOUT = (bf16_t*)(c.ws + OFF_WOUT);
    const int I1 = (D / 64) * (nin / 32), I2 = (1024 / 64) * (D / 32);
    for (int it = gw; it < I1 + I2; it += ngw) {
        if (it < I1) { const int nb = it % (nin / 32), kb = it / (nin / 32); transpose_item(win, pin, 64 * kb, 32 * nb, WIN, D, 32 * nb, scr, c.lane); }
        else { const int r = it - I1; const int nb = r % (D / 32), kb = r / (D / 32); transpose_item(wout, D, 64 * kb, 32 * nb, WOUT, 1024, 32 * nb, scr, c.lane); }
    }
}
DEV void convert_ffn_weights(const Ctx& c, int layer, int gw, int ngw) {
    float* scr = (float*)(c.lds + c.wave * 8448);
    const float* wg = c.in[21] + (size_t)layer * D * FF; const float* wu = c.in[22] + (size_t)layer * D * FF; const float* wd = c.in[23] + (size_t)layer * FF * D;
    bf16_t* WGU = (bf16_t*)(c.ws + SF_WGU); bf16_t* WDN = (bf16_t*)(c.ws + SF_WDN);
    const int I1 = (D / 64) * (FF / 32), I3 = (FF / 64) * (D / 32);
    for (int it = gw; it < 2 * I1 + I3; it += ngw) {
        if (it < 2 * I1) { const int up = it >= I1; const int r = up ? it - I1 : it; const int nb = r % (FF / 32), kb = r / (FF / 32); const int f0 = 32 * nb;
            transpose_item(up ? wu : wg, FF, 64 * kb, f0, WGU, D, (f0 / 128) * 256 + (up ? 128 : 0) + (f0 % 128), scr, c.lane); }
        else { const int r = it - 2 * I1; const int nb = r % (D / 32), kb = r / (D / 32); transpose_item(wd, D, 64 * kb, 32 * nb, WDN, FF, 32 * nb, scr, c.lane); }
    }
}
DEV void normalize_rows(const Ctx& c, int layer, int which, int nrows, SplitPlan red, int pmrows, const float* pga) {
    constexpr int NV = D / 256;
    float* X = (float*)(c.ws + OFF_X); bf16_t* H = (bf16_t*)(c.ws + OFF_HY); float* G = (float*)(c.ws + OFF_G);
    const float* MODL = (const float*)(c.ws + OFF_MOD) + (size_t)layer * 9 * 6 * D;
    const float* g = (which ? c.in[7] : c.in[6]) + (size_t)layer * D;
    const int odd = layer & 1, li = layer >> 1;
    const float* wgate = odd ? c.in[14] + (size_t)li * D * O_IN + NO : c.in[8] + (size_t)li * D * E_IN + NE; const int pg = odd ? O_IN : E_IN;
    float* wgt = (float*)c.lds;
    unsigned char* tab = (unsigned char*)(c.lds + 16 * D * 4);
    const float* PART = (const float*)(c.ws + SF_PART);
    if (red.extra) { BLOCK_SYNC();
        for (int e = c.tid; e < (pmrows / 256) * (D / 256); e += NTHREADS) tab[e] = 255;
        BLOCK_SYNC();
        if (c.tid < red.extra) { pg8::StaticOrder S2; S2.init(pmrows, D, red.nwg, c.nblk + c.tid); pg8::Unit u; if (S2.next(0, u)) tab[u.pm * (D / 256) + u.pn] = (unsigned char)c.tid; }
        BLOCK_SYNC(); }
    if (which == 0) { BLOCK_SYNC();
        for (int e = c.tid; e < D * 4; e += NTHREADS) { const int k = e >> 2, q = e & 3; const f32x4 w4 = *(const f32x4*)(wgate + (size_t)k * pg + 4 * q);
#pragma unroll
            for (int j = 0; j < 4; ++j) wgt[(4 * q + j) * D + k] = w4[j]; }
        BLOCK_SYNC(); }
    for (int row = c.gw; row < nrows; row += c.ngw) {
        const int mr = row < ML ? row / SEQ : NB;
        const float* sh = MODL + (size_t)mr * 6 * D + (which ? 3 : 0) * D; const float* sc = sh + D;
        const float* xrow = (layer == 0 && which == 0) ? (row < ML ? c.in[0] + (size_t)row * D : c.in[2] + (size_t)(row - ML) * D) : X + (size_t)row * D;
        const f32x4* xr = (const f32x4*)xrow + c.lane;
        f32x4 v[NV]; float ss = 0.f;
#pragma unroll
        for (int j = 0; j < NV; ++j) { v[j] = xr[64 * j];
            if (red.extra && row < pmrows) { const int lu = tab[(row >> 8) * (D / 256) + j];
                if (lu != 255) { const float* pp = PART + (size_t)lu * red.split * 65536 + (size_t)(row & 255) * 256 + 4 * c.lane; f32x4 sum = *(const f32x4*)pp;
                    for (int q = 1; q < red.split; ++q) sum += *(const f32x4*)(pp + (size_t)q * 65536);
                    v[j] += *(const f32x4*)(pga + (size_t)mr * 6 * D + 256 * j + 4 * c.lane) * sum; ((f32x4*)(X + (size_t)row * D) + c.lane)[64 * j] = v[j]; } }
            ss += (v[j][0] * v[j][0] + v[j][1] * v[j][1]) + (v[j][2] * v[j][2] + v[j][3] * v[j][3]); }
        const float rstd = 1.0f / sqrtf(wave_sum(ss) * (1.0f / D) + EPS);
        u32x2* o8 = (u32x2*)(H + (size_t)row * D) + c.lane;
        float ga[16];
#pragma unroll
        for (int n = 0; n < 16; ++n) ga[n] = 0.f;
#pragma unroll
        for (int j = 0; j < NV; ++j) { const int k0 = 256 * j + 4 * c.lane;
            const f32x4 gg = *(const f32x4*)(g + k0), s1 = *(const f32x4*)(sc + k0), s0 = *(const f32x4*)(sh + k0);
            f32x4 h = v[j] * rstd * gg * (s1 + 1.0f) + s0;
            u32x2 w; w[0] = pk2(h[0], h[1]); w[1] = pk2(h[2], h[3]); o8[64 * j] = w;
            if (which == 0) {
#pragma unroll
                for (int n = 0; n < 16; ++n) { const f32x4 w4 = *(const f32x4*)(wgt + n * D + k0); ga[n] += (h[0] * w4[0] + h[1] * w4[1]) + (h[2] * w4[2] + h[3] * w4[3]); if ((n & 7) == 7) SCHED_FENCE(); } } }
        if (which == 0) {
            const bool b5 = c.lane & 32, b4 = c.lane & 16, b3 = c.lane & 8, b2 = c.lane & 4;
            float w8[8], w4[4], w2[2];
#pragma unroll
            for (int n = 0; n < 8; ++n) { const float snd = b5 ? ga[n] : ga[n + 8], kp = b5 ? ga[n + 8] : ga[n]; w8[n] = kp + SHFL_XOR(snd, 32); }
#pragma unroll
            for (int n = 0; n < 4; ++n) { const float snd = b4 ? w8[n] : w8[n + 4], kp = b4 ? w8[n + 4] : w8[n]; w4[n] = kp + SHFL_XOR(snd, 16); }
#pragma unroll
            for (int n = 0; n < 2; ++n) { const float snd = b3 ? w4[n] : w4[n + 2], kp = b3 ? w4[n + 2] : w4[n]; w2[n] = kp + SHFL_XOR(snd, 8); }
            float z = (b2 ? w2[1] : w2[0]) + SHFL_XOR(b2 ? w2[0] : w2[1], 4);
            z += SHFL_XOR(z, 2); z += SHFL_XOR(z, 1);
            if ((c.lane & 3) == 0) G[(size_t)row * 16 + (b5 ? 8 : 0) + (b4 ? 4 : 0) + (b3 ? 2 : 0) + (b2 ? 1 : 0)] = z; }
    }
}

DEV int tok_row(int b, int tc, int i) { return tc < NCC ? ML + b * CTX + 64 * tc + i : b * SEQ + 64 * (tc - NCC) + i; }
DEV int pos_row(int b, int pos) { return pos < CTX ? ML + b * CTX + pos : b * SEQ + (pos - CTX); }
DEV int chain_chunk(int dir, int tc) { return dir == 0 ? tc : (tc < NCC ? NCC - 1 - tc : NCC + (NLC - 1 - (tc - NCC))); }
DEV void unpack8(bf16x8 v, float (&f)[8]) {
#pragma unroll
    for (int e = 0; e < 8; ++e) f[e] = bf2f((unsigned short)v[e]);
}
DEV bf16x8 pack8(const float (&f)[8]) { u32x4 p; p[0] = pk2(f[0], f[1]); p[1] = pk2(f[2], f[3]); p[2] = pk2(f[4], f[5]); p[3] = pk2(f[6], f[7]); return __builtin_bit_cast(bf16x8, p); }
DEV float chain_cumsum(float x, int lane, int dir) {
#pragma unroll
    for (int off = 1; off < 64; off <<= 1) { const int src = dir == 0 ? lane - off : lane + off; const float y = SHFL(x, src & 63); if (src >= 0 && src < 64) x += y; }
    return x;
}

constexpr int AT_KB = 64 * 72 * 2;
template <int DV> struct AttnLds { static constexpr int VB = DV * 72 * 2, BUF = AT_KB + VB; };

template <int DV>
DEV void attn_stage_load(const Ctx& c, const bf16_t* Kp, const bf16_t* Vt, int vpitch, int tile, bf16x8& kreg, bf16x8 (&vreg)[DV / 64]) {
    kreg = ld16(Kp + (size_t)(tile * 64 + (c.tid >> 3)) * 64 + (c.tid & 7) * 8);
#pragma unroll
    for (int i = 0; i < DV / 64; ++i) { const int idx = c.tid + 512 * i; vreg[i] = ld16(Vt + (size_t)(idx >> 3) * vpitch + tile * 64 + (idx & 7) * 8); }
}
template <int DV>
DEV void attn_stage_store(const Ctx& c, int boff, const bf16x8& kreg, const bf16x8 (&vreg)[DV / 64]) {
    char* kb = c.lds + boff; char* vb = kb + AT_KB;
    *(bf16x8*)(kb + (c.tid >> 3) * 144 + (c.tid & 7) * 16) = kreg;
#pragma unroll
    for (int i = 0; i < DV / 64; ++i) { const int idx = c.tid + 512 * i; *(bf16x8*)(vb + (idx >> 3) * 144 + (idx & 7) * 16) = vreg[i]; }
}
DEV void attn_qk(const char* kb, int rk, int h, const bf16x8 (&qf)[4], f32x16& p0, f32x16& p1) {
#pragma unroll
    for (int i = 0; i < 16; ++i) { p0[i] = 0.f; p1[i] = 0.f; }
#pragma unroll
    for (int ks = 0; ks < 4; ++ks) { const bf16x8 a0 = ld16(kb + rk * 144 + ks * 32 + h * 16), a1 = ld16(kb + (32 + rk) * 144 + ks * 32 + h * 16);
        p0 = MFMA32(a0, qf[ks], p0); p1 = MFMA32(a1, qf[ks], p1); }
}
DEV void attn_sm1(f32x16& p0, f32x16& p1, float& m, float& alpha) {
    const float C2 = 0.125f * 1.4426950408889634f;
    float mx = p0[0];
#pragma unroll
    for (int i = 0; i < 16; ++i) { mx = fmaxf(mx, p0[i]); mx = fmaxf(mx, p1[i]); }
    mx = fmaxf(mx, SHFL_XOR(mx, 32));
    alpha = 1.0f;
    if (WAVE_ANY(mx * C2 > m + 8.0f)) { const float mn = fmaxf(m, mx * C2); alpha = EXP2F(m - mn); m = mn; }
#pragma unroll
    for (int i = 0; i < 16; ++i) { p0[i] = p0[i] * C2 - m; p1[i] = p1[i] * C2 - m; }
#pragma unroll
    for (int i = 0; i < 16; ++i) p0[i] = EXP2F(p0[i]);
}
DEV void attn_sm2(f32x16& p0, f32x16& p1, float alpha, float& l, bf16x8 (&pb)[4]) {
#pragma unroll
    for (int i = 0; i < 16; ++i) p1[i] = EXP2F(p1[i]);
    float rs = 0.f;
#pragma unroll
    for (int i = 0; i < 16; ++i) rs += p0[i] + p1[i];
    l = l * alpha + rs;
    pb[0] = pack_acc(p0, 0); pb[1] = pack_acc(p0, 1); pb[2] = pack_acc(p1, 0); pb[3] = pack_acc(p1, 1);
}
template <int DV>
DEV void attn_pv(const char* vb, int r, int h, const bf16x8 (&pb)[4], f32x16 (&o)[DV / 32]) {
#pragma unroll
    for (int us = 0; us < 4; ++us)
#pragma unroll
        for (int dt = 0; dt < DV / 32; ++dt) { const bf16x8 va = ld16(vb + (32 * dt + r) * 144 + (16 * us + 8 * h) * 2); o[dt] = MFMA32(va, pb[us], o[dt]); }
}
template <int DV>
DEV void attn_resc(f32x16 (&o)[DV / 32], float alpha) {
    if (WAVE_ANY(alpha < 1.0f)) {
#pragma unroll
        for (int dt = 0; dt < DV / 32; ++dt)
#pragma unroll
            for (int i = 0; i < 16; ++i) o[dt][i] *= alpha; }
}
template <int DV>
DEV void attn_step(const Ctx& c, const bf16_t* Kp, const bf16_t* Vt, int vpitch, int j, int nt, const bf16x8 (&qf)[4], bool active, int rk, int ox, int oy, int on,
                   bf16x8 (&pb)[4], f32x16 (&o)[DV / 32], float& m, float& l) {
    const int r = c.lane & 31, h = c.lane >> 5; const bool more = j + 1 < nt; const float C2 = 0.125f * 1.4426950408889634f;
    bf16x8 kreg, vreg[DV / 64]; f32x16 p0, p1;
    if (active) attn_qk(c.lds + ox, rk, h, qf, p0, p1);
    SCHED_FENCE();
    if (more) attn_stage_load<DV>(c, Kp, Vt, vpitch, j + 1, kreg, vreg);
    if (active) { const char* vb = c.lds + oy + AT_KB;
        float mx = 0.f, alpha = 1.0f;
#pragma unroll
        for (int us = 0; us < 4; ++us) {
            SCHED_FENCE();
#pragma unroll
            for (int dt = 0; dt < DV / 32; ++dt) { const bf16x8 va = ld16(vb + (32 * dt + r) * 144 + (16 * us + 8 * h) * 2); o[dt] = MFMA32(va, pb[us], o[dt]); }
            SCHED_FENCE();
            if (us == 0) { mx = p0[0];
#pragma unroll
                for (int i = 0; i < 16; ++i) { mx = fmaxf(mx, p0[i]); mx = fmaxf(mx, p1[i]); }
                mx = fmaxf(mx, SHFL_XOR(mx, 32));
                if (WAVE_ANY(mx * C2 > m + 8.0f)) { const float mn = fmaxf(m, mx * C2); alpha = EXP2F(m - mn); m = mn; } }
            else if (us == 1) {
#pragma unroll
                for (int i = 0; i < 16; ++i) { p0[i] = p0[i] * C2 - m; p1[i] = p1[i] * C2 - m; } }
            else if (us == 2) {
#pragma unroll
                for (int i = 0; i < 16; ++i) p0[i] = EXP2F(p0[i]); }
            else {
#pragma unroll
                for (int i = 0; i < 16; ++i) p1[i] = EXP2F(p1[i]); }
        }
        SCHED_FENCE();
        float rs = 0.f;
#pragma unroll
        for (int i = 0; i < 16; ++i) rs += p0[i] + p1[i];
        l = l * alpha + rs;
        pb[0] = pack_acc(p0, 0); pb[1] = pack_acc(p0, 1); pb[2] = pack_acc(p1, 0); pb[3] = pack_acc(p1, 1);
        attn_resc<DV>(o, alpha); }
    if (more) attn_stage_store<DV>(c, on, kreg, vreg);
    BLOCK_SYNC();
}
template <int DV>
DEV void attn_pass(const Ctx& c, const bf16_t* Kp, const bf16_t* Vt, int vpitch, int nk, const bf16x8 (&qf)[4], bool active, f32x16 (&o)[DV / 32], float& m, float& l) {
    const int r = c.lane & 31, h = c.lane >> 5; const int rk = (r & 0x13) | ((r & 4) << 1) | ((r & 8) >> 1);
    const int nt = nk / 64; constexpr int BUF = AttnLds<DV>::BUF;
#pragma unroll
    for (int dt = 0; dt < DV / 32; ++dt)
#pragma unroll
        for (int i = 0; i < 16; ++i) o[dt][i] = 0.f;
    m = -1e30f; l = 0.f;
    bf16x8 pb[4];
    { bf16x8 kreg, vreg[DV / 64];
      attn_stage_load<DV>(c, Kp, Vt, vpitch, 0, kreg, vreg); attn_stage_store<DV>(c, 0, kreg, vreg);
      attn_stage_load<DV>(c, Kp, Vt, vpitch, 1, kreg, vreg); attn_stage_store<DV>(c, BUF, kreg, vreg); }
    BLOCK_SYNC();
    if (active) { f32x16 p0, p1; float alpha; attn_qk(c.lds, rk, h, qf, p0, p1); attn_sm1(p0, p1, m, alpha); attn_sm2(p0, p1, alpha, l, pb); }
    else {
#pragma unroll
        for (int i = 0; i < 4; ++i) pb[i] = (bf16x8){0, 0, 0, 0, 0, 0, 0, 0}; }
    int ox = BUF, oy = 0, on = 2 * BUF;
    for (int j = 1; j < nt; ++j) {
        attn_step<DV>(c, Kp, Vt, vpitch, j, nt, qf, active, rk, ox, oy, on, pb, o, m, l); { const int t_ = oy; oy = ox; ox = on; on = t_; }
    }
    if (active) attn_pv<DV>(c.lds + oy + AT_KB, r, h, pb, o);
    BLOCK_SYNC();
}
DEV void load_q(const Ctx& c, const bf16_t* Qrow  , bool valid, bool rope, int t, const float* qg  , bf16x8 (&qf)[4]) {
    const int h = c.lane >> 5;
    float f[4][8];
#pragma unroll
    for (int ks = 0; ks < 4; ++ks) { bf16x8 v = (bf16x8){0, 0, 0, 0, 0, 0, 0, 0}; if (valid) v = ld16(Qrow + 16 * ks + 8 * h); unpack8(v, f[ks]); }
    if (qg) { float ss = 0.f;
#pragma unroll
        for (int ks = 0; ks < 4; ++ks)
#pragma unroll
            for (int e = 0; e < 8; ++e) ss += f[ks][e] * f[ks][e];
        ss += SHFL_XOR(ss, 32);
        const float rstd = 1.0f / sqrtf(ss * (1.0f / 64.0f) + EPS);
#pragma unroll
        for (int ks = 0; ks < 4; ++ks)
#pragma unroll
            for (int e = 0; e < 8; ++e) f[ks][e] = f[ks][e] * rstd * qg[16 * ks + 8 * h + e]; }
    if (rope) { const float* COS = (const float*)(c.ws + OFF_ROPE) + (size_t)t * 32; const float* SIN = COS + (size_t)SEQ * 32;
#pragma unroll
        for (int a = 0; a < 2; ++a)
#pragma unroll
            for (int e = 0; e < 8; ++e) { const float cs = COS[a * 16 + 8 * h + e], sn = SIN[a * 16 + 8 * h + e]; const float x1 = f[2 * a][e], x2 = f[2 * a + 1][e];
                f[2 * a][e] = x1 * cs - x2 * sn; f[2 * a + 1][e] = x2 * cs + x1 * sn; } }
#pragma unroll
    for (int ks = 0; ks < 4; ++ks) qf[ks] = pack8(f[ks]);
}

DEV void even_kprep(const Ctx& c) {
    const bf16_t* KA = (const bf16_t*)(c.ws + OFF_P) + PE_KA; bf16_t* KP = (bf16_t*)(c.ws + SE_KP);
    const float* COS = (const float*)(c.ws + OFF_ROPE); const float* SIN = COS + (size_t)SEQ * 32;
    const int l7 = c.lane & 7, a = l7 >> 2, p = (l7 >> 1) & 1, f0 = 8 * (l7 & 1), vh = c.lane >> 3;
    for (int it = c.gw; it < NB * LK; it += c.ngw) { const int b = it / LK, pos = it % LK; const int row = pos_row(b, pos);
        float f[8]; unpack8(ld16(KA + (size_t)row * 512 + 8 * c.lane), f);
        float g[8];
#pragma unroll
        for (int e = 0; e < 8; ++e) g[e] = SHFL_XOR(f[e], 2);
        if (pos >= CTX) { const int t = pos - CTX;
#pragma unroll
            for (int e = 0; e < 8; ++e) { const float cs = COS[(size_t)t * 32 + a * 16 + f0 + e], sn = SIN[(size_t)t * 32 + a * 16 + f0 + e]; f[e] = p == 0 ? f[e] * cs - g[e] * sn : f[e] * cs + g[e] * sn; } }
        *(bf16x8*)(KP + ((size_t)(b * 8 + vh) * LK + pos) * 64 + 8 * l7) = pack8(f); }
}
template <int DV>
DEV void vt_item(const Ctx& c, const bf16_t* src, int spitch, int colbase, int b, int pc, bf16_t* dstbh  ) {
    bf16_t* T = (bf16_t*)c.lds;
#pragma unroll
    for (int i = 0; i < DV / 64; ++i) { const int idx = c.tid + 512 * i, pl = idx / (DV / 8), cg = idx % (DV / 8); const int row = pos_row(b, 64 * pc + pl);
        const bf16x8 v = ld16(src + (size_t)row * spitch + colbase + 8 * cg);
#pragma unroll
        for (int e = 0; e < 8; ++e) T[(8 * cg + e) * 72 + (((pl >> 3) ^ (cg & 7)) << 3) + (pl & 7)] = (bf16_t)v[e]; }
    BLOCK_SYNC();
#pragma unroll
    for (int i = 0; i < DV / 64; ++i) { const int idx = c.tid + 512 * i, dv = idx >> 3, ch = idx & 7;
        *(bf16x8*)(dstbh + (size_t)dv * LK + 64 * pc + 8 * ch) = *(const bf16x8*)(T + dv * 72 + 8 * (ch ^ ((dv >> 3) & 7))); }
    BLOCK_SYNC();
}

DEV void mlstm_gates(const Ctx& c, int layer, int b, int h, int dir, int tc, float& ipre, float& lf) {
    const float* G = (const float*)(c.ws + OFF_G); const float* bias = c.in[9] + (size_t)(layer >> 1) * 16;
    const int row = tok_row(b, tc, c.lane);
    ipre = G[(size_t)row * 16 + dir * 8 + h] + bias[dir * 8 + h];
    lf = logsigmoidf_(G[(size_t)row * 16 + dir * 8 + 4 + h] + bias[dir * 8 + 4 + h]);
}
DEV void mlstm_m1_item(const Ctx& c, int layer, int it) {
    const int tc = it % NCH, dir = (it / NCH) & 1, h = (it / (2 * NCH)) & 3, b = it / (8 * NCH);
    const int chain = (b * 4 + h) * 2 + dir, cc = chain_chunk(dir, tc); const size_t ci = (size_t)chain * NCH + cc;
    const bf16_t* BK = (const bf16_t*)(c.ws + OFF_P) + PE_BK; const bf16_t* BV = (const bf16_t*)(c.ws + OFF_P) + PE_BV;
    float* DCT = (float*)(c.ws + SE_DCT); float* DN = (float*)(c.ws + SE_DN); float* SC = (float*)(c.ws + SE_SC);
    bf16_t* Kt = (bf16_t*)c.lds; bf16_t* Vt = Kt + 64 * 72; float* wv = (float*)(c.lds + (64 + 128) * 72 * 2);
    if (c.wave == 0) { float ipre, lf; mlstm_gates(c, layer, b, h, dir, tc, ipre, lf);
        const float bcum = chain_cumsum(lf, c.lane, dir), bend = wave_sum(lf), wend = bend - bcum + ipre, mloc = wave_max(wend);
        wv[c.lane] = expf(wend - mloc);
        if (c.lane == 0) { SC[ci * 4 + 0] = bend; SC[ci * 4 + 1] = mloc; } }
    BLOCK_SYNC();
    {   const int i = c.tid >> 3, cg = c.tid & 7; const int row = tok_row(b, tc, i); const float w = wv[i] * 0.125f;
        float f[8]; unpack8(ld16(BK + (size_t)row * 256 + h * 64 + 8 * cg), f);
#pragma unroll
        for (int e = 0; e < 8; ++e) Kt[(8 * cg + e) * 72 + (((i >> 3) ^ (cg & 7)) << 3) + (i & 7)] = (bf16_t)f2bf(f[e] * w); }
#pragma unroll
    for (int ii = 0; ii < 2; ++ii) { const int idx = c.tid + 512 * ii, i = idx >> 4, cg = idx & 15; const int row = tok_row(b, tc, i);
        const bf16x8 v = ld16(BV + (size_t)row * 512 + h * 128 + 8 * cg);
#pragma unroll
        for (int e = 0; e < 8; ++e) Vt[(8 * cg + e) * 72 + (((i >> 3) ^ (cg & 7)) << 3) + (i & 7)] = (bf16_t)v[e]; }
    BLOCK_SYNC();
    {   const int r = c.lane & 31, hh = c.lane >> 5, dvt = c.wave >> 1, dkt = c.wave & 1;
        f32x16 acc;
#pragma unroll
        for (int i = 0; i < 16; ++i) acc[i] = 0.f;
#pragma unroll
        for (int ks = 0; ks < 4; ++ks) acc = MFMA32(ld16(Vt + (32 * dvt + r) * 72 + 8 * ((2 * ks + hh) ^ ((r >> 3) & 3) ^ ((dvt & 1) << 2))), ld16(Kt + (32 * dkt + r) * 72 + 8 * ((2 * ks + hh) ^ ((r >> 3) & 3) ^ ((dkt & 1) << 2))), acc);
        float* dst = DCT + ci * 8192;
#pragma unroll
        for (int i = 0; i < 16; ++i) dst[(32 * dvt + crow(i, hh)) * 64 + 32 * dkt + r] = acc[i];
        if (c.tid < 64) { float s = 0.f; for (int i = 0; i < 64; ++i) s += bf2f(Kt[c.tid * 72 + i]); DN[ci * 64 + c.tid] = s; } }
    BLOCK_SYNC();
}
DEV void mlstm_m2(const Ctx& c) {
    float* DCT = (float*)(c.ws + SE_DCT); float* DN = (float*)(c.ws + SE_DN); float* SC = (float*)(c.ws + SE_SC);
    const long gt = (long)c.bid * NTHREADS + c.tid, GT = (long)c.nblk * NTHREADS;
    for (long it = gt; it < (long)NCHAIN * 8256; it += GT) { const int chain = (int)(it / 8256), e = (int)(it % 8256);
        float* p0 = e < 8192 ? DCT + (size_t)chain * NCH * 8192 + e : DN + (size_t)chain * NCH * 64 + (e - 8192); const size_t pstr = e < 8192 ? 8192 : 64;
        float d[NCH];
#pragma unroll
        for (int cc = 0; cc < NCH; ++cc) d[cc] = p0[cc * pstr];
        float mst = 0.f, val = 0.f;
#pragma unroll
        for (int cc = 0; cc < NCH; ++cc) { const size_t ci = (size_t)chain * NCH + cc; const float bend = SC[ci * 4 + 0], mloc = SC[ci * 4 + 1];
            if (e == 0) SC[ci * 4 + 2] = mst;
            const float mnew = fmaxf(bend + mst, mloc); const float nv = expf(bend + mst - mnew) * val + expf(mloc - mnew) * d[cc]; d[cc] = val; val = nv; mst = mnew; }
#pragma unroll
        for (int cc = 0; cc < NCH; ++cc) p0[cc * pstr] = d[cc]; }
}
DEV void mlstm_m3_item(const Ctx& c, int layer, int it) {
    const int tc = it % NCH, h = (it / NCH) & 3, b = it / (4 * NCH);
    const bf16_t* BQ = (const bf16_t*)(c.ws + OFF_P) + PE_BQ; const bf16_t* BK = (const bf16_t*)(c.ws + OFF_P) + PE_BK; const bf16_t* BV = (const bf16_t*)(c.ws + OFF_P) + PE_BV; const bf16_t* BO = (const bf16_t*)(c.ws + OFF_P) + PE_BO;
    const float* DCT = (const float*)(c.ws + SE_DCT); const float* DN = (const float*)(c.ws + SE_DN); const float* SC = (const float*)(c.ws + SE_SC);
    bf16_t* Y = (bf16_t*)(c.ws + OFF_HY); const float* gn = c.in[12] + (size_t)(layer >> 1) * 128;
    bf16_t* Qs = (bf16_t*)c.lds; bf16_t* Ks = Qs + 64 * 72; bf16_t* Vt = Ks + 64 * 72; float* fl = (float*)(c.lds + (128 + 128) * 72 * 2);
    float* bcs = fl, *ics = fl + 64, *nst = fl + 128, *ssq = fl + 192;
    const int r = c.lane & 31, hh = c.lane >> 5, dvt = c.wave >> 1, tt = c.wave & 1, t = 32 * tt + r;
    f32x16 hs;
#pragma unroll
    for (int i = 0; i < 16; ++i) hs[i] = 0.f;
    {   const int i = c.tid >> 3, cg = c.tid & 7; const int row = tok_row(b, tc, i);
        *(bf16x8*)(Qs + i * 72 + 8 * cg) = ld16(BQ + (size_t)row * 256 + h * 64 + 8 * cg);
        float f[8]; unpack8(ld16(BK + (size_t)row * 256 + h * 64 + 8 * cg), f);
#pragma unroll
        for (int e = 0; e < 8; ++e) f[e] *= 0.125f;
        *(bf16x8*)(Ks + i * 72 + 8 * cg) = pack8(f); }
#pragma unroll
    for (int ii = 0; ii < 2; ++ii) { const int idx = c.tid + 512 * ii, i = idx >> 4, cg = idx & 15; const int row = tok_row(b, tc, i);
        const bf16x8 v = ld16(BV + (size_t)row * 512 + h * 128 + 8 * cg);
#pragma unroll
        for (int e = 0; e < 8; ++e) Vt[(8 * cg + e) * 72 + (((i >> 3) ^ (cg & 7)) << 3) + (i & 7)] = (bf16_t)v[e]; }
    f32x16 sraw[2];
    for (int dir = 0; dir < 2; ++dir) {
        const int chain = (b * 4 + h) * 2 + dir, cc = chain_chunk(dir, tc); const size_t ci = (size_t)chain * NCH + cc;
        if (c.wave == 0) { float ipre, lf; mlstm_gates(c, layer, b, h, dir, tc, ipre, lf); bcs[c.lane] = chain_cumsum(lf, c.lane, dir); ics[c.lane] = ipre; }
        if (c.wave == 1) nst[c.lane] = DN[ci * 64 + c.lane];
        BLOCK_SYNC();
        const float mst = SC[ci * 4 + 2];
        f32x16 st[2];
        if (dir == 0) {
#pragma unroll
            for (int su = 0; su < 2; ++su) {
#pragma unroll
                for (int i = 0; i < 16; ++i) sraw[su][i] = 0.f;
#pragma unroll
                for (int ks = 0; ks < 4; ++ks) sraw[su] = MFMA32(ld16(Ks + (32 * su + r) * 72 + 16 * ks + 8 * hh), ld16(Qs + t * 72 + 16 * ks + 8 * hh), sraw[su]); } }
        const float bt = bcs[t], at = bt + mst;
        float mt = at;
#pragma unroll
        for (int su = 0; su < 2; ++su)
#pragma unroll
            for (int i = 0; i < 16; ++i) { const int s = 32 * su + crow(i, hh); const bool valid = dir == 0 ? s <= t : s >= t; if (valid) mt = fmaxf(mt, bt - bcs[s] + ics[s]); }
        mt = fmaxf(mt, SHFL_XOR(mt, 32));
        const float inter = expf(at - mt);
        float rsum = 0.f;
#pragma unroll
        for (int su = 0; su < 2; ++su)
#pragma unroll
            for (int i = 0; i < 16; ++i) { const int s = 32 * su + crow(i, hh); const bool valid = dir == 0 ? s <= t : s >= t;
                const float p = valid ? expf(bt - bcs[s] + ics[s] - mt) * sraw[su][i] : 0.f; st[su][i] = p; rsum += p; }
        rsum += SHFL_XOR(rsum, 32);
        float qn = 0.f;
        for (int d = 0; d < 32; ++d) qn += bf2f(Qs[t * 72 + 32 * hh + d]) * nst[32 * hh + d];
        qn += SHFL_XOR(qn, 32);
        const float den = inter * qn + rsum, dd = fmaxf(fabsf(den), expf(-mt));
        f32x16 a1;
#pragma unroll
        for (int i = 0; i < 16; ++i) a1[i] = 0.f;
        const float* Cst = DCT + ci * 8192 + (size_t)(32 * dvt + r) * 64;
#pragma unroll
        for (int ks = 0; ks < 4; ++ks) { float f[8]; const f32x4 c0 = *(const f32x4*)(Cst + 16 * ks + 8 * hh), c1 = *(const f32x4*)(Cst + 16 * ks + 8 * hh + 4);
            f[0] = c0[0]; f[1] = c0[1]; f[2] = c0[2]; f[3] = c0[3]; f[4] = c1[0]; f[5] = c1[1]; f[6] = c1[2]; f[7] = c1[3];
            a1 = MFMA32(pack8(f), ld16(Qs + t * 72 + 16 * ks + 8 * hh), a1); }
        f32x16 a2;
#pragma unroll
        for (int i = 0; i < 16; ++i) a2[i] = 0.f;
#pragma unroll
        for (int su = 0; su < 2; ++su)
#pragma unroll
            for (int s2 = 0; s2 < 2; ++s2) { const bf16_t* vr = Vt + (32 * dvt + r) * 72 + 4 * hh; const int sw = ((32 * dvt + r) >> 3) & 7, bk = 4 * su + 2 * s2;
                a2 = MFMA32(cat44(*(const bf16x4*)(vr + 8 * (bk ^ sw)), *(const bf16x4*)(vr + 8 * ((bk + 1) ^ sw))), pack_acc(st[su], s2), a2); }
        const float inv = 1.0f / dd;
#pragma unroll
        for (int i = 0; i < 16; ++i) hs[i] += (inter * a1[i] + a2[i]) * inv;
        BLOCK_SYNC();
    }
    float ss = 0.f;
#pragma unroll
    for (int i = 0; i < 16; ++i) ss += hs[i] * hs[i];
    ss += SHFL_XOR(ss, 32);
    if (hh == 0) ssq[dvt * 64 + t] = ss;
    BLOCK_SYNC();
    const float rstd = 1.0f / sqrtf((ssq[t] + ssq[64 + t] + ssq[128 + t] + ssq[192 + t]) * (1.0f / 128.0f) + EPS);
    const int row = tok_row(b, tc, t);
#pragma unroll
    for (int q4 = 0; q4 < 4; ++q4) { const int dv = 32 * dvt + 8 * q4 + 4 * hh;
        const bf16x4 ov = *(const bf16x4*)(BO + (size_t)row * 512 + h * 128 + dv); float y[4];
#pragma unroll
        for (int e = 0; e < 4; ++e) y[e] = hs[4 * q4 + e] * rstd * gn[dv + e] * sigmoidf_(bf2f((unsigned short)ov[e]));
        u32x2 w; w[0] = pk2(y[0], y[1]); w[1] = pk2(y[2], y[3]);
        *(u32x2*)(Y + (size_t)row * 1024 + 512 + h * 128 + dv) = w; }
    BLOCK_SYNC();
}

DEV void diffattn_unit(const Ctx& c, int layer, int b, int h, bool ctxu, int qb) {
    const bf16_t* QA = (const bf16_t*)(c.ws + OFF_P) + PE_QA; const bf16_t* KP = (const bf16_t*)(c.ws + SE_KP); const bf16_t* VT = (const bf16_t*)(c.ws + SE_VT);
    bf16_t* Y = (bf16_t*)(c.ws + OFF_HY); const int e = layer >> 1;
    const float* lam = c.in[10] + (size_t)e * 256; const float* gn = c.in[11] + (size_t)e * 128;
    const int r = c.lane & 31, hh = c.lane >> 5; const int ql = qb * 256 + c.wave * 32 + r;
    const int nq = ctxu ? CTX : SEQ, nk = ctxu ? CTX : LK; const bool valid = ql < nq, active = (qb * 256 + c.wave * 32) < nq;
    const int row = ctxu ? ML + b * CTX + ql : b * SEQ + ql;
    const int orow = ctxu ? row : b * SEQ + (ql % 128) * (SEQ / 128) + ql / 128;
    f32x16 o[4]; float m, l1, l2; bf16x8 qf[4];
    float* park = (float*)(c.ws + SE_PARK) + ((size_t)c.bid * NTHREADS + c.tid) * 64;
    load_q(c, QA + (size_t)row * 512 + h * 128, valid, !ctxu, ql, nullptr, qf);
    attn_pass<128>(c, KP + (size_t)(b * 8 + 2 * h) * LK * 64, VT + (size_t)(b * 4 + h) * 128 * LK, LK, nk, qf, active, o, m, l1);
    if (active) { l1 += SHFL_XOR(l1, 32); const float i1 = 1.0f / l1;
#pragma unroll
        for (int dt = 0; dt < 4; ++dt)
#pragma unroll
            for (int q4 = 0; q4 < 4; ++q4) *(f32x4*)(park + 16 * dt + 4 * q4) = (f32x4){o[dt][4 * q4] * i1, o[dt][4 * q4 + 1] * i1, o[dt][4 * q4 + 2] * i1, o[dt][4 * q4 + 3] * i1}; }
    load_q(c, QA + (size_t)row * 512 + h * 128 + 64, valid, !ctxu, ql, nullptr, qf);
    attn_pass<128>(c, KP + (size_t)(b * 8 + 2 * h + 1) * LK * 64, VT + (size_t)(b * 4 + h) * 128 * LK, LK, nk, qf, active, o, m, l2);
    const float lam_init = 0.8f - 0.6f * expf(-0.3f * (float)layer);
    const float lmb = expf(wave_sum(lam[c.lane] * lam[64 + c.lane])) - expf(wave_sum(lam[128 + c.lane] * lam[192 + c.lane])) + lam_init;
    if (active) {
        l2 += SHFL_XOR(l2, 32);
        const float i2 = lmb / l2; float ss = 0.f;
#pragma unroll
        for (int dt = 0; dt < 4; ++dt)
#pragma unroll
            for (int q4 = 0; q4 < 4; ++q4) { const f32x4 a = *(const f32x4*)(park + 16 * dt + 4 * q4);
#pragma unroll
                for (int e = 0; e < 4; ++e) { const float v = a[e] - o[dt][4 * q4 + e] * i2; o[dt][4 * q4 + e] = v; ss += v * v; } }
        ss += SHFL_XOR(ss, 32);
        const float sc = (1.0f / sqrtf(ss * (1.0f / 128.0f) + EPS)) * (1.0f - lam_init);
        if (valid) {
#pragma unroll
            for (int dt = 0; dt < 4; ++dt)
#pragma unroll
                for (int q4 = 0; q4 < 4; ++q4) { const int dv = 32 * dt + 8 * q4 + 4 * hh; u32x2 w;
                    w[0] = pk2(o[dt][4 * q4 + 0] * sc * gn[dv + 0], o[dt][4 * q4 + 1] * sc * gn[dv + 1]); w[1] = pk2(o[dt][4 * q4 + 2] * sc * gn[dv + 2], o[dt][4 * q4 + 3] * sc * gn[dv + 3]);
                    *(u32x2*)(Y + (size_t)orow * 1024 + h * 128 + dv) = w; } }
    }
}

DEV void mix_even_a(const Ctx& c, int layer) {
    { PHASE_CTX(pc); if (ON(8)) even_kprep(pc); }
    { PHASE_CTX(pc); if (ON(9)) { const bf16_t* VA = (const bf16_t*)(pc.ws + OFF_P) + PE_VA; bf16_t* VT = (bf16_t*)(pc.ws + SE_VT);
        for (int it = pc.bid; it < NB * 4 * NCH; it += pc.nblk) { const int pch = it % NCH, bh = it / NCH; vt_item<128>(pc, VA, 512, (bh & 3) * 128, bh >> 2, pch, VT + (size_t)bh * 128 * LK); } } }
    REPB(10) { PHASE_CTX(pc); if (ON(10)) for (int it = pc.bid; it < NCHAIN * NCH; it += pc.nblk) mlstm_m1_item(pc, layer, it); }
}
DEV void mix_even_b(const Ctx& c, int layer) {
    { PHASE_CTX(pc); if (ON(11)) mlstm_m2(pc); }
}
DEV void mix_even_c(const Ctx& c, int layer) {
    constexpr int NQBL = SEQ / 256, NQBC = (CTX + 255) / 256, NUL = NB * 4 * NQBL, NUC = NB * 4 * NQBC;
    REPB(12) { PHASE_CTX(pc); if (ON(12)) for (int it = pc.bid; it < NUL + NUC; it += pc.nblk) { const bool cu = it >= NUL; int u = cu ? it - NUL : it; const int nqb = cu ? NQBC : NQBL;
        diffattn_unit(pc, layer, u / (4 * nqb), (u / nqb) & 3, cu, u % nqb); } }
    REPB(13) { PHASE_CTX(pc); if (ON(13)) for (int it = pc.nblk - 1 - pc.bid; it < NB * 4 * NCH; it += pc.nblk) mlstm_m3_item(pc, layer, it); }
}
constexpr size_t SO_KP = OFF_S;
constexpr size_t SO_VT = SO_KP + al256((size_t)NB * 2 * LK * 64 * 2);
constexpr size_t SO_U  = SO_VT + al256((size_t)NB * 2 * 64 * LK * 2);
constexpr size_t SO_W  = OFF_HY;
static_assert((size_t)NCHAIN * NCH * 8192 <= (size_t)MT * cmax(D, 1024), "W fits in the H/Y region");
constexpr size_t SO_AT = SO_U + al256((size_t)NCHAIN * NCH * 8192 * 2);
constexpr size_t SO_QN = SO_AT + al256((size_t)NCHAIN * NCH * 4096 * 2);
constexpr size_t SO_KD = SO_QN + al256((size_t)NCHAIN * NCH * 8192 * 2);
constexpr size_t SO_GE = SO_KD + al256((size_t)NCHAIN * NCH * 8192 * 2);
constexpr size_t SO_END = SO_GE + al256((size_t)NCHAIN * NCH * 4);
constexpr size_t PO_HB = PO_DQKV;
constexpr size_t PO_GO = PO_DQKV + (size_t)MT * 1024;
static_assert((size_t)3 * MT * 512 <= (size_t)MT * 1536, "HB and GO fit in the DQKV segment");

DEV void odd_kprep(const Ctx& c, int layer) {
    const bf16_t* KVC = (const bf16_t*)(c.ws + OFF_P) + PO_KVC; bf16_t* KP = (bf16_t*)(c.ws + SO_KP);
    const float* COS = (const float*)(c.ws + OFF_ROPE); const float* SIN = COS + (size_t)SEQ * 32; const float* kg = c.in[15] + (size_t)(layer >> 1) * 128 + 64;
    const int kv = c.lane >> 5, d0 = 2 * (c.lane & 31);
    const int a = d0 >> 5, p = (d0 >> 4) & 1, f0 = d0 & 15;
    for (int it = c.gw; it < NB * LK; it += c.ngw) { const int b = it / LK, pos = it % LK; const int row = pos_row(b, pos);
        const unsigned w = *(const unsigned*)(KVC + (size_t)row * 256 + 2 * c.lane);
        float x0 = bf2f(w & 0xffffu), x1 = bf2f(w >> 16);
        float ss = x0 * x0 + x1 * x1;
#pragma unroll
        for (int o = 1; o < 32; o <<= 1) ss += SHFL_XOR(ss, o);
        const float rstd = 1.0f / sqrtf(ss * (1.0f / 64.0f) + EPS);
        x0 *= rstd * kg[d0]; x1 *= rstd * kg[d0 + 1];
        const float y0 = SHFL_XOR(x0, 8), y1 = SHFL_XOR(x1, 8);
        if (pos >= CTX) { const int t = pos - CTX; const float c0 = COS[(size_t)t * 32 + a * 16 + f0], s0 = SIN[(size_t)t * 32 + a * 16 + f0], c1 = COS[(size_t)t * 32 + a * 16 + f0 + 1], s1 = SIN[(size_t)t * 32 + a * 16 + f0 + 1];
            x0 = p == 0 ? x0 * c0 - y0 * s0 : x0 * c0 + y0 * s0; x1 = p == 0 ? x1 * c1 - y1 * s1 : x1 * c1 + y1 * s1; }
        *(unsigned*)(KP + ((size_t)(b * 2 + kv) * LK + pos) * 64 + d0) = pk2(x0, x1); }
}
DEV void gqa_unit(const Ctx& c, int layer, int b, int h, bool ctxu, int qb) {
    const bf16_t* QC = (const bf16_t*)(c.ws + OFF_P) + PO_QC; const bf16_t* KP = (const bf16_t*)(c.ws + SO_KP); const bf16_t* VT = (const bf16_t*)(c.ws + SO_VT);
    bf16_t* QO = (bf16_t*)(c.ws + OFF_P) + PO_GO; const float* qg = c.in[15] + (size_t)(layer >> 1) * 128;
    const int r = c.lane & 31, hh = c.lane >> 5, kv = h >> 2; const int ql = qb * 256 + c.wave * 32 + r;
    const int nq = ctxu ? CTX : SEQ, nk = ctxu ? CTX : LK; const bool valid = ql < nq, active = (qb * 256 + c.wave * 32) < nq;
    const int row = ctxu ? ML + b * CTX + ql : b * SEQ + ql;
    const int orow = ctxu ? row : b * SEQ + (ql % 128) * (SEQ / 128) + ql / 128;
    f32x16 o[2]; float m, l; bf16x8 qf[4];
    load_q(c, QC + (size_t)row * 512 + h * 64, valid, !ctxu, ql, qg, qf);
    attn_pass<64>(c, KP + (size_t)(b * 2 + kv) * LK * 64, VT + (size_t)(b * 2 + kv) * 64 * LK, LK, nk, qf, active, o, m, l);
    if (active) { l += SHFL_XOR(l, 32); const float il = 1.0f / l;
        if (valid) {
#pragma unroll
            for (int dt = 0; dt < 2; ++dt)
#pragma unroll
                for (int q4 = 0; q4 < 4; ++q4) { const int dv = 32 * dt + 8 * q4 + 4 * hh; u32x2 w;
                    w[0] = pk2(o[dt][4 * q4 + 0] * il, o[dt][4 * q4 + 1] * il); w[1] = pk2(o[dt][4 * q4 + 2] * il, o[dt][4 * q4 + 3] * il);
                    *(u32x2*)(QO + (size_t)orow * 512 + h * 64 + dv) = w; } } }
}

constexpr int D1_CW_OFF = 110592;
#ifndef D1_STOP
#define D1_STOP 0
#endif
DEV void dn_d1_item(const Ctx& c, int layer, int it, int stop = 0) {
    const int tc = it % NCH, dir = (it / NCH) & 1, h = (it / (2 * NCH)) & 3, b = it / (8 * NCH);
    const int chain = (b * 4 + h) * 2 + dir, cc = chain_chunk(dir, tc); const size_t ci = (size_t)chain * NCH + cc; const int o = layer >> 1;
    const bf16_t* DQ = (const bf16_t*)(c.ws + OFF_P) + PO_DQKV; const float* G = (const float*)(c.ws + OFF_G);
    const float* cwl = (const float*)(c.lds + D1_CW_OFF); const float* alog = c.in[17] + (size_t)o * 8; const float* dtb = c.in[18] + (size_t)o * 8;
    bf16_t* Ub = (bf16_t*)(c.ws + SO_U) + ci * 8192; bf16_t* Wb = (bf16_t*)(c.ws + SO_W) + ci * 8192; bf16_t* ATb = (bf16_t*)(c.ws + SO_AT) + ci * 4096;
    bf16_t* QNb = (bf16_t*)(c.ws + SO_QN) + ci * 8192; bf16_t* KDb = (bf16_t*)(c.ws + SO_KD) + ci * 8192; float* GE = (float*)(c.ws + SO_GE);
    bf16_t* Qs = (bf16_t*)c.lds; bf16_t* Ks = Qs + 64 * 136; bf16_t* Kt = Ks + 64 * 136; bf16_t* Vt = Kt + 128 * 72; float* Am = (float*)(c.lds + (2 * 64 * 136 + 2 * 128 * 72) * 2); float* gc = Am + 64 * 65; float* be = gc + 64;
    float* gam = be + 64; float* T2 = gam + 64; float* Rb = T2 + 64 * 65;
    const int seqlen = tc < NCC ? CTX : SEQ, tok0 = tc < NCC ? 64 * tc : 64 * (tc - NCC), rowbase = tc < NCC ? ML + b * CTX : b * SEQ;
    if (c.wave == 0) { const int j = c.lane, i = dir ? 63 - j : j; const int row = rowbase + tok0 + i;
        const float beta = sigmoidf_(G[(size_t)row * 16 + dir * 8 + h]);
        const float ld = -expf(alog[dir * 4 + h]) * softplusf_(G[(size_t)row * 16 + dir * 8 + 4 + h] + dtb[dir * 4 + h]);
        const float gcum = chain_cumsum(ld, j, 0); gc[j] = gcum; be[j] = beta; gam[j] = expf(gcum);
        if (j == 63) GE[ci] = expf(gcum); }
    {   const int j = c.tid >> 3, cg = c.tid & 7, i = dir ? 63 - j : j, tok = tok0 + i;
        bf16x8 raw[3][2], rawn[3][2];
#define D1_LOADROWS(R, TEN) { _Pragma("unroll") for (int tap = 0; tap < 3; ++tap) { const int tk = tok + tap - 1; const bool in = tk >= 0 && tk < seqlen; \
            const bf16_t* src = DQ + (size_t)(rowbase + (in ? tk : tok)) * 1536 + (TEN) * 512 + h * 128 + 16 * cg; R[tap][0] = ld16(src); R[tap][1] = ld16(src + 8); \
            if (!in) { R[tap][0] = (bf16x8){0, 0, 0, 0, 0, 0, 0, 0}; R[tap][1] = (bf16x8){0, 0, 0, 0, 0, 0, 0, 0}; } } }
        D1_LOADROWS(rawn, 0);
#pragma unroll 1
        for (int ten = 0; ten < 3; ++ten) { const int col = ten * 512 + h * 128 + 16 * cg;
            float val[16];
#pragma unroll
            for (int e = 0; e < 16; ++e) val[e] = 0.f;
#pragma unroll
            for (int tap = 0; tap < 3; ++tap) { raw[tap][0] = rawn[tap][0]; raw[tap][1] = rawn[tap][1]; }
            if (ten < 2) D1_LOADROWS(rawn, ten + 1);
            SCHED_FENCE();
#pragma unroll
            for (int tap = 0; tap < 3; ++tap) { float f0[8], f1[8]; unpack8(raw[tap][0], f0); unpack8(raw[tap][1], f1);
                const float* wp = cwl + tap * 1536 + col;
#pragma unroll
                for (int e = 0; e < 8; ++e) { val[e] += f0[e] * wp[e]; val[8 + e] += f1[e] * wp[8 + e]; }
                SCHED_FENCE(); }
#pragma unroll
            for (int e = 0; e < 16; ++e) val[e] = siluf_(val[e]);
            if (ten < 2) { float ss = 0.f;
#pragma unroll
                for (int e = 0; e < 16; ++e) ss += val[e] * val[e];
                ss += SHFL_XOR(ss, 1); ss += SHFL_XOR(ss, 2); ss += SHFL_XOR(ss, 4);
                const float sc = (1.0f / sqrtf(ss + EPS)) * (ten == 0 ? 0.08838834764831845f : 1.0f);
#pragma unroll
                for (int e = 0; e < 16; ++e) val[e] *= sc; }
            if (ten < 2) { bf16_t* dst = (ten == 0 ? Qs : Ks) + j * 136 + 16 * cg; float fa[8], fb[8];
#pragma unroll
                for (int e = 0; e < 8; ++e) { fa[e] = val[e]; fb[e] = val[8 + e]; }
                *(bf16x8*)dst = pack8(fa); *(bf16x8*)(dst + 8) = pack8(fb); }
            if (ten >= 1) { bf16_t* dstT = (ten == 1 ? Kt : Vt);
#pragma unroll
                for (int e = 0; e < 16; ++e) dstT[(16 * cg + e) * 72 + (((j >> 3) ^ cg) << 3) + (j & 7)] = (bf16_t)f2bf(val[e]); } } }
    BLOCK_SYNC(); if (stop == 1) return;
    const int r = c.lane & 31, hh = c.lane >> 5;
    {
        const int wq = c.wave & 3, tt = wq >> 1, st = wq & 1; const bool isq = c.wave >= 4;
        f32x16 acc;
#pragma unroll
        for (int i = 0; i < 16; ++i) acc[i] = 0.f;
        const bf16_t* Ar = (isq ? Qs : Ks) + (32 * tt + r) * 136; const bf16_t* Br = Ks + (32 * st + r) * 136;
#pragma unroll
        for (int ks = 0; ks < 8; ++ks) acc = MFMA32(ld16(Ar + 16 * ks + 8 * hh), ld16(Br + 16 * ks + 8 * hh), acc);
        const int s = 32 * st + r; const float gs = gc[s];
#pragma unroll
        for (int i = 0; i < 16; ++i) { const int t = 32 * tt + crow(i, hh); const float dec = expf(gc[t] - gs);
            if (!isq) Am[t * 65 + s] = t > s ? be[t] * dec * acc[i] : 0.f;
            else ATb[t * 64 + s] = (bf16_t)f2bf(t >= s ? dec * acc[i] : 0.f); } }
    BLOCK_SYNC(); if (stop == 2) return;
    if (c.wave == 0) { const int d = c.lane >> 4, cc = c.lane & 15; const float* Ad = Am + (16 * d) * 65 + 16 * d; float* Td = T2 + (16 * d) * 65 + 16 * d;
        float t[16];
#pragma unroll
        for (int i = 0; i < 16; ++i) { float acc = (cc == i) ? 1.f : 0.f;
#pragma unroll
            for (int j = 0; j < i; ++j) acc -= Ad[i * 65 + j] * t[j];
            t[i] = acc; }
#pragma unroll
        for (int i = 0; i < 16; ++i) Td[i * 65 + cc] = t[i]; }
    else { for (int e = c.tid - 64; e < 64 * 64; e += NTHREADS - 64) { const int t = e >> 6, s2 = e & 63; if ((s2 >> 4) > (t >> 4)) T2[t * 65 + s2] = 0.f; } }
    BLOCK_SYNC();
    for (int rb = 1; rb < 4; ++rb) { const int wcols = 16 * rb;
        for (int e = c.tid; e < 16 * wcols; e += NTHREADS) { const int i = e & 15, cidx = e >> 4; float acc = 0.f; const float* Ar = Am + (16 * rb + i) * 65;
            for (int kb = cidx & ~15; kb < wcols; kb += 16) {
#pragma unroll
                for (int kk = 0; kk < 16; ++kk) acc += Ar[kb + kk] * T2[(kb + kk) * 65 + cidx]; }
            Rb[i * 49 + cidx] = acc; }
        BLOCK_SYNC();
        for (int e = c.tid; e < 16 * wcols; e += NTHREADS) { const int i = e & 15, cidx = e >> 4; float acc = 0.f; const float* Tr = T2 + (16 * rb + i) * 65 + 16 * rb;
#pragma unroll
            for (int j = 0; j < 16; ++j) acc += Tr[j] * Rb[j * 49 + cidx];
            T2[(16 * rb + i) * 65 + cidx] = -acc; }
        BLOCK_SYNC(); }
    if (stop == 3) return;
#ifndef EMU
    int lane2_ = c.lane; asm volatile("" : "+v"(lane2_));
    const int r2 = lane2_ & 31, hh2 = lane2_ >> 5;
#else
    const int r2 = r, hh2 = hh;
#endif
    {
#pragma unroll
        for (int rep = 0; rep < 2; ++rep) { const int idx = c.wave + 8 * rep, isw = idx >> 3, tt = (idx >> 2) & 1, ct = idx & 3;
            f32x16 acc;
#pragma unroll
            for (int i = 0; i < 16; ++i) acc[i] = 0.f;
            const bf16_t* Bt = (isw ? Kt : Vt) + (32 * ct + r2) * 72;
#pragma unroll
            for (int ks = 0; ks < 4; ++ks) { float f[8];
#pragma unroll
                for (int e = 0; e < 8; ++e) { const int s = 16 * ks + 8 * hh2 + e; f[e] = T2[(32 * tt + r2) * 65 + s] * be[s] * (isw ? gam[s] : 1.0f); }
                acc = MFMA32(pack8(f), ld16(Bt + 8 * ((2 * ks + hh2) ^ (((32 * ct + r2) >> 4) & 7))), acc); }
            bf16_t* dst = (isw ? Wb : Ub);
#pragma unroll
            for (int i = 0; i < 16; ++i) dst[(32 * tt + crow(i, hh2)) * 128 + 32 * ct + r2] = (bf16_t)f2bf(acc[i]); } }
    {
        const float gend = gc[63];
        const int j = c.tid >> 3, cg = c.tid & 7; const float gamj = gam[j];
#pragma unroll
        for (int half = 0; half < 2; ++half) { float f[8]; unpack8(ld16(Qs + j * 136 + 16 * cg + 8 * half), f);
#pragma unroll
            for (int e = 0; e < 8; ++e) f[e] *= gamj;
            *(bf16x8*)(QNb + j * 128 + 16 * cg + 8 * half) = pack8(f); }
#pragma unroll
        for (int ii = 0; ii < 2; ++ii) { const int idx = c.tid + 512 * ii, dk = idx >> 3, ch = idx & 7; float f[8]; unpack8(ld16(Kt + dk * 72 + 8 * (ch ^ ((dk >> 4) & 7))), f);
#pragma unroll
            for (int e = 0; e < 8; ++e) f[e] *= expf(gend - gc[8 * ch + e]);
            *(bf16x8*)(KDb + dk * 64 + 8 * ch) = pack8(f); } }
    BLOCK_SYNC();
}
constexpr int D2_PW = 132, D2_PA = 68;
constexpr int D2_W = 0, D2_QN = 64 * D2_PW * 2, D2_AT = 2 * 64 * D2_PW * 2, D2_KD = D2_AT + 64 * D2_PA * 2, D2_BUF = D2_KD + 128 * D2_PA * 2;
static_assert(2 * D2_BUF <= LDS_MISC, "two D2 buffers fit below the LDS control words");
DEV void dn_d2_stage(const Ctx& c, size_t ci, char* buf) {
    const bf16_t* Wb = (const bf16_t*)(c.ws + SO_W) + ci * 8192; const bf16_t* QNb = (const bf16_t*)(c.ws + SO_QN) + ci * 8192; const bf16_t* ATb = (const bf16_t*)(c.ws + SO_AT) + ci * 4096; const bf16_t* KDb = (const bf16_t*)(c.ws + SO_KD) + ci * 8192;
    const int lt = c.tid - 256;
#pragma unroll 2
    for (int i = 0; i < 14; ++i) { const int idx = lt + 256 * i; const bf16_t* src; char* dst;
        if (idx < 1024) { const int row = idx >> 4, ch = idx & 15; src = Wb + row * 128 + 8 * ch; dst = buf + D2_W + (row * D2_PW + 8 * ch) * 2; }
        else if (idx < 2048) { const int j = idx - 1024, row = j >> 4, ch = j & 15; src = QNb + row * 128 + 8 * ch; dst = buf + D2_QN + (row * D2_PW + 8 * ch) * 2; }
        else if (idx < 2560) { const int j = idx - 2048, row = j >> 3, ch = j & 7; src = ATb + row * 64 + 8 * ch; dst = buf + D2_AT + (row * D2_PA + 8 * ch) * 2; }
        else { const int j = idx - 2560, row = j >> 3, ch = j & 7; src = KDb + row * 64 + 8 * ch; dst = buf + D2_KD + (row * D2_PA + 8 * ch) * 2; }
        const bf16x8 v = ld16(src); const bf16x4 lo = __builtin_shufflevector(v, v, 0, 1, 2, 3), hi = __builtin_shufflevector(v, v, 4, 5, 6, 7);
        *(bf16x4*)dst = lo; *(bf16x4*)(dst + 8) = hi; }
}
DEV void dn_d2_chain(const Ctx& c, int chain, bool emit_ctx) {
    const int dir = chain & 1, h = (chain >> 1) & 3, b = chain >> 3; const int r = c.lane & 31, hh = c.lane >> 5, sl = c.wave & 3; const bool comp = c.wave < 4;
    const bf16_t* U0 = (const bf16_t*)(c.ws + SO_U); const float* GE = (const float*)(c.ws + SO_GE);
    bf16_t* HB = (bf16_t*)(c.ws + OFF_P) + PO_HB + (size_t)dir * MT * 512;
    f32x16 S[4];
#pragma unroll
    for (int t4 = 0; t4 < 4; ++t4)
#pragma unroll
        for (int i = 0; i < 16; ++i) S[t4][i] = 0.f;
    if (!comp) dn_d2_stage(c, (size_t)chain * NCH, c.lds);
    BLOCK_SYNC();
    for (int cc = 0; cc < NCH; ++cc) { const size_t ci = (size_t)chain * NCH + cc; char* buf = c.lds + (cc & 1) * D2_BUF;
        if (!comp) { if (cc + 1 < NCH) dn_d2_stage(c, ci + 1, c.lds + ((cc + 1) & 1) * D2_BUF); }
        else {
            const bf16_t* Ub = U0 + ci * 8192; const bf16_t* Wl = (const bf16_t*)(buf + D2_W); const bf16_t* QNl = (const bf16_t*)(buf + D2_QN); const bf16_t* ATl = (const bf16_t*)(buf + D2_AT); const bf16_t* KDl = (const bf16_t*)(buf + D2_KD);
            f32x16 u[2], ov[2];
#pragma unroll
            for (int tt = 0; tt < 2; ++tt)
#pragma unroll
                for (int i = 0; i < 16; ++i) { u[tt][i] = -bf2f(Ub[(32 * tt + crow(i, hh)) * 128 + 32 * sl + r]); ov[tt][i] = 0.f; }
#pragma unroll
            for (int ks = 0; ks < 8; ++ks) { const bf16x8 sf = pack_acc(S[ks >> 1], ks & 1); const int k0 = 16 * ks + 4 * hh;
#pragma unroll
                for (int tt = 0; tt < 2; ++tt) { const bf16_t* wp = Wl + (32 * tt + r) * D2_PW + k0; const bf16_t* qp = QNl + (32 * tt + r) * D2_PW + k0;
                    u[tt] = MFMA32(cat44(*(const bf16x4*)wp, *(const bf16x4*)(wp + 8)), sf, u[tt]);
                    ov[tt] = MFMA32(cat44(*(const bf16x4*)qp, *(const bf16x4*)(qp + 8)), sf, ov[tt]); } }
#pragma unroll
            for (int tt = 0; tt < 2; ++tt)
#pragma unroll
                for (int i = 0; i < 16; ++i) u[tt][i] = -u[tt][i];
            const float ge = GE[ci];
#pragma unroll
            for (int t4 = 0; t4 < 4; ++t4)
#pragma unroll
                for (int i = 0; i < 16; ++i) S[t4][i] *= ge;
#pragma unroll
            for (int ks = 0; ks < 4; ++ks) { const bf16x8 uf = pack_acc(u[ks >> 1], ks & 1);
#pragma unroll
                for (int tt = 0; tt < 2; ++tt) { const bf16_t* ap = ATl + (32 * tt + r) * D2_PA + 16 * ks + 4 * hh;
                    ov[tt] = MFMA32(cat44(*(const bf16x4*)ap, *(const bf16x4*)(ap + 8)), uf, ov[tt]); }
#pragma unroll
                for (int t4 = 0; t4 < 4; ++t4) { const bf16_t* kp = KDl + (32 * t4 + r) * D2_PA + 16 * ks + 4 * hh;
                    S[t4] = MFMA32(cat44(*(const bf16x4*)kp, *(const bf16x4*)(kp + 8)), uf, S[t4]); } }
            const int tc = dir == 0 ? cc : (cc < NCC ? NCC - 1 - cc : NCC + (NLC - 1 - (cc - NCC)));
            if (tc >= NCC || emit_ctx) {
#pragma unroll
                for (int tt = 0; tt < 2; ++tt)
#pragma unroll
                    for (int i = 0; i < 16; ++i) { const int j = 32 * tt + crow(i, hh); const int row = tok_row(b, tc, dir ? 63 - j : j);
                        HB[(size_t)row * 512 + h * 128 + 32 * sl + r] = (bf16_t)f2bf(ov[tt][i]); } }
        }
        BLOCK_SYNC();
    }
}
DEV void dn_yasm(const Ctx& c, int layer, int nrows) {
    const bf16_t* HB = (const bf16_t*)(c.ws + OFF_P) + PO_HB; const bf16_t* Z = (const bf16_t*)(c.ws + OFF_P) + PO_Z; const bf16_t* QC = (const bf16_t*)(c.ws + OFF_P) + PO_GO; bf16_t* Y = (bf16_t*)(c.ws + OFF_HY);
    const float* gn = c.in[19] + (size_t)(layer >> 1) * 128;
    for (int it = c.gw; it < nrows * 2; it += c.ngw) { const int row = it >> 1, col = (it & 1) * 256 + 4 * c.lane;
        const bf16x4 a = *(const bf16x4*)(HB + (size_t)row * 512 + col), bb = *(const bf16x4*)(HB + (size_t)MT * 512 + (size_t)row * 512 + col), z = *(const bf16x4*)(Z + (size_t)row * 512 + col);
        float v[4], ss = 0.f;
#pragma unroll
        for (int e = 0; e < 4; ++e) { v[e] = bf2f((unsigned short)a[e]) + bf2f((unsigned short)bb[e]); ss += v[e] * v[e]; }
#pragma unroll
        for (int o = 1; o < 32; o <<= 1) ss += SHFL_XOR(ss, o);
        const float rstd = 1.0f / sqrtf(ss * (1.0f / 128.0f) + EPS);
        float y[4];
#pragma unroll
        for (int e = 0; e < 4; ++e) y[e] = v[e] * rstd * gn[(col & 127) + e] * siluf_(bf2f((unsigned short)z[e]));
        u32x2 w; w[0] = pk2(y[0], y[1]); w[1] = pk2(y[2], y[3]);
        *(u32x2*)(Y + (size_t)row * 1024 + 512 + col) = w;
        *(u32x2*)(Y + (size_t)row * 1024 + col) = *(const u32x2*)(QC + (size_t)row * 512 + col); }
}

DEV void gqa_units(const Ctx& c, int layer, bool emit_ctx, int first, int stride) {
    constexpr int NQBL = SEQ / 256, NQBC = (CTX + 255) / 256, NUL = NB * 8 * NQBL, NUC = NB * 8 * NQBC;
    const int nuc = emit_ctx ? NUC : 0;
    for (int it = first; it < NUL + nuc; it += stride) { const bool cu = it >= NUL; int u = cu ? it - NUL : it; const int nqb = cu ? NQBC : NQBL;
        gqa_unit(c, layer, u / (8 * nqb), (u / nqb) & 7, cu, u % nqb); }
}
DEV void mix_odd_a(const Ctx& c, int layer) {
    { PHASE_CTX(pc); if (ON(14)) odd_kprep(pc, layer); }
    { PHASE_CTX(pc); if (ON(15)) { const bf16_t* KVC = (const bf16_t*)(pc.ws + OFF_P) + PO_KVC; bf16_t* VT = (bf16_t*)(pc.ws + SO_VT);
        for (int it = pc.bid; it < NB * 2 * NCH; it += pc.nblk) { const int pch = it % NCH, bk = it / NCH; vt_item<64>(pc, KVC, 256, 128 + (bk & 1) * 64, bk >> 1, pch, VT + (size_t)bk * 64 * LK); } } }
    REPB(16) { PHASE_CTX(pc); if (ON(16)) {
        { const float* convw = pc.in[16] + (size_t)(layer >> 1) * 3 * 1536; float* cwl = (float*)(pc.lds + D1_CW_OFF); BLOCK_SYNC();
          for (int e = pc.tid; e < 3 * 1536 / 4; e += NTHREADS) ((f32x4*)cwl)[e] = ((const f32x4*)convw)[e];
          BLOCK_SYNC(); }
        for (int it = pc.bid; it < NCHAIN * NCH; it += pc.nblk) dn_d1_item(pc, layer, it, (rep_ < (int)(((unsigned long long)(REPM) >> 16) & 1ull)) ? D1_STOP : 0); } }
}
DEV void mix_odd_b(const Ctx& c, int layer, bool emit_ctx) {
    const int nd2 = NCHAIN < c.nblk ? NCHAIN : c.nblk;
    const int na = c.nblk - nd2;
    REPB(17) { PHASE_CTX(pc); if (ON(17)) if (pc.bid < nd2) { for (int ch = pc.bid; ch < NCHAIN; ch += nd2) dn_d2_chain(pc, ch, emit_ctx); } }
    REPB(18) { PHASE_CTX(pc); if (ON(18)) { if (na > 0) { if (pc.bid >= nd2) gqa_units(pc, layer, emit_ctx, pc.bid - nd2, na); } else gqa_units(pc, layer, emit_ctx, pc.bid, pc.nblk); } }
}
DEV void mix_odd_c(const Ctx& c, int layer, bool emit_ctx) {
    { PHASE_CTX(pc); if (ON(19)) dn_yasm(pc, layer, emit_ctx ? MT : ML); }
}

#ifdef SELFTEST
#ifdef EMU
#define ST_HD static inline
#else
#define ST_HD __host__ __device__ inline
#endif
constexpr size_t ST_CHK = 512 * 1024;
ST_HD unsigned st_hash(unsigned a, unsigned b) { unsigned x = a * 0x9E3779B1u ^ (b + 0x7F4A7C15u) * 0x85EBCA6Bu; x ^= x >> 16; x *= 0x7FEB352Du; x ^= x >> 15; x *= 0x846CA68Bu; x ^= x >> 16; return x; }
ST_HD float st_uniform(unsigned t, unsigned i) { return (float)(st_hash(t, i) >> 8) * (1.0f / 16777216.0f); }
ST_HD float st_normal(unsigned tensor, unsigned idx) { const float u1 = ((float)(st_hash(tensor * 4u, idx) >> 8) + 0.5f) * (1.0f / 16777216.0f), u2 = (float)(st_hash(tensor * 4u + 1u, idx) >> 8) * (1.0f / 16777216.0f); return sqrtf(-2.0f * logf(u1)) * cosf(6.2831853f * u2); }
ST_HD size_t st_count(int i) {
    switch (i) {
    case 0: return (size_t)NB * SEQ * D; case 1: return (size_t)NB * D; case 2: return (size_t)NB * CTX * D; case 3: return D;
    case 4: return (size_t)DEPTH * D * 6 * D; case 5: return (size_t)DEPTH * 6 * D; case 6: case 7: return (size_t)DEPTH * D;
    case 8: return (size_t)2 * D * E_IN; case 9: return 32; case 10: return 512; case 11: case 12: return 256; case 13: return (size_t)2 * 1024 * D;
    case 14: return (size_t)2 * D * O_IN; case 15: return 256; case 16: return 2 * 3 * 1536; case 17: return 16; case 18: return 16; case 19: return 256; case 20: return (size_t)2 * 1024 * D;
    case 21: case 22: return (size_t)DEPTH * D * FF; case 23: return (size_t)DEPTH * FF * D; default: return D; }
}
ST_HD float st_value(int i, size_t idx) {
#ifdef ST_SAME_BATCH
    if (i == 0) idx %= (size_t)SEQ * D; if (i == 1) idx %= (size_t)D; if (i == 2) idx %= (size_t)CTX * D;
#endif
    const float d = (float)D; const float n = st_normal((unsigned)i + 1u, (unsigned)idx);
    switch (i) {
    case 0: case 1: case 2: case 3: return n;
    case 4: return n * 0.5f / sqrtf(d); case 5: return n * 0.02f; case 6: case 7: case 11: case 12: case 15: case 19: case 24: return 1.0f + 0.02f * n;
    case 8: case 14: case 21: case 22: return n / sqrtf(d);
    case 9: return 0.1f * n + ((idx & 4) ? 3.0f + (float)(idx & 3) : 0.0f);
    case 10: return 0.1f * n; case 13: case 20: return n * (1.0f / 32.0f); case 16: return n * 0.57735027f;
    case 17: return logf(1.0f + 5.0f * (float)(idx & 3)) + 0.05f * n;
    case 18: { const float dt = expf(-6.9077553f + 4.6051702f * st_uniform(999u, (unsigned)idx)); return dt + logf(-expm1f(-dt)); }
    case 23: return n / sqrtf((float)FF);
    default: return n; }
}
ST_HD size_t st_offset(int i) { size_t o = 0; for (int k = 0; k < i; ++k) o += (st_count(k) + 63) & ~(size_t)63; return o; }
DEV void st_sum(const Ctx& c, int step, int sub, const void* base, size_t n, int is_bf16) {
    step += c.ngw;
    double p[8], s2 = 0.0;
#pragma unroll
    for (int k = 0; k < 8; ++k) p[k] = 0.0;
    const size_t gt = (size_t)c.bid * NTHREADS + c.tid, GT = (size_t)c.nblk * NTHREADS;
    for (size_t i = gt; i < n; i += GT) { const float v = is_bf16 ? bf2f(((const bf16_t*)base)[i]) : ((const float*)base)[i]; const unsigned h = st_hash(0xC0FFEEu + (unsigned)sub, (unsigned)i); s2 += (double)v * (double)v;
#pragma unroll
        for (int k = 0; k < 8; ++k) p[k] += ((h >> (k + 8)) & 1u) ? (double)v : -(double)v; }
    double* chk = (double*)(c.ws + ST_CHK) + ((size_t)step * 4 + sub) * 10;
#ifdef EMU
    for (int k = 0; k < 8; ++k) chk[k] += p[k];
    chk[8] += s2; if (gt == 0) chk[9] = (double)n;
#else
#pragma unroll
    for (int k = 0; k < 8; ++k) atomicAdd(chk + k, p[k]);
    atomicAdd(chk + 8, s2); if (gt == 0) chk[9] = (double)n;
#endif
}
DEV void st_checks(const Ctx& c, int step) {

    const int layer = step / 9, ph = step - 9 * layer, odd = layer & 1; const size_t mrows = layer < DEPTH - 1 ? MT : ML; unsigned char* ws = c.ws;
    if (ph == 0) { st_sum(c, step, 0, ws + OFF_HY, (size_t)MT * D, 1); st_sum(c, step, 1, ws + OFF_G, (size_t)MT * 16, 0); st_sum(c, step, 2, ws + OFF_WIN, (size_t)(odd ? NO : NE) * D, 1); st_sum(c, step, 3, ws + OFF_WOUT, (size_t)D * 1024, 1); }
    else if (ph == 1) { st_sum(c, step, 0, ws + OFF_P, (size_t)MT * (odd ? NO : NE), 1); }
    else if (ph == 2) { if (!odd) { st_sum(c, step, 0, ws + SE_KP, (size_t)NB * 8 * LK * 64, 1); st_sum(c, step, 1, ws + SE_VT, (size_t)NB * 4 * 128 * LK, 1); st_sum(c, step, 2, ws + SE_DCT, (size_t)NCHAIN * NCH * 8192, 0); st_sum(c, step, 3, ws + SE_DN, (size_t)NCHAIN * NCH * 64, 0); }
        else { st_sum(c, step, 0, ws + SO_KP, (size_t)NB * 2 * LK * 64 * 2, 1); st_sum(c, step, 1, ws + SO_U, (size_t)NCHAIN * NCH * 8192, 1); st_sum(c, step, 2, ws + SO_W, (size_t)NCHAIN * NCH * 8192, 1); st_sum(c, step, 3, ws + SO_AT, (size_t)NCHAIN * NCH * (4096 + 8192 + 8192), 1); } }
    else if (ph == 3) { if (!odd) { st_sum(c, step, 0, ws + SE_DCT, (size_t)NCHAIN * NCH * 8192, 0); st_sum(c, step, 1, ws + SE_DN, (size_t)NCHAIN * NCH * 64, 0); }
        else { st_sum(c, step, 0, ws + OFF_P + PO_HB * 2, (size_t)mrows * 512, 1); st_sum(c, step, 1, ws + OFF_P + (PO_HB + (size_t)MT * 512) * 2, (size_t)mrows * 512, 1); st_sum(c, step, 2, ws + OFF_P + PO_GO * 2, (size_t)mrows * 512, 1); } }
    else if (ph == 4) { st_sum(c, step, 0, ws + OFF_HY, (size_t)mrows * 1024, 1); }
    else if (ph == 5 || ph == 8) { st_sum(c, step, 0, ws + OFF_X, (size_t)mrows * D, 0); }
    else if (ph == 6) { st_sum(c, step, 0, ws + OFF_HY, (size_t)mrows * D, 1); st_sum(c, step, 1, ws + SF_WGU, (size_t)2 * FF * D, 1); st_sum(c, step, 2, ws + SF_WDN, (size_t)D * FF, 1); }
    else { st_sum(c, step, 0, ws + OFF_P, (size_t)mrows * FF, 1); }
}
#endif

DEV void final_norm(const Ctx& c) {
    constexpr int NV = D / 256;
    const float* X = (const float*)(c.ws + OFF_X); const float* g = c.in[24];
    for (int row = c.gw; row < ML; row += c.ngw) {
        const f32x4* xr = (const f32x4*)(X + (size_t)row * D) + c.lane; f32x4 v[NV]; float ss = 0.f;
#pragma unroll
        for (int j = 0; j < NV; ++j) { v[j] = xr[64 * j]; ss += (v[j][0] * v[j][0] + v[j][1] * v[j][1]) + (v[j][2] * v[j][2] + v[j][3] * v[j][3]); }
        const float rstd = 1.0f / sqrtf(wave_sum(ss) * (1.0f / D) + EPS);
        f32x4* o = (f32x4*)(c.out + (size_t)row * D) + c.lane;
#pragma unroll
        for (int j = 0; j < NV; ++j) o[64 * j] = v[j] * rstd * *(const f32x4*)(g + 256 * j + 4 * c.lane);
    }
}

constexpr size_t WS_NEED = cmax(WS_NEED_EF, SO_END);
#ifdef EMU
static void mega(Args args) {
    char* lds = emu::blocks[EMU_BID].lds;
    XcdBarrier bar; bar.dummy = 0;
#else
__global__ void __launch_bounds__(NTHREADS, 2) mega(Args args) {
    extern __shared__ __attribute__((aligned(16))) unsigned char lds_raw[];
    char* lds = (char*)lds_raw;
    {   volatile LAS unsigned* misc0 = (volatile LAS unsigned*)((LAS unsigned char*)lds_raw + LDS_MISC);
        if (threadIdx.x < 64) misc0[threadIdx.x] = 0u; }
    __syncthreads();
    XcdBarrier bar = xcd_barrier_post((unsigned*)(args.ws + OFF_CTL) + 4096, (volatile LAS unsigned*)((LAS unsigned char*)lds_raw + LDS_MISC) + 8);
#endif
    Ctx c;
#ifdef EMU
    c.tid = TIDX; c.lane = c.tid & 63; c.wave = c.tid >> 6;
#else
    c.tid = 0; c.lane = 0; c.wave = 0;
#endif
    c.bid = BIDX; c.nblk = NBLK; c.gw = c.bid * NWAVES + c.wave; c.ngw = c.nblk * NWAVES; c.lds = lds; c.in = args.in; c.out = args.out; c.ws = args.ws;

    if (args.prologue) {
    { PHASE_CTX(pc); if (ON(0)) p0_prologue(pc); }
#ifndef EMU
    cg::this_grid().sync();
#else
    GRID_BARRIER();
#endif
    }
#ifndef REPEAT_PH
#define REPEAT_PH -1
#endif
    for (int step2 = 2 * args.step_lo; step2 < 2 * args.step_hi; ++step2) {
        const int step = step2 >> 1; if ((step2 & 1) && !((step % 9) == REPEAT_PH && (REPEAT_PH != 3 || ((step / 9) & 1)))) continue;
        const int layer = step / 9, ph = step - 9 * layer;
        const int odd = layer & 1; const bool emit_ctx = layer < DEPTH - 1; const int mrows = emit_ctx ? MT : ML;
        if (ph == 0) {
            { PHASE_CTX(pc); if (ON(1) && (layer == 0 || step == args.step_lo)) convert_mixer_weights(pc, layer, pc.gw, pc.ngw); }
            { PHASE_CTX(pc); const bool prev = layer > 0 && step > args.step_lo; const int pm_ = MT;
              const SplitPlan red = split_plan(pm_, FF, pc.nblk, prev);
              if (ON(2)) normalize_rows(pc, layer, 0, MT, red, pm_, (const float*)(pc.ws + OFF_MOD) + (size_t)(layer - (prev ? 1 : 0)) * 9 * 6 * D + 5 * D); }
        } else if (ph == 1) {
            if (ON(3)) { PHASE_CTX(pc); pg8::Gemm g{(const bf16_t*)(pc.ws + OFF_HY), (const bf16_t*)(pc.ws + OFF_WIN), MT, odd ? NO : NE, D}; pg8::StaticOrder S; S.init(MT, odd ? NO : NE, c.nblk, c.bid); S.wave = pc.wave;
                if (odd && !emit_ctx && NO == 2816) { S.init(ML, NO, c.nblk, c.bid); S.wave = pc.wave; S.tn = (MC / 256) * 7; S.tpm = ML / 256; S.tpn = 2; S.tw = 7; }
                EpiSeg E{(bf16_t*)(pc.ws + OFF_P), odd};
                GEMM_PHASE(EpiSeg, lds, g, S, E); }
        } else if (ph == 2) { if (!odd) mix_even_a(c, layer); else mix_odd_a(c, layer); }
        else if (ph == 3) { if (!odd) mix_even_b(c, layer); else mix_odd_b(c, layer, emit_ctx); }
        else if (ph == 4) { if (!odd) mix_even_c(c, layer); else mix_odd_c(c, layer, emit_ctx); }
        else if (ph == 5 || ph == 8) {
            if (ON(4)) { PHASE_CTX(pc); const bool dn = ph == 8;
                const int kdim = dn ? FF : 1024; const SplitPlan sp = split_plan(mrows, kdim, pc.nblk, dn && layer + 1 < CFG_LAYERS);
                pg8::Gemm g{(const bf16_t*)(pc.ws + (dn ? OFF_P : OFF_HY)), (const bf16_t*)(pc.ws + (dn ? SF_WDN : OFF_WOUT)), mrows, D, kdim}; pg8::StaticOrder S; S.init(mrows, D, c.nblk, c.bid); S.wave = pc.wave;
                if (sp.extra) S.lim = pc.nblk;
                const bool first = layer == 0 && !dn;
                EpiResid E{(float*)(pc.ws + OFF_X), (const float*)(pc.ws + OFF_MOD) + (size_t)layer * 9 * 6 * D, dn ? 5 * D : 2 * D,
                           first ? pc.in[0] : (const float*)(pc.ws + OFF_X), first ? pc.in[2] - (size_t)ML * D : (const float*)(pc.ws + OFF_X)};
                GEMM_PHASE(EpiResid, lds, g, S, E);
                if (sp.extra && pc.bid < sp.extra * sp.split) {
                    const int lu = pc.bid / sp.split, q = pc.bid % sp.split, pairs = kdim / 128, base = pairs / sp.split, rem = pairs % sp.split;
                    const int np = base + (q < rem ? 1 : 0), p0 = q * base + (q < rem ? q : rem);
                    pg8::Gemm g2{g.A + (size_t)p0 * 128, g.Bt + (size_t)p0 * 128, mrows, D, np * 128, kdim}; pg8::StaticOrder S2; S2.init(mrows, D, sp.nwg, pc.nblk + lu); S2.wave = pc.wave;
                    EpiPart E2{(float*)(pc.ws + SF_PART) + (size_t)pc.bid * 65536};
                    BLOCK_SYNC();
                    GEMM_PHASE(EpiPart, lds, g2, S2, E2); } }
            { PHASE_CTX(pc); const SplitPlan sp = split_plan(mrows, ph == 8 ? FF : 1024, pc.nblk, ph == 8 && layer + 1 < CFG_LAYERS);
              const int nwg = sp.nwg; int busy = (nwg > pc.nblk && nwg < 2 * pc.nblk) ? nwg - pc.nblk : 0; if (sp.extra) busy = (pc.nblk - sp.extra * sp.split > pc.nblk / 4) ? sp.extra * sp.split : 0;
              if (ON(1) && pc.bid >= busy) { BLOCK_SYNC();
                  if (ph == 5) convert_ffn_weights(pc, layer, (pc.bid - busy) * NWAVES + pc.wave, (pc.nblk - busy) * NWAVES);
                  else if (layer + 1 < CFG_LAYERS && step + 1 < args.step_hi) convert_mixer_weights(pc, layer + 1, (pc.bid - busy) * NWAVES + pc.wave, (pc.nblk - busy) * NWAVES); } }
        } else if (ph == 6) {
            { PHASE_CTX(pc); const SplitPlan red = split_plan(mrows, 1024, pc.nblk, false);
              if (ON(2)) normalize_rows(pc, layer, 1, mrows, red, mrows, (const float*)(pc.ws + OFF_MOD) + (size_t)layer * 9 * 6 * D + 2 * D); }
        } else {
            if (ON(5)) { PHASE_CTX(pc); pg8::Gemm g{(const bf16_t*)(pc.ws + OFF_HY), (const bf16_t*)(pc.ws + SF_WGU), mrows, 2 * FF, D}; pg8::StaticOrder S; S.init(mrows, 2 * FF, c.nblk, c.bid); S.wave = pc.wave;
                EpiSwiglu E{(bf16_t*)(pc.ws + OFF_P)};
                GEMM_PHASE(EpiSwiglu, lds, g, S, E); }
        }
        if (step + 1 < args.step_hi || args.final_) GRID_BARRIER();
#ifdef EMU_STOP_AFTER_MIX
        if (layer == CFG_LAYERS - 1 && ph == 4) return;
#endif
    }
    if (args.final_) { PHASE_CTX(pc); if (ON(7)) final_norm(pc); }
}

#ifndef EMU
#ifdef PROBE_Y
__global__ void pr_stat(const bf16_t* Y, int rows, int c0, int c1, double* acc) {
    double s = 0.0, cnt = 0.0; float mx = 0.f;
    for (size_t k = (size_t)blockIdx.x * blockDim.x + threadIdx.x; k < (size_t)rows * 1024; k += (size_t)gridDim.x * blockDim.x) { const int col = (int)(k & 1023); if (col < c0 || col >= c1) continue;
        const float v = bf2f(Y[k]); s += (double)v * v; cnt += 1.0; mx = fmaxf(mx, fabsf(v)); }
    atomicAdd(acc, s); atomicAdd(acc + 1, cnt); atomicMax((unsigned long long*)acc + 2, (unsigned long long)(mx * 1e6f));
}
__global__ void pr_fill(const double* acc, float* out, int n) {
    const float rms = (float)sqrt(acc[0] / acc[1]), mx = (float)((const unsigned long long*)acc)[2] * 1e-6f;
    const float c = sqrtf(rms * 10.0f), B = mx * 10.0f;
    for (size_t k = (size_t)blockIdx.x * blockDim.x + threadIdx.x; k < (size_t)n; k += (size_t)gridDim.x * blockDim.x) out[k] = (k == 12345) ? B : c;
}
#endif
#ifdef SELFTEST
struct StPtrs { float* p[25]; };
__global__ void st_gen_inplace(StPtrs P) {
    for (int i = 0; i < 25; ++i) { const size_t n = st_count(i);
        for (size_t k = (size_t)blockIdx.x * blockDim.x + threadIdx.x; k < n; k += (size_t)gridDim.x * blockDim.x) P.p[i][k] = st_value(i, k); }
}
__global__ void st_gen(float* syn) {
    for (int i = 0; i < 25; ++i) { const size_t n = st_count(i), o = st_offset(i);
        for (size_t k = (size_t)blockIdx.x * blockDim.x + threadIdx.x; k < n; k += (size_t)gridDim.x * blockDim.x) syn[o + k] = st_value(i, k); }
}
constexpr int ST_NEXP = 74;
#ifndef ST_REPORT_SUB
#define ST_REPORT_SUB 0
#endif
#ifndef ST_TOL
#define ST_TOL 0.03
#endif
__device__ const int ST_EXP_STEP[74] = {0,0,0,0,1,2,2,2,2,3,3,4,5,6,6,6,7,8,9,9,9,9,10,11,11,11,11,12,12,12,13,14,15,15,15,16,17,18,18,18,18,19,20,20,20,20,21,21,22,23,24,24,24,25,26,27,27,27,27,28,29,29,29,29,30,30,30,31,32,33,33,33,34,35,};
__device__ const int ST_EXP_SUB[74] = {0,1,2,3,0,0,1,2,3,0,1,0,0,0,1,2,0,0,0,1,2,3,0,0,1,2,3,0,1,2,0,0,0,1,2,0,0,0,1,2,3,0,0,1,2,3,0,1,0,0,0,1,2,0,0,0,1,2,3,0,0,1,2,3,0,1,2,0,0,0,1,2,0,0,};
__device__ const double ST_EXP[74][10] = {
{2823.9405135959387,-6955.5741695016623,-5804.0977028682828,9054.3725127205253,-3966.7899582609534,-4601.8714917525649,7995.7762676179409,971.6921226978302,22251047.414743461,18874368,},
{291.26190879568458,-1573.2945180945098,331.66257446631789,357.45295172557235,-214.97323327884078,864.47900781407952,490.07691208645701,667.85457975044847,340263.10377825046,294912,},
{-23.357008519407827,15.935151411395054,35.883058835112024,57.434714148461353,-51.349641996261198,60.264678716950584,-59.23590717773186,-56.705568651959766,3067.8819070441805,3145728,},
{25.470241500996053,-43.468927160836756,58.065743817947805,4.3800708865746856,11.067458258010447,-10.867067505605519,26.364831392653286,-27.969552277587354,1020.9866835358141,1048576,},
{-11200.415292963386,9297.3592315688729,3203.3726777359843,-9663.7561300396919,-641.6257035061717,-8234.4563228115439,7994.2129158824682,-5521.8908601477742,66654113.07759431,56623104,},
{-1194.5305787473917,-1674.2680710405111,-5463.7986858785152,-4930.0590666979551,-1068.7674529403448,3002.9571408778429,-649.54952663183212,-4412.2754199355841,11106170.817955792,9437184,},
{-5507.6614354923368,1901.5068384334445,-4913.9082106724381,-2596.9450140967965,-1520.3851273730397,3237.6398326531053,-2359.8059303388,2364.7748123183846,11105296.668379547,9437184,},
{1560.4392579563191,-2499.261261367612,1459.3170721097504,-245.48758464773891,1043.47321934717,1419.7026340031534,1920.6481273452355,-1582.4576623782978,1601541.1673813532,18874368,},
{18.923751746769994,105.40070073772222,-9.9321377836167812,-69.897449327632785,166.82718826597556,123.35070158960298,-124.43343016551808,-149.78254351718351,24705.222434743067,147456,},
{2291.1772415378409,-198.18048978019215,106.27707149069283,1579.1373604525679,1783.1593627679513,2121.0945059178157,-2611.1484069368307,-1331.619970235115,2782256.6531369383,18874368,},
{89.759916271461407,27.444828146166401,211.5510761210171,-443.45204046583967,221.2014890195278,-713.03335159321432,-278.38321068481309,161.85793914255919,83907.236548682689,147456,},
{2060.1309491619468,-3099.3174412855878,3189.1278408914804,-1495.998928762041,2018.3208422241732,3951.0027283849195,307.00997438374907,189.92257314547896,8838647.8145213183,18874368,},
{2615.2232726222937,-3851.6311007236727,-5090.8008575433851,8895.7526726254218,-2915.793732104612,-3466.5127967876979,8494.2590465184257,-476.8310997271401,19641291.046898585,18874368,},
{2260.6133435368538,-3524.0150115936995,-6184.6817786470056,8612.6491934210062,-2936.174174323678,-5085.3421624973416,7627.2569323033094,-322.10541462153196,22201812.480418805,18874368,},
{39.211919396329904,-22.191732778126607,71.555887567257741,-34.657468227291247,-37.514794261514908,48.970252739818534,56.030709780199686,21.127209749916801,5631.6743743792158,5767168,},
{-58.957687043759506,-25.822232720500324,27.559850534133147,-19.2058952494408,25.962478367669974,10.300243424077053,-1.6967002287856303,-52.715924362360965,1022.4535583883176,2883584,},
{-194.02440498952637,2323.5604243765411,4943.6193249881908,-6076.2407636700955,-3098.2506252240564,1737.1458579480241,4071.2157669755688,3426.5647126794502,26276154.208520912,51904512,},
{2062.0307282910508,-2404.6291768250012,-4943.0085245753726,8409.3699170327891,-3388.5586135165795,-3156.0619303231506,8070.8516135739701,103.72620783001184,20445489.612024359,18874368,},
{-850.44070326350629,-1898.2922850791365,-5629.5260096881539,5319.5235935095698,-3571.6089787539095,-4582.1209145840257,8084.1448610220104,1201.9745895769447,22408943.624150425,18874368,},
{-276.67351097613573,238.73336043953896,402.49070692062378,1139.6587501242757,412.53829725086689,1001.9456618651748,-199.34280802309513,243.97394938021898,346041.02869538032,294912,},
{55.275690128095448,33.631906502880156,39.819098525680602,39.580814833752811,-56.659358996432275,56.905868629924953,70.874192817136645,32.641803210601211,2813.6335960129777,2883584,},
{16.459319942980073,-15.029889202327468,24.789046118385158,39.597747391439043,22.32851928321179,32.169926681905054,4.3831529127201065,-11.914361283765174,1024.2634621089853,1048576,},
{-8112.7706977427006,-15166.404139339924,9019.1636524870992,-10032.914728678763,-3683.5552492365241,6445.1523703113198,4940.6895737573504,-396.46003675460815,61599346.798404746,51904512,},
{1064.6478829011321,2961.5112186744809,2643.997241653502,3817.1335873380303,2552.6912311688066,2848.1112303361297,2641.0165046826005,877.74564967304468,5155886.6824775627,4718592,},
{-1180.9790783076314,-353.66288720036391,1405.2405796857784,-3003.0330094090896,736.01905330538284,1520.8871299045859,-1925.6258542904397,-909.10001162986737,2434153.6281470573,18874368,},
{60.165285118651028,-119.7430636333083,80.732633202489126,-9.8426874747077857,-101.69595492020277,-92.996986093445443,207.83742497175277,20.265997010018708,8918.7285340001526,18874368,},
{270.78828044847916,-133.56509196904631,-10.835563753045964,-177.08542341093678,116.75884305510037,-401.68338958283317,92.706295374895404,-256.76246256793473,40406.455039767519,47185920,},
{-17.403251063922653,85.550381564797135,-67.875341098901117,39.030201086570742,-44.825321126758354,-24.736986581498059,-130.15850522785331,-6.1346717766427901,3203.0568557028691,9437184,},
{26.677921455280739,-10.301573183693108,-15.383461458186503,23.552394272832316,-16.422941844488378,33.179475616852869,-26.073428510382655,49.43283157730184,2218.7160715744772,9437184,},
{-104.63265653897543,-1025.0813928971766,623.84842114138883,-1420.2001781960716,1368.3365971482126,-86.704579671728425,96.991083307308145,428.70963656844106,889696.22597060842,9437184,},
{2432.259056510753,267.30669010814745,1837.783826454659,2981.6297531555174,-416.17357830458786,-1826.6180147336563,-301.78532918507699,-744.86193079140503,4898348.3318136279,18874368,},
{3294.5902997395533,-865.44878266500746,-4974.0870277224822,6772.8382276698467,-3398.3562051501722,-4187.1136843486529,8143.3624155692742,-612.10508898339322,20872541.311585322,18874368,},
{3536.330776873976,1917.42852505669,-2076.6844129748642,4320.7511040978134,-4890.1908001117408,-4107.6248654313385,10533.807669285685,471.08626228198409,22412768.276720807,18874368,},
{-6.0809309475971531,76.739011337651391,97.496654804484933,-29.642639640796915,0.70117462620510196,-203.53367705441451,-98.699187040134348,-53.162115221513886,5628.1487348292976,5767168,},
{56.758986754866783,46.788941775390413,-43.423746958898846,33.754279191547539,25.984360144881066,-65.525896325649228,5.420765693706926,45.74655341921607,1023.6598906812283,2883584,},
{2102.1720024403512,3520.8294076444326,-6874.5287163143184,3797.4676643103921,3201.4737541926479,2643.8227775447631,352.29275992398834,1880.529091139204,26630809.672188494,51904512,},
{2885.2073127178519,-1385.1170310270754,-4514.0122937517372,7030.8231581723594,-3845.7207517792049,-6356.8220687311768,7588.3782935662384,-564.85132873002294,21742637.688699484,18874368,},
{3812.0284725353122,1621.2253267094493,-4254.9756214395165,6197.9158516302705,8.5768845900893211,-5469.3091325387359,8752.140286244452,-1246.7436530068517,22065010.375674032,18874368,},
{-1149.1737003140152,496.67538012936711,483.18858239427209,650.82792166247964,314.5317993350327,-371.12024437263608,890.37748170271516,-1420.4709294177592,350924.7500354572,294912,},
{88.047429081168957,-74.825534723349847,-23.789757229969837,-97.320472310879268,-4.0056394656421617,-30.904204592457972,-18.987518870853819,-27.849783896817826,3073.3731145051615,3145728,},
{65.20327353652101,3.0222902240930125,25.993390792864375,14.415037170168944,54.844758132356219,-56.249738970887847,19.864254156243987,-27.887308357167058,1025.1381782409978,1048576,},
{-13237.945228233933,-5020.7346298694611,5226.0037766546011,12825.714193224907,-2397.7048603817821,-7119.2997151985765,9948.7588085010648,-5921.2636323198676,66137041.201810837,56623104,},
{-75.766457952558994,2293.2211949080229,-2037.293488740921,1509.2966427430511,6117.5132186114788,479.96601853519678,-5639.6398960202932,1845.2123182713985,11060201.299008245,9437184,},
{-462.10384976491332,5736.9905912540853,-2167.2699889577925,-1180.0111477933824,409.65681508556008,-1780.9929978586733,-671.92641231790185,-1349.7005080021918,11027953.433529973,9437184,},
{-822.00079254147931,-1214.0090433928017,3328.184749965596,87.801341768161365,-495.11205383328706,-877.86274139888337,1911.2223419476468,796.02008414199008,1759052.6843886974,18874368,},
{100.80030664941296,22.118581771384925,-242.38840196980163,-93.397681776899844,-57.195992573630065,-53.402307578828186,-150.74265199294314,-86.528761671390384,31090.621100439952,147456,},
{3075.2200345232932,146.19098324902222,-1073.3931368374535,-3446.3695871779209,37.989448957180798,223.73928401402372,1720.4827841137958,2765.2156565344467,3854013.6325600357,18874368,},
{542.032717238857,-110.56952357693081,1.825648151418136,-830.79371399683441,-111.90571951437596,-416.65702595594485,-459.77385005963879,177.62618795662274,136561.77048135776,147456,},
{-536.59579325607046,3431.0063604712486,3724.987038930878,-672.57181697292253,-3271.82986589754,-275.97591033531353,1134.3561726845801,3369.160484327469,5460094.8227678062,18874368,},
{3690.413550499331,-2055.6428064615766,-5438.0006776863584,7215.5527907973737,-3675.7019953130812,-5533.6785190762885,6701.1122693967927,64.846424879085134,22222666.921814281,18874368,},
{6145.2994565963745,-1456.0999585092068,-5831.9741258770227,8761.7396555989981,-5699.234908297658,-4079.551640689373,4842.0201814621687,-2019.1001229286194,22203324.287363961,18874368,},
{130.56598056000075,66.178603142005159,-72.223813362215878,-40.295281428698217,26.729994425171753,-72.123386049031978,-88.871669880725676,27.124975894665113,5635.9492323544555,5767168,},
{32.54455375490943,72.597239872498903,-17.171426851477008,-4.8966801255592145,-15.258403940417338,-23.122007071331609,-22.899502303858753,62.156484370876569,1023.7774562760339,2883584,},
{-6760.2973620964185,3735.844417643224,1094.1796880429465,4204.2181440759596,-764.49361893783498,-4932.0209130450239,-6261.1468112875446,-4488.8535375963402,26246313.294528794,51904512,},
{4457.1757640697724,-2267.1563059242435,-4745.1736963140393,7186.1535465445595,-4113.5497737388105,-7139.5026401302202,6476.8297955984126,-72.098023249844118,23047663.524188824,18874368,},
{4172.7441230602562,2189.9780470617115,-5133.8792393095791,7288.8046996556222,-5411.0709395520389,-4896.6709096245468,8724.0389158017933,-1300.7641984857619,22255371.479420178,18874368,},
{342.48845159634948,-1155.9452162571251,-355.46573888137937,38.030472237616777,-706.72725258395076,302.12307207658887,1501.216548230499,-189.15161934122443,356337.53284288617,294912,},
{141.34916719738249,55.510840875467693,3.4794936717735254,14.99616638317093,48.530484220267681,80.824254727551306,36.550317391192948,-11.045543047970568,2822.5213800999318,2883584,},
{-1.7540650628507137,-68.523136725649238,20.526102727279067,4.1151908580213785,26.478423124179244,17.260244991630316,26.540773348882794,18.066198658198118,1023.7352584092852,1048576,},
{9615.2207438386977,4784.9471067078412,1940.7497162856162,-5810.9412356205285,-983.56367782130837,7418.8542090691626,16772.396392870694,-7707.8745242021978,61356805.552982159,51904512,},
{1611.5909418128431,-862.28053805604577,-136.1677976809442,-552.47190998122096,983.61643074825406,-2118.3313589207828,2136.0759917013347,1436.2902639396489,5189176.8575152932,4718592,},
{1791.7875226804172,-31.704715774103533,260.74334435508354,2286.3263573826407,2006.0634295089985,-556.23315154918237,2794.1662208863418,265.33516812947346,2237659.8451027921,18874368,},
{1.738220854325472,-47.72536333968177,85.671240820733587,-76.785340997768273,-33.389609302064237,10.517162931163593,-16.605087701564099,-69.403631001852744,4294.4259768959364,18874368,},
{80.462511468439985,-161.96663447577936,103.6356164854663,158.8806262336563,-156.06783419597375,68.553029276052172,-342.86381052307308,-54.733859514236087,20398.968534675096,47185920,},
{52.505996509542456,40.193077393545536,-32.136223205568967,9.6826318503881339,-32.908785335748689,-49.309646418463672,7.7728565156285185,28.182192534412025,933.99111986596574,8388608,},
{-7.5194821398763452,15.928513078688411,-22.494523745699553,-25.74654744003783,-1.9659538757696282,39.424875568918651,-41.204660507297376,-50.291643056989415,1399.3033406704337,8388608,},
{-135.14476990071125,388.87867833836935,-624.19169349339791,-255.41803698171861,749.05279063689522,489.13258223538287,7.6979752753395587,-1529.1879597052466,922125.16740855761,8388608,},
{2513.205304118339,-3002.4781056293286,-591.26384180737659,984.36628054594621,-165.44268643157557,-2587.8124781120569,5950.0621142634191,1918.4807258569635,4533654.192930459,16777216,},
{2830.9344703354946,-4920.8287407121315,-3976.7572222978852,7101.1558030729429,-6279.3158443071807,-7658.587931540409,7596.1372552172033,-980.77548625691998,20848405.50834683,16777216,},
{5663.7043273374438,-4698.0929517224431,-2882.0782249197364,6381.8024617210031,-6684.7693502381444,-6324.1065613850951,5276.286193959415,-1294.3445755466819,19824501.716412377,16777216,},
{105.49113711505197,9.4353141400497407,71.544671961572021,-144.04839801136404,-59.128098372370005,86.345427959226072,-22.445412413449958,-31.521184443496168,5635.2677728111466,5767168,},
{-52.974209187126689,83.749726402067608,-11.22629395038166,-7.1423740544887551,-10.056938788195112,-45.578087951795169,41.377634743421368,16.152020135003113,1023.3413428186279,2883584,},
{1126.9516335337321,-4958.3812902097925,-2794.7144431749111,5195.0455790979104,4310.2982955073458,-6172.0018973502665,4099.1716476037618,-5060.7709415074714,23578261.929520626,46137344,},
{854.11164966656725,-4002.1053702284298,-4016.2943720539079,7535.4821215254451,-6184.3291782648776,-6281.2433878521588,8750.5079252671385,531.59902707755464,21616516.22354921,16777216,},
};
__global__ void st_check_kernel(unsigned char* ws, int step, int slot = 0) { Ctx c; c.tid = threadIdx.x; c.lane = c.tid & 63; c.wave = c.tid >> 6; c.bid = blockIdx.x; c.nblk = gridDim.x; c.gw = 0; c.ngw = slot; c.lds = nullptr; c.in = nullptr; c.out = nullptr; c.ws = ws; st_checks(c, step); }
__global__ void st_report(const unsigned char* ws, float* out, int n) {
    const double* chk = (const double*)(ws + ST_CHK); int code = 0;
    for (int e = 0; e < ST_NEXP && !code; ++e) { const int step = ST_EXP_STEP[e], sub = ST_EXP_SUB[e]; const double* g = chk + (step * 4 + sub) * 10; double d2 = 0.0; if (g[9] == 0.0) continue;
        for (int k = 0; k < 8; ++k) { const double d = g[k] - ST_EXP[e][k]; d2 += d * d; }
        const double eps2 = d2 / (8.0 * ST_EXP[e][8] + 1e-300);
        const bool bad = !(eps2 <= ST_TOL * ST_TOL);
        if (bad) code = ST_REPORT_SUB ? (step == ST_REPORT_SUB - 1 ? sub + 1 : 0) : step + 1; }
    const float v = sqrtf((float)code);
    for (size_t k = (size_t)blockIdx.x * blockDim.x + threadIdx.x; k < (size_t)n; k += (size_t)gridDim.x * blockDim.x) out[k] = v;
}
__global__ void st_repeat_report(const unsigned char* ws, float* out, int n, int nsteps) {
    const double* chk = (const double*)(ws + ST_CHK); int code = 0;
    for (int st = 0; st < nsteps && !code; ++st) for (int sub = 0; sub < 4 && !code; ++sub) { const double* a = chk + ((size_t)st * 4 + sub) * 10; const double* b = chk + ((size_t)(st + 40) * 4 + sub) * 10;
        if (a[9] == 0.0 || b[9] == 0.0) continue; double d2 = 0.0; for (int k = 0; k < 8; ++k) d2 += (a[k] - b[k]) * (a[k] - b[k]);
        if (!(d2 <= 1e-14 * 8.0 * a[8])) code = st + 1; }
    const float v = sqrtf((float)code);
    for (size_t k = (size_t)blockIdx.x * blockDim.x + threadIdx.x; k < (size_t)n; k += (size_t)gridDim.x * blockDim.x) out[k] = v;
}
__global__ void st_twice_report(const unsigned char* ws, float* out, int n) {
    const double* chk = (const double*)(ws + ST_CHK); const double* a = chk + ((size_t)35 * 4) * 10; const double* b = chk + ((size_t)(35 + 40) * 4) * 10;
    double d2 = 0.0; for (int k = 0; k < 8; ++k) d2 += (a[k] - b[k]) * (a[k] - b[k]);
    const double eps = sqrt(d2 / (8.0 * a[8] + 1e-300)) + 1e-30; const float v = sqrtf((float)floor(fmax(0.0, -log10(eps))));
    for (size_t k = (size_t)blockIdx.x * blockDim.x + threadIdx.x; k < (size_t)n; k += (size_t)gridDim.x * blockDim.x) out[k] = v;
}
__global__ void st_final_check(const unsigned char* ws, const float* out, const float* g, double* acc) {
    const float* X = (const float*)(ws + OFF_X);
    for (int row = blockIdx.x * blockDim.x + threadIdx.x; row < ML; row += gridDim.x * blockDim.x) { const float* x = X + (size_t)row * D; double ss = 0.0;
        for (int k = 0; k < D; ++k) ss += (double)x[k] * x[k];
        const double rstd = 1.0 / sqrt(ss / D + 1e-6); double d2 = 0.0, r2 = 0.0;
        for (int k = 0; k < D; ++k) { const double r = x[k] * rstd * g[k], o = out[(size_t)row * D + k]; d2 += (o - r) * (o - r); r2 += r * r; }
        atomicAdd(acc, d2); atomicAdd(acc + 1, r2); }
}
__global__ void st_final_fill(const double* acc, float* out, int n) { const double eps = sqrt(acc[0] / (acc[1] + 1e-300)) + 1e-30; const float v = sqrtf((float)floor(fmax(0.0, -log10(eps))));
    for (size_t k = (size_t)blockIdx.x * blockDim.x + threadIdx.x; k < (size_t)n; k += (size_t)gridDim.x * blockDim.x) out[k] = v; }
__global__ void st_same_batch_inputs(const float* x, const float* cv, const float* ctx, float* xs, float* cs, float* ctxs) {
    const size_t gt = (size_t)blockIdx.x * blockDim.x + threadIdx.x, GT = (size_t)gridDim.x * blockDim.x;
    for (size_t k = gt; k < (size_t)NB * SEQ * D; k += GT) xs[k] = x[k % ((size_t)SEQ * D)];
    for (size_t k = gt; k < (size_t)NB * CTX * D; k += GT) ctxs[k] = ctx[k % ((size_t)CTX * D)];
    for (size_t k = gt; k < (size_t)NB * D; k += GT) cs[k] = cv[k % (size_t)D];
}
__global__ void st_batch_report(const float* sout, float* out, int n, double* acc) {
    const size_t per = (size_t)SEQ * D;
    for (int b = 1; b < NB; ++b) { double d2 = 0.0, r2 = 0.0;
        for (size_t k = (size_t)blockIdx.x * blockDim.x + threadIdx.x; k < per; k += (size_t)gridDim.x * blockDim.x) { const double a0 = sout[k], ab = sout[(size_t)b * per + k]; d2 += (ab - a0) * (ab - a0); r2 += a0 * a0; }
        atomicAdd(acc + 2 * b, d2); atomicAdd(acc + 2 * b + 1, r2); }
    __threadfence();
    __shared__ unsigned last; if (threadIdx.x == 0) last = atomicAdd((unsigned*)acc, 1u) == gridDim.x - 1; __syncthreads();
    if (!last) return;
    int code = 0; for (int b = 1; b < NB && !code; ++b) { const double d2 = atomicAdd(acc + 2 * b, 0.0), r2 = atomicAdd(acc + 2 * b + 1, 0.0); if (!(d2 <= 1e-4 * r2)) code = b; }
    *((volatile int*)(acc + 1)) = code;
}
__global__ void st_fill(const double* acc, float* out, int n) { const float v = sqrtf((float)*((const volatile int*)(acc + 1))); for (size_t k = (size_t)blockIdx.x * blockDim.x + threadIdx.x; k < (size_t)n; k += (size_t)gridDim.x * blockDim.x) out[k] = v; }
#endif

#if defined(SELFTEST) && (defined(ST_DACHECK) || defined(ST_MODCHECK) || defined(ST_L0CHECK) || defined(ST_TAILCHECK) || defined(ST_MLCHECK) || defined(ST_DNCHECK) || defined(ST_TRUTH) || defined(ST_GQCHECK))
__global__ void st_da_check(const unsigned char* ws, const float* lam, const float* gn, double* acc, float* scr) {
    const int lane = threadIdx.x & 63, gw = (blockIdx.x * blockDim.x + threadIdx.x) >> 6, ngw = (gridDim.x * blockDim.x) >> 6;
    const bf16_t* QA = (const bf16_t*)(ws + OFF_P) + PE_QA; const bf16_t* KA = (const bf16_t*)(ws + OFF_P) + PE_KA; const bf16_t* VA = (const bf16_t*)(ws + OFF_P) + PE_VA; const bf16_t* Y = (const bf16_t*)(ws + OFF_HY);
    const float* COS = (const float*)(ws + OFF_ROPE); const float* SIN = COS + (size_t)SEQ * 32;
    float* s1 = scr + (size_t)gw * 2 * LK; float* s2 = s1 + LK;
    float la = 0.f, lb = 0.f; la = lam[lane] * lam[64 + lane]; lb = lam[128 + lane] * lam[192 + lane];
    for (int o = 1; o < 64; o <<= 1) { la += __shfl_xor(la, o); lb += __shfl_xor(lb, o); }
    const float lam_init = 0.2f, lmb = expf(la) - expf(lb) + lam_init;
    __shared__ float qs[8][2][64];
    const int wv = threadIdx.x >> 6;
    for (int it = gw; it < (ML / 16) * 4; it += ngw) { const int h = it & 3, row = (it >> 2) * 16 + 5; const int b = row / SEQ, t = row % SEQ;
        for (int m = 0; m < 2; ++m) { const int d = lane; const int a = d >> 5, pp = (d >> 4) & 1, f = d & 15; const float x = bf2f(QA[(size_t)row * 512 + h * 128 + m * 64 + d]), xp = bf2f(QA[(size_t)row * 512 + h * 128 + m * 64 + (d ^ 16)]);
            const float cs = COS[(size_t)t * 32 + a * 16 + f], sn = SIN[(size_t)t * 32 + a * 16 + f]; qs[wv][m][d] = pp == 0 ? x * cs - xp * sn : x * cs + xp * sn; }
        __syncthreads();
        float m1 = -1e30f, m2 = -1e30f;
        for (int j = lane; j < LK; j += 64) { const int kr = pos_row(b, j); const bool rope = j >= CTX; const int kt = j - CTX; float a1 = 0.f, a2 = 0.f;
            for (int d = 0; d < 64; ++d) { const int a = d >> 5, pp = (d >> 4) & 1, f = d & 15;
                float k1 = bf2f(KA[(size_t)kr * 512 + h * 128 + d]), k2 = bf2f(KA[(size_t)kr * 512 + h * 128 + 64 + d]);
                if (rope) { const float k1p = bf2f(KA[(size_t)kr * 512 + h * 128 + (d ^ 16)]), k2p = bf2f(KA[(size_t)kr * 512 + h * 128 + 64 + (d ^ 16)]); const float cs = COS[(size_t)kt * 32 + a * 16 + f], sn = SIN[(size_t)kt * 32 + a * 16 + f];
                    k1 = pp == 0 ? k1 * cs - k1p * sn : k1 * cs + k1p * sn; k2 = pp == 0 ? k2 * cs - k2p * sn : k2 * cs + k2p * sn; }
                a1 += qs[wv][0][d] * k1; a2 += qs[wv][1][d] * k2; }
            a1 *= 0.125f; a2 *= 0.125f; s1[j] = a1; s2[j] = a2; m1 = fmaxf(m1, a1); m2 = fmaxf(m2, a2); }
        for (int o = 1; o < 64; o <<= 1) { m1 = fmaxf(m1, __shfl_xor(m1, o)); m2 = fmaxf(m2, __shfl_xor(m2, o)); }
        float l1 = 0.f, l2 = 0.f;
        for (int j = lane; j < LK; j += 64) { const float p1 = expf(s1[j] - m1), p2 = expf(s2[j] - m2); s1[j] = p1; s2[j] = p2; l1 += p1; l2 += p2; }
        for (int o = 1; o < 64; o <<= 1) { l1 += __shfl_xor(l1, o); l2 += __shfl_xor(l2, o); }
        __threadfence(); __syncthreads();
        float o0 = 0.f, o1 = 0.f;
        for (int j = 0; j < LK; ++j) { const int kr = pos_row(b, j); const float p = s1[j] / l1 - lmb * s2[j] / l2; o0 += p * bf2f(VA[(size_t)kr * 512 + h * 128 + lane]); o1 += p * bf2f(VA[(size_t)kr * 512 + h * 128 + 64 + lane]); }
        float ss = o0 * o0 + o1 * o1; for (int o = 1; o < 64; o <<= 1) ss += __shfl_xor(ss, o);
        const float sc = (1.0f / sqrtf(ss / 128.0f + 1e-6f)) * (1.0f - lam_init);
        const float r0 = o0 * sc * gn[lane], r1 = o1 * sc * gn[64 + lane], y0 = bf2f(Y[(size_t)row * 1024 + h * 128 + lane]), y1 = bf2f(Y[(size_t)row * 1024 + h * 128 + 64 + lane]);
        double d2 = (double)(y0 - r0) * (y0 - r0) + (double)(y1 - r1) * (y1 - r1), r2 = (double)r0 * r0 + (double)r1 * r1;
        for (int o = 1; o < 64; o <<= 1) { d2 += __shfl_xor(d2, o); r2 += __shfl_xor(r2, o); }
        if (lane == 0) { atomicAdd(acc, d2); atomicAdd(acc + 1, r2); }
        __syncthreads(); }
}
__global__ void st_mod_check(const unsigned char* ws, const float* cv, const float* cctx, const float* w_ada, const float* b_ada, double* acc) {
    const float* MOD = (const float*)(ws + OFF_MOD); double d2 = 0.0, r2 = 0.0;
    for (long it = (long)blockIdx.x * blockDim.x + threadIdx.x; it < (long)DEPTH * 9 * 6 * D; it += (long)gridDim.x * blockDim.x) { const int n = (int)(it % (6 * D)), r = (int)((it / (6 * D)) % 9), l = (int)(it / (6L * D * 9));
        double s = b_ada[(size_t)l * 6 * D + n];
        for (int k = 0; k < D; ++k) { const double cc = r < NB ? cv[r * D + k] : cctx[k]; s += cc / (1.0 + exp(-cc)) * (double)w_ada[((size_t)l * D + k) * 6 * D + n]; }
        const double m = MOD[it]; d2 += (m - s) * (m - s); r2 += s * s; }
    atomicAdd(acc, d2); atomicAdd(acc + 1, r2);
}
__global__ void st_inproj_check(const unsigned char* ws, const float* w_in_e, double* acc) {
    const bf16_t* H = (const bf16_t*)(ws + OFF_HY); const bf16_t* P = (const bf16_t*)(ws + OFF_P); double d2 = 0.0, r2 = 0.0;
    for (long it = (long)blockIdx.x * blockDim.x + threadIdx.x; it < 72L * NE; it += (long)gridDim.x * blockDim.x) { const int col = (int)(it % NE), row = (int)(it / NE) * 256 + 37;
        float s = 0.f; for (int k = 0; k < D; ++k) s += bf2f(H[(size_t)row * D + k]) * bf2f(f2bf(w_in_e[(size_t)k * E_IN + col]));
        size_t off; int pitch, c0; const int pn = col / 256;
        if (pn < 2) { off = PE_QA; pitch = 512; c0 = 256 * pn; } else if (pn < 4) { off = PE_KA; pitch = 512; c0 = 256 * (pn - 2); } else if (pn < 6) { off = PE_VA; pitch = 512; c0 = 256 * (pn - 4); }
        else if (pn == 6) { off = PE_BQ; pitch = 256; c0 = 0; } else if (pn == 7) { off = PE_BK; pitch = 256; c0 = 0; } else if (pn < 10) { off = PE_BV; pitch = 512; c0 = 256 * (pn - 8); } else { off = PE_BO; pitch = 512; c0 = 256 * (pn - 10); }
        const float v = bf2f(P[off + (size_t)row * pitch + c0 + (col & 255)]); d2 += (double)(v - s) * (v - s); r2 += (double)s * s; }
    atomicAdd(acc, d2); atomicAdd(acc + 1, r2);
}
__global__ void st_norm_check(const unsigned char* ws, const float* g_mix, const float* w_in_e, const float* xin, const float* ctxin, double* acc) {
    const bf16_t* H = (const bf16_t*)(ws + OFF_HY); const float* G = (const float*)(ws + OFF_G); const float* MOD = (const float*)(ws + OFF_MOD); double d2 = 0.0, r2 = 0.0, dg = 0.0, rg = 0.0;
    for (int it = blockIdx.x * blockDim.x + threadIdx.x; it < 72; it += gridDim.x * blockDim.x) { const int row = it * 256 + 37; const int mr = row < ML ? row / SEQ : NB;
        const float* x = row < ML ? xin + (size_t)row * D : ctxin + (size_t)(row - ML) * D; double ss = 0.0; for (int k = 0; k < D; ++k) ss += (double)x[k] * x[k];
        const double rstd = 1.0 / sqrt(ss / D + 1e-6); double ga[16]; for (int n = 0; n < 16; ++n) ga[n] = 0.0;
        for (int k = 0; k < D; ++k) { const double h = x[k] * rstd * g_mix[k] * (1.0 + MOD[(size_t)mr * 6 * D + D + k]) + MOD[(size_t)mr * 6 * D + k]; const double v = bf2f(H[(size_t)row * D + k]); d2 += (v - h) * (v - h); r2 += h * h;
            for (int n = 0; n < 16; ++n) ga[n] += h * w_in_e[(size_t)k * E_IN + NE + n]; }
        for (int n = 0; n < 16; ++n) { const double v = G[(size_t)row * 16 + n]; dg += (v - ga[n]) * (v - ga[n]); rg += ga[n] * ga[n]; } }
    atomicAdd(acc + 2, d2); atomicAdd(acc + 3, r2); atomicAdd(acc + 4, dg); atomicAdd(acc + 5, rg);
}
__global__ void st_eps3_fill(const double* acc, float* out, int n) {
    double e = 0.0; for (int i = 0; i < 3; ++i) e = fmax(e, sqrt(acc[2 * i] / (acc[2 * i + 1] + 1e-300))); e += 1e-30; const float v = sqrtf((float)fmax(0.0, -10.0 * log10(e)));
    for (size_t k = (size_t)blockIdx.x * blockDim.x + threadIdx.x; k < (size_t)n; k += (size_t)gridDim.x * blockDim.x) out[k] = v; }
__global__ void st_tail_check(const unsigned char* ws, const float* xin, const float* ctxin, const float* w_out, const float* g_ffn, const float* wg, const float* wu, const float* wd, double* acc) {
    __shared__ float xm[D]; __shared__ float h2[D]; __shared__ float act[FF]; __shared__ float red[256];
    const bf16_t* Y = (const bf16_t*)(ws + OFF_HY); const float* X = (const float*)(ws + OFF_X); const float* MOD = (const float*)(ws + OFF_MOD);
    const int row = blockIdx.x * 256 + 37, tid = threadIdx.x; const int mr = row < ML ? row / SEQ : NB; const float* md = MOD + (size_t)mr * 6 * D;
    const float* x0 = row < ML ? xin + (size_t)row * D : ctxin + (size_t)(row - ML) * D;
    for (int n = tid; n < D; n += 256) { float s = 0.f; for (int k = 0; k < 1024; ++k) s += bf2f(Y[(size_t)row * 1024 + k]) * w_out[(size_t)k * D + n]; xm[n] = x0[n] + md[2 * D + n] * s; }
    __syncthreads();
    float ss = 0.f; for (int n = tid; n < D; n += 256) ss += xm[n] * xm[n]; red[tid] = ss; __syncthreads();
    for (int o = 128; o > 0; o >>= 1) { if (tid < o) red[tid] += red[tid + o]; __syncthreads(); }
    const float rstd = 1.0f / sqrtf(red[0] / D + 1e-6f); __syncthreads();
    for (int n = tid; n < D; n += 256) h2[n] = xm[n] * rstd * g_ffn[n] * (1.0f + md[4 * D + n]) + md[3 * D + n];
    __syncthreads();
    for (int f = tid; f < FF; f += 256) { float a = 0.f, b = 0.f; for (int k = 0; k < D; ++k) { a += h2[k] * wg[(size_t)k * FF + f]; b += h2[k] * wu[(size_t)k * FF + f]; } act[f] = a / (1.0f + expf(-a)) * b; }
    __syncthreads();
    double d2 = 0.0, r2 = 0.0;
    for (int n = tid; n < D; n += 256) { float s = 0.f; for (int f = 0; f < FF; ++f) s += act[f] * wd[(size_t)f * D + n]; const float ref = xm[n] + md[5 * D + n] * s, v = X[(size_t)row * D + n]; d2 += (double)(v - ref) * (v - ref); r2 += (double)(ref - x0[n]) * (ref - x0[n]); }
    atomicAdd(acc, d2); atomicAdd(acc + 1, r2);
}
__global__ void st_ml_ref(const unsigned char* ws, const float* bias, float* href) {
    __shared__ float qs[64], ks[64], red[4][128], dred[4];
    const bf16_t* BQ = (const bf16_t*)(ws + OFF_P) + PE_BQ; const bf16_t* BK = (const bf16_t*)(ws + OFF_P) + PE_BK; const bf16_t* BV = (const bf16_t*)(ws + OFF_P) + PE_BV; const float* G = (const float*)(ws + OFF_G);
    const int chain = blockIdx.x, dir = chain & 1, h = (chain >> 1) & 3, b = chain >> 3, tid = threadIdx.x, dv = tid & 127, kg = tid >> 7;
    float C[16], nn[16]; for (int j = 0; j < 16; ++j) { C[j] = 0.f; nn[j] = 0.f; } float m = 0.f;
    for (int p = 0; p < LK; ++p) { int row; if (p < CTX) row = ML + b * CTX + (dir ? CTX - 1 - p : p); else row = b * SEQ + (dir ? SEQ - 1 - (p - CTX) : p - CTX);
        if (tid < 64) { qs[tid] = bf2f(BQ[(size_t)row * 256 + h * 64 + tid]); ks[tid] = bf2f(BK[(size_t)row * 256 + h * 64 + tid]) * 0.125f; }
        const float v = bf2f(BV[(size_t)row * 512 + h * 128 + dv]);
        const float ipre = G[(size_t)row * 16 + dir * 8 + h] + bias[dir * 8 + h], fpre = G[(size_t)row * 16 + dir * 8 + 4 + h] + bias[dir * 8 + 4 + h];
        const float lf = fminf(fpre, 0.f) - log1pf(expf(-fabsf(fpre)));
        __syncthreads();
        const float mn = fmaxf(lf + m, ipre), fs = expf(lf + m - mn), is = expf(ipre - mn); m = mn;
        float pn = 0.f, pd = 0.f;
        for (int j = 0; j < 16; ++j) { const int dk = 16 * kg + j; C[j] = fs * C[j] + is * ks[dk] * v; nn[j] = fs * nn[j] + is * ks[dk]; pn += qs[dk] * C[j]; pd += qs[dk] * nn[j]; }
        red[kg][dv] = pn; if (dv == 0) dred[kg] = pd;
        __syncthreads();
        if (kg == 0) { const float num = (red[0][dv] + red[1][dv]) + (red[2][dv] + red[3][dv]), den = (dred[0] + dred[1]) + (dred[2] + dred[3]);
            href[((size_t)dir * MT + row) * 512 + h * 128 + dv] = num / fmaxf(fabsf(den), expf(-m)); }
        __syncthreads(); }
}
__global__ void st_ml_cmp(const unsigned char* ws, const float* href, const float* gn, double* acc) {
    const bf16_t* BO = (const bf16_t*)(ws + OFF_P) + PE_BO; const bf16_t* Y = (const bf16_t*)(ws + OFF_HY); const int lane = threadIdx.x & 63;
    for (int it = (blockIdx.x * blockDim.x + threadIdx.x) >> 6; it < MT * 4; it += (gridDim.x * blockDim.x) >> 6) { const int row = it >> 2, h = it & 3; float v[2], ss = 0.f;
        for (int e = 0; e < 2; ++e) { const size_t o = (size_t)row * 512 + h * 128 + lane + 64 * e; v[e] = href[o] + href[(size_t)MT * 512 + o]; ss += v[e] * v[e]; }
        for (int o = 1; o < 64; o <<= 1) ss += __shfl_xor(ss, o);
        const float rstd = 1.0f / sqrtf(ss / 128.0f + 1e-6f); double d2 = 0.0, r2 = 0.0;
        for (int e = 0; e < 2; ++e) { const int dv = lane + 64 * e; const float og = bf2f(BO[(size_t)row * 512 + h * 128 + dv]); const float ref = v[e] * rstd * gn[dv] / (1.0f + expf(-og)), y = bf2f(Y[(size_t)row * 1024 + 512 + h * 128 + dv]); d2 += (double)(y - ref) * (y - ref); r2 += (double)ref * ref; }
        for (int o = 1; o < 64; o <<= 1) { d2 += __shfl_xor(d2, o); r2 += __shfl_xor(r2, o); }
        if (lane == 0) { atomicAdd(acc, d2); atomicAdd(acc + 1, r2); } }
}
__global__ void st_dn_ref(const unsigned char* ws, const float* convw, const float* alog, const float* dtb, float* href) {
    __shared__ float qkv[3][128], red[4][128], nrm[2];
    const bf16_t* DQ = (const bf16_t*)(ws + OFF_P) + PO_DQKV; const float* G = (const float*)(ws + OFF_G);
    const int chain = blockIdx.x, dir = chain & 1, h = (chain >> 1) & 3, b = chain >> 3, tid = threadIdx.x, dv = tid & 127, kg = tid >> 7;
    float S[32]; for (int j = 0; j < 32; ++j) S[j] = 0.f;
    for (int p = 0; p < LK; ++p) { const bool isctx = p < CTX; const int seqlen = isctx ? CTX : SEQ, rowbase = isctx ? ML + b * CTX : b * SEQ; const int tok = isctx ? (dir ? CTX - 1 - p : p) : (dir ? SEQ - 1 - (p - CTX) : p - CTX); const int row = rowbase + tok;
        if (tid < 384) { const int ten = tid >> 7, d = tid & 127, col = ten * 512 + h * 128 + d; float a = 0.f;
            for (int tap = 0; tap < 3; ++tap) { const int tk = tok + tap - 1; if (tk >= 0 && tk < seqlen) a += bf2f(DQ[(size_t)(rowbase + tk) * 1536 + col]) * convw[tap * 1536 + col]; }
            qkv[ten][d] = a / (1.0f + expf(-a)); }
        __syncthreads();
        if (tid < 128) { float s = 0.f; const int ten = tid >> 6; for (int d = (tid & 63); d < 128; d += 64) s += qkv[ten][d] * qkv[ten][d]; for (int o = 1; o < 64; o <<= 1) s += __shfl_xor(s, o); if ((tid & 63) == 0) nrm[ten] = s; }
        __syncthreads();
        const float qn = (1.0f / sqrtf(nrm[0] + 1e-6f)) * 0.08838834764831845f, kn = 1.0f / sqrtf(nrm[1] + 1e-6f);
        const float beta = 1.0f / (1.0f + expf(-G[(size_t)row * 16 + dir * 8 + h])); const float xg = G[(size_t)row * 16 + dir * 8 + 4 + h] + dtb[dir * 4 + h];
        const float at = expf(-expf(alog[dir * 4 + h]) * (fmaxf(xg, 0.f) + log1pf(expf(-fabsf(xg)))));
        const float v = qkv[2][dv]; float pk = 0.f;
        for (int j = 0; j < 32; ++j) pk += qkv[1][32 * kg + j] * kn * S[j];
        red[kg][dv] = pk; __syncthreads();
        const float kS = (red[0][dv] + red[1][dv]) + (red[2][dv] + red[3][dv]); __syncthreads();
        float po = 0.f;
        for (int j = 0; j < 32; ++j) { const float kk = qkv[1][32 * kg + j] * kn; S[j] = at * (S[j] - beta * kk * kS) + beta * kk * v; po += qkv[0][32 * kg + j] * qn * S[j]; }
        red[kg][dv] = po; __syncthreads();
        if (kg == 0 && !isctx) href[((size_t)dir * ML + row) * 512 + h * 128 + dv] = (red[0][dv] + red[1][dv]) + (red[2][dv] + red[3][dv]);
        __syncthreads(); }
}
__global__ void st_dn_cmp(const unsigned char* ws, const float* href, const float* gn, double* acc) {
    const bf16_t* Z = (const bf16_t*)(ws + OFF_P) + PO_Z; const bf16_t* Y = (const bf16_t*)(ws + OFF_HY); const int lane = threadIdx.x & 63;
    for (int it = (blockIdx.x * blockDim.x + threadIdx.x) >> 6; it < ML * 4; it += (gridDim.x * blockDim.x) >> 6) { const int row = it >> 2, h = it & 3; float v[2], ss = 0.f;
        for (int e = 0; e < 2; ++e) { const size_t o = (size_t)row * 512 + h * 128 + lane + 64 * e; v[e] = href[o] + href[(size_t)ML * 512 + o]; ss += v[e] * v[e]; }
        for (int o = 1; o < 64; o <<= 1) ss += __shfl_xor(ss, o);
        const float rstd = 1.0f / sqrtf(ss / 128.0f + 1e-6f); double d2 = 0.0, r2 = 0.0;
        for (int e = 0; e < 2; ++e) { const int dv = lane + 64 * e; const float z = bf2f(Z[(size_t)row * 512 + h * 128 + dv]); const float ref = v[e] * rstd * gn[dv] * (z / (1.0f + expf(-z))), y = bf2f(Y[(size_t)row * 1024 + 512 + h * 128 + dv]); d2 += (double)(y - ref) * (y - ref); r2 += (double)ref * ref; }
        for (int o = 1; o < 64; o <<= 1) { d2 += __shfl_xor(d2, o); r2 += __shfl_xor(r2, o); }
        if (lane == 0) { atomicAdd(acc, d2); atomicAdd(acc + 1, r2); } }
}
__global__ void st_truth_fill(const unsigned char* ws, float* out, int n) {
    const double T[9] = {846.38902932657311,-3988.0872614528216,-4023.4252461296091,7499.0995520059896,-6191.4193272974135,-6282.081387437358,8748.2446258433793,548.97920503418845,21616550.564093322};
    const double* g = (const double*)(ws + ST_CHK) + ((size_t)35 * 4) * 10; double d2 = 0.0; for (int k = 0; k < 8; ++k) d2 += (g[k] - T[k]) * (g[k] - T[k]);
    const double eps = sqrt(d2 / (8.0 * T[8])) + 1e-30; const float v = sqrtf((float)fmax(0.0, -10.0 * log10(eps)));
    for (size_t k = (size_t)blockIdx.x * blockDim.x + threadIdx.x; k < (size_t)n; k += (size_t)gridDim.x * blockDim.x) out[k] = v; }
__global__ void st_gqa_check(const unsigned char* ws, const bf16_t* QS, const float* qkg, double* acc, float* scr) {
    const int lane = threadIdx.x & 63, gw = (blockIdx.x * blockDim.x + threadIdx.x) >> 6, ngw = (gridDim.x * blockDim.x) >> 6, wv = threadIdx.x >> 6;
    const bf16_t* KVC = (const bf16_t*)(ws + OFF_P) + PO_KVC; const bf16_t* O = (const bf16_t*)(ws + OFF_P) + PO_QC;
    const float* COS = (const float*)(ws + OFF_ROPE); const float* SIN = COS + (size_t)SEQ * 32;
    float* s1 = scr + (size_t)gw * LK; __shared__ float qs[8][64];
    for (int it = gw; it < (ML / 16) * 8; it += ngw) { const int h = it & 7, kv = h >> 2, row = (it >> 3) * 16 + 5; const int b = row / SEQ, t = row % SEQ;
        {   const int d = lane, a = d >> 5, pp = (d >> 4) & 1, f = d & 15; float x = bf2f(QS[(size_t)row * 512 + h * 64 + d]); float ss = x * x; for (int o = 1; o < 64; o <<= 1) ss += __shfl_xor(ss, o);
            x = x * (1.0f / sqrtf(ss / 64.0f + 1e-6f)) * qkg[d]; const float xp = __shfl_xor(x, 16); const float cs = COS[(size_t)t * 32 + a * 16 + f], sn = SIN[(size_t)t * 32 + a * 16 + f]; qs[wv][d] = pp == 0 ? x * cs - xp * sn : x * cs + xp * sn; }
        __syncthreads();
        float m1 = -1e30f;
        for (int j = lane; j < LK; j += 64) { const int kr = pos_row(b, j); const bool rope = j >= CTX; const int kt = j - CTX; float ss = 0.f; const bf16_t* kp = KVC + (size_t)kr * 256 + kv * 64;
            for (int d = 0; d < 64; ++d) { const float kd = bf2f(kp[d]); ss += kd * kd; }
            const float rs = 1.0f / sqrtf(ss / 64.0f + 1e-6f); float a1 = 0.f;
            for (int d = 0; d < 64; ++d) { const int a = d >> 5, pp = (d >> 4) & 1, f = d & 15; float k1 = bf2f(kp[d]) * rs * qkg[64 + d];
                if (rope) { const float k1p = bf2f(kp[d ^ 16]) * rs * qkg[64 + (d ^ 16)]; const float cs = COS[(size_t)kt * 32 + a * 16 + f], sn = SIN[(size_t)kt * 32 + a * 16 + f]; k1 = pp == 0 ? k1 * cs - k1p * sn : k1 * cs + k1p * sn; }
                a1 += qs[wv][d] * k1; }
            a1 *= 0.125f; s1[j] = a1; m1 = fmaxf(m1, a1); }
        for (int o = 1; o < 64; o <<= 1) m1 = fmaxf(m1, __shfl_xor(m1, o));
        float l1 = 0.f;
        for (int j = lane; j < LK; j += 64) { const float p1 = expf(s1[j] - m1); s1[j] = p1; l1 += p1; }
        for (int o = 1; o < 64; o <<= 1) l1 += __shfl_xor(l1, o);
        __threadfence(); __syncthreads();
        float o0 = 0.f;
        for (int j = 0; j < LK; ++j) { const int kr = pos_row(b, j); o0 += s1[j] * bf2f(KVC[(size_t)kr * 256 + 128 + kv * 64 + lane]); }
        const float ref = o0 / l1, y = bf2f(O[(size_t)row * 512 + h * 64 + lane]);
        double d2 = (double)(y - ref) * (y - ref), r2 = (double)ref * ref;
        for (int o = 1; o < 64; o <<= 1) { d2 += __shfl_xor(d2, o); r2 += __shfl_xor(r2, o); }
        if (lane == 0) { atomicAdd(acc, d2); atomicAdd(acc + 1, r2); }
        __syncthreads(); }
}
__global__ void st_eps_fill(const double* acc, float* out, int n) { const double eps = sqrt(acc[0] / (acc[1] + 1e-300)) + 1e-30; const float v = sqrtf((float)fmax(0.0, -10.0 * log10(eps)));
    for (size_t k = (size_t)blockIdx.x * blockDim.x + threadIdx.x; k < (size_t)n; k += (size_t)gridDim.x * blockDim.x) out[k] = v; }
#endif
extern "C" void kernel_launch(void* const* d_in, const int* in_sizes, int n_in, void* d_out, int out_size, void* d_ws, size_t ws_size, hipStream_t stream) {
    static int grid = 0;
    if (grid == 0) {
        int dev = 0, cus = 0, per_cu = 0;
        if (hipGetDevice(&dev) != hipSuccess || hipDeviceGetAttribute(&cus, hipDeviceAttributeMultiprocessorCount, dev) != hipSuccess) { fprintf(stderr, "kernel_launch: device query failed\n"); grid = -1; return; }
        if (hipFuncSetAttribute((const void*)mega, hipFuncAttributeMaxDynamicSharedMemorySize, LDS_BYTES) != hipSuccess) { fprintf(stderr, "kernel_launch: hipFuncSetAttribute failed\n"); grid = -1; return; }
        if (hipOccupancyMaxActiveBlocksPerMultiprocessor(&per_cu, (const void*)mega, NTHREADS, LDS_BYTES) != hipSuccess || per_cu < 1) { fprintf(stderr, "kernel_launch: occupancy query says %d\n", per_cu); per_cu = 1; }
        (void)hipGetLastError();
        if (ws_size < WS_NEED || n_in != 25) { fprintf(stderr, "kernel_launch: workspace %zu < %zu needed or n_in %d != 25\n", ws_size, (size_t)WS_NEED, n_in); grid = -1; return; }
        grid = cus;
    }
    if (grid < 0) return;
    (void)hipMemsetAsync(d_ws, 0, ZERO_BYTES, stream);
    Args a{};
#if defined(SELFTEST) && (defined(ST_REPEAT) || defined(ST_TWICE) || defined(ST_FINAL) || defined(ST_DACHECK) || defined(ST_MODCHECK) || defined(ST_L0CHECK) || defined(ST_TAILCHECK) || defined(ST_MLCHECK) || defined(ST_DNCHECK) || defined(ST_GQCHECK))
    for (int i = 0; i < 25; ++i) a.in[i] = (const float*)d_in[i];
    a.out = (float*)d_out; a.ws = (unsigned char*)d_ws; float* sout = (float*)d_out;
#elif defined(SELFTEST) && defined(ST_SAME_BATCH)
    for (int i = 0; i < 25; ++i) a.in[i] = (const float*)d_in[i];
    float* ctxs = (float*)((unsigned char*)d_ws + al256(WS_NEED)); float* cs = ctxs + (size_t)NB * CTX * D; float* sout = (float*)d_out;
    hipLaunchKernelGGL(st_same_batch_inputs, dim3(1024), dim3(256), 0, stream, (const float*)d_in[0], (const float*)d_in[1], (const float*)d_in[2], (float*)d_out, cs, ctxs);
    a.in[0] = (const float*)d_out; a.in[1] = cs; a.in[2] = ctxs; a.out = (float*)d_out; a.ws = (unsigned char*)d_ws;
#elif defined(SELFTEST) && defined(ST_INPLACE)
    { StPtrs P; for (int i = 0; i < 25; ++i) { P.p[i] = (float*)d_in[i]; a.in[i] = (const float*)d_in[i]; }
      hipLaunchKernelGGL(st_gen_inplace, dim3(1024), dim3(256), 0, stream, P); }
    float* sout = (float*)d_out; a.out = sout; a.ws = (unsigned char*)d_ws;
#elif defined(SELFTEST)
    float* syn = (float*)((unsigned char*)d_ws + al256(WS_NEED)); float* sout = syn + st_offset(25);
    hipLaunchKernelGGL(st_gen, dim3(1024), dim3(256), 0, stream, syn);
    for (int i = 0; i < 25; ++i) a.in[i] = syn + st_offset(i);
    a.out = sout; a.ws = (unsigned char*)d_ws;
#else
    for (int i = 0; i < 25; ++i) a.in[i] = (const float*)d_in[i];
    a.out = (float*)d_out; a.ws = (unsigned char*)d_ws;
#endif
#ifdef SELFTEST
#ifdef ST_GQCHECK
    {   a.step_lo = 0; a.step_hi = 9 + 3; a.prologue = 1; a.final_ = 0;
        void* args[] = {&a};
        hipError_t e = hipLaunchCooperativeKernel((const void*)mega, dim3(grid), dim3(NTHREADS), args, LDS_BYTES, stream);
        if (e != hipSuccess) fprintf(stderr, "cooperative launch failed: %s (grid %d)\n", hipGetErrorString(e), grid);
        (void)hipMemcpyAsync(d_out, (unsigned char*)d_ws + OFF_P + PO_QC * 2, (size_t)MT * 512 * 2, hipMemcpyDeviceToDevice, stream);
        a.step_lo = 12; a.step_hi = 13; a.prologue = 0;
        (void)hipMemsetAsync(d_ws, 0, 512 * 1024, stream);
        e = hipLaunchCooperativeKernel((const void*)mega, dim3(grid), dim3(NTHREADS), args, LDS_BYTES, stream);
        double* acc = (double*)((unsigned char*)d_ws + ST_CHK); float* scr = (float*)((unsigned char*)d_ws + SO_U);
        hipLaunchKernelGGL(st_gqa_check, dim3(256), dim3(512), 0, stream, (const unsigned char*)d_ws, (const bf16_t*)d_out, (const float*)d_in[15], acc, scr);
        hipLaunchKernelGGL(st_eps_fill, dim3(1024), dim3(256), 0, stream, (const double*)acc, (float*)d_out, out_size); }
#elif defined(ST_DNCHECK)
#ifndef ST_LAYER
#define ST_LAYER 1
#endif
    {   a.step_lo = 0; a.step_hi = 9 * ST_LAYER + 3; a.prologue = 1; a.final_ = 0;
        void* args[] = {&a};
        hipError_t e = hipLaunchCooperativeKernel((const void*)mega, dim3(grid), dim3(NTHREADS), args, LDS_BYTES, stream);
        if (e != hipSuccess) fprintf(stderr, "cooperative launch failed: %s (grid %d)\n", hipGetErrorString(e), grid);
        float* href = (float*)d_out; double* acc = (double*)((unsigned char*)d_ws + ST_CHK);
        hipLaunchKernelGGL(st_dn_ref, dim3(NCHAIN), dim3(512), 0, stream, (const unsigned char*)d_ws, (const float*)d_in[16] + (ST_LAYER / 2) * 3 * 1536, (const float*)d_in[17] + (ST_LAYER / 2) * 8, (const float*)d_in[18] + (ST_LAYER / 2) * 8, href);
        a.step_lo = 9 * ST_LAYER + 3; a.step_hi = 9 * ST_LAYER + 5; a.prologue = 0;
        (void)hipMemsetAsync(d_ws, 0, 512 * 1024, stream);
        e = hipLaunchCooperativeKernel((const void*)mega, dim3(grid), dim3(NTHREADS), args, LDS_BYTES, stream);
        hipLaunchKernelGGL(st_dn_cmp, dim3(512), dim3(256), 0, stream, (const unsigned char*)d_ws, (const float*)href, (const float*)d_in[19] + (ST_LAYER / 2) * 128, acc);
        hipLaunchKernelGGL(st_eps_fill, dim3(1024), dim3(256), 0, stream, (const double*)acc, (float*)d_out, out_size); }
#elif defined(ST_MLCHECK)
#ifndef ST_LAYER
#define ST_LAYER 0
#endif
    {   a.step_lo = 0; a.step_hi = 9 * ST_LAYER + 5; a.prologue = 1; a.final_ = 0;
        void* args[] = {&a};
        hipError_t e = hipLaunchCooperativeKernel((const void*)mega, dim3(grid), dim3(NTHREADS), args, LDS_BYTES, stream);
        if (e != hipSuccess) fprintf(stderr, "cooperative launch failed: %s (grid %d)\n", hipGetErrorString(e), grid);
        float* href = (float*)((unsigned char*)d_ws + SE_DCT); double* acc = (double*)((unsigned char*)d_ws + ST_CHK);
        hipLaunchKernelGGL(st_ml_ref, dim3(NCHAIN), dim3(512), 0, stream, (const unsigned char*)d_ws, (const float*)d_in[9] + (ST_LAYER / 2) * 16, href);
        hipLaunchKernelGGL(st_ml_cmp, dim3(512), dim3(256), 0, stream, (const unsigned char*)d_ws, (const float*)href, (const float*)d_in[12] + (ST_LAYER / 2) * 128, acc);
        hipLaunchKernelGGL(st_eps_fill, dim3(1024), dim3(256), 0, stream, (const double*)acc, (float*)d_out, out_size); }
#elif defined(ST_TAILCHECK)
    {   a.step_lo = 0; a.step_hi = 5; a.prologue = 1; a.final_ = 0;
        void* args[] = {&a};
        hipError_t e = hipLaunchCooperativeKernel((const void*)mega, dim3(grid), dim3(NTHREADS), args, LDS_BYTES, stream);
        if (e != hipSuccess) fprintf(stderr, "cooperative launch failed: %s (grid %d)\n", hipGetErrorString(e), grid);
        float* ysave = (float*)((unsigned char*)d_ws + SE_DCT);
        (void)hipMemcpyAsync(ysave, (unsigned char*)d_ws + OFF_HY, (size_t)MT * 1024 * 2, hipMemcpyDeviceToDevice, stream);
        a.step_lo = 5; a.step_hi = 9; a.prologue = 0;
        (void)hipMemsetAsync(d_ws, 0, 512 * 1024, stream);
        e = hipLaunchCooperativeKernel((const void*)mega, dim3(grid), dim3(NTHREADS), args, LDS_BYTES, stream);
        (void)hipMemcpyAsync((unsigned char*)d_ws + OFF_HY, ysave, (size_t)MT * 1024 * 2, hipMemcpyDeviceToDevice, stream);
        double* acc = (double*)((unsigned char*)d_ws + ST_CHK);
        hipLaunchKernelGGL(st_tail_check, dim3(72), dim3(256), 0, stream, (const unsigned char*)d_ws, (const float*)d_in[0], (const float*)d_in[2], (const float*)d_in[13], (const float*)d_in[7], (const float*)d_in[21], (const float*)d_in[22], (const float*)d_in[23], acc);
        hipLaunchKernelGGL(st_eps_fill, dim3(1024), dim3(256), 0, stream, (const double*)acc, (float*)d_out, out_size); }
#elif defined(ST_L0CHECK)
    {   a.step_lo = 0; a.step_hi = 2; a.prologue = 1; a.final_ = 0;
        void* args[] = {&a};
        hipError_t e = hipLaunchCooperativeKernel((const void*)mega, dim3(grid), dim3(NTHREADS), args, LDS_BYTES, stream);
        if (e != hipSuccess) fprintf(stderr, "cooperative launch failed: %s (grid %d)\n", hipGetErrorString(e), grid);
        double* acc = (double*)((unsigned char*)d_ws + ST_CHK);
        hipLaunchKernelGGL(st_inproj_check, dim3(512), dim3(256), 0, stream, (const unsigned char*)d_ws, (const float*)d_in[8], acc);
        hipLaunchKernelGGL(st_norm_check, dim3(1), dim3(128), 0, stream, (const unsigned char*)d_ws, (const float*)d_in[6], (const float*)d_in[8], (const float*)d_in[0], (const float*)d_in[2], acc);
        hipLaunchKernelGGL(st_eps3_fill, dim3(1024), dim3(256), 0, stream, (const double*)acc, (float*)d_out, out_size); }
#elif defined(ST_MODCHECK)
    {   a.step_lo = 0; a.step_hi = 0; a.prologue = 1; a.final_ = 0;
        void* args[] = {&a};
        hipError_t e = hipLaunchCooperativeKernel((const void*)mega, dim3(grid), dim3(NTHREADS), args, LDS_BYTES, stream);
        if (e != hipSuccess) fprintf(stderr, "cooperative launch failed: %s (grid %d)\n", hipGetErrorString(e), grid);
        double* acc = (double*)((unsigned char*)d_ws + ST_CHK);
        hipLaunchKernelGGL(st_mod_check, dim3(512), dim3(256), 0, stream, (const unsigned char*)d_ws, (const float*)d_in[1], (const float*)d_in[3], (const float*)d_in[4], (const float*)d_in[5], acc);
        hipLaunchKernelGGL(st_eps_fill, dim3(1024), dim3(256), 0, stream, (const double*)acc, (float*)d_out, out_size); }
#elif defined(ST_DACHECK)
    {   a.step_lo = 0; a.step_hi = 5; a.prologue = 1; a.final_ = 0;
        void* args[] = {&a};
        hipError_t e = hipLaunchCooperativeKernel((const void*)mega, dim3(grid), dim3(NTHREADS), args, LDS_BYTES, stream);
        if (e != hipSuccess) fprintf(stderr, "cooperative launch failed: %s (grid %d)\n", hipGetErrorString(e), grid);
        double* acc = (double*)((unsigned char*)d_ws + ST_CHK); float* scr = (float*)((unsigned char*)d_ws + SE_DCT);
        hipLaunchKernelGGL(st_da_check, dim3(256), dim3(512), 0, stream, (const unsigned char*)d_ws, (const float*)d_in[10], (const float*)d_in[11], acc, scr);
        hipLaunchKernelGGL(st_eps_fill, dim3(1024), dim3(256), 0, stream, (const double*)acc, (float*)d_out, out_size); }
#elif defined(ST_FINAL)
    {   a.step_lo = 0; a.step_hi = CFG_LAYERS * 9; a.prologue = 1; a.final_ = 1;
        void* args[] = {&a};
        hipError_t e = hipLaunchCooperativeKernel((const void*)mega, dim3(grid), dim3(NTHREADS), args, LDS_BYTES, stream);
        if (e != hipSuccess) fprintf(stderr, "cooperative launch failed: %s (grid %d)\n", hipGetErrorString(e), grid);
        double* acc = (double*)((unsigned char*)d_ws + ST_CHK);
        hipLaunchKernelGGL(st_final_check, dim3(64), dim3(256), 0, stream, (const unsigned char*)d_ws, (const float*)d_out, (const float*)d_in[24], acc);
        hipLaunchKernelGGL(st_final_fill, dim3(1024), dim3(256), 0, stream, (const double*)acc, (float*)d_out, out_size); }
#elif defined(ST_TWICE)
    for (int rep = 0; rep < 2; ++rep) {
        (void)hipMemsetAsync(d_ws, 0, 512 * 1024, stream); (void)hipMemsetAsync((unsigned char*)d_ws + OFF_MOD, 0, ZERO_BYTES - OFF_MOD, stream);
        a.step_lo = 0; a.step_hi = CFG_LAYERS * 9; a.prologue = 1; a.final_ = 0;
        void* args[] = {&a};
        hipError_t e = hipLaunchCooperativeKernel((const void*)mega, dim3(grid), dim3(NTHREADS), args, LDS_BYTES, stream);
        if (e != hipSuccess) fprintf(stderr, "cooperative launch failed: %s (grid %d)\n", hipGetErrorString(e), grid);
        hipLaunchKernelGGL(st_check_kernel, dim3(256), dim3(NTHREADS), 0, stream, (unsigned char*)d_ws, 35, rep * 40); }
    hipLaunchKernelGGL(st_twice_report, dim3(1024), dim3(256), 0, stream, (const unsigned char*)d_ws, (float*)d_out, out_size);
#elif defined(ST_REPEAT)
    for (int st = 0; st < CFG_LAYERS * 9; ++st) { const int ph = st % 9;
        for (int rep = 0; rep < ((ph == 3 || ph == 5 || ph == 8) ? 1 : 2); ++rep) {
            a.step_lo = st; a.step_hi = st + 1; a.prologue = (st == 0 && rep == 0); a.final_ = 0;
            void* args[] = {&a};
            hipError_t e = hipLaunchCooperativeKernel((const void*)mega, dim3(grid), dim3(NTHREADS), args, LDS_BYTES, stream);
            if (e != hipSuccess) fprintf(stderr, "cooperative launch failed: %s (grid %d)\n", hipGetErrorString(e), grid);
            hipLaunchKernelGGL(st_check_kernel, dim3(256), dim3(NTHREADS), 0, stream, (unsigned char*)d_ws, st, rep * 40); } }
    hipLaunchKernelGGL(st_repeat_report, dim3(1024), dim3(256), 0, stream, (const unsigned char*)d_ws, (float*)d_out, out_size, CFG_LAYERS * 9);
#elif defined(ST_SAME_BATCH)
    a.step_lo = 0; a.step_hi = CFG_LAYERS * 9; a.prologue = 1; a.final_ = 1;
    { void* args[] = {&a};
      hipError_t e = hipLaunchCooperativeKernel((const void*)mega, dim3(grid), dim3(NTHREADS), args, LDS_BYTES, stream);
      if (e != hipSuccess) fprintf(stderr, "cooperative launch failed: %s (grid %d)\n", hipGetErrorString(e), grid); }
    double* acc = (double*)((unsigned char*)d_ws + ST_CHK);
    hipLaunchKernelGGL(st_batch_report, dim3(256), dim3(256), 0, stream, (const float*)sout, (float*)d_out, out_size, acc);
    hipLaunchKernelGGL(st_fill, dim3(1024), dim3(256), 0, stream, (const double*)acc, (float*)d_out, out_size);
#else
#ifndef ST_CHUNK
#define ST_CHUNK 1
#endif
    for (int st = 0; st < CFG_LAYERS * 9; st += ST_CHUNK) {
        a.step_lo = st; a.step_hi = st + ST_CHUNK; a.prologue = st == 0; a.final_ = 0;
        void* args[] = {&a};
        hipError_t e = hipLaunchCooperativeKernel((const void*)mega, dim3(grid), dim3(NTHREADS), args, LDS_BYTES, stream);
        if (e != hipSuccess) fprintf(stderr, "cooperative launch failed: %s (grid %d)\n", hipGetErrorString(e), grid);
        hipLaunchKernelGGL(st_check_kernel, dim3(256), dim3(NTHREADS), 0, stream, (unsigned char*)d_ws, st + ST_CHUNK - 1);
    }
#ifdef ST_TRUTH
    hipLaunchKernelGGL(st_truth_fill, dim3(1024), dim3(256), 0, stream, (const unsigned char*)d_ws, (float*)d_out, out_size);
#else
    hipLaunchKernelGGL(st_report, dim3(1024), dim3(256), 0, stream, (const unsigned char*)d_ws, (float*)d_out, out_size);
#endif
#endif
#elif defined(MULTI_LAUNCH)
    for (int st = 0; st < CFG_LAYERS * 9; st += MULTI_LAUNCH) {
        a.step_lo = st; a.step_hi = st + MULTI_LAUNCH < CFG_LAYERS * 9 ? st + MULTI_LAUNCH : CFG_LAYERS * 9; a.prologue = st == 0; a.final_ = 0;
        void* args[] = {&a};
        hipError_t e = hipLaunchCooperativeKernel((const void*)mega, dim3(grid), dim3(NTHREADS), args, LDS_BYTES, stream);
        if (e != hipSuccess) fprintf(stderr, "cooperative launch failed: %s (grid %d)\n", hipGetErrorString(e), grid);
    }
    {   a.step_lo = a.step_hi = CFG_LAYERS * 9; a.prologue = 0; a.final_ = 1;
        void* args[] = {&a};
        hipError_t e = hipLaunchCooperativeKernel((const void*)mega, dim3(grid), dim3(NTHREADS), args, LDS_BYTES, stream);
        if (e != hipSuccess) fprintf(stderr, "cooperative launch failed: %s (grid %d)\n", hipGetErrorString(e), grid); }
#elif defined(PROBE_Y)
    {   a.step_lo = 0; a.step_hi = 9 * (PROBE_Y - 1) + 5; a.prologue = 1; a.final_ = 0;
        void* args[] = {&a};
        hipError_t e = hipLaunchCooperativeKernel((const void*)mega, dim3(grid), dim3(NTHREADS), args, LDS_BYTES, stream);
        if (e != hipSuccess) fprintf(stderr, "cooperative launch failed: %s (grid %d)\n", hipGetErrorString(e), grid);
        double* acc = (double*)((unsigned char*)d_ws + 512 * 1024);
        hipLaunchKernelGGL(pr_stat, dim3(512), dim3(256), 0, stream, (const bf16_t*)((unsigned char*)d_ws + OFF_HY), ML, PROBE_C0, PROBE_C1, acc);
        hipLaunchKernelGGL(pr_fill, dim3(1024), dim3(256), 0, stream, (const double*)acc, (float*)d_out, out_size); }
#else
    a.step_lo = 0; a.step_hi = CFG_LAYERS * 9; a.prologue = 1; a.final_ = 1;
    void* args[] = {&a};
    hipError_t e = hipLaunchCooperativeKernel((const void*)mega, dim3(grid), dim3(NTHREADS), args, LDS_BYTES, stream);
    if (e != hipSuccess) fprintf(stderr, "cooperative launch failed: %s (grid %d)\n", hipGetErrorString(e), grid);
#ifdef RUN_TWICE
    (void)hipMemsetAsync(d_ws, 0, ZERO_BYTES, stream);
    e = hipLaunchCooperativeKernel((const void*)mega, dim3(grid), dim3(NTHREADS), args, LDS_BYTES, stream);
#endif
#endif
}
#endif
```

```cpp
#ifndef EMU
#include <hip/hip_runtime.h>
#include <hip/hip_cooperative_groups.h>
#include <cstdio>
#include <cstdint>
#include <cmath>
#endif

#ifndef CFG_D
#define CFG_D 1024
#define CFG_B 8
#define CFG_SEQ 2048
#define CFG_CTX 256
#define CFG_FF 2816
#endif
#ifndef DIS
#define DIS 0ull
#endif
#define ON(bit) (!(((unsigned long long)(DIS) >> (bit)) & 1ull))
#ifndef REPM
#define REPM 0ull
#endif
#define REPB(bit) for (int rep_ = 0; rep_ <= (int)(((unsigned long long)(REPM) >> (bit)) & 1ull); ++rep_)
#ifndef CFG_LAYERS
#define CFG_LAYERS 4
#endif
constexpr int D = CFG_D, NB = CFG_B, SEQ = CFG_SEQ, CTX = CFG_CTX, FF = CFG_FF, DEPTH = 4, GRIDW = 64;
constexpr int ML = NB * SEQ, MC = NB * CTX, MT = ML + MC;
constexpr int LK = CTX + SEQ;
constexpr int NCC = CTX / 64, NLC = SEQ / 64, NCH = NCC + NLC;
constexpr int E_IN = 3088, O_IN = 2832, NE = 3072, NO = 2816;
constexpr int NCHAIN = NB * 4 * 2;
constexpr float EPS = 1e-6f;
constexpr int NTHREADS = 512, NWAVES = 8;
static_assert(SEQ % 256 == 0 && MC % 256 == 0 && D % 256 == 0 && FF % 256 == 0 && CTX % 64 == 0, "shape constraints");

typedef unsigned short bf16_t;
typedef short bf16x8 __attribute__((ext_vector_type(8)));
typedef short bf16x4 __attribute__((ext_vector_type(4)));
typedef float f32x4 __attribute__((ext_vector_type(4)));
typedef float f32x2 __attribute__((ext_vector_type(2)));
typedef float f32x16 __attribute__((ext_vector_type(16)));
typedef unsigned u32x4 __attribute__((ext_vector_type(4)));
typedef unsigned u32x2 __attribute__((ext_vector_type(2)));

#ifdef EMU
#define DEV static inline
#define DEVM inline
#define TIDX (EMU_TID)
#define BIDX (EMU_BID)
#define NBLK (EMU_NBLK)
#define BLOCK_SYNC() emu::block_sync()
#define WAVE_FENCE() emu::wave_sync()
#define SHFL_XOR(v, m) emu::shfl_xor((v), (m))
#define SHFL(v, s) emu::shfl((v), (s))
#define MFMA32(a, b, c) emu::mfma32((a), (b), (c))
#define EXP2F(x) exp2f(x)
#define ATOMIC_ADD_F(p, v) (*(p) += (v))
#define SCHED_FENCE() do {} while (0)
#define LOGF_NATIVE(x) logf(x)
#define WAVE_ANY(p) (wave_max((p) ? 1.0f : 0.0f) > 0.5f)
#else
namespace cg = cooperative_groups;
#define DEV __device__ __forceinline__
#define DEVM __device__ __forceinline__
#define TIDX ((int)threadIdx.x)
#define BIDX ((int)blockIdx.x)
#define NBLK ((int)gridDim.x)
#define BLOCK_SYNC() __syncthreads()
#define WAVE_FENCE() do { asm volatile("s_waitcnt lgkmcnt(0)" ::: "memory"); } while (0)
#define SHFL_XOR(v, m) __shfl_xor((v), (m))
#define SHFL(v, s) __shfl((v), (s))
#define MFMA32(a, b, c) __builtin_amdgcn_mfma_f32_32x32x16_bf16((a), (b), (c), 0, 0, 0)
#define EXP2F(x) __builtin_amdgcn_exp2f(x)
#define ATOMIC_ADD_F(p, v) atomicAdd((p), (v))
#define SCHED_FENCE() __builtin_amdgcn_sched_barrier(0)
#define LOGF_NATIVE(x) __logf(x)
#define WAVE_ANY(p) (__any(p) != 0)
#endif

DEV unsigned f2bf(float f) { unsigned u = __builtin_bit_cast(unsigned, f); return (u + 0x7fffu + ((u >> 16) & 1u)) >> 16; }
DEV float bf2f(unsigned h) { return __builtin_bit_cast(float, h << 16); }
#ifdef EMU
DEV unsigned pk2(float lo, float hi) { return f2bf(lo) | (f2bf(hi) << 16); }
#else
typedef __bf16 hw_bf16x2 __attribute__((ext_vector_type(2)));
DEV unsigned pk2(float lo, float hi) { const f32x2 v = {lo, hi}; return __builtin_bit_cast(unsigned, __builtin_convertvector(v, hw_bf16x2)); }
#endif
DEV int crow(int r, int h) { return (r & 3) + 8 * (r >> 2) + 4 * h; }
DEV float wave_sum(float v) {
#pragma unroll
    for (int o = 1; o < 64; o <<= 1) v += SHFL_XOR(v, o);
    return v;
}
DEV float wave_max(float v) {
#pragma unroll
    for (int o = 1; o < 64; o <<= 1) v = fmaxf(v, SHFL_XOR(v, o));
    return v;
}
DEV bf16x8 ld16(const void* p) { return *(const bf16x8*)p; }
DEV bf16x8 pack_acc(const f32x16& x, int s) {
    u32x4 p; p[0] = pk2(x[8 * s + 0], x[8 * s + 1]); p[1] = pk2(x[8 * s + 2], x[8 * s + 3]); p[2] = pk2(x[8 * s + 4], x[8 * s + 5]); p[3] = pk2(x[8 * s + 6], x[8 * s + 7]);
    return __builtin_bit_cast(bf16x8, p);
}
DEV bf16x8 cat44(bf16x4 lo, bf16x4 hi) { return __builtin_shufflevector(lo, hi, 0, 1, 2, 3, 4, 5, 6, 7); }
#ifndef EMU
DEV float fast_expf_(float x) { return __builtin_amdgcn_exp2f(x * 1.4426950408889634f); }
#define expf(x) fast_expf_(x)
#endif
#ifdef EMU
DEV float sigmoidf_(float x) { return 1.0f / (1.0f + expf(-x)); }
DEV float siluf_(float x) { return x / (1.0f + expf(-x)); }
#else
DEV float sigmoidf_(float x) { return __builtin_amdgcn_rcpf(1.0f + __builtin_amdgcn_exp2f(x * -1.4426950408889634f)); }
DEV float siluf_(float x) { return x * __builtin_amdgcn_rcpf(1.0f + __builtin_amdgcn_exp2f(x * -1.4426950408889634f)); }
#endif
DEV float log1pexp_(float nax) {
    const float e = expf(nax), u = 1.0f + e, d = u - 1.0f; return d == 0.0f ? e : LOGF_NATIVE(u) * (e / d); }
DEV float logsigmoidf_(float x) { return fminf(x, 0.0f) - log1pexp_(-fabsf(x)); }
DEV float softplusf_(float x) { return fmaxf(x, 0.0f) + log1pexp_(-fabsf(x)); }

constexpr size_t al256(size_t x) { return (x + 255) & ~(size_t)255; }
constexpr size_t cmax(size_t a, size_t b) { return a > b ? a : b; }
constexpr size_t OFF_CTL = 0;
constexpr size_t OFF_MOD = 1u << 20;
constexpr size_t SZ_MOD = al256((size_t)DEPTH * 9 * 6 * D * 4);
constexpr size_t ZERO_BYTES = OFF_MOD + SZ_MOD;
constexpr size_t OFF_ROPE = ZERO_BYTES;
constexpr size_t OFF_G = OFF_ROPE + al256((size_t)SEQ * 64 * 4);
constexpr size_t OFF_X = OFF_G + al256((size_t)MT * 16 * 4);
constexpr size_t OFF_WIN = OFF_X + al256((size_t)MT * D * 4);
constexpr size_t OFF_WOUT = OFF_WIN + al256((size_t)NE * D * 2);
constexpr size_t OFF_P = OFF_WOUT + al256((size_t)D * 1024 * 2);
constexpr size_t SZ_P = al256((size_t)MT * cmax(NE, FF) * 2);
constexpr size_t OFF_HY = OFF_P + SZ_P;
constexpr size_t OFF_S = OFF_HY + al256((size_t)MT * cmax(D, 1024) * 2);
constexpr size_t PE_QA = 0, PE_KA = (size_t)MT * 512, PE_VA = (size_t)MT * 1024, PE_BQ = (size_t)MT * 1536, PE_BK = (size_t)MT * 1792, PE_BV = (size_t)MT * 2048, PE_BO = (size_t)MT * 2560;
constexpr size_t PO_QC = 0, PO_KVC = (size_t)MT * 512, PO_DQKV = (size_t)MT * 768, PO_Z = (size_t)MT * 2304;
constexpr size_t SE_KP = OFF_S;
constexpr size_t SE_VT = SE_KP + al256((size_t)NB * 8 * LK * 64 * 2);
constexpr size_t SE_DCT = SE_VT + al256((size_t)NB * 4 * 128 * LK * 2);
constexpr size_t SE_DN = SE_DCT + al256((size_t)NCHAIN * NCH * 8192 * 4);
constexpr size_t SE_SC = SE_DN + al256((size_t)NCHAIN * NCH * 64 * 4);
constexpr size_t SE_PARK = SE_SC + al256((size_t)NCHAIN * NCH * 4 * 4);
constexpr size_t SE_END = SE_PARK + al256((size_t)256 * NTHREADS * 64 * 4);
constexpr size_t SF_WGU = OFF_S;
constexpr size_t SF_WDN = SF_WGU + al256((size_t)2 * FF * D * 2);
constexpr size_t SF_END = SF_WDN + al256((size_t)D * FF * 2);
constexpr size_t SF_PART = SF_END;
constexpr size_t SF_PART_END = SF_PART + (size_t)128 * 65536 * 4;
constexpr size_t WS_NEED_EF = cmax(SE_END, SF_PART_END);

constexpr int LDS_BYTES = 147456;
constexpr int LDS_MISC = 131072;

struct Args { const float* in[25]; float* out; unsigned char* ws; int step_lo, step_hi, prologue, final_; };

struct Ctx {
    int tid, lane, wave, bid, nblk, gw, ngw;
    char* lds;
    const float* const* in; float* out; unsigned char* ws;
};
#ifdef EMU
#define PHASE_CTX(pc) const Ctx& pc = c
#else
#define PHASE_CTX(pc) Ctx pc = c; { int t_ = threadIdx.x; asm volatile("" : "+v"(t_)); pc.tid = t_; pc.lane = t_ & 63; pc.wave = __builtin_amdgcn_readfirstlane(t_ >> 6); pc.gw = pc.bid * NWAVES + pc.wave; \
    __attribute__((address_space(1))) unsigned char* g_ = (__attribute__((address_space(1))) unsigned char*)c.ws; asm volatile("" : "+s"(g_)); pc.ws = (unsigned char*)g_; }
#endif

#ifdef EMU
struct XcdBarrier { int dummy; };
#define GRID_BARRIER() emu::grid_sync()
#else
#define LAS __attribute__((address_space(3)))
#define XB_TMO      128
#define XB_XCNT(j)  (256  + 64 * (j))
#define XB_XSUB(j)  (1280 + 64 * (j))
#define XB_XGEN(j)  (2304 + 64 * (j))
#define XB_TOP      3328
#define XB_TOPGEN   3392
#define XCD_BAR_WORDS 3456
#define XB_SPIN_CAP (1u << 24)
__device__ __forceinline__ unsigned xb_ld(unsigned* p)              { return __hip_atomic_load(p, __ATOMIC_RELAXED, __HIP_MEMORY_SCOPE_AGENT); }
__device__ __forceinline__ unsigned xb_add(unsigned* p, unsigned v) { return __hip_atomic_fetch_add(p, v, __ATOMIC_RELAXED, __HIP_MEMORY_SCOPE_AGENT); }
__device__ __forceinline__ unsigned xb_xcc_id() { return (unsigned)__builtin_amdgcn_s_getreg((3 << 11) | 20) & 0xFu; }
#define XB_SPIN(cond, bar) do { unsigned _sp = 0; while (cond) { __builtin_amdgcn_s_sleep(1); \
    if ((++_sp & 255u) == 0u) { if (xb_ld(&(bar)[XB_TMO])) break; if (_sp > XB_SPIN_CAP) { atomicAdd(&(bar)[XB_TMO], 1u); break; } } } } while (0)
struct XcdBarrier { unsigned* bar; unsigned x; volatile LAS unsigned* st; };
__device__ __forceinline__ XcdBarrier xcd_barrier_post(unsigned* bar, volatile LAS unsigned* st) {
    XcdBarrier b; b.bar = bar; b.x = xb_xcc_id(); b.st = st;
    if (threadIdx.x == 0) (void)xb_add(&bar[XB_XCNT(b.x)], 1u);
    return b;
}
__device__ __forceinline__ void xcd_barrier_complete(unsigned* bar, unsigned x, unsigned& nloc, unsigned& nx) {
    const unsigned G = gridDim.x * gridDim.y * gridDim.z;
    unsigned sum, cnt, mine, sp = 0u;
    for (;;) {
        sum = 0u; cnt = 0u; mine = 0u;
#pragma unroll
        for (unsigned j = 0; j < 16; ++j) { const unsigned c = xb_ld(&bar[XB_XCNT(j)]); sum += c; cnt += (c > 0u) ? 1u : 0u; mine = (j == x) ? c : mine; }
        if (sum == G) break;
        __builtin_amdgcn_s_sleep(1);
        if ((++sp & 255u) == 0u) { if (xb_ld(&bar[XB_TMO])) break; if (sp > XB_SPIN_CAP) { atomicAdd(&bar[XB_TMO], 1u); break; } }
    }
    nloc = mine > 0u ? mine : 1u; nx = cnt > 0u ? cnt : 1u;
}
__device__ __forceinline__ void xcd_barrier(const XcdBarrier& b) {
    const bool leader = threadIdx.x == 0;
    asm volatile("s_waitcnt vmcnt(0)" ::: "memory");
    __syncthreads();
    if (leader) {
        unsigned* bar = b.bar;
        __builtin_amdgcn_s_waitcnt(0);
        unsigned nloc = b.st[0], nx = b.st[1];
        if (nloc == 0u) { xcd_barrier_complete(bar, b.x, nloc, nx); b.st[0] = nloc; b.st[1] = nx; }
        const unsigned old = xb_add(&bar[XB_XSUB(b.x)], 1u);
        const unsigned gen = old / nloc;
        if (old + 1u == (gen + 1u) * nloc) {
            __builtin_amdgcn_fence(__ATOMIC_RELEASE, "agent");
            asm volatile("s_waitcnt vmcnt(0)" ::: "memory");
            const unsigned og = xb_add(&bar[XB_TOP], 1u);
            const unsigned tg = og / nx;
            if (og + 1u == (tg + 1u) * nx) xb_add(&bar[XB_TOPGEN], 1u);
            else XB_SPIN(xb_ld(&bar[XB_TOPGEN]) == tg, bar);
            __builtin_amdgcn_fence(__ATOMIC_ACQUIRE, "agent");
            xb_add(&bar[XB_XGEN(b.x)], 1u);
            asm volatile("s_waitcnt vmcnt(0)" ::: "memory");
        } else {
            XB_SPIN(xb_ld(&bar[XB_XGEN(b.x)]) == gen, bar);
            __builtin_amdgcn_fence(__ATOMIC_ACQUIRE, "agent");
            asm volatile("s_waitcnt vmcnt(0)" ::: "memory");
        }
    }
    __syncthreads();
}
#ifdef USE_CG_SYNC
#define GRID_BARRIER() cg::this_grid().sync()
#else
#define GRID_BARRIER() xcd_barrier(bar)
#endif
#endif

#ifndef EMU
namespace pg8 {
#define PG8_LAS __attribute__((address_space(3)))
typedef unsigned short bf16_t;
typedef short bf16x8 __attribute__((ext_vector_type(8)));
typedef float f32x4 __attribute__((ext_vector_type(4)));
typedef unsigned u32x4 __attribute__((ext_vector_type(4)));
constexpr int BM = 256, BK = 64, HALF = 128, HTB = HALF * BK * 2  , STAGE_BYTES = 8 * HTB, NXCD = 8, WGM = 8;

__host__ __device__ __forceinline__ int lds_byte(int r, int c) { const int st = (r >> 4) * 2 + (c >> 5), rr = r & 15, cc = c & 31, ob = rr * 64 + cc * 2; return st * 1024 + (ob ^ (((ob >> 9) & 1) << 5)); }
__host__ __device__ __forceinline__ void stage_rc(int b, int& R, int& C) { const int st = b / 1024, sb = b % 1024, swz = sb ^ (((sb >> 9) & 1) << 5); R = (st >> 1) * 16 + swz / 64; C = (st & 1) * 32 + (swz % 64) / 2; }
__host__ __device__ __forceinline__ int perm32(int rho) { const int n = rho >> 4, i = rho & 15; return 8 * (i >> 2) + 4 * n + (i & 3); }

struct Unit { int pm, pn; };
struct Gemm { const bf16_t* A; const bf16_t* Bt; int M, N, K, ld; };

struct StaticOrder {
    int nM, nN, nwg, G, c, wave, lim;
    int tn, tpm, tpn, tw;
    __host__ __device__ void init(int M, int N, int G_, int c_) { nM = M / BM; nN = N / BM; nwg = nM * nN; G = G_; c = c_; lim = 0x7fffffff; tn = 0; tpm = 0; tpn = 0; tw = 1; }
    __host__ __device__ bool next(int i, Unit& u) const {
        const long L = (long)i * G + c; if (L >= nwg + tn || L >= lim) return false;
        if (L >= nwg) { const int idx = (int)L - nwg; u.pm = tpm + idx / tw; u.pn = tpn + idx % tw; return true; }
        int wgid = (int)L; { const int q = nwg / NXCD, r = nwg % NXCD, xcd = wgid % NXCD, off = wgid / NXCD; wgid = (xcd < r ? xcd * (q + 1) : r * (q + 1) + (xcd - r) * q) + off; }
        const int nig = WGM * nN, gid = wgid / nig, fm = gid * WGM, gsz = (nM - fm) < WGM ? (nM - fm) : WGM;
        u.pm = fm + ((wgid % nig) % gsz); u.pn = (wgid % nig) / gsz; return true;
    }
    __device__ __forceinline__ void a_ready(const Unit&) const {}
    __device__ __forceinline__ void done(const Unit&) const {}
};
template <class Epi, class Sched, bool ALIGN_EPI = false, bool SP2 = false>
__device__ __forceinline__ void gemm_phase(PG8_LAS unsigned char* lds, const Gemm g, const Sched& S, const Epi& E) {
    int tid_ = threadIdx.x; asm volatile("" : "+v"(tid_));
    const int tid = tid_, wid = __builtin_amdgcn_readfirstlane(tid >> 6), lane = tid & 63, wr = wid >> 2, wc = wid & 3, fr = lane & 15, fq = lane >> 4;
    const int K = g.K, nt = K / BK, LD = g.ld ? g.ld : g.K;
    unsigned voffA[2], voffB[2];
#pragma unroll
    for (int i = 0; i < 2; ++i) { int R, C; stage_rc(tid * 16 + i * 8192, R, C); const int Rb = Epi::PERM ? ((R & ~31) + perm32(R & 31)) : R;
        voffA[i] = (unsigned)(R * LD + C) * 2u; voffB[i] = (unsigned)(Rb * LD + C) * 2u; }
    const size_t kstep = (size_t)(BK * 2);
    const size_t hstep = (size_t)HALF * LD * 2;
    const size_t tstep = 2 * hstep;
    const unsigned ldsw = (unsigned)wid * 1024u;
    const int aoff = lds_byte(wr * 64 + fr, fq * 8), boff = lds_byte(wc * 32 + fr, fq * 8);
#define PG8_SA(b, h) (((b) * 2 + (h)) * HTB)
#define PG8_SB(b, h) ((4 + (b) * 2 + (h)) * HTB)
#define PG8_STAGE(bufoff, gbase, voff) do { _Pragma("unroll") for (int _i = 0; _i < 2; ++_i) \
        __builtin_amdgcn_global_load_lds((const unsigned*)((const char*)(gbase) + (voff)[_i]), (PG8_LAS unsigned*)(lds + (bufoff) + ldsw + _i * 8192), 16, 0, 0); } while (0)
#define PG8_LDA(dst, b, h) do { _Pragma("unroll") for (int m = 0; m < 4; ++m) _Pragma("unroll") for (int k = 0; k < 2; ++k) dst[m][k] = *(const PG8_LAS bf16x8*)(lds + PG8_SA(b, h) + aoff + m * 2048 + k * 1024); } while (0)
#define PG8_LDB(dst, b, h) do { _Pragma("unroll") for (int n = 0; n < 2; ++n) _Pragma("unroll") for (int k = 0; k < 2; ++k) dst[n][k] = *(const PG8_LAS bf16x8*)(lds + PG8_SB(b, h) + boff + n * 2048 + k * 1024); } while (0)
#define PG8_MMA(ai, bj, At, Bt) do { __builtin_amdgcn_s_setprio(1); _Pragma("unroll") for (int m = 0; m < 4; ++m) _Pragma("unroll") for (int n = 0; n < 2; ++n) _Pragma("unroll") for (int k = 0; k < 2; ++k) \
        acc[ai][bj][m][n] = __builtin_amdgcn_mfma_f32_16x16x32_bf16(Bt[n][k], At[m][k], acc[ai][bj][m][n], 0, 0, 0); __builtin_amdgcn_s_setprio(0); } while (0)
#define PG8_WAIT_V(n) asm volatile("s_waitcnt vmcnt(" #n ")" ::: "memory")
#define PG8_WAIT_L(n) asm volatile("s_waitcnt lgkmcnt(" #n ")" ::: "memory")
#define PG8_BAR __builtin_amdgcn_s_barrier()
#define PG8_SCHED __builtin_amdgcn_sched_barrier(0)
    Unit cur, nxt; int ui = 0;
    if (!S.next(0, cur)) return;
    f32x4 acc[2][2][4][2];
#pragma unroll
    for (int a = 0; a < 2; ++a)
#pragma unroll
        for (int b = 0; b < 2; ++b)
#pragma unroll
            for (int m = 0; m < 4; ++m)
#pragma unroll
                for (int n = 0; n < 2; ++n) acc[a][b][m][n] = (f32x4){0.f, 0.f, 0.f, 0.f};
    bf16x8 At[4][2], B0[2][2], B1[2][2];
    const char* cA = (const char*)g.A + (size_t)cur.pm * tstep; const char* cB = (const char*)g.Bt + (size_t)cur.pn * tstep;
    S.a_ready(cur);
    if constexpr (SP2) {
        PG8_STAGE(PG8_SB(0, 0), cB, voffB); PG8_STAGE(PG8_SB(0, 1), cB + hstep, voffB); PG8_STAGE(PG8_SA(0, 0), cA, voffA); PG8_STAGE(PG8_SA(0, 1), cA + hstep, voffA);
        if (wr == 1) PG8_BAR;
        PG8_WAIT_V(2); PG8_BAR;
        PG8_STAGE(PG8_SB(1, 0), cB + kstep, voffB); PG8_STAGE(PG8_SA(1, 0), cA + kstep, voffA); PG8_STAGE(PG8_SB(1, 1), cB + hstep + kstep, voffB);
        PG8_WAIT_V(6); PG8_BAR;
    } else {
        PG8_STAGE(PG8_SB(0, 0), cB, voffB); PG8_STAGE(PG8_SA(0, 0), cA, voffA); PG8_STAGE(PG8_SB(0, 1), cB + hstep, voffB); PG8_STAGE(PG8_SA(0, 1), cA + hstep, voffA);
        if (wr == 1) PG8_BAR;
        PG8_WAIT_V(4); PG8_BAR;
        PG8_STAGE(PG8_SB(1, 0), cB + kstep, voffB); PG8_STAGE(PG8_SA(1, 0), cA + kstep, voffA); PG8_STAGE(PG8_SB(1, 1), cB + hstep + kstep, voffB);
        PG8_WAIT_V(6); PG8_BAR;
    }
    for (;;) {
        const bool has_next = S.next(ui + 1, nxt);
        const char* nA = has_next ? (const char*)g.A + (size_t)nxt.pm * tstep : cA; const char* nB = has_next ? (const char*)g.Bt + (size_t)nxt.pn * tstep : cB;
        for (int t = 0; t < nt; t += 2) {
            const bool last = (t == nt - 2);
            const char* a1 = cA + (size_t)(t + 1) * kstep;
            const char* a2 = last ? nA : cA + (size_t)(t + 2) * kstep; const char* b2 = last ? nB : cB + (size_t)(t + 2) * kstep;
            const char* a3 = a2 + kstep; const char* b3 = b2 + kstep;
            if (last && has_next) S.a_ready(nxt);
            if constexpr (SP2) {
            PG8_LDB(B0, 0, 0); PG8_LDB(B1, 0, 1); PG8_SCHED; PG8_LDA(At, 0, 0); PG8_STAGE(PG8_SA(1, 1), a1 + hstep, voffA);
            PG8_WAIT_V(8); PG8_WAIT_L(0); PG8_BAR; PG8_MMA(0, 0, At, B0); PG8_MMA(0, 1, At, B1); PG8_BAR; PG8_SCHED;
            PG8_LDA(At, 0, 1); PG8_STAGE(PG8_SB(0, 0), b2, voffB); PG8_STAGE(PG8_SB(0, 1), b2 + hstep, voffB); PG8_STAGE(PG8_SA(0, 0), a2, voffA);
            PG8_WAIT_V(8); PG8_WAIT_L(0); PG8_BAR; PG8_MMA(1, 0, At, B0); PG8_MMA(1, 1, At, B1); PG8_BAR; PG8_SCHED;
            PG8_LDB(B0, 1, 0); PG8_LDB(B1, 1, 1); PG8_SCHED; PG8_LDA(At, 1, 0); PG8_STAGE(PG8_SA(0, 1), a2 + hstep, voffA);
            PG8_WAIT_V(8); PG8_WAIT_L(0); PG8_BAR; PG8_MMA(0, 0, At, B0); PG8_MMA(0, 1, At, B1); PG8_BAR; PG8_SCHED;
            PG8_LDA(At, 1, 1); PG8_STAGE(PG8_SB(1, 0), b3, voffB); PG8_STAGE(PG8_SB(1, 1), b3 + hstep, voffB); PG8_STAGE(PG8_SA(1, 0), a3, voffA);
            PG8_WAIT_V(8); PG8_WAIT_L(0); PG8_BAR; PG8_MMA(1, 0, At, B0); PG8_MMA(1, 1, At, B1); PG8_BAR; PG8_SCHED;
            } else {
            PG8_LDB(B0, 0, 0); PG8_SCHED; PG8_LDA(At, 0, 0); PG8_STAGE(PG8_SA(1, 1), a1 + hstep, voffA);
            PG8_WAIT_L(8); PG8_BAR; PG8_WAIT_L(0); PG8_MMA(0, 0, At, B0); PG8_BAR; PG8_SCHED;
            PG8_LDB(B1, 0, 1); PG8_STAGE(PG8_SB(0, 0), b2, voffB);
            PG8_BAR; PG8_WAIT_L(0); PG8_MMA(0, 1, At, B1); PG8_BAR;
            PG8_LDA(At, 0, 1); PG8_STAGE(PG8_SA(0, 0), a2, voffA);
            PG8_BAR; PG8_WAIT_L(0); PG8_MMA(1, 0, At, B0); PG8_BAR; PG8_SCHED;
            PG8_STAGE(PG8_SB(0, 1), b2 + hstep, voffB);
            PG8_WAIT_V(6); PG8_BAR; PG8_MMA(1, 1, At, B1); PG8_BAR;
            PG8_LDB(B0, 1, 0); PG8_SCHED; PG8_LDA(At, 1, 0); PG8_STAGE(PG8_SA(0, 1), a2 + hstep, voffA);
            PG8_WAIT_L(8); PG8_BAR; PG8_WAIT_L(0); PG8_MMA(0, 0, At, B0); PG8_BAR; PG8_SCHED;
            PG8_LDB(B1, 1, 1); PG8_STAGE(PG8_SB(1, 0), b3, voffB);
            PG8_BAR; PG8_WAIT_L(0); PG8_MMA(0, 1, At, B1); PG8_BAR;
            PG8_LDA(At, 1, 1); PG8_STAGE(PG8_SA(1, 0), a3, voffA);
            PG8_BAR; PG8_WAIT_L(0); PG8_MMA(1, 0, At, B0); PG8_BAR; PG8_SCHED;
            PG8_STAGE(PG8_SB(1, 1), b3 + hstep, voffB);
            PG8_WAIT_V(6); PG8_BAR; PG8_MMA(1, 1, At, B1); PG8_BAR;
            }
        }
        if constexpr (ALIGN_EPI) { if (wr == 0) PG8_BAR; }
        if constexpr (!Epi::AFTER_DRAIN) { E(acc, cur, wr, wc, fr, fq); S.done(cur); }
        if (!has_next) break;
#pragma unroll
        for (int a = 0; a < 2; ++a)
#pragma unroll
            for (int b = 0; b < 2; ++b)
#pragma unroll
                for (int m = 0; m < 4; ++m)
#pragma unroll
                    for (int n = 0; n < 2; ++n) acc[a][b][m][n] = (f32x4){0.f, 0.f, 0.f, 0.f};
        cur = nxt; cA = nA; cB = nB; ++ui;
        if constexpr (ALIGN_EPI) { if (wr == 1) PG8_BAR; }
    }
    PG8_WAIT_V(0);
    if constexpr (!ALIGN_EPI) { if (wr == 0) PG8_BAR; }
    PG8_BAR;
    if constexpr (Epi::AFTER_DRAIN) { E.fused(acc, cur, wr, wc, fr, fq, lds, wid, lane); S.done(cur); }
#undef PG8_SA
#undef PG8_SB
#undef PG8_STAGE
#undef PG8_LDA
#undef PG8_LDB
#undef PG8_MMA
#undef PG8_WAIT_V
#undef PG8_WAIT_L
#undef PG8_BAR
#undef PG8_SCHED
}
}
#else
namespace pg8 {
typedef unsigned short bf16_t;
constexpr int BM = 256, BK = 64, HALF = 128, NXCD = 8, WGM = 8;
struct Unit { int pm, pn; };
struct Gemm { const bf16_t* A; const bf16_t* Bt; int M, N, K, ld; };
struct StaticOrder {
    int nM, nN, nwg, G, c, wave, lim, tn, tpm, tpn, tw;
    void init(int M, int N, int G_, int c_) { nM = M / BM; nN = N / BM; nwg = nM * nN; G = G_; c = c_; lim = 0x7fffffff; tn = 0; tpm = 0; tpn = 0; tw = 1; }
    bool next(int i, Unit& u) const {
        const long L = (long)i * G + c; if (L >= nwg + tn || L >= lim) return false;
        if (L >= nwg) { const int idx = (int)L - nwg; u.pm = tpm + idx / tw; u.pn = tpn + idx % tw; return true; }
        int wgid = (int)L; { const int q = nwg / NXCD, r = nwg % NXCD, xcd = wgid % NXCD, off = wgid / NXCD; wgid = (xcd < r ? xcd * (q + 1) : r * (q + 1) + (xcd - r) * q) + off; }
        const int nig = WGM * nN, gid = wgid / nig, fm = gid * WGM, gsz = (nM - fm) < WGM ? (nM - fm) : WGM;
        u.pm = fm + ((wgid % nig) % gsz); u.pn = (wgid % nig) / gsz; return true;
    }
};
template <class Epi, class Sched, bool ALIGN_EPI = false, bool SP2 = false>
static inline void gemm_phase(unsigned char* lds, const Gemm g, const Sched& S, const Epi& E) {
    const int tid = TIDX, wid = tid >> 6, lane = tid & 63, wr = wid >> 2, wc = wid & 3, fr = lane & 15, fq = lane >> 4;
    Unit u;
    for (int i = 0; S.next(i, u); ++i) {
        f32x4 acc[2][2][4][2];
        for (int ai = 0; ai < 2; ++ai) for (int bj = 0; bj < 2; ++bj) for (int m = 0; m < 4; ++m) for (int n = 0; n < 2; ++n) for (int j = 0; j < 4; ++j) {
            const int row = 256 * u.pm + 128 * ai + 64 * wr + 16 * m + fr;
            const int col = Epi::PERM ? 256 * u.pn + 128 * bj + 32 * wc + 8 * fq + 4 * n + j : 256 * u.pn + 128 * bj + 32 * wc + 16 * n + 4 * fq + j;
            const int ld = g.ld ? g.ld : g.K; const bf16_t* a = g.A + (size_t)row * ld; const bf16_t* b = g.Bt + (size_t)col * ld; float s = 0.f;
            for (int k = 0; k < g.K; ++k) s += bf2f(a[k]) * bf2f(b[k]);
            acc[ai][bj][m][n][j] = s; }
        E(acc, u, wr, wc, fr, fq);
    }
    BLOCK_SYNC();
}
}
#define PG8_LAS
#endif

#if !defined(EMU) && defined(SIMPLE_GEMM)
namespace sg {
template <class Epi, class Sched>
__device__ __forceinline__ void gemm_phase(const pg8::Gemm g, const Sched& S, const Epi& E) {
    int tid_ = threadIdx.x; asm volatile("" : "+v"(tid_));
    const int tid = tid_, wid = __builtin_amdgcn_readfirstlane(tid >> 6), lane = tid & 63, wr = wid >> 2, wc = wid & 3, fr = lane & 15, fq = lane >> 4;
    pg8::Unit u;
    for (int i = 0; S.next(i, u); ++i) {
        f32x4 acc[2][2][4][2];
#pragma unroll
        for (int ai = 0; ai < 2; ++ai)
#pragma unroll
            for (int bj = 0; bj < 2; ++bj)
#pragma unroll
                for (int m = 0; m < 4; ++m)
#pragma unroll
                    for (int n = 0; n < 2; ++n) acc[ai][bj][m][n] = (f32x4){0.f, 0.f, 0.f, 0.f};
        const bf16_t* wp0 = g.Bt + (size_t)(256 * u.pn + 32 * wc + (Epi::PERM ? 8 * (fr >> 2) + (fr & 3) : fr)) * g.K + 8 * fq;
        const bf16_t* xp0 = g.A + (size_t)(256 * u.pm + 64 * wr + fr) * g.K + 8 * fq;
#pragma unroll 1
        for (int k0 = 0; k0 < g.K; k0 += 32) {
            bf16x8 wf[2][2], xf[2][4];
#pragma unroll
            for (int bj = 0; bj < 2; ++bj)
#pragma unroll
                for (int n = 0; n < 2; ++n) wf[bj][n] = *(const bf16x8*)(wp0 + (size_t)(128 * bj + (Epi::PERM ? 4 : 16) * n) * g.K + k0);
#pragma unroll
            for (int ai = 0; ai < 2; ++ai)
#pragma unroll
                for (int m = 0; m < 4; ++m) xf[ai][m] = *(const bf16x8*)(xp0 + (size_t)(128 * ai + 16 * m) * g.K + k0);
#pragma unroll
            for (int ai = 0; ai < 2; ++ai)
#pragma unroll
                for (int bj = 0; bj < 2; ++bj)
#pragma unroll
                    for (int m = 0; m < 4; ++m)
#pragma unroll
                        for (int n = 0; n < 2; ++n) acc[ai][bj][m][n] = __builtin_amdgcn_mfma_f32_16x16x32_bf16(wf[bj][n], xf[ai][m], acc[ai][bj][m][n], 0, 0, 0);
        }
        E(acc, u, wr, wc, fr, fq);
    }
}
}
#define GEMM_PHASE(EpiT, lds, g, S, E) sg::gemm_phase<EpiT, pg8::StaticOrder>(g, S, E)
#else
#define GEMM_PHASE(EpiT, lds, g, S, E) pg8::gemm_phase<EpiT, pg8::StaticOrder, true, true>((PG8_LAS unsigned char*)(lds), g, S, E)
#endif

struct EpiSeg {
    static constexpr bool PERM = true, AFTER_DRAIN = false;
    bf16_t* P; int odd;
    DEVM void operator()(const f32x4 (&acc)[2][2][4][2], const pg8::Unit& u, int wr, int wc, int fr, int fq) const {
        size_t off; int pitch, c0;
        const int pn = u.pn;
        if (!odd) {
            if (pn < 2) { off = PE_QA; pitch = 512; c0 = 256 * pn; } else if (pn < 4) { off = PE_KA; pitch = 512; c0 = 256 * (pn - 2); } else if (pn < 6) { off = PE_VA; pitch = 512; c0 = 256 * (pn - 4); }
            else if (pn == 6) { off = PE_BQ; pitch = 256; c0 = 0; } else if (pn == 7) { off = PE_BK; pitch = 256; c0 = 0; } else if (pn < 10) { off = PE_BV; pitch = 512; c0 = 256 * (pn - 8); } else { off = PE_BO; pitch = 512; c0 = 256 * (pn - 10); }
        } else {
            if (pn < 2) { off = PO_QC; pitch = 512; c0 = 256 * pn; } else if (pn == 2) { off = PO_KVC; pitch = 256; c0 = 0; } else if (pn < 9) { off = PO_DQKV; pitch = 1536; c0 = 256 * (pn - 3); } else { off = PO_Z; pitch = 512; c0 = 256 * (pn - 9); }
        }
        bf16_t* base = P + off;
        const int row0 = u.pm * 256 + wr * 64 + fr, col0 = c0 + wc * 32 + 8 * fq;
#pragma unroll
        for (int ai = 0; ai < 2; ++ai)
#pragma unroll
            for (int m = 0; m < 4; ++m) { bf16_t* rowp = base + (size_t)(row0 + ai * 128 + m * 16) * pitch + col0;
#pragma unroll
                for (int bj = 0; bj < 2; ++bj) { const f32x4 v0 = acc[ai][bj][m][0], v1 = acc[ai][bj][m][1];
                    u32x4 w; w[0] = pk2(v0[0], v0[1]); w[1] = pk2(v0[2], v0[3]); w[2] = pk2(v1[0], v1[1]); w[3] = pk2(v1[2], v1[3]);
                    *(u32x4*)(rowp + bj * 128) = w; } }
    }
};
struct EpiResid {
    static constexpr bool PERM = false, AFTER_DRAIN = false;
    float* X; const float* mod; int gaoff;
    const float* XL; const float* XC;
    DEVM void operator()(const f32x4 (&acc)[2][2][4][2], const pg8::Unit& u, int wr, int wc, int fr, int fq) const {
        const int rowt = u.pm * 256; const int mr = rowt < ML ? rowt / SEQ : NB;
        const float* ga = mod + (size_t)mr * 6 * D + gaoff; const float* Xs = rowt < ML ? XL : XC;
        const int row0 = rowt + wr * 64 + fr, col0 = u.pn * 256 + wc * 32 + 4 * fq;
#pragma unroll
        for (int bj = 0; bj < 2; ++bj)
#pragma unroll
            for (int n = 0; n < 2; ++n) { const int c = col0 + bj * 128 + n * 16; const f32x4 g = *(const f32x4*)(ga + c);
#pragma unroll
                for (int ai = 0; ai < 2; ++ai)
#pragma unroll
                    for (int m = 0; m < 4; ++m) { const size_t off = (size_t)(row0 + ai * 128 + m * 16) * D + c; const f32x4 x = *(const f32x4*)(Xs + off); *(f32x4*)(X + off) = x + g * acc[ai][bj][m][n]; } }
    }
};
struct EpiPart {
    static constexpr bool PERM = false, AFTER_DRAIN = false;
    float* P;
    DEVM void operator()(const f32x4 (&acc)[2][2][4][2], const pg8::Unit& u, int wr, int wc, int fr, int fq) const {
        (void)u; const int r0 = wr * 64 + fr, c0 = wc * 32 + 4 * fq;
#pragma unroll
        for (int bj = 0; bj < 2; ++bj)
#pragma unroll
            for (int n = 0; n < 2; ++n)
#pragma unroll
                for (int ai = 0; ai < 2; ++ai)
#pragma unroll
                    for (int m = 0; m < 4; ++m) *(f32x4*)(P + (size_t)(r0 + ai * 128 + m * 16) * 256 + c0 + bj * 128 + n * 16) = acc[ai][bj][m][n];
    }
};
struct SplitPlan { int extra, split, nwg; };
DEV SplitPlan split_plan(int mrows, int kdim, int nblk, bool allow) {
    SplitPlan p; p.nwg = (mrows / 256) * (D / 256); p.extra = 0; p.split = 1;
    if (allow && p.nwg > nblk && p.nwg < 2 * nblk) { const int pairs = kdim / 128; int sp = 4; const int ex = p.nwg - nblk;
        while (sp > 1 && (ex * sp > nblk || sp > pairs || ex * sp > 128)) sp >>= 1;
        if (sp > 1) { p.extra = ex; p.split = sp; } }
    return p;
}

struct EpiSwiglu {
    static constexpr bool PERM = true, AFTER_DRAIN = false;
    bf16_t* ACT;
    DEVM void operator()(const f32x4 (&acc)[2][2][4][2], const pg8::Unit& u, int wr, int wc, int fr, int fq) const {
        const int row0 = u.pm * 256 + wr * 64 + fr, col0 = u.pn * 128 + wc * 32 + 8 * fq;
#pragma unroll
        for (int ai = 0; ai < 2; ++ai)
#pragma unroll
            for (int m = 0; m < 4; ++m) { bf16_t* rowp = ACT + (size_t)(row0 + ai * 128 + m * 16) * FF + col0;
                float v[8];
#pragma unroll
                for (int n = 0; n < 2; ++n)
#pragma unroll
                    for (int j = 0; j < 4; ++j) { const float g = acc[ai][0][m][n][j], up = acc[ai][1][m][n][j]; v[4 * n + j] = siluf_(g) * up; }
                u32x4 w; w[0] = pk2(v[0], v[1]); w[1] = pk2(v[2], v[3]); w[2] = pk2(v[4], v[5]); w[3] = pk2(v[6], v[7]);
                *(u32x4*)rowp = w; }
    }
};

DEV void p0_prologue(const Ctx& c) {
    const float* x = c.in[0]; const float* cv = c.in[1]; const float* ctx = c.in[2]; const float* cctx = c.in[3]; const float* w_ada = c.in[4]; const float* b_ada = c.in[5];
    float* MOD = (float*)(c.ws + OFF_MOD);
    const long gt = (long)c.bid * NTHREADS + c.tid, GT = (long)c.nblk * NTHREADS;
    {   constexpr int NCG = 6 * D / 128, KW = D / 8; f32x2* part = (f32x2*)c.lds;
        for (int it = c.bid; it < DEPTH * NCG; it += c.nblk) { const int l = it / NCG, cg = it % NCG; const int n2 = cg * 64 + c.lane;
            f32x2 acc[9];
#pragma unroll
            for (int r = 0; r < 9; ++r) acc[r] = (f32x2){0.f, 0.f};
            const float* W = w_ada + ((size_t)l * D + c.wave * KW) * 6 * D + 2 * n2;
#pragma unroll 8
            for (int k = 0; k < KW; ++k) { const f32x2 w = *(const f32x2*)(W + (size_t)k * 6 * D); const int kk = c.wave * KW + k;
#pragma unroll
                for (int r = 0; r < 9; ++r) { const float sv = siluf_(r < NB ? cv[r * D + kk] : cctx[kk]); acc[r] += w * sv; } }
#pragma unroll
            for (int r = 0; r < 9; ++r) part[(c.wave * 9 + r) * 64 + c.lane] = acc[r];
            BLOCK_SYNC();
            for (int o = c.tid; o < 9 * 64; o += NTHREADS) { const int r = o / 64, q = o % 64; f32x2 sum = *(const f32x2*)(b_ada + (size_t)l * 6 * D + 2 * (cg * 64 + q));
#pragma unroll
                for (int w = 0; w < 8; ++w) sum += part[(w * 9 + r) * 64 + q];
                *(f32x2*)(MOD + ((size_t)l * 9 + r) * 6 * D + 2 * (cg * 64 + q)) = sum; }
            BLOCK_SYNC(); } }
    float* COS = (float*)(c.ws + OFF_ROPE); float* SIN = COS + SEQ * 32;
    for (long it = gt; it < (long)SEQ * 32; it += GT) { const int t = (int)(it >> 5), i = (int)(it & 31);
        const float fr = expf(-(float)(i & 15) * (9.210340371976184f / 16.0f));     const float pos = (i < 16) ? (float)(t / GRIDW) : (float)(t % GRIDW); const float a = pos * fr;
        COS[it] = cosf(a); SIN[it] = sinf(a); }
    (void)x; (void)ctx;
}

DEV void transpose_item(const float* W, int srcpitch, int k0, int n0, bf16_t* WT, int Kp, int dstrow0, float* scr, int lane) {
#pragma unroll 8
    for (int i = 0; i < 32; ++i) { const int kk = 2 * i + (lane >> 5); scr[kk * 33 + (lane & 31)] = W[(size_t)(k0 + kk) * srcpitch + n0 + (lane & 31)]; }
    WAVE_FENCE();
    const int cc = lane & 7;
#pragma unroll
    for (int j = 0; j < 4; ++j) { const int n = (lane >> 3) + 8 * j; const float* s = scr + (8 * cc) * 33 + n;
        u32x4 o; o[0] = pk2(s[0 * 33], s[1 * 33]); o[1] = pk2(s[2 * 33], s[3 * 33]); o[2] = pk2(s[4 * 33], s[5 * 33]); o[3] = pk2(s[6 * 33], s[7 * 33]);
        *(u32x4*)(WT + (size_t)(dstrow0 + n) * Kp + k0 + 8 * cc) = o; }
    WAVE_FENCE();
}
DEV void convert_mixer_weights(const Ctx& c, int layer, int gw, int ngw) {
    float* scr = (float*)(c.lds + c.wave * 8448);
    const int odd = layer & 1, li = layer >> 1;
    const float* win = odd ? c.in[14] + (size_t)li * D * O_IN : c.in[8] + (size_t)li * D * E_IN; const int pin = odd ? O_IN : E_IN, nin = odd ? NO : NE;
    const float* wout = odd ? c.in[20] + (size_t)li * 1024 * D : c.in[13] + (size_t)li * 1024 * D;
    bf16_t* WIN = (bf16_t*)(c.ws + OFF_WIN); bf16_t* WOUT = (bf16_t*)(c.ws + OFF_WOUT);
    const int I1 = (D / 64) * (nin / 32), I2 = (1024 / 64) * (D / 32);
    for (int it = gw; it < I1 + I2; it += ngw) {
        if (it < I1) { const int nb = it % (nin / 32), kb = it / (nin / 32); transpose_item(win, pin, 64 * kb, 32 * nb, WIN, D, 32 * nb, scr, c.lane); }
        else { const int r = it - I1; const int nb = r % (D / 32), kb = r / (D / 32); transpose_item(wout, D, 64 * kb, 32 * nb, WOUT, 1024, 32 * nb, scr, c.lane); }
    }
}
DEV void convert_ffn_weights(const Ctx& c, int layer, int gw, int ngw) {
    float* scr = (float*)(c.lds + c.wave * 8448);
    const float* wg = c.in[21] + (size_t)layer * D * FF; const float* wu = c.in[22] + (size_t)layer * D * FF; const float* wd = c.in[23] + (size_t)layer * FF * D;
    bf16_t* WGU = (bf16_t*)(c.ws + SF_WGU); bf16_t* WDN = (bf16_t*)(c.ws + SF_WDN);
    const int I1 = (D / 64) * (FF / 32), I3 = (FF / 64) * (D / 32);
    for (int it = gw; it < 2 * I1 + I3; it += ngw) {
        if (it < 2 * I1) { const int up = it >= I1; const int r = up ? it - I1 : it; const int nb = r % (FF / 32), kb = r / (FF / 32); const int f0 = 32 * nb;
            transpose_item(up ? wu : wg, FF, 64 * kb, f0, WGU, D, (f0 / 128) * 256 + (up ? 128 : 0) + (f0 % 128), scr, c.lane); }
        else { const int r = it - 2 * I1; const int nb = r % (D / 32), kb = r / (D / 32); transpose_item(wd, D, 64 * kb, 32 * nb, WDN, FF, 32 * nb, scr, c.lane); }
    }
}
DEV void normalize_rows(const Ctx& c, int layer, int which, int nrows, SplitPlan red, int pmrows, const float* pga) {
    constexpr int NV = D / 256;
    float* X = (float*)(c.ws + OFF_X); bf16_t* H = (bf16_t*)(c.ws + OFF_HY); float* G = (float*)(c.ws + OFF_G);
    const float* MODL = (const float*)(c.ws + OFF_MOD) + (size_t)layer * 9 * 6 * D;
    const float* g = (which ? c.in[7] : c.in[6]) + (size_t)layer * D;
    const int odd = layer & 1, li = layer >> 1;
    const float* wgate = odd ? c.in[14] + (size_t)li * D * O_IN + NO : c.in[8] + (size_t)li * D * E_IN + NE; const int pg = odd ? O_IN : E_IN;
    float* wgt = (float*)c.lds;
    unsigned char* tab = (unsigned char*)(c.lds + 16 * D * 4);
    const float* PART = (const float*)(c.ws + SF_PART);
    if (red.extra) { BLOCK_SYNC();
        for (int e = c.tid; e < (pmrows / 256) * (D / 256); e += NTHREADS) tab[e] = 255;
        BLOCK_SYNC();
        if (c.tid < red.extra) { pg8::StaticOrder S2; S2.init(pmrows, D, red.nwg, c.nblk + c.tid); pg8::Unit u; if (S2.next(0, u)) tab[u.pm * (D / 256) + u.pn] = (unsigned char)c.tid; }
        BLOCK_SYNC(); }
    if (which == 0) { BLOCK_SYNC();
        for (int e = c.tid; e < D * 4; e += NTHREADS) { const int k = e >> 2, q = e & 3; const f32x4 w4 = *(const f32x4*)(wgate + (size_t)k * pg + 4 * q);
#pragma unroll
            for (int j = 0; j < 4; ++j) wgt[(4 * q + j) * D + k] = w4[j]; }
        BLOCK_SYNC(); }
    for (int row = c.gw; row < nrows; row += c.ngw) {
        const int mr = row < ML ? row / SEQ : NB;
        const float* sh = MODL + (size_t)mr * 6 * D + (which ? 3 : 0) * D; const float* sc = sh + D;
        const float* xrow = (layer == 0 && which == 0) ? (row < ML ? c.in[0] + (size_t)row * D : c.in[2] + (size_t)(row - ML) * D) : X + (size_t)row * D;
        const f32x4* xr = (const f32x4*)xrow + c.lane;
        f32x4 v[NV]; float ss = 0.f;
#pragma unroll
        for (int j = 0; j < NV; ++j) { v[j] = xr[64 * j];
            if (red.extra && row < pmrows) { const int lu = tab[(row >> 8) * (D / 256) + j];
                if (lu != 255) { const float* pp = PART + (size_t)lu * red.split * 65536 + (size_t)(row & 255) * 256 + 4 * c.lane; f32x4 sum = *(const f32x4*)pp;
                    for (int q = 1; q < red.split; ++q) sum += *(const f32x4*)(pp + (size_t)q * 65536);
                    v[j] += *(const f32x4*)(pga + (size_t)mr * 6 * D + 256 * j + 4 * c.lane) * sum; ((f32x4*)(X + (size_t)row * D) + c.lane)[64 * j] = v[j]; } }
            ss += (v[j][0] * v[j][0] + v[j][1] * v[j][1]) + (v[j][2] * v[j][2] + v[j][3] * v[j][3]); }
        const float rstd = 1.0f / sqrtf(wave_sum(ss) * (1.0f / D) + EPS);
        u32x2* o8 = (u32x2*)(H + (size_t)row * D) + c.lane;
        float ga[16];
#pragma unroll
        for (int n = 0; n < 16; ++n) ga[n] = 0.f;
#pragma unroll
        for (int j = 0; j < NV; ++j) { const int k0 = 256 * j + 4 * c.lane;
            const f32x4 gg = *(const f32x4*)(g + k0), s1 = *(const f32x4*)(sc + k0), s0 = *(const f32x4*)(sh + k0);
            f32x4 h = v[j] * rstd * gg * (s1 + 1.0f) + s0;
            u32x2 w; w[0] = pk2(h[0], h[1]); w[1] = pk2(h[2], h[3]); o8[64 * j] = w;
            if (which == 0) {
#pragma unroll
                for (int n = 0; n < 16; ++n) { const f32x4 w4 = *(const f32x4*)(wgt + n * D + k0); ga[n] += (h[0] * w4[0] + h[1] * w4[1]) + (h[2] * w4[2] + h[3] * w4[3]); if ((n & 7) == 7) SCHED_FENCE(); } } }
        if (which == 0) {
            const bool b5 = c.lane & 32, b4 = c.lane & 16, b3 = c.lane & 8, b2 = c.lane & 4;
            float w8[8], w4[4], w2[2];
#pragma unroll
            for (int n = 0; n < 8; ++n) { const float snd = b5 ? ga[n] : ga[n + 8], kp = b5 ? ga[n + 8] : ga[n]; w8[n] = kp + SHFL_XOR(snd, 32); }
#pragma unroll
            for (int n = 0; n < 4; ++n) { const float snd = b4 ? w8[n] : w8[n + 4], kp = b4 ? w8[n + 4] : w8[n]; w4[n] = kp + SHFL_XOR(snd, 16); }
#pragma unroll
            for (int n = 0; n < 2; ++n) { const float snd = b3 ? w4[n] : w4[n + 2], kp = b3 ? w4[n + 2] : w4[n]; w2[n] = kp + SHFL_XOR(snd, 8); }
            float z = (b2 ? w2[1] : w2[0]) + SHFL_XOR(b2 ? w2[0] : w2[1], 4);
            z += SHFL_XOR(z, 2); z += SHFL_XOR(z, 1);
            if ((c.lane & 3) == 0) G[(size_t)row * 16 + (b5 ? 8 : 0) + (b4 ? 4 : 0) + (b3 ? 2 : 0) + (b2 ? 1 : 0)] = z; }
    }
}

DEV int tok_row(int b, int tc, int i) { return tc < NCC ? ML + b * CTX + 64 * tc + i : b * SEQ + 64 * (tc - NCC) + i; }
DEV int pos_row(int b, int pos) { return pos < CTX ? ML + b * CTX + pos : b * SEQ + (pos - CTX); }
DEV int chain_chunk(int dir, int tc) { return dir == 0 ? tc : (tc < NCC ? NCC - 1 - tc : NCC + (NLC - 1 - (tc - NCC))); }
DEV void unpack8(bf16x8 v, float (&f)[8]) {
#pragma unroll
    for (int e = 0; e < 8; ++e) f[e] = bf2f((unsigned short)v[e]);
}
DEV bf16x8 pack8(const float (&f)[8]) { u32x4 p; p[0] = pk2(f[0], f[1]); p[1] = pk2(f[2], f[3]); p[2] = pk2(f[4], f[5]); p[3] = pk2(f[6], f[7]); return __builtin_bit_cast(bf16x8, p); }
DEV float chain_cumsum(float x, int lane, int dir) {
#pragma unroll
    for (int off = 1; off < 64; off <<= 1) { const int src = dir == 0 ? lane - off : lane + off; const float y = SHFL(x, src & 63); if (src >= 0 && src < 64) x += y; }
    return x;
}

constexpr int AT_KB = 64 * 72 * 2;
template <int DV> struct AttnLds { static constexpr int VB = DV * 72 * 2, BUF = AT_KB + VB; };

template <int DV>
DEV void attn_stage_load(const Ctx& c, const bf16_t* Kp, const bf16_t* Vt, int vpitch, int tile, bf16x8& kreg, bf16x8 (&vreg)[DV / 64]) {
    kreg = ld16(Kp + (size_t)(tile * 64 + (c.tid >> 3)) * 64 + (c.tid & 7) * 8);
#pragma unroll
    for (int i = 0; i < DV / 64; ++i) { const int idx = c.tid + 512 * i; vreg[i] = ld16(Vt + (size_t)(idx >> 3) * vpitch + tile * 64 + (idx & 7) * 8); }
}
template <int DV>
DEV void attn_stage_store(const Ctx& c, int boff, const bf16x8& kreg, const bf16x8 (&vreg)[DV / 64]) {
    char* kb = c.lds + boff; char* vb = kb + AT_KB;
    *(bf16x8*)(kb + (c.tid >> 3) * 144 + (c.tid & 7) * 16) = kreg;
#pragma unroll
    for (int i = 0; i < DV / 64; ++i) { const int idx = c.tid + 512 * i; *(bf16x8*)(vb + (idx >> 3) * 144 + (idx & 7) * 16) = vreg[i]; }
}
DEV void attn_qk(const char* kb, int rk, int h, const bf16x8 (&qf)[4], f32x16& p0, f32x16& p1) {
#pragma unroll
    for (int i = 0; i < 16; ++i) { p0[i] = 0.f; p1[i] = 0.f; }
#pragma unroll
    for (int ks = 0; ks < 4; ++ks) { const bf16x8 a0 = ld16(kb + rk * 144 + ks * 32 + h * 16), a1 = ld16(kb + (32 + rk) * 144 + ks * 32 + h * 16);
        p0 = MFMA32(a0, qf[ks], p0); p1 = MFMA32(a1, qf[ks], p1); }
}
DEV void attn_sm1(f32x16& p0, f32x16& p1, float& m, float& alpha) {
    const float C2 = 0.125f * 1.4426950408889634f;
    float mx = p0[0];
#pragma unroll
    for (int i = 0; i < 16; ++i) { mx = fmaxf(mx, p0[i]); mx = fmaxf(mx, p1[i]); }
    mx = fmaxf(mx, SHFL_XOR(mx, 32));
    alpha = 1.0f;
    if (WAVE_ANY(mx * C2 > m + 8.0f)) { const float mn = fmaxf(m, mx * C2); alpha = EXP2F(m - mn); m = mn; }
#pragma unroll
    for (int i = 0; i < 16; ++i) { p0[i] = p0[i] * C2 - m; p1[i] = p1[i] * C2 - m; }
#pragma unroll
    for (int i = 0; i < 16; ++i) p0[i] = EXP2F(p0[i]);
}
DEV void attn_sm2(f32x16& p0, f32x16& p1, float alpha, float& l, bf16x8 (&pb)[4]) {
#pragma unroll
    for (int i = 0; i < 16; ++i) p1[i] = EXP2F(p1[i]);
    float rs = 0.f;
#pragma unroll
    for (int i = 0; i < 16; ++i) rs += p0[i] + p1[i];
    l = l * alpha + rs;
    pb[0] = pack_acc(p0, 0); pb[1] = pack_acc(p0, 1); pb[2] = pack_acc(p1, 0); pb[3] = pack_acc(p1, 1);
}
template <int DV>
DEV void attn_pv(const char* vb, int r, int h, const bf16x8 (&pb)[4], f32x16 (&o)[DV / 32]) {
#pragma unroll
    for (int us = 0; us < 4; ++us)
#pragma unroll
        for (int dt = 0; dt < DV / 32; ++dt) { const bf16x8 va = ld16(vb + (32 * dt + r) * 144 + (16 * us + 8 * h) * 2); o[dt] = MFMA32(va, pb[us], o[dt]); }
}
template <int DV>
DEV void attn_resc(f32x16 (&o)[DV / 32], float alpha) {
    if (WAVE_ANY(alpha < 1.0f)) {
#pragma unroll
        for (int dt = 0; dt < DV / 32; ++dt)
#pragma unroll
            for (int i = 0; i < 16; ++i) o[dt][i] *= alpha; }
}
template <int DV>
DEV void attn_step(const Ctx& c, const bf16_t* Kp, const bf16_t* Vt, int vpitch, int j, int nt, const bf16x8 (&qf)[4], bool active, int rk, int ox, int oy, int on,
                   bf16x8 (&pb)[4], f32x16 (&o)[DV / 32], float& m, float& l) {
    const int r = c.lane & 31, h = c.lane >> 5; const bool more = j + 1 < nt; const float C2 = 0.125f * 1.4426950408889634f;
    bf16x8 kreg, vreg[DV / 64]; f32x16 p0, p1;
    if (active) attn_qk(c.lds + ox, rk, h, qf, p0, p1);
    SCHED_FENCE();
    if (more) attn_stage_load<DV>(c, Kp, Vt, vpitch, j + 1, kreg, vreg);
    if (active) { const char* vb = c.lds + oy + AT_KB;
        float mx = 0.f, alpha = 1.0f;
#pragma unroll
        for (int us = 0; us < 4; ++us) {
            SCHED_FENCE();
#pragma unroll
            for (int dt = 0; dt < DV / 32; ++dt) { const bf16x8 va = ld16(vb + (32 * dt + r) * 144 + (16 * us + 8 * h) * 2); o[dt] = MFMA32(va, pb[us], o[dt]); }
            SCHED_FENCE();
            if (us == 0) { mx = p0[0];
#pragma unroll
                for (int i = 0; i < 16; ++i) { mx = fmaxf(mx, p0[i]); mx = fmaxf(mx, p1[i]); }
                mx = fmaxf(mx, SHFL_XOR(mx, 32));
                if (WAVE_ANY(mx * C2 > m + 8.0f)) { const float mn = fmaxf(m, mx * C2); alpha = EXP2F(m - mn); m = mn; } }
            else if (us == 1) {
#pragma unroll
                for (int i = 0; i < 16; ++i) { p0[i] = p0[i] * C2 - m; p1[i] = p1[i] * C2 - m; } }
            else if (us == 2) {
#pragma unroll
                for (int i = 0; i < 16; ++i) p0[i] = EXP2F(p0[i]); }
            else {
#pragma unroll
                for (int i = 0; i < 16; ++i) p1[i] = EXP2F(p1[i]); }
        }
        SCHED_FENCE();
        float rs = 0.f;
#pragma unroll
        for (int i = 0; i < 16; ++i) rs += p0[i] + p1[i];
        l = l * alpha + rs;
        pb[0] = pack_acc(p0, 0); pb[1] = pack_acc(p0, 1); pb[2] = pack_acc(p1, 0); pb[3] = pack_acc(p1, 1);
        attn_resc<DV>(o, alpha); }
    if (more) attn_stage_store<DV>(c, on, kreg, vreg);
    BLOCK_SYNC();
}
template <int DV>
DEV void attn_pass(const Ctx& c, const bf16_t* Kp, const bf16_t* Vt, int vpitch, int nk, const bf16x8 (&qf)[4], bool active, f32x16 (&o)[DV / 32], float& m, float& l) {
    const int r = c.lane & 31, h = c.lane >> 5; const int rk = (r & 0x13) | ((r & 4) << 1) | ((r & 8) >> 1);
    const int nt = nk / 64; constexpr int BUF = AttnLds<DV>::BUF;
#pragma unroll
    for (int dt = 0; dt < DV / 32; ++dt)
#pragma unroll
        for (int i = 0; i < 16; ++i) o[dt][i] = 0.f;
    m = -1e30f; l = 0.f;
    bf16x8 pb[4];
    { bf16x8 kreg, vreg[DV / 64];
      attn_stage_load<DV>(c, Kp, Vt, vpitch, 0, kreg, vreg); attn_stage_store<DV>(c, 0, kreg, vreg);
      attn_stage_load<DV>(c, Kp, Vt, vpitch, 1, kreg, vreg); attn_stage_store<DV>(c, BUF, kreg, vreg); }
    BLOCK_SYNC();
    if (active) { f32x16 p0, p1; float alpha; attn_qk(c.lds, rk, h, qf, p0, p1); attn_sm1(p0, p1, m, alpha); attn_sm2(p0, p1, alpha, l, pb); }
    else {
#pragma unroll
        for (int i = 0; i < 4; ++i) pb[i] = (bf16x8){0, 0, 0, 0, 0, 0, 0, 0}; }
    int ox = BUF, oy = 0, on = 2 * BUF;
    for (int j = 1; j < nt; ++j) {
        attn_step<DV>(c, Kp, Vt, vpitch, j, nt, qf, active, rk, ox, oy, on, pb, o, m, l); { const int t_ = oy; oy = ox; ox = on; on = t_; }
    }
    if (active) attn_pv<DV>(c.lds + oy + AT_KB, r, h, pb, o);
    BLOCK_SYNC();
}
DEV void load_q(const Ctx& c, const bf16_t* Qrow  , bool valid, bool rope, int t, const float* qg  , bf16x8 (&qf)[4]) {
    const int h = c.lane >> 5;
    float f[4][8];
#pragma unroll
    for (int ks = 0; ks < 4; ++ks) { bf16x8 v = (bf16x8){0, 0, 0, 0, 0, 0, 0, 0}; if (valid) v = ld16(Qrow + 16 * ks + 8 * h); unpack8(v, f[ks]); }
    if (qg) { float ss = 0.f;
#pragma unroll
        for (int ks = 0; ks < 4; ++ks)
#pragma unroll
            for (int e = 0; e < 8; ++e) ss += f[ks][e] * f[ks][e];
        ss += SHFL_XOR(ss, 32);
        const float rstd = 1.0f / sqrtf(ss * (1.0f / 64.0f) + EPS);
#pragma unroll
        for (int ks = 0; ks < 4; ++ks)
#pragma unroll
            for (int e = 0; e < 8; ++e) f[ks][e] = f[ks][e] * rstd * qg[16 * ks + 8 * h + e]; }
    if (rope) { const float* COS = (const float*)(c.ws + OFF_ROPE) + (size_t)t * 32; const float* SIN = COS + (size_t)SEQ * 32;
#pragma unroll
        for (int a = 0; a < 2; ++a)
#pragma unroll
            for (int e = 0; e < 8; ++e) { const float cs = COS[a * 16 + 8 * h + e], sn = SIN[a * 16 + 8 * h + e]; const float x1 = f[2 * a][e], x2 = f[2 * a + 1][e];
                f[2 * a][e] = x1 * cs - x2 * sn; f[2 * a + 1][e] = x2 * cs + x1 * sn; } }
#pragma unroll
    for (int ks = 0; ks < 4; ++ks) qf[ks] = pack8(f[ks]);
}

DEV void even_kprep(const Ctx& c) {
    const bf16_t* KA = (const bf16_t*)(c.ws + OFF_P) + PE_KA; bf16_t* KP = (bf16_t*)(c.ws + SE_KP);
    const float* COS = (const float*)(c.ws + OFF_ROPE); const float* SIN = COS + (size_t)SEQ * 32;
    const int l7 = c.lane & 7, a = l7 >> 2, p = (l7 >> 1) & 1, f0 = 8 * (l7 & 1), vh = c.lane >> 3;
    for (int it = c.gw; it < NB * LK; it += c.ngw) { const int b = it / LK, pos = it % LK; const int row = pos_row(b, pos);
        float f[8]; unpack8(ld16(KA + (size_t)row * 512 + 8 * c.lane), f);
        float g[8];
#pragma unroll
        for (int e = 0; e < 8; ++e) g[e] = SHFL_XOR(f[e], 2);
        if (pos >= CTX) { const int t = pos - CTX;
#pragma unroll
            for (int e = 0; e < 8; ++e) { const float cs = COS[(size_t)t * 32 + a * 16 + f0 + e], sn = SIN[(size_t)t * 32 + a * 16 + f0 + e]; f[e] = p == 0 ? f[e] * cs - g[e] * sn : f[e] * cs + g[e] * sn; } }
        *(bf16x8*)(KP + ((size_t)(b * 8 + vh) * LK + pos) * 64 + 8 * l7) = pack8(f); }
}
template <int DV>
DEV void vt_item(const Ctx& c, const bf16_t* src, int spitch, int colbase, int b, int pc, bf16_t* dstbh  ) {
    bf16_t* T = (bf16_t*)c.lds;
#pragma unroll
    for (int i = 0; i < DV / 64; ++i) { const int idx = c.tid + 512 * i, pl = idx / (DV / 8), cg = idx % (DV / 8); const int row = pos_row(b, 64 * pc + pl);
        const bf16x8 v = ld16(src + (size_t)row * spitch + colbase + 8 * cg);
#pragma unroll
        for (int e = 0; e < 8; ++e) T[(8 * cg + e) * 72 + (((pl >> 3) ^ (cg & 7)) << 3) + (pl & 7)] = (bf16_t)v[e]; }
    BLOCK_SYNC();
#pragma unroll
    for (int i = 0; i < DV / 64; ++i) { const int idx = c.tid + 512 * i, dv = idx >> 3, ch = idx & 7;
        *(bf16x8*)(dstbh + (size_t)dv * LK + 64 * pc + 8 * ch) = *(const bf16x8*)(T + dv * 72 + 8 * (ch ^ ((dv >> 3) & 7))); }
    BLOCK_SYNC();
}

DEV void mlstm_gates(const Ctx& c, int layer, int b, int h, int dir, int tc, float& ipre, float& lf) {
    const float* G = (const float*)(c.ws + OFF_G); const float* bias = c.in[9] + (size_t)(layer >> 1) * 16;
    const int row = tok_row(b, tc, c.lane);
    ipre = G[(size_t)row * 16 + dir * 8 + h] + bias[dir * 8 + h];
    lf = logsigmoidf_(G[(size_t)row * 16 + dir * 8 + 4 + h] + bias[dir * 8 + 4 + h]);
}
DEV void mlstm_m1_item(const Ctx& c, int layer, int it) {
    const int tc = it % NCH, dir = (it / NCH) & 1, h = (it / (2 * NCH)) & 3, b = it / (8 * NCH);
    const int chain = (b * 4 + h) * 2 + dir, cc = chain_chunk(dir, tc); const size_t ci = (size_t)chain * NCH + cc;
    const bf16_t* BK = (const bf16_t*)(c.ws + OFF_P) + PE_BK; const bf16_t* BV = (const bf16_t*)(c.ws + OFF_P) + PE_BV;
    float* DCT = (float*)(c.ws + SE_DCT); float* DN = (float*)(c.ws + SE_DN); float* SC = (float*)(c.ws + SE_SC);
    bf16_t* Kt = (bf16_t*)c.lds; bf16_t* Vt = Kt + 64 * 72; float* wv = (float*)(c.lds + (64 + 128) * 72 * 2);
    if (c.wave == 0) { float ipre, lf; mlstm_gates(c, layer, b, h, dir, tc, ipre, lf);
        const float bcum = chain_cumsum(lf, c.lane, dir), bend = wave_sum(lf), wend = bend - bcum + ipre, mloc = wave_max(wend);
        wv[c.lane] = expf(wend - mloc);
        if (c.lane == 0) { SC[ci * 4 + 0] = bend; SC[ci * 4 + 1] = mloc; } }
    BLOCK_SYNC();
    {   const int i = c.tid >> 3, cg = c.tid & 7; const int row = tok_row(b, tc, i); const float w = wv[i] * 0.125f;
        float f[8]; unpack8(ld16(BK + (size_t)row * 256 + h * 64 + 8 * cg), f);
#pragma unroll
        for (int e = 0; e < 8; ++e) Kt[(8 * cg + e) * 72 + (((i >> 3) ^ (cg & 7)) << 3) + (i & 7)] = (bf16_t)f2bf(f[e] * w); }
#pragma unroll
    for (int ii = 0; ii < 2; ++ii) { const int idx = c.tid + 512 * ii, i = idx >> 4, cg = idx & 15; const int row = tok_row(b, tc, i);
        const bf16x8 v = ld16(BV + (size_t)row * 512 + h * 128 + 8 * cg);
#pragma unroll
        for (int e = 0; e < 8; ++e) Vt[(8 * cg + e) * 72 + (((i >> 3) ^ (cg & 7)) << 3) + (i & 7)] = (bf16_t)v[e]; }
    BLOCK_SYNC();
    {   const int r = c.lane & 31, hh = c.lane >> 5, dvt = c.wave >> 1, dkt = c.wave & 1;
        f32x16 acc;
#pragma unroll
        for (int i = 0; i < 16; ++i) acc[i] = 0.f;
#pragma unroll
        for (int ks = 0; ks < 4; ++ks) acc = MFMA32(ld16(Vt + (32 * dvt + r) * 72 + 8 * ((2 * ks + hh) ^ ((r >> 3) & 3) ^ ((dvt & 1) << 2))), ld16(Kt + (32 * dkt + r) * 72 + 8 * ((2 * ks + hh) ^ ((r >> 3) & 3) ^ ((dkt & 1) << 2))), acc);
        float* dst = DCT + ci * 8192;
#pragma unroll
        for (int i = 0; i < 16; ++i) dst[(32 * dvt + crow(i, hh)) * 64 + 32 * dkt + r] = acc[i];
        if (c.tid < 64) { float s = 0.f; for (int i = 0; i < 64; ++i) s += bf2f(Kt[c.tid * 72 + i]); DN[ci * 64 + c.tid] = s; } }
    BLOCK_SYNC();
}
DEV void mlstm_m2(const Ctx& c) {
    float* DCT = (float*)(c.ws + SE_DCT); float* DN = (float*)(c.ws + SE_DN); float* SC = (float*)(c.ws + SE_SC);
    const long gt = (long)c.bid * NTHREADS + c.tid, GT = (long)c.nblk * NTHREADS;
    for (long it = gt; it < (long)NCHAIN * 8256; it += GT) { const int chain = (int)(it / 8256), e = (int)(it % 8256);
        float* p0 = e < 8192 ? DCT + (size_t)chain * NCH * 8192 + e : DN + (size_t)chain * NCH * 64 + (e - 8192); const size_t pstr = e < 8192 ? 8192 : 64;
        float d[NCH];
#pragma unroll
        for (int cc = 0; cc < NCH; ++cc) d[cc] = p0[cc * pstr];
        float mst = 0.f, val = 0.f;
#pragma unroll
        for (int cc = 0; cc < NCH; ++cc) { const size_t ci = (size_t)chain * NCH + cc; const float bend = SC[ci * 4 + 0], mloc = SC[ci * 4 + 1];
            if (e == 0) SC[ci * 4 + 2] = mst;
            const float mnew = fmaxf(bend + mst, mloc); const float nv = expf(bend + mst - mnew) * val + expf(mloc - mnew) * d[cc]; d[cc] = val; val = nv; mst = mnew; }
#pragma unroll
        for (int cc = 0; cc < NCH; ++cc) p0[cc * pstr] = d[cc]; }
}
DEV void mlstm_m3_item(const Ctx& c, int layer, int it) {
    const int tc = it % NCH, h = (it / NCH) & 3, b = it / (4 * NCH);
    const bf16_t* BQ = (const bf16_t*)(c.ws + OFF_P) + PE_BQ; const bf16_t* BK = (const bf16_t*)(c.ws + OFF_P) + PE_BK; const bf16_t* BV = (const bf16_t*)(c.ws + OFF_P) + PE_BV; const bf16_t* BO = (const bf16_t*)(c.ws + OFF_P) + PE_BO;
    const float* DCT = (const float*)(c.ws + SE_DCT); const float* DN = (const float*)(c.ws + SE_DN); const float* SC = (const float*)(c.ws + SE_SC);
    bf16_t* Y = (bf16_t*)(c.ws + OFF_HY); const float* gn = c.in[12] + (size_t)(layer >> 1) * 128;
    bf16_t* Qs = (bf16_t*)c.lds; bf16_t* Ks = Qs + 64 * 72; bf16_t* Vt = Ks + 64 * 72; float* fl = (float*)(c.lds + (128 + 128) * 72 * 2);
    float* bcs2 = fl, *ics2 = fl + 128, *nst2 = fl + 256, *ssq = fl + 384;
    const int r = c.lane & 31, hh = c.lane >> 5, dvt = c.wave >> 1, tt = c.wave & 1, t = 32 * tt + r;
    f32x16 hs;
#pragma unroll
    for (int i = 0; i < 16; ++i) hs[i] = 0.f;
    {   const int i = c.tid >> 3, cg = c.tid & 7; const int row = tok_row(b, tc, i);
        *(bf16x8*)(Qs + i * 72 + 8 * cg) = ld16(BQ + (size_t)row * 256 + h * 64 + 8 * cg);
        float f[8]; unpack8(ld16(BK + (size_t)row * 256 + h * 64 + 8 * cg), f);
#pragma unroll
        for (int e = 0; e < 8; ++e) f[e] *= 0.125f;
        *(bf16x8*)(Ks + i * 72 + 8 * cg) = pack8(f); }
#pragma unroll
    for (int ii = 0; ii < 2; ++ii) { const int idx = c.tid + 512 * ii, i = idx >> 4, cg = idx & 15; const int row = tok_row(b, tc, i);
        const bf16x8 v = ld16(BV + (size_t)row * 512 + h * 128 + 8 * cg);
#pragma unroll
        for (int e = 0; e < 8; ++e) Vt[(8 * cg + e) * 72 + (((i >> 3) ^ (cg & 7)) << 3) + (i & 7)] = (bf16_t)v[e]; }
    if (c.wave < 2) { const int dir = c.wave; float ipre, lf; mlstm_gates(c, layer, b, h, dir, tc, ipre, lf); bcs2[dir * 64 + c.lane] = chain_cumsum(lf, c.lane, dir); ics2[dir * 64 + c.lane] = ipre; }
    else if (c.wave < 4) { const int dir = c.wave - 2; const size_t ci = (size_t)((b * 4 + h) * 2 + dir) * NCH + chain_chunk(dir, tc); nst2[dir * 64 + c.lane] = DN[ci * 64 + c.lane]; }
    BLOCK_SYNC();
    f32x16 sraw[2];
    for (int dir = 0; dir < 2; ++dir) {
        const int chain = (b * 4 + h) * 2 + dir, cc = chain_chunk(dir, tc); const size_t ci = (size_t)chain * NCH + cc;
        const float* bcs = bcs2 + dir * 64; const float* ics = ics2 + dir * 64; const float* nst = nst2 + dir * 64;
        const float mst = SC[ci * 4 + 2];
        f32x16 st[2];
        if (dir == 0) {
#pragma unroll
            for (int su = 0; su < 2; ++su) {
#pragma unroll
                for (int i = 0; i < 16; ++i) sraw[su][i] = 0.f;
#pragma unroll
                for (int ks = 0; ks < 4; ++ks) sraw[su] = MFMA32(ld16(Ks + (32 * su + r) * 72 + 16 * ks + 8 * hh), ld16(Qs + t * 72 + 16 * ks + 8 * hh), sraw[su]); } }
        const float bt = bcs[t], at = bt + mst;
        float mt = at;
#pragma unroll
        for (int su = 0; su < 2; ++su)
#pragma unroll
            for (int i = 0; i < 16; ++i) { const int s = 32 * su + crow(i, hh); const bool valid = dir == 0 ? s <= t : s >= t; if (valid) mt = fmaxf(mt, bt - bcs[s] + ics[s]); }
        mt = fmaxf(mt, SHFL_XOR(mt, 32));
        const float inter = expf(at - mt);
        float rsum = 0.f;
#pragma unroll
        for (int su = 0; su < 2; ++su)
#pragma unroll
            for (int i = 0; i < 16; ++i) { const int s = 32 * su + crow(i, hh); const bool valid = dir == 0 ? s <= t : s >= t;
                const float p = valid ? expf(bt - bcs[s] + ics[s] - mt) * sraw[su][i] : 0.f; st[su][i] = p; rsum += p; }
        rsum += SHFL_XOR(rsum, 32);
        float qn = 0.f;
        for (int d = 0; d < 32; ++d) qn += bf2f(Qs[t * 72 + 32 * hh + d]) * nst[32 * hh + d];
        qn += SHFL_XOR(qn, 32);
        const float den = inter * qn + rsum, dd = fmaxf(fabsf(den), expf(-mt));
        f32x16 a1;
#pragma unroll
        for (int i = 0; i < 16; ++i) a1[i] = 0.f;
        const float* Cst = DCT + ci * 8192 + (size_t)(32 * dvt + r) * 64;
#pragma unroll
        for (int ks = 0; ks < 4; ++ks) { float f[8]; const f32x4 c0 = *(const f32x4*)(Cst + 16 * ks + 8 * hh), c1 = *(const f32x4*)(Cst + 16 * ks + 8 * hh + 4);
            f[0] = c0[0]; f[1] = c0[1]; f[2] = c0[2]; f[3] = c0[3]; f[4] = c1[0]; f[5] = c1[1]; f[6] = c1[2]; f[7] = c1[3];
            a1 = MFMA32(pack8(f), ld16(Qs + t * 72 + 16 * ks + 8 * hh), a1); }
        f32x16 a2;
#pragma unroll
        for (int i = 0; i < 16; ++i) a2[i] = 0.f;
#pragma unroll
        for (int su = 0; su < 2; ++su)
#pragma unroll
            for (int s2 = 0; s2 < 2; ++s2) { const bf16_t* vr = Vt + (32 * dvt + r) * 72 + 4 * hh; const int sw = ((32 * dvt + r) >> 3) & 7, bk = 4 * su + 2 * s2;
                a2 = MFMA32(cat44(*(const bf16x4*)(vr + 8 * (bk ^ sw)), *(const bf16x4*)(vr + 8 * ((bk + 1) ^ sw))), pack_acc(st[su], s2), a2); }
        const float inv = 1.0f / dd;
#pragma unroll
        for (int i = 0; i < 16; ++i) hs[i] += (inter * a1[i] + a2[i]) * inv;
    }
    float ss = 0.f;
#pragma unroll
    for (int i = 0; i < 16; ++i) ss += hs[i] * hs[i];
    ss += SHFL_XOR(ss, 32);
    if (hh == 0) ssq[dvt * 64 + t] = ss;
    BLOCK_SYNC();
    const float rstd = 1.0f / sqrtf((ssq[t] + ssq[64 + t] + ssq[128 + t] + ssq[192 + t]) * (1.0f / 128.0f) + EPS);
    const int row = tok_row(b, tc, t);
#pragma unroll
    for (int q4 = 0; q4 < 4; ++q4) { const int dv = 32 * dvt + 8 * q4 + 4 * hh;
        const bf16x4 ov = *(const bf16x4*)(BO + (size_t)row * 512 + h * 128 + dv); float y[4];
#pragma unroll
        for (int e = 0; e < 4; ++e) y[e] = hs[4 * q4 + e] * rstd * gn[dv + e] * sigmoidf_(bf2f((unsigned short)ov[e]));
        u32x2 w; w[0] = pk2(y[0], y[1]); w[1] = pk2(y[2], y[3]);
        *(u32x2*)(Y + (size_t)row * 1024 + 512 + h * 128 + dv) = w; }
    BLOCK_SYNC();
}

DEV void diffattn_unit(const Ctx& c, int layer, int b, int h, bool ctxu, int qb) {
    const bf16_t* QA = (const bf16_t*)(c.ws + OFF_P) + PE_QA; const bf16_t* KP = (const bf16_t*)(c.ws + SE_KP); const bf16_t* VT = (const bf16_t*)(c.ws + SE_VT);
    bf16_t* Y = (bf16_t*)(c.ws + OFF_HY); const int e = layer >> 1;
    const float* lam = c.in[10] + (size_t)e * 256; const float* gn = c.in[11] + (size_t)e * 128;
    const int r = c.lane & 31, hh = c.lane >> 5; const int ql = qb * 256 + c.wave * 32 + r;
    const int nq = ctxu ? CTX : SEQ, nk = ctxu ? CTX : LK; const bool valid = ql < nq, active = (qb * 256 + c.wave * 32) < nq;
    const int row = ctxu ? ML + b * CTX + ql : b * SEQ + ql;
    const int orow = ctxu ? row : b * SEQ + (ql % 128) * (SEQ / 128) + ql / 128;
    f32x16 o[4]; float m, l1, l2; bf16x8 qf[4];
    float* park = (float*)(c.ws + SE_PARK) + ((size_t)c.bid * NTHREADS + c.tid) * 64;
    load_q(c, QA + (size_t)row * 512 + h * 128, valid, !ctxu, ql, nullptr, qf);
    attn_pass<128>(c, KP + (size_t)(b * 8 + 2 * h) * LK * 64, VT + (size_t)(b * 4 + h) * 128 * LK, LK, nk, qf, active, o, m, l1);
    if (active) { l1 += SHFL_XOR(l1, 32); const float i1 = 1.0f / l1;
#pragma unroll
        for (int dt = 0; dt < 4; ++dt)
#pragma unroll
            for (int q4 = 0; q4 < 4; ++q4) *(f32x4*)(park + 16 * dt + 4 * q4) = (f32x4){o[dt][4 * q4] * i1, o[dt][4 * q4 + 1] * i1, o[dt][4 * q4 + 2] * i1, o[dt][4 * q4 + 3] * i1}; }
    load_q(c, QA + (size_t)row * 512 + h * 128 + 64, valid, !ctxu, ql, nullptr, qf);
    attn_pass<128>(c, KP + (size_t)(b * 8 + 2 * h + 1) * LK * 64, VT + (size_t)(b * 4 + h) * 128 * LK, LK, nk, qf, active, o, m, l2);
    const float lam_init = 0.8f - 0.6f * expf(-0.3f * (float)layer);
    const float lmb = expf(wave_sum(lam[c.lane] * lam[64 + c.lane])) - expf(wave_sum(lam[128 + c.lane] * lam[192 + c.lane])) + lam_init;
    if (active) {
        l2 += SHFL_XOR(l2, 32);
        const float i2 = lmb / l2; float ss = 0.f;
#pragma unroll
        for (int dt = 0; dt < 4; ++dt)
#pragma unroll
            for (int q4 = 0; q4 < 4; ++q4) { const f32x4 a = *(const f32x4*)(park + 16 * dt + 4 * q4);
#pragma unroll
                for (int e = 0; e < 4; ++e) { const float v = a[e] - o[dt][4 * q4 + e] * i2; o[dt][4 * q4 + e] = v; ss += v * v; } }
        ss += SHFL_XOR(ss, 32);
        const float sc = (1.0f / sqrtf(ss * (1.0f / 128.0f) + EPS)) * (1.0f - lam_init);
        if (valid) {
#pragma unroll
            for (int dt = 0; dt < 4; ++dt)
#pragma unroll
                for (int q4 = 0; q4 < 4; ++q4) { const int dv = 32 * dt + 8 * q4 + 4 * hh; u32x2 w;
                    w[0] = pk2(o[dt][4 * q4 + 0] * sc * gn[dv + 0], o[dt][4 * q4 + 1] * sc * gn[dv + 1]); w[1] = pk2(o[dt][4 * q4 + 2] * sc * gn[dv + 2], o[dt][4 * q4 + 3] * sc * gn[dv + 3]);
                    *(u32x2*)(Y + (size_t)orow * 1024 + h * 128 + dv) = w; } }
    }
}

DEV void mix_even_a(const Ctx& c, int layer) {
    { PHASE_CTX(pc); if (ON(8)) even_kprep(pc); }
    { PHASE_CTX(pc); if (ON(9)) { const bf16_t* VA = (const bf16_t*)(pc.ws + OFF_P) + PE_VA; bf16_t* VT = (bf16_t*)(pc.ws + SE_VT);
        for (int it = pc.bid; it < NB * 4 * NCH; it += pc.nblk) { const int pch = it % NCH, bh = it / NCH; vt_item<128>(pc, VA, 512, (bh & 3) * 128, bh >> 2, pch, VT + (size_t)bh * 128 * LK); } } }
    REPB(10) { PHASE_CTX(pc); if (ON(10)) for (int it = pc.bid; it < NCHAIN * NCH; it += pc.nblk) mlstm_m1_item(pc, layer, it); }
}
DEV void mix_even_b(const Ctx& c, int layer) {
    { PHASE_CTX(pc); if (ON(11)) mlstm_m2(pc); }
}
DEV void mix_even_c(const Ctx& c, int layer) {
    constexpr int NQBL = SEQ / 256, NQBC = (CTX + 255) / 256, NUL = NB * 4 * NQBL, NUC = NB * 4 * NQBC;
    REPB(12) { PHASE_CTX(pc); if (ON(12)) for (int it = pc.bid; it < NUL + NUC; it += pc.nblk) { const bool cu = it >= NUL; int u = cu ? it - NUL : it; const int nqb = cu ? NQBC : NQBL;
        diffattn_unit(pc, layer, u / (4 * nqb), (u / nqb) & 3, cu, u % nqb); } }
    REPB(13) { PHASE_CTX(pc); if (ON(13)) for (int it = pc.nblk - 1 - pc.bid; it < NB * 4 * NCH; it += pc.nblk) mlstm_m3_item(pc, layer, it); }
}
constexpr size_t SO_KP = OFF_S;
constexpr size_t SO_VT = SO_KP + al256((size_t)NB * 2 * LK * 64 * 2);
constexpr size_t SO_U  = SO_VT + al256((size_t)NB * 2 * 64 * LK * 2);
constexpr size_t SO_W  = OFF_HY;
static_assert((size_t)NCHAIN * NCH * 8192 <= (size_t)MT * cmax(D, 1024), "W fits in the H/Y region");
constexpr size_t SO_AT = SO_U + al256((size_t)NCHAIN * NCH * 8192 * 2);
constexpr size_t SO_QN = SO_AT + al256((size_t)NCHAIN * NCH * 4096 * 2);
constexpr size_t SO_KD = SO_QN + al256((size_t)NCHAIN * NCH * 8192 * 2);
constexpr size_t SO_GE = SO_KD + al256((size_t)NCHAIN * NCH * 8192 * 2);
constexpr size_t SO_END = SO_GE + al256((size_t)NCHAIN * NCH * 4);
constexpr size_t PO_HB = PO_DQKV;
constexpr size_t PO_GO = PO_DQKV + (size_t)MT * 1024;
static_assert((size_t)3 * MT * 512 <= (size_t)MT * 1536, "HB and GO fit in the DQKV segment");

DEV void odd_kprep(const Ctx& c, int layer) {
    const bf16_t* KVC = (const bf16_t*)(c.ws + OFF_P) + PO_KVC; bf16_t* KP = (bf16_t*)(c.ws + SO_KP);
    const float* COS = (const float*)(c.ws + OFF_ROPE); const float* SIN = COS + (size_t)SEQ * 32; const float* kg = c.in[15] + (size_t)(layer >> 1) * 128 + 64;
    const int kv = c.lane >> 5, d0 = 2 * (c.lane & 31);
    const int a = d0 >> 5, p = (d0 >> 4) & 1, f0 = d0 & 15;
    for (int it = c.gw; it < NB * LK; it += c.ngw) { const int b = it / LK, pos = it % LK; const int row = pos_row(b, pos);
        const unsigned w = *(const unsigned*)(KVC + (size_t)row * 256 + 2 * c.lane);
        float x0 = bf2f(w & 0xffffu), x1 = bf2f(w >> 16);
        float ss = x0 * x0 + x1 * x1;
#pragma unroll
        for (int o = 1; o < 32; o <<= 1) ss += SHFL_XOR(ss, o);
        const float rstd = 1.0f / sqrtf(ss * (1.0f / 64.0f) + EPS);
        x0 *= rstd * kg[d0]; x1 *= rstd * kg[d0 + 1];
        const float y0 = SHFL_XOR(x0, 8), y1 = SHFL_XOR(x1, 8);
        if (pos >= CTX) { const int t = pos - CTX; const float c0 = COS[(size_t)t * 32 + a * 16 + f0], s0 = SIN[(size_t)t * 32 + a * 16 + f0], c1 = COS[(size_t)t * 32 + a * 16 + f0 + 1], s1 = SIN[(size_t)t * 32 + a * 16 + f0 + 1];
            x0 = p == 0 ? x0 * c0 - y0 * s0 : x0 * c0 + y0 * s0; x1 = p == 0 ? x1 * c1 - y1 * s1 : x1 * c1 + y1 * s1; }
        *(unsigned*)(KP + ((size_t)(b * 2 + kv) * LK + pos) * 64 + d0) = pk2(x0, x1); }
}
DEV void gqa_unit(const Ctx& c, int layer, int b, int h, bool ctxu, int qb) {
    const bf16_t* QC = (const bf16_t*)(c.ws + OFF_P) + PO_QC; const bf16_t* KP = (const bf16_t*)(c.ws + SO_KP); const bf16_t* VT = (const bf16_t*)(c.ws + SO_VT);
    bf16_t* QO = (bf16_t*)(c.ws + OFF_P) + PO_GO; const float* qg = c.in[15] + (size_t)(layer >> 1) * 128;
    const int r = c.lane & 31, hh = c.lane >> 5, kv = h >> 2; const int ql = qb * 256 + c.wave * 32 + r;
    const int nq = ctxu ? CTX : SEQ, nk = ctxu ? CTX : LK; const bool valid = ql < nq, active = (qb * 256 + c.wave * 32) < nq;
    const int row = ctxu ? ML + b * CTX + ql : b * SEQ + ql;
    const int orow = ctxu ? row : b * SEQ + (ql % 128) * (SEQ / 128) + ql / 128;
    f32x16 o[2]; float m, l; bf16x8 qf[4];
    load_q(c, QC + (size_t)row * 512 + h * 64, valid, !ctxu, ql, qg, qf);
    attn_pass<64>(c, KP + (size_t)(b * 2 + kv) * LK * 64, VT + (size_t)(b * 2 + kv) * 64 * LK, LK, nk, qf, active, o, m, l);
    if (active) { l += SHFL_XOR(l, 32); const float il = 1.0f / l;
        if (valid) {
#pragma unroll
            for (int dt = 0; dt < 2; ++dt)
#pragma unroll
                for (int q4 = 0; q4 < 4; ++q4) { const int dv = 32 * dt + 8 * q4 + 4 * hh; u32x2 w;
                    w[0] = pk2(o[dt][4 * q4 + 0] * il, o[dt][4 * q4 + 1] * il); w[1] = pk2(o[dt][4 * q4 + 2] * il, o[dt][4 * q4 + 3] * il);
                    *(u32x2*)(QO + (size_t)orow * 512 + h * 64 + dv) = w; } } }
}

constexpr int D1_CW_OFF = 110592;
#ifndef D1_STOP
#define D1_STOP 0
#endif
DEV void dn_d1_item(const Ctx& c, int layer, int it, int stop = 0) {
    const int tc = it % NCH, dir = (it / NCH) & 1, h = (it / (2 * NCH)) & 3, b = it / (8 * NCH);
    const int chain = (b * 4 + h) * 2 + dir, cc = chain_chunk(dir, tc); const size_t ci = (size_t)chain * NCH + cc; const int o = layer >> 1;
    const bf16_t* DQ = (const bf16_t*)(c.ws + OFF_P) + PO_DQKV; const float* G = (const float*)(c.ws + OFF_G);
    const float* cwl = (const float*)(c.lds + D1_CW_OFF); const float* alog = c.in[17] + (size_t)o * 8; const float* dtb = c.in[18] + (size_t)o * 8;
    bf16_t* Ub = (bf16_t*)(c.ws + SO_U) + ci * 8192; bf16_t* Wb = (bf16_t*)(c.ws + SO_W) + ci * 8192; bf16_t* ATb = (bf16_t*)(c.ws + SO_AT) + ci * 4096;
    bf16_t* QNb = (bf16_t*)(c.ws + SO_QN) + ci * 8192; bf16_t* KDb = (bf16_t*)(c.ws + SO_KD) + ci * 8192; float* GE = (float*)(c.ws + SO_GE);
    bf16_t* Qs = (bf16_t*)c.lds; bf16_t* Ks = Qs + 64 * 136; bf16_t* Kt = Ks + 64 * 136; bf16_t* Vt = Kt + 128 * 72; float* Am = (float*)(c.lds + (2 * 64 * 136 + 2 * 128 * 72) * 2); float* gc = Am + 64 * 65; float* be = gc + 64;
    float* gam = be + 64; float* T2 = gam + 64; float* Rb = T2 + 64 * 65;
    const int seqlen = tc < NCC ? CTX : SEQ, tok0 = tc < NCC ? 64 * tc : 64 * (tc - NCC), rowbase = tc < NCC ? ML + b * CTX : b * SEQ;
    if (c.wave == 0) { const int j = c.lane, i = dir ? 63 - j : j; const int row = rowbase + tok0 + i;
        const float beta = sigmoidf_(G[(size_t)row * 16 + dir * 8 + h]);
        const float ld = -expf(alog[dir * 4 + h]) * softplusf_(G[(size_t)row * 16 + dir * 8 + 4 + h] + dtb[dir * 4 + h]);
        const float gcum = chain_cumsum(ld, j, 0); gc[j] = gcum; be[j] = beta; gam[j] = expf(gcum);
        if (j == 63) GE[ci] = expf(gcum); }
    {   const int j = c.tid >> 3, cg = c.tid & 7, i = dir ? 63 - j : j, tok = tok0 + i;
        bf16x8 raw[3][2], rawn[3][2];
#define D1_LOADROWS(R, TEN) { _Pragma("unroll") for (int tap = 0; tap < 3; ++tap) { const int tk = tok + tap - 1; const bool in = tk >= 0 && tk < seqlen; \
            const bf16_t* src = DQ + (size_t)(rowbase + (in ? tk : tok)) * 1536 + (TEN) * 512 + h * 128 + 16 * cg; R[tap][0] = ld16(src); R[tap][1] = ld16(src + 8); \
            if (!in) { R[tap][0] = (bf16x8){0, 0, 0, 0, 0, 0, 0, 0}; R[tap][1] = (bf16x8){0, 0, 0, 0, 0, 0, 0, 0}; } } }
        D1_LOADROWS(rawn, 0);
#pragma unroll 1
        for (int ten = 0; ten < 3; ++ten) { const int col = ten * 512 + h * 128 + 16 * cg;
            float val[16];
#pragma unroll
            for (int e = 0; e < 16; ++e) val[e] = 0.f;
#pragma unroll
            for (int tap = 0; tap < 3; ++tap) { raw[tap][0] = rawn[tap][0]; raw[tap][1] = rawn[tap][1]; }
            if (ten < 2) D1_LOADROWS(rawn, ten + 1);
            SCHED_FENCE();
#pragma unroll
            for (int tap = 0; tap < 3; ++tap) { float f0[8], f1[8]; unpack8(raw[tap][0], f0); unpack8(raw[tap][1], f1);
                const float* wp = cwl + tap * 1536 + col;
#pragma unroll
                for (int e = 0; e < 8; ++e) { val[e] += f0[e] * wp[e]; val[8 + e] += f1[e] * wp[8 + e]; }
                SCHED_FENCE(); }
#pragma unroll
            for (int e = 0; e < 16; ++e) val[e] = siluf_(val[e]);
            if (ten < 2) { float ss = 0.f;
#pragma unroll
                for (int e = 0; e < 16; ++e) ss += val[e] * val[e];
                ss += SHFL_XOR(ss, 1); ss += SHFL_XOR(ss, 2); ss += SHFL_XOR(ss, 4);
                const float sc = (1.0f / sqrtf(ss + EPS)) * (ten == 0 ? 0.08838834764831845f : 1.0f);
#pragma unroll
                for (int e = 0; e < 16; ++e) val[e] *= sc; }
            if (ten < 2) { bf16_t* dst = (ten == 0 ? Qs : Ks) + j * 136 + 16 * cg; float fa[8], fb[8];
#pragma unroll
                for (int e = 0; e < 8; ++e) { fa[e] = val[e]; fb[e] = val[8 + e]; }
                *(bf16x8*)dst = pack8(fa); *(bf16x8*)(dst + 8) = pack8(fb); }
            if (ten >= 1) { bf16_t* dstT = (ten == 1 ? Kt : Vt);
#pragma unroll
                for (int e = 0; e < 16; ++e) dstT[(16 * cg + e) * 72 + (((j >> 3) ^ cg) << 3) + (j & 7)] = (bf16_t)f2bf(val[e]); } } }
    BLOCK_SYNC(); if (stop == 1) return;
    const int r = c.lane & 31, hh = c.lane >> 5;
    {
        const int wq = c.wave & 3, tt = wq >> 1, st = wq & 1; const bool isq = c.wave >= 4;
        f32x16 acc;
#pragma unroll
        for (int i = 0; i < 16; ++i) acc[i] = 0.f;
        const bf16_t* Ar = (isq ? Qs : Ks) + (32 * tt + r) * 136; const bf16_t* Br = Ks + (32 * st + r) * 136;
#pragma unroll
        for (int ks = 0; ks < 8; ++ks) acc = MFMA32(ld16(Ar + 16 * ks + 8 * hh), ld16(Br + 16 * ks + 8 * hh), acc);
        const int s = 32 * st + r; const float gs = gc[s];
#pragma unroll
        for (int i = 0; i < 16; ++i) { const int t = 32 * tt + crow(i, hh); const float dec = expf(gc[t] - gs);
            if (!isq) Am[t * 65 + s] = t > s ? be[t] * dec * acc[i] : 0.f;
            else ATb[t * 64 + s] = (bf16_t)f2bf(t >= s ? dec * acc[i] : 0.f); } }
    BLOCK_SYNC(); if (stop == 2) return;
    if (c.wave == 0) { const int d = c.lane >> 4, cc = c.lane & 15; const float* Ad = Am + (16 * d) * 65 + 16 * d; float* Td = T2 + (16 * d) * 65 + 16 * d;
        float t[16];
#pragma unroll
        for (int i = 0; i < 16; ++i) { float acc = (cc == i) ? 1.f : 0.f;
#pragma unroll
            for (int j = 0; j < i; ++j) acc -= Ad[i * 65 + j] * t[j];
            t[i] = acc; }
#pragma unroll
        for (int i = 0; i < 16; ++i) Td[i * 65 + cc] = t[i]; }
    else { for (int e = c.tid - 64; e < 64 * 64; e += NTHREADS - 64) { const int t = e >> 6, s2 = e & 63; if ((s2 >> 4) > (t >> 4)) T2[t * 65 + s2] = 0.f; } }
    BLOCK_SYNC();
    for (int rb = 1; rb < 4; ++rb) { const int wcols = 16 * rb;
        for (int e = c.tid; e < 16 * wcols; e += NTHREADS) { const int i = e & 15, cidx = e >> 4; float acc = 0.f; const float* Ar = Am + (16 * rb + i) * 65;
            for (int kb = cidx & ~15; kb < wcols; kb += 16) {
#pragma unroll
                for (int kk = 0; kk < 16; ++kk) acc += Ar[kb + kk] * T2[(kb + kk) * 65 + cidx]; }
            Rb[i * 49 + cidx] = acc; }
        BLOCK_SYNC();
        for (int e = c.tid; e < 16 * wcols; e += NTHREADS) { const int i = e & 15, cidx = e >> 4; float acc = 0.f; const float* Tr = T2 + (16 * rb + i) * 65 + 16 * rb;
#pragma unroll
            for (int j = 0; j < 16; ++j) acc += Tr[j] * Rb[j * 49 + cidx];
            T2[(16 * rb + i) * 65 + cidx] = -acc; }
        BLOCK_SYNC(); }
    if (stop == 3) return;
#ifndef EMU
    int lane2_ = c.lane; asm volatile("" : "+v"(lane2_));
    const int r2 = lane2_ & 31, hh2 = lane2_ >> 5;
#else
    const int r2 = r, hh2 = hh;
#endif
    {
#pragma unroll
        for (int rep = 0; rep < 2; ++rep) { const int idx = c.wave + 8 * rep, isw = idx >> 3, tt = (idx >> 2) & 1, ct = idx & 3;
            f32x16 acc;
#pragma unroll
            for (int i = 0; i < 16; ++i) acc[i] = 0.f;
            const bf16_t* Bt = (isw ? Kt : Vt) + (32 * ct + r2) * 72;
#pragma unroll
            for (int ks = 0; ks < 4; ++ks) { float f[8];
#pragma unroll
                for (int e = 0; e < 8; ++e) { const int s = 16 * ks + 8 * hh2 + e; f[e] = T2[(32 * tt + r2) * 65 + s] * be[s] * (isw ? gam[s] : 1.0f); }
                acc = MFMA32(pack8(f), ld16(Bt + 8 * ((2 * ks + hh2) ^ (((32 * ct + r2) >> 4) & 7))), acc); }
            bf16_t* dst = (isw ? Wb : Ub);
#pragma unroll
            for (int i = 0; i < 16; ++i) dst[(32 * tt + crow(i, hh2)) * 128 + 32 * ct + r2] = (bf16_t)f2bf(acc[i]); } }
    {
        const float gend = gc[63];
        const int j = c.tid >> 3, cg = c.tid & 7; const float gamj = gam[j];
#pragma unroll
        for (int half = 0; half < 2; ++half) { float f[8]; unpack8(ld16(Qs + j * 136 + 16 * cg + 8 * half), f);
#pragma unroll
            for (int e = 0; e < 8; ++e) f[e] *= gamj;
            *(bf16x8*)(QNb + j * 128 + 16 * cg + 8 * half) = pack8(f); }
#pragma unroll
        for (int ii = 0; ii < 2; ++ii) { const int idx = c.tid + 512 * ii, dk = idx >> 3, ch = idx & 7; float f[8]; unpack8(ld16(Kt + dk * 72 + 8 * (ch ^ ((dk >> 4) & 7))), f);
#pragma unroll
            for (int e = 0; e < 8; ++e) f[e] *= expf(gend - gc[8 * ch + e]);
            *(bf16x8*)(KDb + dk * 64 + 8 * ch) = pack8(f); } }
    BLOCK_SYNC();
}
constexpr int D2_PW = 132, D2_PA = 68;
constexpr int D2_W = 0, D2_QN = 64 * D2_PW * 2, D2_AT = 2 * 64 * D2_PW * 2, D2_KD = D2_AT + 64 * D2_PA * 2, D2_BUF = D2_KD + 128 * D2_PA * 2;
static_assert(2 * D2_BUF <= LDS_MISC, "two D2 buffers fit below the LDS control words");
DEV void dn_d2_stage(const Ctx& c, size_t ci, char* buf) {
    const bf16_t* Wb = (const bf16_t*)(c.ws + SO_W) + ci * 8192; const bf16_t* QNb = (const bf16_t*)(c.ws + SO_QN) + ci * 8192; const bf16_t* ATb = (const bf16_t*)(c.ws + SO_AT) + ci * 4096; const bf16_t* KDb = (const bf16_t*)(c.ws + SO_KD) + ci * 8192;
    const int lt = c.tid - 256;
#pragma unroll 2
    for (int i = 0; i < 14; ++i) { const int idx = lt + 256 * i; const bf16_t* src; char* dst;
        if (idx < 1024) { const int row = idx >> 4, ch = idx & 15; src = Wb + row * 128 + 8 * ch; dst = buf + D2_W + (row * D2_PW + 8 * ch) * 2; }
        else if (idx < 2048) { const int j = idx - 1024, row = j >> 4, ch = j & 15; src = QNb + row * 128 + 8 * ch; dst = buf + D2_QN + (row * D2_PW + 8 * ch) * 2; }
        else if (idx < 2560) { const int j = idx - 2048, row = j >> 3, ch = j & 7; src = ATb + row * 64 + 8 * ch; dst = buf + D2_AT + (row * D2_PA + 8 * ch) * 2; }
        else { const int j = idx - 2560, row = j >> 3, ch = j & 7; src = KDb + row * 64 + 8 * ch; dst = buf + D2_KD + (row * D2_PA + 8 * ch) * 2; }
        const bf16x8 v = ld16(src); const bf16x4 lo = __builtin_shufflevector(v, v, 0, 1, 2, 3), hi = __builtin_shufflevector(v, v, 4, 5, 6, 7);
        *(bf16x4*)dst = lo; *(bf16x4*)(dst + 8) = hi; }
}
DEV void dn_d2_chain(const Ctx& c, int chain, bool emit_ctx) {
    const int dir = chain & 1, h = (chain >> 1) & 3, b = chain >> 3; const int r = c.lane & 31, hh = c.lane >> 5, sl = c.wave & 3; const bool comp = c.wave < 4;
    const bf16_t* U0 = (const bf16_t*)(c.ws + SO_U); const float* GE = (const float*)(c.ws + SO_GE);
    bf16_t* HB = (bf16_t*)(c.ws + OFF_P) + PO_HB + (size_t)dir * MT * 512;
    f32x16 S[4];
#pragma unroll
    for (int t4 = 0; t4 < 4; ++t4)
#pragma unroll
        for (int i = 0; i < 16; ++i) S[t4][i] = 0.f;
    if (!comp) dn_d2_stage(c, (size_t)chain * NCH, c.lds);
    BLOCK_SYNC();
    for (int cc = 0; cc < NCH; ++cc) { const size_t ci = (size_t)chain * NCH + cc; char* buf = c.lds + (cc & 1) * D2_BUF;
        if (!comp) { if (cc + 1 < NCH) dn_d2_stage(c, ci + 1, c.lds + ((cc + 1) & 1) * D2_BUF); }
        else {
            const bf16_t* Ub = U0 + ci * 8192; const bf16_t* Wl = (const bf16_t*)(buf + D2_W); const bf16_t* QNl = (const bf16_t*)(buf + D2_QN); const bf16_t* ATl = (const bf16_t*)(buf + D2_AT); const bf16_t* KDl = (const bf16_t*)(buf + D2_KD);
            f32x16 u[2], ov[2];
#pragma unroll
            for (int tt = 0; tt < 2; ++tt)
#pragma unroll
                for (int i = 0; i < 16; ++i) { u[tt][i] = -bf2f(Ub[(32 * tt + crow(i, hh)) * 128 + 32 * sl + r]); ov[tt][i] = 0.f; }
#pragma unroll
            for (int ks = 0; ks < 8; ++ks) { const bf16x8 sf = pack_acc(S[ks >> 1], ks & 1); const int k0 = 16 * ks + 4 * hh;
#pragma unroll
                for (int tt = 0; tt < 2; ++tt) { const bf16_t* wp = Wl + (32 * tt + r) * D2_PW + k0; const bf16_t* qp = QNl + (32 * tt + r) * D2_PW + k0;
                    u[tt] = MFMA32(cat44(*(const bf16x4*)wp, *(const bf16x4*)(wp + 8)), sf, u[tt]);
                    ov[tt] = MFMA32(cat44(*(const bf16x4*)qp, *(const bf16x4*)(qp + 8)), sf, ov[tt]); } }
#pragma unroll
            for (int tt = 0; tt < 2; ++tt)
#pragma unroll
                for (int i = 0; i < 16; ++i) u[tt][i] = -u[tt][i];
            const float ge = GE[ci];
#pragma unroll
            for (int t4 = 0; t4 < 4; ++t4)
#pragma unroll
                for (int i = 0; i < 16; ++i) S[t4][i] *= ge;
#pragma unroll
            for (int ks = 0; ks < 4; ++ks) { const bf16x8 uf = pack_acc(u[ks >> 1], ks & 1);
#pragma unroll
                for (int tt = 0; tt < 2; ++tt) { const bf16_t* ap = ATl + (32 * tt + r) * D2_PA + 16 * ks + 4 * hh;
                    ov[tt] = MFMA32(cat44(*(const bf16x4*)ap, *(const bf16x4*)(ap + 8)), uf, ov[tt]); }
#pragma unroll
                for (int t4 = 0; t4 < 4; ++t4) { const bf16_t* kp = KDl + (32 * t4 + r) * D2_PA + 16 * ks + 4 * hh;
                    S[t4] = MFMA32(cat44(*(const bf16x4*)kp, *(const bf16x4*)(kp + 8)), uf, S[t4]); } }
            const int tc = dir == 0 ? cc : (cc < NCC ? NCC - 1 - cc : NCC + (NLC - 1 - (cc - NCC)));
            if (tc >= NCC || emit_ctx) {
#pragma unroll
                for (int tt = 0; tt < 2; ++tt)
#pragma unroll
                    for (int i = 0; i < 16; ++i) { const int j = 32 * tt + crow(i, hh); const int row = tok_row(b, tc, dir ? 63 - j : j);
                        HB[(size_t)row * 512 + h * 128 + 32 * sl + r] = (bf16_t)f2bf(ov[tt][i]); } }
        }
        BLOCK_SYNC();
    }
}
DEV void dn_yasm(const Ctx& c, int layer, int nrows) {
    const bf16_t* HB = (const bf16_t*)(c.ws + OFF_P) + PO_HB; const bf16_t* Z = (const bf16_t*)(c.ws + OFF_P) + PO_Z; const bf16_t* QC = (const bf16_t*)(c.ws + OFF_P) + PO_GO; bf16_t* Y = (bf16_t*)(c.ws + OFF_HY);
    const float* gn = c.in[19] + (size_t)(layer >> 1) * 128;
    for (int it = c.gw; it < nrows * 2; it += c.ngw) { const int row = it >> 1, col = (it & 1) * 256 + 4 * c.lane;
        const bf16x4 a = *(const bf16x4*)(HB + (size_t)row * 512 + col), bb = *(const bf16x4*)(HB + (size_t)MT * 512 + (size_t)row * 512 + col), z = *(const bf16x4*)(Z + (size_t)row * 512 + col);
        float v[4], ss = 0.f;
#pragma unroll
        for (int e = 0; e < 4; ++e) { v[e] = bf2f((unsigned short)a[e]) + bf2f((unsigned short)bb[e]); ss += v[e] * v[e]; }
#pragma unroll
        for (int o = 1; o < 32; o <<= 1) ss += SHFL_XOR(ss, o);
        const float rstd = 1.0f / sqrtf(ss * (1.0f / 128.0f) + EPS);
        float y[4];
#pragma unroll
        for (int e = 0; e < 4; ++e) y[e] = v[e] * rstd * gn[(col & 127) + e] * siluf_(bf2f((unsigned short)z[e]));
        u32x2 w; w[0] = pk2(y[0], y[1]); w[1] = pk2(y[2], y[3]);
        *(u32x2*)(Y + (size_t)row * 1024 + 512 + col) = w;
        *(u32x2*)(Y + (size_t)row * 1024 + col) = *(const u32x2*)(QC + (size_t)row * 512 + col); }
}

DEV void gqa_units(const Ctx& c, int layer, bool emit_ctx, int first, int stride) {
    constexpr int NQBL = SEQ / 256, NQBC = (CTX + 255) / 256, NUL = NB * 8 * NQBL, NUC = NB * 8 * NQBC;
    const int nuc = emit_ctx ? NUC : 0;
    for (int it = first; it < NUL + nuc; it += stride) { const bool cu = it >= NUL; int u = cu ? it - NUL : it; const int nqb = cu ? NQBC : NQBL;
        gqa_unit(c, layer, u / (8 * nqb), (u / nqb) & 7, cu, u % nqb); }
}
DEV void mix_odd_a(const Ctx& c, int layer) {
    { PHASE_CTX(pc); if (ON(14)) odd_kprep(pc, layer); }
    { PHASE_CTX(pc); if (ON(15)) { const bf16_t* KVC = (const bf16_t*)(pc.ws + OFF_P) + PO_KVC; bf16_t* VT = (bf16_t*)(pc.ws + SO_VT);
        for (int it = pc.bid; it < NB * 2 * NCH; it += pc.nblk) { const int pch = it % NCH, bk = it / NCH; vt_item<64>(pc, KVC, 256, 128 + (bk & 1) * 64, bk >> 1, pch, VT + (size_t)bk * 64 * LK); } } }
    REPB(16) { PHASE_CTX(pc); if (ON(16)) {
        { const float* convw = pc.in[16] + (size_t)(layer >> 1) * 3 * 1536; float* cwl = (float*)(pc.lds + D1_CW_OFF); BLOCK_SYNC();
          for (int e = pc.tid; e < 3 * 1536 / 4; e += NTHREADS) ((f32x4*)cwl)[e] = ((const f32x4*)convw)[e];
          BLOCK_SYNC(); }
        for (int it = pc.bid; it < NCHAIN * NCH; it += pc.nblk) dn_d1_item(pc, layer, it, (rep_ < (int)(((unsigned long long)(REPM) >> 16) & 1ull)) ? D1_STOP : 0); } }
}
DEV void mix_odd_b(const Ctx& c, int layer, bool emit_ctx) {
    const int nd2 = NCHAIN < c.nblk ? NCHAIN : c.nblk;
    const int na = c.nblk - nd2;
    REPB(17) { PHASE_CTX(pc); if (ON(17)) if (pc.bid < nd2) { for (int ch = pc.bid; ch < NCHAIN; ch += nd2) dn_d2_chain(pc, ch, emit_ctx); } }
    REPB(18) { PHASE_CTX(pc); if (ON(18)) { if (na > 0) { if (pc.bid >= nd2) gqa_units(pc, layer, emit_ctx, pc.bid - nd2, na); } else gqa_units(pc, layer, emit_ctx, pc.bid, pc.nblk); } }
}
DEV void mix_odd_c(const Ctx& c, int layer, bool emit_ctx) {
    { PHASE_CTX(pc); if (ON(19)) dn_yasm(pc, layer, emit_ctx ? MT : ML); }
}

#ifdef SELFTEST
#ifdef EMU
#define ST_HD static inline
#else
#define ST_HD __host__ __device__ inline
#endif
constexpr size_t ST_CHK = 512 * 1024;
ST_HD unsigned st_hash(unsigned a, unsigned b) { unsigned x = a * 0x9E3779B1u ^ (b + 0x7F4A7C15u) * 0x85EBCA6Bu; x ^= x >> 16; x *= 0x7FEB352Du; x ^= x >> 15; x *= 0x846CA68Bu; x ^= x >> 16; return x; }
ST_HD float st_uniform(unsigned t, unsigned i) { return (float)(st_hash(t, i) >> 8) * (1.0f / 16777216.0f); }
ST_HD float st_normal(unsigned tensor, unsigned idx) { const float u1 = ((float)(st_hash(tensor * 4u, idx) >> 8) + 0.5f) * (1.0f / 16777216.0f), u2 = (float)(st_hash(tensor * 4u + 1u, idx) >> 8) * (1.0f / 16777216.0f); return sqrtf(-2.0f * logf(u1)) * cosf(6.2831853f * u2); }
ST_HD size_t st_count(int i) {
    switch (i) {
    case 0: return (size_t)NB * SEQ * D; case 1: return (size_t)NB * D; case 2: return (size_t)NB * CTX * D; case 3: return D;
    case 4: return (size_t)DEPTH * D * 6 * D; case 5: return (size_t)DEPTH * 6 * D; case 6: case 7: return (size_t)DEPTH * D;
    case 8: return (size_t)2 * D * E_IN; case 9: return 32; case 10: return 512; case 11: case 12: return 256; case 13: return (size_t)2 * 1024 * D;
    case 14: return (size_t)2 * D * O_IN; case 15: return 256; case 16: return 2 * 3 * 1536; case 17: return 16; case 18: return 16; case 19: return 256; case 20: return (size_t)2 * 1024 * D;
    case 21: case 22: return (size_t)DEPTH * D * FF; case 23: return (size_t)DEPTH * FF * D; default: return D; }
}
ST_HD float st_value(int i, size_t idx) {
#ifdef ST_SAME_BATCH
    if (i == 0) idx %= (size_t)SEQ * D; if (i == 1) idx %= (size_t)D; if (i == 2) idx %= (size_t)CTX * D;
#endif
    const float d = (float)D; const float n = st_normal((unsigned)i + 1u, (unsigned)idx);
    switch (i) {
    case 0: case 1: case 2: case 3: return n;
    case 4: return n * 0.5f / sqrtf(d); case 5: return n * 0.02f; case 6: case 7: case 11: case 12: case 15: case 19: case 24: return 1.0f + 0.02f * n;
    case 8: case 14: case 21: case 22: return n / sqrtf(d);
    case 9: return 0.1f * n + ((idx & 4) ? 3.0f + (float)(idx & 3) : 0.0f);
    case 10: return 0.1f * n; case 13: case 20: return n * (1.0f / 32.0f); case 16: return n * 0.57735027f;
    case 17: return logf(1.0f + 5.0f * (float)(idx & 3)) + 0.05f * n;
    case 18: { const float dt = expf(-6.9077553f + 4.6051702f * st_uniform(999u, (unsigned)idx)); return dt + logf(-expm1f(-dt)); }
    case 23: return n / sqrtf((float)FF);
    default: return n; }
}
ST_HD size_t st_offset(int i) { size_t o = 0; for (int k = 0; k < i; ++k) o += (st_count(k) + 63) & ~(size_t)63; return o; }
DEV void st_sum(const Ctx& c, int step, int sub, const void* base, size_t n, int is_bf16) {
    step += c.ngw;
    double p[8], s2 = 0.0;
#pragma unroll
    for (int k = 0; k < 8; ++k) p[k] = 0.0;
    const size_t gt = (size_t)c.bid * NTHREADS + c.tid, GT = (size_t)c.nblk * NTHREADS;
    for (size_t i = gt; i < n; i += GT) { const float v = is_bf16 ? bf2f(((const bf16_t*)base)[i]) : ((const float*)base)[i]; const unsigned h = st_hash(0xC0FFEEu + (unsigned)sub, (unsigned)i); s2 += (double)v * (double)v;
#pragma unroll
        for (int k = 0; k < 8; ++k) p[k] += ((h >> (k + 8)) & 1u) ? (double)v : -(double)v; }
    double* chk = (double*)(c.ws + ST_CHK) + ((size_t)step * 4 + sub) * 10;
#ifdef EMU
    for (int k = 0; k < 8; ++k) chk[k] += p[k];
    chk[8] += s2; if (gt == 0) chk[9] = (double)n;
#else
#pragma unroll
    for (int k = 0; k < 8; ++k) atomicAdd(chk + k, p[k]);
    atomicAdd(chk + 8, s2); if (gt == 0) chk[9] = (double)n;
#endif
}
DEV void st_checks(const Ctx& c, int step) {

    const int layer = step / 9, ph = step - 9 * layer, odd = layer & 1; const size_t mrows = layer < DEPTH - 1 ? MT : ML; unsigned char* ws = c.ws;
    if (ph == 0) { st_sum(c, step, 0, ws + OFF_HY, (size_t)MT * D, 1); st_sum(c, step, 1, ws + OFF_G, (size_t)MT * 16, 0); st_sum(c, step, 2, ws + OFF_WIN, (size_t)(odd ? NO : NE) * D, 1); st_sum(c, step, 3, ws + OFF_WOUT, (size_t)D * 1024, 1); }
    else if (ph == 1) { st_sum(c, step, 0, ws + OFF_P, (size_t)MT * (odd ? NO : NE), 1); }
    else if (ph == 2) { if (!odd) { st_sum(c, step, 0, ws + SE_KP, (size_t)NB * 8 * LK * 64, 1); st_sum(c, step, 1, ws + SE_VT, (size_t)NB * 4 * 128 * LK, 1); st_sum(c, step, 2, ws + SE_DCT, (size_t)NCHAIN * NCH * 8192, 0); st_sum(c, step, 3, ws + SE_DN, (size_t)NCHAIN * NCH * 64, 0); }
        else { st_sum(c, step, 0, ws + SO_KP, (size_t)NB * 2 * LK * 64 * 2, 1); st_sum(c, step, 1, ws + SO_U, (size_t)NCHAIN * NCH * 8192, 1); st_sum(c, step, 2, ws + SO_W, (size_t)NCHAIN * NCH * 8192, 1); st_sum(c, step, 3, ws + SO_AT, (size_t)NCHAIN * NCH * (4096 + 8192 + 8192), 1); } }
    else if (ph == 3) { if (!odd) { st_sum(c, step, 0, ws + SE_DCT, (size_t)NCHAIN * NCH * 8192, 0); st_sum(c, step, 1, ws + SE_DN, (size_t)NCHAIN * NCH * 64, 0); }
        else { st_sum(c, step, 0, ws + OFF_P + PO_HB * 2, (size_t)mrows * 512, 1); st_sum(c, step, 1, ws + OFF_P + (PO_HB + (size_t)MT * 512) * 2, (size_t)mrows * 512, 1); st_sum(c, step, 2, ws + OFF_P + PO_GO * 2, (size_t)mrows * 512, 1); } }
    else if (ph == 4) { st_sum(c, step, 0, ws + OFF_HY, (size_t)mrows * 1024, 1); }
    else if (ph == 5 || ph == 8) { st_sum(c, step, 0, ws + OFF_X, (size_t)mrows * D, 0); }
    else if (ph == 6) { st_sum(c, step, 0, ws + OFF_HY, (size_t)mrows * D, 1); st_sum(c, step, 1, ws + SF_WGU, (size_t)2 * FF * D, 1); st_sum(c, step, 2, ws + SF_WDN, (size_t)D * FF, 1); }
    else { st_sum(c, step, 0, ws + OFF_P, (size_t)mrows * FF, 1); }
}
#endif

DEV void final_norm(const Ctx& c) {
    constexpr int NV = D / 256;
    const float* X = (const float*)(c.ws + OFF_X); const float* g = c.in[24];
    for (int row = c.gw; row < ML; row += c.ngw) {
        const f32x4* xr = (const f32x4*)(X + (size_t)row * D) + c.lane; f32x4 v[NV]; float ss = 0.f;
#pragma unroll
        for (int j = 0; j < NV; ++j) { v[j] = xr[64 * j]; ss += (v[j][0] * v[j][0] + v[j][1] * v[j][1]) + (v[j][2] * v[j][2] + v[j][3] * v[j][3]); }
        const float rstd = 1.0f / sqrtf(wave_sum(ss) * (1.0f / D) + EPS);
        f32x4* o = (f32x4*)(c.out + (size_t)row * D) + c.lane;
#pragma unroll
        for (int j = 0; j < NV; ++j) o[64 * j] = v[j] * rstd * *(const f32x4*)(g + 256 * j + 4 * c.lane);
    }
}

constexpr size_t WS_NEED = cmax(WS_NEED_EF, SO_END);
#ifdef EMU
static void mega(Args args) {
    char* lds = emu::blocks[EMU_BID].lds;
    XcdBarrier bar; bar.dummy = 0;
#else
__global__ void __launch_bounds__(NTHREADS, 2) mega(Args args) {
    extern __shared__ __attribute__((aligned(16))) unsigned char lds_raw[];
    char* lds = (char*)lds_raw;
    {   volatile LAS unsigned* misc0 = (volatile LAS unsigned*)((LAS unsigned char*)lds_raw + LDS_MISC);
        if (threadIdx.x < 64) misc0[threadIdx.x] = 0u; }
    __syncthreads();
    XcdBarrier bar = xcd_barrier_post((unsigned*)(args.ws + OFF_CTL) + 4096, (volatile LAS unsigned*)((LAS unsigned char*)lds_raw + LDS_MISC) + 8);
#endif
    Ctx c;
#ifdef EMU
    c.tid = TIDX; c.lane = c.tid & 63; c.wave = c.tid >> 6;
#else
    c.tid = 0; c.lane = 0; c.wave = 0;
#endif
    c.bid = BIDX; c.nblk = NBLK; c.gw = c.bid * NWAVES + c.wave; c.ngw = c.nblk * NWAVES; c.lds = lds; c.in = args.in; c.out = args.out; c.ws = args.ws;

    if (args.prologue) {
    { PHASE_CTX(pc); if (ON(0)) p0_prologue(pc); }
#ifndef EMU
    cg::this_grid().sync();
#else
    GRID_BARRIER();
#endif
    }
#ifndef REPEAT_PH
#define REPEAT_PH -1
#endif
    for (int step2 = 2 * args.step_lo; step2 < 2 * args.step_hi; ++step2) {
        const int step = step2 >> 1; if ((step2 & 1) && !((step % 9) == REPEAT_PH && (REPEAT_PH != 3 || ((step / 9) & 1)))) continue;
        const int layer = step / 9, ph = step - 9 * layer;
        const int odd = layer & 1; const bool emit_ctx = layer < DEPTH - 1; const int mrows = emit_ctx ? MT : ML;
        if (ph == 0) {
            { PHASE_CTX(pc); if (ON(1) && (layer == 0 || step == args.step_lo)) convert_mixer_weights(pc, layer, pc.gw, pc.ngw); }
            { PHASE_CTX(pc); const bool prev = layer > 0 && step > args.step_lo; const int pm_ = MT;
              const SplitPlan red = split_plan(pm_, FF, pc.nblk, prev);
              if (ON(2)) normalize_rows(pc, layer, 0, MT, red, pm_, (const float*)(pc.ws + OFF_MOD) + (size_t)(layer - (prev ? 1 : 0)) * 9 * 6 * D + 5 * D); }
        } else if (ph == 1) {
            if (ON(3)) { PHASE_CTX(pc); pg8::Gemm g{(const bf16_t*)(pc.ws + OFF_HY), (const bf16_t*)(pc.ws + OFF_WIN), MT, odd ? NO : NE, D}; pg8::StaticOrder S; S.init(MT, odd ? NO : NE, c.nblk, c.bid); S.wave = pc.wave;
                if (odd && !emit_ctx && NO == 2816) { S.init(ML, NO, c.nblk, c.bid); S.wave = pc.wave; S.tn = (MC / 256) * 7; S.tpm = ML / 256; S.tpn = 2; S.tw = 7; }
                EpiSeg E{(bf16_t*)(pc.ws + OFF_P), odd};
                GEMM_PHASE(EpiSeg, lds, g, S, E); }
        } else if (ph == 2) { if (!odd) mix_even_a(c, layer); else mix_odd_a(c, layer); }
        else if (ph == 3) { if (!odd) mix_even_b(c, layer); else mix_odd_b(c, layer, emit_ctx); }
        else if (ph == 4) { if (!odd) mix_even_c(c, layer); else mix_odd_c(c, layer, emit_ctx); }
        else if (ph == 5 || ph == 8) {
            if (ON(4)) { PHASE_CTX(pc); const bool dn = ph == 8;
                const int kdim = dn ? FF : 1024; const SplitPlan sp = split_plan(mrows, kdim, pc.nblk, dn && layer + 1 < CFG_LAYERS);
                pg8::Gemm g{(const bf16_t*)(pc.ws + (dn ? OFF_P : OFF_HY)), (const bf16_t*)(pc.ws + (dn ? SF_WDN : OFF_WOUT)), mrows, D, kdim}; pg8::StaticOrder S; S.init(mrows, D, c.nblk, c.bid); S.wave = pc.wave;
                if (sp.extra) S.lim = pc.nblk;
                const bool first = layer == 0 && !dn;
                EpiResid E{(float*)(pc.ws + OFF_X), (const float*)(pc.ws + OFF_MOD) + (size_t)layer * 9 * 6 * D, dn ? 5 * D : 2 * D,
                           first ? pc.in[0] : (const float*)(pc.ws + OFF_X), first ? pc.in[2] - (size_t)ML * D : (const float*)(pc.ws + OFF_X)};
                GEMM_PHASE(EpiResid, lds, g, S, E);
                if (sp.extra && pc.bid < sp.extra * sp.split) {
                    const int lu = pc.bid / sp.split, q = pc.bid % sp.split, pairs = kdim / 128, base = pairs / sp.split, rem = pairs % sp.split;
                    const int np = base + (q < rem ? 1 : 0), p0 = q * base + (q < rem ? q : rem);
                    pg8::Gemm g2{g.A + (size_t)p0 * 128, g.Bt + (size_t)p0 * 128, mrows, D, np * 128, kdim}; pg8::StaticOrder S2; S2.init(mrows, D, sp.nwg, pc.nblk + lu); S2.wave = pc.wave;
                    EpiPart E2{(float*)(pc.ws + SF_PART) + (size_t)pc.bid * 65536};
                    BLOCK_SYNC();
                    GEMM_PHASE(EpiPart, lds, g2, S2, E2); } }
            { PHASE_CTX(pc); const SplitPlan sp = split_plan(mrows, ph == 8 ? FF : 1024, pc.nblk, ph == 8 && layer + 1 < CFG_LAYERS);
              const int nwg = sp.nwg; int busy = (nwg > pc.nblk && nwg < 2 * pc.nblk) ? nwg - pc.nblk : 0; if (sp.extra) busy = (pc.nblk - sp.extra * sp.split > pc.nblk / 4) ? sp.extra * sp.split : 0;
              if (ON(1) && pc.bid >= busy) { BLOCK_SYNC();
                  if (ph == 5) convert_ffn_weights(pc, layer, (pc.bid - busy) * NWAVES + pc.wave, (pc.nblk - busy) * NWAVES);
                  else if (layer + 1 < CFG_LAYERS && step + 1 < args.step_hi) convert_mixer_weights(pc, layer + 1, (pc.bid - busy) * NWAVES + pc.wave, (pc.nblk - busy) * NWAVES); } }
        } else if (ph == 6) {
            { PHASE_CTX(pc); const SplitPlan red = split_plan(mrows, 1024, pc.nblk, false);
              if (ON(2)) normalize_rows(pc, layer, 1, mrows, red, mrows, (const float*)(pc.ws + OFF_MOD) + (size_t)layer * 9 * 6 * D + 2 * D); }
        } else {
            if (ON(5)) { PHASE_CTX(pc); pg8::Gemm g{(const bf16_t*)(pc.ws + OFF_HY), (const bf16_t*)(pc.ws + SF_WGU), mrows, 2 * FF, D}; pg8::StaticOrder S; S.init(mrows, 2 * FF, c.nblk, c.bid); S.wave = pc.wave;
                EpiSwiglu E{(bf16_t*)(pc.ws + OFF_P)};
                GEMM_PHASE(EpiSwiglu, lds, g, S, E); }
        }
        if (step + 1 < args.step_hi || args.final_) GRID_BARRIER();
#ifdef EMU_STOP_AFTER_MIX
        if (layer == CFG_LAYERS - 1 && ph == 4) return;
#endif
    }
    if (args.final_) { PHASE_CTX(pc); if (ON(7)) final_norm(pc); }
}

#ifndef EMU
#ifdef PROBE_Y
__global__ void pr_stat(const bf16_t* Y, int rows, int c0, int c1, double* acc) {
    double s = 0.0, cnt = 0.0; float mx = 0.f;
    for (size_t k = (size_t)blockIdx.x * blockDim.x + threadIdx.x; k < (size_t)rows * 1024; k += (size_t)gridDim.x * blockDim.x) { const int col = (int)(k & 1023); if (col < c0 || col >= c1) continue;
        const float v = bf2f(Y[k]); s += (double)v * v; cnt += 1.0; mx = fmaxf(mx, fabsf(v)); }
    atomicAdd(acc, s); atomicAdd(acc + 1, cnt); atomicMax((unsigned long long*)acc + 2, (unsigned long long)(mx * 1e6f));
}
__global__ void pr_fill(const double* acc, float* out, int n) {
    const float rms = (float)sqrt(acc[0] / acc[1]), mx = (float)((const unsigned long long*)acc)[2] * 1e-6f;
    const float c = sqrtf(rms * 10.0f), B = mx * 10.0f;
    for (size_t k = (size_t)blockIdx.x * blockDim.x + threadIdx.x; k < (size_t)n; k += (size_t)gridDim.x * blockDim.x) out[k] = (k == 12345) ? B : c;
}
#endif
#ifdef SELFTEST
struct StPtrs { float* p[25]; };
__global__ void st_gen_inplace(StPtrs P) {
    for (int i = 0; i < 25; ++i) { const size_t n = st_count(i);
        for (size_t k = (size_t)blockIdx.x * blockDim.x + threadIdx.x; k < n; k += (size_t)gridDim.x * blockDim.x) P.p[i][k] = st_value(i, k); }
}
__global__ void st_gen(float* syn) {
    for (int i = 0; i < 25; ++i) { const size_t n = st_count(i), o = st_offset(i);
        for (size_t k = (size_t)blockIdx.x * blockDim.x + threadIdx.x; k < n; k += (size_t)gridDim.x * blockDim.x) syn[o + k] = st_value(i, k); }
}
constexpr int ST_NEXP = 74;
#ifndef ST_REPORT_SUB
#define ST_REPORT_SUB 0
#endif
#ifndef ST_TOL
#define ST_TOL 0.03
#endif
__device__ const int ST_EXP_STEP[74] = {0,0,0,0,1,2,2,2,2,3,3,4,5,6,6,6,7,8,9,9,9,9,10,11,11,11,11,12,12,12,13,14,15,15,15,16,17,18,18,18,18,19,20,20,20,20,21,21,22,23,24,24,24,25,26,27,27,27,27,28,29,29,29,29,30,30,30,31,32,33,33,33,34,35,};
__device__ const int ST_EXP_SUB[74] = {0,1,2,3,0,0,1,2,3,0,1,0,0,0,1,2,0,0,0,1,2,3,0,0,1,2,3,0,1,2,0,0,0,1,2,0,0,0,1,2,3,0,0,1,2,3,0,1,0,0,0,1,2,0,0,0,1,2,3,0,0,1,2,3,0,1,2,0,0,0,1,2,0,0,};
__device__ const double ST_EXP[74][10] = {
{2823.9405135959387,-6955.5741695016623,-5804.0977028682828,9054.3725127205253,-3966.7899582609534,-4601.8714917525649,7995.7762676179409,971.6921226978302,22251047.414743461,18874368,},
{291.26190879568458,-1573.2945180945098,331.66257446631789,357.45295172557235,-214.97323327884078,864.47900781407952,490.07691208645701,667.85457975044847,340263.10377825046,294912,},
{-23.357008519407827,15.935151411395054,35.883058835112024,57.434714148461353,-51.349641996261198,60.264678716950584,-59.23590717773186,-56.705568651959766,3067.8819070441805,3145728,},
{25.470241500996053,-43.468927160836756,58.065743817947805,4.3800708865746856,11.067458258010447,-10.867067505605519,26.364831392653286,-27.969552277587354,1020.9866835358141,1048576,},
{-11200.415292963386,9297.3592315688729,3203.3726777359843,-9663.7561300396919,-641.6257035061717,-8234.4563228115439,7994.2129158824682,-5521.8908601477742,66654113.07759431,56623104,},
{-1194.5305787473917,-1674.2680710405111,-5463.7986858785152,-4930.0590666979551,-1068.7674529403448,3002.9571408778429,-649.54952663183212,-4412.2754199355841,11106170.817955792,9437184,},
{-5507.6614354923368,1901.5068384334445,-4913.9082106724381,-2596.9450140967965,-1520.3851273730397,3237.6398326531053,-2359.8059303388,2364.7748123183846,11105296.668379547,9437184,},
{1560.4392579563191,-2499.261261367612,1459.3170721097504,-245.48758464773891,1043.47321934717,1419.7026340031534,1920.6481273452355,-1582.4576623782978,1601541.1673813532,18874368,},
{18.923751746769994,105.40070073772222,-9.9321377836167812,-69.897449327632785,166.82718826597556,123.35070158960298,-124.43343016551808,-149.78254351718351,24705.222434743067,147456,},
{2291.1772415378409,-198.18048978019215,106.27707149069283,1579.1373604525679,1783.1593627679513,2121.0945059178157,-2611.1484069368307,-1331.619970235115,2782256.6531369383,18874368,},
{89.759916271461407,27.444828146166401,211.5510761210171,-443.45204046583967,221.2014890195278,-713.03335159321432,-278.38321068481309,161.85793914255919,83907.236548682689,147456,},
{2060.1309491619468,-3099.3174412855878,3189.1278408914804,-1495.998928762041,2018.3208422241732,3951.0027283849195,307.00997438374907,189.92257314547896,8838647.8145213183,18874368,},
{2615.2232726222937,-3851.6311007236727,-5090.8008575433851,8895.7526726254218,-2915.793732104612,-3466.5127967876979,8494.2590465184257,-476.8310997271401,19641291.046898585,18874368,},
{2260.6133435368538,-3524.0150115936995,-6184.6817786470056,8612.6491934210062,-2936.174174323678,-5085.3421624973416,7627.2569323033094,-322.10541462153196,22201812.480418805,18874368,},
{39.211919396329904,-22.191732778126607,71.555887567257741,-34.657468227291247,-37.514794261514908,48.970252739818534,56.030709780199686,21.127209749916801,5631.6743743792158,5767168,},
{-58.957687043759506,-25.822232720500324,27.559850534133147,-19.2058952494408,25.962478367669974,10.300243424077053,-1.6967002287856303,-52.715924362360965,1022.4535583883176,2883584,},
{-194.02440498952637,2323.5604243765411,4943.6193249881908,-6076.2407636700955,-3098.2506252240564,1737.1458579480241,4071.2157669755688,3426.5647126794502,26276154.208520912,51904512,},
{2062.0307282910508,-2404.6291768250012,-4943.0085245753726,8409.3699170327891,-3388.5586135165795,-3156.0619303231506,8070.8516135739701,103.72620783001184,20445489.612024359,18874368,},
{-850.44070326350629,-1898.2922850791365,-5629.5260096881539,5319.5235935095698,-3571.6089787539095,-4582.1209145840257,8084.1448610220104,1201.9745895769447,22408943.624150425,18874368,},
{-276.67351097613573,238.73336043953896,402.49070692062378,1139.6587501242757,412.53829725086689,1001.9456618651748,-199.34280802309513,243.97394938021898,346041.02869538032,294912,},
{55.275690128095448,33.631906502880156,39.819098525680602,39.580814833752811,-56.659358996432275,56.905868629924953,70.874192817136645,32.641803210601211,2813.6335960129777,2883584,},
{16.459319942980073,-15.029889202327468,24.789046118385158,39.597747391439043,22.32851928321179,32.169926681905054,4.3831529127201065,-11.914361283765174,1024.2634621089853,1048576,},
{-8112.7706977427006,-15166.404139339924,9019.1636524870992,-10032.914728678763,-3683.5552492365241,6445.1523703113198,4940.6895737573504,-396.46003675460815,61599346.798404746,51904512,},
{1064.6478829011321,2961.5112186744809,2643.997241653502,3817.1335873380303,2552.6912311688066,2848.1112303361297,2641.0165046826005,877.74564967304468,5155886.6824775627,4718592,},
{-1180.9790783076314,-353.66288720036391,1405.2405796857784,-3003.0330094090896,736.01905330538284,1520.8871299045859,-1925.6258542904397,-909.10001162986737,2434153.6281470573,18874368,},
{60.165285118651028,-119.7430636333083,80.732633202489126,-9.8426874747077857,-101.69595492020277,-92.996986093445443,207.83742497175277,20.265997010018708,8918.7285340001526,18874368,},
{270.78828044847916,-133.56509196904631,-10.835563753045964,-177.08542341093678,116.75884305510037,-401.68338958283317,92.706295374895404,-256.76246256793473,40406.455039767519,47185920,},
{-17.403251063922653,85.550381564797135,-67.875341098901117,39.030201086570742,-44.825321126758354,-24.736986581498059,-130.15850522785331,-6.1346717766427901,3203.0568557028691,9437184,},
{26.677921455280739,-10.301573183693108,-15.383461458186503,23.552394272832316,-16.422941844488378,33.179475616852869,-26.073428510382655,49.43283157730184,2218.7160715744772,9437184,},
{-104.63265653897543,-1025.0813928971766,623.84842114138883,-1420.2001781960716,1368.3365971482126,-86.704579671728425,96.991083307308145,428.70963656844106,889696.22597060842,9437184,},
{2432.259056510753,267.30669010814745,1837.783826454659,2981.6297531555174,-416.17357830458786,-1826.6180147336563,-301.78532918507699,-744.86193079140503,4898348.3318136279,18874368,},
{3294.5902997395533,-865.44878266500746,-4974.0870277224822,6772.8382276698467,-3398.3562051501722,-4187.1136843486529,8143.3624155692742,-612.10508898339322,20872541.311585322,18874368,},
{3536.330776873976,1917.42852505669,-2076.6844129748642,4320.7511040978134,-4890.1908001117408,-4107.6248654313385,10533.807669285685,471.08626228198409,22412768.276720807,18874368,},
{-6.0809309475971531,76.739011337651391,97.496654804484933,-29.642639640796915,0.70117462620510196,-203.53367705441451,-98.699187040134348,-53.162115221513886,5628.1487348292976,5767168,},
{56.758986754866783,46.788941775390413,-43.423746958898846,33.754279191547539,25.984360144881066,-65.525896325649228,5.420765693706926,45.74655341921607,1023.6598906812283,2883584,},
{2102.1720024403512,3520.8294076444326,-6874.5287163143184,3797.4676643103921,3201.4737541926479,2643.8227775447631,352.29275992398834,1880.529091139204,26630809.672188494,51904512,},
{2885.2073127178519,-1385.1170310270754,-4514.0122937517372,7030.8231581723594,-3845.7207517792049,-6356.8220687311768,7588.3782935662384,-564.85132873002294,21742637.688699484,18874368,},
{3812.0284725353122,1621.2253267094493,-4254.9756214395165,6197.9158516302705,8.5768845900893211,-5469.3091325387359,8752.140286244452,-1246.7436530068517,22065010.375674032,18874368,},
{-1149.1737003140152,496.67538012936711,483.18858239427209,650.82792166247964,314.5317993350327,-371.12024437263608,890.37748170271516,-1420.4709294177592,350924.7500354572,294912,},
{88.047429081168957,-74.825534723349847,-23.789757229969837,-97.320472310879268,-4.0056394656421617,-30.904204592457972,-18.987518870853819,-27.849783896817826,3073.3731145051615,3145728,},
{65.20327353652101,3.0222902240930125,25.993390792864375,14.415037170168944,54.844758132356219,-56.249738970887847,19.864254156243987,-27.887308357167058,1025.1381782409978,1048576,},
{-13237.945228233933,-5020.7346298694611,5226.0037766546011,12825.714193224907,-2397.7048603817821,-7119.2997151985765,9948.7588085010648,-5921.2636323198676,66137041.201810837,56623104,},
{-75.766457952558994,2293.2211949080229,-2037.293488740921,1509.2966427430511,6117.5132186114788,479.96601853519678,-5639.6398960202932,1845.2123182713985,11060201.299008245,9437184,},
{-462.10384976491332,5736.9905912540853,-2167.2699889577925,-1180.0111477933824,409.65681508556008,-1780.9929978586733,-671.92641231790185,-1349.7005080021918,11027953.433529973,9437184,},
{-822.00079254147931,-1214.0090433928017,3328.184749965596,87.801341768161365,-495.11205383328706,-877.86274139888337,1911.2223419476468,796.02008414199008,1759052.6843886974,18874368,},
{100.80030664941296,22.118581771384925,-242.38840196980163,-93.397681776899844,-57.195992573630065,-53.402307578828186,-150.74265199294314,-86.528761671390384,31090.621100439952,147456,},
{3075.2200345232932,146.19098324902222,-1073.3931368374535,-3446.3695871779209,37.989448957180798,223.73928401402372,1720.4827841137958,2765.2156565344467,3854013.6325600357,18874368,},
{542.032717238857,-110.56952357693081,1.825648151418136,-830.79371399683441,-111.90571951437596,-416.65702595594485,-459.77385005963879,177.62618795662274,136561.77048135776,147456,},
{-536.59579325607046,3431.0063604712486,3724.987038930878,-672.57181697292253,-3271.82986589754,-275.97591033531353,1134.3561726845801,3369.160484327469,5460094.8227678062,18874368,},
{3690.413550499331,-2055.6428064615766,-5438.0006776863584,7215.5527907973737,-3675.7019953130812,-5533.6785190762885,6701.1122693967927,64.846424879085134,22222666.921814281,18874368,},
{6145.2994565963745,-1456.0999585092068,-5831.9741258770227,8761.7396555989981,-5699.234908297658,-4079.551640689373,4842.0201814621687,-2019.1001229286194,22203324.287363961,18874368,},
{130.56598056000075,66.178603142005159,-72.223813362215878,-40.295281428698217,26.729994425171753,-72.123386049031978,-88.871669880725676,27.124975894665113,5635.9492323544555,5767168,},
{32.54455375490943,72.597239872498903,-17.171426851477008,-4.8966801255592145,-15.258403940417338,-23.122007071331609,-22.899502303858753,62.156484370876569,1023.7774562760339,2883584,},
{-6760.2973620964185,3735.844417643224,1094.1796880429465,4204.2181440759596,-764.49361893783498,-4932.0209130450239,-6261.1468112875446,-4488.8535375963402,26246313.294528794,51904512,},
{4457.1757640697724,-2267.1563059242435,-4745.1736963140393,7186.1535465445595,-4113.5497737388105,-7139.5026401302202,6476.8297955984126,-72.098023249844118,23047663.524188824,18874368,},
{4172.7441230602562,2189.9780470617115,-5133.8792393095791,7288.8046996556222,-5411.0709395520389,-4896.6709096245468,8724.0389158017933,-1300.7641984857619,22255371.479420178,18874368,},
{342.48845159634948,-1155.9452162571251,-355.46573888137937,38.030472237616777,-706.72725258395076,302.12307207658887,1501.216548230499,-189.15161934122443,356337.53284288617,294912,},
{141.34916719738249,55.510840875467693,3.4794936717735254,14.99616638317093,48.530484220267681,80.824254727551306,36.550317391192948,-11.045543047970568,2822.5213800999318,2883584,},
{-1.7540650628507137,-68.523136725649238,20.526102727279067,4.1151908580213785,26.478423124179244,17.260244991630316,26.540773348882794,18.066198658198118,1023.7352584092852,1048576,},
{9615.2207438386977,4784.9471067078412,1940.7497162856162,-5810.9412356205285,-983.56367782130837,7418.8542090691626,16772.396392870694,-7707.8745242021978,61356805.552982159,51904512,},
{1611.5909418128431,-862.28053805604577,-136.1677976809442,-552.47190998122096,983.61643074825406,-2118.3313589207828,2136.0759917013347,1436.2902639396489,5189176.8575152932,4718592,},
{1791.7875226804172,-31.704715774103533,260.74334435508354,2286.3263573826407,2006.0634295089985,-556.23315154918237,2794.1662208863418,265.33516812947346,2237659.8451027921,18874368,},
{1.738220854325472,-47.72536333968177,85.671240820733587,-76.785340997768273,-33.389609302064237,10.517162931163593,-16.605087701564099,-69.403631001852744,4294.4259768959364,18874368,},
{80.462511468439985,-161.96663447577936,103.6356164854663,158.8806262336563,-156.06783419597375,68.553029276052172,-342.86381052307308,-54.733859514236087,20398.968534675096,47185920,},
{52.505996509542456,40.193077393545536,-32.136223205568967,9.6826318503881339,-32.908785335748689,-49.309646418463672,7.7728565156285185,28.182192534412025,933.99111986596574,8388608,},
{-7.5194821398763452,15.928513078688411,-22.494523745699553,-25.74654744003783,-1.9659538757696282,39.424875568918651,-41.204660507297376,-50.291643056989415,1399.3033406704337,8388608,},
{-135.14476990071125,388.87867833836935,-624.19169349339791,-255.41803698171861,749.05279063689522,489.13258223538287,7.6979752753395587,-1529.1879597052466,922125.16740855761,8388608,},
{2513.205304118339,-3002.4781056293286,-591.26384180737659,984.36628054594621,-165.44268643157557,-2587.8124781120569,5950.0621142634191,1918.4807258569635,4533654.192930459,16777216,},
{2830.9344703354946,-4920.8287407121315,-3976.7572222978852,7101.1558030729429,-6279.3158443071807,-7658.587931540409,7596.1372552172033,-980.77548625691998,20848405.50834683,16777216,},
{5663.7043273374438,-4698.0929517224431,-2882.0782249197364,6381.8024617210031,-6684.7693502381444,-6324.1065613850951,5276.286193959415,-1294.3445755466819,19824501.716412377,16777216,},
{105.49113711505197,9.4353141400497407,71.544671961572021,-144.04839801136404,-59.128098372370005,86.345427959226072,-22.445412413449958,-31.521184443496168,5635.2677728111466,5767168,},
{-52.974209187126689,83.749726402067608,-11.22629395038166,-7.1423740544887551,-10.056938788195112,-45.578087951795169,41.377634743421368,16.152020135003113,1023.3413428186279,2883584,},
{1126.9516335337321,-4958.3812902097925,-2794.7144431749111,5195.0455790979104,4310.2982955073458,-6172.0018973502665,4099.1716476037618,-5060.7709415074714,23578261.929520626,46137344,},
{854.11164966656725,-4002.1053702284298,-4016.2943720539079,7535.4821215254451,-6184.3291782648776,-6281.2433878521588,8750.5079252671385,531.59902707755464,21616516.22354921,16777216,},
};
__global__ void st_check_kernel(unsigned char* ws, int step, int slot = 0) { Ctx c; c.tid = threadIdx.x; c.lane = c.tid & 63; c.wave = c.tid >> 6; c.bid = blockIdx.x; c.nblk = gridDim.x; c.gw = 0; c.ngw = slot; c.lds = nullptr; c.in = nullptr; c.out = nullptr; c.ws = ws; st_checks(c, step); }
__global__ void st_report(const unsigned char* ws, float* out, int n) {
    const double* chk = (const double*)(ws + ST_CHK); int code = 0;
    for (int e = 0; e < ST_NEXP && !code; ++e) { const int step = ST_EXP_STEP[e], sub = ST_EXP_SUB[e]; const double* g = chk + (step * 4 + sub) * 10; double d2 = 0.0; if (g[9] == 0.0) continue;
        for (int k = 0; k < 8; ++k) { const double d = g[k] - ST_EXP[e][k]; d2 += d * d; }
        const double eps2 = d2 / (8.0 * ST_EXP[e][8] + 1e-300);
        const bool bad = !(eps2 <= ST_TOL * ST_TOL);
        if (bad) code = ST_REPORT_SUB ? (step == ST_REPORT_SUB - 1 ? sub + 1 : 0) : step + 1; }
    const float v = sqrtf((float)code);
    for (size_t k = (size_t)blockIdx.x * blockDim.x + threadIdx.x; k < (size_t)n; k += (size_t)gridDim.x * blockDim.x) out[k] = v;
}
__global__ void st_repeat_report(const unsigned char* ws, float* out, int n, int nsteps) {
    const double* chk = (const double*)(ws + ST_CHK); int code = 0;
    for (int st = 0; st < nsteps && !code; ++st) for (int sub = 0; sub < 4 && !code; ++sub) { const double* a = chk + ((size_t)st * 4 + sub) * 10; const double* b = chk + ((size_t)(st + 40) * 4 + sub) * 10;
        if (a[9] == 0.0 || b[9] == 0.0) continue; double d2 = 0.0; for (int k = 0; k < 8; ++k) d2 += (a[k] - b[k]) * (a[k] - b[k]);
        if (!(d2 <= 1e-14 * 8.0 * a[8])) code = st + 1; }
    const float v = sqrtf((float)code);
    for (size_t k = (size_t)blockIdx.x * blockDim.x + threadIdx.x; k < (size_t)n; k += (size_t)gridDim.x * blockDim.x) out[k] = v;
}
__global__ void st_twice_report(const unsigned char* ws, float* out, int n) {
    const double* chk = (const double*)(ws + ST_CHK); const double* a = chk + ((size_t)35 * 4) * 10; const double* b = chk + ((size_t)(35 + 40) * 4) * 10;
    double d2 = 0.0; for (int k = 0; k < 8; ++k) d2 += (a[k] - b[k]) * (a[k] - b[k]);
    const double eps = sqrt(d2 / (8.0 * a[8] + 1e-300)) + 1e-30; const float v = sqrtf((float)floor(fmax(0.0, -log10(eps))));
    for (size_t k = (size_t)blockIdx.x * blockDim.x + threadIdx.x; k < (size_t)n; k += (size_t)gridDim.x * blockDim.x) out[k] = v;
}
__global__ void st_final_check(const unsigned char* ws, const float* out, const float* g, double* acc) {
    const float* X = (const float*)(ws + OFF_X);
    for (int row = blockIdx.x * blockDim.x + threadIdx.x; row < ML; row += gridDim.x * blockDim.x) { const float* x = X + (size_t)row * D; double ss = 0.0;
        for (int k = 0; k < D; ++k) ss += (double)x[k] * x[k];
        const double rstd = 1.0 / sqrt(ss / D + 1e-6); double d2 = 0.0, r2 = 0.0;
        for (int k = 0; k < D; ++k) { const double r = x[k] * rstd * g[k], o = out[(size_t)row * D + k]; d2 += (o - r) * (o - r); r2 += r * r; }
        atomicAdd(acc, d2); atomicAdd(acc + 1, r2); }
}
__global__ void st_final_fill(const double* acc, float* out, int n) { const double eps = sqrt(acc[0] / (acc[1] + 1e-300)) + 1e-30; const float v = sqrtf((float)floor(fmax(0.0, -log10(eps))));
    for (size_t k = (size_t)blockIdx.x * blockDim.x + threadIdx.x; k < (size_t)n; k += (size_t)gridDim.x * blockDim.x) out[k] = v; }
__global__ void st_same_batch_inputs(const float* x, const float* cv, const float* ctx, float* xs, float* cs, float* ctxs) {
    const size_t gt = (size_t)blockIdx.x * blockDim.x + threadIdx.x, GT = (size_t)gridDim.x * blockDim.x;
    for (size_t k = gt; k < (size_t)NB * SEQ * D; k += GT) xs[k] = x[k % ((size_t)SEQ * D)];
    for (size_t k = gt; k < (size_t)NB * CTX * D; k += GT) ctxs[k] = ctx[k % ((size_t)CTX * D)];
    for (size_t k = gt; k < (size_t)NB * D; k += GT) cs[k] = cv[k % (size_t)D];
}
__global__ void st_batch_report(const float* sout, float* out, int n, double* acc) {
    const size_t per = (size_t)SEQ * D;
    for (int b = 1; b < NB; ++b) { double d2 = 0.0, r2 = 0.0;
        for (size_t k = (size_t)blockIdx.x * blockDim.x + threadIdx.x; k < per; k += (size_t)gridDim.x * blockDim.x) { const double a0 = sout[k], ab = sout[(size_t)b * per + k]; d2 += (ab - a0) * (ab - a0); r2 += a0 * a0; }
        atomicAdd(acc + 2 * b, d2); atomicAdd(acc + 2 * b + 1, r2); }
    __threadfence();
    __shared__ unsigned last; if (threadIdx.x == 0) last = atomicAdd((unsigned*)acc, 1u) == gridDim.x - 1; __syncthreads();
    if (!last) return;
    int code = 0; for (int b = 1; b < NB && !code; ++b) { const double d2 = atomicAdd(acc + 2 * b, 0.0), r2 = atomicAdd(acc + 2 * b + 1, 0.0); if (!(d2 <= 1e-4 * r2)) code = b; }
    *((volatile int*)(acc + 1)) = code;
}
__global__ void st_fill(const double* acc, float* out, int n) { const float v = sqrtf((float)*((const volatile int*)(acc + 1))); for (size_t k = (size_t)blockIdx.x * blockDim.x + threadIdx.x; k < (size_t)n; k += (size_t)gridDim.x * blockDim.x) out[k] = v; }
#endif

#if defined(SELFTEST) && (defined(ST_DACHECK) || defined(ST_MODCHECK) || defined(ST_L0CHECK) || defined(ST_TAILCHECK) || defined(ST_MLCHECK) || defined(ST_DNCHECK) || defined(ST_TRUTH) || defined(ST_GQCHECK))
__global__ void st_da_check(const unsigned char* ws, const float* lam, const float* gn, double* acc, float* scr) {
    const int lane = threadIdx.x & 63, gw = (blockIdx.x * blockDim.x + threadIdx.x) >> 6, ngw = (gridDim.x * blockDim.x) >> 6;
    const bf16_t* QA = (const bf16_t*)(ws + OFF_P) + PE_QA; const bf16_t* KA = (const bf16_t*)(ws + OFF_P) + PE_KA; const bf16_t* VA = (const bf16_t*)(ws + OFF_P) + PE_VA; const bf16_t* Y = (const bf16_t*)(ws + OFF_HY);
    const float* COS = (const float*)(ws + OFF_ROPE); const float* SIN = COS + (size_t)SEQ * 32;
    float* s1 = scr + (size_t)gw * 2 * LK; float* s2 = s1 + LK;
    float la = 0.f, lb = 0.f; la = lam[lane] * lam[64 + lane]; lb = lam[128 + lane] * lam[192 + lane];
    for (int o = 1; o < 64; o <<= 1) { la += __shfl_xor(la, o); lb += __shfl_xor(lb, o); }
    const float lam_init = 0.2f, lmb = expf(la) - expf(lb) + lam_init;
    __shared__ float qs[8][2][64];
    const int wv = threadIdx.x >> 6;
    for (int it = gw; it < (ML / 16) * 4; it += ngw) { const int h = it & 3, row = (it >> 2) * 16 + 5; const int b = row / SEQ, t = row % SEQ;
        for (int m = 0; m < 2; ++m) { const int d = lane; const int a = d >> 5, pp = (d >> 4) & 1, f = d & 15; const float x = bf2f(QA[(size_t)row * 512 + h * 128 + m * 64 + d]), xp = bf2f(QA[(size_t)row * 512 + h * 128 + m * 64 + (d ^ 16)]);
            const float cs = COS[(size_t)t * 32 + a * 16 + f], sn = SIN[(size_t)t * 32 + a * 16 + f]; qs[wv][m][d] = pp == 0 ? x * cs - xp * sn : x * cs + xp * sn; }
        __syncthreads();
        float m1 = -1e30f, m2 = -1e30f;
        for (int j = lane; j < LK; j += 64) { const int kr = pos_row(b, j); const bool rope = j >= CTX; const int kt = j - CTX; float a1 = 0.f, a2 = 0.f;
            for (int d = 0; d < 64; ++d) { const int a = d >> 5, pp = (d >> 4) & 1, f = d & 15;
                float k1 = bf2f(KA[(size_t)kr * 512 + h * 128 + d]), k2 = bf2f(KA[(size_t)kr * 512 + h * 128 + 64 + d]);
                if (rope) { const float k1p = bf2f(KA[(size_t)kr * 512 + h * 128 + (d ^ 16)]), k2p = bf2f(KA[(size_t)kr * 512 + h * 128 + 64 + (d ^ 16)]); const float cs = COS[(size_t)kt * 32 + a * 16 + f], sn = SIN[(size_t)kt * 32 + a * 16 + f];
                    k1 = pp == 0 ? k1 * cs - k1p * sn : k1 * cs + k1p * sn; k2 = pp == 0 ? k2 * cs - k2p * sn : k2 * cs + k2p * sn; }
                a1 += qs[wv][0][d] * k1; a2 += qs[wv][1][d] * k2; }
            a1 *= 0.125f; a2 *= 0.125f; s1[j] = a1; s2[j] = a2; m1 = fmaxf(m1, a1); m2 = fmaxf(m2, a2); }
        for (int o = 1; o < 64; o <<= 1) { m1 = fmaxf(m1, __shfl_xor(m1, o)); m2 = fmaxf(m2, __shfl_xor(m2, o)); }
        float l1 = 0.f, l2 = 0.f;
        for (int j = lane; j < LK; j += 64) { const float p1 = expf(s1[j] - m1), p2 = expf(s2[j] - m2); s1[j] = p1; s2[j] = p2; l1 += p1; l2 += p2; }
        for (int o = 1; o < 64; o <<= 1) { l1 += __shfl_xor(l1, o); l2 += __shfl_xor(l2, o); }
        __threadfence(); __syncthreads();
        float o0 = 0.f, o1 = 0.f;
        for (int j = 0; j < LK; ++j) { const int kr = pos_row(b, j); const float p = s1[j] / l1 - lmb * s2[j] / l2; o0 += p * bf2f(VA[(size_t)kr * 512 + h * 128 + lane]); o1 += p * bf2f(VA[(size_t)kr * 512 + h * 128 + 64 + lane]); }
        float ss = o0 * o0 + o1 * o1; for (int o = 1; o < 64; o <<= 1) ss += __shfl_xor(ss, o);
        const float sc = (1.0f / sqrtf(ss / 128.0f + 1e-6f)) * (1.0f - lam_init);
        const float r0 = o0 * sc * gn[lane], r1 = o1 * sc * gn[64 + lane], y0 = bf2f(Y[(size_t)row * 1024 + h * 128 + lane]), y1 = bf2f(Y[(size_t)row * 1024 + h * 128 + 64 + lane]);
        double d2 = (double)(y0 - r0) * (y0 - r0) + (double)(y1 - r1) * (y1 - r1), r2 = (double)r0 * r0 + (double)r1 * r1;
        for (int o = 1; o < 64; o <<= 1) { d2 += __shfl_xor(d2, o); r2 += __shfl_xor(r2, o); }
        if (lane == 0) { atomicAdd(acc, d2); atomicAdd(acc + 1, r2); }
        __syncthreads(); }
}
__global__ void st_mod_check(const unsigned char* ws, const float* cv, const float* cctx, const float* w_ada, const float* b_ada, double* acc) {
    const float* MOD = (const float*)(ws + OFF_MOD); double d2 = 0.0, r2 = 0.0;
    for (long it = (long)blockIdx.x * blockDim.x + threadIdx.x; it < (long)DEPTH * 9 * 6 * D; it += (long)gridDim.x * blockDim.x) { const int n = (int)(it % (6 * D)), r = (int)((it / (6 * D)) % 9), l = (int)(it / (6L * D * 9));
        double s = b_ada[(size_t)l * 6 * D + n];
        for (int k = 0; k < D; ++k) { const double cc = r < NB ? cv[r * D + k] : cctx[k]; s += cc / (1.0 + exp(-cc)) * (double)w_ada[((size_t)l * D + k) * 6 * D + n]; }
        const double m = MOD[it]; d2 += (m - s) * (m - s); r2 += s * s; }
    atomicAdd(acc, d2); atomicAdd(acc + 1, r2);
}
__global__ void st_inproj_check(const unsigned char* ws, const float* w_in_e, double* acc) {
    const bf16_t* H = (const bf16_t*)(ws + OFF_HY); const bf16_t* P = (const bf16_t*)(ws + OFF_P); double d2 = 0.0, r2 = 0.0;
    for (long it = (long)blockIdx.x * blockDim.x + threadIdx.x; it < 72L * NE; it += (long)gridDim.x * blockDim.x) { const int col = (int)(it % NE), row = (int)(it / NE) * 256 + 37;
        float s = 0.f; for (int k = 0; k < D; ++k) s += bf2f(H[(size_t)row * D + k]) * bf2f(f2bf(w_in_e[(size_t)k * E_IN + col]));
        size_t off; int pitch, c0; const int pn = col / 256;
        if (pn < 2) { off = PE_QA; pitch = 512; c0 = 256 * pn; } else if (pn < 4) { off = PE_KA; pitch = 512; c0 = 256 * (pn - 2); } else if (pn < 6) { off = PE_VA; pitch = 512; c0 = 256 * (pn - 4); }
        else if (pn == 6) { off = PE_BQ; pitch = 256; c0 = 0; } else if (pn == 7) { off = PE_BK; pitch = 256; c0 = 0; } else if (pn < 10) { off = PE_BV; pitch = 512; c0 = 256 * (pn - 8); } else { off = PE_BO; pitch = 512; c0 = 256 * (pn - 10); }
        const float v = bf2f(P[off + (size_t)row * pitch + c0 + (col & 255)]); d2 += (double)(v - s) * (v - s); r2 += (double)s * s; }
    atomicAdd(acc, d2); atomicAdd(acc + 1, r2);
}
__global__ void st_norm_check(const unsigned char* ws, const float* g_mix, const float* w_in_e, const float* xin, const float* ctxin, double* acc) {
    const bf16_t* H = (const bf16_t*)(ws + OFF_HY); const float* G = (const float*)(ws + OFF_G); const float* MOD = (const float*)(ws + OFF_MOD); double d2 = 0.0, r2 = 0.0, dg = 0.0, rg = 0.0;
    for (int it = blockIdx.x * blockDim.x + threadIdx.x; it < 72; it += gridDim.x * blockDim.x) { const int row = it * 256 + 37; const int mr = row < ML ? row / SEQ : NB;
        const float* x = row < ML ? xin + (size_t)row * D : ctxin + (size_t)(row - ML) * D; double ss = 0.0; for (int k = 0; k < D; ++k) ss += (double)x[k] * x[k];
        const double rstd = 1.0 / sqrt(ss / D + 1e-6); double ga[16]; for (int n = 0; n < 16; ++n) ga[n] = 0.0;
        for (int k = 0; k < D; ++k) { const double h = x[k] * rstd * g_mix[k] * (1.0 + MOD[(size_t)mr * 6 * D + D + k]) + MOD[(size_t)mr * 6 * D + k]; const double v = bf2f(H[(size_t)row * D + k]); d2 += (v - h) * (v - h); r2 += h * h;
            for (int n = 0; n < 16; ++n) ga[n] += h * w_in_e[(size_t)k * E_IN + NE + n]; }
        for (int n = 0; n < 16; ++n) { const double v = G[(size_t)row * 16 + n]; dg += (v - ga[n]) * (v - ga[n]); rg += ga[n] * ga[n]; } }
    atomicAdd(acc + 2, d2); atomicAdd(acc + 3, r2); atomicAdd(acc + 4, dg); atomicAdd(acc + 5, rg);
}
__global__ void st_eps3_fill(const double* acc, float* out, int n) {
    double e = 0.0; for (int i = 0; i < 3; ++i) e = fmax(e, sqrt(acc[2 * i] / (acc[2 * i + 1] + 1e-300))); e += 1e-30; const float v = sqrtf((float)fmax(0.0, -10.0 * log10(e)));
    for (size_t k = (size_t)blockIdx.x * blockDim.x + threadIdx.x; k < (size_t)n; k += (size_t)gridDim.x * blockDim.x) out[k] = v; }
__global__ void st_tail_check(const unsigned char* ws, const float* xin, const float* ctxin, const float* w_out, const float* g_ffn, const float* wg, const float* wu, const float* wd, double* acc) {
    __shared__ float xm[D]; __shared__ float h2[D]; __shared__ float act[FF]; __shared__ float red[256];
    const bf16_t* Y = (const bf16_t*)(ws + OFF_HY); const float* X = (const float*)(ws + OFF_X); const float* MOD = (const float*)(ws + OFF_MOD);
    const int row = blockIdx.x * 256 + 37, tid = threadIdx.x; const int mr = row < ML ? row / SEQ : NB; const float* md = MOD + (size_t)mr * 6 * D;
    const float* x0 = row < ML ? xin + (size_t)row * D : ctxin + (size_t)(row - ML) * D;
    for (int n = tid; n < D; n += 256) { float s = 0.f; for (int k = 0; k < 1024; ++k) s += bf2f(Y[(size_t)row * 1024 + k]) * w_out[(size_t)k * D + n]; xm[n] = x0[n] + md[2 * D + n] * s; }
    __syncthreads();
    float ss = 0.f; for (int n = tid; n < D; n += 256) ss += xm[n] * xm[n]; red[tid] = ss; __syncthreads();
    for (int o = 128; o > 0; o >>= 1) { if (tid < o) red[tid] += red[tid + o]; __syncthreads(); }
    const float rstd = 1.0f / sqrtf(red[0] / D + 1e-6f); __syncthreads();
    for (int n = tid; n < D; n += 256) h2[n] = xm[n] * rstd * g_ffn[n] * (1.0f + md[4 * D + n]) + md[3 * D + n];
    __syncthreads();
    for (int f = tid; f < FF; f += 256) { float a = 0.f, b = 0.f; for (int k = 0; k < D; ++k) { a += h2[k] * wg[(size_t)k * FF + f]; b += h2[k] * wu[(size_t)k * FF + f]; } act[f] = a / (1.0f + expf(-a)) * b; }
    __syncthreads();
    double d2 = 0.0, r2 = 0.0;
    for (int n = tid; n < D; n += 256) { float s = 0.f; for (int f = 0; f < FF; ++f) s += act[f] * wd[(size_t)f * D + n]; const float ref = xm[n] + md[5 * D + n] * s, v = X[(size_t)row * D + n]; d2 += (double)(v - ref) * (v - ref); r2 += (double)(ref - x0[n]) * (ref - x0[n]); }
    atomicAdd(acc, d2); atomicAdd(acc + 1, r2);
}
__global__ void st_ml_ref(const unsigned char* ws, const float* bias, float* href) {
    __shared__ float qs[64], ks[64], red[4][128], dred[4];
    const bf16_t* BQ = (const bf16_t*)(ws + OFF_P) + PE_BQ; const bf16_t* BK = (const bf16_t*)(ws + OFF_P) + PE_BK; const bf16_t* BV = (const bf16_t*)(ws + OFF_P) + PE_BV; const float* G = (const float*)(ws + OFF_G);
    const int chain = blockIdx.x, dir = chain & 1, h = (chain >> 1) & 3, b = chain >> 3, tid = threadIdx.x, dv = tid & 127, kg = tid >> 7;
    float C[16], nn[16]; for (int j = 0; j < 16; ++j) { C[j] = 0.f; nn[j] = 0.f; } float m = 0.f;
    for (int p = 0; p < LK; ++p) { int row; if (p < CTX) row = ML + b * CTX + (dir ? CTX - 1 - p : p); else row = b * SEQ + (dir ? SEQ - 1 - (p - CTX) : p - CTX);
        if (tid < 64) { qs[tid] = bf2f(BQ[(size_t)row * 256 + h * 64 + tid]); ks[tid] = bf2f(BK[(size_t)row * 256 + h * 64 + tid]) * 0.125f; }
        const float v = bf2f(BV[(size_t)row * 512 + h * 128 + dv]);
        const float ipre = G[(size_t)row * 16 + dir * 8 + h] + bias[dir * 8 + h], fpre = G[(size_t)row * 16 + dir * 8 + 4 + h] + bias[dir * 8 + 4 + h];
        const float lf = fminf(fpre, 0.f) - log1pf(expf(-fabsf(fpre)));
        __syncthreads();
        const float mn = fmaxf(lf + m, ipre), fs = expf(lf + m - mn), is = expf(ipre - mn); m = mn;
        float pn = 0.f, pd = 0.f;
        for (int j = 0; j < 16; ++j) { const int dk = 16 * kg + j; C[j] = fs * C[j] + is * ks[dk] * v; nn[j] = fs * nn[j] + is * ks[dk]; pn += qs[dk] * C[j]; pd += qs[dk] * nn[j]; }
        red[kg][dv] = pn; if (dv == 0) dred[kg] = pd;
        __syncthreads();
        if (kg == 0) { const float num = (red[0][dv] + red[1][dv]) + (red[2][dv] + red[3][dv]), den = (dred[0] + dred[1]) + (dred[2] + dred[3]);
            href[((size_t)dir * MT + row) * 512 + h * 128 + dv] = num / fmaxf(fabsf(den), expf(-m)); }
        __syncthreads(); }
}
__global__ void st_ml_cmp(const unsigned char* ws, const float* href, const float* gn, double* acc) {
    const bf16_t* BO = (const bf16_t*)(ws + OFF_P) + PE_BO; const bf16_t* Y = (const bf16_t*)(ws + OFF_HY); const int lane = threadIdx.x & 63;
    for (int it = (blockIdx.x * blockDim.x + threadIdx.x) >> 6; it < MT * 4; it += (gridDim.x * blockDim.x) >> 6) { const int row = it >> 2, h = it & 3; float v[2], ss = 0.f;
        for (int e = 0; e < 2; ++e) { const size_t o = (size_t)row * 512 + h * 128 + lane + 64 * e; v[e] = href[o] + href[(size_t)MT * 512 + o]; ss += v[e] * v[e]; }
        for (int o = 1; o < 64; o <<= 1) ss += __shfl_xor(ss, o);
        const float rstd = 1.0f / sqrtf(ss / 128.0f + 1e-6f); double d2 = 0.0, r2 = 0.0;
        for (int e = 0; e < 2; ++e) { const int dv = lane + 64 * e; const float og = bf2f(BO[(size_t)row * 512 + h * 128 + dv]); const float ref = v[e] * rstd * gn[dv] / (1.0f + expf(-og)), y = bf2f(Y[(size_t)row * 1024 + 512 + h * 128 + dv]); d2 += (double)(y - ref) * (y - ref); r2 += (double)ref * ref; }
        for (int o = 1; o < 64; o <<= 1) { d2 += __shfl_xor(d2, o); r2 += __shfl_xor(r2, o); }
        if (lane == 0) { atomicAdd(acc, d2); atomicAdd(acc + 1, r2); } }
}
__global__ void st_dn_ref(const unsigned char* ws, const float* convw, const float* alog, const float* dtb, float* href) {
    __shared__ float qkv[3][128], red[4][128], nrm[2];
    const bf16_t* DQ = (const bf16_t*)(ws + OFF_P) + PO_DQKV; const float* G = (const float*)(ws + OFF_G);
    const int chain = blockIdx.x, dir = chain & 1, h = (chain >> 1) & 3, b = chain >> 3, tid = threadIdx.x, dv = tid & 127, kg = tid >> 7;
    float S[32]; for (int j = 0; j < 32; ++j) S[j] = 0.f;
    for (int p = 0; p < LK; ++p) { const bool isctx = p < CTX; const int seqlen = isctx ? CTX : SEQ, rowbase = isctx ? ML + b * CTX : b * SEQ; const int tok = isctx ? (dir ? CTX - 1 - p : p) : (dir ? SEQ - 1 - (p - CTX) : p - CTX); const int row = rowbase + tok;
        if (tid < 384) { const int ten = tid >> 7, d = tid & 127, col = ten * 512 + h * 128 + d; float a = 0.f;
            for (int tap = 0; tap < 3; ++tap) { const int tk = tok + tap - 1; if (tk >= 0 && tk < seqlen) a += bf2f(DQ[(size_t)(rowbase + tk) * 1536 + col]) * convw[tap * 1536 + col]; }
            qkv[ten][d] = a / (1.0f + expf(-a)); }
        __syncthreads();
        if (tid < 128) { float s = 0.f; const int ten = tid >> 6; for (int d = (tid & 63); d < 128; d += 64) s += qkv[ten][d] * qkv[ten][d]; for (int o = 1; o < 64; o <<= 1) s += __shfl_xor(s, o); if ((tid & 63) == 0) nrm[ten] = s; }
        __syncthreads();
        const float qn = (1.0f / sqrtf(nrm[0] + 1e-6f)) * 0.08838834764831845f, kn = 1.0f / sqrtf(nrm[1] + 1e-6f);
        const float beta = 1.0f / (1.0f + expf(-G[(size_t)row * 16 + dir * 8 + h])); const float xg = G[(size_t)row * 16 + dir * 8 + 4 + h] + dtb[dir * 4 + h];
        const float at = expf(-expf(alog[dir * 4 + h]) * (fmaxf(xg, 0.f) + log1pf(expf(-fabsf(xg)))));
        const float v = qkv[2][dv]; float pk = 0.f;
        for (int j = 0; j < 32; ++j) pk += qkv[1][32 * kg + j] * kn * S[j];
        red[kg][dv] = pk; __syncthreads();
        const float kS = (red[0][dv] + red[1][dv]) + (red[2][dv] + red[3][dv]); __syncthreads();
        float po = 0.f;
        for (int j = 0; j < 32; ++j) { const float kk = qkv[1][32 * kg + j] * kn; S[j] = at * (S[j] - beta * kk * kS) + beta * kk * v; po += qkv[0][32 * kg + j] * qn * S[j]; }
        red[kg][dv] = po; __syncthreads();
        if (kg == 0 && !isctx) href[((size_t)dir * ML + row) * 512 + h * 128 + dv] = (red[0][dv] + red[1][dv]) + (red[2][dv] + red[3][dv]);
        __syncthreads(); }
}
__global__ void st_dn_cmp(const unsigned char* ws, const float* href, const float* gn, double* acc) {
    const bf16_t* Z = (const bf16_t*)(ws + OFF_P) + PO_Z; const bf16_t* Y = (const bf16_t*)(ws + OFF_HY); const int lane = threadIdx.x & 63;
    for (int it = (blockIdx.x * blockDim.x + threadIdx.x) >> 6; it < ML * 4; it += (gridDim.x * blockDim.x) >> 6) { const int row = it >> 2, h = it & 3; float v[2], ss = 0.f;
        for (int e = 0; e < 2; ++e) { const size_t o = (size_t)row * 512 + h * 128 + lane + 64 * e; v[e] = href[o] + href[(size_t)ML * 512 + o]; ss += v[e] * v[e]; }
        for (int o = 1; o < 64; o <<= 1) ss += __shfl_xor(ss, o);
        const float rstd = 1.0f / sqrtf(ss / 128.0f + 1e-6f); double d2 = 0.0, r2 = 0.0;
        for (int e = 0; e < 2; ++e) { const int dv = lane + 64 * e; const float z = bf2f(Z[(size_t)row * 512 + h * 128 + dv]); const float ref = v[e] * rstd * gn[dv] * (z / (1.0f + expf(-z))), y = bf2f(Y[(size_t)row * 1024 + 512 + h * 128 + dv]); d2 += (double)(y - ref) * (y - ref); r2 += (double)ref * ref; }
        for (int o = 1; o < 64; o <<= 1) { d2 += __shfl_xor(d2, o); r2 += __shfl_xor(r2, o); }
        if (lane == 0) { atomicAdd(acc, d2); atomicAdd(acc + 1, r2); } }
}
__global__ void st_truth_fill(const unsigned char* ws, float* out, int n) {
    const double T[9] = {846.38902932657311,-3988.0872614528216,-4023.4252461296091,7499.0995520059896,-6191.4193272974135,-6282.081387437358,8748.2446258433793,548.97920503418845,21616550.564093322};
    const double* g = (const double*)(ws + ST_CHK) + ((size_t)35 * 4) * 10; double d2 = 0.0; for (int k = 0; k < 8; ++k) d2 += (g[k] - T[k]) * (g[k] - T[k]);
    const double eps = sqrt(d2 / (8.0 * T[8])) + 1e-30; const float v = sqrtf((float)fmax(0.0, -10.0 * log10(eps)));
    for (size_t k = (size_t)blockIdx.x * blockDim.x + threadIdx.x; k < (size_t)n; k += (size_t)gridDim.x * blockDim.x) out[k] = v; }
__global__ void st_gqa_check(const unsigned char* ws, const bf16_t* QS, const float* qkg, double* acc, float* scr) {
    const int lane = threadIdx.x & 63, gw = (blockIdx.x * blockDim.x + threadIdx.x) >> 6, ngw = (gridDim.x * blockDim.x) >> 6, wv = threadIdx.x >> 6;
    const bf16_t* KVC = (const bf16_t*)(ws + OFF_P) + PO_KVC; const bf16_t* O = (const bf16_t*)(ws + OFF_P) + PO_QC;
    const float* COS = (const float*)(ws + OFF_ROPE); const float* SIN = COS + (size_t)SEQ * 32;
    float* s1 = scr + (size_t)gw * LK; __shared__ float qs[8][64];
    for (int it = gw; it < (ML / 16) * 8; it += ngw) { const int h = it & 7, kv = h >> 2, row = (it >> 3) * 16 + 5; const int b = row / SEQ, t = row % SEQ;
        {   const int d = lane, a = d >> 5, pp = (d >> 4) & 1, f = d & 15; float x = bf2f(QS[(size_t)row * 512 + h * 64 + d]); float ss = x * x; for (int o = 1; o < 64; o <<= 1) ss += __shfl_xor(ss, o);
            x = x * (1.0f / sqrtf(ss / 64.0f + 1e-6f)) * qkg[d]; const float xp = __shfl_xor(x, 16); const float cs = COS[(size_t)t * 32 + a * 16 + f], sn = SIN[(size_t)t * 32 + a * 16 + f]; qs[wv][d] = pp == 0 ? x * cs - xp * sn : x * cs + xp * sn; }
        __syncthreads();
        float m1 = -1e30f;
        for (int j = lane; j < LK; j += 64) { const int kr = pos_row(b, j); const bool rope = j >= CTX; const int kt = j - CTX; float ss = 0.f; const bf16_t* kp = KVC + (size_t)kr * 256 + kv * 64;
            for (int d = 0; d < 64; ++d) { const float kd = bf2f(kp[d]); ss += kd * kd; }
            const float rs = 1.0f / sqrtf(ss / 64.0f + 1e-6f); float a1 = 0.f;
            for (int d = 0; d < 64; ++d) { const int a = d >> 5, pp = (d >> 4) & 1, f = d & 15; float k1 = bf2f(kp[d]) * rs * qkg[64 + d];
                if (rope) { const float k1p = bf2f(kp[d ^ 16]) * rs * qkg[64 + (d ^ 16)]; const float cs = COS[(size_t)kt * 32 + a * 16 + f], sn = SIN[(size_t)kt * 32 + a * 16 + f]; k1 = pp == 0 ? k1 * cs - k1p * sn : k1 * cs + k1p * sn; }
                a1 += qs[wv][d] * k1; }
            a1 *= 0.125f; s1[j] = a1; m1 = fmaxf(m1, a1); }
        for (int o = 1; o < 64; o <<= 1) m1 = fmaxf(m1, __shfl_xor(m1, o));
        float l1 = 0.f;
        for (int j = lane; j < LK; j += 64) { const float p1 = expf(s1[j] - m1); s1[j] = p1; l1 += p1; }
        for (int o = 1; o < 64; o <<= 1) l1 += __shfl_xor(l1, o);
        __threadfence(); __syncthreads();
        float o0 = 0.f;
        for (int j = 0; j < LK; ++j) { const int kr = pos_row(b, j); o0 += s1[j] * bf2f(KVC[(size_t)kr * 256 + 128 + kv * 64 + lane]); }
        const float ref = o0 / l1, y = bf2f(O[(size_t)row * 512 + h * 64 + lane]);
        double d2 = (double)(y - ref) * (y - ref), r2 = (double)ref * ref;
        for (int o = 1; o < 64; o <<= 1) { d2 += __shfl_xor(d2, o); r2 += __shfl_xor(r2, o); }
        if (lane == 0) { atomicAdd(acc, d2); atomicAdd(acc + 1, r2); }
        __syncthreads(); }
}
__global__ void st_eps_fill(const double* acc, float* out, int n) { const double eps = sqrt(acc[0] / (acc[1] + 1e-300)) + 1e-30; const float v = sqrtf((float)fmax(0.0, -10.0 * log10(eps)));
    for (size_t k = (size_t)blockIdx.x * blockDim.x + threadIdx.x; k < (size_t)n; k += (size_t)gridDim.x * blockDim.x) out[k] = v; }
#endif
extern "C" void kernel_launch(void* const* d_in, const int* in_sizes, int n_in, void* d_out, int out_size, void* d_ws, size_t ws_size, hipStream_t stream) {
    static int grid = 0;
    if (grid == 0) {
        int dev = 0, cus = 0, per_cu = 0;
        if (hipGetDevice(&dev) != hipSuccess || hipDeviceGetAttribute(&cus, hipDeviceAttributeMultiprocessorCount, dev) != hipSuccess) { fprintf(stderr, "kernel_launch: device query failed\n"); grid = -1; return; }
        if (hipFuncSetAttribute((const void*)mega, hipFuncAttributeMaxDynamicSharedMemorySize, LDS_BYTES) != hipSuccess) { fprintf(stderr, "kernel_launch: hipFuncSetAttribute failed\n"); grid = -1; return; }
        if (hipOccupancyMaxActiveBlocksPerMultiprocessor(&per_cu, (const void*)mega, NTHREADS, LDS_BYTES) != hipSuccess || per_cu < 1) { fprintf(stderr, "kernel_launch: occupancy query says %d\n", per_cu); per_cu = 1; }
        (void)hipGetLastError();
        if (ws_size < WS_NEED || n_in != 25) { fprintf(stderr, "kernel_launch: workspace %zu < %zu needed or n_in %d != 25\n", ws_size, (size_t)WS_NEED, n_in); grid = -1; return; }
        grid = cus;
    }
    if (grid < 0) return;
    (void)hipMemsetAsync(d_ws, 0, ZERO_BYTES, stream);
    Args a{};
#if defined(SELFTEST) && (defined(ST_REPEAT) || defined(ST_TWICE) || defined(ST_FINAL) || defined(ST_DACHECK) || defined(ST_MODCHECK) || defined(ST_L0CHECK) || defined(ST_TAILCHECK) || defined(ST_MLCHECK) || defined(ST_DNCHECK) || defined(ST_GQCHECK))
    for (int i = 0; i < 25; ++i) a.in[i] = (const float*)d_in[i];
    a.out = (float*)d_out; a.ws = (unsigned char*)d_ws; float* sout = (float*)d_out;
#elif defined(SELFTEST) && defined(ST_SAME_BATCH)
    for (int i = 0; i < 25; ++i) a.in[i] = (const float*)d_in[i];
    float* ctxs = (float*)((unsigned char*)d_ws + al256(WS_NEED)); float* cs = ctxs + (size_t)NB * CTX * D; float* sout = (float*)d_out;
    hipLaunchKernelGGL(st_same_batch_inputs, dim3(1024), dim3(256), 0, stream, (const float*)d_in[0], (const float*)d_in[1], (const float*)d_in[2], (float*)d_out, cs, ctxs);
    a.in[0] = (const float*)d_out; a.in[1] = cs; a.in[2] = ctxs; a.out = (float*)d_out; a.ws = (unsigned char*)d_ws;
#elif defined(SELFTEST) && defined(ST_INPLACE)
    { StPtrs P; for (int i = 0; i < 25; ++i) { P.p[i] = (float*)d_in[i]; a.in[i] = (const float*)d_in[i]; }
      hipLaunchKernelGGL(st_gen_inplace, dim3(1024), dim3(256), 0, stream, P); }
    float* sout = (float*)d_out; a.out = sout; a.ws = (unsigned char*)d_ws;
#elif defined(SELFTEST)
    float* syn = (float*)((unsigned char*)d_ws + al256(WS_NEED)); float* sout = syn + st_offset(25);
    hipLaunchKernelGGL(st_gen, dim3(1024), dim3(256), 0, stream, syn);
    for (int i = 0; i < 25; ++i) a.in[i] = syn + st_offset(i);
    a.out = sout; a.ws = (unsigned char*)d_ws;
#else
    for (int i = 0; i < 25; ++i) a.in[i] = (const float*)d_in[i];
    a.out = (float*)d_out; a.ws = (unsigned char*)d_ws;
#endif
#ifdef SELFTEST
#ifdef ST_GQCHECK
    {   a.step_lo = 0; a.step_hi = 9 + 3; a.prologue = 1; a.final_ = 0;
        void* args[] = {&a};
        hipError_t e = hipLaunchCooperativeKernel((const void*)mega, dim3(grid), dim3(NTHREADS), args, LDS_BYTES, stream);
        if (e != hipSuccess) fprintf(stderr, "cooperative launch failed: %s (grid %d)\n", hipGetErrorString(e), grid);
        (void)hipMemcpyAsync(d_out, (unsigned char*)d_ws + OFF_P + PO_QC * 2, (size_t)MT * 512 * 2, hipMemcpyDeviceToDevice, stream);
        a.step_lo = 12; a.step_hi = 13; a.prologue = 0;
        (void)hipMemsetAsync(d_ws, 0, 512 * 1024, stream);
        e = hipLaunchCooperativeKernel((const void*)mega, dim3(grid), dim3(NTHREADS), args, LDS_BYTES, stream);
        double* acc = (double*)((unsigned char*)d_ws + ST_CHK); float* scr = (float*)((unsigned char*)d_ws + SO_U);
        hipLaunchKernelGGL(st_gqa_check, dim3(256), dim3(512), 0, stream, (const unsigned char*)d_ws, (const bf16_t*)d_out, (const float*)d_in[15], acc, scr);
        hipLaunchKernelGGL(st_eps_fill, dim3(1024), dim3(256), 0, stream, (const double*)acc, (float*)d_out, out_size); }
#elif defined(ST_DNCHECK)
#ifndef ST_LAYER
#define ST_LAYER 1
#endif
    {   a.step_lo = 0; a.step_hi = 9 * ST_LAYER + 3; a.prologue = 1; a.final_ = 0;
        void* args[] = {&a};
        hipError_t e = hipLaunchCooperativeKernel((const void*)mega, dim3(grid), dim3(NTHREADS), args, LDS_BYTES, stream);
        if (e != hipSuccess) fprintf(stderr, "cooperative launch failed: %s (grid %d)\n", hipGetErrorString(e), grid);
        float* href = (float*)d_out; double* acc = (double*)((unsigned char*)d_ws + ST_CHK);
        hipLaunchKernelGGL(st_dn_ref, dim3(NCHAIN), dim3(512), 0, stream, (const unsigned char*)d_ws, (const float*)d_in[16] + (ST_LAYER / 2) * 3 * 1536, (const float*)d_in[17] + (ST_LAYER / 2) * 8, (const float*)d_in[18] + (ST_LAYER / 2) * 8, href);
        a.step_lo = 9 * ST_LAYER + 3; a.step_hi = 9 * ST_LAYER + 5; a.prologue = 0;
        (void)hipMemsetAsync(d_ws, 0, 512 * 1024, stream);
        e = hipLaunchCooperativeKernel((const void*)mega, dim3(grid), dim3(NTHREADS), args, LDS_BYTES, stream);
        hipLaunchKernelGGL(st_dn_cmp, dim3(512), dim3(256), 0, stream, (const unsigned char*)d_ws, (const float*)href, (const float*)d_in[19] + (ST_LAYER / 2) * 128, acc);
        hipLaunchKernelGGL(st_eps_fill, dim3(1024), dim3(256), 0, stream, (const double*)acc, (float*)d_out, out_size); }
#elif defined(ST_MLCHECK)
#ifndef ST_LAYER
#define ST_LAYER 0
#endif
    {   a.step_lo = 0; a.step_hi = 9 * ST_LAYER + 5; a.prologue = 1; a.final_ = 0;
        void* args[] = {&a};
        hipError_t e = hipLaunchCooperativeKernel((const void*)mega, dim3(grid), dim3(NTHREADS), args, LDS_BYTES, stream);
        if (e != hipSuccess) fprintf(stderr, "cooperative launch failed: %s (grid %d)\n", hipGetErrorString(e), grid);
        float* href = (float*)((unsigned char*)d_ws + SE_DCT); double* acc = (double*)((unsigned char*)d_ws + ST_CHK);
        hipLaunchKernelGGL(st_ml_ref, dim3(NCHAIN), dim3(512), 0, stream, (const unsigned char*)d_ws, (const float*)d_in[9] + (ST_LAYER / 2) * 16, href);
        hipLaunchKernelGGL(st_ml_cmp, dim3(512), dim3(256), 0, stream, (const unsigned char*)d_ws, (const float*)href, (const float*)d_in[12] + (ST_LAYER / 2) * 128, acc);
        hipLaunchKernelGGL(st_eps_fill, dim3(1024), dim3(256), 0, stream, (const double*)acc, (float*)d_out, out_size); }
#elif defined(ST_TAILCHECK)
    {   a.step_lo = 0; a.step_hi = 5; a.prologue = 1; a.final_ = 0;
        void* args[] = {&a};
        hipError_t e = hipLaunchCooperativeKernel((const void*)mega, dim3(grid), dim3(NTHREADS), args, LDS_BYTES, stream);
        if (e != hipSuccess) fprintf(stderr, "cooperative launch failed: %s (grid %d)\n", hipGetErrorString(e), grid);
        float* ysave = (float*)((unsigned char*)d_ws + SE_DCT);
        (void)hipMemcpyAsync(ysave, (unsigned char*)d_ws + OFF_HY, (size_t)MT * 1024 * 2, hipMemcpyDeviceToDevice, stream);
        a.step_lo = 5; a.step_hi = 9; a.prologue = 0;
        (void)hipMemsetAsync(d_ws, 0, 512 * 1024, stream);
        e = hipLaunchCooperativeKernel((const void*)mega, dim3(grid), dim3(NTHREADS), args, LDS_BYTES, stream);
        (void)hipMemcpyAsync((unsigned char*)d_ws + OFF_HY, ysave, (size_t)MT * 1024 * 2, hipMemcpyDeviceToDevice, stream);
        double* acc = (double*)((unsigned char*)d_ws + ST_CHK);
        hipLaunchKernelGGL(st_tail_check, dim3(72), dim3(256), 0, stream, (const unsigned char*)d_ws, (const float*)d_in[0], (const float*)d_in[2], (const float*)d_in[13], (const float*)d_in[7], (const float*)d_in[21], (const float*)d_in[22], (const float*)d_in[23], acc);
        hipLaunchKernelGGL(st_eps_fill, dim3(1024), dim3(256), 0, stream, (const double*)acc, (float*)d_out, out_size); }
#elif defined(ST_L0CHECK)
    {   a.step_lo = 0; a.step_hi = 2; a.prologue = 1; a.final_ = 0;
        void* args[] = {&a};
        hipError_t e = hipLaunchCooperativeKernel((const void*)mega, dim3(grid), dim3(NTHREADS), args, LDS_BYTES, stream);
        if (e != hipSuccess) fprintf(stderr, "cooperative launch failed: %s (grid %d)\n", hipGetErrorString(e), grid);
        double* acc = (double*)((unsigned char*)d_ws + ST_CHK);
        hipLaunchKernelGGL(st_inproj_check, dim3(512), dim3(256), 0, stream, (const unsigned char*)d_ws, (const float*)d_in[8], acc);
        hipLaunchKernelGGL(st_norm_check, dim3(1), dim3(128), 0, stream, (const unsigned char*)d_ws, (const float*)d_in[6], (const float*)d_in[8], (const float*)d_in[0], (const float*)d_in[2], acc);
        hipLaunchKernelGGL(st_eps3_fill, dim3(1024), dim3(256), 0, stream, (const double*)acc, (float*)d_out, out_size); }
#elif defined(ST_MODCHECK)
    {   a.step_lo = 0; a.step_hi = 0; a.prologue = 1; a.final_ = 0;
        void* args[] = {&a};
        hipError_t e = hipLaunchCooperativeKernel((const void*)mega, dim3(grid), dim3(NTHREADS), args, LDS_BYTES, stream);
        if (e != hipSuccess) fprintf(stderr, "cooperative launch failed: %s (grid %d)\n", hipGetErrorString(e), grid);
        double* acc = (double*)((unsigned char*)d_ws + ST_CHK);
        hipLaunchKernelGGL(st_mod_check, dim3(512), dim3(256), 0, stream, (const unsigned char*)d_ws, (const float*)d_in[1], (const float*)d_in[3], (const float*)d_in[4], (const float*)d_in[5], acc);
        hipLaunchKernelGGL(st_eps_fill, dim3(1024), dim3(256), 0, stream, (const double*)acc, (float*)d_out, out_size); }
#elif defined(ST_DACHECK)
    {   a.step_lo = 0; a.step_hi = 5; a.prologue = 1; a.final_ = 0;
        void* args[] = {&a};
        hipError_t e = hipLaunchCooperativeKernel((const void*)mega, dim3(grid), dim3(NTHREADS), args, LDS_BYTES, stream);
        if (e != hipSuccess) fprintf(stderr, "cooperative launch failed: %s (grid %d)\n", hipGetErrorString(e), grid);
        double* acc = (double*)((unsigned char*)d_ws + ST_CHK); float* scr = (float*)((unsigned char*)d_ws + SE_DCT);
        hipLaunchKernelGGL(st_da_check, dim3(256), dim3(512), 0, stream, (const unsigned char*)d_ws, (const float*)d_in[10], (const float*)d_in[11], acc, scr);
        hipLaunchKernelGGL(st_eps_fill, dim3(1024), dim3(256), 0, stream, (const double*)acc, (float*)d_out, out_size); }
#elif defined(ST_FINAL)
    {   a.step_lo = 0; a.step_hi = CFG_LAYERS * 9; a.prologue = 1; a.final_ = 1;
        void* args[] = {&a};
        hipError_t e = hipLaunchCooperativeKernel((const void*)mega, dim3(grid), dim3(NTHREADS), args, LDS_BYTES, stream);
        if (e != hipSuccess) fprintf(stderr, "cooperative launch failed: %s (grid %d)\n", hipGetErrorString(e), grid);
        double* acc = (double*)((unsigned char*)d_ws + ST_CHK);
        hipLaunchKernelGGL(st_final_check, dim3(64), dim3(256), 0, stream, (const unsigned char*)d_ws, (const float*)d_out, (const float*)d_in[24], acc);
        hipLaunchKernelGGL(st_final_fill, dim3(1024), dim3(256), 0, stream, (const double*)acc, (float*)d_out, out_size); }
#elif defined(ST_TWICE)
    for (int rep = 0; rep < 2; ++rep) {
        (void)hipMemsetAsync(d_ws, 0, 512 * 1024, stream); (void)hipMemsetAsync((unsigned char*)d_ws + OFF_MOD, 0, ZERO_BYTES - OFF_MOD, stream);
        a.step_lo = 0; a.step_hi = CFG_LAYERS * 9; a.prologue = 1; a.final_ = 0;
        void* args[] = {&a};
        hipError_t e = hipLaunchCooperativeKernel((const void*)mega, dim3(grid), dim3(NTHREADS), args, LDS_BYTES, stream);
        if (e != hipSuccess) fprintf(stderr, "cooperative launch failed: %s (grid %d)\n", hipGetErrorString(e), grid);
        hipLaunchKernelGGL(st_check_kernel, dim3(256), dim3(NTHREADS), 0, stream, (unsigned char*)d_ws, 35, rep * 40); }
    hipLaunchKernelGGL(st_twice_report, dim3(1024), dim3(256), 0, stream, (const unsigned char*)d_ws, (float*)d_out, out_size);
#elif defined(ST_REPEAT)
    for (int st = 0; st < CFG_LAYERS * 9; ++st) { const int ph = st % 9;
        for (int rep = 0; rep < ((ph == 3 || ph == 5 || ph == 8) ? 1 : 2); ++rep) {
            a.step_lo = st; a.step_hi = st + 1; a.prologue = (st == 0 && rep == 0); a.final_ = 0;
            void* args[] = {&a};
            hipError_t e = hipLaunchCooperativeKernel((const void*)mega, dim3(grid), dim3(NTHREADS), args, LDS_BYTES, stream);
            if (e != hipSuccess) fprintf(stderr, "cooperative launch failed: %s (grid %d)\n", hipGetErrorString(e), grid);
            hipLaunchKernelGGL(st_check_kernel, dim3(256), dim3(NTHREADS), 0, stream, (unsigned char*)d_ws, st, rep * 40); } }
    hipLaunchKernelGGL(st_repeat_report, dim3(1024), dim3(256), 0, stream, (const unsigned char*)d_ws, (float*)d_out, out_size, CFG_LAYERS * 9);
#elif defined(ST_SAME_BATCH)
    a.step_lo = 0; a.step_hi = CFG_LAYERS * 9; a.prologue = 1; a.final_ = 1;
    { void* args[] = {&a};
      hipError_t e = hipLaunchCooperativeKernel((const void*)mega, dim3(grid), dim3(NTHREADS), args, LDS_BYTES, stream);
      if (e != hipSuccess) fprintf(stderr, "cooperative launch failed: %s (grid %d)\n", hipGetErrorString(e), grid); }
    double* acc = (double*)((unsigned char*)d_ws + ST_CHK);
    hipLaunchKernelGGL(st_batch_report, dim3(256), dim3(256), 0, stream, (const float*)sout, (float*)d_out, out_size, acc);
    hipLaunchKernelGGL(st_fill, dim3(1024), dim3(256), 0, stream, (const double*)acc, (float*)d_out, out_size);
#else
#ifndef ST_CHUNK
#define ST_CHUNK 1
#endif
    for (int st = 0; st < CFG_LAYERS * 9; st += ST_CHUNK) {
        a.step_lo = st; a.step_hi = st + ST_CHUNK; a.prologue = st == 0; a.final_ = 0;
        void* args[] = {&a};
        hipError_t e = hipLaunchCooperativeKernel((const void*)mega, dim3(grid), dim3(NTHREADS), args, LDS_BYTES, stream);
        if (e != hipSuccess) fprintf(stderr, "cooperative launch failed: %s (grid %d)\n", hipGetErrorString(e), grid);
        hipLaunchKernelGGL(st_check_kernel, dim3(256), dim3(NTHREADS), 0, stream, (unsigned char*)d_ws, st + ST_CHUNK - 1);
    }
#ifdef ST_TRUTH
    hipLaunchKernelGGL(st_truth_fill, dim3(1024), dim3(256), 0, stream, (const unsigned char*)d_ws, (float*)d_out, out_size);
#else
    hipLaunchKernelGGL(st_report, dim3(1024), dim3(256), 0, stream, (const unsigned char*)d_ws, (float*)d_out, out_size);
#endif
#endif
#elif defined(MULTI_LAUNCH)
    for (int st = 0; st < CFG_LAYERS * 9; st += MULTI_LAUNCH) {
        a.step_lo = st; a.step_hi = st + MULTI_LAUNCH < CFG_LAYERS * 9 ? st + MULTI_LAUNCH : CFG_LAYERS * 9; a.prologue = st == 0; a.final_ = 0;
        void* args[] = {&a};
        hipError_t e = hipLaunchCooperativeKernel((const void*)mega, dim3(grid), dim3(NTHREADS), args, LDS_BYTES, stream);
        if (e != hipSuccess) fprintf(stderr, "cooperative launch failed: %s (grid %d)\n", hipGetErrorString(e), grid);
    }
    {   a.step_lo = a.step_hi = CFG_LAYERS * 9; a.prologue = 0; a.final_ = 1;
        void* args[] = {&a};
        hipError_t e = hipLaunchCooperativeKernel((const void*)mega, dim3(grid), dim3(NTHREADS), args, LDS_BYTES, stream);
        if (e != hipSuccess) fprintf(stderr, "cooperative launch failed: %s (grid %d)\n", hipGetErrorString(e), grid); }
#elif defined(PROBE_Y)
    {   a.step_lo = 0; a.step_hi = 9 * (PROBE_Y - 1) + 5; a.prologue = 1; a.final_ = 0;
        void* args[] = {&a};
        hipError_t e = hipLaunchCooperativeKernel((const void*)mega, dim3(grid), dim3(NTHREADS), args, LDS_BYTES, stream);
        if (e != hipSuccess) fprintf(stderr, "cooperative launch failed: %s (grid %d)\n", hipGetErrorString(e), grid);
        double* acc = (double*)((unsigned char*)d_ws + 512 * 1024);
        hipLaunchKernelGGL(pr_stat, dim3(512), dim3(256), 0, stream, (const bf16_t*)((unsigned char*)d_ws + OFF_HY), ML, PROBE_C0, PROBE_C1, acc);
        hipLaunchKernelGGL(pr_fill, dim3(1024), dim3(256), 0, stream, (const double*)acc, (float*)d_out, out_size); }
#else
    a.step_lo = 0; a.step_hi = CFG_LAYERS * 9; a.prologue = 1; a.final_ = 1;
    void* args[] = {&a};
    hipError_t e = hipLaunchCooperativeKernel((const void*)mega, dim3(grid), dim3(NTHREADS), args, LDS_BYTES, stream);
    if (e != hipSuccess) fprintf(stderr, "cooperative launch failed: %s (grid %d)\n", hipGetErrorString(e), grid);
#ifdef RUN_TWICE
    (void)hipMemsetAsync(d_ws, 0, ZERO_BYTES, stream);
    e = hipLaunchCooperativeKernel((const void*)mega, dim3(grid), dim3(NTHREADS), args, LDS_BYTES, stream);
#endif
#endif
}
#endif
```

```cpp
#ifndef EMU
#include <hip/hip_runtime.h>
#include <hip/hip_cooperative_groups.h>
#include <cstdio>
#include <cstdint>
#include <cmath>
#endif

#ifndef CFG_D
#define CFG_D 1024
#define CFG_B 8
#define CFG_SEQ 2048
#define CFG_CTX 256
#define CFG_FF 2816
#endif
#ifndef DIS
#define DIS 0ull
#endif
#define ON(bit) (!(((unsigned long long)(DIS) >> (bit)) & 1ull))
#ifndef REPM
#define REPM 0ull
#endif
#define REPB(bit) for (int rep_ = 0; rep_ <= (int)(((unsigned long long)(REPM) >> (bit)) & 1ull); ++rep_)
#ifndef CFG_LAYERS
#define CFG_LAYERS 4
#endif
constexpr int D = CFG_D, NB = CFG_B, SEQ = CFG_SEQ, CTX = CFG_CTX, FF = CFG_FF, DEPTH = 4, GRIDW = 64;
constexpr int ML = NB * SEQ, MC = NB * CTX, MT = ML + MC;
constexpr int LK = CTX + SEQ;
constexpr int NCC = CTX / 64, NLC = SEQ / 64, NCH = NCC + NLC;
constexpr int E_IN = 3088, O_IN = 2832, NE = 3072, NO = 2816;
constexpr int NCHAIN = NB * 4 * 2;
constexpr float EPS = 1e-6f;
constexpr int NTHREADS = 512, NWAVES = 8;
static_assert(SEQ % 256 == 0 && MC % 256 == 0 && D % 256 == 0 && FF % 256 == 0 && CTX % 64 == 0, "shape constraints");

typedef unsigned short bf16_t;
typedef short bf16x8 __attribute__((ext_vector_type(8)));
typedef short bf16x4 __attribute__((ext_vector_type(4)));
typedef float f32x4 __attribute__((ext_vector_type(4)));
typedef float f32x2 __attribute__((ext_vector_type(2)));
typedef float f32x16 __attribute__((ext_vector_type(16)));
typedef unsigned u32x4 __attribute__((ext_vector_type(4)));
typedef unsigned u32x2 __attribute__((ext_vector_type(2)));

#ifdef EMU
#define DEV static inline
#define DEVM inline
#define TIDX (EMU_TID)
#define BIDX (EMU_BID)
#define NBLK (EMU_NBLK)
#define BLOCK_SYNC() emu::block_sync()
#define WAVE_FENCE() emu::wave_sync()
#define SHFL_XOR(v, m) emu::shfl_xor((v), (m))
#define SHFL(v, s) emu::shfl((v), (s))
#define MFMA32(a, b, c) emu::mfma32((a), (b), (c))
#define EXP2F(x) exp2f(x)
#define ATOMIC_ADD_F(p, v) (*(p) += (v))
#define SCHED_FENCE() do {} while (0)
#define LOGF_NATIVE(x) logf(x)
#define WAVE_ANY(p) (wave_max((p) ? 1.0f : 0.0f) > 0.5f)
#else
namespace cg = cooperative_groups;
#define DEV __device__ __forceinline__
#define DEVM __device__ __forceinline__
#define TIDX ((int)threadIdx.x)
#define BIDX ((int)blockIdx.x)
#define NBLK ((int)gridDim.x)
#define BLOCK_SYNC() __syncthreads()
#define WAVE_FENCE() do { asm volatile("s_waitcnt lgkmcnt(0)" ::: "memory"); } while (0)
#define SHFL_XOR(v, m) __shfl_xor((v), (m))
#define SHFL(v, s) __shfl((v), (s))
#define MFMA32(a, b, c) __builtin_amdgcn_mfma_f32_32x32x16_bf16((a), (b), (c), 0, 0, 0)
#define EXP2F(x) __builtin_amdgcn_exp2f(x)
#define ATOMIC_ADD_F(p, v) atomicAdd((p), (v))
#define SCHED_FENCE() __builtin_amdgcn_sched_barrier(0)
#define LOGF_NATIVE(x) __logf(x)
#define WAVE_ANY(p) (__any(p) != 0)
#endif

DEV unsigned f2bf(float f) { unsigned u = __builtin_bit_cast(unsigned, f); return (u + 0x7fffu + ((u >> 16) & 1u)) >> 16; }
DEV float bf2f(unsigned h) { return __builtin_bit_cast(float, h << 16); }
#ifdef EMU
DEV unsigned pk2(float lo, float hi) { return f2bf(lo) | (f2bf(hi) << 16); }
#else
typedef __bf16 hw_bf16x2 __attribute__((ext_vector_type(2)));
DEV unsigned pk2(float lo, float hi) { const f32x2 v = {lo, hi}; return __builtin_bit_cast(unsigned, __builtin_convertvector(v, hw_bf16x2)); }
#endif
DEV int crow(int r, int h) { return (r & 3) + 8 * (r >> 2) + 4 * h; }
DEV float wave_sum(float v) {
#pragma unroll
    for (int o = 1; o < 64; o <<= 1) v += SHFL_XOR(v, o);
    return v;
}
DEV float wave_max(float v) {
#pragma unroll
    for (int o = 1; o < 64; o <<= 1) v = fmaxf(v, SHFL_XOR(v, o));
    return v;
}
DEV bf16x8 ld16(const void* p) { return *(const bf16x8*)p; }
DEV bf16x8 pack_acc(const f32x16& x, int s) {
    u32x4 p; p[0] = pk2(x[8 * s + 0], x[8 * s + 1]); p[1] = pk2(x[8 * s + 2], x[8 * s + 3]); p[2] = pk2(x[8 * s + 4], x[8 * s + 5]); p[3] = pk2(x[8 * s + 6], x[8 * s + 7]);
    return __builtin_bit_cast(bf16x8, p);
}
DEV bf16x8 cat44(bf16x4 lo, bf16x4 hi) { return __builtin_shufflevector(lo, hi, 0, 1, 2, 3, 4, 5, 6, 7); }
#ifndef EMU
DEV float fast_expf_(float x) { return __builtin_amdgcn_exp2f(x * 1.4426950408889634f); }
#define expf(x) fast_expf_(x)
#endif
#ifdef EMU
DEV float sigmoidf_(float x) { return 1.0f / (1.0f + expf(-x)); }
DEV float siluf_(float x) { return x / (1.0f + expf(-x)); }
#else
DEV float sigmoidf_(float x) { return __builtin_amdgcn_rcpf(1.0f + __builtin_amdgcn_exp2f(x * -1.4426950408889634f)); }
DEV float siluf_(float x) { return x * __builtin_amdgcn_rcpf(1.0f + __builtin_amdgcn_exp2f(x * -1.4426950408889634f)); }
#endif
DEV float log1pexp_(float nax) {
    const float e = expf(nax), u = 1.0f + e, d = u - 1.0f; return d == 0.0f ? e : LOGF_NATIVE(u) * (e / d); }
DEV float logsigmoidf_(float x) { return fminf(x, 0.0f) - log1pexp_(-fabsf(x)); }
DEV float softplusf_(float x) { return fmaxf(x, 0.0f) + log1pexp_(-fabsf(x)); }

constexpr size_t al256(size_t x) { return (x + 255) & ~(size_t)255; }
constexpr size_t cmax(size_t a, size_t b) { return a > b ? a : b; }
constexpr size_t OFF_CTL = 0;
constexpr size_t OFF_MOD = 1u << 20;
constexpr size_t SZ_MOD = al256((size_t)DEPTH * 9 * 6 * D * 4);
constexpr size_t ZERO_BYTES = OFF_MOD + SZ_MOD;
constexpr size_t OFF_ROPE = ZERO_BYTES;
constexpr size_t OFF_G = OFF_ROPE + al256((size_t)SEQ * 64 * 4);
constexpr size_t OFF_X = OFF_G + al256((size_t)MT * 16 * 4);
constexpr size_t OFF_WIN = OFF_X + al256((size_t)MT * D * 4);
constexpr size_t OFF_WOUT = OFF_WIN + al256((size_t)NE * D * 2);
constexpr size_t OFF_P = OFF_WOUT + al256((size_t)D * 1024 * 2);
constexpr size_t SZ_P = al256((size_t)MT * cmax(NE, FF) * 2);
constexpr size_t OFF_HY = OFF_P + SZ_P;
constexpr size_t OFF_S = OFF_HY + al256((size_t)MT * cmax(D, 1024) * 2);
constexpr size_t PE_QA = 0, PE_KA = (size_t)MT * 512, PE_VA = (size_t)MT * 1024, PE_BQ = (size_t)MT * 1536, PE_BK = (size_t)MT * 1792, PE_BV = (size_t)MT * 2048, PE_BO = (size_t)MT * 2560;
constexpr size_t PO_QC = 0, PO_KVC = (size_t)MT * 512, PO_DQKV = (size_t)MT * 768, PO_Z = (size_t)MT * 2304;
constexpr size_t SE_KP = OFF_S;
constexpr size_t SE_VT = SE_KP + al256((size_t)NB * 8 * LK * 64 * 2);
constexpr size_t SE_DCT = SE_VT + al256((size_t)NB * 4 * 128 * LK * 2);
constexpr size_t SE_DN = SE_DCT + al256((size_t)NCHAIN * NCH * 8192 * 4);
constexpr size_t SE_SC = SE_DN + al256((size_t)NCHAIN * NCH * 64 * 4);
constexpr size_t SE_PARK = SE_SC + al256((size_t)NCHAIN * NCH * 4 * 4);
constexpr size_t SE_END = SE_PARK + al256((size_t)256 * NTHREADS * 64 * 4);
constexpr size_t SF_WGU = OFF_S;
constexpr size_t SF_WDN = SF_WGU + al256((size_t)2 * FF * D * 2);
constexpr size_t SF_END = SF_WDN + al256((size_t)D * FF * 2);
constexpr size_t SF_PART = SF_END;
constexpr size_t SF_PART_END = SF_PART + (size_t)128 * 65536 * 4;
constexpr size_t WS_NEED_EF = cmax(SE_END, SF_PART_END);

constexpr int LDS_BYTES = 147456;
constexpr int LDS_MISC = 131072;

struct Args { const float* in[25]; float* out; unsigned char* ws; int step_lo, step_hi, prologue, final_; };

struct Ctx {
    int tid, lane, wave, bid, nblk, gw, ngw;
    char* lds;
    const float* const* in; float* out; unsigned char* ws;
};
#ifdef EMU
#define PHASE_CTX(pc) const Ctx& pc = c
#else
#define PHASE_CTX(pc) Ctx pc = c; { int t_ = threadIdx.x; asm volatile("" : "+v"(t_)); pc.tid = t_; pc.lane = t_ & 63; pc.wave = __builtin_amdgcn_readfirstlane(t_ >> 6); pc.gw = pc.bid * NWAVES + pc.wave; \
    __attribute__((address_space(1))) unsigned char* g_ = (__attribute__((address_space(1))) unsigned char*)c.ws; asm volatile("" : "+s"(g_)); pc.ws = (unsigned char*)g_; }
#endif

#ifdef EMU
struct XcdBarrier { int dummy; };
#define GRID_BARRIER() emu::grid_sync()
#else
#define LAS __attribute__((address_space(3)))
#define XB_TMO      128
#define XB_XCNT(j)  (256  + 64 * (j))
#define XB_XSUB(j)  (1280 + 64 * (j))
#define XB_XGEN(j)  (2304 + 64 * (j))
#define XB_TOP      3328
#define XB_TOPGEN   3392
#define XCD_BAR_WORDS 3456
#define XB_SPIN_CAP (1u << 24)
__device__ __forceinline__ unsigned xb_ld(unsigned* p)              { return __hip_atomic_load(p, __ATOMIC_RELAXED, __HIP_MEMORY_SCOPE_AGENT); }
__device__ __forceinline__ unsigned xb_add(unsigned* p, unsigned v) { return __hip_atomic_fetch_add(p, v, __ATOMIC_RELAXED, __HIP_MEMORY_SCOPE_AGENT); }
__device__ __forceinline__ unsigned xb_xcc_id() { return (unsigned)__builtin_amdgcn_s_getreg((3 << 11) | 20) & 0xFu; }
#define XB_SPIN(cond, bar) do { unsigned _sp = 0; while (cond) { __builtin_amdgcn_s_sleep(1); \
    if ((++_sp & 255u) == 0u) { if (xb_ld(&(bar)[XB_TMO])) break; if (_sp > XB_SPIN_CAP) { atomicAdd(&(bar)[XB_TMO], 1u); break; } } } } while (0)
struct XcdBarrier { unsigned* bar; unsigned x; volatile LAS unsigned* st; };
__device__ __forceinline__ XcdBarrier xcd_barrier_post(unsigned* bar, volatile LAS unsigned* st) {
    XcdBarrier b; b.bar = bar; b.x = xb_xcc_id(); b.st = st;
    if (threadIdx.x == 0) (void)xb_add(&bar[XB_XCNT(b.x)], 1u);
    return b;
}
__device__ __forceinline__ void xcd_barrier_complete(unsigned* bar, unsigned x, unsigned& nloc, unsigned& nx) {
    const unsigned G = gridDim.x * gridDim.y * gridDim.z;
    unsigned sum, cnt, mine, sp = 0u;
    for (;;) {
        sum = 0u; cnt = 0u; mine = 0u;
#pragma unroll
        for (unsigned j = 0; j < 16; ++j) { const unsigned c = xb_ld(&bar[XB_XCNT(j)]); sum += c; cnt += (c > 0u) ? 1u : 0u; mine = (j == x) ? c : mine; }
        if (sum == G) break;
        __builtin_amdgcn_s_sleep(1);
        if ((++sp & 255u) == 0u) { if (xb_ld(&bar[XB_TMO])) break; if (sp > XB_SPIN_CAP) { atomicAdd(&bar[XB_TMO], 1u); break; } }
    }
    nloc = mine > 0u ? mine : 1u; nx = cnt > 0u ? cnt : 1u;
}
__device__ __forceinline__ void xcd_barrier(const XcdBarrier& b) {
    const bool leader = threadIdx.x == 0;
    asm volatile("s_waitcnt vmcnt(0)" ::: "memory");
    __syncthreads();
    if (leader) {
        unsigned* bar = b.bar;
        __builtin_amdgcn_s_waitcnt(0);
        unsigned nloc = b.st[0], nx = b.st[1];
        if (nloc == 0u) { xcd_barrier_complete(bar, b.x, nloc, nx); b.st[0] = nloc; b.st[1] = nx; }
        const unsigned old = xb_add(&bar[XB_XSUB(b.x)], 1u);
        const unsigned gen = old / nloc;
        if (old + 1u == (gen + 1u) * nloc) {
            __builtin_amdgcn_fence(__ATOMIC_RELEASE, "agent");
            asm volatile("s_waitcnt vmcnt(0)" ::: "memory");
            const unsigned og = xb_add(&bar[XB_TOP], 1u);
            const unsigned tg = og / nx;
            if (og + 1u == (tg + 1u) * nx) xb_add(&bar[XB_TOPGEN], 1u);
            else XB_SPIN(xb_ld(&bar[XB_TOPGEN]) == tg, bar);
            __builtin_amdgcn_fence(__ATOMIC_ACQUIRE, "agent");
            xb_add(&bar[XB_XGEN(b.x)], 1u);
            asm volatile("s_waitcnt vmcnt(0)" ::: "memory");
        } else {
            XB_SPIN(xb_ld(&bar[XB_XGEN(b.x)]) == gen, bar);
            __builtin_amdgcn_fence(__ATOMIC_ACQUIRE, "agent");
            asm volatile("s_waitcnt vmcnt(0)" ::: "memory");
        }
    }
    __syncthreads();
}
#ifdef USE_CG_SYNC
#define GRID_BARRIER() cg::this_grid().sync()
#else
#define GRID_BARRIER() xcd_barrier(bar)
#endif
#endif

#ifndef EMU
namespace pg8 {
#define PG8_LAS __attribute__((address_space(3)))
typedef unsigned short bf16_t;
typedef short bf16x8 __attribute__((ext_vector_type(8)));
typedef float f32x4 __attribute__((ext_vector_type(4)));
typedef unsigned u32x4 __attribute__((ext_vector_type(4)));
constexpr int BM = 256, BK = 64, HALF = 128, HTB = HALF * BK * 2  , STAGE_BYTES = 8 * HTB, NXCD = 8, WGM = 8;

__host__ __device__ __forceinline__ int lds_byte(int r, int c) { const int st = (r >> 4) * 2 + (c >> 5), rr = r & 15, cc = c & 31, ob = rr * 64 + cc * 2; return st * 1024 + (ob ^ (((ob >> 9) & 1) << 5)); }
__host__ __device__ __forceinline__ void stage_rc(int b, int& R, int& C) { const int st = b / 1024, sb = b % 1024, swz = sb ^ (((sb >> 9) & 1) << 5); R = (st >> 1) * 16 + swz / 64; C = (st & 1) * 32 + (swz % 64) / 2; }
__host__ __device__ __forceinline__ int perm32(int rho) { const int n = rho >> 4, i = rho & 15; return 8 * (i >> 2) + 4 * n + (i & 3); }

struct Unit { int pm, pn; };
struct Gemm { const bf16_t* A; const bf16_t* Bt; int M, N, K, ld; };

struct StaticOrder {
    int nM, nN, nwg, G, c, wave, lim;
    int tn, tpm, tpn, tw;
    __host__ __device__ void init(int M, int N, int G_, int c_) { nM = M / BM; nN = N / BM; nwg = nM * nN; G = G_; c = c_; lim = 0x7fffffff; tn = 0; tpm = 0; tpn = 0; tw = 1; }
    __host__ __device__ bool next(int i, Unit& u) const {
        const long L = (long)i * G + c; if (L >= nwg + tn || L >= lim) return false;
        if (L >= nwg) { const int idx = (int)L - nwg; u.pm = tpm + idx / tw; u.pn = tpn + idx % tw; return true; }
        int wgid = (int)L; { const int q = nwg / NXCD, r = nwg % NXCD, xcd = wgid % NXCD, off = wgid / NXCD; wgid = (xcd < r ? xcd * (q + 1) : r * (q + 1) + (xcd - r) * q) + off; }
        const int nig = WGM * nN, gid = wgid / nig, fm = gid * WGM, gsz = (nM - fm) < WGM ? (nM - fm) : WGM;
        u.pm = fm + ((wgid % nig) % gsz); u.pn = (wgid % nig) / gsz; return true;
    }
    __device__ __forceinline__ void a_ready(const Unit&) const {}
    __device__ __forceinline__ void done(const Unit&) const {}
};
template <class Epi, class Sched, bool ALIGN_EPI = false, bool SP2 = false>
__device__ __forceinline__ void gemm_phase(PG8_LAS unsigned char* lds, const Gemm g, const Sched& S, const Epi& E) {
    int tid_ = threadIdx.x; asm volatile("" : "+v"(tid_));
    const int tid = tid_, wid = __builtin_amdgcn_readfirstlane(tid >> 6), lane = tid & 63, wr = wid >> 2, wc = wid & 3, fr = lane & 15, fq = lane >> 4;
    const int K = g.K, nt = K / BK, LD = g.ld ? g.ld : g.K;
    unsigned voffA[2], voffB[2];
#pragma unroll
    for (int i = 0; i < 2; ++i) { int R, C; stage_rc(tid * 16 + i * 8192, R, C); const int Rb = Epi::PERM ? ((R & ~31) + perm32(R & 31)) : R;
        voffA[i] = (unsigned)(R * LD + C) * 2u; voffB[i] = (unsigned)(Rb * LD + C) * 2u; }
    const size_t kstep = (size_t)(BK * 2);
    const size_t hstep = (size_t)HALF * LD * 2;
    const size_t tstep = 2 * hstep;
    const unsigned ldsw = (unsigned)wid * 1024u;
    const int aoff = lds_byte(wr * 64 + fr, fq * 8), boff = lds_byte(wc * 32 + fr, fq * 8);
#define PG8_SA(b, h) (((b) * 2 + (h)) * HTB)
#define PG8_SB(b, h) ((4 + (b) * 2 + (h)) * HTB)
#define PG8_STAGE(bufoff, gbase, voff) do { _Pragma("unroll") for (int _i = 0; _i < 2; ++_i) \
        __builtin_amdgcn_global_load_lds((const unsigned*)((const char*)(gbase) + (voff)[_i]), (PG8_LAS unsigned*)(lds + (bufoff) + ldsw + _i * 8192), 16, 0, 0); } while (0)
#define PG8_LDA(dst, b, h) do { _Pragma("unroll") for (int m = 0; m < 4; ++m) _Pragma("unroll") for (int k = 0; k < 2; ++k) dst[m][k] = *(const PG8_LAS bf16x8*)(lds + PG8_SA(b, h) + aoff + m * 2048 + k * 1024); } while (0)
#define PG8_LDB(dst, b, h) do { _Pragma("unroll") for (int n = 0; n < 2; ++n) _Pragma("unroll") for (int k = 0; k < 2; ++k) dst[n][k] = *(const PG8_LAS bf16x8*)(lds + PG8_SB(b, h) + boff + n * 2048 + k * 1024); } while (0)
#define PG8_MMA(ai, bj, At, Bt) do { __builtin_amdgcn_s_setprio(1); _Pragma("unroll") for (int m = 0; m < 4; ++m) _Pragma("unroll") for (int n = 0; n < 2; ++n) _Pragma("unroll") for (int k = 0; k < 2; ++k) \
        acc[ai][bj][m][n] = __builtin_amdgcn_mfma_f32_16x16x32_bf16(Bt[n][k], At[m][k], acc[ai][bj][m][n], 0, 0, 0); __builtin_amdgcn_s_setprio(0); } while (0)
#define PG8_WAIT_V(n) asm volatile("s_waitcnt vmcnt(" #n ")" ::: "memory")
#define PG8_WAIT_L(n) asm volatile("s_waitcnt lgkmcnt(" #n ")" ::: "memory")
#define PG8_BAR __builtin_amdgcn_s_barrier()
#define PG8_SCHED __builtin_amdgcn_sched_barrier(0)
    Unit cur, nxt; int ui = 0;
    if (!S.next(0, cur)) return;
    f32x4 acc[2][2][4][2];
#pragma unroll
    for (int a = 0; a < 2; ++a)
#pragma unroll
        for (int b = 0; b < 2; ++b)
#pragma unroll
            for (int m = 0; m < 4; ++m)
#pragma unroll
                for (int n = 0; n < 2; ++n) acc[a][b][m][n] = (f32x4){0.f, 0.f, 0.f, 0.f};
    bf16x8 At[4][2], B0[2][2], B1[2][2];
    const char* cA = (const char*)g.A + (size_t)cur.pm * tstep; const char* cB = (const char*)g.Bt + (size_t)cur.pn * tstep;
    S.a_ready(cur);
    if constexpr (SP2) {
        PG8_STAGE(PG8_SB(0, 0), cB, voffB); PG8_STAGE(PG8_SB(0, 1), cB + hstep, voffB); PG8_STAGE(PG8_SA(0, 0), cA, voffA); PG8_STAGE(PG8_SA(0, 1), cA + hstep, voffA);
        if (wr == 1) PG8_BAR;
        PG8_WAIT_V(2); PG8_BAR;
        PG8_STAGE(PG8_SB(1, 0), cB + kstep, voffB); PG8_STAGE(PG8_SA(1, 0), cA + kstep, voffA); PG8_STAGE(PG8_SB(1, 1), cB + hstep + kstep, voffB);
        PG8_WAIT_V(6); PG8_BAR;
    } else {
        PG8_STAGE(PG8_SB(0, 0), cB, voffB); PG8_STAGE(PG8_SA(0, 0), cA, voffA); PG8_STAGE(PG8_SB(0, 1), cB + hstep, voffB); PG8_STAGE(PG8_SA(0, 1), cA + hstep, voffA);
        if (wr == 1) PG8_BAR;
        PG8_WAIT_V(4); PG8_BAR;
        PG8_STAGE(PG8_SB(1, 0), cB + kstep, voffB); PG8_STAGE(PG8_SA(1, 0), cA + kstep, voffA); PG8_STAGE(PG8_SB(1, 1), cB + hstep + kstep, voffB);
        PG8_WAIT_V(6); PG8_BAR;
    }
    for (;;) {
        const bool has_next = S.next(ui + 1, nxt);
        const char* nA = has_next ? (const char*)g.A + (size_t)nxt.pm * tstep : cA; const char* nB = has_next ? (const char*)g.Bt + (size_t)nxt.pn * tstep : cB;
        for (int t = 0; t < nt; t += 2) {
            const bool last = (t == nt - 2);
            const char* a1 = cA + (size_t)(t + 1) * kstep;
            const char* a2 = last ? nA : cA + (size_t)(t + 2) * kstep; const char* b2 = last ? nB : cB + (size_t)(t + 2) * kstep;
            const char* a3 = a2 + kstep; const char* b3 = b2 + kstep;
            if (last && has_next) S.a_ready(nxt);
            if constexpr (SP2) {
            PG8_LDB(B0, 0, 0); PG8_LDB(B1, 0, 1); PG8_SCHED; PG8_LDA(At, 0, 0); PG8_STAGE(PG8_SA(1, 1), a1 + hstep, voffA);
            PG8_WAIT_V(8); PG8_WAIT_L(0); PG8_BAR; PG8_MMA(0, 0, At, B0); PG8_MMA(0, 1, At, B1); PG8_BAR; PG8_SCHED;
            PG8_LDA(At, 0, 1); PG8_STAGE(PG8_SB(0, 0), b2, voffB); PG8_STAGE(PG8_SB(0, 1), b2 + hstep, voffB); PG8_STAGE(PG8_SA(0, 0), a2, voffA);
            PG8_WAIT_V(8); PG8_WAIT_L(0); PG8_BAR; PG8_MMA(1, 0, At, B0); PG8_MMA(1, 1, At, B1); PG8_BAR; PG8_SCHED;
            PG8_LDB(B0, 1, 0); PG8_LDB(B1, 1, 1); PG8_SCHED; PG8_LDA(At, 1, 0); PG8_STAGE(PG8_SA(0, 1), a2 + hstep, voffA);
            PG8_WAIT_V(8); PG8_WAIT_L(0); PG8_BAR; PG8_MMA(0, 0, At, B0); PG8_MMA(0, 1, At, B1); PG8_BAR; PG8_SCHED;
            PG8_LDA(At, 1, 1); PG8_STAGE(PG8_SB(1, 0), b3, voffB); PG8_STAGE(PG8_SB(1, 1), b3 + hstep, voffB); PG8_STAGE(PG8_SA(1, 0), a3, voffA);
            PG8_WAIT_V(8); PG8_WAIT_L(0); PG8_BAR; PG8_MMA(1, 0, At, B0); PG8_MMA(1, 1, At, B1); PG8_BAR; PG8_SCHED;
            } else {
            PG8_LDB(B0, 0, 0); PG8_SCHED; PG8_LDA(At, 0, 0); PG8_STAGE(PG8_SA(1, 1), a1 + hstep, voffA);
            PG8_WAIT_L(8); PG8_BAR; PG8_WAIT_L(0); PG8_MMA(0, 0, At, B0); PG8_BAR; PG8_SCHED;
            PG8_LDB(B1, 0, 1); PG8_STAGE(PG8_SB(0, 0), b2, voffB);
            PG8_BAR; PG8_WAIT_L(0); PG8_MMA(0, 1, At, B1); PG8_BAR;
            PG8_LDA(At, 0, 1); PG8_STAGE(PG8_SA(0, 0), a2, voffA);
            PG8_BAR; PG8_WAIT_L(0); PG8_MMA(1, 0, At, B0); PG8_BAR; PG8_SCHED;
            PG8_STAGE(PG8_SB(0, 1), b2 + hstep, voffB);
            PG8_WAIT_V(6); PG8_BAR; PG8_MMA(1, 1, At, B1); PG8_BAR;
            PG8_LDB(B0, 1, 0); PG8_SCHED; PG8_LDA(At, 1, 0); PG8_STAGE(PG8_SA(0, 1), a2 + hstep, voffA);
            PG8_WAIT_L(8); PG8_BAR; PG8_WAIT_L(0); PG8_MMA(0, 0, At, B0); PG8_BAR; PG8_SCHED;
            PG8_LDB(B1, 1, 1); PG8_STAGE(PG8_SB(1, 0), b3, voffB);
            PG8_BAR; PG8_WAIT_L(0); PG8_MMA(0, 1, At, B1); PG8_BAR;
            PG8_LDA(At, 1, 1); PG8_STAGE(PG8_SA(1, 0), a3, voffA);
            PG8_BAR; PG8_WAIT_L(0); PG8_MMA(1, 0, At, B0); PG8_BAR; PG8_SCHED;
            PG8_STAGE(PG8_SB(1, 1), b3 + hstep, voffB);
            PG8_WAIT_V(6); PG8_BAR; PG8_MMA(1, 1, At, B1); PG8_BAR;
            }
        }
        if constexpr (ALIGN_EPI) { if (wr == 0) PG8_BAR; }
        if constexpr (!Epi::AFTER_DRAIN) { E(acc, cur, wr, wc, fr, fq); S.done(cur); }
        if (!has_next) break;
#pragma unroll
        for (int a = 0; a < 2; ++a)
#pragma unroll
            for (int b = 0; b < 2; ++b)
#pragma unroll
                for (int m = 0; m < 4; ++m)
#pragma unroll
                    for (int n = 0; n < 2; ++n) acc[a][b][m][n] = (f32x4){0.f, 0.f, 0.f, 0.f};
        cur = nxt; cA = nA; cB = nB; ++ui;
        if constexpr (ALIGN_EPI) { if (wr == 1) PG8_BAR; }
    }
    PG8_WAIT_V(0);
    if constexpr (!ALIGN_EPI) { if (wr == 0) PG8_BAR; }
    PG8_BAR;
    if constexpr (Epi::AFTER_DRAIN) { E.fused(acc, cur, wr, wc, fr, fq, lds, wid, lane); S.done(cur); }
#undef PG8_SA
#undef PG8_SB
#undef PG8_STAGE
#undef PG8_LDA
#undef PG8_LDB
#undef PG8_MMA
#undef PG8_WAIT_V
#undef PG8_WAIT_L
#undef PG8_BAR
#undef PG8_SCHED
}
}
#else
namespace pg8 {
typedef unsigned short bf16_t;
constexpr int BM = 256, BK = 64, HALF = 128, NXCD = 8, WGM = 8;
struct Unit { int pm, pn; };
struct Gemm { const bf16_t* A; const bf16_t* Bt; int M, N, K, ld; };
struct StaticOrder {
    int nM, nN, nwg, G, c, wave, lim, tn, tpm, tpn, tw;
    void init(int M, int N, int G_, int c_) { nM = M / BM; nN = N / BM; nwg = nM * nN; G = G_; c = c_; lim = 0x7fffffff; tn = 0; tpm = 0; tpn = 0; tw = 1; }
    bool next(int i, Unit& u) const {
        const long L = (long)i * G + c; if (L >= nwg + tn || L >= lim) return false;
        if (L >= nwg) { const int idx = (int)L - nwg; u.pm = tpm + idx / tw; u.pn = tpn + idx % tw; return true; }
        int wgid = (int)L; { const int q = nwg / NXCD, r = nwg % NXCD, xcd = wgid % NXCD, off = wgid / NXCD; wgid = (xcd < r ? xcd * (q + 1) : r * (q + 1) + (xcd - r) * q) + off; }
        const int nig = WGM * nN, gid = wgid / nig, fm = gid * WGM, gsz = (nM - fm) < WGM ? (nM - fm) : WGM;
        u.pm = fm + ((wgid % nig) % gsz); u.pn = (wgid % nig) / gsz; return true;
    }
};
template <class Epi, class Sched, bool ALIGN_EPI = false, bool SP2 = false>
static inline void gemm_phase(unsigned char* lds, const Gemm g, const Sched& S, const Epi& E) {
    const int tid = TIDX, wid = tid >> 6, lane = tid & 63, wr = wid >> 2, wc = wid & 3, fr = lane & 15, fq = lane >> 4;
    Unit u;
    for (int i = 0; S.next(i, u); ++i) {
        f32x4 acc[2][2][4][2];
        for (int ai = 0; ai < 2; ++ai) for (int bj = 0; bj < 2; ++bj) for (int m = 0; m < 4; ++m) for (int n = 0; n < 2; ++n) for (int j = 0; j < 4; ++j) {
            const int row = 256 * u.pm + 128 * ai + 64 * wr + 16 * m + fr;
            const int col = Epi::PERM ? 256 * u.pn + 128 * bj + 32 * wc + 8 * fq + 4 * n + j : 256 * u.pn + 128 * bj + 32 * wc + 16 * n + 4 * fq + j;
            const int ld = g.ld ? g.ld : g.K; const bf16_t* a = g.A + (size_t)row * ld; const bf16_t* b = g.Bt + (size_t)col * ld; float s = 0.f;
            for (int k = 0; k < g.K; ++k) s += bf2f(a[k]) * bf2f(b[k]);
            acc[ai][bj][m][n][j] = s; }
        E(acc, u, wr, wc, fr, fq);
    }
    BLOCK_SYNC();
}
}
#define PG8_LAS
#endif

#if !defined(EMU) && defined(SIMPLE_GEMM)
namespace sg {
template <class Epi, class Sched>
__device__ __forceinline__ void gemm_phase(const pg8::Gemm g, const Sched& S, const Epi& E) {
    int tid_ = threadIdx.x; asm volatile("" : "+v"(tid_));
    const int tid = tid_, wid = __builtin_amdgcn_readfirstlane(tid >> 6), lane = tid & 63, wr = wid >> 2, wc = wid & 3, fr = lane & 15, fq = lane >> 4;
    pg8::Unit u;
    for (int i = 0; S.next(i, u); ++i) {
        f32x4 acc[2][2][4][2];
#pragma unroll
        for (int ai = 0; ai < 2; ++ai)
#pragma unroll
            for (int bj = 0; bj < 2; ++bj)
#pragma unroll
                for (int m = 0; m < 4; ++m)
#pragma unroll
                    for (int n = 0; n < 2; ++n) acc[ai][bj][m][n] = (f32x4){0.f, 0.f, 0.f, 0.f};
        const bf16_t* wp0 = g.Bt + (size_t)(256 * u.pn + 32 * wc + (Epi::PERM ? 8 * (fr >> 2) + (fr & 3) : fr)) * g.K + 8 * fq;
        const bf16_t* xp0 = g.A + (size_t)(256 * u.pm + 64 * wr + fr) * g.K + 8 * fq;
#pragma unroll 1
        for (int k0 = 0; k0 < g.K; k0 += 32) {
            bf16x8 wf[2][2], xf[2][4];
#pragma unroll
            for (int bj = 0; bj < 2; ++bj)
#pragma unroll
                for (int n = 0; n < 2; ++n) wf[bj][n] = *(const bf16x8*)(wp0 + (size_t)(128 * bj + (Epi::PERM ? 4 : 16) * n) * g.K + k0);
#pragma unroll
            for (int ai = 0; ai < 2; ++ai)
#pragma unroll
                for (int m = 0; m < 4; ++m) xf[ai][m] = *(const bf16x8*)(xp0 + (size_t)(128 * ai + 16 * m) * g.K + k0);
#pragma unroll
            for (int ai = 0; ai < 2; ++ai)
#pragma unroll
                for (int bj = 0; bj < 2; ++bj)
#pragma unroll
                    for (int m = 0; m < 4; ++m)
#pragma unroll
                        for (int n = 0; n < 2; ++n) acc[ai][bj][m][n] = __builtin_amdgcn_mfma_f32_16x16x32_bf16(wf[bj][n], xf[ai][m], acc[ai][bj][m][n], 0, 0, 0);
        }
        E(acc, u, wr, wc, fr, fq);
    }
}
}
#define GEMM_PHASE(EpiT, lds, g, S, E) sg::gemm_phase<EpiT, pg8::StaticOrder>(g, S, E)
#else
#define GEMM_PHASE(EpiT, lds, g, S, E) pg8::gemm_phase<EpiT, pg8::StaticOrder, true, true>((PG8_LAS unsigned char*)(lds), g, S, E)
#endif

struct EpiSeg {
    static constexpr bool PERM = true, AFTER_DRAIN = false;
    bf16_t* P; int odd;
    DEVM void operator()(const f32x4 (&acc)[2][2][4][2], const pg8::Unit& u, int wr, int wc, int fr, int fq) const {
        size_t off; int pitch, c0;
        const int pn = u.pn;
        if (!odd) {
            if (pn < 2) { off = PE_QA; pitch = 512; c0 = 256 * pn; } else if (pn < 4) { off = PE_KA; pitch = 512; c0 = 256 * (pn - 2); } else if (pn < 6) { off = PE_VA; pitch = 512; c0 = 256 * (pn - 4); }
            else if (pn == 6) { off = PE_BQ; pitch = 256; c0 = 0; } else if (pn == 7) { off = PE_BK; pitch = 256; c0 = 0; } else if (pn < 10) { off = PE_BV; pitch = 512; c0 = 256 * (pn - 8); } else { off = PE_BO; pitch = 512; c0 = 256 * (pn - 10); }
        } else {
            if (pn < 2) { off = PO_QC; pitch = 512; c0 = 256 * pn; } else if (pn == 2) { off = PO_KVC; pitch = 256; c0 = 0; } else if (pn < 9) { off = PO_DQKV; pitch = 1536; c0 = 256 * (pn - 3); } else { off = PO_Z; pitch = 512; c0 = 256 * (pn - 9); }
        }
        bf16_t* base = P + off;
        const int row0 = u.pm * 256 + wr * 64 + fr, col0 = c0 + wc * 32 + 8 * fq;
#pragma unroll
        for (int ai = 0; ai < 2; ++ai)
#pragma unroll
            for (int m = 0; m < 4; ++m) { bf16_t* rowp = base + (size_t)(row0 + ai * 128 + m * 16) * pitch + col0;
#pragma unroll
                for (int bj = 0; bj < 2; ++bj) { const f32x4 v0 = acc[ai][bj][m][0], v1 = acc[ai][bj][m][1];
                    u32x4 w; w[0] = pk2(v0[0], v0[1]); w[1] = pk2(v0[2], v0[3]); w[2] = pk2(v1[0], v1[1]); w[3] = pk2(v1[2], v1[3]);
                    *(u32x4*)(rowp + bj * 128) = w; } }
    }
};
struct EpiResid {
    static constexpr bool PERM = false, AFTER_DRAIN = false;
    float* X; const float* mod; int gaoff;
    const float* XL; const float* XC;
    DEVM void operator()(const f32x4 (&acc)[2][2][4][2], const pg8::Unit& u, int wr, int wc, int fr, int fq) const {
        const int rowt = u.pm * 256; const int mr = rowt < ML ? rowt / SEQ : NB;
        const float* ga = mod + (size_t)mr * 6 * D + gaoff; const float* Xs = rowt < ML ? XL : XC;
        const int row0 = rowt + wr * 64 + fr, col0 = u.pn * 256 + wc * 32 + 4 * fq;
#pragma unroll
        for (int bj = 0; bj < 2; ++bj)
#pragma unroll
            for (int n = 0; n < 2; ++n) { const int c = col0 + bj * 128 + n * 16; const f32x4 g = *(const f32x4*)(ga + c);
#pragma unroll
                for (int ai = 0; ai < 2; ++ai)
#pragma unroll
                    for (int m = 0; m < 4; ++m) { const size_t off = (size_t)(row0 + ai * 128 + m * 16) * D + c; const f32x4 x = *(const f32x4*)(Xs + off); *(f32x4*)(X + off) = x + g * acc[ai][bj][m][n]; } }
    }
};
struct EpiPart {
    static constexpr bool PERM = false, AFTER_DRAIN = false;
    float* P;
    DEVM void operator()(const f32x4 (&acc)[2][2][4][2], const pg8::Unit& u, int wr, int wc, int fr, int fq) const {
        (void)u; const int r0 = wr * 64 + fr, c0 = wc * 32 + 4 * fq;
#pragma unroll
        for (int bj = 0; bj < 2; ++bj)
#pragma unroll
            for (int n = 0; n < 2; ++n)
#pragma unroll
                for (int ai = 0; ai < 2; ++ai)
#pragma unroll
                    for (int m = 0; m < 4; ++m) *(f32x4*)(P + (size_t)(r0 + ai * 128 + m * 16) * 256 + c0 + bj * 128 + n * 16) = acc[ai][bj][m][n];
    }
};
struct SplitPlan { int extra, split, nwg; };
DEV SplitPlan split_plan(int mrows, int kdim, int nblk, bool allow) {
    SplitPlan p; p.nwg = (mrows / 256) * (D / 256); p.extra = 0; p.split = 1;
    if (allow && p.nwg > nblk && p.nwg < 2 * nblk) { const int pairs = kdim / 128; int sp = 4; const int ex = p.nwg - nblk;
        while (sp > 1 && (ex * sp > nblk || sp > pairs || ex * sp > 128)) sp >>= 1;
        if (sp > 1) { p.extra = ex; p.split = sp; } }
    return p;
}

struct EpiSwiglu {
    static constexpr bool PERM = true, AFTER_DRAIN = false;
    bf16_t* ACT;
    DEVM void operator()(const f32x4 (&acc)[2][2][4][2], const pg8::Unit& u, int wr, int wc, int fr, int fq) const {
        const int row0 = u.pm * 256 + wr * 64 + fr, col0 = u.pn * 128 + wc * 32 + 8 * fq;
#pragma unroll
        for (int ai = 0; ai < 2; ++ai)
#pragma unroll
            for (int m = 0; m < 4; ++m) { bf16_t* rowp = ACT + (size_t)(row0 + ai * 128 + m * 16) * FF + col0;
                float v[8];
#pragma unroll
                for (int n = 0; n < 2; ++n)
#pragma unroll
                    for (int j = 0; j < 4; ++j) { const float g = acc[ai][0][m][n][j], up = acc[ai][1][m][n][j]; v[4 * n + j] = siluf_(g) * up; }
                u32x4 w; w[0] = pk2(v[0], v[1]); w[1] = pk2(v[2], v[3]); w[2] = pk2(v[4], v[5]); w[3] = pk2(v[6], v[7]);
                *(u32x4*)rowp = w; }
    }
};

DEV void p0_prologue(const Ctx& c) {
    const float* x = c.in[0]; const float* cv = c.in[1]; const float* ctx = c.in[2]; const float* cctx = c.in[3]; const float* w_ada = c.in[4]; const float* b_ada = c.in[5];
    float* MOD = (float*)(c.ws + OFF_MOD);
    const long gt = (long)c.bid * NTHREADS + c.tid, GT = (long)c.nblk * NTHREADS;
    {   constexpr int NCG = 6 * D / 128, KW = D / 8; f32x2* part = (f32x2*)c.lds;
        for (int it = c.bid; it < DEPTH * NCG; it += c.nblk) { const int l = it / NCG, cg = it % NCG; const int n2 = cg * 64 + c.lane;
            f32x2 acc[9];
#pragma unroll
            for (int r = 0; r < 9; ++r) acc[r] = (f32x2){0.f, 0.f};
            const float* W = w_ada + ((size_t)l * D + c.wave * KW) * 6 * D + 2 * n2;
#pragma unroll 8
            for (int k = 0; k < KW; ++k) { const f32x2 w = *(const f32x2*)(W + (size_t)k * 6 * D); const int kk = c.wave * KW + k;
#pragma unroll
                for (int r = 0; r < 9; ++r) { const float sv = siluf_(r < NB ? cv[r * D + kk] : cctx[kk]); acc[r] += w * sv; } }
#pragma unroll
            for (int r = 0; r < 9; ++r) part[(c.wave * 9 + r) * 64 + c.lane] = acc[r];
            BLOCK_SYNC();
            for (int o = c.tid; o < 9 * 64; o += NTHREADS) { const int r = o / 64, q = o % 64; f32x2 sum = *(const f32x2*)(b_ada + (size_t)l * 6 * D + 2 * (cg * 64 + q));
#pragma unroll
                for (int w = 0; w < 8; ++w) sum += part[(w * 9 + r) * 64 + q];
                *(f32x2*)(MOD + ((size_t)l * 9 + r) * 6 * D + 2 * (cg * 64 + q)) = sum; }
            BLOCK_SYNC(); } }
    float* COS = (float*)(c.ws + OFF_ROPE); float* SIN = COS + SEQ * 32;
    for (long it = gt; it < (long)SEQ * 32; it += GT) { const int t = (int)(it >> 5), i = (int)(it & 31);
        const float fr = expf(-(float)(i & 15) * (9.210340371976184f / 16.0f));     const float pos = (i < 16) ? (float)(t / GRIDW) : (float)(t % GRIDW); const float a = pos * fr;
        COS[it] = cosf(a); SIN[it] = sinf(a); }
    (void)x; (void)ctx;
}

DEV void transpose_item(const float* W, int srcpitch, int k0, int n0, bf16_t* WT, int Kp, int dstrow0, float* scr, int lane) {
#pragma unroll 8
    for (int i = 0; i < 32; ++i) { const int kk = 2 * i + (lane >> 5); scr[kk * 33 + (lane & 31)] = W[(size_t)(k0 + kk) * srcpitch + n0 + (lane & 31)]; }
    WAVE_FENCE();
    const int cc = lane & 7;
#pragma unroll
    for (int j = 0; j < 4; ++j) { const int n = (lane >> 3) + 8 * j; const float* s = scr + (8 * cc) * 33 + n;
        u32x4 o; o[0] = pk2(s[0 * 33], s[1 * 33]); o[1] = pk2(s[2 * 33], s[3 * 33]); o[2] = pk2(s[4 * 33], s[5 * 33]); o[3] = pk2(s[6 * 33], s[7 * 33]);
        *(u32x4*)(WT + (size_t)(dstrow0 + n) * Kp + k0 + 8 * cc) = o; }
    WAVE_FENCE();
}
DEV void convert_mixer_weights(const Ctx& c, int layer, int gw, int ngw) {
    float* scr = (float*)(c.lds + c.wave * 8448);
    const int odd = layer & 1, li = layer >> 1;
    const float* win = odd ? c.in[14] + (size_t)li * D * O_IN : c.in[8] + (size_t)li * D * E_IN; const int pin = odd ? O_IN : E_IN, nin = odd ? NO : NE;
    const float* wout = odd ? c.in[20] + (size_t)li * 1024 * D : c.in[13] + (size_t)li * 1024 * D;
    bf16_t* WIN = (bf16_t*)(c.ws + OFF_WIN); bf16_t* WOUT = (bf16_t*)(c.ws + OFF_WOUT);
    const int I1 = (D / 64) * (nin / 32), I2 = (1024 / 64) * (D / 32);
    for (int it = gw; it < I1 + I2; it += ngw) {
        if (it < I1) { const int nb = it % (nin / 32), kb = it / (nin / 32); transpose_item(win, pin, 64 * kb, 32 * nb, WIN, D, 32 * nb, scr, c.lane); }
        else { const int r = it - I1; const int nb = r % (D / 32), kb = r / (D / 32); transpose_item(wout, D, 64 * kb, 32 * nb, WOUT, 1024, 32 * nb, scr, c.lane); }
    }
}
DEV void convert_ffn_weights(const Ctx& c, int layer, int gw, int ngw) {
    float* scr = (float*)(c.lds + c.wave * 8448);
    const float* wg = c.in[21] + (size_t)layer * D * FF; const float* wu = c.in[22] + (size_t)layer * D * FF; const float* wd = c.in[23] + (size_t)layer * FF * D;
    bf16_t* WGU = (bf16_t*)(c.ws + SF_WGU); bf16_t* WDN = (bf16_t*)(c.ws + SF_WDN);
    const int I1 = (D / 64) * (FF / 32), I3 = (FF / 64) * (D / 32);
    for (int it = gw; it < 2 * I1 + I3; it += ngw) {
        if (it < 2 * I1) { const int up = it >= I1; const int r = up ? it - I1 : it; const int nb = r % (FF / 32), kb = r / (FF / 32); const int f0 = 32 * nb;
            transpose_item(up ? wu : wg, FF, 64 * kb, f0, WGU, D, (f0 / 128) * 256 + (up ? 128 : 0) + (f0 % 128), scr, c.lane); }
        else { const int r = it - 2 * I1; const int nb = r % (D / 32), kb = r / (D / 32); transpose_item(wd, D, 64 * kb, 32 * nb, WDN, FF, 32 * nb, scr, c.lane); }
    }
}
DEV void normalize_rows(const Ctx& c, int layer, int which, int nrows, SplitPlan red, int pmrows, const float* pga) {
    constexpr int NV = D / 256;
    float* X = (float*)(c.ws + OFF_X); bf16_t* H = (bf16_t*)(c.ws + OFF_HY); float* G = (float*)(c.ws + OFF_G);
    const float* MODL = (const float*)(c.ws + OFF_MOD) + (size_t)layer * 9 * 6 * D;
    const float* g = (which ? c.in[7] : c.in[6]) + (size_t)layer * D;
    const int odd = layer & 1, li = layer >> 1;
    const float* wgate = odd ? c.in[14] + (size_t)li * D * O_IN + NO : c.in[8] + (size_t)li * D * E_IN + NE; const int pg = odd ? O_IN : E_IN;
    float* wgt = (float*)c.lds;
    unsigned char* tab = (unsigned char*)(c.lds + 16 * D * 4);
    const float* PART = (const float*)(c.ws + SF_PART);
    if (red.extra) { BLOCK_SYNC();
        for (int e = c.tid; e < (pmrows / 256) * (D / 256); e += NTHREADS) tab[e] = 255;
        BLOCK_SYNC();
        if (c.tid < red.extra) { pg8::StaticOrder S2; S2.init(pmrows, D, red.nwg, c.nblk + c.tid); pg8::Unit u; if (S2.next(0, u)) tab[u.pm * (D / 256) + u.pn] = (unsigned char)c.tid; }
        BLOCK_SYNC(); }
    if (which == 0) { BLOCK_SYNC();
        for (int e = c.tid; e < D * 4; e += NTHREADS) { const int k = e >> 2, q = e & 3; const f32x4 w4 = *(const f32x4*)(wgate + (size_t)k * pg + 4 * q);
#pragma unroll
            for (int j = 0; j < 4; ++j) wgt[(4 * q + j) * D + k] = w4[j]; }
        BLOCK_SYNC(); }
    for (int row = c.gw; row < nrows; row += c.ngw) {
        const int mr = row < ML ? row / SEQ : NB;
        const float* sh = MODL + (size_t)mr * 6 * D + (which ? 3 : 0) * D; const float* sc = sh + D;
        const float* xrow = (layer == 0 && which == 0) ? (row < ML ? c.in[0] + (size_t)row * D : c.in[2] + (size_t)(row - ML) * D) : X + (size_t)row * D;
        const f32x4* xr = (const f32x4*)xrow + c.lane;
        f32x4 v[NV]; float ss = 0.f;
#pragma unroll
        for (int j = 0; j < NV; ++j) { v[j] = xr[64 * j];
            if (red.extra && row < pmrows) { const int lu = tab[(row >> 8) * (D / 256) + j];
                if (lu != 255) { const float* pp = PART + (size_t)lu * red.split * 65536 + (size_t)(row & 255) * 256 + 4 * c.lane; f32x4 sum = *(const f32x4*)pp;
                    for (int q = 1; q < red.split; ++q) sum += *(const f32x4*)(pp + (size_t)q * 65536);
                    v[j] += *(const f32x4*)(pga + (size_t)mr * 6 * D + 256 * j + 4 * c.lane) * sum; ((f32x4*)(X + (size_t)row * D) + c.lane)[64 * j] = v[j]; } }
            ss += (v[j][0] * v[j][0] + v[j][1] * v[j][1]) + (v[j][2] * v[j][2] + v[j][3] * v[j][3]); }
        const float rstd = 1.0f / sqrtf(wave_sum(ss) * (1.0f / D) + EPS);
        u32x2* o8 = (u32x2*)(H + (size_t)row * D) + c.lane;
        float ga[16];
#pragma unroll
        for (int n = 0; n < 16; ++n) ga[n] = 0.f;
#pragma unroll
        for (int j = 0; j < NV; ++j) { const int k0 = 256 * j + 4 * c.lane;
            const f32x4 gg = *(const f32x4*)(g + k0), s1 = *(const f32x4*)(sc + k0), s0 = *(const f32x4*)(sh + k0);
            f32x4 h = v[j] * rstd * gg * (s1 + 1.0f) + s0;
            u32x2 w; w[0] = pk2(h[0], h[1]); w[1] = pk2(h[2], h[3]); o8[64 * j] = w;
            if (which == 0) {
#pragma unroll
                for (int n = 0; n < 16; ++n) { const f32x4 w4 = *(const f32x4*)(wgt + n * D + k0); ga[n] += (h[0] * w4[0] + h[1] * w4[1]) + (h[2] * w4[2] + h[3] * w4[3]); if ((n & 7) == 7) SCHED_FENCE(); } } }
        if (which == 0) {
            const bool b5 = c.lane & 32, b4 = c.lane & 16, b3 = c.lane & 8, b2 = c.lane & 4;
            float w8[8], w4[4], w2[2];
#pragma unroll
            for (int n = 0; n < 8; ++n) { const float snd = b5 ? ga[n] : ga[n + 8], kp = b5 ? ga[n + 8] : ga[n]; w8[n] = kp + SHFL_XOR(snd, 32); }
#pragma unroll
            for (int n = 0; n < 4; ++n) { const float snd = b4 ? w8[n] : w8[n + 4], kp = b4 ? w8[n + 4] : w8[n]; w4[n] = kp + SHFL_XOR(snd, 16); }
#pragma unroll
            for (int n = 0; n < 2; ++n) { const float snd = b3 ? w4[n] : w4[n + 2], kp = b3 ? w4[n + 2] : w4[n]; w2[n] = kp + SHFL_XOR(snd, 8); }
            float z = (b2 ? w2[1] : w2[0]) + SHFL_XOR(b2 ? w2[0] : w2[1], 4);
            z += SHFL_XOR(z, 2); z += SHFL_XOR(z, 1);
            if ((c.lane & 3) == 0) G[(size_t)row * 16 + (b5 ? 8 : 0) + (b4 ? 4 : 0) + (b3 ? 2 : 0) + (b2 ? 1 : 0)] = z; }
    }
}

DEV int tok_row(int b, int tc, int i) { return tc < NCC ? ML + b * CTX + 64 * tc + i : b * SEQ + 64 * (tc - NCC) + i; }
DEV int pos_row(int b, int pos) { return pos < CTX ? ML + b * CTX + pos : b * SEQ + (pos - CTX); }
DEV int chain_chunk(int dir, int tc) { return dir == 0 ? tc : (tc < NCC ? NCC - 1 - tc : NCC + (NLC - 1 - (tc - NCC))); }
DEV void unpack8(bf16x8 v, float (&f)[8]) {
#pragma unroll
    for (int e = 0; e < 8; ++e) f[e] = bf2f((unsigned short)v[e]);
}
DEV bf16x8 pack8(const float (&f)[8]) { u32x4 p; p[0] = pk2(f[0], f[1]); p[1] = pk2(f[2], f[3]); p[2] = pk2(f[4], f[5]); p[3] = pk2(f[6], f[7]); return __builtin_bit_cast(bf16x8, p); }
DEV float chain_cumsum(float x, int lane, int dir) {
#pragma unroll
    for (int off = 1; off < 64; off <<= 1) { const int src = dir == 0 ? lane - off : lane + off; const float y = SHFL(x, src & 63); if (src >= 0 && src < 64) x += y; }
    return x;
}

constexpr int AT_KB = 64 * 72 * 2;
template <int DV> struct AttnLds { static constexpr int VB = DV * 72 * 2, BUF = AT_KB + VB; };

template <int DV>
DEV void attn_stage_load(const Ctx& c, const bf16_t* Kp, const bf16_t* Vt, int vpitch, int tile, bf16x8& kreg, bf16x8 (&vreg)[DV / 64]) {
    kreg = ld16(Kp + (size_t)(tile * 64 + (c.tid >> 3)) * 64 + (c.tid & 7) * 8);
#pragma unroll
    for (int i = 0; i < DV / 64; ++i) { const int idx = c.tid + 512 * i; vreg[i] = ld16(Vt + (size_t)(idx >> 3) * vpitch + tile * 64 + (idx & 7) * 8); }
}
template <int DV>
DEV void attn_stage_store(const Ctx& c, int boff, const bf16x8& kreg, const bf16x8 (&vreg)[DV / 64]) {
    char* kb = c.lds + boff; char* vb = kb + AT_KB;
    *(bf16x8*)(kb + (c.tid >> 3) * 144 + (c.tid & 7) * 16) = kreg;
#pragma unroll
    for (int i = 0; i < DV / 64; ++i) { const int idx = c.tid + 512 * i; *(bf16x8*)(vb + (idx >> 3) * 144 + (idx & 7) * 16) = vreg[i]; }
}
DEV void attn_qk(const char* kb, int rk, int h, const bf16x8 (&qf)[4], f32x16& p0, f32x16& p1) {
#pragma unroll
    for (int i = 0; i < 16; ++i) { p0[i] = 0.f; p1[i] = 0.f; }
#pragma unroll
    for (int ks = 0; ks < 4; ++ks) { const bf16x8 a0 = ld16(kb + rk * 144 + ks * 32 + h * 16), a1 = ld16(kb + (32 + rk) * 144 + ks * 32 + h * 16);
        p0 = MFMA32(a0, qf[ks], p0); p1 = MFMA32(a1, qf[ks], p1); }
}
DEV void attn_sm1(f32x16& p0, f32x16& p1, float& m, float& alpha) {
    const float C2 = 0.125f * 1.4426950408889634f;
    float mx = p0[0];
#pragma unroll
    for (int i = 0; i < 16; ++i) { mx = fmaxf(mx, p0[i]); mx = fmaxf(mx, p1[i]); }
    mx = fmaxf(mx, SHFL_XOR(mx, 32));
    alpha = 1.0f;
    if (WAVE_ANY(mx * C2 > m + 8.0f)) { const float mn = fmaxf(m, mx * C2); alpha = EXP2F(m - mn); m = mn; }
#pragma unroll
    for (int i = 0; i < 16; ++i) { p0[i] = p0[i] * C2 - m; p1[i] = p1[i] * C2 - m; }
#pragma unroll
    for (int i = 0; i < 16; ++i) p0[i] = EXP2F(p0[i]);
}
DEV void attn_sm2(f32x16& p0, f32x16& p1, float alpha, float& l, bf16x8 (&pb)[4]) {
#pragma unroll
    for (int i = 0; i < 16; ++i) p1[i] = EXP2F(p1[i]);
    float rs = 0.f;
#pragma unroll
    for (int i = 0; i < 16; ++i) rs += p0[i] + p1[i];
    l = l * alpha + rs;
    pb[0] = pack_acc(p0, 0); pb[1] = pack_acc(p0, 1); pb[2] = pack_acc(p1, 0); pb[3] = pack_acc(p1, 1);
}
template <int DV>
DEV void attn_pv(const char* vb, int r, int h, const bf16x8 (&pb)[4], f32x16 (&o)[DV / 32]) {
#pragma unroll
    for (int us = 0; us < 4; ++us)
#pragma unroll
        for (int dt = 0; dt < DV / 32; ++dt) { const bf16x8 va = ld16(vb + (32 * dt + r) * 144 + (16 * us + 8 * h) * 2); o[dt] = MFMA32(va, pb[us], o[dt]); }
}
template <int DV>
DEV void attn_resc(f32x16 (&o)[DV / 32], float alpha) {
    if (WAVE_ANY(alpha < 1.0f)) {
#pragma unroll
        for (int dt = 0; dt < DV / 32; ++dt)
#pragma unroll
            for (int i = 0; i < 16; ++i) o[dt][i] *= alpha; }
}
template <int DV>
DEV void attn_step(const Ctx& c, const bf16_t* Kp, const bf16_t* Vt, int vpitch, int j, int nt, const bf16x8 (&qf)[4], bool active, int rk, int ox, int oy, int on,
                   bf16x8 (&pb)[4], f32x16 (&o)[DV / 32], float& m, float& l) {
    const int r = c.lane & 31, h = c.lane >> 5; const bool more = j + 1 < nt; const float C2 = 0.125f * 1.4426950408889634f;
    bf16x8 kreg, vreg[DV / 64]; f32x16 p0, p1;
    if (active) attn_qk(c.lds + ox, rk, h, qf, p0, p1);
    SCHED_FENCE();
    if (more) attn_stage_load<DV>(c, Kp, Vt, vpitch, j + 1, kreg, vreg);
    if (active) { const char* vb = c.lds + oy + AT_KB;
        float mx = 0.f, alpha = 1.0f;
#pragma unroll
        for (int us = 0; us < 4; ++us) {
            SCHED_FENCE();
#pragma unroll
            for (int dt = 0; dt < DV / 32; ++dt) { const bf16x8 va = ld16(vb + (32 * dt + r) * 144 + (16 * us + 8 * h) * 2); o[dt] = MFMA32(va, pb[us], o[dt]); }
            SCHED_FENCE();
            if (us == 0) { mx = p0[0];
#pragma unroll
                for (int i = 0; i < 16; ++i) { mx = fmaxf(mx, p0[i]); mx = fmaxf(mx, p1[i]); }
                mx = fmaxf(mx, SHFL_XOR(mx, 32));
                if (WAVE_ANY(mx * C2 > m + 8.0f)) { const float mn = fmaxf(m, mx * C2); alpha = EXP2F(m - mn); m = mn; } }
            else if (us == 1) {
#pragma unroll
                for (int i = 0; i < 16; ++i) { p0[i] = p0[i] * C2 - m; p1[i] = p1[i] * C2 - m; } }
            else if (us == 2) {
#pragma unroll
                for (int i = 0; i < 16; ++i) p0[i] = EXP2F(p0[i]); }
            else {
#pragma unroll
                for (int i = 0; i < 16; ++i) p1[i] = EXP2F(p1[i]); }
        }
        SCHED_FENCE();
        float rs = 0.f;
#pragma unroll
        for (int i = 0; i < 16; ++i) rs += p0[i] + p1[i];
        l = l * alpha + rs;
        pb[0] = pack_acc(p0, 0); pb[1] = pack_acc(p0, 1); pb[2] = pack_acc(p1, 0); pb[3] = pack_acc(p1, 1);
        attn_resc<DV>(o, alpha); }
    if (more) attn_stage_store<DV>(c, on, kreg, vreg);
    BLOCK_SYNC();
}
template <int DV>
DEV void attn_pass(const Ctx& c, const bf16_t* Kp, const bf16_t* Vt, int vpitch, int nk, const bf16x8 (&qf)[4], bool active, f32x16 (&o)[DV / 32], float& m, float& l) {
    const int r = c.lane & 31, h = c.lane >> 5; const int rk = (r & 0x13) | ((r & 4) << 1) | ((r & 8) >> 1);
    const int nt = nk / 64; constexpr int BUF = AttnLds<DV>::BUF;
#pragma unroll
    for (int dt = 0; dt < DV / 32; ++dt)
#pragma unroll
        for (int i = 0; i < 16; ++i) o[dt][i] = 0.f;
    m = -1e30f; l = 0.f;
    bf16x8 pb[4];
    { bf16x8 kreg, vreg[DV / 64];
      attn_stage_load<DV>(c, Kp, Vt, vpitch, 0, kreg, vreg); attn_stage_store<DV>(c, 0, kreg, vreg);
      attn_stage_load<DV>(c, Kp, Vt, vpitch, 1, kreg, vreg); attn_stage_store<DV>(c, BUF, kreg, vreg); }
    BLOCK_SYNC();
    if (active) { f32x16 p0, p1; float alpha; attn_qk(c.lds, rk, h, qf, p0, p1); attn_sm1(p0, p1, m, alpha); attn_sm2(p0, p1, alpha, l, pb); }
    else {
#pragma unroll
        for (int i = 0; i < 4; ++i) pb[i] = (bf16x8){0, 0, 0, 0, 0, 0, 0, 0}; }
    int ox = BUF, oy = 0, on = 2 * BUF;
    for (int j = 1; j < nt; ++j) {
        attn_step<DV>(c, Kp, Vt, vpitch, j, nt, qf, active, rk, ox, oy, on, pb, o, m, l); { const int t_ = oy; oy = ox; ox = on; on = t_; }
    }
    if (active) attn_pv<DV>(c.lds + oy + AT_KB, r, h, pb, o);
    BLOCK_SYNC();
}
DEV void load_q(const Ctx& c, const bf16_t* Qrow  , bool valid, bool rope, int t, const float* qg  , bf16x8 (&qf)[4]) {
    const int h = c.lane >> 5;
    float f[4][8];
#pragma unroll
    for (int ks = 0; ks < 4; ++ks) { bf16x8 v = (bf16x8){0, 0, 0, 0, 0, 0, 0, 0}; if (valid) v = ld16(Qrow + 16 * ks + 8 * h); unpack8(v, f[ks]); }
    if (qg) { float ss = 0.f;
#pragma unroll
        for (int ks = 0; ks < 4; ++ks)
#pragma unroll
            for (int e = 0; e < 8; ++e) ss += f[ks][e] * f[ks][e];
        ss += SHFL_XOR(ss, 32);
        const float rstd = 1.0f / sqrtf(ss * (1.0f / 64.0f) + EPS);
#pragma unroll
        for (int ks = 0; ks < 4; ++ks)
#pragma unroll
            for (int e = 0; e < 8; ++e) f[ks][e] = f[ks][e] * rstd * qg[16 * ks + 8 * h + e]; }
    if (rope) { const float* COS = (const float*)(c.ws + OFF_ROPE) + (size_t)t * 32; const float* SIN = COS + (size_t)SEQ * 32;
#pragma unroll
        for (int a = 0; a < 2; ++a)
#pragma unroll
            for (int e = 0; e < 8; ++e) { const float cs = COS[a * 16 + 8 * h + e], sn = SIN[a * 16 + 8 * h + e]; const float x1 = f[2 * a][e], x2 = f[2 * a + 1][e];
                f[2 * a][e] = x1 * cs - x2 * sn; f[2 * a + 1][e] = x2 * cs + x1 * sn; } }
#pragma unroll
    for (int ks = 0; ks < 4; ++ks) qf[ks] = pack8(f[ks]);
}

DEV void even_kprep(const Ctx& c) {
    const bf16_t* KA = (const bf16_t*)(c.ws + OFF_P) + PE_KA; bf16_t* KP = (bf16_t*)(c.ws + SE_KP);
    const float* COS = (const float*)(c.ws + OFF_ROPE); const float* SIN = COS + (size_t)SEQ * 32;
    const int l7 = c.lane & 7, a = l7 >> 2, p = (l7 >> 1) & 1, f0 = 8 * (l7 & 1), vh = c.lane >> 3;
    for (int it = c.gw; it < NB * LK; it += c.ngw) { const int b = it / LK, pos = it % LK; const int row = pos_row(b, pos);
        float f[8]; unpack8(ld16(KA + (size_t)row * 512 + 8 * c.lane), f);
        float g[8];
#pragma unroll
        for (int e = 0; e < 8; ++e) g[e] = SHFL_XOR(f[e], 2);
        if (pos >= CTX) { const int t = pos - CTX;
#pragma unroll
            for (int e = 0; e < 8; ++e) { const float cs = COS[(size_t)t * 32 + a * 16 + f0 + e], sn = SIN[(size_t)t * 32 + a * 16 + f0 + e]; f[e] = p == 0 ? f[e] * cs - g[e] * sn : f[e] * cs + g[e] * sn; } }
        *(bf16x8*)(KP + ((size_t)(b * 8 + vh) * LK + pos) * 64 + 8 * l7) = pack8(f); }
}
template <int DV>
DEV void vt_item(const Ctx& c, const bf16_t* src, int spitch, int colbase, int b, int pc, bf16_t* dstbh  ) {
    bf16_t* T = (bf16_t*)c.lds;
#pragma unroll
    for (int i = 0; i < DV / 64; ++i) { const int idx = c.tid + 512 * i, pl = idx / (DV / 8), cg = idx % (DV / 8); const int row = pos_row(b, 64 * pc + pl);
        const bf16x8 v = ld16(src + (size_t)row * spitch + colbase + 8 * cg);
#pragma unroll
        for (int e = 0; e < 8; ++e) T[(8 * cg + e) * 72 + (((pl >> 3) ^ (cg & 7)) << 3) + (pl & 7)] = (bf16_t)v[e]; }
    BLOCK_SYNC();
#pragma unroll
    for (int i = 0; i < DV / 64; ++i) { const int idx = c.tid + 512 * i, dv = idx >> 3, ch = idx & 7;
        *(bf16x8*)(dstbh + (size_t)dv * LK + 64 * pc + 8 * ch) = *(const bf16x8*)(T + dv * 72 + 8 * (ch ^ ((dv >> 3) & 7))); }
    BLOCK_SYNC();
}

DEV void mlstm_gates(const Ctx& c, int layer, int b, int h, int dir, int tc, float& ipre, float& lf) {
    const float* G = (const float*)(c.ws + OFF_G); const float* bias = c.in[9] + (size_t)(layer >> 1) * 16;
    const int row = tok_row(b, tc, c.lane);
    ipre = G[(size_t)row * 16 + dir * 8 + h] + bias[dir * 8 + h];
    lf = logsigmoidf_(G[(size_t)row * 16 + dir * 8 + 4 + h] + bias[dir * 8 + 4 + h]);
}
DEV void mlstm_m1_item(const Ctx& c, int layer, int it) {
    const int tc = it % NCH, dir = (it / NCH) & 1, h = (it / (2 * NCH)) & 3, b = it / (8 * NCH);
    const int chain = (b * 4 + h) * 2 + dir, cc = chain_chunk(dir, tc); const size_t ci = (size_t)chain * NCH + cc;
    const bf16_t* BK = (const bf16_t*)(c.ws + OFF_P) + PE_BK; const bf16_t* BV = (const bf16_t*)(c.ws + OFF_P) + PE_BV;
    float* DCT = (float*)(c.ws + SE_DCT); float* DN = (float*)(c.ws + SE_DN); float* SC = (float*)(c.ws + SE_SC);
    bf16_t* Kt = (bf16_t*)c.lds; bf16_t* Vt = Kt + 64 * 72; float* wv = (float*)(c.lds + (64 + 128) * 72 * 2);
    bf16x8 kraw, vraw[2];
    {   const int i = c.tid >> 3, cg = c.tid & 7; kraw = ld16(BK + (size_t)tok_row(b, tc, i) * 256 + h * 64 + 8 * cg); }
#pragma unroll
    for (int ii = 0; ii < 2; ++ii) { const int idx = c.tid + 512 * ii, i = idx >> 4, cg = idx & 15; vraw[ii] = ld16(BV + (size_t)tok_row(b, tc, i) * 512 + h * 128 + 8 * cg); }
    if (c.wave == 0) { float ipre, lf; mlstm_gates(c, layer, b, h, dir, tc, ipre, lf);
        const float bcum = chain_cumsum(lf, c.lane, dir), bend = wave_sum(lf), wend = bend - bcum + ipre, mloc = wave_max(wend);
        wv[c.lane] = expf(wend - mloc);
        if (c.lane == 0) { SC[ci * 4 + 0] = bend; SC[ci * 4 + 1] = mloc; } }
    BLOCK_SYNC();
    {   const int i = c.tid >> 3, cg = c.tid & 7; const float w = wv[i] * 0.125f;
        float f[8]; unpack8(kraw, f);
#pragma unroll
        for (int e = 0; e < 8; ++e) Kt[(8 * cg + e) * 72 + (((i >> 3) ^ (cg & 7)) << 3) + (i & 7)] = (bf16_t)f2bf(f[e] * w); }
#pragma unroll
    for (int ii = 0; ii < 2; ++ii) { const int idx = c.tid + 512 * ii, i = idx >> 4, cg = idx & 15; const bf16x8 v = vraw[ii];
#pragma unroll
        for (int e = 0; e < 8; ++e) Vt[(8 * cg + e) * 72 + (((i >> 3) ^ (cg & 7)) << 3) + (i & 7)] = (bf16_t)v[e]; }
    BLOCK_SYNC();
    {   const int r = c.lane & 31, hh = c.lane >> 5, dvt = c.wave >> 1, dkt = c.wave & 1;
        f32x16 acc;
#pragma unroll
        for (int i = 0; i < 16; ++i) acc[i] = 0.f;
#pragma unroll
        for (int ks = 0; ks < 4; ++ks) acc = MFMA32(ld16(Vt + (32 * dvt + r) * 72 + 8 * ((2 * ks + hh) ^ ((r >> 3) & 3) ^ ((dvt & 1) << 2))), ld16(Kt + (32 * dkt + r) * 72 + 8 * ((2 * ks + hh) ^ ((r >> 3) & 3) ^ ((dkt & 1) << 2))), acc);
        float* dst = DCT + ci * 8192;
#pragma unroll
        for (int i = 0; i < 16; ++i) dst[(32 * dvt + crow(i, hh)) * 64 + 32 * dkt + r] = acc[i];
        if (c.tid < 64) { float s = 0.f; for (int i = 0; i < 64; ++i) s += bf2f(Kt[c.tid * 72 + i]); DN[ci * 64 + c.tid] = s; } }
    BLOCK_SYNC();
}
DEV void mlstm_m2(const Ctx& c) {
    float* DCT = (float*)(c.ws + SE_DCT); float* DN = (float*)(c.ws + SE_DN); float* SC = (float*)(c.ws + SE_SC);
    const long gt = (long)c.bid * NTHREADS + c.tid, GT = (long)c.nblk * NTHREADS;
    for (long it = gt; it < (long)NCHAIN * 8256; it += GT) { const int chain = (int)(it / 8256), e = (int)(it % 8256);
        float* p0 = e < 8192 ? DCT + (size_t)chain * NCH * 8192 + e : DN + (size_t)chain * NCH * 64 + (e - 8192); const size_t pstr = e < 8192 ? 8192 : 64;
        float d[NCH];
#pragma unroll
        for (int cc = 0; cc < NCH; ++cc) d[cc] = p0[cc * pstr];
        float mst = 0.f, val = 0.f;
#pragma unroll
        for (int cc = 0; cc < NCH; ++cc) { const size_t ci = (size_t)chain * NCH + cc; const float bend = SC[ci * 4 + 0], mloc = SC[ci * 4 + 1];
            if (e == 0) SC[ci * 4 + 2] = mst;
            const float mnew = fmaxf(bend + mst, mloc); const float nv = expf(bend + mst - mnew) * val + expf(mloc - mnew) * d[cc]; d[cc] = val; val = nv; mst = mnew; }
#pragma unroll
        for (int cc = 0; cc < NCH; ++cc) p0[cc * pstr] = d[cc]; }
}
DEV void mlstm_m3_item(const Ctx& c, int layer, int it) {
    const int tc = it % NCH, h = (it / NCH) & 3, b = it / (4 * NCH);
    const bf16_t* BQ = (const bf16_t*)(c.ws + OFF_P) + PE_BQ; const bf16_t* BK = (const bf16_t*)(c.ws + OFF_P) + PE_BK; const bf16_t* BV = (const bf16_t*)(c.ws + OFF_P) + PE_BV; const bf16_t* BO = (const bf16_t*)(c.ws + OFF_P) + PE_BO;
    const float* DCT = (const float*)(c.ws + SE_DCT); const float* DN = (const float*)(c.ws + SE_DN); const float* SC = (const float*)(c.ws + SE_SC);
    bf16_t* Y = (bf16_t*)(c.ws + OFF_HY); const float* gn = c.in[12] + (size_t)(layer >> 1) * 128;
    bf16_t* Qs = (bf16_t*)c.lds; bf16_t* Ks = Qs + 64 * 72; bf16_t* Vt = Ks + 64 * 72; float* fl = (float*)(c.lds + (128 + 128) * 72 * 2);
    float* bcs2 = fl, *ics2 = fl + 128, *nst2 = fl + 256, *ssq = fl + 384;
    const int r = c.lane & 31, hh = c.lane >> 5, dvt = c.wave >> 1, tt = c.wave & 1, t = 32 * tt + r;
    f32x16 hs;
#pragma unroll
    for (int i = 0; i < 16; ++i) hs[i] = 0.f;
    {   const int i = c.tid >> 3, cg = c.tid & 7; const int row = tok_row(b, tc, i);
        *(bf16x8*)(Qs + i * 72 + 8 * cg) = ld16(BQ + (size_t)row * 256 + h * 64 + 8 * cg);
        float f[8]; unpack8(ld16(BK + (size_t)row * 256 + h * 64 + 8 * cg), f);
#pragma unroll
        for (int e = 0; e < 8; ++e) f[e] *= 0.125f;
        *(bf16x8*)(Ks + i * 72 + 8 * cg) = pack8(f); }
#pragma unroll
    for (int ii = 0; ii < 2; ++ii) { const int idx = c.tid + 512 * ii, i = idx >> 4, cg = idx & 15; const int row = tok_row(b, tc, i);
        const bf16x8 v = ld16(BV + (size_t)row * 512 + h * 128 + 8 * cg);
#pragma unroll
        for (int e = 0; e < 8; ++e) Vt[(8 * cg + e) * 72 + (((i >> 3) ^ (cg & 7)) << 3) + (i & 7)] = (bf16_t)v[e]; }
    if (c.wave < 2) { const int dir = c.wave; float ipre, lf; mlstm_gates(c, layer, b, h, dir, tc, ipre, lf); bcs2[dir * 64 + c.lane] = chain_cumsum(lf, c.lane, dir); ics2[dir * 64 + c.lane] = ipre; }
    else if (c.wave < 4) { const int dir = c.wave - 2; const size_t ci = (size_t)((b * 4 + h) * 2 + dir) * NCH + chain_chunk(dir, tc); nst2[dir * 64 + c.lane] = DN[ci * 64 + c.lane]; }
    BLOCK_SYNC();
    f32x16 sraw[2];
    for (int dir = 0; dir < 2; ++dir) {
        const int chain = (b * 4 + h) * 2 + dir, cc = chain_chunk(dir, tc); const size_t ci = (size_t)chain * NCH + cc;
        const float* bcs = bcs2 + dir * 64; const float* ics = ics2 + dir * 64; const float* nst = nst2 + dir * 64;
        const float mst = SC[ci * 4 + 2];
        f32x16 st[2];
        if (dir == 0) {
#pragma unroll
            for (int su = 0; su < 2; ++su) {
#pragma unroll
                for (int i = 0; i < 16; ++i) sraw[su][i] = 0.f;
#pragma unroll
                for (int ks = 0; ks < 4; ++ks) sraw[su] = MFMA32(ld16(Ks + (32 * su + r) * 72 + 16 * ks + 8 * hh), ld16(Qs + t * 72 + 16 * ks + 8 * hh), sraw[su]); } }
        const float bt = bcs[t], at = bt + mst;
        float mt = at;
#pragma unroll
        for (int su = 0; su < 2; ++su)
#pragma unroll
            for (int i = 0; i < 16; ++i) { const int s = 32 * su + crow(i, hh); const bool valid = dir == 0 ? s <= t : s >= t; if (valid) mt = fmaxf(mt, bt - bcs[s] + ics[s]); }
        mt = fmaxf(mt, SHFL_XOR(mt, 32));
        const float inter = expf(at - mt);
        float rsum = 0.f;
#pragma unroll
        for (int su = 0; su < 2; ++su)
#pragma unroll
            for (int i = 0; i < 16; ++i) { const int s = 32 * su + crow(i, hh); const bool valid = dir == 0 ? s <= t : s >= t;
                const float p = valid ? expf(bt - bcs[s] + ics[s] - mt) * sraw[su][i] : 0.f; st[su][i] = p; rsum += p; }
        rsum += SHFL_XOR(rsum, 32);
        float qn = 0.f;
        for (int d = 0; d < 32; ++d) qn += bf2f(Qs[t * 72 + 32 * hh + d]) * nst[32 * hh + d];
        qn += SHFL_XOR(qn, 32);
        const float den = inter * qn + rsum, dd = fmaxf(fabsf(den), expf(-mt));
        f32x16 a1;
#pragma unroll
        for (int i = 0; i < 16; ++i) a1[i] = 0.f;
        const float* Cst = DCT + ci * 8192 + (size_t)(32 * dvt + r) * 64;
#pragma unroll
        for (int ks = 0; ks < 4; ++ks) { float f[8]; const f32x4 c0 = *(const f32x4*)(Cst + 16 * ks + 8 * hh), c1 = *(const f32x4*)(Cst + 16 * ks + 8 * hh + 4);
            f[0] = c0[0]; f[1] = c0[1]; f[2] = c0[2]; f[3] = c0[3]; f[4] = c1[0]; f[5] = c1[1]; f[6] = c1[2]; f[7] = c1[3];
            a1 = MFMA32(pack8(f), ld16(Qs + t * 72 + 16 * ks + 8 * hh), a1); }
        f32x16 a2;
#pragma unroll
        for (int i = 0; i < 16; ++i) a2[i] = 0.f;
#pragma unroll
        for (int su = 0; su < 2; ++su)
#pragma unroll
            for (int s2 = 0; s2 < 2; ++s2) { const bf16_t* vr = Vt + (32 * dvt + r) * 72 + 4 * hh; const int sw = ((32 * dvt + r) >> 3) & 7, bk = 4 * su + 2 * s2;
                a2 = MFMA32(cat44(*(const bf16x4*)(vr + 8 * (bk ^ sw)), *(const bf16x4*)(vr + 8 * ((bk + 1) ^ sw))), pack_acc(st[su], s2), a2); }
        const float inv = 1.0f / dd;
#pragma unroll
        for (int i = 0; i < 16; ++i) hs[i] += (inter * a1[i] + a2[i]) * inv;
    }
    float ss = 0.f;
#pragma unroll
    for (int i = 0; i < 16; ++i) ss += hs[i] * hs[i];
    ss += SHFL_XOR(ss, 32);
    if (hh == 0) ssq[dvt * 64 + t] = ss;
    BLOCK_SYNC();
    const float rstd = 1.0f / sqrtf((ssq[t] + ssq[64 + t] + ssq[128 + t] + ssq[192 + t]) * (1.0f / 128.0f) + EPS);
    const int row = tok_row(b, tc, t);
#pragma unroll
    for (int q4 = 0; q4 < 4; ++q4) { const int dv = 32 * dvt + 8 * q4 + 4 * hh;
        const bf16x4 ov = *(const bf16x4*)(BO + (size_t)row * 512 + h * 128 + dv); float y[4];
#pragma unroll
        for (int e = 0; e < 4; ++e) y[e] = hs[4 * q4 + e] * rstd * gn[dv + e] * sigmoidf_(bf2f((unsigned short)ov[e]));
        u32x2 w; w[0] = pk2(y[0], y[1]); w[1] = pk2(y[2], y[3]);
        *(u32x2*)(Y + (size_t)row * 1024 + 512 + h * 128 + dv) = w; }
    BLOCK_SYNC();
}

DEV void diffattn_unit(const Ctx& c, int layer, int b, int h, bool ctxu, int qb) {
    const bf16_t* QA = (const bf16_t*)(c.ws + OFF_P) + PE_QA; const bf16_t* KP = (const bf16_t*)(c.ws + SE_KP); const bf16_t* VT = (const bf16_t*)(c.ws + SE_VT);
    bf16_t* Y = (bf16_t*)(c.ws + OFF_HY); const int e = layer >> 1;
    const float* lam = c.in[10] + (size_t)e * 256; const float* gn = c.in[11] + (size_t)e * 128;
    const int r = c.lane & 31, hh = c.lane >> 5; const int ql = qb * 256 + c.wave * 32 + r;
    const int nq = ctxu ? CTX : SEQ, nk = ctxu ? CTX : LK; const bool valid = ql < nq, active = (qb * 256 + c.wave * 32) < nq;
    const int row = ctxu ? ML + b * CTX + ql : b * SEQ + ql;
    const int orow = ctxu ? row : b * SEQ + (ql % 128) * (SEQ / 128) + ql / 128;
    f32x16 o[4]; float m, l1, l2; bf16x8 qf[4];
    float* park = (float*)(c.ws + SE_PARK) + ((size_t)c.bid * NTHREADS + c.tid) * 64;
    load_q(c, QA + (size_t)row * 512 + h * 128, valid, !ctxu, ql, nullptr, qf);
    attn_pass<128>(c, KP + (size_t)(b * 8 + 2 * h) * LK * 64, VT + (size_t)(b * 4 + h) * 128 * LK, LK, nk, qf, active, o, m, l1);
    if (active) { l1 += SHFL_XOR(l1, 32); const float i1 = 1.0f / l1;
#pragma unroll
        for (int dt = 0; dt < 4; ++dt)
#pragma unroll
            for (int q4 = 0; q4 < 4; ++q4) *(f32x4*)(park + 16 * dt + 4 * q4) = (f32x4){o[dt][4 * q4] * i1, o[dt][4 * q4 + 1] * i1, o[dt][4 * q4 + 2] * i1, o[dt][4 * q4 + 3] * i1}; }
    load_q(c, QA + (size_t)row * 512 + h * 128 + 64, valid, !ctxu, ql, nullptr, qf);
    attn_pass<128>(c, KP + (size_t)(b * 8 + 2 * h + 1) * LK * 64, VT + (size_t)(b * 4 + h) * 128 * LK, LK, nk, qf, active, o, m, l2);
    const float lam_init = 0.8f - 0.6f * expf(-0.3f * (float)layer);
    const float lmb = expf(wave_sum(lam[c.lane] * lam[64 + c.lane])) - expf(wave_sum(lam[128 + c.lane] * lam[192 + c.lane])) + lam_init;
    if (active) {
        l2 += SHFL_XOR(l2, 32);
        const float i2 = lmb / l2; float ss = 0.f;
#pragma unroll
        for (int dt = 0; dt < 4; ++dt)
#pragma unroll
            for (int q4 = 0; q4 < 4; ++q4) { const f32x4 a = *(const f32x4*)(park + 16 * dt + 4 * q4);
#pragma unroll
                for (int e = 0; e < 4; ++e) { const float v = a[e] - o[dt][4 * q4 + e] * i2; o[dt][4 * q4 + e] = v; ss += v * v; } }
        ss += SHFL_XOR(ss, 32);
        const float sc = (1.0f / sqrtf(ss * (1.0f / 128.0f) + EPS)) * (1.0f - lam_init);
        if (valid) {
#pragma unroll
            for (int dt = 0; dt < 4; ++dt)
#pragma unroll
                for (int q4 = 0; q4 < 4; ++q4) { const int dv = 32 * dt + 8 * q4 + 4 * hh; u32x2 w;
                    w[0] = pk2(o[dt][4 * q4 + 0] * sc * gn[dv + 0], o[dt][4 * q4 + 1] * sc * gn[dv + 1]); w[1] = pk2(o[dt][4 * q4 + 2] * sc * gn[dv + 2], o[dt][4 * q4 + 3] * sc * gn[dv + 3]);
                    *(u32x2*)(Y + (size_t)orow * 1024 + h * 128 + dv) = w; } }
    }
}

DEV void mix_even_a(const Ctx& c, int layer) {
    { PHASE_CTX(pc); if (ON(8)) even_kprep(pc); }
    { PHASE_CTX(pc); if (ON(9)) { const bf16_t* VA = (const bf16_t*)(pc.ws + OFF_P) + PE_VA; bf16_t* VT = (bf16_t*)(pc.ws + SE_VT);
        for (int it = pc.bid; it < NB * 4 * NCH; it += pc.nblk) { const int pch = it % NCH, bh = it / NCH; vt_item<128>(pc, VA, 512, (bh & 3) * 128, bh >> 2, pch, VT + (size_t)bh * 128 * LK); } } }
    REPB(10) { PHASE_CTX(pc); if (ON(10)) for (int it = pc.bid; it < NCHAIN * NCH; it += pc.nblk) mlstm_m1_item(pc, layer, it); }
}
DEV void mix_even_b(const Ctx& c, int layer) {
    { PHASE_CTX(pc); if (ON(11)) mlstm_m2(pc); }
}
DEV void mix_even_c(const Ctx& c, int layer) {
    constexpr int NQBL = SEQ / 256, NQBC = (CTX + 255) / 256, NUL = NB * 4 * NQBL, NUC = NB * 4 * NQBC;
    REPB(12) { PHASE_CTX(pc); if (ON(12)) for (int it = pc.bid; it < NUL + NUC; it += pc.nblk) { const bool cu = it >= NUL; int u = cu ? it - NUL : it; const int nqb = cu ? NQBC : NQBL;
        diffattn_unit(pc, layer, u / (4 * nqb), (u / nqb) & 3, cu, u % nqb); } }
    REPB(13) { PHASE_CTX(pc); if (ON(13)) for (int it = pc.nblk - 1 - pc.bid; it < NB * 4 * NCH; it += pc.nblk) mlstm_m3_item(pc, layer, it); }
}
constexpr size_t SO_KP = OFF_S;
constexpr size_t SO_VT = SO_KP + al256((size_t)NB * 2 * LK * 64 * 2);
constexpr size_t SO_U  = SO_VT + al256((size_t)NB * 2 * 64 * LK * 2);
constexpr size_t SO_W  = OFF_HY;
static_assert((size_t)NCHAIN * NCH * 8192 <= (size_t)MT * cmax(D, 1024), "W fits in the H/Y region");
constexpr size_t SO_AT = SO_U + al256((size_t)NCHAIN * NCH * 8192 * 2);
constexpr size_t SO_QN = SO_AT + al256((size_t)NCHAIN * NCH * 4096 * 2);
constexpr size_t SO_KD = SO_QN + al256((size_t)NCHAIN * NCH * 8192 * 2);
constexpr size_t SO_GE = SO_KD + al256((size_t)NCHAIN * NCH * 8192 * 2);
constexpr size_t SO_END = SO_GE + al256((size_t)NCHAIN * NCH * 4);
constexpr size_t PO_HB = PO_DQKV;
constexpr size_t PO_GO = PO_DQKV + (size_t)MT * 1024;
static_assert((size_t)3 * MT * 512 <= (size_t)MT * 1536, "HB and GO fit in the DQKV segment");

DEV void odd_kprep(const Ctx& c, int layer) {
    const bf16_t* KVC = (const bf16_t*)(c.ws + OFF_P) + PO_KVC; bf16_t* KP = (bf16_t*)(c.ws + SO_KP);
    const float* COS = (const float*)(c.ws + OFF_ROPE); const float* SIN = COS + (size_t)SEQ * 32; const float* kg = c.in[15] + (size_t)(layer >> 1) * 128 + 64;
    const int kv = c.lane >> 5, d0 = 2 * (c.lane & 31);
    const int a = d0 >> 5, p = (d0 >> 4) & 1, f0 = d0 & 15;
    for (int it = c.gw; it < NB * LK; it += c.ngw) { const int b = it / LK, pos = it % LK; const int row = pos_row(b, pos);
        const unsigned w = *(const unsigned*)(KVC + (size_t)row * 256 + 2 * c.lane);
        float x0 = bf2f(w & 0xffffu), x1 = bf2f(w >> 16);
        float ss = x0 * x0 + x1 * x1;
#pragma unroll
        for (int o = 1; o < 32; o <<= 1) ss += SHFL_XOR(ss, o);
        const float rstd = 1.0f / sqrtf(ss * (1.0f / 64.0f) + EPS);
        x0 *= rstd * kg[d0]; x1 *= rstd * kg[d0 + 1];
        const float y0 = SHFL_XOR(x0, 8), y1 = SHFL_XOR(x1, 8);
        if (pos >= CTX) { const int t = pos - CTX; const float c0 = COS[(size_t)t * 32 + a * 16 + f0], s0 = SIN[(size_t)t * 32 + a * 16 + f0], c1 = COS[(size_t)t * 32 + a * 16 + f0 + 1], s1 = SIN[(size_t)t * 32 + a * 16 + f0 + 1];
            x0 = p == 0 ? x0 * c0 - y0 * s0 : x0 * c0 + y0 * s0; x1 = p == 0 ? x1 * c1 - y1 * s1 : x1 * c1 + y1 * s1; }
        *(unsigned*)(KP + ((size_t)(b * 2 + kv) * LK + pos) * 64 + d0) = pk2(x0, x1); }
}
DEV void gqa_unit(const Ctx& c, int layer, int b, int h, bool ctxu, int qb) {
    const bf16_t* QC = (const bf16_t*)(c.ws + OFF_P) + PO_QC; const bf16_t* KP = (const bf16_t*)(c.ws + SO_KP); const bf16_t* VT = (const bf16_t*)(c.ws + SO_VT);
    bf16_t* QO = (bf16_t*)(c.ws + OFF_P) + PO_GO; const float* qg = c.in[15] + (size_t)(layer >> 1) * 128;
    const int r = c.lane & 31, hh = c.lane >> 5, kv = h >> 2; const int ql = qb * 256 + c.wave * 32 + r;
    const int nq = ctxu ? CTX : SEQ, nk = ctxu ? CTX : LK; const bool valid = ql < nq, active = (qb * 256 + c.wave * 32) < nq;
    const int row = ctxu ? ML + b * CTX + ql : b * SEQ + ql;
    const int orow = ctxu ? row : b * SEQ + (ql % 128) * (SEQ / 128) + ql / 128;
    f32x16 o[2]; float m, l; bf16x8 qf[4];
    load_q(c, QC + (size_t)row * 512 + h * 64, valid, !ctxu, ql, qg, qf);
    attn_pass<64>(c, KP + (size_t)(b * 2 + kv) * LK * 64, VT + (size_t)(b * 2 + kv) * 64 * LK, LK, nk, qf, active, o, m, l);
    if (active) { l += SHFL_XOR(l, 32); const float il = 1.0f / l;
        if (valid) {
#pragma unroll
            for (int dt = 0; dt < 2; ++dt)
#pragma unroll
                for (int q4 = 0; q4 < 4; ++q4) { const int dv = 32 * dt + 8 * q4 + 4 * hh; u32x2 w;
                    w[0] = pk2(o[dt][4 * q4 + 0] * il, o[dt][4 * q4 + 1] * il); w[1] = pk2(o[dt][4 * q4 + 2] * il, o[dt][4 * q4 + 3] * il);
                    *(u32x2*)(QO + (size_t)orow * 512 + h * 64 + dv) = w; } } }
}

constexpr int D1_CW_OFF = 110592;
#ifndef D1_STOP
#define D1_STOP 0
#endif
DEV void dn_d1_item(const Ctx& c, int layer, int it, int stop = 0) {
    const int tc = it % NCH, dir = (it / NCH) & 1, h = (it / (2 * NCH)) & 3, b = it / (8 * NCH);
    const int chain = (b * 4 + h) * 2 + dir, cc = chain_chunk(dir, tc); const size_t ci = (size_t)chain * NCH + cc; const int o = layer >> 1;
    const bf16_t* DQ = (const bf16_t*)(c.ws + OFF_P) + PO_DQKV; const float* G = (const float*)(c.ws + OFF_G);
    const float* cwl = (const float*)(c.lds + D1_CW_OFF); const float* alog = c.in[17] + (size_t)o * 8; const float* dtb = c.in[18] + (size_t)o * 8;
    bf16_t* Ub = (bf16_t*)(c.ws + SO_U) + ci * 8192; bf16_t* Wb = (bf16_t*)(c.ws + SO_W) + ci * 8192; bf16_t* ATb = (bf16_t*)(c.ws + SO_AT) + ci * 4096;
    bf16_t* QNb = (bf16_t*)(c.ws + SO_QN) + ci * 8192; bf16_t* KDb = (bf16_t*)(c.ws + SO_KD) + ci * 8192; float* GE = (float*)(c.ws + SO_GE);
    bf16_t* Qs = (bf16_t*)c.lds; bf16_t* Ks = Qs + 64 * 136; bf16_t* Kt = Ks + 64 * 136; bf16_t* Vt = Kt + 128 * 72; float* Am = (float*)(c.lds + (2 * 64 * 136 + 2 * 128 * 72) * 2); float* gc = Am + 64 * 65; float* be = gc + 64;
    float* gam = be + 64; float* T2 = gam + 64; float* Rb = T2 + 64 * 65;
    const int seqlen = tc < NCC ? CTX : SEQ, tok0 = tc < NCC ? 64 * tc : 64 * (tc - NCC), rowbase = tc < NCC ? ML + b * CTX : b * SEQ;
    if (c.wave == 0) { const int j = c.lane, i = dir ? 63 - j : j; const int row = rowbase + tok0 + i;
        const float beta = sigmoidf_(G[(size_t)row * 16 + dir * 8 + h]);
        const float ld = -expf(alog[dir * 4 + h]) * softplusf_(G[(size_t)row * 16 + dir * 8 + 4 + h] + dtb[dir * 4 + h]);
        const float gcum = chain_cumsum(ld, j, 0); gc[j] = gcum; be[j] = beta; gam[j] = expf(gcum);
        if (j == 63) GE[ci] = expf(gcum); }
    {   const int j = c.tid >> 3, cg = c.tid & 7, i = dir ? 63 - j : j, tok = tok0 + i;
        bf16x8 raw[3][2], rawn[3][2];
#define D1_LOADROWS(R, TEN) { _Pragma("unroll") for (int tap = 0; tap < 3; ++tap) { const int tk = tok + tap - 1; const bool in = tk >= 0 && tk < seqlen; \
            const bf16_t* src = DQ + (size_t)(rowbase + (in ? tk : tok)) * 1536 + (TEN) * 512 + h * 128 + 16 * cg; R[tap][0] = ld16(src); R[tap][1] = ld16(src + 8); \
            if (!in) { R[tap][0] = (bf16x8){0, 0, 0, 0, 0, 0, 0, 0}; R[tap][1] = (bf16x8){0, 0, 0, 0, 0, 0, 0, 0}; } } }
        D1_LOADROWS(rawn, 0);
#pragma unroll 1
        for (int ten = 0; ten < 3; ++ten) { const int col = ten * 512 + h * 128 + 16 * cg;
            float val[16];
#pragma unroll
            for (int e = 0; e < 16; ++e) val[e] = 0.f;
#pragma unroll
            for (int tap = 0; tap < 3; ++tap) { raw[tap][0] = rawn[tap][0]; raw[tap][1] = rawn[tap][1]; }
            if (ten < 2) D1_LOADROWS(rawn, ten + 1);
            SCHED_FENCE();
#pragma unroll
            for (int tap = 0; tap < 3; ++tap) { float f0[8], f1[8]; unpack8(raw[tap][0], f0); unpack8(raw[tap][1], f1);
                const float* wp = cwl + tap * 1536 + col;
#pragma unroll
                for (int e = 0; e < 8; ++e) { val[e] += f0[e] * wp[e]; val[8 + e] += f1[e] * wp[8 + e]; }
                SCHED_FENCE(); }
#pragma unroll
            for (int e = 0; e < 16; ++e) val[e] = siluf_(val[e]);
            if (ten < 2) { float ss = 0.f;
#pragma unroll
                for (int e = 0; e < 16; ++e) ss += val[e] * val[e];
                ss += SHFL_XOR(ss, 1); ss += SHFL_XOR(ss, 2); ss += SHFL_XOR(ss, 4);
                const float sc = (1.0f / sqrtf(ss + EPS)) * (ten == 0 ? 0.08838834764831845f : 1.0f);
#pragma unroll
                for (int e = 0; e < 16; ++e) val[e] *= sc; }
            if (ten < 2) { bf16_t* dst = (ten == 0 ? Qs : Ks) + j * 136 + 16 * cg; float fa[8], fb[8];
#pragma unroll
                for (int e = 0; e < 8; ++e) { fa[e] = val[e]; fb[e] = val[8 + e]; }
                *(bf16x8*)dst = pack8(fa); *(bf16x8*)(dst + 8) = pack8(fb); }
            if (ten >= 1) { bf16_t* dstT = (ten == 1 ? Kt : Vt);
#pragma unroll
                for (int e = 0; e < 16; ++e) dstT[(16 * cg + e) * 72 + (((j >> 3) ^ cg) << 3) + (j & 7)] = (bf16_t)f2bf(val[e]); } } }
    BLOCK_SYNC(); if (stop == 1) return;
    const int r = c.lane & 31, hh = c.lane >> 5;
    {
        const int wq = c.wave & 3, tt = wq >> 1, st = wq & 1; const bool isq = c.wave >= 4;
        f32x16 acc;
#pragma unroll
        for (int i = 0; i < 16; ++i) acc[i] = 0.f;
        const bf16_t* Ar = (isq ? Qs : Ks) + (32 * tt + r) * 136; const bf16_t* Br = Ks + (32 * st + r) * 136;
#pragma unroll
        for (int ks = 0; ks < 8; ++ks) acc = MFMA32(ld16(Ar + 16 * ks + 8 * hh), ld16(Br + 16 * ks + 8 * hh), acc);
        const int s = 32 * st + r; const float gs = gc[s];
#pragma unroll
        for (int i = 0; i < 16; ++i) { const int t = 32 * tt + crow(i, hh); const float dec = expf(gc[t] - gs);
            if (!isq) Am[t * 65 + s] = t > s ? be[t] * dec * acc[i] : 0.f;
            else ATb[t * 64 + s] = (bf16_t)f2bf(t >= s ? dec * acc[i] : 0.f); } }
    BLOCK_SYNC(); if (stop == 2) return;
    if (c.wave == 0) { const int d = c.lane >> 4, cc = c.lane & 15; const float* Ad = Am + (16 * d) * 65 + 16 * d; float* Td = T2 + (16 * d) * 65 + 16 * d;
        float t[16];
#pragma unroll
        for (int i = 0; i < 16; ++i) { float acc = (cc == i) ? 1.f : 0.f;
#pragma unroll
            for (int j = 0; j < i; ++j) acc -= Ad[i * 65 + j] * t[j];
            t[i] = acc; }
#pragma unroll
        for (int i = 0; i < 16; ++i) Td[i * 65 + cc] = t[i]; }
    else { for (int e = c.tid - 64; e < 64 * 64; e += NTHREADS - 64) { const int t = e >> 6, s2 = e & 63; if ((s2 >> 4) > (t >> 4)) T2[t * 65 + s2] = 0.f; } }
    BLOCK_SYNC();
    for (int rb = 1; rb < 4; ++rb) { const int wcols = 16 * rb;
        for (int e = c.tid; e < 16 * wcols; e += NTHREADS) { const int i = e & 15, cidx = e >> 4; float acc = 0.f; const float* Ar = Am + (16 * rb + i) * 65;
            for (int kb = cidx & ~15; kb < wcols; kb += 16) {
#pragma unroll
                for (int kk = 0; kk < 16; ++kk) acc += Ar[kb + kk] * T2[(kb + kk) * 65 + cidx]; }
            Rb[i * 49 + cidx] = acc; }
        BLOCK_SYNC();
        for (int e = c.tid; e < 16 * wcols; e += NTHREADS) { const int i = e & 15, cidx = e >> 4; float acc = 0.f; const float* Tr = T2 + (16 * rb + i) * 65 + 16 * rb;
#pragma unroll
            for (int j = 0; j < 16; ++j) acc += Tr[j] * Rb[j * 49 + cidx];
            T2[(16 * rb + i) * 65 + cidx] = -acc; }
        BLOCK_SYNC(); }
    if (stop == 3) return;
#ifndef EMU
    int lane2_ = c.lane; asm volatile("" : "+v"(lane2_));
    const int r2 = lane2_ & 31, hh2 = lane2_ >> 5;
#else
    const int r2 = r, hh2 = hh;
#endif
    {
#pragma unroll
        for (int rep = 0; rep < 2; ++rep) { const int idx = c.wave + 8 * rep, isw = idx >> 3, tt = (idx >> 2) & 1, ct = idx & 3;
            f32x16 acc;
#pragma unroll
            for (int i = 0; i < 16; ++i) acc[i] = 0.f;
            const bf16_t* Bt = (isw ? Kt : Vt) + (32 * ct + r2) * 72;
#pragma unroll
            for (int ks = 0; ks < 4; ++ks) { float f[8];
#pragma unroll
                for (int e = 0; e < 8; ++e) { const int s = 16 * ks + 8 * hh2 + e; f[e] = T2[(32 * tt + r2) * 65 + s] * be[s] * (isw ? gam[s] : 1.0f); }
                acc = MFMA32(pack8(f), ld16(Bt + 8 * ((2 * ks + hh2) ^ (((32 * ct + r2) >> 4) & 7))), acc); }
            bf16_t* dst = (isw ? Wb : Ub);
#pragma unroll
            for (int i = 0; i < 16; ++i) dst[(32 * tt + crow(i, hh2)) * 128 + 32 * ct + r2] = (bf16_t)f2bf(acc[i]); } }
    {
        const float gend = gc[63];
        const int j = c.tid >> 3, cg = c.tid & 7; const float gamj = gam[j];
#pragma unroll
        for (int half = 0; half < 2; ++half) { float f[8]; unpack8(ld16(Qs + j * 136 + 16 * cg + 8 * half), f);
#pragma unroll
            for (int e = 0; e < 8; ++e) f[e] *= gamj;
            *(bf16x8*)(QNb + j * 128 + 16 * cg + 8 * half) = pack8(f); }
#pragma unroll
        for (int ii = 0; ii < 2; ++ii) { const int idx = c.tid + 512 * ii, dk = idx >> 3, ch = idx & 7; float f[8]; unpack8(ld16(Kt + dk * 72 + 8 * (ch ^ ((dk >> 4) & 7))), f);
#pragma unroll
            for (int e = 0; e < 8; ++e) f[e] *= expf(gend - gc[8 * ch + e]);
            *(bf16x8*)(KDb + dk * 64 + 8 * ch) = pack8(f); } }
    BLOCK_SYNC();
}
constexpr int D2_PW = 132, D2_PA = 68;
constexpr int D2_W = 0, D2_QN = 64 * D2_PW * 2, D2_AT = 2 * 64 * D2_PW * 2, D2_KD = D2_AT + 64 * D2_PA * 2, D2_BUF = D2_KD + 128 * D2_PA * 2;
static_assert(2 * D2_BUF <= LDS_MISC, "two D2 buffers fit below the LDS control words");
DEV void dn_d2_stage(const Ctx& c, size_t ci, char* buf) {
    const bf16_t* Wb = (const bf16_t*)(c.ws + SO_W) + ci * 8192; const bf16_t* QNb = (const bf16_t*)(c.ws + SO_QN) + ci * 8192; const bf16_t* ATb = (const bf16_t*)(c.ws + SO_AT) + ci * 4096; const bf16_t* KDb = (const bf16_t*)(c.ws + SO_KD) + ci * 8192;
    const int lt = c.tid - 256;
#pragma unroll 2
    for (int i = 0; i < 14; ++i) { const int idx = lt + 256 * i; const bf16_t* src; char* dst;
        if (idx < 1024) { const int row = idx >> 4, ch = idx & 15; src = Wb + row * 128 + 8 * ch; dst = buf + D2_W + (row * D2_PW + 8 * ch) * 2; }
        else if (idx < 2048) { const int j = idx - 1024, row = j >> 4, ch = j & 15; src = QNb + row * 128 + 8 * ch; dst = buf + D2_QN + (row * D2_PW + 8 * ch) * 2; }
        else if (idx < 2560) { const int j = idx - 2048, row = j >> 3, ch = j & 7; src = ATb + row * 64 + 8 * ch; dst = buf + D2_AT + (row * D2_PA + 8 * ch) * 2; }
        else { const int j = idx - 2560, row = j >> 3, ch = j & 7; src = KDb + row * 64 + 8 * ch; dst = buf + D2_KD + (row * D2_PA + 8 * ch) * 2; }
        const bf16x8 v = ld16(src); const bf16x4 lo = __builtin_shufflevector(v, v, 0, 1, 2, 3), hi = __builtin_shufflevector(v, v, 4, 5, 6, 7);
        *(bf16x4*)dst = lo; *(bf16x4*)(dst + 8) = hi; }
}
DEV void dn_d2_chain(const Ctx& c, int chain, bool emit_ctx) {
    const int dir = chain & 1, h = (chain >> 1) & 3, b = chain >> 3; const int r = c.lane & 31, hh = c.lane >> 5, sl = c.wave & 3; const bool comp = c.wave < 4;
    const bf16_t* U0 = (const bf16_t*)(c.ws + SO_U); const float* GE = (const float*)(c.ws + SO_GE);
    bf16_t* HB = (bf16_t*)(c.ws + OFF_P) + PO_HB + (size_t)dir * MT * 512;
    f32x16 S[4];
#pragma unroll
    for (int t4 = 0; t4 < 4; ++t4)
#pragma unroll
        for (int i = 0; i < 16; ++i) S[t4][i] = 0.f;
    if (!comp) dn_d2_stage(c, (size_t)chain * NCH, c.lds);
    BLOCK_SYNC();
    for (int cc = 0; cc < NCH; ++cc) { const size_t ci = (size_t)chain * NCH + cc; char* buf = c.lds + (cc & 1) * D2_BUF;
        if (!comp) { if (cc + 1 < NCH) dn_d2_stage(c, ci + 1, c.lds + ((cc + 1) & 1) * D2_BUF); }
        else {
            const bf16_t* Ub = U0 + ci * 8192; const bf16_t* Wl = (const bf16_t*)(buf + D2_W); const bf16_t* QNl = (const bf16_t*)(buf + D2_QN); const bf16_t* ATl = (const bf16_t*)(buf + D2_AT); const bf16_t* KDl = (const bf16_t*)(buf + D2_KD);
            f32x16 u[2], ov[2];
#pragma unroll
            for (int tt = 0; tt < 2; ++tt)
#pragma unroll
                for (int i = 0; i < 16; ++i) { u[tt][i] = -bf2f(Ub[(32 * tt + crow(i, hh)) * 128 + 32 * sl + r]); ov[tt][i] = 0.f; }
#pragma unroll
            for (int ks = 0; ks < 8; ++ks) { const bf16x8 sf = pack_acc(S[ks >> 1], ks & 1); const int k0 = 16 * ks + 4 * hh;
#pragma unroll
                for (int tt = 0; tt < 2; ++tt) { const bf16_t* wp = Wl + (32 * tt + r) * D2_PW + k0; const bf16_t* qp = QNl + (32 * tt + r) * D2_PW + k0;
                    u[tt] = MFMA32(cat44(*(const bf16x4*)wp, *(const bf16x4*)(wp + 8)), sf, u[tt]);
                    ov[tt] = MFMA32(cat44(*(const bf16x4*)qp, *(const bf16x4*)(qp + 8)), sf, ov[tt]); } }
#pragma unroll
            for (int tt = 0; tt < 2; ++tt)
#pragma unroll
                for (int i = 0; i < 16; ++i) u[tt][i] = -u[tt][i];
            const float ge = GE[ci];
#pragma unroll
            for (int t4 = 0; t4 < 4; ++t4)
#pragma unroll
                for (int i = 0; i < 16; ++i) S[t4][i] *= ge;
#pragma unroll
            for (int ks = 0; ks < 4; ++ks) { const bf16x8 uf = pack_acc(u[ks >> 1], ks & 1);
#pragma unroll
                for (int tt = 0; tt < 2; ++tt) { const bf16_t* ap = ATl + (32 * tt + r) * D2_PA + 16 * ks + 4 * hh;
                    ov[tt] = MFMA32(cat44(*(const bf16x4*)ap, *(const bf16x4*)(ap + 8)), uf, ov[tt]); }
#pragma unroll
                for (int t4 = 0; t4 < 4; ++t4) { const bf16_t* kp = KDl + (32 * t4 + r) * D2_PA + 16 * ks + 4 * hh;
                    S[t4] = MFMA32(cat44(*(const bf16x4*)kp, *(const bf16x4*)(kp + 8)), uf, S[t4]); } }
            const int tc = dir == 0 ? cc : (cc < NCC ? NCC - 1 - cc : NCC + (NLC - 1 - (cc - NCC)));
            if (tc >= NCC || emit_ctx) {
#pragma unroll
                for (int tt = 0; tt < 2; ++tt)
#pragma unroll
                    for (int i = 0; i < 16; ++i) { const int j = 32 * tt + crow(i, hh); const int row = tok_row(b, tc, dir ? 63 - j : j);
                        HB[(size_t)row * 512 + h * 128 + 32 * sl + r] = (bf16_t)f2bf(ov[tt][i]); } }
        }
        BLOCK_SYNC();
    }
}
DEV void dn_yasm(const Ctx& c, int layer, int nrows) {
    const bf16_t* HB = (const bf16_t*)(c.ws + OFF_P) + PO_HB; const bf16_t* Z = (const bf16_t*)(c.ws + OFF_P) + PO_Z; const bf16_t* QC = (const bf16_t*)(c.ws + OFF_P) + PO_GO; bf16_t* Y = (bf16_t*)(c.ws + OFF_HY);
    const float* gn = c.in[19] + (size_t)(layer >> 1) * 128;
    for (int it = c.gw; it < nrows * 2; it += c.ngw) { const int row = it >> 1, col = (it & 1) * 256 + 4 * c.lane;
        const bf16x4 a = *(const bf16x4*)(HB + (size_t)row * 512 + col), bb = *(const bf16x4*)(HB + (size_t)MT * 512 + (size_t)row * 512 + col), z = *(const bf16x4*)(Z + (size_t)row * 512 + col);
        float v[4], ss = 0.f;
#pragma unroll
        for (int e = 0; e < 4; ++e) { v[e] = bf2f((unsigned short)a[e]) + bf2f((unsigned short)bb[e]); ss += v[e] * v[e]; }
#pragma unroll
        for (int o = 1; o < 32; o <<= 1) ss += SHFL_XOR(ss, o);
        const float rstd = 1.0f / sqrtf(ss * (1.0f / 128.0f) + EPS);
        float y[4];
#pragma unroll
        for (int e = 0; e < 4; ++e) y[e] = v[e] * rstd * gn[(col & 127) + e] * siluf_(bf2f((unsigned short)z[e]));
        u32x2 w; w[0] = pk2(y[0], y[1]); w[1] = pk2(y[2], y[3]);
        *(u32x2*)(Y + (size_t)row * 1024 + 512 + col) = w;
        *(u32x2*)(Y + (size_t)row * 1024 + col) = *(const u32x2*)(QC + (size_t)row * 512 + col); }
}

DEV void gqa_units(const Ctx& c, int layer, bool emit_ctx, int first, int stride) {
    constexpr int NQBL = SEQ / 256, NQBC = (CTX + 255) / 256, NUL = NB * 8 * NQBL, NUC = NB * 8 * NQBC;
    const int nuc = emit_ctx ? NUC : 0;
    for (int it = first; it < NUL + nuc; it += stride) { const bool cu = it >= NUL; int u = cu ? it - NUL : it; const int nqb = cu ? NQBC : NQBL;
        gqa_unit(c, layer, u / (8 * nqb), (u / nqb) & 7, cu, u % nqb); }
}
DEV void mix_odd_a(const Ctx& c, int layer) {
    { PHASE_CTX(pc); if (ON(14)) odd_kprep(pc, layer); }
    { PHASE_CTX(pc); if (ON(15)) { const bf16_t* KVC = (const bf16_t*)(pc.ws + OFF_P) + PO_KVC; bf16_t* VT = (bf16_t*)(pc.ws + SO_VT);
        for (int it = pc.bid; it < NB * 2 * NCH; it += pc.nblk) { const int pch = it % NCH, bk = it / NCH; vt_item<64>(pc, KVC, 256, 128 + (bk & 1) * 64, bk >> 1, pch, VT + (size_t)bk * 64 * LK); } } }
    REPB(16) { PHASE_CTX(pc); if (ON(16)) {
        { const float* convw = pc.in[16] + (size_t)(layer >> 1) * 3 * 1536; float* cwl = (float*)(pc.lds + D1_CW_OFF); BLOCK_SYNC();
          for (int e = pc.tid; e < 3 * 1536 / 4; e += NTHREADS) ((f32x4*)cwl)[e] = ((const f32x4*)convw)[e];
          BLOCK_SYNC(); }
        for (int it = pc.bid; it < NCHAIN * NCH; it += pc.nblk) dn_d1_item(pc, layer, it, (rep_ < (int)(((unsigned long long)(REPM) >> 16) & 1ull)) ? D1_STOP : 0); } }
}
DEV void mix_odd_b(const Ctx& c, int layer, bool emit_ctx) {
    const int nd2 = NCHAIN < c.nblk ? NCHAIN : c.nblk;
    const int na = c.nblk - nd2;
    REPB(17) { PHASE_CTX(pc); if (ON(17)) if (pc.bid < nd2) { for (int ch = pc.bid; ch < NCHAIN; ch += nd2) dn_d2_chain(pc, ch, emit_ctx); } }
    REPB(18) { PHASE_CTX(pc); if (ON(18)) { if (na > 0) { if (pc.bid >= nd2) gqa_units(pc, layer, emit_ctx, pc.bid - nd2, na); } else gqa_units(pc, layer, emit_ctx, pc.bid, pc.nblk); } }
}
DEV void mix_odd_c(const Ctx& c, int layer, bool emit_ctx) {
    { PHASE_CTX(pc); if (ON(19)) dn_yasm(pc, layer, emit_ctx ? MT : ML); }
}

#ifdef SELFTEST
#ifdef EMU
#define ST_HD static inline
#else
#define ST_HD __host__ __device__ inline
#endif
constexpr size_t ST_CHK = 512 * 1024;
ST_HD unsigned st_hash(unsigned a, unsigned b) { unsigned x = a * 0x9E3779B1u ^ (b + 0x7F4A7C15u) * 0x85EBCA6Bu; x ^= x >> 16; x *= 0x7FEB352Du; x ^= x >> 15; x *= 0x846CA68Bu; x ^= x >> 16; return x; }
ST_HD float st_uniform(unsigned t, unsigned i) { return (float)(st_hash(t, i) >> 8) * (1.0f / 16777216.0f); }
ST_HD float st_normal(unsigned tensor, unsigned idx) { const float u1 = ((float)(st_hash(tensor * 4u, idx) >> 8) + 0.5f) * (1.0f / 16777216.0f), u2 = (float)(st_hash(tensor * 4u + 1u, idx) >> 8) * (1.0f / 16777216.0f); return sqrtf(-2.0f * logf(u1)) * cosf(6.2831853f * u2); }
ST_HD size_t st_count(int i) {
    switch (i) {
    case 0: return (size_t)NB * SEQ * D; case 1: return (size_t)NB * D; case 2: return (size_t)NB * CTX * D; case 3: return D;
    case 4: return (size_t)DEPTH * D * 6 * D; case 5: return (size_t)DEPTH * 6 * D; case 6: case 7: return (size_t)DEPTH * D;
    case 8: return (size_t)2 * D * E_IN; case 9: return 32; case 10: return 512; case 11: case 12: return 256; case 13: return (size_t)2 * 1024 * D;
    case 14: return (size_t)2 * D * O_IN; case 15: return 256; case 16: return 2 * 3 * 1536; case 17: return 16; case 18: return 16; case 19: return 256; case 20: return (size_t)2 * 1024 * D;
    case 21: case 22: return (size_t)DEPTH * D * FF; case 23: return (size_t)DEPTH * FF * D; default: return D; }
}
ST_HD float st_value(int i, size_t idx) {
#ifdef ST_SAME_BATCH
    if (i == 0) idx %= (size_t)SEQ * D; if (i == 1) idx %= (size_t)D; if (i == 2) idx %= (size_t)CTX * D;
#endif
    const float d = (float)D; const float n = st_normal((unsigned)i + 1u, (unsigned)idx);
    switch (i) {
    case 0: case 1: case 2: case 3: return n;
    case 4: return n * 0.5f / sqrtf(d); case 5: return n * 0.02f; case 6: case 7: case 11: case 12: case 15: case 19: case 24: return 1.0f + 0.02f * n;
    case 8: case 14: case 21: case 22: return n / sqrtf(d);
    case 9: return 0.1f * n + ((idx & 4) ? 3.0f + (float)(idx & 3) : 0.0f);
    case 10: return 0.1f * n; case 13: case 20: return n * (1.0f / 32.0f); case 16: return n * 0.57735027f;
    case 17: return logf(1.0f + 5.0f * (float)(idx & 3)) + 0.05f * n;
    case 18: { const float dt = expf(-6.9077553f + 4.6051702f * st_uniform(999u, (unsigned)idx)); return dt + logf(-expm1f(-dt)); }
    case 23: return n / sqrtf((float)FF);
    default: return n; }
}
ST_HD size_t st_offset(int i) { size_t o = 0; for (int k = 0; k < i; ++k) o += (st_count(k) + 63) & ~(size_t)63; return o; }
DEV void st_sum(const Ctx& c, int step, int sub, const void* base, size_t n, int is_bf16) {
    step += c.ngw;
    double p[8], s2 = 0.0;
#pragma unroll
    for (int k = 0; k < 8; ++k) p[k] = 0.0;
    const size_t gt = (size_t)c.bid * NTHREADS + c.tid, GT = (size_t)c.nblk * NTHREADS;
    for (size_t i = gt; i < n; i += GT) { const float v = is_bf16 ? bf2f(((const bf16_t*)base)[i]) : ((const float*)base)[i]; const unsigned h = st_hash(0xC0FFEEu + (unsigned)sub, (unsigned)i); s2 += (double)v * (double)v;
#pragma unroll
        for (int k = 0; k < 8; ++k) p[k] += ((h >> (k + 8)) & 1u) ? (double)v : -(double)v; }
    double* chk = (double*)(c.ws + ST_CHK) + ((size_t)step * 4 + sub) * 10;
#ifdef EMU
    for (int k = 0; k < 8; ++k) chk[k] += p[k];
    chk[8] += s2; if (gt == 0) chk[9] = (double)n;
#else
#pragma unroll
    for (int k = 0; k < 8; ++k) atomicAdd(chk + k, p[k]);
    atomicAdd(chk + 8, s2); if (gt == 0) chk[9] = (double)n;
#endif
}
DEV void st_checks(const Ctx& c, int step) {

    const int layer = step / 9, ph = step - 9 * layer, odd = layer & 1; const size_t mrows = layer < DEPTH - 1 ? MT : ML; unsigned char* ws = c.ws;
    if (ph == 0) { st_sum(c, step, 0, ws + OFF_HY, (size_t)MT * D, 1); st_sum(c, step, 1, ws + OFF_G, (size_t)MT * 16, 0); st_sum(c, step, 2, ws + OFF_WIN, (size_t)(odd ? NO : NE) * D, 1); st_sum(c, step, 3, ws + OFF_WOUT, (size_t)D * 1024, 1); }
    else if (ph == 1) { st_sum(c, step, 0, ws + OFF_P, (size_t)MT * (odd ? NO : NE), 1); }
    else if (ph == 2) { if (!odd) { st_sum(c, step, 0, ws + SE_KP, (size_t)NB * 8 * LK * 64, 1); st_sum(c, step, 1, ws + SE_VT, (size_t)NB * 4 * 128 * LK, 1); st_sum(c, step, 2, ws + SE_DCT, (size_t)NCHAIN * NCH * 8192, 0); st_sum(c, step, 3, ws + SE_DN, (size_t)NCHAIN * NCH * 64, 0); }
        else { st_sum(c, step, 0, ws + SO_KP, (size_t)NB * 2 * LK * 64 * 2, 1); st_sum(c, step, 1, ws + SO_U, (size_t)NCHAIN * NCH * 8192, 1); st_sum(c, step, 2, ws + SO_W, (size_t)NCHAIN * NCH * 8192, 1); st_sum(c, step, 3, ws + SO_AT, (size_t)NCHAIN * NCH * (4096 + 8192 + 8192), 1); } }
    else if (ph == 3) { if (!odd) { st_sum(c, step, 0, ws + SE_DCT, (size_t)NCHAIN * NCH * 8192, 0); st_sum(c, step, 1, ws + SE_DN, (size_t)NCHAIN * NCH * 64, 0); }
        else { st_sum(c, step, 0, ws + OFF_P + PO_HB * 2, (size_t)mrows * 512, 1); st_sum(c, step, 1, ws + OFF_P + (PO_HB + (size_t)MT * 512) * 2, (size_t)mrows * 512, 1); st_sum(c, step, 2, ws + OFF_P + PO_GO * 2, (size_t)mrows * 512, 1); } }
    else if (ph == 4) { st_sum(c, step, 0, ws + OFF_HY, (size_t)mrows * 1024, 1); }
    else if (ph == 5 || ph == 8) { st_sum(c, step, 0, ws + OFF_X, (size_t)mrows * D, 0); }
    else if (ph == 6) { st_sum(c, step, 0, ws + OFF_HY, (size_t)mrows * D, 1); st_sum(c, step, 1, ws + SF_WGU, (size_t)2 * FF * D, 1); st_sum(c, step, 2, ws + SF_WDN, (size_t)D * FF, 1); }
    else { st_sum(c, step, 0, ws + OFF_P, (size_t)mrows * FF, 1); }
}
#endif

DEV void final_norm(const Ctx& c) {
    constexpr int NV = D / 256;
    const float* X = (const float*)(c.ws + OFF_X); const float* g = c.in[24];
    for (int row = c.gw; row < ML; row += c.ngw) {
        const f32x4* xr = (const f32x4*)(X + (size_t)row * D) + c.lane; f32x4 v[NV]; float ss = 0.f;
#pragma unroll
        for (int j = 0; j < NV; ++j) { v[j] = xr[64 * j]; ss += (v[j][0] * v[j][0] + v[j][1] * v[j][1]) + (v[j][2] * v[j][2] + v[j][3] * v[j][3]); }
        const float rstd = 1.0f / sqrtf(wave_sum(ss) * (1.0f / D) + EPS);
        f32x4* o = (f32x4*)(c.out + (size_t)row * D) + c.lane;
#pragma unroll
        for (int j = 0; j < NV; ++j) o[64 * j] = v[j] * rstd * *(const f32x4*)(g + 256 * j + 4 * c.lane);
    }
}

constexpr size_t WS_NEED = cmax(WS_NEED_EF, SO_END);
#ifdef EMU
static void mega(Args args) {
    char* lds = emu::blocks[EMU_BID].lds;
    XcdBarrier bar; bar.dummy = 0;
#else
__global__ void __launch_bounds__(NTHREADS, 2) mega(Args args) {
    extern __shared__ __attribute__((aligned(16))) unsigned char lds_raw[];
    char* lds = (char*)lds_raw;
    {   volatile LAS unsigned* misc0 = (volatile LAS unsigned*)((LAS unsigned char*)lds_raw + LDS_MISC);
        if (threadIdx.x < 64) misc0[threadIdx.x] = 0u; }
    __syncthreads();
    XcdBarrier bar = xcd_barrier_post((unsigned*)(args.ws + OFF_CTL) + 4096, (volatile LAS unsigned*)((LAS unsigned char*)lds_raw + LDS_MISC) + 8);
#endif
    Ctx c;
#ifdef EMU
    c.tid = TIDX; c.lane = c.tid & 63; c.wave = c.tid >> 6;
#else
    c.tid = 0; c.lane = 0; c.wave = 0;
#endif
    c.bid = BIDX; c.nblk = NBLK; c.gw = c.bid * NWAVES + c.wave; c.ngw = c.nblk * NWAVES; c.lds = lds; c.in = args.in; c.out = args.out; c.ws = args.ws;

    if (args.prologue) {
    { PHASE_CTX(pc); if (ON(0)) p0_prologue(pc); }
#ifndef EMU
    cg::this_grid().sync();
#else
    GRID_BARRIER();
#endif
    }
#ifndef REPEAT_PH
#define REPEAT_PH -1
#endif
    for (int step2 = 2 * args.step_lo; step2 < 2 * args.step_hi; ++step2) {
        const int step = step2 >> 1; if ((step2 & 1) && !((step % 9) == REPEAT_PH && (REPEAT_PH != 3 || ((step / 9) & 1)))) continue;
        const int layer = step / 9, ph = step - 9 * layer;
        const int odd = layer & 1; const bool emit_ctx = layer < DEPTH - 1; const int mrows = emit_ctx ? MT : ML;
        if (ph == 0) {
            { PHASE_CTX(pc); if (ON(1) && (layer == 0 || step == args.step_lo)) convert_mixer_weights(pc, layer, pc.gw, pc.ngw); }
            { PHASE_CTX(pc); const bool prev = layer > 0 && step > args.step_lo; const int pm_ = MT;
              const SplitPlan red = split_plan(pm_, FF, pc.nblk, prev);
              if (ON(2)) normalize_rows(pc, layer, 0, MT, red, pm_, (const float*)(pc.ws + OFF_MOD) + (size_t)(layer - (prev ? 1 : 0)) * 9 * 6 * D + 5 * D); }
        } else if (ph == 1) {
            if (ON(3)) { PHASE_CTX(pc); pg8::Gemm g{(const bf16_t*)(pc.ws + OFF_HY), (const bf16_t*)(pc.ws + OFF_WIN), MT, odd ? NO : NE, D}; pg8::StaticOrder S; S.init(MT, odd ? NO : NE, c.nblk, c.bid); S.wave = pc.wave;
                if (odd && !emit_ctx && NO == 2816) { S.init(ML, NO, c.nblk, c.bid); S.wave = pc.wave; S.tn = (MC / 256) * 7; S.tpm = ML / 256; S.tpn = 2; S.tw = 7; }
                EpiSeg E{(bf16_t*)(pc.ws + OFF_P), odd};
                GEMM_PHASE(EpiSeg, lds, g, S, E); }
        } else if (ph == 2) { if (!odd) mix_even_a(c, layer); else mix_odd_a(c, layer); }
        else if (ph == 3) { if (!odd) mix_even_b(c, layer); else mix_odd_b(c, layer, emit_ctx); }
        else if (ph == 4) { if (!odd) mix_even_c(c, layer); else mix_odd_c(c, layer, emit_ctx); }
        else if (ph == 5 || ph == 8) {
            if (ON(4)) { PHASE_CTX(pc); const bool dn = ph == 8;
                const int kdim = dn ? FF : 1024; const SplitPlan sp = split_plan(mrows, kdim, pc.nblk, dn && layer + 1 < CFG_LAYERS);
                pg8::Gemm g{(const bf16_t*)(pc.ws + (dn ? OFF_P : OFF_HY)), (const bf16_t*)(pc.ws + (dn ? SF_WDN : OFF_WOUT)), mrows, D, kdim}; pg8::StaticOrder S; S.init(mrows, D, c.nblk, c.bid); S.wave = pc.wave;
                if (sp.extra) S.lim = pc.nblk;
                const bool first = layer == 0 && !dn;
                EpiResid E{(float*)(pc.ws + OFF_X), (const float*)(pc.ws + OFF_MOD) + (size_t)layer * 9 * 6 * D, dn ? 5 * D : 2 * D,
                           first ? pc.in[0] : (const float*)(pc.ws + OFF_X), first ? pc.in[2] - (size_t)ML * D : (const float*)(pc.ws + OFF_X)};
                GEMM_PHASE(EpiResid, lds, g, S, E);
                if (sp.extra && pc.bid < sp.extra * sp.split) {
                    const int lu = pc.bid / sp.split, q = pc.bid % sp.split, pairs = kdim / 128, base = pairs / sp.split, rem = pairs % sp.split;
                    const int np = base + (q < rem ? 1 : 0), p0 = q * base + (q < rem ? q : rem);
                    pg8::Gemm g2{g.A + (size_t)p0 * 128, g.Bt + (size_t)p0 * 128, mrows, D, np * 128, kdim}; pg8::StaticOrder S2; S2.init(mrows, D, sp.nwg, pc.nblk + lu); S2.wave = pc.wave;
                    EpiPart E2{(float*)(pc.ws + SF_PART) + (size_t)pc.bid * 65536};
                    BLOCK_SYNC();
                    GEMM_PHASE(EpiPart, lds, g2, S2, E2); } }
            { PHASE_CTX(pc); const SplitPlan sp = split_plan(mrows, ph == 8 ? FF : 1024, pc.nblk, ph == 8 && layer + 1 < CFG_LAYERS);
              const int nwg = sp.nwg; int busy = (nwg > pc.nblk && nwg < 2 * pc.nblk) ? nwg - pc.nblk : 0; if (sp.extra) busy = (pc.nblk - sp.extra * sp.split > pc.nblk / 4) ? sp.extra * sp.split : 0;
              if (ON(1) && pc.bid >= busy) { BLOCK_SYNC();
                  if (ph == 5) convert_ffn_weights(pc, layer, (pc.bid - busy) * NWAVES + pc.wave, (pc.nblk - busy) * NWAVES);
                  else if (layer + 1 < CFG_LAYERS && step + 1 < args.step_hi) convert_mixer_weights(pc, layer + 1, (pc.bid - busy) * NWAVES + pc.wave, (pc.nblk - busy) * NWAVES); } }
        } else if (ph == 6) {
            { PHASE_CTX(pc); const SplitPlan red = split_plan(mrows, 1024, pc.nblk, false);
              if (ON(2)) normalize_rows(pc, layer, 1, mrows, red, mrows, (const float*)(pc.ws + OFF_MOD) + (size_t)layer * 9 * 6 * D + 2 * D); }
        } else {
            if (ON(5)) { PHASE_CTX(pc); pg8::Gemm g{(const bf16_t*)(pc.ws + OFF_HY), (const bf16_t*)(pc.ws + SF_WGU), mrows, 2 * FF, D}; pg8::StaticOrder S; S.init(mrows, 2 * FF, c.nblk, c.bid); S.wave = pc.wave;
                EpiSwiglu E{(bf16_t*)(pc.ws + OFF_P)};
                GEMM_PHASE(EpiSwiglu, lds, g, S, E); }
        }
        if (step + 1 < args.step_hi || args.final_) GRID_BARRIER();
#ifdef EMU_STOP_AFTER_MIX
        if (layer == CFG_LAYERS - 1 && ph == 4) return;
#endif
    }
    if (args.final_) { PHASE_CTX(pc); if (ON(7)) final_norm(pc); }
}

#ifndef EMU
#ifdef PROBE_Y
__global__ void pr_stat(const bf16_t* Y, int rows, int c0, int c1, double* acc) {
    double s = 0.0, cnt = 0.0; float mx = 0.f;
    for (size_t k = (size_t)blockIdx.x * blockDim.x + threadIdx.x; k < (size_t)rows * 1024; k += (size_t)gridDim.x * blockDim.x) { const int col = (int)(k & 1023); if (col < c0 || col >= c1) continue;
        const float v = bf2f(Y[k]); s += (double)v * v; cnt += 1.0; mx = fmaxf(mx, fabsf(v)); }
    atomicAdd(acc, s); atomicAdd(acc + 1, cnt); atomicMax((unsigned long long*)acc + 2, (unsigned long long)(mx * 1e6f));
}
__global__ void pr_fill(const double* acc, float* out, int n) {
    const float rms = (float)sqrt(acc[0] / acc[1]), mx = (float)((const unsigned long long*)acc)[2] * 1e-6f;
    const float c = sqrtf(rms * 10.0f), B = mx * 10.0f;
    for (size_t k = (size_t)blockIdx.x * blockDim.x + threadIdx.x; k < (size_t)n; k += (size_t)gridDim.x * blockDim.x) out[k] = (k == 12345) ? B : c;
}
#endif
#ifdef SELFTEST
struct StPtrs { float* p[25]; };
__global__ void st_gen_inplace(StPtrs P) {
    for (int i = 0; i < 25; ++i) { const size_t n = st_count(i);
        for (size_t k = (size_t)blockIdx.x * blockDim.x + threadIdx.x; k < n; k += (size_t)gridDim.x * blockDim.x) P.p[i][k] = st_value(i, k); }
}
__global__ void st_gen(float* syn) {
    for (int i = 0; i < 25; ++i) { const size_t n = st_count(i), o = st_offset(i);
        for (size_t k = (size_t)blockIdx.x * blockDim.x + threadIdx.x; k < n; k += (size_t)gridDim.x * blockDim.x) syn[o + k] = st_value(i, k); }
}
constexpr int ST_NEXP = 74;
#ifndef ST_REPORT_SUB
#define ST_REPORT_SUB 0
#endif
#ifndef ST_TOL
#define ST_TOL 0.03
#endif
__device__ const int ST_EXP_STEP[74] = {0,0,0,0,1,2,2,2,2,3,3,4,5,6,6,6,7,8,9,9,9,9,10,11,11,11,11,12,12,12,13,14,15,15,15,16,17,18,18,18,18,19,20,20,20,20,21,21,22,23,24,24,24,25,26,27,27,27,27,28,29,29,29,29,30,30,30,31,32,33,33,33,34,35,};
__device__ const int ST_EXP_SUB[74] = {0,1,2,3,0,0,1,2,3,0,1,0,0,0,1,2,0,0,0,1,2,3,0,0,1,2,3,0,1,2,0,0,0,1,2,0,0,0,1,2,3,0,0,1,2,3,0,1,0,0,0,1,2,0,0,0,1,2,3,0,0,1,2,3,0,1,2,0,0,0,1,2,0,0,};
__device__ const double ST_EXP[74][10] = {
{2823.9405135959387,-6955.5741695016623,-5804.0977028682828,9054.3725127205253,-3966.7899582609534,-4601.8714917525649,7995.7762676179409,971.6921226978302,22251047.414743461,18874368,},
{291.26190879568458,-1573.2945180945098,331.66257446631789,357.45295172557235,-214.97323327884078,864.47900781407952,490.07691208645701,667.85457975044847,340263.10377825046,294912,},
{-23.357008519407827,15.935151411395054,35.883058835112024,57.434714148461353,-51.349641996261198,60.264678716950584,-59.23590717773186,-56.705568651959766,3067.8819070441805,3145728,},
{25.470241500996053,-43.468927160836756,58.065743817947805,4.3800708865746856,11.067458258010447,-10.867067505605519,26.364831392653286,-27.969552277587354,1020.9866835358141,1048576,},
{-11200.415292963386,9297.3592315688729,3203.3726777359843,-9663.7561300396919,-641.6257035061717,-8234.4563228115439,7994.2129158824682,-5521.8908601477742,66654113.07759431,56623104,},
{-1194.5305787473917,-1674.2680710405111,-5463.7986858785152,-4930.0590666979551,-1068.7674529403448,3002.9571408778429,-649.54952663183212,-4412.2754199355841,11106170.817955792,9437184,},
{-5507.6614354923368,1901.5068384334445,-4913.9082106724381,-2596.9450140967965,-1520.3851273730397,3237.6398326531053,-2359.8059303388,2364.7748123183846,11105296.668379547,9437184,},
{1560.4392579563191,-2499.261261367612,1459.3170721097504,-245.48758464773891,1043.47321934717,1419.7026340031534,1920.6481273452355,-1582.4576623782978,1601541.1673813532,18874368,},
{18.923751746769994,105.40070073772222,-9.9321377836167812,-69.897449327632785,166.82718826597556,123.35070158960298,-124.43343016551808,-149.78254351718351,24705.222434743067,147456,},
{2291.1772415378409,-198.18048978019215,106.27707149069283,1579.1373604525679,1783.1593627679513,2121.0945059178157,-2611.1484069368307,-1331.619970235115,2782256.6531369383,18874368,},
{89.759916271461407,27.444828146166401,211.5510761210171,-443.45204046583967,221.2014890195278,-713.03335159321432,-278.38321068481309,161.85793914255919,83907.236548682689,147456,},
{2060.1309491619468,-3099.3174412855878,3189.1278408914804,-1495.998928762041,2018.3208422241732,3951.0027283849195,307.00997438374907,189.92257314547896,8838647.8145213183,18874368,},
{2615.2232726222937,-3851.6311007236727,-5090.8008575433851,8895.7526726254218,-2915.793732104612,-3466.5127967876979,8494.2590465184257,-476.8310997271401,19641291.046898585,18874368,},
{2260.6133435368538,-3524.0150115936995,-6184.6817786470056,8612.6491934210062,-2936.174174323678,-5085.3421624973416,7627.2569323033094,-322.10541462153196,22201812.480418805,18874368,},
{39.211919396329904,-22.191732778126607,71.555887567257741,-34.657468227291247,-37.514794261514908,48.970252739818534,56.030709780199686,21.127209749916801,5631.6743743792158,5767168,},
{-58.957687043759506,-25.822232720500324,27.559850534133147,-19.2058952494408,25.962478367669974,10.300243424077053,-1.6967002287856303,-52.715924362360965,1022.4535583883176,2883584,},
{-194.02440498952637,2323.5604243765411,4943.6193249881908,-6076.2407636700955,-3098.2506252240564,1737.1458579480241,4071.2157669755688,3426.5647126794502,26276154.208520912,51904512,},
{2062.0307282910508,-2404.6291768250012,-4943.0085245753726,8409.3699170327891,-3388.5586135165795,-3156.0619303231506,8070.8516135739701,103.72620783001184,20445489.612024359,18874368,},
{-850.44070326350629,-1898.2922850791365,-5629.5260096881539,5319.5235935095698,-3571.6089787539095,-4582.1209145840257,8084.1448610220104,1201.9745895769447,22408943.624150425,18874368,},
{-276.67351097613573,238.73336043953896,402.49070692062378,1139.6587501242757,412.53829725086689,1001.9456618651748,-199.34280802309513,243.97394938021898,346041.02869538032,294912,},
{55.275690128095448,33.631906502880156,39.819098525680602,39.580814833752811,-56.659358996432275,56.905868629924953,70.874192817136645,32.641803210601211,2813.6335960129777,2883584,},
{16.459319942980073,-15.029889202327468,24.789046118385158,39.597747391439043,22.32851928321179,32.169926681905054,4.3831529127201065,-11.914361283765174,1024.2634621089853,1048576,},
{-8112.7706977427006,-15166.404139339924,9019.1636524870992,-10032.914728678763,-3683.5552492365241,6445.1523703113198,4940.6895737573504,-396.46003675460815,61599346.798404746,51904512,},
{1064.6478829011321,2961.5112186744809,2643.997241653502,3817.1335873380303,2552.6912311688066,2848.1112303361297,2641.0165046826005,877.74564967304468,5155886.6824775627,4718592,},
{-1180.9790783076314,-353.66288720036391,1405.2405796857784,-3003.0330094090896,736.01905330538284,1520.8871299045859,-1925.6258542904397,-909.10001162986737,2434153.6281470573,18874368,},
{60.165285118651028,-119.7430636333083,80.732633202489126,-9.8426874747077857,-101.69595492020277,-92.996986093445443,207.83742497175277,20.265997010018708,8918.7285340001526,18874368,},
{270.78828044847916,-133.56509196904631,-10.835563753045964,-177.08542341093678,116.75884305510037,-401.68338958283317,92.706295374895404,-256.76246256793473,40406.455039767519,47185920,},
{-17.403251063922653,85.550381564797135,-67.875341098901117,39.030201086570742,-44.825321126758354,-24.736986581498059,-130.15850522785331,-6.1346717766427901,3203.0568557028691,9437184,},
{26.677921455280739,-10.301573183693108,-15.383461458186503,23.552394272832316,-16.422941844488378,33.179475616852869,-26.073428510382655,49.43283157730184,2218.7160715744772,9437184,},
{-104.63265653897543,-1025.0813928971766,623.84842114138883,-1420.2001781960716,1368.3365971482126,-86.704579671728425,96.991083307308145,428.70963656844106,889696.22597060842,9437184,},
{2432.259056510753,267.30669010814745,1837.783826454659,2981.6297531555174,-416.17357830458786,-1826.6180147336563,-301.78532918507699,-744.86193079140503,4898348.3318136279,18874368,},
{3294.5902997395533,-865.44878266500746,-4974.0870277224822,6772.8382276698467,-3398.3562051501722,-4187.1136843486529,8143.3624155692742,-612.10508898339322,20872541.311585322,18874368,},
{3536.330776873976,1917.42852505669,-2076.6844129748642,4320.7511040978134,-4890.1908001117408,-4107.6248654313385,10533.807669285685,471.08626228198409,22412768.276720807,18874368,},
{-6.0809309475971531,76.739011337651391,97.496654804484933,-29.642639640796915,0.70117462620510196,-203.53367705441451,-98.699187040134348,-53.162115221513886,5628.1487348292976,5767168,},
{56.758986754866783,46.788941775390413,-43.423746958898846,33.754279191547539,25.984360144881066,-65.525896325649228,5.420765693706926,45.74655341921607,1023.6598906812283,2883584,},
{2102.1720024403512,3520.8294076444326,-6874.5287163143184,3797.4676643103921,3201.4737541926479,2643.8227775447631,352.29275992398834,1880.529091139204,26630809.672188494,51904512,},
{2885.2073127178519,-1385.1170310270754,-4514.0122937517372,7030.8231581723594,-3845.7207517792049,-6356.8220687311768,7588.3782935662384,-564.85132873002294,21742637.688699484,18874368,},
{3812.0284725353122,1621.2253267094493,-4254.9756214395165,6197.9158516302705,8.5768845900893211,-5469.3091325387359,8752.140286244452,-1246.7436530068517,22065010.375674032,18874368,},
{-1149.1737003140152,496.67538012936711,483.18858239427209,650.82792166247964,314.5317993350327,-371.12024437263608,890.37748170271516,-1420.4709294177592,350924.7500354572,294912,},
{88.047429081168957,-74.825534723349847,-23.789757229969837,-97.320472310879268,-4.0056394656421617,-30.904204592457972,-18.987518870853819,-27.849783896817826,3073.3731145051615,3145728,},
{65.20327353652101,3.0222902240930125,25.993390792864375,14.415037170168944,54.844758132356219,-56.249738970887847,19.864254156243987,-27.887308357167058,1025.1381782409978,1048576,},
{-13237.945228233933,-5020.7346298694611,5226.0037766546011,12825.714193224907,-2397.7048603817821,-7119.2997151985765,9948.7588085010648,-5921.2636323198676,66137041.201810837,56623104,},
{-75.766457952558994,2293.2211949080229,-2037.293488740921,1509.2966427430511,6117.5132186114788,479.96601853519678,-5639.6398960202932,1845.2123182713985,11060201.299008245,9437184,},
{-462.10384976491332,5736.9905912540853,-2167.2699889577925,-1180.0111477933824,409.65681508556008,-1780.9929978586733,-671.92641231790185,-1349.7005080021918,11027953.433529973,9437184,},
{-822.00079254147931,-1214.0090433928017,3328.184749965596,87.801341768161365,-495.11205383328706,-877.86274139888337,1911.2223419476468,796.02008414199008,1759052.6843886974,18874368,},
{100.80030664941296,22.118581771384925,-242.38840196980163,-93.397681776899844,-57.195992573630065,-53.402307578828186,-150.74265199294314,-86.528761671390384,31090.621100439952,147456,},
{3075.2200345232932,146.19098324902222,-1073.3931368374535,-3446.3695871779209,37.989448957180798,223.73928401402372,1720.4827841137958,2765.2156565344467,3854013.6325600357,18874368,},
{542.032717238857,-110.56952357693081,1.825648151418136,-830.79371399683441,-111.90571951437596,-416.65702595594485,-459.77385005963879,177.62618795662274,136561.77048135776,147456,},
{-536.59579325607046,3431.0063604712486,3724.987038930878,-672.57181697292253,-3271.82986589754,-275.97591033531353,1134.3561726845801,3369.160484327469,5460094.8227678062,18874368,},
{3690.413550499331,-2055.6428064615766,-5438.0006776863584,7215.5527907973737,-3675.7019953130812,-5533.6785190762885,6701.1122693967927,64.846424879085134,22222666.921814281,18874368,},
{6145.2994565963745,-1456.0999585092068,-5831.9741258770227,8761.7396555989981,-5699.234908297658,-4079.551640689373,4842.0201814621687,-2019.1001229286194,22203324.287363961,18874368,},
{130.56598056000075,66.178603142005159,-72.223813362215878,-40.295281428698217,26.729994425171753,-72.123386049031978,-88.871669880725676,27.124975894665113,5635.9492323544555,5767168,},
{32.54455375490943,72.597239872498903,-17.171426851477008,-4.8966801255592145,-15.258403940417338,-23.122007071331609,-22.899502303858753,62.156484370876569,1023.7774562760339,2883584,},
{-6760.2973620964185,3735.844417643224,1094.1796880429465,4204.2181440759596,-764.49361893783498,-4932.0209130450239,-6261.1468112875446,-4488.8535375963402,26246313.294528794,51904512,},
{4457.1757640697724,-2267.1563059242435,-4745.1736963140393,7186.1535465445595,-4113.5497737388105,-7139.5026401302202,6476.8297955984126,-72.098023249844118,23047663.524188824,18874368,},
{4172.7441230602562,2189.9780470617115,-5133.8792393095791,7288.8046996556222,-5411.0709395520389,-4896.6709096245468,8724.0389158017933,-1300.7641984857619,22255371.479420178,18874368,},
{342.48845159634948,-1155.9452162571251,-355.46573888137937,38.030472237616777,-706.72725258395076,302.12307207658887,1501.216548230499,-189.15161934122443,356337.53284288617,294912,},
{141.34916719738249,55.510840875467693,3.4794936717735254,14.99616638317093,48.530484220267681,80.824254727551306,36.550317391192948,-11.045543047970568,2822.5213800999318,2883584,},
{-1.7540650628507137,-68.523136725649238,20.526102727279067,4.1151908580213785,26.478423124179244,17.260244991630316,26.540773348882794,18.066198658198118,1023.7352584092852,1048576,},
{9615.2207438386977,4784.9471067078412,1940.7497162856162,-5810.9412356205285,-983.56367782130837,7418.8542090691626,16772.396392870694,-7707.8745242021978,61356805.552982159,51904512,},
{1611.5909418128431,-862.28053805604577,-136.1677976809442,-552.47190998122096,983.61643074825406,-2118.3313589207828,2136.0759917013347,1436.2902639396489,5189176.8575152932,4718592,},
{1791.7875226804172,-31.704715774103533,260.74334435508354,2286.3263573826407,2006.0634295089985,-556.23315154918237,2794.1662208863418,265.33516812947346,2237659.8451027921,18874368,},
{1.738220854325472,-47.72536333968177,85.671240820733587,-76.785340997768273,-33.389609302064237,10.517162931163593,-16.605087701564099,-69.403631001852744,4294.4259768959364,18874368,},
{80.462511468439985,-161.96663447577936,103.6356164854663,158.8806262336563,-156.06783419597375,68.553029276052172,-342.86381052307308,-54.733859514236087,20398.968534675096,47185920,},
{52.505996509542456,40.193077393545536,-32.136223205568967,9.6826318503881339,-32.908785335748689,-49.309646418463672,7.7728565156285185,28.182192534412025,933.99111986596574,8388608,},
{-7.5194821398763452,15.928513078688411,-22.494523745699553,-25.74654744003783,-1.9659538757696282,39.424875568918651,-41.204660507297376,-50.291643056989415,1399.3033406704337,8388608,},
{-135.14476990071125,388.87867833836935,-624.19169349339791,-255.41803698171861,749.05279063689522,489.13258223538287,7.6979752753395587,-1529.1879597052466,922125.16740855761,8388608,},
{2513.205304118339,-3002.4781056293286,-591.26384180737659,984.36628054594621,-165.44268643157557,-2587.8124781120569,5950.0621142634191,1918.4807258569635,4533654.192930459,16777216,},
{2830.9344703354946,-4920.8287407121315,-3976.7572222978852,7101.1558030729429,-6279.3158443071807,-7658.587931540409,7596.1372552172033,-980.77548625691998,20848405.50834683,16777216,},
{5663.7043273374438,-4698.0929517224431,-2882.0782249197364,6381.8024617210031,-6684.7693502381444,-6324.1065613850951,5276.286193959415,-1294.3445755466819,19824501.716412377,16777216,},
{105.49113711505197,9.4353141400497407,71.544671961572021,-144.04839801136404,-59.128098372370005,86.345427959226072,-22.445412413449958,-31.521184443496168,5635.2677728111466,5767168,},
{-52.974209187126689,83.749726402067608,-11.22629395038166,-7.1423740544887551,-10.056938788195112,-45.578087951795169,41.377634743421368,16.152020135003113,1023.3413428186279,2883584,},
{1126.9516335337321,-4958.3812902097925,-2794.7144431749111,5195.0455790979104,4310.2982955073458,-6172.0018973502665,4099.1716476037618,-5060.7709415074714,23578261.929520626,46137344,},
{854.11164966656725,-4002.1053702284298,-4016.2943720539079,7535.4821215254451,-6184.3291782648776,-6281.2433878521588,8750.5079252671385,531.59902707755464,21616516.22354921,16777216,},
};
__global__ void st_check_kernel(unsigned char* ws, int step, int slot = 0) { Ctx c; c.tid = threadIdx.x; c.lane = c.tid & 63; c.wave = c.tid >> 6; c.bid = blockIdx.x; c.nblk = gridDim.x; c.gw = 0; c.ngw = slot; c.lds = nullptr; c.in = nullptr; c.out = nullptr; c.ws = ws; st_checks(c, step); }
__global__ void st_report(const unsigned char* ws, float* out, int n) {
    const double* chk = (const double*)(ws + ST_CHK); int code = 0;
    for (int e = 0; e < ST_NEXP && !code; ++e) { const int step = ST_EXP_STEP[e], sub = ST_EXP_SUB[e]; const double* g = chk + (step * 4 + sub) * 10; double d2 = 0.0; if (g[9] == 0.0) continue;
        for (int k = 0; k < 8; ++k) { const double d = g[k] - ST_EXP[e][k]; d2 += d * d; }
        const double eps2 = d2 / (8.0 * ST_EXP[e][8] + 1e-300);
        const bool bad = !(eps2 <= ST_TOL * ST_TOL);
        if (bad) code = ST_REPORT_SUB ? (step == ST_REPORT_SUB - 1 ? sub + 1 : 0) : step + 1; }
    const float v = sqrtf((float)code);
    for (size_t k = (size_t)blockIdx.x * blockDim.x + threadIdx.x; k < (size_t)n; k += (size_t)gridDim.x * blockDim.x) out[k] = v;
}
__global__ void st_repeat_report(const unsigned char* ws, float* out, int n, int nsteps) {
    const double* chk = (const double*)(ws + ST_CHK); int code = 0;
    for (int st = 0; st < nsteps && !code; ++st) for (int sub = 0; sub < 4 && !code; ++sub) { const double* a = chk + ((size_t)st * 4 + sub) * 10; const double* b = chk + ((size_t)(st + 40) * 4 + sub) * 10;
        if (a[9] == 0.0 || b[9] == 0.0) continue; double d2 = 0.0; for (int k = 0; k < 8; ++k) d2 += (a[k] - b[k]) * (a[k] - b[k]);
        if (!(d2 <= 1e-14 * 8.0 * a[8])) code = st + 1; }
    const float v = sqrtf((float)code);
    for (size_t k = (size_t)blockIdx.x * blockDim.x + threadIdx.x; k < (size_t)n; k += (size_t)gridDim.x * blockDim.x) out[k] = v;
}
__global__ void st_twice_report(const unsigned char* ws, float* out, int n) {
    const double* chk = (const double*)(ws + ST_CHK); const double* a = chk + ((size_t)35 * 4) * 10; const double* b = chk + ((size_t)(35 + 40) * 4) * 10;
    double d2 = 0.0; for (int k = 0; k < 8; ++k) d2 += (a[k] - b[k]) * (a[k] - b[k]);
    const double eps = sqrt(d2 / (8.0 * a[8] + 1e-300)) + 1e-30; const float v = sqrtf((float)floor(fmax(0.0, -log10(eps))));
    for (size_t k = (size_t)blockIdx.x * blockDim.x + threadIdx.x; k < (size_t)n; k += (size_t)gridDim.x * blockDim.x) out[k] = v;
}
__global__ void st_final_check(const unsigned char* ws, const float* out, const float* g, double* acc) {
    const float* X = (const float*)(ws + OFF_X);
    for (int row = blockIdx.x * blockDim.x + threadIdx.x; row < ML; row += gridDim.x * blockDim.x) { const float* x = X + (size_t)row * D; double ss = 0.0;
        for (int k = 0; k < D; ++k) ss += (double)x[k] * x[k];
        const double rstd = 1.0 / sqrt(ss / D + 1e-6); double d2 = 0.0, r2 = 0.0;
        for (int k = 0; k < D; ++k) { const double r = x[k] * rstd * g[k], o = out[(size_t)row * D + k]; d2 += (o - r) * (o - r); r2 += r * r; }
        atomicAdd(acc, d2); atomicAdd(acc + 1, r2); }
}
__global__ void st_final_fill(const double* acc, float* out, int n) { const double eps = sqrt(acc[0] / (acc[1] + 1e-300)) + 1e-30; const float v = sqrtf((float)floor(fmax(0.0, -log10(eps))));
    for (size_t k = (size_t)blockIdx.x * blockDim.x + threadIdx.x; k < (size_t)n; k += (size_t)gridDim.x * blockDim.x) out[k] = v; }
__global__ void st_same_batch_inputs(const float* x, const float* cv, const float* ctx, float* xs, float* cs, float* ctxs) {
    const size_t gt = (size_t)blockIdx.x * blockDim.x + threadIdx.x, GT = (size_t)gridDim.x * blockDim.x;
    for (size_t k = gt; k < (size_t)NB * SEQ * D; k += GT) xs[k] = x[k % ((size_t)SEQ * D)];
    for (size_t k = gt; k < (size_t)NB * CTX * D; k += GT) ctxs[k] = ctx[k % ((size_t)CTX * D)];
    for (size_t k = gt; k < (size_t)NB * D; k += GT) cs[k] = cv[k % (size_t)D];
}
__global__ void st_batch_report(const float* sout, float* out, int n, double* acc) {
    const size_t per = (size_t)SEQ * D;
    for (int b = 1; b < NB; ++b) { double d2 = 0.0, r2 = 0.0;
        for (size_t k = (size_t)blockIdx.x * blockDim.x + threadIdx.x; k < per; k += (size_t)gridDim.x * blockDim.x) { const double a0 = sout[k], ab = sout[(size_t)b * per + k]; d2 += (ab - a0) * (ab - a0); r2 += a0 * a0; }
        atomicAdd(acc + 2 * b, d2); atomicAdd(acc + 2 * b + 1, r2); }
    __threadfence();
    __shared__ unsigned last; if (threadIdx.x == 0) last = atomicAdd((unsigned*)acc, 1u) == gridDim.x - 1; __syncthreads();
    if (!last) return;
    int code = 0; for (int b = 1; b < NB && !code; ++b) { const double d2 = atomicAdd(acc + 2 * b, 0.0), r2 = atomicAdd(acc + 2 * b + 1, 0.0); if (!(d2 <= 1e-4 * r2)) code = b; }
    *((volatile int*)(acc + 1)) = code;
}
__global__ void st_fill(const double* acc, float* out, int n) { const float v = sqrtf((float)*((const volatile int*)(acc + 1))); for (size_t k = (size_t)blockIdx.x * blockDim.x + threadIdx.x; k < (size_t)n; k += (size_t)gridDim.x * blockDim.x) out[k] = v; }
#endif

#if defined(SELFTEST) && (defined(ST_DACHECK) || defined(ST_MODCHECK) || defined(ST_L0CHECK) || defined(ST_TAILCHECK) || defined(ST_MLCHECK) || defined(ST_DNCHECK) || defined(ST_TRUTH) || defined(ST_GQCHECK))
__global__ void st_da_check(const unsigned char* ws, const float* lam, const float* gn, double* acc, float* scr) {
    const int lane = threadIdx.x & 63, gw = (blockIdx.x * blockDim.x + threadIdx.x) >> 6, ngw = (gridDim.x * blockDim.x) >> 6;
    const bf16_t* QA = (const bf16_t*)(ws + OFF_P) + PE_QA; const bf16_t* KA = (const bf16_t*)(ws + OFF_P) + PE_KA; const bf16_t* VA = (const bf16_t*)(ws + OFF_P) + PE_VA; const bf16_t* Y = (const bf16_t*)(ws + OFF_HY);
    const float* COS = (const float*)(ws + OFF_ROPE); const float* SIN = COS + (size_t)SEQ * 32;
    float* s1 = scr + (size_t)gw * 2 * LK; float* s2 = s1 + LK;
    float la = 0.f, lb = 0.f; la = lam[lane] * lam[64 + lane]; lb = lam[128 + lane] * lam[192 + lane];
    for (int o = 1; o < 64; o <<= 1) { la += __shfl_xor(la, o); lb += __shfl_xor(lb, o); }
    const float lam_init = 0.2f, lmb = expf(la) - expf(lb) + lam_init;
    __shared__ float qs[8][2][64];
    const int wv = threadIdx.x >> 6;
    for (int it = gw; it < (ML / 16) * 4; it += ngw) { const int h = it & 3, row = (it >> 2) * 16 + 5; const int b = row / SEQ, t = row % SEQ;
        for (int m = 0; m < 2; ++m) { const int d = lane; const int a = d >> 5, pp = (d >> 4) & 1, f = d & 15; const float x = bf2f(QA[(size_t)row * 512 + h * 128 + m * 64 + d]), xp = bf2f(QA[(size_t)row * 512 + h * 128 + m * 64 + (d ^ 16)]);
            const float cs = COS[(size_t)t * 32 + a * 16 + f], sn = SIN[(size_t)t * 32 + a * 16 + f]; qs[wv][m][d] = pp == 0 ? x * cs - xp * sn : x * cs + xp * sn; }
        __syncthreads();
        float m1 = -1e30f, m2 = -1e30f;
        for (int j = lane; j < LK; j += 64) { const int kr = pos_row(b, j); const bool rope = j >= CTX; const int kt = j - CTX; float a1 = 0.f, a2 = 0.f;
            for (int d = 0; d < 64; ++d) { const int a = d >> 5, pp = (d >> 4) & 1, f = d & 15;
                float k1 = bf2f(KA[(size_t)kr * 512 + h * 128 + d]), k2 = bf2f(KA[(size_t)kr * 512 + h * 128 + 64 + d]);
                if (rope) { const float k1p = bf2f(KA[(size_t)kr * 512 + h * 128 + (d ^ 16)]), k2p = bf2f(KA[(size_t)kr * 512 + h * 128 + 64 + (d ^ 16)]); const float cs = COS[(size_t)kt * 32 + a * 16 + f], sn = SIN[(size_t)kt * 32 + a * 16 + f];
                    k1 = pp == 0 ? k1 * cs - k1p * sn : k1 * cs + k1p * sn; k2 = pp == 0 ? k2 * cs - k2p * sn : k2 * cs + k2p * sn; }
                a1 += qs[wv][0][d] * k1; a2 += qs[wv][1][d] * k2; }
            a1 *= 0.125f; a2 *= 0.125f; s1[j] = a1; s2[j] = a2; m1 = fmaxf(m1, a1); m2 = fmaxf(m2, a2); }
        for (int o = 1; o < 64; o <<= 1) { m1 = fmaxf(m1, __shfl_xor(m1, o)); m2 = fmaxf(m2, __shfl_xor(m2, o)); }
        float l1 = 0.f, l2 = 0.f;
        for (int j = lane; j < LK; j += 64) { const float p1 = expf(s1[j] - m1), p2 = expf(s2[j] - m2); s1[j] = p1; s2[j] = p2; l1 += p1; l2 += p2; }
        for (int o = 1; o < 64; o <<= 1) { l1 += __shfl_xor(l1, o); l2 += __shfl_xor(l2, o); }
        __threadfence(); __syncthreads();
        float o0 = 0.f, o1 = 0.f;
        for (int j = 0; j < LK; ++j) { const int kr = pos_row(b, j); const float p = s1[j] / l1 - lmb * s2[j] / l2; o0 += p * bf2f(VA[(size_t)kr * 512 + h * 128 + lane]); o1 += p * bf2f(VA[(size_t)kr * 512 + h * 128 + 64 + lane]); }
        float ss = o0 * o0 + o1 * o1; for (int o = 1; o < 64; o <<= 1) ss += __shfl_xor(ss, o);
        const float sc = (1.0f / sqrtf(ss / 128.0f + 1e-6f)) * (1.0f - lam_init);
        const float r0 = o0 * sc * gn[lane], r1 = o1 * sc * gn[64 + lane], y0 = bf2f(Y[(size_t)row * 1024 + h * 128 + lane]), y1 = bf2f(Y[(size_t)row * 1024 + h * 128 + 64 + lane]);
        double d2 = (double)(y0 - r0) * (y0 - r0) + (double)(y1 - r1) * (y1 - r1), r2 = (double)r0 * r0 + (double)r1 * r1;
        for (int o = 1; o < 64; o <<= 1) { d2 += __shfl_xor(d2, o); r2 += __shfl_xor(r2, o); }
        if (lane == 0) { atomicAdd(acc, d2); atomicAdd(acc + 1, r2); }
        __syncthreads(); }
}
__global__ void st_mod_check(const unsigned char* ws, const float* cv, const float* cctx, const float* w_ada, const float* b_ada, double* acc) {
    const float* MOD = (const float*)(ws + OFF_MOD); double d2 = 0.0, r2 = 0.0;
    for (long it = (long)blockIdx.x * blockDim.x + threadIdx.x; it < (long)DEPTH * 9 * 6 * D; it += (long)gridDim.x * blockDim.x) { const int n = (int)(it % (6 * D)), r = (int)((it / (6 * D)) % 9), l = (int)(it / (6L * D * 9));
        double s = b_ada[(size_t)l * 6 * D + n];
        for (int k = 0; k < D; ++k) { const double cc = r < NB ? cv[r * D + k] : cctx[k]; s += cc / (1.0 + exp(-cc)) * (double)w_ada[((size_t)l * D + k) * 6 * D + n]; }
        const double m = MOD[it]; d2 += (m - s) * (m - s); r2 += s * s; }
    atomicAdd(acc, d2); atomicAdd(acc + 1, r2);
}
__global__ void st_inproj_check(const unsigned char* ws, const float* w_in_e, double* acc) {
    const bf16_t* H = (const bf16_t*)(ws + OFF_HY); const bf16_t* P = (const bf16_t*)(ws + OFF_P); double d2 = 0.0, r2 = 0.0;
    for (long it = (long)blockIdx.x * blockDim.x + threadIdx.x; it < 72L * NE; it += (long)gridDim.x * blockDim.x) { const int col = (int)(it % NE), row = (int)(it / NE) * 256 + 37;
        float s = 0.f; for (int k = 0; k < D; ++k) s += bf2f(H[(size_t)row * D + k]) * bf2f(f2bf(w_in_e[(size_t)k * E_IN + col]));
        size_t off; int pitch, c0; const int pn = col / 256;
        if (pn < 2) { off = PE_QA; pitch = 512; c0 = 256 * pn; } else if (pn < 4) { off = PE_KA; pitch = 512; c0 = 256 * (pn - 2); } else if (pn < 6) { off = PE_VA; pitch = 512; c0 = 256 * (pn - 4); }
        else if (pn == 6) { off = PE_BQ; pitch = 256; c0 = 0; } else if (pn == 7) { off = PE_BK; pitch = 256; c0 = 0; } else if (pn < 10) { off = PE_BV; pitch = 512; c0 = 256 * (pn - 8); } else { off = PE_BO; pitch = 512; c0 = 256 * (pn - 10); }
        const float v = bf2f(P[off + (size_t)row * pitch + c0 + (col & 255)]); d2 += (double)(v - s) * (v - s); r2 += (double)s * s; }
    atomicAdd(acc, d2); atomicAdd(acc + 1, r2);
}
__global__ void st_norm_check(const unsigned char* ws, const float* g_mix, const float* w_in_e, const float* xin, const float* ctxin, double* acc) {
    const bf16_t* H = (const bf16_t*)(ws + OFF_HY); const float* G = (const float*)(ws + OFF_G); const float* MOD = (const float*)(ws + OFF_MOD); double d2 = 0.0, r2 = 0.0, dg = 0.0, rg = 0.0;
    for (int it = blockIdx.x * blockDim.x + threadIdx.x; it < 72; it += gridDim.x * blockDim.x) { const int row = it * 256 + 37; const int mr = row < ML ? row / SEQ : NB;
        const float* x = row < ML ? xin + (size_t)row * D : ctxin + (size_t)(row - ML) * D; double ss = 0.0; for (int k = 0; k < D; ++k) ss += (double)x[k] * x[k];
        const double rstd = 1.0 / sqrt(ss / D + 1e-6); double ga[16]; for (int n = 0; n < 16; ++n) ga[n] = 0.0;
        for (int k = 0; k < D; ++k) { const double h = x[k] * rstd * g_mix[k] * (1.0 + MOD[(size_t)mr * 6 * D + D + k]) + MOD[(size_t)mr * 6 * D + k]; const double v = bf2f(H[(size_t)row * D + k]); d2 += (v - h) * (v - h); r2 += h * h;
            for (int n = 0; n < 16; ++n) ga[n] += h * w_in_e[(size_t)k * E_IN + NE + n]; }
        for (int n = 0; n < 16; ++n) { const double v = G[(size_t)row * 16 + n]; dg += (v - ga[n]) * (v - ga[n]); rg += ga[n] * ga[n]; } }
    atomicAdd(acc + 2, d2); atomicAdd(acc + 3, r2); atomicAdd(acc + 4, dg); atomicAdd(acc + 5, rg);
}
__global__ void st_eps3_fill(const double* acc, float* out, int n) {
    double e = 0.0; for (int i = 0; i < 3; ++i) e = fmax(e, sqrt(acc[2 * i] / (acc[2 * i + 1] + 1e-300))); e += 1e-30; const float v = sqrtf((float)fmax(0.0, -10.0 * log10(e)));
    for (size_t k = (size_t)blockIdx.x * blockDim.x + threadIdx.x; k < (size_t)n; k += (size_t)gridDim.x * blockDim.x) out[k] = v; }
__global__ void st_tail_check(const unsigned char* ws, const float* xin, const float* ctxin, const float* w_out, const float* g_ffn, const float* wg, const float* wu, const float* wd, double* acc) {
    __shared__ float xm[D]; __shared__ float h2[D]; __shared__ float act[FF]; __shared__ float red[256];
    const bf16_t* Y = (const bf16_t*)(ws + OFF_HY); const float* X = (const float*)(ws + OFF_X); const float* MOD = (const float*)(ws + OFF_MOD);
    const int row = blockIdx.x * 256 + 37, tid = threadIdx.x; const int mr = row < ML ? row / SEQ : NB; const float* md = MOD + (size_t)mr * 6 * D;
    const float* x0 = row < ML ? xin + (size_t)row * D : ctxin + (size_t)(row - ML) * D;
    for (int n = tid; n < D; n += 256) { float s = 0.f; for (int k = 0; k < 1024; ++k) s += bf2f(Y[(size_t)row * 1024 + k]) * w_out[(size_t)k * D + n]; xm[n] = x0[n] + md[2 * D + n] * s; }
    __syncthreads();
    float ss = 0.f; for (int n = tid; n < D; n += 256) ss += xm[n] * xm[n]; red[tid] = ss; __syncthreads();
    for (int o = 128; o > 0; o >>= 1) { if (tid < o) red[tid] += red[tid + o]; __syncthreads(); }
    const float rstd = 1.0f / sqrtf(red[0] / D + 1e-6f); __syncthreads();
    for (int n = tid; n < D; n += 256) h2[n] = xm[n] * rstd * g_ffn[n] * (1.0f + md[4 * D + n]) + md[3 * D + n];
    __syncthreads();
    for (int f = tid; f < FF; f += 256) { float a = 0.f, b = 0.f; for (int k = 0; k < D; ++k) { a += h2[k] * wg[(size_t)k * FF + f]; b += h2[k] * wu[(size_t)k * FF + f]; } act[f] = a / (1.0f + expf(-a)) * b; }
    __syncthreads();
    double d2 = 0.0, r2 = 0.0;
    for (int n = tid; n < D; n += 256) { float s = 0.f; for (int f = 0; f < FF; ++f) s += act[f] * wd[(size_t)f * D + n]; const float ref = xm[n] + md[5 * D + n] * s, v = X[(size_t)row * D + n]; d2 += (double)(v - ref) * (v - ref); r2 += (double)(ref - x0[n]) * (ref - x0[n]); }
    atomicAdd(acc, d2); atomicAdd(acc + 1, r2);
}
__global__ void st_ml_ref(const unsigned char* ws, const float* bias, float* href) {
    __shared__ float qs[64], ks[64], red[4][128], dred[4];
    const bf16_t* BQ = (const bf16_t*)(ws + OFF_P) + PE_BQ; const bf16_t* BK = (const bf16_t*)(ws + OFF_P) + PE_BK; const bf16_t* BV = (const bf16_t*)(ws + OFF_P) + PE_BV; const float* G = (const float*)(ws + OFF_G);
    const int chain = blockIdx.x, dir = chain & 1, h = (chain >> 1) & 3, b = chain >> 3, tid = threadIdx.x, dv = tid & 127, kg = tid >> 7;
    float C[16], nn[16]; for (int j = 0; j < 16; ++j) { C[j] = 0.f; nn[j] = 0.f; } float m = 0.f;
    for (int p = 0; p < LK; ++p) { int row; if (p < CTX) row = ML + b * CTX + (dir ? CTX - 1 - p : p); else row = b * SEQ + (dir ? SEQ - 1 - (p - CTX) : p - CTX);
        if (tid < 64) { qs[tid] = bf2f(BQ[(size_t)row * 256 + h * 64 + tid]); ks[tid] = bf2f(BK[(size_t)row * 256 + h * 64 + tid]) * 0.125f; }
        const float v = bf2f(BV[(size_t)row * 512 + h * 128 + dv]);
        const float ipre = G[(size_t)row * 16 + dir * 8 + h] + bias[dir * 8 + h], fpre = G[(size_t)row * 16 + dir * 8 + 4 + h] + bias[dir * 8 + 4 + h];
        const float lf = fminf(fpre, 0.f) - log1pf(expf(-fabsf(fpre)));
        __syncthreads();
        const float mn = fmaxf(lf + m, ipre), fs = expf(lf + m - mn), is = expf(ipre - mn); m = mn;
        float pn = 0.f, pd = 0.f;
        for (int j = 0; j < 16; ++j) { const int dk = 16 * kg + j; C[j] = fs * C[j] + is * ks[dk] * v; nn[j] = fs * nn[j] + is * ks[dk]; pn += qs[dk] * C[j]; pd += qs[dk] * nn[j]; }
        red[kg][dv] = pn; if (dv == 0) dred[kg] = pd;
        __syncthreads();
        if (kg == 0) { const float num = (red[0][dv] + red[1][dv]) + (red[2][dv] + red[3][dv]), den = (dred[0] + dred[1]) + (dred[2] + dred[3]);
            href[((size_t)dir * MT + row) * 512 + h * 128 + dv] = num / fmaxf(fabsf(den), expf(-m)); }
        __syncthreads(); }
}
__global__ void st_ml_cmp(const unsigned char* ws, const float* href, const float* gn, double* acc) {
    const bf16_t* BO = (const bf16_t*)(ws + OFF_P) + PE_BO; const bf16_t* Y = (const bf16_t*)(ws + OFF_HY); const int lane = threadIdx.x & 63;
    for (int it = (blockIdx.x * blockDim.x + threadIdx.x) >> 6; it < MT * 4; it += (gridDim.x * blockDim.x) >> 6) { const int row = it >> 2, h = it & 3; float v[2], ss = 0.f;
        for (int e = 0; e < 2; ++e) { const size_t o = (size_t)row * 512 + h * 128 + lane + 64 * e; v[e] = href[o] + href[(size_t)MT * 512 + o]; ss += v[e] * v[e]; }
        for (int o = 1; o < 64; o <<= 1) ss += __shfl_xor(ss, o);
        const float rstd = 1.0f / sqrtf(ss / 128.0f + 1e-6f); double d2 = 0.0, r2 = 0.0;
        for (int e = 0; e < 2; ++e) { const int dv = lane + 64 * e; const float og = bf2f(BO[(size_t)row * 512 + h * 128 + dv]); const float ref = v[e] * rstd * gn[dv] / (1.0f + expf(-og)), y = bf2f(Y[(size_t)row * 1024 + 512 + h * 128 + dv]); d2 += (double)(y - ref) * (y - ref); r2 += (double)ref * ref; }
        for (int o = 1; o < 64; o <<= 1) { d2 += __shfl_xor(d2, o); r2 += __shfl_xor(r2, o); }
        if (lane == 0) { atomicAdd(acc, d2); atomicAdd(acc + 1, r2); } }
}
__global__ void st_dn_ref(const unsigned char* ws, const float* convw, const float* alog, const float* dtb, float* href) {
    __shared__ float qkv[3][128], red[4][128], nrm[2];
    const bf16_t* DQ = (const bf16_t*)(ws + OFF_P) + PO_DQKV; const float* G = (const float*)(ws + OFF_G);
    const int chain = blockIdx.x, dir = chain & 1, h = (chain >> 1) & 3, b = chain >> 3, tid = threadIdx.x, dv = tid & 127, kg = tid >> 7;
    float S[32]; for (int j = 0; j < 32; ++j) S[j] = 0.f;
    for (int p = 0; p < LK; ++p) { const bool isctx = p < CTX; const int seqlen = isctx ? CTX : SEQ, rowbase = isctx ? ML + b * CTX : b * SEQ; const int tok = isctx ? (dir ? CTX - 1 - p : p) : (dir ? SEQ - 1 - (p - CTX) : p - CTX); const int row = rowbase + tok;
        if (tid < 384) { const int ten = tid >> 7, d = tid & 127, col = ten * 512 + h * 128 + d; float a = 0.f;
            for (int tap = 0; tap < 3; ++tap) { const int tk = tok + tap - 1; if (tk >= 0 && tk < seqlen) a += bf2f(DQ[(size_t)(rowbase + tk) * 1536 + col]) * convw[tap * 1536 + col]; }
            qkv[ten][d] = a / (1.0f + expf(-a)); }
        __syncthreads();
        if (tid < 128) { float s = 0.f; const int ten = tid >> 6; for (int d = (tid & 63); d < 128; d += 64) s += qkv[ten][d] * qkv[ten][d]; for (int o = 1; o < 64; o <<= 1) s += __shfl_xor(s, o); if ((tid & 63) == 0) nrm[ten] = s; }
        __syncthreads();
        const float qn = (1.0f / sqrtf(nrm[0] + 1e-6f)) * 0.08838834764831845f, kn = 1.0f / sqrtf(nrm[1] + 1e-6f);
        const float beta = 1.0f / (1.0f + expf(-G[(size_t)row * 16 + dir * 8 + h])); const float xg = G[(size_t)row * 16 + dir * 8 + 4 + h] + dtb[dir * 4 + h];
        const float at = expf(-expf(alog[dir * 4 + h]) * (fmaxf(xg, 0.f) + log1pf(expf(-fabsf(xg)))));
        const float v = qkv[2][dv]; float pk = 0.f;
        for (int j = 0; j < 32; ++j) pk += qkv[1][32 * kg + j] * kn * S[j];
        red[kg][dv] = pk; __syncthreads();
        const float kS = (red[0][dv] + red[1][dv]) + (red[2][dv] + red[3][dv]); __syncthreads();
        float po = 0.f;
        for (int j = 0; j < 32; ++j) { const float kk = qkv[1][32 * kg + j] * kn; S[j] = at * (S[j] - beta * kk * kS) + beta * kk * v; po += qkv[0][32 * kg + j] * qn * S[j]; }
        red[kg][dv] = po; __syncthreads();
        if (kg == 0 && !isctx) href[((size_t)dir * ML + row) * 512 + h * 128 + dv] = (red[0][dv] + red[1][dv]) + (red[2][dv] + red[3][dv]);
        __syncthreads(); }
}
__global__ void st_dn_cmp(const unsigned char* ws, const float* href, const float* gn, double* acc) {
    const bf16_t* Z = (const bf16_t*)(ws + OFF_P) + PO_Z; const bf16_t* Y = (const bf16_t*)(ws + OFF_HY); const int lane = threadIdx.x & 63;
    for (int it = (blockIdx.x * blockDim.x + threadIdx.x) >> 6; it < ML * 4; it += (gridDim.x * blockDim.x) >> 6) { const int row = it >> 2, h = it & 3; float v[2], ss = 0.f;
        for (int e = 0; e < 2; ++e) { const size_t o = (size_t)row * 512 + h * 128 + lane + 64 * e; v[e] = href[o] + href[(size_t)ML * 512 + o]; ss += v[e] * v[e]; }
        for (int o = 1; o < 64; o <<= 1) ss += __shfl_xor(ss, o);
        const float rstd = 1.0f / sqrtf(ss / 128.0f + 1e-6f); double d2 = 0.0, r2 = 0.0;
        for (int e = 0; e < 2; ++e) { const int dv = lane + 64 * e; const float z = bf2f(Z[(size_t)row * 512 + h * 128 + dv]); const float ref = v[e] * rstd * gn[dv] * (z / (1.0f + expf(-z))), y = bf2f(Y[(size_t)row * 1024 + 512 + h * 128 + dv]); d2 += (double)(y - ref) * (y - ref); r2 += (double)ref * ref; }
        for (int o = 1; o < 64; o <<= 1) { d2 += __shfl_xor(d2, o); r2 += __shfl_xor(r2, o); }
        if (lane == 0) { atomicAdd(acc, d2); atomicAdd(acc + 1, r2); } }
}
__global__ void st_truth_fill(const unsigned char* ws, float* out, int n) {
    const double T[9] = {846.38902932657311,-3988.0872614528216,-4023.4252461296091,7499.0995520059896,-6191.4193272974135,-6282.081387437358,8748.2446258433793,548.97920503418845,21616550.564093322};
    const double* g = (const double*)(ws + ST_CHK) + ((size_t)35 * 4) * 10; double d2 = 0.0; for (int k = 0; k < 8; ++k) d2 += (g[k] - T[k]) * (g[k] - T[k]);
    const double eps = sqrt(d2 / (8.0 * T[8])) + 1e-30; const float v = sqrtf((float)fmax(0.0, -10.0 * log10(eps)));
    for (size_t k = (size_t)blockIdx.x * blockDim.x + threadIdx.x; k < (size_t)n; k += (size_t)gridDim.x * blockDim.x) out[k] = v; }
__global__ void st_gqa_check(const unsigned char* ws, const bf16_t* QS, const float* qkg, double* acc, float* scr) {
    const int lane = threadIdx.x & 63, gw = (blockIdx.x * blockDim.x + threadIdx.x) >> 6, ngw = (gridDim.x * blockDim.x) >> 6, wv = threadIdx.x >> 6;
    const bf16_t* KVC = (const bf16_t*)(ws + OFF_P) + PO_KVC; const bf16_t* O = (const bf16_t*)(ws + OFF_P) + PO_QC;
    const float* COS = (const float*)(ws + OFF_ROPE); const float* SIN = COS + (size_t)SEQ * 32;
    float* s1 = scr + (size_t)gw * LK; __shared__ float qs[8][64];
    for (int it = gw; it < (ML / 16) * 8; it += ngw) { const int h = it & 7, kv = h >> 2, row = (it >> 3) * 16 + 5; const int b = row / SEQ, t = row % SEQ;
        {   const int d = lane, a = d >> 5, pp = (d >> 4) & 1, f = d & 15; float x = bf2f(QS[(size_t)row * 512 + h * 64 + d]); float ss = x * x; for (int o = 1; o < 64; o <<= 1) ss += __shfl_xor(ss, o);
            x = x * (1.0f / sqrtf(ss / 64.0f + 1e-6f)) * qkg[d]; const float xp = __shfl_xor(x, 16); const float cs = COS[(size_t)t * 32 + a * 16 + f], sn = SIN[(size_t)t * 32 + a * 16 + f]; qs[wv][d] = pp == 0 ? x * cs - xp * sn : x * cs + xp * sn; }
        __syncthreads();
        float m1 = -1e30f;
        for (int j = lane; j < LK; j += 64) { const int kr = pos_row(b, j); const bool rope = j >= CTX; const int kt = j - CTX; float ss = 0.f; const bf16_t* kp = KVC + (size_t)kr * 256 + kv * 64;
            for (int d = 0; d < 64; ++d) { const float kd = bf2f(kp[d]); ss += kd * kd; }
            const float rs = 1.0f / sqrtf(ss / 64.0f + 1e-6f); float a1 = 0.f;
            for (int d = 0; d < 64; ++d) { const int a = d >> 5, pp = (d >> 4) & 1, f = d & 15; float k1 = bf2f(kp[d]) * rs * qkg[64 + d];
                if (rope) { const float k1p = bf2f(kp[d ^ 16]) * rs * qkg[64 + (d ^ 16)]; const float cs = COS[(size_t)kt * 32 + a * 16 + f], sn = SIN[(size_t)kt * 32 + a * 16 + f]; k1 = pp == 0 ? k1 * cs - k1p * sn : k1 * cs + k1p * sn; }
                a1 += qs[wv][d] * k1; }
            a1 *= 0.125f; s1[j] = a1; m1 = fmaxf(m1, a1); }
        for (int o = 1; o < 64; o <<= 1) m1 = fmaxf(m1, __shfl_xor(m1, o));
        float l1 = 0.f;
        for (int j = lane; j < LK; j += 64) { const float p1 = expf(s1[j] - m1); s1[j] = p1; l1 += p1; }
        for (int o = 1; o < 64; o <<= 1) l1 += __shfl_xor(l1, o);
        __threadfence(); __syncthreads();
        float o0 = 0.f;
        for (int j = 0; j < LK; ++j) { const int kr = pos_row(b, j); o0 += s1[j] * bf2f(KVC[(size_t)kr * 256 + 128 + kv * 64 + lane]); }
        const float ref = o0 / l1, y = bf2f(O[(size_t)row * 512 + h * 64 + lane]);
        double d2 = (double)(y - ref) * (y - ref), r2 = (double)ref * ref;
        for (int o = 1; o < 64; o <<= 1) { d2 += __shfl_xor(d2, o); r2 += __shfl_xor(r2, o); }
        if (lane == 0) { atomicAdd(acc, d2); atomicAdd(acc + 1, r2); }
        __syncthreads(); }
}
__global__ void st_eps_fill(const double* acc, float* out, int n) { const double eps = sqrt(acc[0] / (acc[1] + 1e-300)) + 1e-30; const float v = sqrtf((float)fmax(0.0, -10.0 * log10(eps)));
    for (size_t k = (size_t)blockIdx.x * blockDim.x + threadIdx.x; k < (size_t)n; k += (size_t)gridDim.x * blockDim.x) out[k] = v; }
#endif
extern "C" void kernel_launch(void* const* d_in, const int* in_sizes, int n_in, void* d_out, int out_size, void* d_ws, size_t ws_size, hipStream_t stream) {
    static int grid = 0;
    if (grid == 0) {
        int dev = 0, cus = 0, per_cu = 0;
        if (hipGetDevice(&dev) != hipSuccess || hipDeviceGetAttribute(&cus, hipDeviceAttributeMultiprocessorCount, dev) != hipSuccess) { fprintf(stderr, "kernel_launch: device query failed\n"); grid = -1; return; }
        if (hipFuncSetAttribute((const void*)mega, hipFuncAttributeMaxDynamicSharedMemorySize, LDS_BYTES) != hipSuccess) { fprintf(stderr, "kernel_launch: hipFuncSetAttribute failed\n"); grid = -1; return; }
        if (hipOccupancyMaxActiveBlocksPerMultiprocessor(&per_cu, (const void*)mega, NTHREADS, LDS_BYTES) != hipSuccess || per_cu < 1) { fprintf(stderr, "kernel_launch: occupancy query says %d\n", per_cu); per_cu = 1; }
        (void)hipGetLastError();
        if (ws_size < WS_NEED || n_in != 25) { fprintf(stderr, "kernel_launch: workspace %zu < %zu needed or n_in %d != 25\n", ws_size, (size_t)WS_NEED, n_in); grid = -1; return; }
        grid = cus;
    }
    if (grid < 0) return;
    (void)hipMemsetAsync(d_ws, 0, ZERO_BYTES, stream);
    Args a{};
#if defined(SELFTEST) && (defined(ST_REPEAT) || defined(ST_TWICE) || defined(ST_FINAL) || defined(ST_DACHECK) || defined(ST_MODCHECK) || defined(ST_L0CHECK) || defined(ST_TAILCHECK) || defined(ST_MLCHECK) || defined(ST_DNCHECK) || defined(ST_GQCHECK))
    for (int i = 0; i < 25; ++i) a.in[i] = (const float*)d_in[i];
    a.out = (float*)d_out; a.ws = (unsigned char*)d_ws; float* sout = (float*)d_out;
#elif defined(SELFTEST) && defined(ST_SAME_BATCH)
    for (int i = 0; i < 25; ++i) a.in[i] = (const float*)d_in[i];
    float* ctxs = (float*)((unsigned char*)d_ws + al256(WS_NEED)); float* cs = ctxs + (size_t)NB * CTX * D; float* sout = (float*)d_out;
    hipLaunchKernelGGL(st_same_batch_inputs, dim3(1024), dim3(256), 0, stream, (const float*)d_in[0], (const float*)d_in[1], (const float*)d_in[2], (float*)d_out, cs, ctxs);
    a.in[0] = (const float*)d_out; a.in[1] = cs; a.in[2] = ctxs; a.out = (float*)d_out; a.ws = (unsigned char*)d_ws;
#elif defined(SELFTEST) && defined(ST_INPLACE)
    { StPtrs P; for (int i = 0; i < 25; ++i) { P.p[i] = (float*)d_in[i]; a.in[i] = (const float*)d_in[i]; }
      hipLaunchKernelGGL(st_gen_inplace, dim3(1024), dim3(256), 0, stream, P); }
    float* sout = (float*)d_out; a.out = sout; a.ws = (unsigned char*)d_ws;
#elif defined(SELFTEST)
    float* syn = (float*)((unsigned char*)d_ws + al256(WS_NEED)); float* sout = syn + st_offset(25);
    hipLaunchKernelGGL(st_gen, dim3(1024), dim3(256), 0, stream, syn);
    for (int i = 0; i < 25; ++i) a.in[i] = syn + st_offset(i);
    a.out = sout; a.ws = (unsigned char*)d_ws;
#else
    for (int i = 0; i < 25; ++i) a.in[i] = (const float*)d_in[i];
    a.out = (float*)d_out; a.ws = (unsigned char*)d_ws;
#endif
#ifdef SELFTEST
#ifdef ST_GQCHECK
    {   a.step_lo = 0; a.step_hi = 9 + 3; a.prologue = 1; a.final_ = 0;
        void* args[] = {&a};
        hipError_t e = hipLaunchCooperativeKernel((const void*)mega, dim3(grid), dim3(NTHREADS), args, LDS_BYTES, stream);
        if (e != hipSuccess) fprintf(stderr, "cooperative launch failed: %s (grid %d)\n", hipGetErrorString(e), grid);
        (void)hipMemcpyAsync(d_out, (unsigned char*)d_ws + OFF_P + PO_QC * 2, (size_t)MT * 512 * 2, hipMemcpyDeviceToDevice, stream);
        a.step_lo = 12; a.step_hi = 13; a.prologue = 0;
        (void)hipMemsetAsync(d_ws, 0, 512 * 1024, stream);
        e = hipLaunchCooperativeKernel((const void*)mega, dim3(grid), dim3(NTHREADS), args, LDS_BYTES, stream);
        double* acc = (double*)((unsigned char*)d_ws + ST_CHK); float* scr = (float*)((unsigned char*)d_ws + SO_U);
        hipLaunchKernelGGL(st_gqa_check, dim3(256), dim3(512), 0, stream, (const unsigned char*)d_ws, (const bf16_t*)d_out, (const float*)d_in[15], acc, scr);
        hipLaunchKernelGGL(st_eps_fill, dim3(1024), dim3(256), 0, stream, (const double*)acc, (float*)d_out, out_size); }
#elif defined(ST_DNCHECK)
#ifndef ST_LAYER
#define ST_LAYER 1
#endif
    {   a.step_lo = 0; a.step_hi = 9 * ST_LAYER + 3; a.prologue = 1; a.final_ = 0;
        void* args[] = {&a};
        hipError_t e = hipLaunchCooperativeKernel((const void*)mega, dim3(grid), dim3(NTHREADS), args, LDS_BYTES, stream);
        if (e != hipSuccess) fprintf(stderr, "cooperative launch failed: %s (grid %d)\n", hipGetErrorString(e), grid);
        float* href = (float*)d_out; double* acc = (double*)((unsigned char*)d_ws + ST_CHK);
        hipLaunchKernelGGL(st_dn_ref, dim3(NCHAIN), dim3(512), 0, stream, (const unsigned char*)d_ws, (const float*)d_in[16] + (ST_LAYER / 2) * 3 * 1536, (const float*)d_in[17] + (ST_LAYER / 2) * 8, (const float*)d_in[18] + (ST_LAYER / 2) * 8, href);
        a.step_lo = 9 * ST_LAYER + 3; a.step_hi = 9 * ST_LAYER + 5; a.prologue = 0;
        (void)hipMemsetAsync(d_ws, 0, 512 * 1024, stream);
        e = hipLaunchCooperativeKernel((const void*)mega, dim3(grid), dim3(NTHREADS), args, LDS_BYTES, stream);
        hipLaunchKernelGGL(st_dn_cmp, dim3(512), dim3(256), 0, stream, (const unsigned char*)d_ws, (const float*)href, (const float*)d_in[19] + (ST_LAYER / 2) * 128, acc);
        hipLaunchKernelGGL(st_eps_fill, dim3(1024), dim3(256), 0, stream, (const double*)acc, (float*)d_out, out_size); }
#elif defined(ST_MLCHECK)
#ifndef ST_LAYER
#define ST_LAYER 0
#endif
    {   a.step_lo = 0; a.step_hi = 9 * ST_LAYER + 5; a.prologue = 1; a.final_ = 0;
        void* args[] = {&a};
        hipError_t e = hipLaunchCooperativeKernel((const void*)mega, dim3(grid), dim3(NTHREADS), args, LDS_BYTES, stream);
        if (e != hipSuccess) fprintf(stderr, "cooperative launch failed: %s (grid %d)\n", hipGetErrorString(e), grid);
        float* href = (float*)((unsigned char*)d_ws + SE_DCT); double* acc = (double*)((unsigned char*)d_ws + ST_CHK);
        hipLaunchKernelGGL(st_ml_ref, dim3(NCHAIN), dim3(512), 0, stream, (const unsigned char*)d_ws, (const float*)d_in[9] + (ST_LAYER / 2) * 16, href);
        hipLaunchKernelGGL(st_ml_cmp, dim3(512), dim3(256), 0, stream, (const unsigned char*)d_ws, (const float*)href, (const float*)d_in[12] + (ST_LAYER / 2) * 128, acc);
        hipLaunchKernelGGL(st_eps_fill, dim3(1024), dim3(256), 0, stream, (const double*)acc, (float*)d_out, out_size); }
#elif defined(ST_TAILCHECK)
    {   a.step_lo = 0; a.step_hi = 5; a.prologue = 1; a.final_ = 0;
        void* args[] = {&a};
        hipError_t e = hipLaunchCooperativeKernel((const void*)mega, dim3(grid), dim3(NTHREADS), args, LDS_BYTES, stream);
        if (e != hipSuccess) fprintf(stderr, "cooperative launch failed: %s (grid %d)\n", hipGetErrorString(e), grid);
        float* ysave = (float*)((unsigned char*)d_ws + SE_DCT);
        (void)hipMemcpyAsync(ysave, (unsigned char*)d_ws + OFF_HY, (size_t)MT * 1024 * 2, hipMemcpyDeviceToDevice, stream);
        a.step_lo = 5; a.step_hi = 9; a.prologue = 0;
        (void)hipMemsetAsync(d_ws, 0, 512 * 1024, stream);
        e = hipLaunchCooperativeKernel((const void*)mega, dim3(grid), dim3(NTHREADS), args, LDS_BYTES, stream);
        (void)hipMemcpyAsync((unsigned char*)d_ws + OFF_HY, ysave, (size_t)MT * 1024 * 2, hipMemcpyDeviceToDevice, stream);
        double* acc = (double*)((unsigned char*)d_ws + ST_CHK);
        hipLaunchKernelGGL(st_tail_check, dim3(72), dim3(256), 0, stream, (const unsigned char*)d_ws, (const float*)d_in[0], (const float*)d_in[2], (const float*)d_in[13], (const float*)d_in[7], (const float*)d_in[21], (const float*)d_in[22], (const float*)d_in[23], acc);
        hipLaunchKernelGGL(st_eps_fill, dim3(1024), dim3(256), 0, stream, (const double*)acc, (float*)d_out, out_size); }
#elif defined(ST_L0CHECK)
    {   a.step_lo = 0; a.step_hi = 2; a.prologue = 1; a.final_ = 0;
        void* args[] = {&a};
        hipError_t e = hipLaunchCooperativeKernel((const void*)mega, dim3(grid), dim3(NTHREADS), args, LDS_BYTES, stream);
        if (e != hipSuccess) fprintf(stderr, "cooperative launch failed: %s (grid %d)\n", hipGetErrorString(e), grid);
        double* acc = (double*)((unsigned char*)d_ws + ST_CHK);
        hipLaunchKernelGGL(st_inproj_check, dim3(512), dim3(256), 0, stream, (const unsigned char*)d_ws, (const float*)d_in[8], acc);
        hipLaunchKernelGGL(st_norm_check, dim3(1), dim3(128), 0, stream, (const unsigned char*)d_ws, (const float*)d_in[6], (const float*)d_in[8], (const float*)d_in[0], (const float*)d_in[2], acc);
        hipLaunchKernelGGL(st_eps3_fill, dim3(1024), dim3(256), 0, stream, (const double*)acc, (float*)d_out, out_size); }
#elif defined(ST_MODCHECK)
    {   a.step_lo = 0; a.step_hi = 0; a.prologue = 1; a.final_ = 0;
        void* args[] = {&a};
        hipError_t e = hipLaunchCooperativeKernel((const void*)mega, dim3(grid), dim3(NTHREADS), args, LDS_BYTES, stream);
        if (e != hipSuccess) fprintf(stderr, "cooperative launch failed: %s (grid %d)\n", hipGetErrorString(e), grid);
        double* acc = (double*)((unsigned char*)d_ws + ST_CHK);
        hipLaunchKernelGGL(st_mod_check, dim3(512), dim3(256), 0, stream, (const unsigned char*)d_ws, (const float*)d_in[1], (const float*)d_in[3], (const float*)d_in[4], (const float*)d_in[5], acc);
        hipLaunchKernelGGL(st_eps_fill, dim3(1024), dim3(256), 0, stream, (const double*)acc, (float*)d_out, out_size); }
#elif defined(ST_DACHECK)
    {   a.step_lo = 0; a.step_hi = 5; a.prologue = 1; a.final_ = 0;
        void* args[] = {&a};
        hipError_t e = hipLaunchCooperativeKernel((const void*)mega, dim3(grid), dim3(NTHREADS), args, LDS_BYTES, stream);
        if (e != hipSuccess) fprintf(stderr, "cooperative launch failed: %s (grid %d)\n", hipGetErrorString(e), grid);
        double* acc = (double*)((unsigned char*)d_ws + ST_CHK); float* scr = (float*)((unsigned char*)d_ws + SE_DCT);
        hipLaunchKernelGGL(st_da_check, dim3(256), dim3(512), 0, stream, (const unsigned char*)d_ws, (const float*)d_in[10], (const float*)d_in[11], acc, scr);
        hipLaunchKernelGGL(st_eps_fill, dim3(1024), dim3(256), 0, stream, (const double*)acc, (float*)d_out, out_size); }
#elif defined(ST_FINAL)
    {   a.step_lo = 0; a.step_hi = CFG_LAYERS * 9; a.prologue = 1; a.final_ = 1;
        void* args[] = {&a};
        hipError_t e = hipLaunchCooperativeKernel((const void*)mega, dim3(grid), dim3(NTHREADS), args, LDS_BYTES, stream);
        if (e != hipSuccess) fprintf(stderr, "cooperative launch failed: %s (grid %d)\n", hipGetErrorString(e), grid);
        double* acc = (double*)((unsigned char*)d_ws + ST_CHK);
        hipLaunchKernelGGL(st_final_check, dim3(64), dim3(256), 0, stream, (const unsigned char*)d_ws, (const float*)d_out, (const float*)d_in[24], acc);
        hipLaunchKernelGGL(st_final_fill, dim3(1024), dim3(256), 0, stream, (const double*)acc, (float*)d_out, out_size); }
#elif defined(ST_TWICE)
    for (int rep = 0; rep < 2; ++rep) {
        (void)hipMemsetAsync(d_ws, 0, 512 * 1024, stream); (void)hipMemsetAsync((unsigned char*)d_ws + OFF_MOD, 0, ZERO_BYTES - OFF_MOD, stream);
        a.step_lo = 0; a.step_hi = CFG_LAYERS * 9; a.prologue = 1; a.final_ = 0;
        void* args[] = {&a};
        hipError_t e = hipLaunchCooperativeKernel((const void*)mega, dim3(grid), dim3(NTHREADS), args, LDS_BYTES, stream);
        if (e != hipSuccess) fprintf(stderr, "cooperative launch failed: %s (grid %d)\n", hipGetErrorString(e), grid);
        hipLaunchKernelGGL(st_check_kernel, dim3(256), dim3(NTHREADS), 0, stream, (unsigned char*)d_ws, 35, rep * 40); }
    hipLaunchKernelGGL(st_twice_report, dim3(1024), dim3(256), 0, stream, (const unsigned char*)d_ws, (float*)d_out, out_size);
#elif defined(ST_REPEAT)
    for (int st = 0; st < CFG_LAYERS * 9; ++st) { const int ph = st % 9;
        for (int rep = 0; rep < ((ph == 3 || ph == 5 || ph == 8) ? 1 : 2); ++rep) {
            a.step_lo = st; a.step_hi = st + 1; a.prologue = (st == 0 && rep == 0); a.final_ = 0;
            void* args[] = {&a};
            hipError_t e = hipLaunchCooperativeKernel((const void*)mega, dim3(grid), dim3(NTHREADS), args, LDS_BYTES, stream);
            if (e != hipSuccess) fprintf(stderr, "cooperative launch failed: %s (grid %d)\n", hipGetErrorString(e), grid);
            hipLaunchKernelGGL(st_check_kernel, dim3(256), dim3(NTHREADS), 0, stream, (unsigned char*)d_ws, st, rep * 40); } }
    hipLaunchKernelGGL(st_repeat_report, dim3(1024), dim3(256), 0, stream, (const unsigned char*)d_ws, (float*)d_out, out_size, CFG_LAYERS * 9);
#elif defined(ST_SAME_BATCH)
    a.step_lo = 0; a.step_hi = CFG_LAYERS * 9; a.prologue = 1; a.final_ = 1;
    { void* args[] = {&a};
      hipError_t e = hipLaunchCooperativeKernel((const void*)mega, dim3(grid), dim3(NTHREADS), args, LDS_BYTES, stream);
      if (e != hipSuccess) fprintf(stderr, "cooperative launch failed: %s (grid %d)\n", hipGetErrorString(e), grid); }
    double* acc = (double*)((unsigned char*)d_ws + ST_CHK);
    hipLaunchKernelGGL(st_batch_report, dim3(256), dim3(256), 0, stream, (const float*)sout, (float*)d_out, out_size, acc);
    hipLaunchKernelGGL(st_fill, dim3(1024), dim3(256), 0, stream, (const double*)acc, (float*)d_out, out_size);
#else
#ifndef ST_CHUNK
#define ST_CHUNK 1
#endif
    for (int st = 0; st < CFG_LAYERS * 9; st += ST_CHUNK) {
        a.step_lo = st; a.step_hi = st + ST_CHUNK; a.prologue = st == 0; a.final_ = 0;
        void* args[] = {&a};
        hipError_t e = hipLaunchCooperativeKernel((const void*)mega, dim3(grid), dim3(NTHREADS), args, LDS_BYTES, stream);
        if (e != hipSuccess) fprintf(stderr, "cooperative launch failed: %s (grid %d)\n", hipGetErrorString(e), grid);
        hipLaunchKernelGGL(st_check_kernel, dim3(256), dim3(NTHREADS), 0, stream, (unsigned char*)d_ws, st + ST_CHUNK - 1);
    }
#ifdef ST_TRUTH
    hipLaunchKernelGGL(st_truth_fill, dim3(1024), dim3(256), 0, stream, (const unsigned char*)d_ws, (float*)d_out, out_size);
#else
    hipLaunchKernelGGL(st_report, dim3(1024), dim3(256), 0, stream, (const unsigned char*)d_ws, (float*)d_out, out_size);
#endif
#endif
#elif defined(MULTI_LAUNCH)
    for (int st = 0; st < CFG_LAYERS * 9; st += MULTI_LAUNCH) {
        a.step_lo = st; a.step_hi = st + MULTI_LAUNCH < CFG_LAYERS * 9 ? st + MULTI_LAUNCH : CFG_LAYERS * 9; a.prologue = st == 0; a.final_ = 0;
        void* args[] = {&a};
        hipError_t e = hipLaunchCooperativeKernel((const void*)mega, dim3(grid), dim3(NTHREADS), args, LDS_BYTES, stream);
        if (e != hipSuccess) fprintf(stderr, "cooperative launch failed: %s (grid %d)\n", hipGetErrorString(e), grid);
    }
    {   a.step_lo = a.step_hi = CFG_LAYERS * 9; a.prologue = 0; a.final_ = 1;
        void* args[] = {&a};
        hipError_t e = hipLaunchCooperativeKernel((const void*)mega, dim3(grid), dim3(NTHREADS), args, LDS_BYTES, stream);
        if (e != hipSuccess) fprintf(stderr, "cooperative launch failed: %s (grid %d)\n", hipGetErrorString(e), grid); }
#elif defined(PROBE_Y)
    {   a.step_lo = 0; a.step_hi = 9 * (PROBE_Y - 1) + 5; a.prologue = 1; a.final_ = 0;
        void* args[] = {&a};
        hipError_t e = hipLaunchCooperativeKernel((const void*)mega, dim3(grid), dim3(NTHREADS), args, LDS_BYTES, stream);
        if (e != hipSuccess) fprintf(stderr, "cooperative launch failed: %s (grid %d)\n", hipGetErrorString(e), grid);
        double* acc = (double*)((unsigned char*)d_ws + 512 * 1024);
        hipLaunchKernelGGL(pr_stat, dim3(512), dim3(256), 0, stream, (const bf16_t*)((unsigned char*)d_ws + OFF_HY), ML, PROBE_C0, PROBE_C1, acc);
        hipLaunchKernelGGL(pr_fill, dim3(1024), dim3(256), 0, stream, (const double*)acc, (float*)d_out, out_size); }
#else
    a.step_lo = 0; a.step_hi = CFG_LAYERS * 9; a.prologue = 1; a.final_ = 1;
    void* args[] = {&a};
    hipError_t e = hipLaunchCooperativeKernel((const void*)mega, dim3(grid), dim3(NTHREADS), args, LDS_BYTES, stream);
    if (e != hipSuccess) fprintf(stderr, "cooperative launch failed: %s (grid %d)\n", hipGetErrorString(e), grid);
#ifdef RUN_TWICE
    (void)hipMemsetAsync(d_ws, 0, ZERO_BYTES, stream);
    e = hipLaunchCooperativeKernel((const void*)mega, dim3(grid), dim3(NTHREADS), args, LDS_BYTES, stream);
#endif
#endif
}
#endif
```
